# Optimizing an MI355X kernel written in HIP

```python
import jax, jax.numpy as jnp
from jax import lax
import numpy as np

D_MODEL = 1024
BATCH = 16
SEQ = 4096
DEPTH = 4

GRID_W = 64
CTX_LEN = 256
HEAD_DIM = 64
RET_HEADS = 4
RET_DK = 64
RET_DV = 128
RET_CHUNK = 128
WIN_Q_HEADS = 4
WIN_KV_HEADS = 2
WINDOW = 128
GLB_Q_HEADS = 4
GLB_KV_HEADS = 2
BLOCK_Q = 128
ROPE_BASE = 10000.0
N_EXPERTS = 16
N_GROUPS = 4
EXPERTS_PER_GROUP = N_EXPERTS // N_GROUPS
TOP_K = 2
D_EXPERT = 1024
MOE_BLOCK = 256
EPS = 1e-6
ADA_INIT = 0.3
NEG_INF = -1e30
SPLIT_SIZES = (RET_HEADS * RET_DK, RET_HEADS * RET_DK, RET_HEADS * RET_DV, RET_HEADS * RET_DV,
               WIN_Q_HEADS * HEAD_DIM, WIN_KV_HEADS * HEAD_DIM, WIN_KV_HEADS * HEAD_DIM,
               GLB_Q_HEADS * HEAD_DIM, GLB_KV_HEADS * HEAD_DIM, GLB_KV_HEADS * HEAD_DIM)
D_IN = sum(SPLIT_SIZES)
D_MIX = RET_HEADS * RET_DV + WIN_Q_HEADS * HEAD_DIM + GLB_Q_HEADS * HEAD_DIM

kernel_name = 'hybrid_parallel_heads_retention_swa_axial_moe_dit'


def _rms(x, gain):
    x32 = x.astype(jnp.float32)
    y = x32 * lax.rsqrt(jnp.mean(x32 * x32, axis=-1, keepdims=True) + EPS)
    return (y * gain.astype(jnp.float32)).astype(x.dtype)


def _modulate(h, shift, scale):
    return h * (1 + scale) + shift


def _split_cols(p):
    outs, start = [], 0
    for s in SPLIT_SIZES:
        outs.append(p[..., start:start + s])
        start += s
    return outs


def _heads(t, n_heads):
    b, l, _ = t.shape
    return t.reshape(b, l, n_heads, -1).transpose(0, 2, 1, 3)


def _rope_tables(n_tok, dtype):
    rows = n_tok // GRID_W
    row = jnp.repeat(jnp.arange(rows), GRID_W).astype(jnp.float32)
    col = (jnp.arange(rows * GRID_W) % GRID_W).astype(jnp.float32)
    half = HEAD_DIM // 2
    inv = jnp.power(ROPE_BASE, -jnp.arange(0, half, 2, dtype=jnp.float32) / half)
    ang = jnp.concatenate([row[:, None] * inv, col[:, None] * inv], -1)
    return jnp.cos(ang).astype(dtype), jnp.sin(ang).astype(dtype)


def _rope_2d(x, cos, sin):
    q = HEAD_DIM // 4
    parts = []
    for a in range(2):
        xa = x[..., 2 * a * q:(2 * a + 2) * q]
        x1, x2 = xa[..., :q], xa[..., q:]
        c, s = cos[:, a * q:(a + 1) * q], sin[:, a * q:(a + 1) * q]
        parts += [x1 * c - x2 * s, x2 * c + x1 * s]
    return jnp.concatenate(parts, -1)


def _attn_prep(q, k, v, n_q, n_kv, gain, rope):
    q = _rms(_heads(q, n_q), gain[0])
    k = _rms(_heads(k, n_kv), gain[1])
    v = _heads(v, n_kv)
    if rope is not None:
        q = _rope_2d(q, *rope)
        k = _rope_2d(k, *rope)
    b, _, l, _ = q.shape
    q = (q * HEAD_DIM ** -0.5).reshape(b, n_kv, n_q // n_kv, l, HEAD_DIM)
    return q, k, v


def _attend(q, k, v, mask, sink):
    s = jnp.einsum('bhgqd,bhkd->bhgqk', q, k).astype(jnp.float32)
    if mask is not None:
        s = jnp.where(mask, s, NEG_INF)
    m = jnp.max(s, axis=-1, keepdims=True)
    if sink is not None:
        sk = sink.astype(jnp.float32)[None, :, :, None, None]
        m = jnp.maximum(m, sk)
    p = jnp.exp(s - m)
    den = jnp.sum(p, axis=-1, keepdims=True)
    if sink is not None:
        den = den + jnp.exp(sk - m)
    return jnp.einsum('bhgqk,bhkd->bhgqd', (p / den).astype(v.dtype), v)


def _to_blocks(q):
    b, hk, g, l, hd = q.shape
    return jnp.moveaxis(q.reshape(b, hk, g, l // BLOCK_Q, BLOCK_Q, hd), 3, 0)


def _from_blocks(o):
    nb, b, hk, g, bq, hd = o.shape
    return jnp.moveaxis(o, 0, 3).reshape(b, hk, g, nb * bq, hd)


def _merge_heads(o):
    b, hk, g, l, hd = o.shape
    return o.reshape(b, hk * g, l, hd).transpose(0, 2, 1, 3).reshape(b, l, hk * g * hd)


def _ret_scan(q, k, v, log_g, s0):
    b, h, l, _ = q.shape
    n = l // RET_CHUNK
    idx = jnp.arange(RET_CHUNK, dtype=jnp.float32)
    diff = idx[:, None] - idx[None, :]
    d_in = jnp.where(diff >= 0, jnp.exp(jnp.maximum(diff, 0.0) * log_g[:, None, None]), 0.0).astype(q.dtype)
    xi = jnp.exp((idx + 1.0) * log_g[:, None]).astype(q.dtype)[..., None]
    zeta = jnp.exp((RET_CHUNK - 1.0 - idx) * log_g[:, None]).astype(q.dtype)[..., None]
    g_c = jnp.exp(RET_CHUNK * log_g).astype(q.dtype)[:, None, None]

    def chunks(t):
        return jnp.moveaxis(t.reshape(b, h, n, RET_CHUNK, t.shape[-1]), 2, 0)

    def step(s, inp):
        qi, ki, vi = inp
        att = jnp.einsum('bhqd,bhkd->bhqk', qi, ki) * d_in
        o = jnp.einsum('bhqk,bhkv->bhqv', att, vi) + jnp.einsum('bhqd,bhdv->bhqv', qi, s) * xi
        s = g_c * s + jnp.einsum('bhkd,bhkv->bhdv', ki * zeta, vi)
        return s, o

    s_fin, o = lax.scan(step, s0, (chunks(q), chunks(k), chunks(v)))
    return jnp.moveaxis(o, 0, 2).reshape(b, h, l, -1), s_fin


def _ret_out(o, g):
    o32 = o.astype(jnp.float32)
    mu = jnp.mean(o32, axis=-1, keepdims=True)
    var = jnp.mean(jnp.square(o32 - mu), axis=-1, keepdims=True)
    o = ((o32 - mu) * lax.rsqrt(var + EPS)).astype(g.dtype)
    b, h, l, dv = o.shape
    return jax.nn.silu(g) * o.transpose(0, 2, 1, 3).reshape(b, l, h * dv)


def _retention(q, k, v, g, qc, kc, vc, gc, decay_logit, need_ctx):
    log_g = jax.nn.log_sigmoid(decay_logit.astype(jnp.float32))

    def prep(q, k, v):
        return _heads(q, RET_HEADS), _heads(k, RET_HEADS) * RET_DK ** -0.5, _heads(v, RET_HEADS)

    q, k, v = prep(q, k, v)
    qc, kc, vc = prep(qc, kc, vc)
    flip = lambda t: jnp.flip(t, axis=2)
    s0 = jnp.zeros((q.shape[0], RET_HEADS, RET_DK, RET_DV), q.dtype)
    oc_f, s_f = _ret_scan(qc, kc, vc, log_g[0], s0)
    oc_b, s_b = _ret_scan(flip(qc), flip(kc), flip(vc), log_g[1], s0)
    o_f, _ = _ret_scan(q, k, v, log_g[0], s_f)
    o_b, _ = _ret_scan(flip(q), flip(k), flip(v), log_g[1], s_b)
    y = _ret_out(o_f + flip(o_b), g)
    yc = _ret_out(oc_f + flip(oc_b), gc) if need_ctx else None
    return y, yc


def _window_mixer(q, k, v, qc, kc, vc, gain, sink, rope, need_ctx):
    q, k, v = _attn_prep(q, k, v, WIN_Q_HEADS, WIN_KV_HEADS, gain, rope)
    qc, kc, vc = _attn_prep(qc, kc, vc, WIN_Q_HEADS, WIN_KV_HEADS, gain, None)
    sink = sink.reshape(WIN_KV_HEADS, WIN_Q_HEADS // WIN_KV_HEADS)
    l = q.shape[3]
    nb = l // BLOCK_Q
    span = BLOCK_Q + 2 * WINDOW
    pad = ((0, 0), (0, 0), (WINDOW, WINDOW), (0, 0))
    kp, vp = jnp.pad(k, pad), jnp.pad(v, pad)
    off = jnp.arange(span) - WINDOW
    band = jnp.abs(off[None, :] - jnp.arange(BLOCK_Q)[:, None]) <= WINDOW
    ctx_ok = jnp.ones((BLOCK_Q, kc.shape[2]), bool)

    def block(args):
        qb, i = args
        start = i * BLOCK_Q
        kw = lax.dynamic_slice_in_dim(kp, start, span, axis=2)
        vw = lax.dynamic_slice_in_dim(vp, start, span, axis=2)
        kpos = start + off
        mask = band & ((kpos >= 0) & (kpos < l))[None, :]
        return _attend(qb, jnp.concatenate([kw, kc], 2), jnp.concatenate([vw, vc], 2),
                       jnp.concatenate([mask, ctx_ok], 1), sink)

    o = lax.map(block, (_to_blocks(q), jnp.arange(nb)))
    y = _merge_heads(_from_blocks(o))
    yc = _merge_heads(_attend(qc, kc, vc, None, sink)) if need_ctx else None
    return y, yc


def _global_mixer(q, k, v, qc, kc, vc, gain, rope, need_ctx):
    q, k, v = _attn_prep(q, k, v, GLB_Q_HEADS, GLB_KV_HEADS, gain, rope)
    qc, kc, vc = _attn_prep(qc, kc, vc, GLB_Q_HEADS, GLB_KV_HEADS, gain, None)
    k_all = jnp.concatenate([k, kc], 2)
    v_all = jnp.concatenate([v, vc], 2)
    o = lax.map(lambda qb: _attend(qb, k_all, v_all, None, None), _to_blocks(q))
    y = _merge_heads(_from_blocks(o))
    yc = _merge_heads(_attend(qc, kc, vc, None, None)) if need_ctx else None
    return y, yc


def _mixers(px, pc, ret_decay, win_gain, win_sink, glb_gain, rope, need_ctx):
    rq, rk, rv, rg, wq, wk, wv, gq, gk, gv = _split_cols(px)
    rqc, rkc, rvc, rgc, wqc, wkc, wvc, gqc, gkc, gvc = _split_cols(pc)
    yr, yrc = _retention(rq, rk, rv, rg, rqc, rkc, rvc, rgc, ret_decay, need_ctx)
    yw, ywc = _window_mixer(wq, wk, wv, wqc, wkc, wvc, win_gain, win_sink, rope, need_ctx)
    yg, ygc = _global_mixer(gq, gk, gv, gqc, gkc, gvc, glb_gain, rope, need_ctx)
    y = jnp.concatenate([yr, yw, yg], -1)
    yc = jnp.concatenate([yrc, ywc, ygc], -1) if need_ctx else None
    return y, yc


def _route(h, w_router, b_router):
    s = jax.nn.sigmoid(jnp.dot(h, w_router).astype(jnp.float32))
    grouped = (s + b_router.astype(jnp.float32)).reshape(-1, N_GROUPS, EXPERTS_PER_GROUP)
    gscore = lax.top_k(grouped, TOP_K)[0].sum(-1)
    grp = jnp.argmax(gscore, axis=-1)
    cand = jnp.take_along_axis(grouped, grp[:, None, None], axis=1)[:, 0]
    _, loc = lax.top_k(cand, TOP_K)
    e_idx = grp[:, None] * EXPERTS_PER_GROUP + loc
    w = jnp.take_along_axis(s, e_idx, axis=1)
    return e_idx, w / jnp.sum(w, axis=-1, keepdims=True)


def _moe(h, w_router, b_router, w_gu, w_down):
    t, d = h.shape
    e_idx, gate = _route(h, w_router, b_router)
    flat_e = e_idx.reshape(-1)
    order = jnp.argsort(flat_e)
    e_sorted = flat_e[order]
    tok = order // TOP_K
    counts = jnp.bincount(flat_e, length=N_EXPERTS)
    padded = (counts + MOE_BLOCK - 1) // MOE_BLOCK * MOE_BLOCK
    pad_end = jnp.cumsum(padded)
    dest = (pad_end - padded)[e_sorted] + jnp.arange(t * TOP_K) - (jnp.cumsum(counts) - counts)[e_sorted]
    n_blocks = (t * TOP_K + N_EXPERTS * (MOE_BLOCK - 1) + MOE_BLOCK - 1) // MOE_BLOCK
    xp = jnp.zeros((n_blocks * MOE_BLOCK, d), h.dtype).at[dest].set(h[tok])
    blk_e = jnp.minimum(jnp.searchsorted(pad_end, jnp.arange(n_blocks) * MOE_BLOCK, side='right'), N_EXPERTS - 1)

    def expert_block(args):
        xb, e = args
        a, u = jnp.split(xb @ w_gu[e], 2, axis=-1)
        return (jax.nn.silu(a) * u) @ w_down[e]

    yp = lax.map(expert_block, (xp.reshape(n_blocks, MOE_BLOCK, d), blk_e)).reshape(-1, d)
    y = yp[dest] * gate.reshape(-1)[order][:, None].astype(h.dtype)
    return jnp.zeros_like(h).at[tok].add(y)


def setup_inputs(seed: int = 0) -> dict:
    key = jax.random.key(seed)
    ks = jax.random.split(key, 20)
    f32 = jnp.float32
    nrm = lambda k, shape, scale: jax.random.normal(k, shape, f32) * scale
    base_gamma = 1.0 - jnp.power(2.0, -5.0 - jnp.arange(RET_HEADS, dtype=f32))
    base_logit = jnp.log(base_gamma) - jnp.log1p(-base_gamma)
    return {
        'x': nrm(ks[0], (BATCH, SEQ, D_MODEL), 1.0),
        'c': nrm(ks[1], (BATCH, D_MODEL), 1.0),
        'ctx': nrm(ks[2], (BATCH, CTX_LEN, D_MODEL), 1.0),
        'c_ctx': nrm(ks[3], (D_MODEL,), 1.0),
        'ada_w': nrm(ks[4], (DEPTH, D_MODEL, 6 * D_MODEL), ADA_INIT * D_MODEL ** -0.5),
        'ada_b': nrm(ks[5], (DEPTH, 6 * D_MODEL), 0.02),
        'norm1': 1.0 + nrm(ks[6], (DEPTH, D_MODEL), 0.02),
        'norm2': 1.0 + nrm(ks[7], (DEPTH, D_MODEL), 0.02),
        'w_in': nrm(ks[8], (DEPTH, D_MODEL, D_IN), D_MODEL ** -0.5),
        'w_out': nrm(ks[9], (DEPTH, D_MIX, D_MODEL), D_MIX ** -0.5),
        'ret_decay': base_logit[None, None, :] + nrm(ks[10], (DEPTH, 2, RET_HEADS), 0.1),
        'win_qk_gain': 1.0 + nrm(ks[11], (DEPTH, 2, HEAD_DIM), 0.02),
        'win_sink': nrm(ks[12], (DEPTH, WIN_Q_HEADS), 0.5),
        'glb_qk_gain': 1.0 + nrm(ks[13], (DEPTH, 2, HEAD_DIM), 0.02),
        'w_router': nrm(ks[14], (D_MODEL, N_EXPERTS), D_MODEL ** -0.5),
        'b_router': nrm(ks[15], (N_EXPERTS,), 0.01),
        'w_gate_up': nrm(ks[16], (DEPTH, N_EXPERTS, D_MODEL, 2 * D_EXPERT), D_MODEL ** -0.5),
        'w_down': nrm(ks[17], (DEPTH, N_EXPERTS, D_EXPERT, D_MODEL), D_EXPERT ** -0.5),
    }


def reference(x, c, ctx, c_ctx, ada_w, ada_b, norm1, norm2, w_in, w_out, ret_decay, win_qk_gain, win_sink,
              glb_qk_gain, w_router, b_router, w_gate_up, w_down):
    b, l, d = x.shape
    rope = _rope_tables(l, x.dtype)
    sc, sc_ctx = jax.nn.silu(c), jax.nn.silu(c_ctx)
    for i in range(DEPTH):
        last = i == DEPTH - 1
        mod = (sc @ ada_w[i] + ada_b[i])[:, None, :]
        mod_c = sc_ctx @ ada_w[i] + ada_b[i]
        sh1, s1, g1, sh2, s2, g2 = jnp.split(mod, 6, axis=-1)
        sh1c, s1c, g1c, sh2c, s2c, g2c = jnp.split(mod_c, 6, axis=-1)
        px = _modulate(_rms(x, norm1[i]), sh1, s1) @ w_in[i]
        pc = _modulate(_rms(ctx, norm1[i]), sh1c, s1c) @ w_in[i]
        yx, yc = _mixers(px, pc, ret_decay[i], win_qk_gain[i], win_sink[i], glb_qk_gain[i], rope, not last)
        x = x + g1 * (yx @ w_out[i])
        hx = _modulate(_rms(x, norm2[i]), sh2, s2).reshape(b * l, d)
        if last:
            x = x + g2 * _moe(hx, w_router, b_router, w_gate_up[i], w_down[i]).reshape(b, l, d)
        else:
            ctx = ctx + g1c * (yc @ w_out[i])
            hc = _modulate(_rms(ctx, norm2[i]), sh2c, s2c).reshape(-1, d)
            y = _moe(jnp.concatenate([hx, hc], 0), w_router, b_router, w_gate_up[i], w_down[i])
            x = x + g2 * y[:b * l].reshape(b, l, d)
            ctx = ctx + g2c * y[b * l:].reshape(ctx.shape)
    return x
```

```cpp
#include <hip/hip_runtime.h>
#include <cstdio>
#include <cstdint>

#define GAS __attribute__((address_space(1)))
#define LAS __attribute__((address_space(3)))
typedef unsigned short bf16_t;
typedef short bf16x8 __attribute__((ext_vector_type(8)));
typedef float f32x4 __attribute__((ext_vector_type(4)));
typedef float f32x2 __attribute__((ext_vector_type(2)));
typedef float f32x16 __attribute__((ext_vector_type(16)));
typedef unsigned u32x4 __attribute__((ext_vector_type(4)));
typedef unsigned u32x2 __attribute__((ext_vector_type(2)));

constexpr int DM = 1024, NB = 16, SEQ = 4096, CTX = 256, TPB = SEQ + CTX, MROWS = NB * TPB, DEPTH = 4;
constexpr int DIN = 2560;
constexpr int C_RQ = 0, C_RK = 256, C_RV = 512, C_RG = 1024, C_WQ = 1536, C_WK = 1792, C_WV = 1920, C_GQ = 2048, C_GK = 2304, C_GV = 2432;
constexpr int NE = 16, FF = 1024, NCH = TPB / 128;
constexpr float EPS = 1e-6f;
constexpr float LOG2E = 1.4426950408889634f;
constexpr float QSCALE = 0.125f * LOG2E;

__device__ __forceinline__ unsigned f2bf(float f) { unsigned u = __builtin_bit_cast(unsigned, f); return (u + 0x7fffu + ((u >> 16) & 1u)) >> 16; }
__device__ __forceinline__ unsigned pk2(float lo, float hi) { return f2bf(lo) | (f2bf(hi) << 16); }
__device__ __forceinline__ float bf2f(unsigned short h) { return __builtin_bit_cast(float, (unsigned)h << 16); }
__device__ __forceinline__ float bflo(unsigned w) { return __builtin_bit_cast(float, w << 16); }
__device__ __forceinline__ float bfhi(unsigned w) { return __builtin_bit_cast(float, w & 0xffff0000u); }

namespace pg8 {
constexpr int BM = 256, BK = 64, HALF = 128, HTB = HALF * BK * 2, STAGE_BYTES = 8 * HTB, NXCD = 8, WGM = 8;
__host__ __device__ __forceinline__ int lds_byte(int r, int c) { const int st = (r >> 4) * 2 + (c >> 5), rr = r & 15, cc = c & 31, ob = rr * 64 + cc * 2; return st * 1024 + (ob ^ (((ob >> 9) & 1) << 5)); }
__host__ __device__ __forceinline__ void stage_rc(int b, int& R, int& C) { const int st = b / 1024, sb = b % 1024, swz = sb ^ (((sb >> 9) & 1) << 5); R = (st >> 1) * 16 + swz / 64; C = (st & 1) * 32 + (swz % 64) / 2; }
__host__ __device__ __forceinline__ int perm32(int rho) { const int n = rho >> 4, i = rho & 15; return 8 * (i >> 2) + 4 * n + (i & 3); }

struct Unit { int pm, pn; };
struct Gemm { const bf16_t* A; const bf16_t* Bt; int M, N, K; };

struct StaticOrder {
    static constexpr bool GATHER = false;
    int nM, nN, nwg, G, c;
    __device__ void init(int M, int N, int G_, int c_) { nM = M / BM; nN = N / BM; nwg = nM * nN; G = G_; c = c_; }
    __device__ bool next(int i, Unit& u) const {
        const long L = (long)i * G + c; if (L >= nwg) return false;
        int wgid = (int)L; { const int q = nwg / NXCD, r = nwg % NXCD, xcd = wgid % NXCD, off = wgid / NXCD; wgid = (xcd < r ? xcd * (q + 1) : r * (q + 1) + (xcd - r) * q) + off; }
        const int nig = WGM * nN, gid = wgid / nig, fm = gid * WGM, gsz = (nM - fm) < WGM ? (nM - fm) : WGM;
        u.pm = fm + ((wgid % nig) % gsz); u.pn = (wgid % nig) / gsz; return true;
    }
    __device__ __forceinline__ unsigned arow(const Unit&, int) const { return 0u; }
};

__device__ __forceinline__ unsigned cvt_pk_bf16(float lo, float hi) { unsigned r; asm volatile("v_cvt_pk_bf16_f32 %0, %1, %2" : "=v"(r) : "v"(lo), "v"(hi)); return r; }

struct EpiBf16 {
    static constexpr bool PERM = true;
    bf16_t* O; int ldc;
    __device__ __forceinline__ void operator()(const f32x4 (&acc)[2][2][4][2], const Unit& u, int wr, int wc, int fr, int fq) const {
        const int row0 = u.pm * BM + wr * 64 + fr; const int col0 = u.pn * BM + wc * 32 + 8 * fq;
#pragma unroll
        for (int ai = 0; ai < 2; ++ai)
#pragma unroll
            for (int m = 0; m < 4; ++m) { const unsigned off = ((unsigned)(row0 + ai * HALF + m * 16) * (unsigned)ldc + (unsigned)col0) * 2u;
#pragma unroll
                for (int bj = 0; bj < 2; ++bj) { const f32x4 v0 = acc[ai][bj][m][0], v1 = acc[ai][bj][m][1];
                    u32x4 w; w.x = cvt_pk_bf16(v0[0], v0[1]); w.y = cvt_pk_bf16(v0[2], v0[3]); w.z = cvt_pk_bf16(v1[0], v1[1]); w.w = cvt_pk_bf16(v1[2], v1[3]);
                    *(u32x4*)((char*)O + off + bj * HALF * 2) = w; } }
    }
};

struct EpiResid {
    static constexpr bool PERM = false;
    float* X; const float* gate;
    __device__ __forceinline__ void operator()(const f32x4 (&acc)[2][2][4][2], const Unit& u, int wr, int wc, int fr, int fq) const {
        const int set = (u.pm % 17 == 0) ? 16 : (u.pm / 17);
        const float* gp = gate + (size_t)set * 6 * DM;
        const int col0 = u.pn * BM + wc * 32 + 4 * fq;
        f32x4 gv[2][2];
#pragma unroll
        for (int bj = 0; bj < 2; ++bj)
#pragma unroll
            for (int n = 0; n < 2; ++n) gv[bj][n] = *(const f32x4*)(gp + col0 + bj * HALF + n * 16);
#pragma unroll
        for (int ai = 0; ai < 2; ++ai)
#pragma unroll
            for (int m = 0; m < 4; ++m) { const unsigned off = ((unsigned)(u.pm * BM + ai * HALF + wr * 64 + m * 16 + fr) * (unsigned)DM + (unsigned)col0) * 4u;
#pragma unroll
                for (int bj = 0; bj < 2; ++bj)
#pragma unroll
                    for (int n = 0; n < 2; ++n) { f32x4* p = (f32x4*)((char*)X + off + (bj * HALF + n * 16) * 4); *p = *p + gv[bj][n] * acc[ai][bj][m][n]; } }
    }
};

template <class Epi, class Sched, bool ALIGN_EPI>
__device__ __forceinline__ void gemm_phase(LAS unsigned char* lds, const Gemm g, const Sched& S, const Epi& E, const int tid) {
    const int wid = __builtin_amdgcn_readfirstlane(tid >> 6), lane = tid & 63, wr = wid >> 2, wc = wid & 3, fr = lane & 15, fq = lane >> 4;
    const int K = g.K, nt = K / BK;
    unsigned voffB[2], vA[2][2], vAn[2][2]; int sR[2], sC[2];
#pragma unroll
    for (int i = 0; i < 2; ++i) { int R, C; stage_rc(tid * 16 + i * 8192, R, C); sR[i] = R; sC[i] = C; const int Rb = Epi::PERM ? ((R & ~31) + perm32(R & 31)) : R;
        voffB[i] = (unsigned)(Rb * K + C) * 2u; }
#define PG8_SETV(v, u) do { _Pragma("unroll") for (int h_ = 0; h_ < 2; ++h_) _Pragma("unroll") for (int i_ = 0; i_ < 2; ++i_) { \
        if constexpr (Sched::GATHER) v[h_][i_] = S.arow(u, h_ * HALF + sR[i_]) * (unsigned)(K * 2) + (unsigned)(sC[i_] * 2); \
        else v[h_][i_] = (unsigned)((h_ * HALF + sR[i_]) * K + sC[i_]) * 2u; } } while (0)
    const size_t kstep = (size_t)(BK * 2);
    const size_t hstep = (size_t)HALF * K * 2;
    const size_t tstep = 2 * hstep;
    const size_t atstep = Sched::GATHER ? (size_t)0 : tstep;
    const unsigned ldsw = (unsigned)wid * 1024u;
    const int aoff = lds_byte(wr * 64 + fr, fq * 8), boff = lds_byte(wc * 32 + fr, fq * 8);
#define PG8_SA(b, h) (((b) * 2 + (h)) * HTB)
#define PG8_SB(b, h) ((4 + (b) * 2 + (h)) * HTB)
#define PG8_STAGE(bufoff, gbase, voff) do { _Pragma("unroll") for (int _i = 0; _i < 2; ++_i) \
        __builtin_amdgcn_global_load_lds((const unsigned*)((const char*)(gbase) + (voff)[_i]), (LAS unsigned*)(lds + (bufoff) + ldsw + _i * 8192), 16, 0, 0); } while (0)
#define PG8_LDA(dst, b, h) do { _Pragma("unroll") for (int m = 0; m < 4; ++m) _Pragma("unroll") for (int k = 0; k < 2; ++k) dst[m][k] = *(const LAS bf16x8*)(lds + PG8_SA(b, h) + aoff + m * 2048 + k * 1024); } while (0)
#define PG8_LDB(dst, b, h) do { _Pragma("unroll") for (int n = 0; n < 2; ++n) _Pragma("unroll") for (int k = 0; k < 2; ++k) dst[n][k] = *(const LAS bf16x8*)(lds + PG8_SB(b, h) + boff + n * 2048 + k * 1024); } while (0)
#define PG8_MMA(ai, bj, At, Bt) do { __builtin_amdgcn_s_setprio(1); _Pragma("unroll") for (int m = 0; m < 4; ++m) _Pragma("unroll") for (int n = 0; n < 2; ++n) _Pragma("unroll") for (int k = 0; k < 2; ++k) \
        acc[ai][bj][m][n] = __builtin_amdgcn_mfma_f32_16x16x32_bf16(Bt[n][k], At[m][k], acc[ai][bj][m][n], 0, 0, 0); __builtin_amdgcn_s_setprio(0); } while (0)
#define PG8_WAIT_V(n) asm volatile("s_waitcnt vmcnt(" #n ")" ::: "memory")
#define PG8_WAIT_L(n) asm volatile("s_waitcnt lgkmcnt(" #n ")" ::: "memory")
#define PG8_BAR __builtin_amdgcn_s_barrier()
#define PG8_SCHED __builtin_amdgcn_sched_barrier(0)
    Unit cur, nxt; int ui = 0;
    if (!S.next(0, cur)) return;
    float z0 = 0.f; asm volatile("" : "+v"(z0));
    f32x4 acc[2][2][4][2];
#pragma unroll
    for (int a = 0; a < 2; ++a)
#pragma unroll
        for (int b = 0; b < 2; ++b)
#pragma unroll
            for (int m = 0; m < 4; ++m)
#pragma unroll
                for (int n = 0; n < 2; ++n) acc[a][b][m][n] = (f32x4){z0, z0, z0, z0};
    bf16x8 At[4][2], B0[2][2], B1[2][2];
    const char* cA = (const char*)g.A + (size_t)cur.pm * atstep; const char* cB = (const char*)g.Bt + (size_t)cur.pn * tstep;
    PG8_SETV(vA, cur);
    PG8_STAGE(PG8_SB(0, 0), cB, voffB); PG8_STAGE(PG8_SB(0, 1), cB + hstep, voffB); PG8_STAGE(PG8_SA(0, 0), cA, vA[0]); PG8_STAGE(PG8_SA(0, 1), cA, vA[1]);
    if (wr == 1) PG8_BAR;
    PG8_WAIT_V(2); PG8_BAR;
    PG8_STAGE(PG8_SB(1, 0), cB + kstep, voffB); PG8_STAGE(PG8_SA(1, 0), cA + kstep, vA[0]); PG8_STAGE(PG8_SB(1, 1), cB + hstep + kstep, voffB);
    PG8_WAIT_V(6); PG8_BAR;
    for (;;) {
        const bool has_next = S.next(ui + 1, nxt);
        const char* nA = has_next ? (const char*)g.A + (size_t)nxt.pm * atstep : cA; const char* nB = has_next ? (const char*)g.Bt + (size_t)nxt.pn * tstep : cB;
        if (has_next) { PG8_SETV(vAn, nxt); } else {
#pragma unroll
            for (int h_ = 0; h_ < 2; ++h_)
#pragma unroll
                for (int i_ = 0; i_ < 2; ++i_) vAn[h_][i_] = vA[h_][i_]; }
        for (int t = 0; t < nt; t += 2) {
            const bool last = (t == nt - 2);
            const char* a1 = cA + (size_t)(t + 1) * kstep;
            const char* a2 = last ? nA : cA + (size_t)(t + 2) * kstep; const char* b2 = last ? nB : cB + (size_t)(t + 2) * kstep;
            const char* a3 = a2 + kstep; const char* b3 = b2 + kstep;
            unsigned o2[2][2];
#pragma unroll
            for (int h_ = 0; h_ < 2; ++h_)
#pragma unroll
                for (int i_ = 0; i_ < 2; ++i_) o2[h_][i_] = last ? vAn[h_][i_] : vA[h_][i_];
            PG8_LDB(B0, 0, 0); PG8_LDB(B1, 0, 1); PG8_SCHED; PG8_LDA(At, 0, 0); PG8_STAGE(PG8_SA(1, 1), a1, vA[1]);
            PG8_WAIT_V(8); PG8_WAIT_L(0); PG8_BAR; PG8_MMA(0, 0, At, B0); PG8_MMA(0, 1, At, B1); PG8_BAR; PG8_SCHED;
            PG8_LDA(At, 0, 1); PG8_STAGE(PG8_SB(0, 0), b2, voffB); PG8_STAGE(PG8_SB(0, 1), b2 + hstep, voffB); PG8_STAGE(PG8_SA(0, 0), a2, o2[0]);
            PG8_WAIT_V(8); PG8_WAIT_L(0); PG8_BAR; PG8_MMA(1, 0, At, B0); PG8_MMA(1, 1, At, B1); PG8_BAR; PG8_SCHED;
            PG8_LDB(B0, 1, 0); PG8_LDB(B1, 1, 1); PG8_SCHED; PG8_LDA(At, 1, 0); PG8_STAGE(PG8_SA(0, 1), a2, o2[1]);
            PG8_WAIT_V(8); PG8_WAIT_L(0); PG8_BAR; PG8_MMA(0, 0, At, B0); PG8_MMA(0, 1, At, B1); PG8_BAR; PG8_SCHED;
            PG8_LDA(At, 1, 1); PG8_STAGE(PG8_SB(1, 0), b3, voffB); PG8_STAGE(PG8_SB(1, 1), b3 + hstep, voffB); PG8_STAGE(PG8_SA(1, 0), a3, o2[0]);
            PG8_WAIT_V(8); PG8_WAIT_L(0); PG8_BAR; PG8_MMA(1, 0, At, B0); PG8_MMA(1, 1, At, B1); PG8_BAR; PG8_SCHED;
        }
        if constexpr (ALIGN_EPI) { if (wr == 0) PG8_BAR; }
        E(acc, cur, wr, wc, fr, fq);
        if (!has_next) break;
#pragma unroll
        for (int a = 0; a < 2; ++a)
#pragma unroll
            for (int b = 0; b < 2; ++b)
#pragma unroll
                for (int m = 0; m < 4; ++m)
#pragma unroll
                    for (int n = 0; n < 2; ++n) acc[a][b][m][n] = (f32x4){z0, z0, z0, z0};
        cur = nxt; cA = nA; cB = nB; ++ui;
#pragma unroll
        for (int h_ = 0; h_ < 2; ++h_)
#pragma unroll
            for (int i_ = 0; i_ < 2; ++i_) vA[h_][i_] = vAn[h_][i_];
        if constexpr (ALIGN_EPI) { if (wr == 1) PG8_BAR; }
    }
    PG8_WAIT_V(0);
    if constexpr (!ALIGN_EPI) { if (wr == 0) PG8_BAR; }
    PG8_BAR;
#undef PG8_SETV
#undef PG8_SA
#undef PG8_SB
#undef PG8_STAGE
#undef PG8_LDA
#undef PG8_LDB
#undef PG8_MMA
#undef PG8_WAIT_V
#undef PG8_WAIT_L
#undef PG8_BAR
#undef PG8_SCHED
}
}
#include <hip/hip_bf16.h>
#include <cmath>
namespace attn_body {
using bf16=__hip_bfloat16;
using s16x4=__attribute__((ext_vector_type(4)))short;
constexpr int D=64,QP=DIN,OP=1024;
constexpr int NW=8,QBLK=32,QB=QBLK*NW,KVBLK=64;
__device__ __forceinline__ int crow(int r,int hi){return (r&3)+8*(r>>2)+4*hi;}
#define SBAR() __builtin_amdgcn_sched_barrier(0)
__device__ __forceinline__ void wmask(f32x16&p0,f32x16&p1,int kq,int hi){
  const float NEG=-INFINITY; const int kb=kq+4*hi;
  #pragma unroll
  for(int r=0;r<16;++r){const int d=kb+(r&3)+8*(r>>2); if(d>128||d<-128)p0[r]=NEG; if(d+32>128||d+32<-128)p1[r]=NEG;}
}

constexpr int NSLOT=3, SLOTB=8192;
constexpr int LDS_K=0, LDS_V=NSLOT*SLOTB, LDS_WS=2*NSLOT*SLOTB, LDS_OST=LDS_WS+NW*64*4, LDS_BYTES=LDS_OST+NW*4096;
constexpr float C2=0.125f*1.4426950408889634f;
__device__ __forceinline__ void glds16(const void*gsrc,unsigned lds_dst){unsigned keep;
  asm volatile("s_mov_b32 %0, m0\n\ts_mov_b32 m0, %2\n\ts_nop 0\n\tglobal_load_lds_dwordx4 %1, off\n\ts_mov_b32 m0, %0":"=&s"(keep):"v"(gsrc),"s"(lds_dst):"memory");}
__device__ __forceinline__ float max3f(float a,float b,float c){float r;asm("v_max3_f32 %0, %1, %2, %3":"=v"(r):"v"(a),"v"(b),"v"(c));return r;}
__device__ __forceinline__ float max2f(float a,float b){float r;asm("v_max_f32_e32 %0, %1, %2":"=v"(r):"v"(a),"v"(b));return r;}
__device__ __forceinline__ float fadd_s(float a,float b){float r;asm("v_add_f32_e32 %0, %1, %2":"=v"(r):"v"(a),"v"(b));return r;}
__device__ __forceinline__ float fsub_s(float a,float b){float r;asm("v_sub_f32_e32 %0, %1, %2":"=v"(r):"v"(a),"v"(b));return r;}
typedef float f32x2_t __attribute__((ext_vector_type(2))); typedef __bf16 bf16x2_t __attribute__((ext_vector_type(2)));
__device__ __forceinline__ unsigned cvtpk_s(float lo,float hi){f32x2_t v={lo,hi};bf16x2_t b=__builtin_convertvector(v,bf16x2_t);return __builtin_bit_cast(unsigned,b);}
#define WAIT_BAR(N) asm volatile("s_waitcnt vmcnt(" #N ") lgkmcnt(0)\n\ts_barrier":::"memory")

__device__ __forceinline__ void qkt(f32x16&p0,f32x16&p1,const char*Kslot,const bf16x8*qr,const f32x16&negm,int r32,int hi){
  const char*kb=Kslot+hi*1024+r32*16;
  #pragma unroll
  for(int d0=0;d0<4;++d0){
    const bf16x8 b0=*reinterpret_cast<const bf16x8*>(kb+d0*2048);
    const bf16x8 b1=*reinterpret_cast<const bf16x8*>(kb+d0*2048+512);
    if(d0==0){p0=__builtin_amdgcn_mfma_f32_32x32x16_bf16(b0,qr[0],negm,0,0,0);p1=__builtin_amdgcn_mfma_f32_32x32x16_bf16(b1,qr[0],negm,0,0,0);}
    else{p0=__builtin_amdgcn_mfma_f32_32x32x16_bf16(b0,qr[d0],p0,0,0,0);p1=__builtin_amdgcn_mfma_f32_32x32x16_bf16(b1,qr[d0],p1,0,0,0);}}
}
typedef __attribute__((address_space(3))) const char* lds_cptr;
typedef short v4i16_t __attribute__((ext_vector_type(4)));
__device__ __forceinline__ void kload8(bf16x8*kf,lds_cptr kp){
  kf[0]=*(const __attribute__((address_space(3))) bf16x8*)(kp);      kf[1]=*(const __attribute__((address_space(3))) bf16x8*)(kp+512);
  kf[2]=*(const __attribute__((address_space(3))) bf16x8*)(kp+2048); kf[3]=*(const __attribute__((address_space(3))) bf16x8*)(kp+2560);
  kf[4]=*(const __attribute__((address_space(3))) bf16x8*)(kp+4096); kf[5]=*(const __attribute__((address_space(3))) bf16x8*)(kp+4608);
  kf[6]=*(const __attribute__((address_space(3))) bf16x8*)(kp+6144); kf[7]=*(const __attribute__((address_space(3))) bf16x8*)(kp+6656);
}
__device__ __forceinline__ void kload2(bf16x8*kf,lds_cptr kp,int j){ kf[2*j]=*(const __attribute__((address_space(3))) bf16x8*)(kp+j*2048); kf[2*j+1]=*(const __attribute__((address_space(3))) bf16x8*)(kp+j*2048+512); }
__device__ __forceinline__ s16x4 vtr(lds_cptr p){ return __builtin_bit_cast(s16x4,__builtin_amdgcn_ds_read_tr16_b64_v4i16((__attribute__((address_space(3))) v4i16_t*)p)); }
__device__ __forceinline__ float rowmax(const f32x16&p0,const f32x16&p1){
  float a=max3f(p0[0],p0[1],p1[0]),b=max3f(p0[2],p0[3],p1[1]);a=max3f(a,p1[2],p1[3]);
  #pragma unroll
  for(int r=4;r<16;r+=4){a=max3f(a,p0[r],p0[r+1]);b=max3f(b,p0[r+2],p0[r+3]);a=max3f(a,p1[r],p1[r+1]);b=max3f(b,p1[r+2],p1[r+3]);}
  const float m=max2f(a,b);
  auto rr=__builtin_amdgcn_permlane32_swap(__float_as_uint(m),__float_as_uint(m),false,false);
  return max2f(__uint_as_float(rr[0]),__uint_as_float(rr[1]));
}
__device__ __forceinline__ void pv(f32x16*o,int vb,bf16x8 pa0,bf16x8 pa1,bf16x8 pa2,bf16x8 pa3){
  #pragma unroll
  for(int d0=0;d0<2;++d0){s16x4 lo[4],hi[4];
    #pragma unroll
    for(int ks=0;ks<4;++ks){
      asm volatile("ds_read_b64_tr_b16 %0,%1 offset:%c2":"=&v"(lo[ks]):"v"(vb),"i"(d0*4096+ks*1024):"memory");
      asm volatile("ds_read_b64_tr_b16 %0,%1 offset:%c2":"=&v"(hi[ks]):"v"(vb),"i"(d0*4096+ks*1024+512):"memory");}
    asm volatile("s_waitcnt lgkmcnt(0)":::"memory");SBAR();
    #define PK(k) (bf16x8){lo[k][0],lo[k][1],lo[k][2],lo[k][3],hi[k][0],hi[k][1],hi[k][2],hi[k][3]}
    o[d0]=__builtin_amdgcn_mfma_f32_32x32x16_bf16(pa0,PK(0),o[d0],0,0,0);
    o[d0]=__builtin_amdgcn_mfma_f32_32x32x16_bf16(pa1,PK(1),o[d0],0,0,0);
    o[d0]=__builtin_amdgcn_mfma_f32_32x32x16_bf16(pa2,PK(2),o[d0],0,0,0);
    o[d0]=__builtin_amdgcn_mfma_f32_32x32x16_bf16(pa3,PK(3),o[d0],0,0,0);
    #undef PK
  }
}

#ifndef ATTN_STORE16
#define ATTN_STORE16(p,v) (*(u32x4*)(p)=(v))
#endif
template<int THRL,bool WIN> __device__ __forceinline__ void attn_unit(const bf16*Qb,const bf16*__restrict__ Kb,const bf16*__restrict__ Vb,bf16*Ob,int q0,int NT,int tdelta,float sink_l2,int tid,char*shm){
  const int lane=tid&63,r32=lane&31,hi=lane>>5; const int wid=__builtin_amdgcn_readfirstlane(tid>>6);
  const bf16*Qw=Qb+(long)(q0+wid*QBLK)*QP;
  const bf16*Kh=Kb,*Vh=Vb;
  const unsigned lds0=(unsigned)(uintptr_t)shm;
  float*wsf=(float*)(shm+LDS_WS)+wid*64;
  const bf16*ksrc=Kh+(long)lane*QP+wid*8;
  const bf16*vsrc=Vh+(long)(16*(wid&3)+(lane>>2))*QP+(wid>>2)*32+(lane&3)*8;
  const unsigned kdst=lds0+LDS_K+wid*1024, vdst=lds0+LDS_V+wid*1024;
  #define TM(t) ((t)<4?(t):(t)+tdelta)
  #define DMA_K(t,slot) glds16(ksrc+(long)TM(t)*KVBLK*QP,(unsigned)__builtin_amdgcn_readfirstlane(kdst+(slot)))
  #define DMA_V(t,slot) glds16(vsrc+(long)TM(t)*KVBLK*QP,(unsigned)__builtin_amdgcn_readfirstlane(vdst+(slot)))
  const int vb0=(int)(lds0+LDS_V)+((lane>>4)&1)*32+(lane&3)*8+(4*hi+((lane&15)>>2))*64;
  const char*Kbase=shm+LDS_K; bf16x8 kf[8];
  const lds_cptr shm3=(lds_cptr)shm; const lds_cptr kp0=shm3+LDS_K+hi*1024+r32*16; const lds_cptr vp0=shm3+LDS_V+((lane>>4)&1)*32+(lane&3)*8+(4*hi+((lane&15)>>2))*64;
  DMA_K(0,0);DMA_V(0,0);DMA_K(1,SLOTB);
  bf16x8 qr[4];
  #pragma unroll
  for(int d0=0;d0<4;++d0)qr[d0]=*reinterpret_cast<const bf16x8*>(&Qw[(long)r32*QP+d0*16+hi*8]);
  float mhat=0.f,l_reg=0.f;float z0_=0.f;asm volatile("":"+v"(z0_));f32x16 o[2];
  #pragma unroll
  for(int r_=0;r_<16;++r_){o[0][r_]=z0_;o[1][r_]=z0_;}
  f32x16 negm;
  #pragma unroll
  for(int r_=0;r_<16;++r_)negm[r_]=z0_;
  asm volatile("":"+v"(negm));
  const int qrow=q0+wid*QBLK+r32;
  #define CMASK(P0,P1,t) do{ if(WIN&&(t)>=4)wmask(P0,P1,TM(t)*KVBLK-qrow,hi); }while(0)
  bool resc=false;
  #define START(P0,P1) do{ const float rm=rowmax(P0,P1); resc=false; \
    { const float dl=rm; mhat=fadd_s(mhat,dl); \
      _Pragma("unroll") for(int r=0;r<16;++r){P0[r]=fsub_s(P0[r],dl);P1[r]=fsub_s(P1[r],dl);} \
      _Pragma("unroll") for(int r=0;r<16;++r)negm[r]=-mhat; asm volatile("":"+v"(negm)); } \
    _Pragma("unroll") for(int r=0;r<16;++r)P0[r]=__builtin_amdgcn_exp2f(P0[r]); }while(0)
  #define RESC() do{ if(resc){ asm volatile("s_waitcnt lgkmcnt(0)":::"memory"); \
      _Pragma("unroll") for(int d_=0;d_<2;++d_) _Pragma("unroll") for(int r=0;r<16;++r)o[d_][r]*=wsf[crow(r,hi)]; } }while(0)
  f32x16 pA0,pA1,pB0,pB1;
  int sl_prev=0,sl_cur=0,sl_next=SLOTB;
  #define ROT() do{sl_prev=sl_cur;sl_cur=sl_next;sl_next=(sl_next==(NSLOT-1)*SLOTB)?0:sl_next+SLOTB;}while(0)
  DMA_K(2,2*SLOTB);
  WAIT_BAR(3);
  qkt(pA0,pA1,Kbase,qr,negm,r32,hi);asm volatile("s_nop 15\n\ts_nop 7":"+v"(pA0),"+v"(pA1));CMASK(pA0,pA1,0);
  START(pA0,pA1);
  _Pragma("unroll") for(int r=0;r<16;++r)pA1[r]=__builtin_amdgcn_exp2f(pA1[r]);
  WAIT_BAR(0);
  DMA_K(3,0);DMA_V(1,SLOTB);
  ROT();
  kload8(kf,kp0+sl_cur);
  WAIT_BAR(2);
  s16x4 vlo[8],vhi[8]; u32x4 pw0,pw1,pw2,pw3;
  #define PKW(P,B) cvtpk_s(P[B],P[B+1])
  #define PAF(k) __builtin_bit_cast(bf16x8,pw##k)
  #define VFR(i) (bf16x8){vlo[i][0],vlo[i][1],vlo[i][2],vlo[i][3],vhi[i][0],vhi[i][1],vhi[i][2],vhi[i][3]}
  #define PIN(x) asm volatile("":"+v"(x))
  #define MX3(a,b,c) __builtin_fmaxf(__builtin_fmaxf((a),(b)),(c))
  #define GAPA(MF,A0,A1,A2,A3,W0,W1,PW) do{ MF; sacc+=A0; sacc+=A1; sacc+=A2; sacc+=A3; PIN(sacc); W0; W1; PIN(PW); SBAR(); }while(0)
  #define EX(v) __builtin_amdgcn_exp2f(v)
  #define GAPB(MF,X,B) do{ MF; X[B]=EX(X[B]); X[B+1]=EX(X[B+1]); X[B+2]=EX(X[B+2]); X[B+3]=EX(X[B+3]); PIN(X); SBAR(); }while(0)
  #define VRD(i) do{ vlo[i]=vtr(vp_+(((i)>>2)*4096+((i)&3)*1024)); vhi[i]=vtr(vp_+(((i)>>2)*4096+((i)&3)*1024+512)); }while(0)
  #define KRD(G,j) do{ if(G){ kload2(kf,kp0+sl_next,j); SBAR(); } }while(0)
  #define STEP(C0,C1,P0,P1,t,GK,GV,GL) do{ SBAR(); \
    const lds_cptr vp_=vp0+sl_prev; \
    VRD(0); SBAR(); float sacc=(P0[0]+P0[1]); \
    GAPA(C0=__builtin_amdgcn_mfma_f32_32x32x16_bf16(kf[0],qr[0],negm,0,0,0), P0[2],P0[3],P0[4],P0[5],     pw0[0]=PKW(P0,0), pw0[1]=PKW(P0,2), pw0); \
    VRD(4); SBAR(); GAPA(C1=__builtin_amdgcn_mfma_f32_32x32x16_bf16(kf[1],qr[0],negm,0,0,0), P0[6],P0[7],P0[8],P0[9],     pw0[2]=PKW(P0,4), pw0[3]=PKW(P0,6), pw0); \
    VRD(1); SBAR(); GAPA(C0=__builtin_amdgcn_mfma_f32_32x32x16_bf16(kf[2],qr[1],C0,0,0,0),   P0[10],P0[11],P0[12],P0[13], pw1[0]=PKW(P0,8), pw1[1]=PKW(P0,10), pw1); \
    VRD(5); SBAR(); GAPA(C1=__builtin_amdgcn_mfma_f32_32x32x16_bf16(kf[3],qr[1],C1,0,0,0),   P0[14],P0[15],P1[0],P1[1],   pw1[2]=PKW(P0,12),pw1[3]=PKW(P0,14), pw1); \
    VRD(2); SBAR(); GAPA(C0=__builtin_amdgcn_mfma_f32_32x32x16_bf16(kf[4],qr[2],C0,0,0,0),   P1[2],P1[3],P1[4],P1[5],     pw2[0]=PKW(P1,0), pw2[1]=PKW(P1,2), pw2); \
    VRD(6); SBAR(); GAPA(C1=__builtin_amdgcn_mfma_f32_32x32x16_bf16(kf[5],qr[2],C1,0,0,0),   P1[6],P1[7],P1[8],P1[9],     pw2[2]=PKW(P1,4), pw2[3]=PKW(P1,6), pw2); \
    VRD(3); SBAR(); GAPA(C0=__builtin_amdgcn_mfma_f32_32x32x16_bf16(kf[6],qr[3],C0,0,0,0),   P1[10],P1[11],P1[12],P1[13], pw3[0]=PKW(P1,8), pw3[1]=PKW(P1,10), pw3); \
    VRD(7); SBAR(); GAPA(C1=__builtin_amdgcn_mfma_f32_32x32x16_bf16(kf[7],qr[3],C1,0,0,0),   P1[14],P1[15],0.f,0.f,       pw3[2]=PKW(P1,12),pw3[3]=PKW(P1,14), pw3); \
    l_reg+=sacc; \
    if(GK){DMA_K((t)+3,sl_cur);} if(GV){DMA_V((t)+1,sl_next);} \
    CMASK(C0,C1,t); \
    { float a=MX3(C0[0],C0[1],C1[0]),b=MX3(C0[2],C0[3],C1[1]); a=MX3(a,C1[2],C1[3]); \
      _Pragma("unroll") for(int r=4;r<16;r+=4){a=MX3(a,C0[r],C0[r+1]);b=MX3(b,C0[r+2],C0[r+3]);a=MX3(a,C1[r],C1[r+1]);b=MX3(b,C1[r+2],C1[r+3]);} \
      float rm=__builtin_fmaxf(a,b); { auto rr=__builtin_amdgcn_permlane32_swap(__float_as_uint(rm),__float_as_uint(rm),false,false); rm=__builtin_fmaxf(__uint_as_float(rr[0]),__uint_as_float(rr[1])); } \
      resc=false; \
      if(__builtin_expect(__any(rm>(float)THRL),0)){ const float dl=__builtin_fmaxf(rm,0.f); mhat+=dl; \
        _Pragma("unroll") for(int r=0;r<16;++r){C0[r]-=dl;C1[r]-=dl;} \
        _Pragma("unroll") for(int r=0;r<16;++r)negm[r]=-mhat; asm volatile("":"+v"(negm)); \
        const float f=__builtin_amdgcn_exp2f(-dl); l_reg*=f; if(hi==0)wsf[r32]=f; resc=true; } } \
    SBAR(); \
    GAPB(o[0]=__builtin_amdgcn_mfma_f32_32x32x16_bf16(PAF(0),VFR(0),o[0],0,0,0), C0,0); \
    GAPB(o[1]=__builtin_amdgcn_mfma_f32_32x32x16_bf16(PAF(0),VFR(4),o[1],0,0,0), C0,4); \
    KRD(GL,0); GAPB(o[0]=__builtin_amdgcn_mfma_f32_32x32x16_bf16(PAF(1),VFR(1),o[0],0,0,0), C0,8); \
    KRD(GL,1); GAPB(o[1]=__builtin_amdgcn_mfma_f32_32x32x16_bf16(PAF(1),VFR(5),o[1],0,0,0), C0,12); \
    KRD(GL,2); GAPB(o[0]=__builtin_amdgcn_mfma_f32_32x32x16_bf16(PAF(2),VFR(2),o[0],0,0,0), C1,0); \
    KRD(GL,3); GAPB(o[1]=__builtin_amdgcn_mfma_f32_32x32x16_bf16(PAF(2),VFR(6),o[1],0,0,0), C1,4); \
    GAPB(o[0]=__builtin_amdgcn_mfma_f32_32x32x16_bf16(PAF(3),VFR(3),o[0],0,0,0), C1,8); \
    GAPB(o[1]=__builtin_amdgcn_mfma_f32_32x32x16_bf16(PAF(3),VFR(7),o[1],0,0,0), C1,12); \
    }while(0)
  int t=1;
  for(;t+5<NT;t+=2){
    STEP(pB0,pB1,pA0,pA1,t,true,true,true);     WAIT_BAR(2); RESC(); ROT();
    STEP(pA0,pA1,pB0,pB1,t+1,true,true,true);   WAIT_BAR(2); RESC(); ROT();
  }
  #define ENDW(tt) do{ if((tt)+3<NT){WAIT_BAR(2);} else if((tt)+2<NT){WAIT_BAR(1);} else {WAIT_BAR(0);} }while(0)
  for(;t+1<NT;t+=2){
    STEP(pB0,pB1,pA0,pA1,t,(t+3<NT),(t+1<NT),(t+1<NT));       ENDW(t);   RESC(); ROT();
    STEP(pA0,pA1,pB0,pB1,t+1,(t+4<NT),(t+2<NT),(t+2<NT));     ENDW(t+1); RESC(); ROT();
  }
  STEP(pB0,pB1,pA0,pA1,NT-1,false,false,false); RESC();
  { float sacc=pB0[0]+pB0[1]; _Pragma("unroll") for(int r=2;r<16;++r)sacc+=pB0[r]; _Pragma("unroll") for(int r=0;r<16;++r)sacc+=pB1[r]; l_reg+=sacc;
    pw0=(u32x4){PKW(pB0,0),PKW(pB0,2),PKW(pB0,4),PKW(pB0,6)};pw1=(u32x4){PKW(pB0,8),PKW(pB0,10),PKW(pB0,12),PKW(pB0,14)};pw2=(u32x4){PKW(pB1,0),PKW(pB1,2),PKW(pB1,4),PKW(pB1,6)};pw3=(u32x4){PKW(pB1,8),PKW(pB1,10),PKW(pB1,12),PKW(pB1,14)};
    SBAR(); pv(o,vb0+sl_cur,PAF(0),PAF(1),PAF(2),PAF(3)); }
  #undef PKW
  #undef PAF
  #undef VFR
  #undef PIN
  #undef MX3
  #undef GAPA
  #undef GAPB
  #undef EX
  #undef VRD
  #undef KRD
  #undef STEP
  #undef ENDW
  {auto rr=__builtin_amdgcn_permlane32_swap(__float_as_uint(l_reg),__float_as_uint(l_reg),false,false);l_reg=__uint_as_float(rr[0])+__uint_as_float(rr[1]);}
  if(WIN)l_reg+=__builtin_amdgcn_exp2f(sink_l2-mhat);
  if(hi==0)wsf[32+r32]=l_reg;asm volatile("s_waitcnt lgkmcnt(0)":::"memory");
  float rli[16];
  #pragma unroll
  for(int r=0;r<16;++r)rli[r]=__builtin_amdgcn_rcpf(wsf[32+crow(r,hi)]);
  bf16*Ow=Ob+(long)(q0+wid*QBLK)*OP;
  { bf16*stg=(bf16*)(shm+LDS_OST)+wid*2048;
    #pragma unroll
    for(int r=0;r<16;++r){const int orow=crow(r,hi);
      #pragma unroll
      for(int d0=0;d0<2;++d0)stg[orow*64+d0*32+r32]=__float2bfloat16(o[d0][r]*rli[r]);}
    asm volatile("s_waitcnt lgkmcnt(0)":::"memory");
    #pragma unroll
    for(int i=0;i<4;++i){const int row=i*8+(lane>>3),ch=lane&7; const u32x4 v=*(const u32x4*)(stg+row*64+ch*8); ATTN_STORE16(Ow+(long)row*OP+ch*8,v);} }
  asm volatile("s_waitcnt lgkmcnt(0)\n\ts_barrier":::"memory");
  #undef TM
  #undef DMA_K
  #undef DMA_V
  #undef CMASK
  #undef START
  #undef RESC
  #undef ROT
}
constexpr int ATTN_LDS_BYTES=LDS_BYTES;
#undef SBAR
#undef WAIT_BAR
}
#define XB_TMO      128
#define XB_XCNT(j)  (256  + 64 * (j))
#define XB_XSUB(j)  (1280 + 64 * (j))
#define XB_XGEN(j)  (2304 + 64 * (j))
#define XB_TOP      3328
#define XB_TOPGEN   3392
#define XCD_BAR_WORDS 3456
#define XB_SPIN_CAP (1u << 21)

__device__ __forceinline__ unsigned xb_ld(unsigned* p)              { return __hip_atomic_load(p, __ATOMIC_RELAXED, __HIP_MEMORY_SCOPE_AGENT); }
__device__ __forceinline__ unsigned xb_add(unsigned* p, unsigned v) { return __hip_atomic_fetch_add(p, v, __ATOMIC_RELAXED, __HIP_MEMORY_SCOPE_AGENT); }
__device__ __forceinline__ unsigned xb_xcc_id() { return (unsigned)__builtin_amdgcn_s_getreg((3 << 11) | 20) & 0xFu; }
#define XB_SPIN(cond, bar) do { unsigned _sp = 0; while (cond) { __builtin_amdgcn_s_sleep(1); \
    if ((++_sp & 255u) == 0u) { if (xb_ld(&(bar)[XB_TMO])) break; if (_sp > XB_SPIN_CAP) { atomicAdd(&(bar)[XB_TMO], 1u); break; } } } } while (0)

struct XcdBarrier {
    unsigned* bar; unsigned x;
    volatile LAS unsigned* st;
};

__device__ __forceinline__ XcdBarrier xcd_barrier_post(unsigned* bar, volatile LAS unsigned* st) {
    XcdBarrier b; b.bar = bar; b.x = xb_xcc_id(); b.st = st;
    if (threadIdx.x == 0) (void)xb_add(&bar[XB_XCNT(b.x)], 1u);
    return b;
}
__device__ __forceinline__ void xcd_barrier_complete(unsigned* bar, unsigned x, unsigned& nloc, unsigned& nx) {
    const unsigned G = gridDim.x * gridDim.y * gridDim.z;
    unsigned sum, cnt, mine, sp = 0u;
    for (;;) {
        sum = 0u; cnt = 0u; mine = 0u;
#pragma unroll
        for (unsigned j = 0; j < 16; ++j) { const unsigned c = xb_ld(&bar[XB_XCNT(j)]); sum += c; cnt += (c > 0u) ? 1u : 0u; mine = (j == x) ? c : mine; }
        if (sum == G) break;
        __builtin_amdgcn_s_sleep(1);
        if ((++sp & 255u) == 0u) { if (xb_ld(&bar[XB_TMO])) break; if (sp > XB_SPIN_CAP) { atomicAdd(&bar[XB_TMO], 1u); break; } }
    }
    nloc = mine > 0u ? mine : 1u; nx = cnt > 0u ? cnt : 1u;
}

__device__ __forceinline__ void xcd_barrier(const XcdBarrier& b) {
    asm volatile("s_waitcnt vmcnt(0)" ::: "memory");
    __syncthreads();
    if (threadIdx.x == 0) {
        unsigned* bar = b.bar; unsigned bx_ = b.x; asm volatile("" : "+s"(bar), "+s"(bx_));
        __builtin_amdgcn_s_waitcnt(0);
        unsigned nloc = b.st[0], nx = b.st[1];
        if (nloc == 0u) { xcd_barrier_complete(bar, bx_, nloc, nx); b.st[0] = nloc; b.st[1] = nx; }
        const unsigned old = xb_add(&bar[XB_XSUB(bx_)], 1u);
        const unsigned gen = old / nloc;
        if (old + 1u == (gen + 1u) * nloc) {
            __builtin_amdgcn_fence(__ATOMIC_RELEASE, "agent");
            asm volatile("s_waitcnt vmcnt(0)" ::: "memory");
            const unsigned og = xb_add(&bar[XB_TOP], 1u);
            const unsigned tg = og / nx;
            if (og + 1u == (tg + 1u) * nx) xb_add(&bar[XB_TOPGEN], 1u);
            else XB_SPIN(xb_ld(&bar[XB_TOPGEN]) == tg, bar);
            __builtin_amdgcn_fence(__ATOMIC_ACQUIRE, "agent");
            xb_add(&bar[XB_XGEN(bx_)], 1u);
            asm volatile("s_waitcnt vmcnt(0)" ::: "memory");
        } else {
            XB_SPIN(xb_ld(&bar[XB_XGEN(bx_)]) == gen, bar);
            __builtin_amdgcn_fence(__ATOMIC_ACQUIRE, "agent");
            asm volatile("s_waitcnt vmcnt(0)" ::: "memory");
        }
    }
    __syncthreads();
}

constexpr size_t alup(size_t x) { return (x + 4095) & ~(size_t)4095; }
constexpr size_t CTL_BYTES = 1u << 20;
constexpr size_t SZ_WIN = (size_t)DEPTH * DIN * DM * 2, SZ_WOUT = (size_t)DEPTH * DM * DM * 2, SZ_WGU = (size_t)DEPTH * NE * 2 * FF * DM * 2, SZ_WDN = (size_t)DEPTH * NE * DM * FF * 2;
constexpr size_t SZ_MODP = (size_t)DEPTH * 16 * 17 * 6144 * 4, SZ_MOD = (size_t)DEPTH * 17 * 6144 * 4;
constexpr size_t SZ_X32 = (size_t)MROWS * DM * 4, SZ_H = (size_t)MROWS * DM * 2, SZ_P = (size_t)MROWS * DIN * 2, SZ_Y = (size_t)MROWS * DM * 2, SZ_YP = (size_t)MROWS * 2 * DM * 2;
constexpr size_t SZ_LIST = (size_t)NE * MROWS * 4, SZ_GW = (size_t)MROWS * 2 * 4;
constexpr int MAXBLK = (MROWS * 2) / 256 + NE;
static_assert((size_t)MAXBLK * 256 * FF * 2 <= SZ_P, "HMID overlays P");
static_assert((size_t)2 * NB * 4 * NCH * 128 * 64 * 4 <= SZ_H, "KVT overlays H");
static_assert((size_t)2 * NB * 4 * NCH * 128 * 64 * 2 <= SZ_YP, "ST overlays YP");
constexpr size_t WS_CTL = 0;
constexpr size_t WS_WIN = CTL_BYTES, WS_WOUT = WS_WIN + alup(SZ_WIN), WS_WGU = WS_WOUT + alup(SZ_WOUT), WS_WDN = WS_WGU + alup(SZ_WGU);
constexpr size_t WS_MODP = WS_WDN + alup(SZ_WDN), WS_MOD = WS_MODP + alup(SZ_MODP);
constexpr size_t WS_X32 = WS_MOD + alup(SZ_MOD), WS_H = WS_X32 + alup(SZ_X32), WS_P = WS_H + alup(SZ_H), WS_Y = WS_P + alup(SZ_P), WS_YP = WS_Y + alup(SZ_Y);
constexpr size_t WS_LIST = WS_YP + alup(SZ_YP), WS_GW = WS_LIST + alup(SZ_LIST), WS_END = WS_GW + alup(SZ_GW);
constexpr int CW_BAR = 4096;
constexpr int CW_CNT = 16384;

constexpr int RING_BYTES = 131072;
constexpr int LDSCTL_OFF = RING_BYTES;
constexpr int LDS_BYTES = 147456;

#define ATTN_STORE16(p,v) (*(u32x4*)(p)=(v))

#define CAS __attribute__((address_space(4)))
__device__ __forceinline__ const float* inp(int i) {
    const CAS unsigned char* k = (const CAS unsigned char*)__builtin_amdgcn_kernarg_segment_ptr();
    asm volatile("" : "+s"(k));
    return *(const float* const CAS*)(k + 8 * i);
}
struct Ctx {
    float* out; unsigned char* ws;
    __device__ __forceinline__ const float* x() const { return inp(0); }
    __device__ __forceinline__ const float* c() const { return inp(1); }
    __device__ __forceinline__ const float* ctx() const { return inp(2); }
    __device__ __forceinline__ const float* c_ctx() const { return inp(3); }
    __device__ __forceinline__ const float* ada_w() const { return inp(4); }
    __device__ __forceinline__ const float* ada_b() const { return inp(5); }
    __device__ __forceinline__ const float* norm1() const { return inp(6); }
    __device__ __forceinline__ const float* norm2() const { return inp(7); }
    __device__ __forceinline__ const float* w_in() const { return inp(8); }
    __device__ __forceinline__ const float* w_out() const { return inp(9); }
    __device__ __forceinline__ const float* ret_decay() const { return inp(10); }
    __device__ __forceinline__ const float* win_gain() const { return inp(11); }
    __device__ __forceinline__ const float* win_sink() const { return inp(12); }
    __device__ __forceinline__ const float* glb_gain() const { return inp(13); }
    __device__ __forceinline__ const float* w_router() const { return inp(14); }
    __device__ __forceinline__ const float* b_router() const { return inp(15); }
    __device__ __forceinline__ const float* w_gu() const { return inp(16); }
    __device__ __forceinline__ const float* w_dn() const { return inp(17); }
};

template <int CTRL> __device__ __forceinline__ float dppx(float v) { return __builtin_bit_cast(float, __builtin_amdgcn_update_dpp(0, __builtin_bit_cast(int, v), CTRL, 0xF, 0xF, true)); }
__device__ __forceinline__ float xor1(float v) { return dppx<0xB1>(v); }
__device__ __forceinline__ float xor2(float v) { return dppx<0x4E>(v); }
__device__ __forceinline__ float wave_sum(float v) {
    v += dppx<0xB1>(v); v += dppx<0x4E>(v); v += dppx<0x141>(v); v += dppx<0x140>(v);
    { const unsigned u = __builtin_bit_cast(unsigned, v); auto r = __builtin_amdgcn_permlane16_swap(u, u, false, false); v = __builtin_bit_cast(float, (unsigned)r[0]) + __builtin_bit_cast(float, (unsigned)r[1]); }
    { const unsigned u = __builtin_bit_cast(unsigned, v); auto r = __builtin_amdgcn_permlane32_swap(u, u, false, false); v = __builtin_bit_cast(float, (unsigned)r[0]) + __builtin_bit_cast(float, (unsigned)r[1]); }
    return v;
}
__device__ __forceinline__ float xor16(float v, int lane) { const unsigned u = __builtin_bit_cast(unsigned, v); auto r = __builtin_amdgcn_permlane16_swap(u, u, false, false);
    return __builtin_bit_cast(float, (lane & 16) ? (unsigned)r[0] : (unsigned)r[1]); }
__device__ __forceinline__ float silu_f(float v) { return v * __builtin_amdgcn_rcpf(1.f + __builtin_amdgcn_exp2f(-LOG2E * v)); }
__device__ __forceinline__ float log2_sigmoid(float x) { return -log1pf(expf(-x)) * LOG2E; }

__device__ __forceinline__ void transpose_item(const float* W, int N, int nsrc0, int k0, bf16_t* WT, int K, int nrow0, LAS float* scr, int lane) {
#pragma unroll 8
    for (int i = 0; i < 32; ++i) { const int kk = 2 * i + (lane >> 5); scr[kk * 33 + (lane & 31)] = W[(size_t)(k0 + kk) * N + nsrc0 + (lane & 31)]; }
    asm volatile("s_waitcnt lgkmcnt(0)" ::: "memory");
    const int c = lane & 7;
#pragma unroll
    for (int j = 0; j < 4; ++j) { const int n = (lane >> 3) + 8 * j; const LAS float* s = scr + (8 * c) * 33 + n;
        u32x4 o; o.x = pk2(s[0 * 33], s[1 * 33]); o.y = pk2(s[2 * 33], s[3 * 33]); o.z = pk2(s[4 * 33], s[5 * 33]); o.w = pk2(s[6 * 33], s[7 * 33]);
        *(u32x4*)(WT + (size_t)(nrow0 + n) * K + k0 + 8 * c) = o; }
    asm volatile("s_waitcnt lgkmcnt(0)" ::: "memory");
}
constexpr int IT_WIN = 16 * 80, IT_WOUT = 16 * 32, IT_GU = 16 * 64, IT_DN = 16 * 32, IT_LAYER = IT_WIN + IT_WOUT + NE * (IT_GU + IT_DN);
__device__ __forceinline__ void phase_prologue(const Ctx& C, LAS unsigned char* lds, int G, int vcu, int bx, int tid) {
    const int lane = tid & 63, wave = tid >> 6;
    {
        LAS float* scs = (LAS float*)lds;
        bool have = false;
        for (int it = bx; it < DEPTH * 12 * 16; it += G) {
            if (!have) {
                for (int i = tid; i < 17 * DM; i += 512) { const int r = i >> 10, k = i & 1023; const float v = r < 16 ? C.c()[r * DM + k] : C.c_ctx()[k]; scs[i] = v / (1.f + expf(-v)); }
                __syncthreads(); have = true;
            }
            const int l = it / 192, rem = it % 192, cb = rem / 16, kc = rem % 16;
            const float* w = C.ada_w() + ((size_t)l * DM + kc * 64) * 6144 + cb * 512 + tid;
            float acc[17];
#pragma unroll
            for (int r = 0; r < 17; ++r) acc[r] = 0.f;
#pragma unroll 4
            for (int kk = 0; kk < 64; ++kk) { const float wv = w[(size_t)kk * 6144];
#pragma unroll
                for (int r = 0; r < 17; ++r) acc[r] += scs[r * DM + kc * 64 + kk] * wv; }
            float* mp = (float*)(C.ws + WS_MODP) + ((size_t)(l * 16 + kc) * 17) * 6144 + cb * 512 + tid;
#pragma unroll
            for (int r = 0; r < 17; ++r) mp[(size_t)r * 6144] = acc[r];
        }
        __syncthreads();
    }
    LAS float* scr = (LAS float*)(lds + wave * 16384);
    const int gw = vcu * 8 + wave, NGW = G * 8;
    for (int it = gw; it < DEPTH * IT_LAYER; it += NGW) {
        const int l = it / IT_LAYER; int r = it % IT_LAYER;
        if (r < IT_WIN) { const int kb = r / 80, nb = r % 80;
            transpose_item(C.w_in() + (size_t)l * DM * DIN, DIN, 32 * nb, 64 * kb, (bf16_t*)(C.ws + WS_WIN) + (size_t)l * DIN * DM, DM, 32 * nb, scr, lane); continue; }
        r -= IT_WIN;
        if (r < IT_WOUT) { const int kb = r / 32, nb = r % 32;
            transpose_item(C.w_out() + (size_t)l * DM * DM, DM, 32 * nb, 64 * kb, (bf16_t*)(C.ws + WS_WOUT) + (size_t)l * DM * DM, DM, 32 * nb, scr, lane); continue; }
        r -= IT_WOUT;
        if (r < NE * IT_GU) { const int e = r / IT_GU, q = r % IT_GU, kb = q / 64, nb = q % 64;
            const int np = 32 * nb, tile = np >> 8, within = np & 255, nsrc = within < 128 ? tile * 128 + within : FF + tile * 128 + within - 128;
            transpose_item(C.w_gu() + (size_t)(l * NE + e) * DM * 2 * FF, 2 * FF, nsrc, 64 * kb, (bf16_t*)(C.ws + WS_WGU) + (size_t)(l * NE + e) * 2 * FF * DM, DM, np, scr, lane); continue; }
        r -= NE * IT_GU;
        { const int e = r / IT_DN, q = r % IT_DN, kb = q / 32, nb = q % 32;
            transpose_item(C.w_dn() + (size_t)(l * NE + e) * FF * DM, DM, 32 * nb, 64 * kb, (bf16_t*)(C.ws + WS_WDN) + (size_t)(l * NE + e) * DM * FF, FF, 32 * nb, scr, lane); }
    }
}
__device__ __forceinline__ void phase_modsum(const Ctx& C, int G, int bx, int tid) {
    const float* mp = (const float*)(C.ws + WS_MODP); float* mod = (float*)(C.ws + WS_MOD);
    for (int i = bx * 512 + tid; i < DEPTH * 17 * 6144; i += G * 512) {
        const int l = i / (17 * 6144), rem = i % (17 * 6144), r = rem / 6144, n = rem % 6144;
        float s = C.ada_b()[l * 6144 + n];
#pragma unroll
        for (int kc = 0; kc < 16; ++kc) s += mp[((size_t)(l * 16 + kc) * 17 + r) * 6144 + n];
        mod[i] = s;
    }
}

__device__ __forceinline__ void phase_norm1(const Ctx& C, int layer, int gw, int NGW, int lane) {
    const float* mod = (const float*)(C.ws + WS_MOD) + (size_t)layer * 17 * 6144;
    const float* gain = C.norm1() + layer * DM;
    float* X32 = (float*)(C.ws + WS_X32); bf16_t* H = (bf16_t*)(C.ws + WS_H); const bf16_t* YP = (const bf16_t*)(C.ws + WS_YP);
    for (int m = gw; m < MROWS; m += NGW) {
        const int b = m / TPB, t = m - b * TPB, set = t < CTX ? 16 : b;
        f32x4 v[4];
        if (layer == 0) {
            const f32x4* src = (const f32x4*)(t < CTX ? C.ctx() + ((size_t)b * CTX + t) * DM : C.x() + ((size_t)b * SEQ + (t - CTX)) * DM) + lane;
#pragma unroll
            for (int j = 0; j < 4; ++j) v[j] = src[64 * j];
        } else {
            const f32x4* xr = (const f32x4*)(X32 + (size_t)m * DM) + lane;
            const u32x2* y0 = (const u32x2*)(YP + (size_t)m * 2 * DM) + lane; const u32x2* y1 = y0 + DM / 4;
            const f32x4* g2 = (const f32x4*)(mod - 17 * 6144 + (size_t)set * 6144 + 5 * DM) + lane;
#pragma unroll
            for (int j = 0; j < 4; ++j) { const u32x2 a = y0[64 * j], bb = y1[64 * j]; const f32x4 g = g2[64 * j];
                f32x4 y; y[0] = bflo(a.x) + bflo(bb.x); y[1] = bfhi(a.x) + bfhi(bb.x); y[2] = bflo(a.y) + bflo(bb.y); y[3] = bfhi(a.y) + bfhi(bb.y);
                v[j] = xr[64 * j] + g * y; }
        }
        f32x4* xo = (f32x4*)(X32 + (size_t)m * DM) + lane;
        float ss = 0.f;
#pragma unroll
        for (int j = 0; j < 4; ++j) { xo[64 * j] = v[j]; ss += (v[j][0] * v[j][0] + v[j][1] * v[j][1]) + (v[j][2] * v[j][2] + v[j][3] * v[j][3]); }
        const float rstd = 1.0f / sqrtf(wave_sum(ss) * (1.f / DM) + EPS);
        const f32x4* gp = (const f32x4*)gain + lane; const f32x4* shp = (const f32x4*)(mod + (size_t)set * 6144) + lane; const f32x4* scp = shp + DM / 4;
        u32x2* ho = (u32x2*)(H + (size_t)m * DM) + lane;
#pragma unroll
        for (int j = 0; j < 4; ++j) { const f32x4 h = (v[j] * rstd) * gp[64 * j] * (scp[64 * j] + 1.0f) + shp[64 * j];
            u32x2 w; w.x = pk2(h[0], h[1]); w.y = pk2(h[2], h[3]); ho[64 * j] = w; }
    }
}

__device__ __forceinline__ void phase_qkprep(const Ctx& C, int layer, int gw, int NGW, int lane) {
    bf16_t* P = (bf16_t*)(C.ws + WS_P);
    const float gwq = C.win_gain()[(layer * 2 + 0) * 64 + lane], gwk = C.win_gain()[(layer * 2 + 1) * 64 + lane];
    const float ggq = C.glb_gain()[(layer * 2 + 0) * 64 + lane], ggk = C.glb_gain()[(layer * 2 + 1) * 64 + lane];
    const float inv = exp2f(-(float)(lane & 15) * (13.287712379549449f / 16.0f));
    for (int m = gw; m < MROWS; m += NGW) {
        const int b = m / TPB, t = m - b * TPB; const bool isx = t >= CTX; const int pos = t - CTX;
        float cs = 1.f, sn = 0.f;
        if (isx) { const float ang = (float)((lane & 32) ? (pos & 63) : (pos >> 6)) * inv; cs = cosf(ang); sn = sinf(ang); if (!(lane & 16)) sn = -sn; }
        bf16_t* row = P + (size_t)m * DIN;
#pragma unroll
        for (int hh = 0; hh < 12; ++hh) {
            const int col = hh < 4 ? C_WQ + 64 * hh : hh < 6 ? C_WK + 64 * (hh - 4) : hh < 10 ? C_GQ + 64 * (hh - 6) : C_GK + 64 * (hh - 10);
            const bool isq = hh < 4 || (hh >= 6 && hh < 10);
            const float g = hh < 4 ? gwq : hh < 6 ? gwk : hh < 10 ? ggq : ggk;
            float v = bf2f(row[col + lane]);
            const float r = 1.0f / sqrtf(wave_sum(v * v) * (1.f / 64.f) + EPS);
            v = v * r * g;
            const float pr = xor16(v, lane);
            v = v * cs + pr * sn;
            if (isq) v *= QSCALE;
            row[col + lane] = (bf16_t)f2bf(v);
        }
    }
}

__device__ __forceinline__ void stage_vt(const bf16_t* P, size_t r0, int h, LAS bf16_t* VT, int tid) {
#pragma unroll
    for (int i = 0; i < 4; ++i) { const int p = tid + 512 * i, j = p >> 4, dv0 = (p & 15) * 8;
        const u32x4 w = *(const u32x4*)(P + (r0 + j) * DIN + C_RV + h * 128 + dv0);
        VT[(dv0 + 0) * 136 + j] = (bf16_t)(w.x & 0xffffu); VT[(dv0 + 1) * 136 + j] = (bf16_t)(w.x >> 16);
        VT[(dv0 + 2) * 136 + j] = (bf16_t)(w.y & 0xffffu); VT[(dv0 + 3) * 136 + j] = (bf16_t)(w.y >> 16);
        VT[(dv0 + 4) * 136 + j] = (bf16_t)(w.z & 0xffffu); VT[(dv0 + 5) * 136 + j] = (bf16_t)(w.z >> 16);
        VT[(dv0 + 6) * 136 + j] = (bf16_t)(w.w & 0xffffu); VT[(dv0 + 7) * 136 + j] = (bf16_t)(w.w >> 16); }
}
__device__ __forceinline__ void ret_r1_unit(const Ctx& C, int layer, int b, int h, int c, LAS unsigned char* lds, int tid) {
    const int lane = tid & 63, wid = tid >> 6;
    const bf16_t* P = (const bf16_t*)(C.ws + WS_P); float* KVT = (float*)(C.ws + WS_H);
    LAS bf16_t* KzfT = (LAS bf16_t*)lds; LAS bf16_t* KzbT = KzfT + 64 * 136; LAS bf16_t* VT = KzbT + 64 * 136;
    const float lf = log2_sigmoid(C.ret_decay()[(layer * 2 + 0) * 4 + h]), lb = log2_sigmoid(C.ret_decay()[(layer * 2 + 1) * 4 + h]);
    const size_t r0 = (size_t)b * TPB + c * 128;
#pragma unroll
    for (int i = 0; i < 2; ++i) { const int p = tid + 512 * i, j = p >> 3, dk0 = (p & 7) * 8;
        const u32x4 w = *(const u32x4*)(P + (r0 + j) * DIN + C_RK + h * 64 + dk0);
        const float zf = exp2f((float)(127 - j) * lf) * 0.125f, zb = exp2f((float)j * lb) * 0.125f;
        const float x[8] = {bflo(w.x), bfhi(w.x), bflo(w.y), bfhi(w.y), bflo(w.z), bfhi(w.z), bflo(w.w), bfhi(w.w)};
#pragma unroll
        for (int e = 0; e < 8; ++e) { KzfT[(dk0 + e) * 136 + j] = (bf16_t)f2bf(x[e] * zf); KzbT[(dk0 + e) * 136 + j] = (bf16_t)f2bf(x[e] * zb); } }
    stage_vt(P, r0, h, VT, tid);
    __syncthreads();
    const int mb = wid >> 1, nb = wid & 1, r = lane & 31, hh = lane >> 5;
    float z0 = 0.f; asm volatile("" : "+v"(z0)); f32x16 af, ab;
#pragma unroll
    for (int i = 0; i < 16; ++i) { af[i] = z0; ab[i] = z0; }
#pragma unroll
    for (int ks = 0; ks < 8; ++ks) {
        const bf16x8 a = *(const LAS bf16x8*)(VT + (32 * mb + r) * 136 + 16 * ks + 8 * hh);
        const bf16x8 bf = *(const LAS bf16x8*)(KzfT + (32 * nb + r) * 136 + 16 * ks + 8 * hh);
        const bf16x8 bb = *(const LAS bf16x8*)(KzbT + (32 * nb + r) * 136 + 16 * ks + 8 * hh);
        af = __builtin_amdgcn_mfma_f32_32x32x16_bf16(a, bf, af, 0, 0, 0);
        ab = __builtin_amdgcn_mfma_f32_32x32x16_bf16(a, bb, ab, 0, 0, 0);
    }
    float* of = KVT + ((size_t)((0 * NB + b) * 4 + h) * NCH + c) * 8192; float* ob = KVT + ((size_t)((1 * NB + b) * 4 + h) * NCH + c) * 8192;
#pragma unroll
    for (int reg = 0; reg < 16; ++reg) { const int dv = 32 * mb + (reg & 3) + 8 * (reg >> 2) + 4 * hh, dk = 32 * nb + r; of[dv * 64 + dk] = af[reg]; ob[dv * 64 + dk] = ab[reg]; }
    __syncthreads();
}
__device__ __forceinline__ void ret_r2_unit(const Ctx& C, int layer, int u, int tid) {
    const int q = u & 3, bh = (u >> 2) & 63, dir = u >> 8, b = bh >> 2, h = bh & 3;
    const float G = exp2f(128.f * log2_sigmoid(C.ret_decay()[(layer * 2 + dir) * 4 + h]));
    const size_t base = ((size_t)((dir * NB + b) * 4 + h) * NCH) * 8192 + q * 2048 + tid * 4;
    const float* KVT = (const float*)(C.ws + WS_H) + base; bf16_t* ST = (bf16_t*)(C.ws + WS_YP) + base;
    float z0 = 0.f; asm volatile("" : "+v"(z0)); f32x4 S = {z0, z0, z0, z0};
#pragma unroll
    for (int half = 0; half < 2; ++half) {
        f32x4 kv[17];
#pragma unroll
        for (int s = 0; s < 17; ++s) { const int step = half * 17 + s; const int c = dir == 0 ? step : (step < 2 ? 1 - step : 35 - step); kv[s] = *(const f32x4*)(KVT + (size_t)c * 8192); }
#pragma unroll
        for (int s = 0; s < 17; ++s) { const int step = half * 17 + s; const int c = dir == 0 ? step : (step < 2 ? 1 - step : 35 - step);
            u32x2 w; w.x = pk2(S[0], S[1]); w.y = pk2(S[2], S[3]); *(u32x2*)(ST + (size_t)c * 8192) = w;
            S = S * G + kv[s]; }
    }
}
#define CBAR() do { asm volatile("" ::: "memory"); __builtin_amdgcn_sched_barrier(0); } while (0)
__device__ __forceinline__ void ret_r3_unit(const Ctx& C, int layer, int b, int h, int c, LAS unsigned char* lds, int tid) {
    const int lane = tid & 63, wid = tid >> 6, r = lane & 31, hh = lane >> 5, wr = wid >> 1, wc = wid & 1;
    const bf16_t* P = (const bf16_t*)(C.ws + WS_P);
    LAS float* tab = (LAS float*)lds;
    LAS bf16_t* VT = (LAS bf16_t*)(lds + 2048); LAS bf16_t* Pl = VT + 128 * 136;
    LAS float* Ol = (LAS float*)(lds + 2048);
    const size_t r0 = (size_t)b * TPB + c * 128;
    if (tid < 128) { const float* dec = C.ret_decay(); const float lf = log2_sigmoid(dec[(layer * 2 + 0) * 4 + h]), lb = log2_sigmoid(dec[(layer * 2 + 1) * 4 + h]);
        tab[tid] = exp2f((float)tid * lf) * 0.125f; tab[128 + tid] = exp2f((float)tid * lb) * 0.125f; tab[256 + tid] = exp2f((float)(tid + 1) * lf); tab[384 + tid] = exp2f((float)(128 - tid) * lb); }
    stage_vt(P, r0, h, VT, tid);
    CBAR();
    bf16x8 qf[4];
    { const bf16_t* Qp = P + (r0 + 32 * wr + r) * DIN + C_RQ + h * 64 + 8 * hh;
#pragma unroll
      for (int ks = 0; ks < 4; ++ks) qf[ks] = *(const bf16x8*)(Qp + 16 * ks); }
    float z0 = 0.f; asm volatile("" : "+v"(z0)); f32x16 zv;
#pragma unroll
    for (int i = 0; i < 16; ++i) zv[i] = z0;
    f32x16 acc[2];
    { const bf16_t* Kp = P + (r0 + 64 * wc + r) * DIN + C_RK + h * 64 + 8 * hh;
#pragma unroll
      for (int t = 0; t < 2; ++t) { acc[t] = zv;
#pragma unroll
        for (int ks = 0; ks < 4; ++ks) acc[t] = __builtin_amdgcn_mfma_f32_32x32x16_bf16(qf[ks], *(const bf16x8*)(Kp + (size_t)t * 32 * DIN + 16 * ks), acc[t], 0, 0, 0); } }
    __syncthreads();
#pragma unroll
    for (int t = 0; t < 2; ++t)
#pragma unroll
        for (int reg = 0; reg < 16; ++reg) { const int i = 32 * wr + (reg & 3) + 8 * (reg >> 2) + 4 * hh, j = 64 * wc + 32 * t + r, d = i - j;
            const float D = d > 0 ? tab[d] : (d < 0 ? tab[128 - d] : tab[0] + tab[128]);
            Pl[i * 136 + j] = (bf16_t)f2bf(acc[t][reg] * D); }
    __syncthreads();
    f32x16 o1[2];
    o1[0] = zv; o1[1] = zv;
#pragma unroll
    for (int ks = 0; ks < 8; ++ks) { const bf16x8 a = *(const LAS bf16x8*)(Pl + (32 * wr + r) * 136 + 16 * ks + 8 * hh);
#pragma unroll
        for (int t = 0; t < 2; ++t) o1[t] = __builtin_amdgcn_mfma_f32_32x32x16_bf16(a, *(const LAS bf16x8*)(VT + (64 * wc + 32 * t + r) * 136 + 16 * ks + 8 * hh), o1[t], 0, 0, 0); }
    CBAR();
#pragma unroll
    for (int dir = 0; dir < 2; ++dir) {
        const bf16_t* sp = (const bf16_t*)(C.ws + WS_YP) + ((size_t)((dir * NB + b) * 4 + h) * NCH + c) * 8192 + (64 * wc + r) * 64 + 8 * hh;
#pragma unroll
        for (int t = 0; t < 2; ++t) { acc[t] = zv;
#pragma unroll
            for (int ks = 0; ks < 4; ++ks) acc[t] = __builtin_amdgcn_mfma_f32_32x32x16_bf16(qf[ks], *(const bf16x8*)(sp + t * 32 * 64 + 16 * ks), acc[t], 0, 0, 0); }
#pragma unroll
        for (int t = 0; t < 2; ++t)
#pragma unroll
            for (int reg = 0; reg < 16; ++reg) { const int i = 32 * wr + (reg & 3) + 8 * (reg >> 2) + 4 * hh; o1[t][reg] += tab[256 + 128 * dir + i] * acc[t][reg]; }
        CBAR();
    }
    __syncthreads();
#pragma unroll
    for (int t = 0; t < 2; ++t)
#pragma unroll
        for (int reg = 0; reg < 16; ++reg) { const int i = 32 * wr + (reg & 3) + 8 * (reg >> 2) + 4 * hh, dv = 64 * wc + 32 * t + r; Ol[i * 132 + dv] = o1[t][reg]; }
    __syncthreads();
    { const int row = tid >> 2, q = tid & 3; f32x4 x[8]; float sm = 0.f;
#pragma unroll
      for (int e = 0; e < 8; ++e) { x[e] = *(const LAS f32x4*)(Ol + row * 132 + 32 * q + 4 * e); sm += (x[e][0] + x[e][1]) + (x[e][2] + x[e][3]); }
      sm += xor1(sm); sm += xor2(sm);
      const float mu = sm * (1.f / 128.f); float vs = 0.f;
#pragma unroll
      for (int e = 0; e < 8; ++e) { x[e] = x[e] - mu; vs += (x[e][0] * x[e][0] + x[e][1] * x[e][1]) + (x[e][2] * x[e][2] + x[e][3] * x[e][3]); }
      vs += xor1(vs); vs += xor2(vs);
      const float rstd = 1.0f / sqrtf(vs * (1.f / 128.f) + EPS);
      const bf16_t* gp = P + (r0 + row) * DIN + C_RG + h * 128 + 32 * q; bf16_t* yp = (bf16_t*)(C.ws + WS_Y) + (r0 + row) * DM + h * 128 + 32 * q;
#pragma unroll
      for (int e2 = 0; e2 < 4; ++e2) { const u32x4 gw = *(const u32x4*)(gp + 8 * e2); const f32x4 a = x[2 * e2] * rstd, bq = x[2 * e2 + 1] * rstd;
          u32x4 o; o.x = pk2(a[0] * silu_f(bflo(gw.x)), a[1] * silu_f(bfhi(gw.x))); o.y = pk2(a[2] * silu_f(bflo(gw.y)), a[3] * silu_f(bfhi(gw.y)));
          o.z = pk2(bq[0] * silu_f(bflo(gw.z)), bq[1] * silu_f(bfhi(gw.z))); o.w = pk2(bq[2] * silu_f(bflo(gw.w)), bq[3] * silu_f(bfhi(gw.w)));
          *(u32x4*)(yp + 8 * e2) = o; } }
    __syncthreads();
}

template <bool WIN>
__device__ __forceinline__ void attn_dispatch(const Ctx& C, int layer, int U, int tid, char* lds) {
    using attn_body::bf16;
    int b, h, q0, NT, tdelta;
    if (U < 1024) { b = U >> 6; h = ((U >> 5) & 1) * 2 + ((U >> 4) & 1); q0 = CTX + 256 * (U & 15);
        if (WIN) { const int ts = (q0 / 64 - 2) > 4 ? (q0 / 64 - 2) : 4, te = (q0 / 64 + 6) < 68 ? (q0 / 64 + 6) : 68; NT = 4 + te - ts; tdelta = ts - 4; } else { NT = 68; tdelta = 0; } }
    else { b = (U - 1024) >> 2; h = (U - 1024) & 3; q0 = 0; NT = 4; tdelta = 0; }
    const int kvh = h >> 1;
    const bf16* Pb = (const bf16*)(C.ws + WS_P) + (size_t)b * TPB * DIN; bf16* Yb = (bf16*)(C.ws + WS_Y) + (size_t)b * TPB * DM;
    if (WIN) attn_body::attn_unit<8, true>(Pb + C_WQ + 64 * h, Pb + C_WK + 64 * kvh, Pb + C_WV + 64 * kvh, Yb + 512 + 64 * h, q0, NT, tdelta, C.win_sink()[layer * 4 + h] * LOG2E, tid, lds);
    else     attn_body::attn_unit<8, false>(Pb + C_GQ + 64 * h, Pb + C_GK + 64 * kvh, Pb + C_GV + 64 * kvh, Yb + 768 + 64 * h, q0, NT, tdelta, 0.f, tid, lds);
}
template <bool WIN>
__device__ __forceinline__ void attn_units(const Ctx& C, int layer, int G, int vcu, int bx, int tid, char* lds) {
    const int nctx = (layer == DEPTH - 1) ? 0 : 64;
    if (G == 256) {
        for (int k = 0; k < 4; ++k) attn_dispatch<WIN>(C, layer, vcu * 4 + k, tid, lds);
        if (vcu < nctx) attn_dispatch<WIN>(C, layer, 1024 + vcu, tid, lds);
    } else {
        for (int U = bx; U < 1024 + nctx; U += G) attn_dispatch<WIN>(C, layer, U, tid, lds);
    }
}

__device__ __forceinline__ void phase_norm2_route(const Ctx& C, int layer, LAS unsigned char* lds, int G, int bx, int tid) {
    const int lane = tid & 63, wave = tid >> 6;
    const float* mod = (const float*)(C.ws + WS_MOD) + (size_t)layer * 17 * 6144;
    const float* gain = C.norm2() + layer * DM;
    const float* X32 = (const float*)(C.ws + WS_X32); bf16_t* H = (bf16_t*)(C.ws + WS_H);
    int* list = (int*)(C.ws + WS_LIST); float* GW = (float*)(C.ws + WS_GW);
    unsigned* gcnt = (unsigned*)(C.ws + WS_CTL) + CW_CNT + 64 * layer;
    LAS float* wrT = (LAS float*)lds;
    LAS int* lcnt = (LAS int*)(lds + 65536);
    LAS int* lbase = lcnt + 16;
    LAS int* rec_e = lcnt + 32;
    LAS float* rec_w = (LAS float*)(rec_e + 544);
    for (int i = tid; i < DM * NE; i += 512) { const int k = i >> 4, e = i & 15; wrT[e * DM + k] = C.w_router()[i]; }
    if (tid < 16) lcnt[tid] = 0;
    float br[16];
#pragma unroll
    for (int e = 0; e < 16; ++e) br[e] = C.b_router()[e];
    __syncthreads();
    constexpr int RPC = MROWS / 256;
    for (int chunk = bx; chunk < 256; chunk += G) {
        for (int i = 0; i < RPC / 8; ++i) {
            const int rl = wave * (RPC / 8) + i, m = chunk * RPC + rl;
            const int b = m / TPB, t = m - b * TPB, set = t < CTX ? 16 : b;
            const f32x4* xr = (const f32x4*)(X32 + (size_t)m * DM) + lane;
            f32x4 v[4]; float ss = 0.f;
#pragma unroll
            for (int j = 0; j < 4; ++j) { v[j] = xr[64 * j]; ss += (v[j][0] * v[j][0] + v[j][1] * v[j][1]) + (v[j][2] * v[j][2] + v[j][3] * v[j][3]); }
            const float rstd = 1.0f / sqrtf(wave_sum(ss) * (1.f / DM) + EPS);
            const f32x4* gp = (const f32x4*)gain + lane; const f32x4* shp = (const f32x4*)(mod + (size_t)set * 6144 + 3 * DM) + lane; const f32x4* scp = shp + DM / 4;
            u32x2* ho = (u32x2*)(H + (size_t)m * DM) + lane;
#pragma unroll
            for (int j = 0; j < 4; ++j) { v[j] = (v[j] * rstd) * gp[64 * j] * (scp[64 * j] + 1.0f) + shp[64 * j];
                u32x2 w; w.x = pk2(v[j][0], v[j][1]); w.y = pk2(v[j][2], v[j][3]); ho[64 * j] = w; }
            float lg[16];
#pragma unroll
            for (int e = 0; e < 16; ++e) { float a = 0.f;
#pragma unroll
                for (int j = 0; j < 4; ++j) { const f32x4 w = *(const LAS f32x4*)(wrT + e * DM + 4 * lane + 256 * j); a += (v[j][0] * w[0] + v[j][1] * w[1]) + (v[j][2] * w[2] + v[j][3] * w[3]); }
                lg[e] = wave_sum(a); }
            float sg[16], bs[16];
#pragma unroll
            for (int e = 0; e < 16; ++e) { sg[e] = 1.f / (1.f + expf(-lg[e])); bs[e] = sg[e] + br[e]; }
            int grp = 0; float best = -1e30f;
#pragma unroll
            for (int g = 0; g < 4; ++g) { const float a0 = bs[4 * g], a1 = bs[4 * g + 1], a2 = bs[4 * g + 2], a3 = bs[4 * g + 3];
                const float hi01 = fmaxf(a0, a1), lo01 = fminf(a0, a1), hi23 = fmaxf(a2, a3), lo23 = fminf(a2, a3);
                const float top = fmaxf(hi01, hi23), second = fmaxf(fminf(hi01, hi23), hi01 >= hi23 ? lo01 : lo23);
                const float sc = top + second; if (sc > best) { best = sc; grp = g; } }
            float c4[4], s4[4];
#pragma unroll
            for (int k = 0; k < 4; ++k) { c4[k] = grp == 0 ? bs[k] : grp == 1 ? bs[4 + k] : grp == 2 ? bs[8 + k] : bs[12 + k]; s4[k] = grp == 0 ? sg[k] : grp == 1 ? sg[4 + k] : grp == 2 ? sg[8 + k] : sg[12 + k]; }
            int l0 = 0; float m0 = c4[0];
#pragma unroll
            for (int k = 1; k < 4; ++k) if (c4[k] > m0) { m0 = c4[k]; l0 = k; }
            int l1 = -1; float m1 = -1e30f;
#pragma unroll
            for (int k = 0; k < 4; ++k) if (k != l0 && c4[k] > m1) { m1 = c4[k]; l1 = k; }
            const float w0 = l0 == 0 ? s4[0] : l0 == 1 ? s4[1] : l0 == 2 ? s4[2] : s4[3], w1 = l1 == 0 ? s4[0] : l1 == 1 ? s4[1] : l1 == 2 ? s4[2] : s4[3];
            const float wn = 1.f / (w0 + w1);
            if (lane == 0) { const int e0 = grp * 4 + l0, e1 = grp * 4 + l1;
                const int p0 = __hip_atomic_fetch_add(lcnt + e0, 1, __ATOMIC_RELAXED, __HIP_MEMORY_SCOPE_WORKGROUP);
                const int p1 = __hip_atomic_fetch_add(lcnt + e1, 1, __ATOMIC_RELAXED, __HIP_MEMORY_SCOPE_WORKGROUP);
                rec_e[2 * rl] = e0 | (p0 << 8); rec_e[2 * rl + 1] = e1 | (p1 << 8); rec_w[2 * rl] = w0 * wn; rec_w[2 * rl + 1] = w1 * wn; }
        }
        __syncthreads();
        if (tid < 16) lbase[tid] = (int)__hip_atomic_fetch_add(gcnt + tid, (unsigned)lcnt[tid], __ATOMIC_RELAXED, __HIP_MEMORY_SCOPE_AGENT);
        __syncthreads();
        for (int i = tid; i < 2 * RPC; i += 512) { const int re = rec_e[i], e = re & 255, p = re >> 8; const int id = (chunk * RPC + (i >> 1)) * 2 + (i & 1);
            list[(size_t)e * MROWS + lbase[e] + p] = id; GW[id] = rec_w[i]; }
        __syncthreads();
        if (tid < 16) lcnt[tid] = 0;
        __syncthreads();
    }
}

template <bool GATHER_, int NT>
struct MoeOrder {
    static constexpr bool GATHER = GATHER_;
    const int* list; const LAS int* boff; const LAS int* cnt; int G, c;
    __device__ __forceinline__ bool next(int i, pg8::Unit& u) const {
        const int L = i * G + c; if (L >= boff[16] * NT) return false;
        const int blk = L / NT, pn = L - blk * NT; int e = 0;
#pragma unroll
        for (int k = 1; k < 16; ++k) e += (blk >= boff[k]) ? 1 : 0;
        u.pm = blk; u.pn = e * NT + pn; return true;
    }
    __device__ __forceinline__ unsigned arow(const pg8::Unit& u, int r) const {
        const int e = u.pn / NT, li = (u.pm - boff[e]) * 256 + r;
        const int id = li < cnt[e] ? list[e * MROWS + li] : 0;
        return (unsigned)(id >> 1);
    }
};
struct EpiGateUp {
    static constexpr bool PERM = true;
    bf16_t* O;
    __device__ __forceinline__ void operator()(const f32x4 (&acc)[2][2][4][2], const pg8::Unit& u, int wr, int wc, int fr, int fq) const {
        const int row0 = u.pm * 256 + wr * 64 + fr, col0 = (u.pn & 7) * 128 + wc * 32 + 8 * fq;
#pragma unroll
        for (int ai = 0; ai < 2; ++ai)
#pragma unroll
            for (int m = 0; m < 4; ++m) { const f32x4 a0 = acc[ai][0][m][0], a1 = acc[ai][0][m][1], u0 = acc[ai][1][m][0], u1 = acc[ai][1][m][1];
                u32x4 w; w.x = pk2(silu_f(a0[0]) * u0[0], silu_f(a0[1]) * u0[1]); w.y = pk2(silu_f(a0[2]) * u0[2], silu_f(a0[3]) * u0[3]);
                w.z = pk2(silu_f(a1[0]) * u1[0], silu_f(a1[1]) * u1[1]); w.w = pk2(silu_f(a1[2]) * u1[2], silu_f(a1[3]) * u1[3]);
                *(u32x4*)((char*)O + ((unsigned)(row0 + ai * 128 + m * 16) * (unsigned)FF + (unsigned)col0) * 2u) = w; }
    }
};
struct EpiDown {
    static constexpr bool PERM = true;
    bf16_t* YP; const float* GW; const int* list; const LAS int* boff; const LAS int* cnt;
    __device__ __forceinline__ void operator()(const f32x4 (&acc)[2][2][4][2], const pg8::Unit& u, int wr, int wc, int fr, int fq) const {
        const int e = u.pn >> 2, lb = (u.pm - boff[e]) * 256, n = cnt[e]; const int col0 = (u.pn & 3) * 256 + wc * 32 + 8 * fq;
#pragma unroll
        for (int ai = 0; ai < 2; ++ai)
#pragma unroll
            for (int m = 0; m < 4; ++m) { const int li = lb + ai * 128 + wr * 64 + m * 16 + fr;
                if (li < n) { const int id = list[e * MROWS + li]; const float g = GW[id]; const unsigned off = ((unsigned)id * (unsigned)DM + (unsigned)col0) * 2u;
#pragma unroll
                    for (int bj = 0; bj < 2; ++bj) { const f32x4 v0 = acc[ai][bj][m][0] * g, v1 = acc[ai][bj][m][1] * g;
                        u32x4 w; w.x = pk2(v0[0], v0[1]); w.y = pk2(v0[2], v0[3]); w.z = pk2(v1[0], v1[1]); w.w = pk2(v1[2], v1[3]); *(u32x4*)((char*)YP + off + bj * 256) = w; } } }
    }
};
__device__ __forceinline__ void moe_offsets(const Ctx& C, int layer, LAS int* boff, LAS int* cnt, int tid) {
    if (tid == 0) { const unsigned* gcnt = (const unsigned*)(C.ws + WS_CTL) + CW_CNT + 64 * layer; int acc = 0;
        for (int e = 0; e < 16; ++e) { const int n = (int)__hip_atomic_load(gcnt + e, __ATOMIC_RELAXED, __HIP_MEMORY_SCOPE_AGENT); cnt[e] = n; boff[e] = acc; acc += (n + 255) >> 8; }
        boff[16] = acc; }
    __syncthreads();
}

__device__ __forceinline__ void phase_final(const Ctx& C, int gw, int NGW, int lane) {
    const float* mod = (const float*)(C.ws + WS_MOD) + (size_t)(DEPTH - 1) * 17 * 6144;
    const float* X32 = (const float*)(C.ws + WS_X32); const bf16_t* YP = (const bf16_t*)(C.ws + WS_YP);
    for (int r = gw; r < NB * SEQ; r += NGW) {
        const int b = r / SEQ, t = r - b * SEQ; const size_t m = (size_t)b * TPB + CTX + t;
        const f32x4* xr = (const f32x4*)(X32 + m * DM) + lane; const u32x2* y0 = (const u32x2*)(YP + m * 2 * DM) + lane; const u32x2* y1 = y0 + DM / 4;
        const f32x4* g2 = (const f32x4*)(mod + (size_t)b * 6144 + 5 * DM) + lane; f32x4* o = (f32x4*)(C.out + (size_t)r * DM) + lane;
#pragma unroll
        for (int j = 0; j < 4; ++j) { const u32x2 a = y0[64 * j], bb = y1[64 * j]; const f32x4 g = g2[64 * j];
            f32x4 y; y[0] = bflo(a.x) + bflo(bb.x); y[1] = bfhi(a.x) + bfhi(bb.x); y[2] = bflo(a.y) + bflo(bb.y); y[3] = bfhi(a.y) + bfhi(bb.y);
            o[64 * j] = xr[64 * j] + g * y; }
    }
}

#ifndef PHMASK
#define PHMASK 0xFFFF
#endif
#ifndef MK_ONE_LAUNCH
#define MK_ONE_LAUNCH 1
#endif
constexpr int PH_PER_LAYER = 9, PH_LAYER0 = 2, PH_FINAL = PH_LAYER0 + DEPTH * PH_PER_LAYER, PH_COUNT = PH_FINAL + 1;
struct Args { const float* in[18]; float* out; unsigned char* ws; int ph_lo, ph_hi; };
__global__ void __launch_bounds__(512, 2) mega_fwd(Args args) {
    extern __shared__ __attribute__((aligned(16))) unsigned char lds_raw[];
    LAS unsigned char* lds = (LAS unsigned char*)lds_raw;
    Ctx C; C.out = args.out; C.ws = args.ws;
    const int tid = threadIdx.x, lane = tid & 63, wave = __builtin_amdgcn_readfirstlane(tid >> 6);
    const int G = gridDim.x; const int bx = blockIdx.x; const int vcu = (G % 8 == 0) ? (bx % 8) * (G / 8) + bx / 8 : bx;
    const int gw = vcu * 8 + wave, NGW = G * 8;
    volatile LAS unsigned* MISC = (volatile LAS unsigned*)(lds + LDSCTL_OFF);
    for (int u = tid; u < (LDS_BYTES - LDSCTL_OFF) / 4; u += 512) ((LAS unsigned*)(lds + LDSCTL_OFF))[u] = 0u;
    __syncthreads();
    const int lo = args.ph_lo, hi = args.ph_hi;
    XcdBarrier bar; bar.bar = (unsigned*)(C.ws + WS_CTL) + CW_BAR; bar.x = 0; bar.st = nullptr;
    if (hi - lo > 1) bar = xcd_barrier_post((unsigned*)(C.ws + WS_CTL) + CW_BAR, MISC);
#define IN(k) (lo <= (k) && (k) < hi)
#define PHASE_IDS() int bx_ = bx, wave_ = wave; LAS unsigned char* lds_ = lds; asm volatile("" : "+s"(bx_), "+s"(wave_), "+s"(lds_)); int lane_; asm volatile("v_mbcnt_lo_u32_b32 %0, -1, 0\n\tv_mbcnt_hi_u32_b32 %0, -1, %0" : "=v"(lane_)); const int tid_ = wave_ * 64 + lane_; \
    const int vcu_ = (G % 8 == 0) ? (bx_ % 8) * (G / 8) + bx_ / 8 : bx_; const int gw_ = vcu_ * 8 + wave_; (void)lane_; (void)gw_; (void)vcu_
#define SEAM(k) do { if (IN(k) && IN((k) + 1)) xcd_barrier(bar); } while (0)

    if (IN(0) && (PHMASK & 1)) { PHASE_IDS(); phase_prologue(C, lds_, G, vcu_, bx_, tid_); } SEAM(0);
    if (IN(1) && (PHMASK & 2)) { PHASE_IDS(); phase_modsum(C, G, bx_, tid_); } SEAM(1);

#ifdef LAYER_UNROLL
#pragma unroll
#else
#pragma nounroll
#endif
    for (int layer = 0; layer < DEPTH; ++layer) {
        const int p0 = PH_LAYER0 + layer * PH_PER_LAYER;
        if (IN(p0 + 0) && (PHMASK & 4)) { PHASE_IDS(); phase_norm1(C, layer, gw_, NGW, lane_); } SEAM(p0 + 0);
        if (IN(p0 + 1) && (PHMASK & 8)) {
            pg8::Gemm g{(const bf16_t*)(C.ws + WS_H), (const bf16_t*)(C.ws + WS_WIN) + (size_t)layer * DIN * DM, MROWS, DIN, DM};
            PHASE_IDS(); pg8::StaticOrder S; S.init(MROWS, DIN, G, bx_);
            pg8::EpiBf16 E{(bf16_t*)(C.ws + WS_P), DIN};
            pg8::gemm_phase<pg8::EpiBf16, pg8::StaticOrder, true>(lds_, g, S, E, tid_);
        } SEAM(p0 + 1);
        if (IN(p0 + 2) && (PHMASK & 16)) {
            PHASE_IDS(); phase_qkprep(C, layer, gw_, NGW, lane_);
            for (int u = bx_; u < NB * 4 * NCH; u += G) { const int c = u % NCH, bh = u / NCH; ret_r1_unit(C, layer, bh >> 2, bh & 3, c, lds_, tid_); }
        } SEAM(p0 + 2);
        if (IN(p0 + 3) && (PHMASK & 32)) {
            PHASE_IDS(); for (int u = bx_; u < 512; u += G) ret_r2_unit(C, layer, u, tid_);
            attn_units<false>(C, layer, G, vcu_, bx_, tid_, (char*)lds_);
        } SEAM(p0 + 3);
        if (IN(p0 + 4) && (PHMASK & 64)) {
            PHASE_IDS();
#ifndef NO_WIN
            attn_units<true>(C, layer, G, vcu_, bx_, tid_, (char*)lds_);
#endif
#ifndef NO_R3
            for (int u = bx_; u < NB * 4 * NCH; u += G) { const int c = u % NCH, bh = u / NCH; ret_r3_unit(C, layer, bh >> 2, bh & 3, c, lds_, tid_); }
#endif
        } SEAM(p0 + 4);
        if (IN(p0 + 5) && (PHMASK & 128)) {
            pg8::Gemm g{(const bf16_t*)(C.ws + WS_Y), (const bf16_t*)(C.ws + WS_WOUT) + (size_t)layer * DM * DM, MROWS, DM, DM};
            PHASE_IDS(); pg8::StaticOrder S; S.init(MROWS, DM, G, bx_);
            pg8::EpiResid E{(float*)(C.ws + WS_X32), (const float*)(C.ws + WS_MOD) + (size_t)layer * 17 * 6144 + 2 * DM};
            pg8::gemm_phase<pg8::EpiResid, pg8::StaticOrder, true>(lds_, g, S, E, tid_);
        } SEAM(p0 + 5);
        if (IN(p0 + 6) && (PHMASK & 256)) { PHASE_IDS(); phase_norm2_route(C, layer, lds_, G, bx_, tid_); } SEAM(p0 + 6);
        if (IN(p0 + 7) && (PHMASK & 512)) {
            PHASE_IDS(); LAS int* boff = (LAS int*)(lds_ + LDSCTL_OFF + 64); LAS int* mcnt = (LAS int*)(lds_ + LDSCTL_OFF + 192); moe_offsets(C, layer, boff, mcnt, tid_);
            pg8::Gemm g{(const bf16_t*)(C.ws + WS_H), (const bf16_t*)(C.ws + WS_WGU) + (size_t)layer * NE * 2 * FF * DM, 0, 2 * FF, DM};
            MoeOrder<true, 8> S{(const int*)(C.ws + WS_LIST), boff, mcnt, G, bx_};
            EpiGateUp E{(bf16_t*)(C.ws + WS_P)};
            pg8::gemm_phase<EpiGateUp, MoeOrder<true, 8>, true>(lds_, g, S, E, tid_);
        } SEAM(p0 + 7);
        if (IN(p0 + 8) && (PHMASK & 1024)) {
            PHASE_IDS(); LAS int* boff = (LAS int*)(lds_ + LDSCTL_OFF + 64); LAS int* mcnt = (LAS int*)(lds_ + LDSCTL_OFF + 192); moe_offsets(C, layer, boff, mcnt, tid_);
            pg8::Gemm g{(const bf16_t*)(C.ws + WS_P), (const bf16_t*)(C.ws + WS_WDN) + (size_t)layer * NE * DM * FF, 0, DM, FF};
            MoeOrder<false, 4> S{(const int*)(C.ws + WS_LIST), boff, mcnt, G, bx_};
            EpiDown E{(bf16_t*)(C.ws + WS_YP), (const float*)(C.ws + WS_GW), (const int*)(C.ws + WS_LIST), boff, mcnt};
            pg8::gemm_phase<EpiDown, MoeOrder<false, 4>, true>(lds_, g, S, E, tid_);
        } SEAM(p0 + 8);
    }
    if (IN(PH_FINAL) && (PHMASK & 2048)) { PHASE_IDS(); phase_final(C, gw_, NGW, lane_); }
#undef IN
#undef SEAM
}

extern "C" void kernel_launch(void* const* d_in, const int* in_sizes, int n_in, void* d_out, int out_size, void* d_ws, size_t ws_size, hipStream_t stream) {
    static int grid = 0;
    if (grid == 0) {
        if (n_in != 18 || in_sizes[0] != NB * SEQ * DM || out_size != NB * SEQ * DM || ws_size < WS_END) {
            fprintf(stderr, "kernel_launch: unexpected shapes (n_in %d, in0 %d, out %d, ws %zu, need %zu); nothing launched\n", n_in, n_in > 0 ? in_sizes[0] : -1, out_size, ws_size, (size_t)WS_END); grid = -1; return; }
        int dev = 0, cus = 0, per_cu = 0;
        if (hipGetDevice(&dev) != hipSuccess || hipDeviceGetAttribute(&cus, hipDeviceAttributeMultiprocessorCount, dev) != hipSuccess) { grid = -1; return; }
        if (hipFuncSetAttribute((const void*)mega_fwd, hipFuncAttributeMaxDynamicSharedMemorySize, LDS_BYTES) != hipSuccess) { fprintf(stderr, "kernel_launch: hipFuncSetAttribute failed\n"); grid = -1; return; }
        if (hipOccupancyMaxActiveBlocksPerMultiprocessor(&per_cu, (const void*)mega_fwd, 512, LDS_BYTES) != hipSuccess || per_cu < 1) fprintf(stderr, "kernel_launch: occupancy query says %d\n", per_cu);
        (void)hipGetLastError();
        grid = cus;
    }
    if (grid < 0) return;
    if (hipMemsetAsync((char*)d_ws + WS_CTL, 0, CTL_BYTES, stream) != hipSuccess) return;
    Args a{};
    for (int i = 0; i < 18; ++i) a.in[i] = (const float*)d_in[i];
    a.out = (float*)d_out; a.ws = (unsigned char*)d_ws;
#if MK_ONE_LAUNCH
    a.ph_lo = 0; a.ph_hi = PH_COUNT;
    hipLaunchKernelGGL(mega_fwd, dim3(grid), dim3(512), LDS_BYTES, stream, a);
#else
    for (int p = 0; p < PH_COUNT; ++p) { a.ph_lo = p; a.ph_hi = p + 1; hipLaunchKernelGGL(mega_fwd, dim3(grid), dim3(512), LDS_BYTES, stream, a); }
#endif
}
```

```cpp
#define MK_ONE_LAUNCH 1
#include <hip/hip_runtime.h>
#include <cstdio>
#include <cstdint>

#define GAS __attribute__((address_space(1)))
#define LAS __attribute__((address_space(3)))
typedef unsigned short bf16_t;
typedef short bf16x8 __attribute__((ext_vector_type(8)));
typedef float f32x4 __attribute__((ext_vector_type(4)));
typedef float f32x2 __attribute__((ext_vector_type(2)));
typedef float f32x16 __attribute__((ext_vector_type(16)));
typedef unsigned u32x4 __attribute__((ext_vector_type(4)));
typedef unsigned u32x2 __attribute__((ext_vector_type(2)));

constexpr int DM = 1024, NB = 16, SEQ = 4096, CTX = 256, TPB = SEQ + CTX, MROWS = NB * TPB, DEPTH = 4;
constexpr int DIN = 2560;
constexpr int C_RQ = 0, C_RK = 256, C_RV = 512, C_RG = 1024, C_WQ = 1536, C_WK = 1792, C_WV = 1920, C_GQ = 2048, C_GK = 2304, C_GV = 2432;
constexpr int NE = 16, FF = 1024, NCH = TPB / 128;
constexpr float EPS = 1e-6f;
constexpr float LOG2E = 1.4426950408889634f;
constexpr float QSCALE = 0.125f * LOG2E;

__device__ __forceinline__ unsigned f2bf(float f) { unsigned u = __builtin_bit_cast(unsigned, f); return (u + 0x7fffu + ((u >> 16) & 1u)) >> 16; }
__device__ __forceinline__ unsigned pk2(float lo, float hi) { return f2bf(lo) | (f2bf(hi) << 16); }
__device__ __forceinline__ float bf2f(unsigned short h) { return __builtin_bit_cast(float, (unsigned)h << 16); }
__device__ __forceinline__ float bflo(unsigned w) { return __builtin_bit_cast(float, w << 16); }
__device__ __forceinline__ float bfhi(unsigned w) { return __builtin_bit_cast(float, w & 0xffff0000u); }

namespace pg8 {
constexpr int BM = 256, BK = 64, HALF = 128, HTB = HALF * BK * 2, STAGE_BYTES = 8 * HTB, NXCD = 8, WGM = 8;
__host__ __device__ __forceinline__ int lds_byte(int r, int c) { const int st = (r >> 4) * 2 + (c >> 5), rr = r & 15, cc = c & 31, ob = rr * 64 + cc * 2; return st * 1024 + (ob ^ (((ob >> 9) & 1) << 5)); }
__host__ __device__ __forceinline__ void stage_rc(int b, int& R, int& C) { const int st = b / 1024, sb = b % 1024, swz = sb ^ (((sb >> 9) & 1) << 5); R = (st >> 1) * 16 + swz / 64; C = (st & 1) * 32 + (swz % 64) / 2; }
__host__ __device__ __forceinline__ int perm32(int rho) { const int n = rho >> 4, i = rho & 15; return 8 * (i >> 2) + 4 * n + (i & 3); }

struct Unit { int pm, pn; };
struct Gemm { const bf16_t* A; const bf16_t* Bt; int M, N, K; };

struct StaticOrder {
    static constexpr bool GATHER = false;
    int nM, nN, nwg, G, c;
    __device__ void init(int M, int N, int G_, int c_) { nM = M / BM; nN = N / BM; nwg = nM * nN; G = G_; c = c_; }
    __device__ bool next(int i, Unit& u) const {
        const long L = (long)i * G + c; if (L >= nwg) return false;
        int wgid = (int)L; { const int q = nwg / NXCD, r = nwg % NXCD, xcd = wgid % NXCD, off = wgid / NXCD; wgid = (xcd < r ? xcd * (q + 1) : r * (q + 1) + (xcd - r) * q) + off; }
        const int nig = WGM * nN, gid = wgid / nig, fm = gid * WGM, gsz = (nM - fm) < WGM ? (nM - fm) : WGM;
        u.pm = fm + ((wgid % nig) % gsz); u.pn = (wgid % nig) / gsz; return true;
    }
    __device__ __forceinline__ unsigned arow(const Unit&, int) const { return 0u; }
};

__device__ __forceinline__ unsigned cvt_pk_bf16(float lo, float hi) { unsigned r; asm volatile("v_cvt_pk_bf16_f32 %0, %1, %2" : "=v"(r) : "v"(lo), "v"(hi)); return r; }

struct EpiBf16 {
    static constexpr bool PERM = true;
    bf16_t* O; int ldc;
    __device__ __forceinline__ void operator()(const f32x4 (&acc)[2][2][4][2], const Unit& u, int wr, int wc, int fr, int fq) const {
        const int row0 = u.pm * BM + wr * 64 + fr; const int col0 = u.pn * BM + wc * 32 + 8 * fq;
#pragma unroll
        for (int ai = 0; ai < 2; ++ai)
#pragma unroll
            for (int m = 0; m < 4; ++m) { const unsigned off = ((unsigned)(row0 + ai * HALF + m * 16) * (unsigned)ldc + (unsigned)col0) * 2u;
#pragma unroll
                for (int bj = 0; bj < 2; ++bj) { const f32x4 v0 = acc[ai][bj][m][0], v1 = acc[ai][bj][m][1];
                    u32x4 w; w.x = cvt_pk_bf16(v0[0], v0[1]); w.y = cvt_pk_bf16(v0[2], v0[3]); w.z = cvt_pk_bf16(v1[0], v1[1]); w.w = cvt_pk_bf16(v1[2], v1[3]);
                    *(u32x4*)((char*)O + off + bj * HALF * 2) = w; } }
    }
};

struct EpiResid {
    static constexpr bool PERM = false;
    float* X; const float* gate;
    __device__ __forceinline__ void operator()(const f32x4 (&acc)[2][2][4][2], const Unit& u, int wr, int wc, int fr, int fq) const {
        const int set = (u.pm % 17 == 0) ? 16 : (u.pm / 17);
        const float* gp = gate + (size_t)set * 6 * DM;
        const int col0 = u.pn * BM + wc * 32 + 4 * fq;
        f32x4 gv[2][2];
#pragma unroll
        for (int bj = 0; bj < 2; ++bj)
#pragma unroll
            for (int n = 0; n < 2; ++n) gv[bj][n] = *(const f32x4*)(gp + col0 + bj * HALF + n * 16);
#pragma unroll
        for (int ai = 0; ai < 2; ++ai) {
            f32x4 xin[4][2][2];
#pragma unroll
            for (int m = 0; m < 4; ++m) { const unsigned off = ((unsigned)(u.pm * BM + ai * HALF + wr * 64 + m * 16 + fr) * (unsigned)DM + (unsigned)col0) * 4u;
#pragma unroll
                for (int bj = 0; bj < 2; ++bj)
#pragma unroll
                    for (int n = 0; n < 2; ++n) xin[m][bj][n] = *(const f32x4*)((const char*)X + off + (bj * HALF + n * 16) * 4); }
            asm volatile("" ::: "memory");
#pragma unroll
            for (int m = 0; m < 4; ++m) { const unsigned off = ((unsigned)(u.pm * BM + ai * HALF + wr * 64 + m * 16 + fr) * (unsigned)DM + (unsigned)col0) * 4u;
#pragma unroll
                for (int bj = 0; bj < 2; ++bj)
#pragma unroll
                    for (int n = 0; n < 2; ++n) *(f32x4*)((char*)X + off + (bj * HALF + n * 16) * 4) = xin[m][bj][n] + gv[bj][n] * acc[ai][bj][m][n]; }
            asm volatile("" ::: "memory");
        }
    }
};

template <class Epi, class Sched, bool ALIGN_EPI>
__device__ __forceinline__ void gemm_phase(LAS unsigned char* lds, const Gemm g, const Sched& S, const Epi& E, const int tid) {
    const int wid = __builtin_amdgcn_readfirstlane(tid >> 6), lane = tid & 63, wr = wid >> 2, wc = wid & 3, fr = lane & 15, fq = lane >> 4;
    const int K = g.K, nt = K / BK;
    unsigned voffB[2], vA[2][2], vAn[2][2]; int sR[2], sC[2];
#pragma unroll
    for (int i = 0; i < 2; ++i) { int R, C; stage_rc(tid * 16 + i * 8192, R, C); sR[i] = R; sC[i] = C; const int Rb = Epi::PERM ? ((R & ~31) + perm32(R & 31)) : R;
        voffB[i] = (unsigned)(Rb * K + C) * 2u; }
#define PG8_SETV(v, u) do { _Pragma("unroll") for (int h_ = 0; h_ < 2; ++h_) _Pragma("unroll") for (int i_ = 0; i_ < 2; ++i_) { \
        if constexpr (Sched::GATHER) v[h_][i_] = S.arow(u, h_ * HALF + sR[i_]) * (unsigned)(K * 2) + (unsigned)(sC[i_] * 2); \
        else v[h_][i_] = (unsigned)((h_ * HALF + sR[i_]) * K + sC[i_]) * 2u; } } while (0)
    const size_t kstep = (size_t)(BK * 2);
    const size_t hstep = (size_t)HALF * K * 2;
    const size_t tstep = 2 * hstep;
    const size_t atstep = Sched::GATHER ? (size_t)0 : tstep;
    const unsigned ldsw = (unsigned)wid * 1024u;
    const int aoff = lds_byte(wr * 64 + fr, fq * 8), boff = lds_byte(wc * 32 + fr, fq * 8);
#define PG8_SA(b, h) (((b) * 2 + (h)) * HTB)
#define PG8_SB(b, h) ((4 + (b) * 2 + (h)) * HTB)
#define PG8_STAGE(bufoff, gbase, voff) do { _Pragma("unroll") for (int _i = 0; _i < 2; ++_i) \
        __builtin_amdgcn_global_load_lds((const unsigned*)((const char*)(gbase) + (voff)[_i]), (LAS unsigned*)(lds + (bufoff) + ldsw + _i * 8192), 16, 0, 0); } while (0)
#define PG8_LDA(dst, b, h) do { _Pragma("unroll") for (int m = 0; m < 4; ++m) _Pragma("unroll") for (int k = 0; k < 2; ++k) dst[m][k] = *(const LAS bf16x8*)(lds + PG8_SA(b, h) + aoff + m * 2048 + k * 1024); } while (0)
#define PG8_LDB(dst, b, h) do { _Pragma("unroll") for (int n = 0; n < 2; ++n) _Pragma("unroll") for (int k = 0; k < 2; ++k) dst[n][k] = *(const LAS bf16x8*)(lds + PG8_SB(b, h) + boff + n * 2048 + k * 1024); } while (0)
#define PG8_MMA(ai, bj, At, Bt) do { __builtin_amdgcn_s_setprio(1); _Pragma("unroll") for (int m = 0; m < 4; ++m) _Pragma("unroll") for (int n = 0; n < 2; ++n) _Pragma("unroll") for (int k = 0; k < 2; ++k) \
        acc[ai][bj][m][n] = __builtin_amdgcn_mfma_f32_16x16x32_bf16(Bt[n][k], At[m][k], acc[ai][bj][m][n], 0, 0, 0); __builtin_amdgcn_s_setprio(0); } while (0)
#define PG8_WAIT_V(n) asm volatile("s_waitcnt vmcnt(" #n ")" ::: "memory")
#define PG8_WAIT_L(n) asm volatile("s_waitcnt lgkmcnt(" #n ")" ::: "memory")
#define PG8_BAR __builtin_amdgcn_s_barrier()
#define PG8_SCHED __builtin_amdgcn_sched_barrier(0)
    Unit cur, nxt; int ui = 0;
    if (!S.next(0, cur)) return;
    float z0 = 0.f; asm volatile("" : "+v"(z0));
    f32x4 acc[2][2][4][2];
#pragma unroll
    for (int a = 0; a < 2; ++a)
#pragma unroll
        for (int b = 0; b < 2; ++b)
#pragma unroll
            for (int m = 0; m < 4; ++m)
#pragma unroll
                for (int n = 0; n < 2; ++n) acc[a][b][m][n] = (f32x4){z0, z0, z0, z0};
    bf16x8 At[4][2], B0[2][2], B1[2][2];
    const char* cA = (const char*)g.A + (size_t)cur.pm * atstep; const char* cB = (const char*)g.Bt + (size_t)cur.pn * tstep;
    PG8_SETV(vA, cur);
    PG8_STAGE(PG8_SB(0, 0), cB, voffB); PG8_STAGE(PG8_SB(0, 1), cB + hstep, voffB); PG8_STAGE(PG8_SA(0, 0), cA, vA[0]); PG8_STAGE(PG8_SA(0, 1), cA, vA[1]);
    if (wr == 1) PG8_BAR;
    PG8_WAIT_V(2); PG8_BAR;
    PG8_STAGE(PG8_SB(1, 0), cB + kstep, voffB); PG8_STAGE(PG8_SA(1, 0), cA + kstep, vA[0]); PG8_STAGE(PG8_SB(1, 1), cB + hstep + kstep, voffB);
    PG8_WAIT_V(6); PG8_BAR;
    for (;;) {
        const bool has_next = S.next(ui + 1, nxt);
        const char* nA = has_next ? (const char*)g.A + (size_t)nxt.pm * atstep : cA; const char* nB = has_next ? (const char*)g.Bt + (size_t)nxt.pn * tstep : cB;
        if (has_next) { PG8_SETV(vAn, nxt); } else {
#pragma unroll
            for (int h_ = 0; h_ < 2; ++h_)
#pragma unroll
                for (int i_ = 0; i_ < 2; ++i_) vAn[h_][i_] = vA[h_][i_]; }
        for (int t = 0; t < nt; t += 2) {
            const bool last = (t == nt - 2);
            const char* a1 = cA + (size_t)(t + 1) * kstep;
            const char* a2 = last ? nA : cA + (size_t)(t + 2) * kstep; const char* b2 = last ? nB : cB + (size_t)(t + 2) * kstep;
            const char* a3 = a2 + kstep; const char* b3 = b2 + kstep;
            unsigned o2[2][2];
#pragma unroll
            for (int h_ = 0; h_ < 2; ++h_)
#pragma unroll
                for (int i_ = 0; i_ < 2; ++i_) o2[h_][i_] = last ? vAn[h_][i_] : vA[h_][i_];
            PG8_LDB(B0, 0, 0); PG8_LDB(B1, 0, 1); PG8_SCHED; PG8_LDA(At, 0, 0); PG8_STAGE(PG8_SA(1, 1), a1, vA[1]);
            PG8_WAIT_V(8); PG8_WAIT_L(0); PG8_BAR; PG8_MMA(0, 0, At, B0); PG8_MMA(0, 1, At, B1); PG8_BAR; PG8_SCHED;
            PG8_LDA(At, 0, 1); PG8_STAGE(PG8_SB(0, 0), b2, voffB); PG8_STAGE(PG8_SB(0, 1), b2 + hstep, voffB); PG8_STAGE(PG8_SA(0, 0), a2, o2[0]);
            PG8_WAIT_V(8); PG8_WAIT_L(0); PG8_BAR; PG8_MMA(1, 0, At, B0); PG8_MMA(1, 1, At, B1); PG8_BAR; PG8_SCHED;
            PG8_LDB(B0, 1, 0); PG8_LDB(B1, 1, 1); PG8_SCHED; PG8_LDA(At, 1, 0); PG8_STAGE(PG8_SA(0, 1), a2, o2[1]);
            PG8_WAIT_V(8); PG8_WAIT_L(0); PG8_BAR; PG8_MMA(0, 0, At, B0); PG8_MMA(0, 1, At, B1); PG8_BAR; PG8_SCHED;
            PG8_LDA(At, 1, 1); PG8_STAGE(PG8_SB(1, 0), b3, voffB); PG8_STAGE(PG8_SB(1, 1), b3 + hstep, voffB); PG8_STAGE(PG8_SA(1, 0), a3, o2[0]);
            PG8_WAIT_V(8); PG8_WAIT_L(0); PG8_BAR; PG8_MMA(1, 0, At, B0); PG8_MMA(1, 1, At, B1); PG8_BAR; PG8_SCHED;
        }
        if constexpr (ALIGN_EPI) { if (wr == 0) PG8_BAR; }
        E(acc, cur, wr, wc, fr, fq);
        if (!has_next) break;
#pragma unroll
        for (int a = 0; a < 2; ++a)
#pragma unroll
            for (int b = 0; b < 2; ++b)
#pragma unroll
                for (int m = 0; m < 4; ++m)
#pragma unroll
                    for (int n = 0; n < 2; ++n) acc[a][b][m][n] = (f32x4){z0, z0, z0, z0};
        cur = nxt; cA = nA; cB = nB; ++ui;
#pragma unroll
        for (int h_ = 0; h_ < 2; ++h_)
#pragma unroll
            for (int i_ = 0; i_ < 2; ++i_) vA[h_][i_] = vAn[h_][i_];
        if constexpr (ALIGN_EPI) { if (wr == 1) PG8_BAR; }
    }
    PG8_WAIT_V(0);
    if constexpr (!ALIGN_EPI) { if (wr == 0) PG8_BAR; }
    PG8_BAR;
#undef PG8_SETV
#undef PG8_SA
#undef PG8_SB
#undef PG8_STAGE
#undef PG8_LDA
#undef PG8_LDB
#undef PG8_MMA
#undef PG8_WAIT_V
#undef PG8_WAIT_L
#undef PG8_BAR
#undef PG8_SCHED
}
}
#include <hip/hip_bf16.h>
#include <cmath>
namespace attn_body {
using bf16=__hip_bfloat16;
using s16x4=__attribute__((ext_vector_type(4)))short;
constexpr int D=64,QP=DIN,OP=1024;
constexpr int NW=8,QBLK=32,QB=QBLK*NW,KVBLK=64;
__device__ __forceinline__ int crow(int r,int hi){return (r&3)+8*(r>>2)+4*hi;}
#define SBAR() __builtin_amdgcn_sched_barrier(0)
__device__ __forceinline__ void wmask(f32x16&p0,f32x16&p1,int kq,int hi){
  const float NEG=-INFINITY; const int kb=kq+4*hi;
  #pragma unroll
  for(int r=0;r<16;++r){const int d=kb+(r&3)+8*(r>>2); if(d>128||d<-128)p0[r]=NEG; if(d+32>128||d+32<-128)p1[r]=NEG;}
}

constexpr int NSLOT=3, SLOTB=8192;
constexpr int LDS_K=0, LDS_V=NSLOT*SLOTB, LDS_WS=2*NSLOT*SLOTB, LDS_OST=LDS_WS+NW*64*4, LDS_BYTES=LDS_OST+NW*4096;
constexpr float C2=0.125f*1.4426950408889634f;
__device__ __forceinline__ void glds16(const void*gsrc,unsigned lds_dst){unsigned keep;
  asm volatile("s_mov_b32 %0, m0\n\ts_mov_b32 m0, %2\n\ts_nop 0\n\tglobal_load_lds_dwordx4 %1, off\n\ts_mov_b32 m0, %0":"=&s"(keep):"v"(gsrc),"s"(lds_dst):"memory");}
__device__ __forceinline__ float max3f(float a,float b,float c){float r;asm("v_max3_f32 %0, %1, %2, %3":"=v"(r):"v"(a),"v"(b),"v"(c));return r;}
__device__ __forceinline__ float max2f(float a,float b){float r;asm("v_max_f32_e32 %0, %1, %2":"=v"(r):"v"(a),"v"(b));return r;}
__device__ __forceinline__ float fadd_s(float a,float b){float r;asm("v_add_f32_e32 %0, %1, %2":"=v"(r):"v"(a),"v"(b));return r;}
__device__ __forceinline__ float fsub_s(float a,float b){float r;asm("v_sub_f32_e32 %0, %1, %2":"=v"(r):"v"(a),"v"(b));return r;}
typedef float f32x2_t __attribute__((ext_vector_type(2))); typedef __bf16 bf16x2_t __attribute__((ext_vector_type(2)));
__device__ __forceinline__ unsigned cvtpk_s(float lo,float hi){f32x2_t v={lo,hi};bf16x2_t b=__builtin_convertvector(v,bf16x2_t);return __builtin_bit_cast(unsigned,b);}
#define WAIT_BAR(N) asm volatile("s_waitcnt vmcnt(" #N ") lgkmcnt(0)\n\ts_barrier":::"memory")

__device__ __forceinline__ void qkt(f32x16&p0,f32x16&p1,const char*Kslot,const bf16x8*qr,const f32x16&negm,int r32,int hi){
  const char*kb=Kslot+hi*1024+r32*16;
  #pragma unroll
  for(int d0=0;d0<4;++d0){
    const bf16x8 b0=*reinterpret_cast<const bf16x8*>(kb+d0*2048);
    const bf16x8 b1=*reinterpret_cast<const bf16x8*>(kb+d0*2048+512);
    if(d0==0){p0=__builtin_amdgcn_mfma_f32_32x32x16_bf16(b0,qr[0],negm,0,0,0);p1=__builtin_amdgcn_mfma_f32_32x32x16_bf16(b1,qr[0],negm,0,0,0);}
    else{p0=__builtin_amdgcn_mfma_f32_32x32x16_bf16(b0,qr[d0],p0,0,0,0);p1=__builtin_amdgcn_mfma_f32_32x32x16_bf16(b1,qr[d0],p1,0,0,0);}}
}
typedef __attribute__((address_space(3))) const char* lds_cptr;
typedef short v4i16_t __attribute__((ext_vector_type(4)));
__device__ __forceinline__ void kload8(bf16x8*kf,lds_cptr kp){
  kf[0]=*(const __attribute__((address_space(3))) bf16x8*)(kp);      kf[1]=*(const __attribute__((address_space(3))) bf16x8*)(kp+512);
  kf[2]=*(const __attribute__((address_space(3))) bf16x8*)(kp+2048); kf[3]=*(const __attribute__((address_space(3))) bf16x8*)(kp+2560);
  kf[4]=*(const __attribute__((address_space(3))) bf16x8*)(kp+4096); kf[5]=*(const __attribute__((address_space(3))) bf16x8*)(kp+4608);
  kf[6]=*(const __attribute__((address_space(3))) bf16x8*)(kp+6144); kf[7]=*(const __attribute__((address_space(3))) bf16x8*)(kp+6656);
}
__device__ __forceinline__ void kload2(bf16x8*kf,lds_cptr kp,int j){ kf[2*j]=*(const __attribute__((address_space(3))) bf16x8*)(kp+j*2048); kf[2*j+1]=*(const __attribute__((address_space(3))) bf16x8*)(kp+j*2048+512); }
__device__ __forceinline__ s16x4 vtr(lds_cptr p){ return __builtin_bit_cast(s16x4,__builtin_amdgcn_ds_read_tr16_b64_v4i16((__attribute__((address_space(3))) v4i16_t*)p)); }
__device__ __forceinline__ float rowmax(const f32x16&p0,const f32x16&p1){
  float a=max3f(p0[0],p0[1],p1[0]),b=max3f(p0[2],p0[3],p1[1]);a=max3f(a,p1[2],p1[3]);
  #pragma unroll
  for(int r=4;r<16;r+=4){a=max3f(a,p0[r],p0[r+1]);b=max3f(b,p0[r+2],p0[r+3]);a=max3f(a,p1[r],p1[r+1]);b=max3f(b,p1[r+2],p1[r+3]);}
  const float m=max2f(a,b);
  auto rr=__builtin_amdgcn_permlane32_swap(__float_as_uint(m),__float_as_uint(m),false,false);
  return max2f(__uint_as_float(rr[0]),__uint_as_float(rr[1]));
}
__device__ __forceinline__ void pv(f32x16*o,int vb,bf16x8 pa0,bf16x8 pa1,bf16x8 pa2,bf16x8 pa3){
  #pragma unroll
  for(int d0=0;d0<2;++d0){s16x4 lo[4],hi[4];
    #pragma unroll
    for(int ks=0;ks<4;++ks){
      asm volatile("ds_read_b64_tr_b16 %0,%1 offset:%c2":"=&v"(lo[ks]):"v"(vb),"i"(d0*4096+ks*1024):"memory");
      asm volatile("ds_read_b64_tr_b16 %0,%1 offset:%c2":"=&v"(hi[ks]):"v"(vb),"i"(d0*4096+ks*1024+512):"memory");}
    asm volatile("s_waitcnt lgkmcnt(0)":::"memory");SBAR();
    #define PK(k) (bf16x8){lo[k][0],lo[k][1],lo[k][2],lo[k][3],hi[k][0],hi[k][1],hi[k][2],hi[k][3]}
    o[d0]=__builtin_amdgcn_mfma_f32_32x32x16_bf16(pa0,PK(0),o[d0],0,0,0);
    o[d0]=__builtin_amdgcn_mfma_f32_32x32x16_bf16(pa1,PK(1),o[d0],0,0,0);
    o[d0]=__builtin_amdgcn_mfma_f32_32x32x16_bf16(pa2,PK(2),o[d0],0,0,0);
    o[d0]=__builtin_amdgcn_mfma_f32_32x32x16_bf16(pa3,PK(3),o[d0],0,0,0);
    #undef PK
  }
}

#ifndef ATTN_STORE16
#define ATTN_STORE16(p,v) (*(u32x4*)(p)=(v))
#endif
template<int THRL,bool WIN> __device__ __forceinline__ void attn_unit(const bf16*Qb,const bf16*__restrict__ Kb,const bf16*__restrict__ Vb,bf16*Ob,int q0,int NT,int tdelta,float sink_l2,int tid,char*shm){
  const int lane=tid&63,r32=lane&31,hi=lane>>5; const int wid=__builtin_amdgcn_readfirstlane(tid>>6);
  const bf16*Qw=Qb+(long)(q0+wid*QBLK)*QP;
  const bf16*Kh=Kb,*Vh=Vb;
  const unsigned lds0=(unsigned)(uintptr_t)shm;
  float*wsf=(float*)(shm+LDS_WS)+wid*64;
  const bf16*ksrc=Kh+(long)lane*QP+wid*8;
  const bf16*vsrc=Vh+(long)(16*(wid&3)+(lane>>2))*QP+(wid>>2)*32+(lane&3)*8;
  const unsigned kdst=lds0+LDS_K+wid*1024, vdst=lds0+LDS_V+wid*1024;
  #define TM(t) ((t)<4?(t):(t)+tdelta)
  #define DMA_K(t,slot) glds16(ksrc+(long)TM(t)*KVBLK*QP,(unsigned)__builtin_amdgcn_readfirstlane(kdst+(slot)))
  #define DMA_V(t,slot) glds16(vsrc+(long)TM(t)*KVBLK*QP,(unsigned)__builtin_amdgcn_readfirstlane(vdst+(slot)))
  const int vb0=(int)(lds0+LDS_V)+((lane>>4)&1)*32+(lane&3)*8+(4*hi+((lane&15)>>2))*64;
  const char*Kbase=shm+LDS_K; bf16x8 kf[8];
  const lds_cptr shm3=(lds_cptr)shm; const lds_cptr kp0=shm3+LDS_K+hi*1024+r32*16; const lds_cptr vp0=shm3+LDS_V+((lane>>4)&1)*32+(lane&3)*8+(4*hi+((lane&15)>>2))*64;
  DMA_K(0,0);DMA_V(0,0);DMA_K(1,SLOTB);
  bf16x8 qr[4];
  #pragma unroll
  for(int d0=0;d0<4;++d0)qr[d0]=*reinterpret_cast<const bf16x8*>(&Qw[(long)r32*QP+d0*16+hi*8]);
  float mhat=0.f,l_reg=0.f;float z0_=0.f;asm volatile("":"+v"(z0_));f32x16 o[2];
  #pragma unroll
  for(int r_=0;r_<16;++r_){o[0][r_]=z0_;o[1][r_]=z0_;}
  f32x16 negm;
  #pragma unroll
  for(int r_=0;r_<16;++r_)negm[r_]=z0_;
  asm volatile("":"+v"(negm));
  const int qrow=q0+wid*QBLK+r32;
  #define CMASK(P0,P1,t) do{ if(WIN&&(t)>=4)wmask(P0,P1,TM(t)*KVBLK-qrow,hi); }while(0)
  bool resc=false;
  #define START(P0,P1) do{ const float rm=rowmax(P0,P1); resc=false; \
    { const float dl=rm; mhat=fadd_s(mhat,dl); \
      _Pragma("unroll") for(int r=0;r<16;++r){P0[r]=fsub_s(P0[r],dl);P1[r]=fsub_s(P1[r],dl);} \
      _Pragma("unroll") for(int r=0;r<16;++r)negm[r]=-mhat; asm volatile("":"+v"(negm)); } \
    _Pragma("unroll") for(int r=0;r<16;++r)P0[r]=__builtin_amdgcn_exp2f(P0[r]); }while(0)
  #define RESC() do{ if(resc){ asm volatile("s_waitcnt lgkmcnt(0)":::"memory"); \
      _Pragma("unroll") for(int d_=0;d_<2;++d_) _Pragma("unroll") for(int r=0;r<16;++r)o[d_][r]*=wsf[crow(r,hi)]; } }while(0)
  f32x16 pA0,pA1,pB0,pB1;
  int sl_prev=0,sl_cur=0,sl_next=SLOTB;
  #define ROT() do{sl_prev=sl_cur;sl_cur=sl_next;sl_next=(sl_next==(NSLOT-1)*SLOTB)?0:sl_next+SLOTB;}while(0)
  DMA_K(2,2*SLOTB);
  WAIT_BAR(3);
  qkt(pA0,pA1,Kbase,qr,negm,r32,hi);asm volatile("s_nop 15\n\ts_nop 7":"+v"(pA0),"+v"(pA1));CMASK(pA0,pA1,0);
  START(pA0,pA1);
  _Pragma("unroll") for(int r=0;r<16;++r)pA1[r]=__builtin_amdgcn_exp2f(pA1[r]);
  WAIT_BAR(0);
  DMA_K(3,0);DMA_V(1,SLOTB);
  ROT();
  kload8(kf,kp0+sl_cur);
  WAIT_BAR(2);
  s16x4 vlo[8],vhi[8]; u32x4 pw0,pw1,pw2,pw3;
  #define PKW(P,B) cvtpk_s(P[B],P[B+1])
  #define PAF(k) __builtin_bit_cast(bf16x8,pw##k)
  #define VFR(i) (bf16x8){vlo[i][0],vlo[i][1],vlo[i][2],vlo[i][3],vhi[i][0],vhi[i][1],vhi[i][2],vhi[i][3]}
  #define PIN(x) asm volatile("":"+v"(x))
  #define MX3(a,b,c) __builtin_fmaxf(__builtin_fmaxf((a),(b)),(c))
  #define GAPA(MF,A0,A1,A2,A3,W0,W1,PW) do{ MF; sacc+=A0; sacc+=A1; sacc+=A2; sacc+=A3; PIN(sacc); W0; W1; PIN(PW); SBAR(); }while(0)
  #define EX(v) __builtin_amdgcn_exp2f(v)
  #define GAPB(MF,X,B) do{ MF; X[B]=EX(X[B]); X[B+1]=EX(X[B+1]); X[B+2]=EX(X[B+2]); X[B+3]=EX(X[B+3]); PIN(X); SBAR(); }while(0)
  #define VRD(i) do{ vlo[i]=vtr(vp_+(((i)>>2)*4096+((i)&3)*1024)); vhi[i]=vtr(vp_+(((i)>>2)*4096+((i)&3)*1024+512)); }while(0)
  #define KRD(G,j) do{ if(G){ kload2(kf,kp0+sl_next,j); SBAR(); } }while(0)
  #define STEP(C0,C1,P0,P1,t,GK,GV,GL) do{ SBAR(); \
    const lds_cptr vp_=vp0+sl_prev; \
    VRD(0); SBAR(); float sacc=(P0[0]+P0[1]); \
    GAPA(C0=__builtin_amdgcn_mfma_f32_32x32x16_bf16(kf[0],qr[0],negm,0,0,0), P0[2],P0[3],P0[4],P0[5],     pw0[0]=PKW(P0,0), pw0[1]=PKW(P0,2), pw0); \
    VRD(4); SBAR(); GAPA(C1=__builtin_amdgcn_mfma_f32_32x32x16_bf16(kf[1],qr[0],negm,0,0,0), P0[6],P0[7],P0[8],P0[9],     pw0[2]=PKW(P0,4), pw0[3]=PKW(P0,6), pw0); \
    VRD(1); SBAR(); GAPA(C0=__builtin_amdgcn_mfma_f32_32x32x16_bf16(kf[2],qr[1],C0,0,0,0),   P0[10],P0[11],P0[12],P0[13], pw1[0]=PKW(P0,8), pw1[1]=PKW(P0,10), pw1); \
    VRD(5); SBAR(); GAPA(C1=__builtin_amdgcn_mfma_f32_32x32x16_bf16(kf[3],qr[1],C1,0,0,0),   P0[14],P0[15],P1[0],P1[1],   pw1[2]=PKW(P0,12),pw1[3]=PKW(P0,14), pw1); \
    VRD(2); SBAR(); GAPA(C0=__builtin_amdgcn_mfma_f32_32x32x16_bf16(kf[4],qr[2],C0,0,0,0),   P1[2],P1[3],P1[4],P1[5],     pw2[0]=PKW(P1,0), pw2[1]=PKW(P1,2), pw2); \
    VRD(6); SBAR(); GAPA(C1=__builtin_amdgcn_mfma_f32_32x32x16_bf16(kf[5],qr[2],C1,0,0,0),   P1[6],P1[7],P1[8],P1[9],     pw2[2]=PKW(P1,4), pw2[3]=PKW(P1,6), pw2); \
    VRD(3); SBAR(); GAPA(C0=__builtin_amdgcn_mfma_f32_32x32x16_bf16(kf[6],qr[3],C0,0,0,0),   P1[10],P1[11],P1[12],P1[13], pw3[0]=PKW(P1,8), pw3[1]=PKW(P1,10), pw3); \
    VRD(7); SBAR(); GAPA(C1=__builtin_amdgcn_mfma_f32_32x32x16_bf16(kf[7],qr[3],C1,0,0,0),   P1[14],P1[15],0.f,0.f,       pw3[2]=PKW(P1,12),pw3[3]=PKW(P1,14), pw3); \
    l_reg+=sacc; \
    if(GK){DMA_K((t)+3,sl_cur);} if(GV){DMA_V((t)+1,sl_next);} \
    CMASK(C0,C1,t); \
    { float a=MX3(C0[0],C0[1],C1[0]),b=MX3(C0[2],C0[3],C1[1]); a=MX3(a,C1[2],C1[3]); \
      _Pragma("unroll") for(int r=4;r<16;r+=4){a=MX3(a,C0[r],C0[r+1]);b=MX3(b,C0[r+2],C0[r+3]);a=MX3(a,C1[r],C1[r+1]);b=MX3(b,C1[r+2],C1[r+3]);} \
      float rm=__builtin_fmaxf(a,b); { auto rr=__builtin_amdgcn_permlane32_swap(__float_as_uint(rm),__float_as_uint(rm),false,false); rm=__builtin_fmaxf(__uint_as_float(rr[0]),__uint_as_float(rr[1])); } \
      resc=false; \
      if(__builtin_expect(__any(rm>(float)THRL),0)){ const float dl=__builtin_fmaxf(rm,0.f); mhat+=dl; \
        _Pragma("unroll") for(int r=0;r<16;++r){C0[r]-=dl;C1[r]-=dl;} \
        _Pragma("unroll") for(int r=0;r<16;++r)negm[r]=-mhat; asm volatile("":"+v"(negm)); \
        const float f=__builtin_amdgcn_exp2f(-dl); l_reg*=f; if(hi==0)wsf[r32]=f; resc=true; } } \
    SBAR(); \
    GAPB(o[0]=__builtin_amdgcn_mfma_f32_32x32x16_bf16(PAF(0),VFR(0),o[0],0,0,0), C0,0); \
    GAPB(o[1]=__builtin_amdgcn_mfma_f32_32x32x16_bf16(PAF(0),VFR(4),o[1],0,0,0), C0,4); \
    KRD(GL,0); GAPB(o[0]=__builtin_amdgcn_mfma_f32_32x32x16_bf16(PAF(1),VFR(1),o[0],0,0,0), C0,8); \
    KRD(GL,1); GAPB(o[1]=__builtin_amdgcn_mfma_f32_32x32x16_bf16(PAF(1),VFR(5),o[1],0,0,0), C0,12); \
    KRD(GL,2); GAPB(o[0]=__builtin_amdgcn_mfma_f32_32x32x16_bf16(PAF(2),VFR(2),o[0],0,0,0), C1,0); \
    KRD(GL,3); GAPB(o[1]=__builtin_amdgcn_mfma_f32_32x32x16_bf16(PAF(2),VFR(6),o[1],0,0,0), C1,4); \
    GAPB(o[0]=__builtin_amdgcn_mfma_f32_32x32x16_bf16(PAF(3),VFR(3),o[0],0,0,0), C1,8); \
    GAPB(o[1]=__builtin_amdgcn_mfma_f32_32x32x16_bf16(PAF(3),VFR(7),o[1],0,0,0), C1,12); \
    }while(0)
  int t=1;
  for(;t+5<NT;t+=2){
    STEP(pB0,pB1,pA0,pA1,t,true,true,true);     WAIT_BAR(2); RESC(); ROT();
    STEP(pA0,pA1,pB0,pB1,t+1,true,true,true);   WAIT_BAR(2); RESC(); ROT();
  }
  #define ENDW(tt) do{ if((tt)+3<NT){WAIT_BAR(2);} else if((tt)+2<NT){WAIT_BAR(1);} else {WAIT_BAR(0);} }while(0)
  for(;t+1<NT;t+=2){
    STEP(pB0,pB1,pA0,pA1,t,(t+3<NT),(t+1<NT),(t+1<NT));       ENDW(t);   RESC(); ROT();
    STEP(pA0,pA1,pB0,pB1,t+1,(t+4<NT),(t+2<NT),(t+2<NT));     ENDW(t+1); RESC(); ROT();
  }
  STEP(pB0,pB1,pA0,pA1,NT-1,false,false,false); RESC();
  { float sacc=pB0[0]+pB0[1]; _Pragma("unroll") for(int r=2;r<16;++r)sacc+=pB0[r]; _Pragma("unroll") for(int r=0;r<16;++r)sacc+=pB1[r]; l_reg+=sacc;
    pw0=(u32x4){PKW(pB0,0),PKW(pB0,2),PKW(pB0,4),PKW(pB0,6)};pw1=(u32x4){PKW(pB0,8),PKW(pB0,10),PKW(pB0,12),PKW(pB0,14)};pw2=(u32x4){PKW(pB1,0),PKW(pB1,2),PKW(pB1,4),PKW(pB1,6)};pw3=(u32x4){PKW(pB1,8),PKW(pB1,10),PKW(pB1,12),PKW(pB1,14)};
    SBAR(); pv(o,vb0+sl_cur,PAF(0),PAF(1),PAF(2),PAF(3)); }
  #undef PKW
  #undef PAF
  #undef VFR
  #undef PIN
  #undef MX3
  #undef GAPA
  #undef GAPB
  #undef EX
  #undef VRD
  #undef KRD
  #undef STEP
  #undef ENDW
  {auto rr=__builtin_amdgcn_permlane32_swap(__float_as_uint(l_reg),__float_as_uint(l_reg),false,false);l_reg=__uint_as_float(rr[0])+__uint_as_float(rr[1]);}
  if(WIN)l_reg+=__builtin_amdgcn_exp2f(sink_l2-mhat);
  if(hi==0)wsf[32+r32]=l_reg;asm volatile("s_waitcnt lgkmcnt(0)":::"memory");
  float rli[16];
  #pragma unroll
  for(int r=0;r<16;++r)rli[r]=__builtin_amdgcn_rcpf(wsf[32+crow(r,hi)]);
  bf16*Ow=Ob+(long)(q0+wid*QBLK)*OP;
  { bf16*stg=(bf16*)(shm+LDS_OST)+wid*2048;
    #pragma unroll
    for(int r=0;r<16;++r){const int orow=crow(r,hi);
      #pragma unroll
      for(int d0=0;d0<2;++d0)stg[orow*64+d0*32+r32]=__float2bfloat16(o[d0][r]*rli[r]);}
    asm volatile("s_waitcnt lgkmcnt(0)":::"memory");
    #pragma unroll
    for(int i=0;i<4;++i){const int row=i*8+(lane>>3),ch=lane&7; const u32x4 v=*(const u32x4*)(stg+row*64+ch*8); ATTN_STORE16(Ow+(long)row*OP+ch*8,v);} }
  asm volatile("s_waitcnt lgkmcnt(0)\n\ts_barrier":::"memory");
  #undef TM
  #undef DMA_K
  #undef DMA_V
  #undef CMASK
  #undef START
  #undef RESC
  #undef ROT
}
constexpr int ATTN_LDS_BYTES=LDS_BYTES;
#undef SBAR
#undef WAIT_BAR
}
#define XB_TMO      128
#define XB_XCNT(j)  (256  + 64 * (j))
#define XB_XSUB(j)  (1280 + 64 * (j))
#define XB_XGEN(j)  (2304 + 64 * (j))
#define XB_TOP      3328
#define XB_TOPGEN   3392
#define XCD_BAR_WORDS 3456
#define XB_SPIN_CAP (1u << 21)

__device__ __forceinline__ unsigned xb_ld(unsigned* p)              { return __hip_atomic_load(p, __ATOMIC_RELAXED, __HIP_MEMORY_SCOPE_AGENT); }
__device__ __forceinline__ unsigned xb_add(unsigned* p, unsigned v) { return __hip_atomic_fetch_add(p, v, __ATOMIC_RELAXED, __HIP_MEMORY_SCOPE_AGENT); }
__device__ __forceinline__ unsigned xb_xcc_id() { return (unsigned)__builtin_amdgcn_s_getreg((3 << 11) | 20) & 0xFu; }
#define XB_SPIN(cond, bar) do { unsigned _sp = 0; while (cond) { __builtin_amdgcn_s_sleep(1); \
    if ((++_sp & 255u) == 0u) { if (xb_ld(&(bar)[XB_TMO])) break; if (_sp > XB_SPIN_CAP) { atomicAdd(&(bar)[XB_TMO], 1u); break; } } } } while (0)

struct XcdBarrier {
    unsigned* bar; unsigned x;
    volatile LAS unsigned* st;
};

__device__ __forceinline__ XcdBarrier xcd_barrier_post(unsigned* bar, volatile LAS unsigned* st) {
    XcdBarrier b; b.bar = bar; b.x = xb_xcc_id(); b.st = st;
    if (threadIdx.x == 0) (void)xb_add(&bar[XB_XCNT(b.x)], 1u);
    return b;
}
__device__ __forceinline__ void xcd_barrier_complete(unsigned* bar, unsigned x, unsigned& nloc, unsigned& nx) {
    const unsigned G = gridDim.x * gridDim.y * gridDim.z;
    unsigned sum, cnt, mine, sp = 0u;
    for (;;) {
        sum = 0u; cnt = 0u; mine = 0u;
#pragma unroll
        for (unsigned j = 0; j < 16; ++j) { const unsigned c = xb_ld(&bar[XB_XCNT(j)]); sum += c; cnt += (c > 0u) ? 1u : 0u; mine = (j == x) ? c : mine; }
        if (sum == G) break;
        __builtin_amdgcn_s_sleep(1);
        if ((++sp & 255u) == 0u) { if (xb_ld(&bar[XB_TMO])) break; if (sp > XB_SPIN_CAP) { atomicAdd(&bar[XB_TMO], 1u); break; } }
    }
    nloc = mine > 0u ? mine : 1u; nx = cnt > 0u ? cnt : 1u;
}

__device__ __forceinline__ void xcd_barrier(const XcdBarrier& b) {
    asm volatile("s_waitcnt vmcnt(0)" ::: "memory");
    __syncthreads();
    if (threadIdx.x == 0) {
        unsigned* bar = b.bar; unsigned bx_ = b.x; asm volatile("" : "+s"(bar), "+s"(bx_));
        __builtin_amdgcn_s_waitcnt(0);
        unsigned nloc = b.st[0], nx = b.st[1];
        if (nloc == 0u) { xcd_barrier_complete(bar, bx_, nloc, nx); b.st[0] = nloc; b.st[1] = nx; }
        const unsigned old = xb_add(&bar[XB_XSUB(bx_)], 1u);
        const unsigned gen = old / nloc;
        if (old + 1u == (gen + 1u) * nloc) {
            __builtin_amdgcn_fence(__ATOMIC_RELEASE, "agent");
            asm volatile("s_waitcnt vmcnt(0)" ::: "memory");
            const unsigned og = xb_add(&bar[XB_TOP], 1u);
            const unsigned tg = og / nx;
            if (og + 1u == (tg + 1u) * nx) xb_add(&bar[XB_TOPGEN], 1u);
            else XB_SPIN(xb_ld(&bar[XB_TOPGEN]) == tg, bar);
            __builtin_amdgcn_fence(__ATOMIC_ACQUIRE, "agent");
            xb_add(&bar[XB_XGEN(bx_)], 1u);
            asm volatile("s_waitcnt vmcnt(0)" ::: "memory");
        } else {
            XB_SPIN(xb_ld(&bar[XB_XGEN(bx_)]) == gen, bar);
            __builtin_amdgcn_fence(__ATOMIC_ACQUIRE, "agent");
            asm volatile("s_waitcnt vmcnt(0)" ::: "memory");
        }
    }
    __syncthreads();
}

constexpr size_t alup(size_t x) { return (x + 4095) & ~(size_t)4095; }
constexpr size_t CTL_BYTES = 1u << 20;
constexpr size_t SZ_WIN = (size_t)DEPTH * DIN * DM * 2, SZ_WOUT = (size_t)DEPTH * DM * DM * 2, SZ_WGU = (size_t)DEPTH * NE * 2 * FF * DM * 2, SZ_WDN = (size_t)DEPTH * NE * DM * FF * 2;
constexpr size_t SZ_MODP = (size_t)DEPTH * 16 * 17 * 6144 * 4, SZ_MOD = (size_t)DEPTH * 17 * 6144 * 4;
constexpr size_t SZ_X32 = (size_t)MROWS * DM * 4, SZ_H = (size_t)MROWS * DM * 2, SZ_P = (size_t)MROWS * DIN * 2, SZ_Y = (size_t)MROWS * DM * 2, SZ_YP = (size_t)MROWS * 2 * DM * 2;
constexpr size_t SZ_LIST = (size_t)NE * MROWS * 4, SZ_GW = (size_t)MROWS * 2 * 4;
constexpr int MAXBLK = (MROWS * 2) / 256 + NE;
static_assert((size_t)MAXBLK * 256 * FF * 2 <= SZ_P, "HMID overlays P");
static_assert((size_t)2 * NB * 4 * NCH * 128 * 64 * 4 <= SZ_H, "KVT overlays H");
static_assert((size_t)2 * NB * 4 * NCH * 128 * 64 * 2 <= SZ_YP, "ST overlays YP");
constexpr size_t WS_CTL = 0;
constexpr size_t WS_WIN = CTL_BYTES, WS_WOUT = WS_WIN + alup(SZ_WIN), WS_WGU = WS_WOUT + alup(SZ_WOUT), WS_WDN = WS_WGU + alup(SZ_WGU);
constexpr size_t WS_MODP = WS_WDN + alup(SZ_WDN), WS_MOD = WS_MODP + alup(SZ_MODP);
constexpr size_t WS_X32 = WS_MOD + alup(SZ_MOD), WS_H = WS_X32 + alup(SZ_X32), WS_P = WS_H + alup(SZ_H), WS_Y = WS_P + alup(SZ_P), WS_YP = WS_Y + alup(SZ_Y);
constexpr size_t WS_LIST = WS_YP + alup(SZ_YP), WS_GW = WS_LIST + alup(SZ_LIST), WS_END = WS_GW + alup(SZ_GW);
constexpr int CW_BAR = 4096;
constexpr int CW_CNT = 16384;

constexpr int RING_BYTES = 131072;
constexpr int LDSCTL_OFF = RING_BYTES;
constexpr int LDS_BYTES = 147456;

#define ATTN_STORE16(p,v) (*(u32x4*)(p)=(v))

#define CAS __attribute__((address_space(4)))
__device__ __forceinline__ const float* inp(int i) {
    const CAS unsigned char* k = (const CAS unsigned char*)__builtin_amdgcn_kernarg_segment_ptr();
    asm volatile("" : "+s"(k));
    return *(const float* const CAS*)(k + 8 * i);
}
struct Ctx {
    float* out; unsigned char* ws;
    __device__ __forceinline__ const float* x() const { return inp(0); }
    __device__ __forceinline__ const float* c() const { return inp(1); }
    __device__ __forceinline__ const float* ctx() const { return inp(2); }
    __device__ __forceinline__ const float* c_ctx() const { return inp(3); }
    __device__ __forceinline__ const float* ada_w() const { return inp(4); }
    __device__ __forceinline__ const float* ada_b() const { return inp(5); }
    __device__ __forceinline__ const float* norm1() const { return inp(6); }
    __device__ __forceinline__ const float* norm2() const { return inp(7); }
    __device__ __forceinline__ const float* w_in() const { return inp(8); }
    __device__ __forceinline__ const float* w_out() const { return inp(9); }
    __device__ __forceinline__ const float* ret_decay() const { return inp(10); }
    __device__ __forceinline__ const float* win_gain() const { return inp(11); }
    __device__ __forceinline__ const float* win_sink() const { return inp(12); }
    __device__ __forceinline__ const float* glb_gain() const { return inp(13); }
    __device__ __forceinline__ const float* w_router() const { return inp(14); }
    __device__ __forceinline__ const float* b_router() const { return inp(15); }
    __device__ __forceinline__ const float* w_gu() const { return inp(16); }
    __device__ __forceinline__ const float* w_dn() const { return inp(17); }
};

template <int CTRL> __device__ __forceinline__ float dppx(float v) { return __builtin_bit_cast(float, __builtin_amdgcn_update_dpp(0, __builtin_bit_cast(int, v), CTRL, 0xF, 0xF, true)); }
__device__ __forceinline__ float xor1(float v) { return dppx<0xB1>(v); }
__device__ __forceinline__ float xor2(float v) { return dppx<0x4E>(v); }
__device__ __forceinline__ float wave_sum(float v) {
    v += dppx<0xB1>(v); v += dppx<0x4E>(v); v += dppx<0x141>(v); v += dppx<0x140>(v);
    { const unsigned u = __builtin_bit_cast(unsigned, v); auto r = __builtin_amdgcn_permlane16_swap(u, u, false, false); v = __builtin_bit_cast(float, (unsigned)r[0]) + __builtin_bit_cast(float, (unsigned)r[1]); }
    { const unsigned u = __builtin_bit_cast(unsigned, v); auto r = __builtin_amdgcn_permlane32_swap(u, u, false, false); v = __builtin_bit_cast(float, (unsigned)r[0]) + __builtin_bit_cast(float, (unsigned)r[1]); }
    return v;
}
__device__ __forceinline__ float xor16(float v, int lane) { const unsigned u = __builtin_bit_cast(unsigned, v); auto r = __builtin_amdgcn_permlane16_swap(u, u, false, false);
    return __builtin_bit_cast(float, (lane & 16) ? (unsigned)r[0] : (unsigned)r[1]); }
__device__ __forceinline__ float silu_f(float v) { return v * __builtin_amdgcn_rcpf(1.f + __builtin_amdgcn_exp2f(-LOG2E * v)); }
__device__ __forceinline__ float log2_sigmoid(float x) { return -log1pf(expf(-x)) * LOG2E; }

__device__ __forceinline__ void transpose_item(const float* W, int N, int nsrc0, int k0, bf16_t* WT, int K, int nrow0, LAS float* scr, int lane) {
#pragma unroll 8
    for (int i = 0; i < 32; ++i) { const int kk = 2 * i + (lane >> 5); scr[kk * 33 + (lane & 31)] = W[(size_t)(k0 + kk) * N + nsrc0 + (lane & 31)]; }
    asm volatile("s_waitcnt lgkmcnt(0)" ::: "memory");
    const int c = lane & 7;
#pragma unroll
    for (int j = 0; j < 4; ++j) { const int n = (lane >> 3) + 8 * j; const LAS float* s = scr + (8 * c) * 33 + n;
        u32x4 o; o.x = pk2(s[0 * 33], s[1 * 33]); o.y = pk2(s[2 * 33], s[3 * 33]); o.z = pk2(s[4 * 33], s[5 * 33]); o.w = pk2(s[6 * 33], s[7 * 33]);
        *(u32x4*)(WT + (size_t)(nrow0 + n) * K + k0 + 8 * c) = o; }
    asm volatile("s_waitcnt lgkmcnt(0)" ::: "memory");
}
constexpr int IT_WIN = 16 * 80, IT_WOUT = 16 * 32, IT_GU = 16 * 64, IT_DN = 16 * 32, IT_LAYER = IT_WIN + IT_WOUT + NE * (IT_GU + IT_DN);
__device__ __forceinline__ void phase_prologue(const Ctx& C, LAS unsigned char* lds, int G, int vcu, int bx, int tid) {
    const int lane = tid & 63, wave = tid >> 6;
    {
        LAS float* scs = (LAS float*)lds;
        bool have = false;
        for (int it = bx; it < DEPTH * 12 * 16; it += G) {
            if (!have) {
                for (int i = tid; i < 17 * DM; i += 512) { const int r = i >> 10, k = i & 1023; const float v = r < 16 ? C.c()[r * DM + k] : C.c_ctx()[k]; scs[i] = v / (1.f + expf(-v)); }
                __syncthreads(); have = true;
            }
            const int l = it / 192, rem = it % 192, cb = rem / 16, kc = rem % 16;
            const float* w = C.ada_w() + ((size_t)l * DM + kc * 64) * 6144 + cb * 512 + tid;
            float acc[17];
#pragma unroll
            for (int r = 0; r < 17; ++r) acc[r] = 0.f;
#pragma unroll 4
            for (int kk = 0; kk < 64; ++kk) { const float wv = w[(size_t)kk * 6144];
#pragma unroll
                for (int r = 0; r < 17; ++r) acc[r] += scs[r * DM + kc * 64 + kk] * wv; }
            float* mp = (float*)(C.ws + WS_MODP) + ((size_t)(l * 16 + kc) * 17) * 6144 + cb * 512 + tid;
#pragma unroll
            for (int r = 0; r < 17; ++r) mp[(size_t)r * 6144] = acc[r];
        }
        __syncthreads();
    }
    LAS float* scr = (LAS float*)(lds + wave * 16384);
    const int gw = vcu * 8 + wave, NGW = G * 8;
    for (int it = gw; it < DEPTH * IT_LAYER; it += NGW) {
        const int l = it / IT_LAYER; int r = it % IT_LAYER;
        if (r < IT_WIN) { const int kb = r / 80, nb = r % 80;
            transpose_item(C.w_in() + (size_t)l * DM * DIN, DIN, 32 * nb, 64 * kb, (bf16_t*)(C.ws + WS_WIN) + (size_t)l * DIN * DM, DM, 32 * nb, scr, lane); continue; }
        r -= IT_WIN;
        if (r < IT_WOUT) { const int kb = r / 32, nb = r % 32;
            transpose_item(C.w_out() + (size_t)l * DM * DM, DM, 32 * nb, 64 * kb, (bf16_t*)(C.ws + WS_WOUT) + (size_t)l * DM * DM, DM, 32 * nb, scr, lane); continue; }
        r -= IT_WOUT;
        if (r < NE * IT_GU) { const int e = r / IT_GU, q = r % IT_GU, kb = q / 64, nb = q % 64;
            const int np = 32 * nb, tile = np >> 8, within = np & 255, nsrc = within < 128 ? tile * 128 + within : FF + tile * 128 + within - 128;
            transpose_item(C.w_gu() + (size_t)(l * NE + e) * DM * 2 * FF, 2 * FF, nsrc, 64 * kb, (bf16_t*)(C.ws + WS_WGU) + (size_t)(l * NE + e) * 2 * FF * DM, DM, np, scr, lane); continue; }
        r -= NE * IT_GU;
        { const int e = r / IT_DN, q = r % IT_DN, kb = q / 32, nb = q % 32;
            transpose_item(C.w_dn() + (size_t)(l * NE + e) * FF * DM, DM, 32 * nb, 64 * kb, (bf16_t*)(C.ws + WS_WDN) + (size_t)(l * NE + e) * DM * FF, FF, 32 * nb, scr, lane); }
    }
}
__device__ __forceinline__ void phase_modsum(const Ctx& C, int G, int bx, int tid) {
    const float* mp = (const float*)(C.ws + WS_MODP); float* mod = (float*)(C.ws + WS_MOD);
    for (int i = bx * 512 + tid; i < DEPTH * 17 * 6144; i += G * 512) {
        const int l = i / (17 * 6144), rem = i % (17 * 6144), r = rem / 6144, n = rem % 6144;
        float s = C.ada_b()[l * 6144 + n];
#pragma unroll
        for (int kc = 0; kc < 16; ++kc) s += mp[((size_t)(l * 16 + kc) * 17 + r) * 6144 + n];
        mod[i] = s;
    }
}

__device__ __forceinline__ void phase_norm1(const Ctx& C, int layer, int gw, int NGW, int lane) {
    const float* mod = (const float*)(C.ws + WS_MOD) + (size_t)layer * 17 * 6144;
    const float* gain = C.norm1() + layer * DM;
    float* X32 = (float*)(C.ws + WS_X32); bf16_t* H = (bf16_t*)(C.ws + WS_H); const bf16_t* YP = (const bf16_t*)(C.ws + WS_YP);
    const float* xin = C.x(); const float* cin = C.ctx();
    f32x4 nx[4]; u32x2 na[4], nb[4];
#define N1_LOAD(mm) do { const int b_ = (mm) / TPB, t_ = (mm) - b_ * TPB; \
        if (layer == 0) { const f32x4* s_ = (const f32x4*)(t_ < CTX ? cin + ((size_t)b_ * CTX + t_) * DM : xin + ((size_t)b_ * SEQ + (t_ - CTX)) * DM) + lane; \
            _Pragma("unroll") for (int j = 0; j < 4; ++j) nx[j] = s_[64 * j]; } \
        else { const f32x4* s_ = (const f32x4*)(X32 + (size_t)(mm) * DM) + lane; const u32x2* y0_ = (const u32x2*)(YP + (size_t)(mm) * 2 * DM) + lane; \
            _Pragma("unroll") for (int j = 0; j < 4; ++j) { nx[j] = s_[64 * j]; na[j] = y0_[64 * j]; nb[j] = y0_[DM / 4 + 64 * j]; } } } while (0)
    if (gw < MROWS) N1_LOAD(gw);
    for (int m = gw; m < MROWS; m += NGW) {
        const int b = m / TPB, t = m - b * TPB, set = t < CTX ? 16 : b;
        f32x4 v[4];
        if (layer == 0) {
#pragma unroll
            for (int j = 0; j < 4; ++j) v[j] = nx[j];
        } else {
            const f32x4* g2 = (const f32x4*)(mod - 17 * 6144 + (size_t)set * 6144 + 5 * DM) + lane;
#pragma unroll
            for (int j = 0; j < 4; ++j) { const u32x2 a = na[j], bb = nb[j]; const f32x4 g = g2[64 * j];
                f32x4 y; y[0] = bflo(a.x) + bflo(bb.x); y[1] = bfhi(a.x) + bfhi(bb.x); y[2] = bflo(a.y) + bflo(bb.y); y[3] = bfhi(a.y) + bfhi(bb.y);
                v[j] = nx[j] + g * y; }
        }
        if (m + NGW < MROWS) N1_LOAD(m + NGW);
        f32x4* xo = (f32x4*)(X32 + (size_t)m * DM) + lane;
        float ss = 0.f;
#pragma unroll
        for (int j = 0; j < 4; ++j) { xo[64 * j] = v[j]; ss += (v[j][0] * v[j][0] + v[j][1] * v[j][1]) + (v[j][2] * v[j][2] + v[j][3] * v[j][3]); }
        const float rstd = 1.0f / sqrtf(wave_sum(ss) * (1.f / DM) + EPS);
        const f32x4* gp = (const f32x4*)gain + lane; const f32x4* shp = (const f32x4*)(mod + (size_t)set * 6144) + lane; const f32x4* scp = shp + DM / 4;
        u32x2* ho = (u32x2*)(H + (size_t)m * DM) + lane;
#pragma unroll
        for (int j = 0; j < 4; ++j) { const f32x4 h = (v[j] * rstd) * gp[64 * j] * (scp[64 * j] + 1.0f) + shp[64 * j];
            u32x2 w; w.x = pk2(h[0], h[1]); w.y = pk2(h[2], h[3]); ho[64 * j] = w; }
    }
#undef N1_LOAD
}

__device__ __forceinline__ float swz_xor4(float v) { return __builtin_bit_cast(float, __builtin_amdgcn_ds_swizzle(__builtin_bit_cast(int, v), 0x101F)); }
__device__ __forceinline__ float swz_xor8(float v) { return __builtin_bit_cast(float, __builtin_amdgcn_ds_swizzle(__builtin_bit_cast(int, v), 0x201F)); }
__device__ __forceinline__ void phase_qkprep(const Ctx& C, int layer, int gw, int NGW, int lane, bf16_t* PO) {
    const bf16_t* P = (const bf16_t*)(C.ws + WS_P);
    const int hs = lane >> 3, j = lane & 7;
    const int col0 = (hs < 4 ? C_WQ + 64 * hs : hs < 6 ? C_WK + 64 * (hs - 4) : C_GQ + 64 * (hs - 6)) + 8 * j;
    const int col1 = (hs < 2 ? C_GQ + 128 + 64 * hs : C_GK + 64 * ((hs - 2) & 1)) + 8 * j;
    float g0[8], g1[8], inv[8];
    { const float* wg = C.win_gain() + layer * 128; const float* gg = C.glb_gain() + layer * 128;
      const float* s0p = hs < 4 ? wg : hs < 6 ? wg + 64 : gg; const float sc0 = (hs < 4 || hs >= 6) ? QSCALE : 1.f;
      const float* s1p = hs < 2 ? gg : gg + 64; const float sc1 = hs < 2 ? QSCALE : 1.f;
#pragma unroll
      for (int i = 0; i < 8; ++i) { g0[i] = s0p[8 * j + i] * sc0; g1[i] = s1p[8 * j + i] * sc1; inv[i] = exp2f(-(float)(8 * (j & 1) + i) * (13.287712379549449f / 16.0f)); } }
    const bool x2 = (j & 2) != 0, colax = (j & 4) != 0, act1 = lane < 32;
    u32x4 w0 = {0u, 0u, 0u, 0u}, w1 = {0u, 0u, 0u, 0u};
    if (gw < MROWS) { const bf16_t* row = P + (size_t)gw * DIN; w0 = *(const u32x4*)(row + col0); if (act1) w1 = *(const u32x4*)(row + col1); }
    for (int m = gw; m < MROWS; m += NGW) {
        const u32x4 c0 = w0, c1 = w1;
        if (m + NGW < MROWS) { const bf16_t* row = P + (size_t)(m + NGW) * DIN; w0 = *(const u32x4*)(row + col0); if (act1) w1 = *(const u32x4*)(row + col1); }
        const int b = m / TPB, t = m - b * TPB; const bool isx = t >= CTX; const int pos = t - CTX;
        float cs[8], sn[8];
        if (isx) { const float pv = (float)(colax ? (pos & 63) : (pos >> 6));
#pragma unroll
            for (int i = 0; i < 8; ++i) { const float ang = pv * inv[i]; cs[i] = __cosf(ang); sn[i] = x2 ? __sinf(ang) : -__sinf(ang); } }
        else {
#pragma unroll
            for (int i = 0; i < 8; ++i) { cs[i] = 1.f; sn[i] = 0.f; } }
        bf16_t* orow = PO + (size_t)m * (PO == P ? DIN : 256);
#pragma unroll
        for (int pass = 0; pass < 2; ++pass) {
            const u32x4 w = pass ? c1 : c0;
            float x[8] = {bflo(w.x), bfhi(w.x), bflo(w.y), bfhi(w.y), bflo(w.z), bfhi(w.z), bflo(w.w), bfhi(w.w)};
            float ss = 0.f;
#pragma unroll
            for (int i = 0; i < 8; ++i) ss += x[i] * x[i];
            ss += xor1(ss); ss += xor2(ss); ss += swz_xor4(ss);
            const float r = 1.0f / sqrtf(ss * (1.f / 64.f) + EPS);
            float y[8];
#pragma unroll
            for (int i = 0; i < 8; ++i) { x[i] = x[i] * r * (pass ? g1[i] : g0[i]); }
#pragma unroll
            for (int i = 0; i < 8; ++i) { const float pr = xor2(x[i]); y[i] = x[i] * cs[i] + pr * sn[i]; }
            u32x4 o; o.x = pk2(y[0], y[1]); o.y = pk2(y[2], y[3]); o.z = pk2(y[4], y[5]); o.w = pk2(y[6], y[7]);
            const int col = pass ? col1 : col0;
            if (pass == 0 || act1) *(u32x4*)(orow + (PO == P ? col : (col & 127))) = o;
        }
    }
}

__device__ __forceinline__ void stage_vt(const bf16_t* P, size_t r0, int h, LAS bf16_t* VT, int tid) {
#pragma unroll
    for (int i = 0; i < 4; ++i) { const int p = tid + 512 * i, j = p >> 4, dv0 = (p & 15) * 8;
        const u32x4 w = *(const u32x4*)(P + (r0 + j) * DIN + C_RV + h * 128 + dv0);
        VT[(dv0 + 0) * 136 + j] = (bf16_t)(w.x & 0xffffu); VT[(dv0 + 1) * 136 + j] = (bf16_t)(w.x >> 16);
        VT[(dv0 + 2) * 136 + j] = (bf16_t)(w.y & 0xffffu); VT[(dv0 + 3) * 136 + j] = (bf16_t)(w.y >> 16);
        VT[(dv0 + 4) * 136 + j] = (bf16_t)(w.z & 0xffffu); VT[(dv0 + 5) * 136 + j] = (bf16_t)(w.z >> 16);
        VT[(dv0 + 6) * 136 + j] = (bf16_t)(w.w & 0xffffu); VT[(dv0 + 7) * 136 + j] = (bf16_t)(w.w >> 16); }
}
__device__ __forceinline__ void ret_r1_unit(const Ctx& C, int layer, int b, int h, int c, LAS unsigned char* lds, int tid) {
    const int lane = tid & 63, wid = tid >> 6;
    const bf16_t* P = (const bf16_t*)(C.ws + WS_P); float* KVT = (float*)(C.ws + WS_H);
    LAS bf16_t* KzfT = (LAS bf16_t*)lds; LAS bf16_t* KzbT = KzfT + 64 * 136; LAS bf16_t* VT = KzbT + 64 * 136;
    const float lf = log2_sigmoid(C.ret_decay()[(layer * 2 + 0) * 4 + h]), lb = log2_sigmoid(C.ret_decay()[(layer * 2 + 1) * 4 + h]);
    const size_t r0 = (size_t)b * TPB + c * 128;
#pragma unroll
    for (int i = 0; i < 2; ++i) { const int p = tid + 512 * i, j = p >> 3, dk0 = (p & 7) * 8;
        const u32x4 w = *(const u32x4*)(P + (r0 + j) * DIN + C_RK + h * 64 + dk0);
        const float zf = exp2f((float)(127 - j) * lf) * 0.125f, zb = exp2f((float)j * lb) * 0.125f;
        const float x[8] = {bflo(w.x), bfhi(w.x), bflo(w.y), bfhi(w.y), bflo(w.z), bfhi(w.z), bflo(w.w), bfhi(w.w)};
#pragma unroll
        for (int e = 0; e < 8; ++e) { KzfT[(dk0 + e) * 136 + j] = (bf16_t)f2bf(x[e] * zf); KzbT[(dk0 + e) * 136 + j] = (bf16_t)f2bf(x[e] * zb); } }
    stage_vt(P, r0, h, VT, tid);
    __syncthreads();
    const int mb = wid >> 1, nb = wid & 1, r = lane & 31, hh = lane >> 5;
    float z0 = 0.f; asm volatile("" : "+v"(z0)); f32x16 af, ab;
#pragma unroll
    for (int i = 0; i < 16; ++i) { af[i] = z0; ab[i] = z0; }
#pragma unroll
    for (int ks = 0; ks < 8; ++ks) {
        const bf16x8 a = *(const LAS bf16x8*)(VT + (32 * mb + r) * 136 + 16 * ks + 8 * hh);
        const bf16x8 bf = *(const LAS bf16x8*)(KzfT + (32 * nb + r) * 136 + 16 * ks + 8 * hh);
        const bf16x8 bb = *(const LAS bf16x8*)(KzbT + (32 * nb + r) * 136 + 16 * ks + 8 * hh);
        af = __builtin_amdgcn_mfma_f32_32x32x16_bf16(a, bf, af, 0, 0, 0);
        ab = __builtin_amdgcn_mfma_f32_32x32x16_bf16(a, bb, ab, 0, 0, 0);
    }
    float* of = KVT + ((size_t)((0 * NB + b) * 4 + h) * NCH + c) * 8192; float* ob = KVT + ((size_t)((1 * NB + b) * 4 + h) * NCH + c) * 8192;
#pragma unroll
    for (int reg = 0; reg < 16; ++reg) { const int dv = 32 * mb + (reg & 3) + 8 * (reg >> 2) + 4 * hh, dk = 32 * nb + r; of[dv * 64 + dk] = af[reg]; ob[dv * 64 + dk] = ab[reg]; }
    __syncthreads();
}
__device__ __forceinline__ void ret_r2_unit(const Ctx& C, int layer, int u, int tid) {
    const int q = u & 3, bh = (u >> 2) & 63, dir = u >> 8, b = bh >> 2, h = bh & 3;
    const float G = exp2f(128.f * log2_sigmoid(C.ret_decay()[(layer * 2 + dir) * 4 + h]));
    const size_t base = ((size_t)((dir * NB + b) * 4 + h) * NCH) * 8192 + q * 2048 + tid * 4;
    const float* KVT = (const float*)(C.ws + WS_H) + base; bf16_t* ST = (bf16_t*)(C.ws + WS_YP) + base;
    float z0 = 0.f; asm volatile("" : "+v"(z0)); f32x4 S = {z0, z0, z0, z0};
#pragma unroll
    for (int half = 0; half < 2; ++half) {
        f32x4 kv[17];
#pragma unroll
        for (int s = 0; s < 17; ++s) { const int step = half * 17 + s; const int c = dir == 0 ? step : (step < 2 ? 1 - step : 35 - step); kv[s] = *(const f32x4*)(KVT + (size_t)c * 8192); }
#pragma unroll
        for (int s = 0; s < 17; ++s) { const int step = half * 17 + s; const int c = dir == 0 ? step : (step < 2 ? 1 - step : 35 - step);
            u32x2 w; w.x = pk2(S[0], S[1]); w.y = pk2(S[2], S[3]); *(u32x2*)(ST + (size_t)c * 8192) = w;
            S = S * G + kv[s]; }
    }
}
#define CBAR() do { asm volatile("" ::: "memory"); __builtin_amdgcn_sched_barrier(0); } while (0)
__device__ __forceinline__ void ret_r3_unit(const Ctx& C, int layer, int b, int h, int c, LAS unsigned char* lds, int tid) {
    const int lane = tid & 63, wid = tid >> 6, r = lane & 31, hh = lane >> 5, wr = wid >> 1, wc = wid & 1;
    const bf16_t* P = (const bf16_t*)(C.ws + WS_P);
    LAS float* tab = (LAS float*)lds;
    LAS bf16_t* VT = (LAS bf16_t*)(lds + 2048); LAS bf16_t* Pl = VT + 128 * 136;
    LAS float* Ol = (LAS float*)(lds + 2048);
    const size_t r0 = (size_t)b * TPB + c * 128;
    if (tid < 128) { const float* dec = C.ret_decay(); const float lf = log2_sigmoid(dec[(layer * 2 + 0) * 4 + h]), lb = log2_sigmoid(dec[(layer * 2 + 1) * 4 + h]);
        tab[tid] = exp2f((float)tid * lf) * 0.125f; tab[128 + tid] = exp2f((float)tid * lb) * 0.125f; tab[256 + tid] = exp2f((float)(tid + 1) * lf); tab[384 + tid] = exp2f((float)(128 - tid) * lb); }
    stage_vt(P, r0, h, VT, tid);
    CBAR();
    bf16x8 qf[4];
    { const bf16_t* Qp = P + (r0 + 32 * wr + r) * DIN + C_RQ + h * 64 + 8 * hh;
#pragma unroll
      for (int ks = 0; ks < 4; ++ks) qf[ks] = *(const bf16x8*)(Qp + 16 * ks); }
    float z0 = 0.f; asm volatile("" : "+v"(z0)); f32x16 zv;
#pragma unroll
    for (int i = 0; i < 16; ++i) zv[i] = z0;
    f32x16 acc[2];
    { const bf16_t* Kp = P + (r0 + 64 * wc + r) * DIN + C_RK + h * 64 + 8 * hh;
#pragma unroll
      for (int t = 0; t < 2; ++t) { acc[t] = zv;
#pragma unroll
        for (int ks = 0; ks < 4; ++ks) acc[t] = __builtin_amdgcn_mfma_f32_32x32x16_bf16(qf[ks], *(const bf16x8*)(Kp + (size_t)t * 32 * DIN + 16 * ks), acc[t], 0, 0, 0); } }
    __syncthreads();
#pragma unroll
    for (int t = 0; t < 2; ++t)
#pragma unroll
        for (int reg = 0; reg < 16; ++reg) { const int i = 32 * wr + (reg & 3) + 8 * (reg >> 2) + 4 * hh, j = 64 * wc + 32 * t + r, d = i - j;
            const float D = d > 0 ? tab[d] : (d < 0 ? tab[128 - d] : tab[0] + tab[128]);
            Pl[i * 136 + j] = (bf16_t)f2bf(acc[t][reg] * D); }
    __syncthreads();
    f32x16 o1[2];
    o1[0] = zv; o1[1] = zv;
#pragma unroll
    for (int ks = 0; ks < 8; ++ks) { const bf16x8 a = *(const LAS bf16x8*)(Pl + (32 * wr + r) * 136 + 16 * ks + 8 * hh);
#pragma unroll
        for (int t = 0; t < 2; ++t) o1[t] = __builtin_amdgcn_mfma_f32_32x32x16_bf16(a, *(const LAS bf16x8*)(VT + (64 * wc + 32 * t + r) * 136 + 16 * ks + 8 * hh), o1[t], 0, 0, 0); }
    CBAR();
#pragma unroll
    for (int dir = 0; dir < 2; ++dir) {
        const bf16_t* sp = (const bf16_t*)(C.ws + WS_YP) + ((size_t)((dir * NB + b) * 4 + h) * NCH + c) * 8192 + (64 * wc + r) * 64 + 8 * hh;
#pragma unroll
        for (int t = 0; t < 2; ++t) { acc[t] = zv;
#pragma unroll
            for (int ks = 0; ks < 4; ++ks) acc[t] = __builtin_amdgcn_mfma_f32_32x32x16_bf16(qf[ks], *(const bf16x8*)(sp + t * 32 * 64 + 16 * ks), acc[t], 0, 0, 0); }
#pragma unroll
        for (int t = 0; t < 2; ++t)
#pragma unroll
            for (int reg = 0; reg < 16; ++reg) { const int i = 32 * wr + (reg & 3) + 8 * (reg >> 2) + 4 * hh; o1[t][reg] += tab[256 + 128 * dir + i] * acc[t][reg]; }
        CBAR();
    }
    __syncthreads();
#pragma unroll
    for (int t = 0; t < 2; ++t)
#pragma unroll
        for (int reg = 0; reg < 16; ++reg) { const int i = 32 * wr + (reg & 3) + 8 * (reg >> 2) + 4 * hh, dv = 64 * wc + 32 * t + r; Ol[i * 132 + dv] = o1[t][reg]; }
    __syncthreads();
    { const int row = tid >> 2, q = tid & 3; f32x4 x[8]; float sm = 0.f;
#pragma unroll
      for (int e = 0; e < 8; ++e) { x[e] = *(const LAS f32x4*)(Ol + row * 132 + 32 * q + 4 * e); sm += (x[e][0] + x[e][1]) + (x[e][2] + x[e][3]); }
      sm += xor1(sm); sm += xor2(sm);
      const float mu = sm * (1.f / 128.f); float vs = 0.f;
#pragma unroll
      for (int e = 0; e < 8; ++e) { x[e] = x[e] - mu; vs += (x[e][0] * x[e][0] + x[e][1] * x[e][1]) + (x[e][2] * x[e][2] + x[e][3] * x[e][3]); }
      vs += xor1(vs); vs += xor2(vs);
      const float rstd = 1.0f / sqrtf(vs * (1.f / 128.f) + EPS);
      const bf16_t* gp = P + (r0 + row) * DIN + C_RG + h * 128 + 32 * q; bf16_t* yp = (bf16_t*)(C.ws + WS_Y) + (r0 + row) * DM + h * 128 + 32 * q;
#pragma unroll
      for (int e2 = 0; e2 < 4; ++e2) { const u32x4 gw = *(const u32x4*)(gp + 8 * e2); const f32x4 a = x[2 * e2] * rstd, bq = x[2 * e2 + 1] * rstd;
          u32x4 o; o.x = pk2(a[0] * silu_f(bflo(gw.x)), a[1] * silu_f(bfhi(gw.x))); o.y = pk2(a[2] * silu_f(bflo(gw.y)), a[3] * silu_f(bfhi(gw.y)));
          o.z = pk2(bq[0] * silu_f(bflo(gw.z)), bq[1] * silu_f(bfhi(gw.z))); o.w = pk2(bq[2] * silu_f(bflo(gw.w)), bq[3] * silu_f(bfhi(gw.w)));
          *(u32x4*)(yp + 8 * e2) = o; } }
    __syncthreads();
}

template <bool WIN>
__device__ __forceinline__ void attn_dispatch(const Ctx& C, int layer, int U, int tid, char* lds) {
    using attn_body::bf16;
    int b, h, q0, NT, tdelta;
    if (U < 1024) { b = U >> 6; h = ((U >> 5) & 1) * 2 + ((U >> 4) & 1); q0 = CTX + 256 * (U & 15);
        if (WIN) { const int ts = (q0 / 64 - 2) > 4 ? (q0 / 64 - 2) : 4, te = (q0 / 64 + 6) < 68 ? (q0 / 64 + 6) : 68; NT = 4 + te - ts; tdelta = ts - 4; } else { NT = 68; tdelta = 0; } }
    else { b = (U - 1024) >> 2; h = (U - 1024) & 3; q0 = 0; NT = 4; tdelta = 0; }
    const int kvh = h >> 1;
    const bf16* Pb = (const bf16*)(C.ws + WS_P) + (size_t)b * TPB * DIN; bf16* Yb = (bf16*)(C.ws + WS_Y) + (size_t)b * TPB * DM;
    if (WIN) attn_body::attn_unit<8, true>(Pb + C_WQ + 64 * h, Pb + C_WK + 64 * kvh, Pb + C_WV + 64 * kvh, Yb + 512 + 64 * h, q0, NT, tdelta, C.win_sink()[layer * 4 + h] * LOG2E, tid, lds);
    else     attn_body::attn_unit<8, false>(Pb + C_GQ + 64 * h, Pb + C_GK + 64 * kvh, Pb + C_GV + 64 * kvh, Yb + 768 + 64 * h, q0, NT, tdelta, 0.f, tid, lds);
}
template <bool WIN>
__device__ __forceinline__ void attn_units(const Ctx& C, int layer, int G, int vcu, int bx, int tid, char* lds) {
    const int nctx = (layer == DEPTH - 1) ? 0 : 64;
    if (G == 256) {
        for (int k = 0; k < 4; ++k) attn_dispatch<WIN>(C, layer, vcu * 4 + k, tid, lds);
        if (vcu < nctx) attn_dispatch<WIN>(C, layer, 1024 + vcu, tid, lds);
    } else {
        for (int U = bx; U < 1024 + nctx; U += G) attn_dispatch<WIN>(C, layer, U, tid, lds);
    }
}

__device__ __forceinline__ f32x2 swap32(float a, float b) { auto r = __builtin_amdgcn_permlane32_swap(__builtin_bit_cast(unsigned, a), __builtin_bit_cast(unsigned, b), false, false);
    return (f32x2){__builtin_bit_cast(float, (unsigned)r[0]), __builtin_bit_cast(float, (unsigned)r[1])}; }
__device__ __forceinline__ f32x2 swap16(float a, float b) { auto r = __builtin_amdgcn_permlane16_swap(__builtin_bit_cast(unsigned, a), __builtin_bit_cast(unsigned, b), false, false);
    return (f32x2){__builtin_bit_cast(float, (unsigned)r[0]), __builtin_bit_cast(float, (unsigned)r[1])}; }
__device__ __forceinline__ void phase_norm2_route(const Ctx& C, int layer_c, LAS unsigned char* lds, int G, int bx, int tid) {
    const int layer = layer_c & 3;
    const int lane = tid & 63, wave = tid >> 6;
    const float* mod = (const float*)(C.ws + WS_MOD) + (size_t)layer * 17 * 6144;
    const float* gain = C.norm2() + layer * DM;
    const float* X32 = (const float*)(C.ws + WS_X32); bf16_t* H = (bf16_t*)(C.ws + WS_H);
    int* list = (int*)(C.ws + WS_LIST); float* GW = (float*)(C.ws + WS_GW);
    unsigned* gcnt = (unsigned*)(C.ws + WS_CTL) + CW_CNT + 64 * layer_c;
    constexpr int RPC = MROWS / 256, RPW = RPC / 8;
    LAS float* wrT = (LAS float*)lds;
    LAS float* lgs = (LAS float*)(lds + 65536);
    LAS int* lcnt = (LAS int*)(lds + 65536 + RPC * 64);
    LAS int* lbase = lcnt + 16;
    LAS int* rec_e = lcnt + 32;
    LAS float* rec_w = (LAS float*)(rec_e + 2 * RPC);
    { const float* wr = C.w_router(); for (int i = tid; i < DM * NE; i += 512) { const int k = i >> 4, e = i & 15; wrT[e * DM + k] = wr[i]; } }
    if (tid < 16) lcnt[tid] = 0;
    __syncthreads();
    const bool b5 = (lane & 32) != 0, b4 = (lane & 16) != 0, b3 = (lane & 8) != 0, b2 = (lane & 4) != 0; (void)b5; (void)b4;
    for (int chunk = bx; chunk < 256; chunk += G) {
        const int m0 = chunk * RPC + wave * RPW;
        f32x4 nx[4];
        { const f32x4* xr = (const f32x4*)(X32 + (size_t)m0 * DM) + lane;
#pragma unroll
          for (int j = 0; j < 4; ++j) nx[j] = xr[64 * j]; }
        for (int i = 0; i < RPW; ++i) {
            const int m = m0 + i;
            const int b = m / TPB, t = m - b * TPB, set = t < CTX ? 16 : b;
            f32x4 v[4]; float ss = 0.f;
#pragma unroll
            for (int j = 0; j < 4; ++j) { v[j] = nx[j]; ss += (v[j][0] * v[j][0] + v[j][1] * v[j][1]) + (v[j][2] * v[j][2] + v[j][3] * v[j][3]); }
            if (i + 1 < RPW) { const f32x4* xr = (const f32x4*)(X32 + (size_t)(m + 1) * DM) + lane;
#pragma unroll
                for (int j = 0; j < 4; ++j) nx[j] = xr[64 * j]; }
            const float rstd = 1.0f / sqrtf(wave_sum(ss) * (1.f / DM) + EPS);
            const f32x4* gp = (const f32x4*)gain + lane; const f32x4* shp = (const f32x4*)(mod + (size_t)set * 6144 + 3 * DM) + lane; const f32x4* scp = shp + DM / 4;
            u32x2* ho = (u32x2*)(H + (size_t)m * DM) + lane;
#pragma unroll
            for (int j = 0; j < 4; ++j) { v[j] = (v[j] * rstd) * gp[64 * j] * (scp[64 * j] + 1.0f) + shp[64 * j];
                u32x2 w; w.x = pk2(v[j][0], v[j][1]); w.y = pk2(v[j][2], v[j][3]); ho[64 * j] = w; }
            float pe[16];
#pragma unroll
            for (int e = 0; e < 16; ++e) { float a = 0.f;
#pragma unroll
                for (int j = 0; j < 4; ++j) { const f32x4 w = *(const LAS f32x4*)(wrT + e * DM + 4 * lane + 256 * j); a += (v[j][0] * w[0] + v[j][1] * w[1]) + (v[j][2] * w[2] + v[j][3] * w[3]); }
                pe[e] = a; }
            float q8[8], q4[4], q2[2];
#pragma unroll
            for (int e = 0; e < 8; ++e) { const f32x2 r = swap32(pe[e], pe[e + 8]); q8[e] = r[0] + r[1]; }
#pragma unroll
            for (int e = 0; e < 4; ++e) { const f32x2 r = swap16(q8[e], q8[e + 4]); q4[e] = r[0] + r[1]; }
#pragma unroll
            for (int e = 0; e < 2; ++e) { const float keep = b3 ? q4[e + 2] : q4[e], send = b3 ? q4[e] : q4[e + 2]; q2[e] = keep + swz_xor8(send); }
            float lg = (b2 ? q2[1] : q2[0]) + swz_xor4(b2 ? q2[0] : q2[1]);
            lg += xor2(lg); lg += xor1(lg);
            if ((lane & 3) == 0) lgs[(wave * RPW + i) * 16 + (lane >> 2)] = lg;
        }
        asm volatile("s_waitcnt lgkmcnt(0)" ::: "memory");
        if (lane < RPW) {
            const int rl = wave * RPW + lane; const float* br = C.b_router();
            float sg[16], bs[16];
#pragma unroll
            for (int e4 = 0; e4 < 4; ++e4) { const f32x4 l4 = *(const LAS f32x4*)(lgs + rl * 16 + 4 * e4);
#pragma unroll
                for (int k = 0; k < 4; ++k) { sg[4 * e4 + k] = 1.f / (1.f + expf(-l4[k])); bs[4 * e4 + k] = sg[4 * e4 + k] + br[4 * e4 + k]; } }
            int grp = 0; float best = -1e30f;
#pragma unroll
            for (int g = 0; g < 4; ++g) { const float a0 = bs[4 * g], a1 = bs[4 * g + 1], a2 = bs[4 * g + 2], a3 = bs[4 * g + 3];
                const float hi01 = fmaxf(a0, a1), lo01 = fminf(a0, a1), hi23 = fmaxf(a2, a3), lo23 = fminf(a2, a3);
                const float top = fmaxf(hi01, hi23), second = fmaxf(fminf(hi01, hi23), hi01 >= hi23 ? lo01 : lo23);
                const float sc = top + second; if (sc > best) { best = sc; grp = g; } }
            float c4[4], s4[4];
#pragma unroll
            for (int k = 0; k < 4; ++k) { c4[k] = grp == 0 ? bs[k] : grp == 1 ? bs[4 + k] : grp == 2 ? bs[8 + k] : bs[12 + k]; s4[k] = grp == 0 ? sg[k] : grp == 1 ? sg[4 + k] : grp == 2 ? sg[8 + k] : sg[12 + k]; }
            int l0 = 0; float mx0 = c4[0];
#pragma unroll
            for (int k = 1; k < 4; ++k) if (c4[k] > mx0) { mx0 = c4[k]; l0 = k; }
            int l1 = -1; float mx1 = -1e30f;
#pragma unroll
            for (int k = 0; k < 4; ++k) if (k != l0 && c4[k] > mx1) { mx1 = c4[k]; l1 = k; }
            const float w0 = l0 == 0 ? s4[0] : l0 == 1 ? s4[1] : l0 == 2 ? s4[2] : s4[3], w1 = l1 == 0 ? s4[0] : l1 == 1 ? s4[1] : l1 == 2 ? s4[2] : s4[3];
            const float wn = 1.f / (w0 + w1);
            const int e0 = grp * 4 + l0, e1 = grp * 4 + l1;
            const int p0 = __hip_atomic_fetch_add(lcnt + e0, 1, __ATOMIC_RELAXED, __HIP_MEMORY_SCOPE_WORKGROUP);
            const int p1 = __hip_atomic_fetch_add(lcnt + e1, 1, __ATOMIC_RELAXED, __HIP_MEMORY_SCOPE_WORKGROUP);
            rec_e[2 * rl] = e0 | (p0 << 8); rec_e[2 * rl + 1] = e1 | (p1 << 8); rec_w[2 * rl] = w0 * wn; rec_w[2 * rl + 1] = w1 * wn;
        }
        __syncthreads();
        if (tid < 16) lbase[tid] = (int)__hip_atomic_fetch_add(gcnt + tid, (unsigned)lcnt[tid], __ATOMIC_RELAXED, __HIP_MEMORY_SCOPE_AGENT);
        __syncthreads();
        for (int i = tid; i < 2 * RPC; i += 512) { const int re = rec_e[i], e = re & 255, pp = re >> 8; const int id = (chunk * RPC + (i >> 1)) * 2 + (i & 1);
            list[e * MROWS + lbase[e] + pp] = id; GW[id] = rec_w[i]; }
        __syncthreads();
        if (tid < 16) lcnt[tid] = 0;
        __syncthreads();
    }
}

template <bool GATHER_, int NT>
struct MoeOrder {
    static constexpr bool GATHER = GATHER_;
    const int* list; const LAS int* boff; const LAS int* cnt; int G, c;
    __device__ __forceinline__ bool next(int i, pg8::Unit& u) const {
        const int L = i * G + c; if (L >= boff[16] * NT) return false;
        const int blk = L / NT, pn = L - blk * NT; int e = 0;
#pragma unroll
        for (int k = 1; k < 16; ++k) e += (blk >= boff[k]) ? 1 : 0;
        u.pm = blk; u.pn = e * NT + pn; return true;
    }
    __device__ __forceinline__ unsigned arow(const pg8::Unit& u, int r) const {
        const int e = u.pn / NT, li = (u.pm - boff[e]) * 256 + r;
        const int id = li < cnt[e] ? list[e * MROWS + li] : 0;
        return (unsigned)(id >> 1);
    }
};
struct EpiGateUp {
    static constexpr bool PERM = true;
    bf16_t* O;
    __device__ __forceinline__ void operator()(const f32x4 (&acc)[2][2][4][2], const pg8::Unit& u, int wr, int wc, int fr, int fq) const {
        const int row0 = u.pm * 256 + wr * 64 + fr, col0 = (u.pn & 7) * 128 + wc * 32 + 8 * fq;
#pragma unroll
        for (int ai = 0; ai < 2; ++ai)
#pragma unroll
            for (int m = 0; m < 4; ++m) { const f32x4 a0 = acc[ai][0][m][0], a1 = acc[ai][0][m][1], u0 = acc[ai][1][m][0], u1 = acc[ai][1][m][1];
                u32x4 w; w.x = pk2(silu_f(a0[0]) * u0[0], silu_f(a0[1]) * u0[1]); w.y = pk2(silu_f(a0[2]) * u0[2], silu_f(a0[3]) * u0[3]);
                w.z = pk2(silu_f(a1[0]) * u1[0], silu_f(a1[1]) * u1[1]); w.w = pk2(silu_f(a1[2]) * u1[2], silu_f(a1[3]) * u1[3]);
                *(u32x4*)((char*)O + ((unsigned)(row0 + ai * 128 + m * 16) * (unsigned)FF + (unsigned)col0) * 2u) = w; }
    }
};
struct EpiDown {
    static constexpr bool PERM = true;
    bf16_t* YP; const float* GW; const int* list; const LAS int* boff; const LAS int* cnt;
    __device__ __forceinline__ void operator()(const f32x4 (&acc)[2][2][4][2], const pg8::Unit& u, int wr, int wc, int fr, int fq) const {
        const int e = u.pn >> 2, lb = (u.pm - boff[e]) * 256, n = cnt[e]; const int col0 = (u.pn & 3) * 256 + wc * 32 + 8 * fq;
#pragma unroll
        for (int ai = 0; ai < 2; ++ai)
#pragma unroll
            for (int m = 0; m < 4; ++m) { const int li = lb + ai * 128 + wr * 64 + m * 16 + fr;
                if (li < n) { const int id = list[e * MROWS + li]; const float g = GW[id]; const unsigned off = ((unsigned)id * (unsigned)DM + (unsigned)col0) * 2u;
#pragma unroll
                    for (int bj = 0; bj < 2; ++bj) { const f32x4 v0 = acc[ai][bj][m][0] * g, v1 = acc[ai][bj][m][1] * g;
                        u32x4 w; w.x = pk2(v0[0], v0[1]); w.y = pk2(v0[2], v0[3]); w.z = pk2(v1[0], v1[1]); w.w = pk2(v1[2], v1[3]); *(u32x4*)((char*)YP + off + bj * 256) = w; } } }
    }
};
__device__ __forceinline__ void moe_offsets(const Ctx& C, int layer, LAS int* boff, LAS int* cnt, int tid) {
    if (tid == 0) { const unsigned* gcnt = (const unsigned*)(C.ws + WS_CTL) + CW_CNT + 64 * layer; int acc = 0;
        for (int e = 0; e < 16; ++e) { const int n = (int)__hip_atomic_load(gcnt + e, __ATOMIC_RELAXED, __HIP_MEMORY_SCOPE_AGENT); cnt[e] = n; boff[e] = acc; acc += (n + 255) >> 8; }
        boff[16] = acc; }
    __syncthreads();
}

__device__ __forceinline__ void phase_final(const Ctx& C, int gw, int NGW, int lane) {
    const float* mod = (const float*)(C.ws + WS_MOD) + (size_t)(DEPTH - 1) * 17 * 6144;
    const float* X32 = (const float*)(C.ws + WS_X32); const bf16_t* YP = (const bf16_t*)(C.ws + WS_YP);
    for (int r = gw; r < NB * SEQ; r += NGW) {
        const int b = r / SEQ, t = r - b * SEQ; const size_t m = (size_t)b * TPB + CTX + t;
        const f32x4* xr = (const f32x4*)(X32 + m * DM) + lane; const u32x2* y0 = (const u32x2*)(YP + m * 2 * DM) + lane; const u32x2* y1 = y0 + DM / 4;
        const f32x4* g2 = (const f32x4*)(mod + (size_t)b * 6144 + 5 * DM) + lane; f32x4* o = (f32x4*)(C.out + (size_t)r * DM) + lane;
#pragma unroll
        for (int j = 0; j < 4; ++j) { const u32x2 a = y0[64 * j], bb = y1[64 * j]; const f32x4 g = g2[64 * j];
            f32x4 y; y[0] = bflo(a.x) + bflo(bb.x); y[1] = bfhi(a.x) + bfhi(bb.x); y[2] = bflo(a.y) + bflo(bb.y); y[3] = bfhi(a.y) + bfhi(bb.y);
            o[64 * j] = xr[64 * j] + g * y; }
    }
}

#ifndef PHMASK
#define PHMASK 0xFFFF
#endif
#ifndef MK_ONE_LAUNCH
#define MK_ONE_LAUNCH 1
#endif
constexpr int PH_PER_LAYER = 9, PH_LAYER0 = 2, PH_FINAL = PH_LAYER0 + DEPTH * PH_PER_LAYER, PH_COUNT = PH_FINAL + 1;
struct Args { const float* in[18]; float* out; unsigned char* ws; int ph_lo, ph_hi, flags, pad; };
__global__ void __launch_bounds__(512, 2) mega_fwd(Args args) {
    extern __shared__ __attribute__((aligned(16))) unsigned char lds_raw[];
    LAS unsigned char* lds = (LAS unsigned char*)lds_raw;
    Ctx C; C.out = args.out; C.ws = args.ws;
    const int tid = threadIdx.x, lane = tid & 63, wave = __builtin_amdgcn_readfirstlane(tid >> 6);
    const int G = gridDim.x; const int bx = blockIdx.x; const int vcu = (G % 8 == 0) ? (bx % 8) * (G / 8) + bx / 8 : bx;
    const int gw = vcu * 8 + wave, NGW = G * 8;
    volatile LAS unsigned* MISC = (volatile LAS unsigned*)(lds + LDSCTL_OFF);
    for (int u = tid; u < (LDS_BYTES - LDSCTL_OFF) / 4; u += 512) ((LAS unsigned*)(lds + LDSCTL_OFF))[u] = 0u;
    __syncthreads();
    const int lo = args.ph_lo, hi = args.ph_hi;
    XcdBarrier bar; bar.bar = (unsigned*)(C.ws + WS_CTL) + CW_BAR; bar.x = 0; bar.st = nullptr;
    if (hi - lo > 1) bar = xcd_barrier_post((unsigned*)(C.ws + WS_CTL) + CW_BAR, MISC);
#define IN(k) (lo <= (k) && (k) < hi)
#define PHASE_IDS() int bx_ = bx, wave_ = wave; LAS unsigned char* lds_ = lds; asm volatile("" : "+s"(bx_), "+s"(wave_), "+s"(lds_)); int lane_; asm volatile("v_mbcnt_lo_u32_b32 %0, -1, 0\n\tv_mbcnt_hi_u32_b32 %0, -1, %0" : "=v"(lane_)); const int tid_ = wave_ * 64 + lane_; \
    const int vcu_ = (G % 8 == 0) ? (bx_ % 8) * (G / 8) + bx_ / 8 : bx_; const int gw_ = vcu_ * 8 + wave_; (void)lane_; (void)gw_; (void)vcu_
#define SEAM(k) do { if (IN(k) && IN((k) + 1)) xcd_barrier(bar); } while (0)

    if (IN(0) && (PHMASK & 1)) { PHASE_IDS(); phase_prologue(C, lds_, G, vcu_, bx_, tid_); } SEAM(0);
    if (IN(1) && (PHMASK & 2)) { PHASE_IDS(); phase_modsum(C, G, bx_, tid_); } SEAM(1);

#ifdef LAYER_UNROLL
#pragma unroll
#else
#pragma nounroll
#endif
    for (int layer = 0; layer < DEPTH; ++layer) {
        const int p0 = PH_LAYER0 + layer * PH_PER_LAYER;
        if (IN(p0 + 0) && (PHMASK & 4)) { PHASE_IDS(); phase_norm1(C, layer, gw_, NGW, lane_); } SEAM(p0 + 0);
        if (IN(p0 + 1) && (PHMASK & 8)) {
            pg8::Gemm g{(const bf16_t*)(C.ws + WS_H), (const bf16_t*)(C.ws + WS_WIN) + (size_t)layer * DIN * DM, MROWS, DIN, DM};
            PHASE_IDS(); pg8::StaticOrder S; S.init(MROWS, DIN, G, bx_);
            pg8::EpiBf16 E{(bf16_t*)(C.ws + WS_P), DIN};
            pg8::gemm_phase<pg8::EpiBf16, pg8::StaticOrder, true>(lds_, g, S, E, tid_);
        } SEAM(p0 + 1);
        if (IN(p0 + 2) && (PHMASK & 16)) {
            PHASE_IDS(); if (!(args.flags & 1)) phase_qkprep(C, layer, gw_, NGW, lane_, (args.flags & 8) ? (bf16_t*)(C.ws + WS_Y) : (bf16_t*)(C.ws + WS_P));
            if (!(args.flags & 8)) for (int u = bx_; u < NB * 4 * NCH; u += G) { const int c = u % NCH, bh = u / NCH; ret_r1_unit(C, layer, bh >> 2, bh & 3, c, lds_, tid_); }
        } SEAM(p0 + 2);
        if (IN(p0 + 3) && (PHMASK & 32)) {
            PHASE_IDS(); for (int u = bx_; u < 512; u += G) ret_r2_unit(C, layer, u, tid_);
            attn_units<false>(C, layer, G, vcu_, bx_, tid_, (char*)lds_);
        } SEAM(p0 + 3);
        if (IN(p0 + 4) && (PHMASK & 64)) {
            PHASE_IDS();
#ifndef NO_WIN
            attn_units<true>(C, layer, G, vcu_, bx_, tid_, (char*)lds_);
#endif
#ifndef NO_R3
            for (int u = bx_; u < NB * 4 * NCH; u += G) { const int c = u % NCH, bh = u / NCH; ret_r3_unit(C, layer, bh >> 2, bh & 3, c, lds_, tid_); }
#endif
        } SEAM(p0 + 4);
        if (IN(p0 + 5) && (PHMASK & 128)) {
            pg8::Gemm g{(const bf16_t*)(C.ws + WS_Y), (const bf16_t*)(C.ws + WS_WOUT) + (size_t)layer * DM * DM, MROWS, DM, DM};
            PHASE_IDS(); pg8::StaticOrder S; S.init(MROWS, DM, G, bx_);
            pg8::EpiResid E{(float*)(C.ws + ((args.flags & 4) ? WS_P : WS_X32)), (const float*)(C.ws + WS_MOD) + (size_t)layer * 17 * 6144 + 2 * DM};
            pg8::gemm_phase<pg8::EpiResid, pg8::StaticOrder, true>(lds_, g, S, E, tid_);
        } SEAM(p0 + 5);
        if (IN(p0 + 6) && (PHMASK & 256)) { PHASE_IDS(); phase_norm2_route(C, layer + ((args.flags & 2) ? 4 : 0), lds_, G, bx_, tid_); } SEAM(p0 + 6);
        if (IN(p0 + 7) && (PHMASK & 512)) {
            PHASE_IDS(); LAS int* boff = (LAS int*)(lds_ + LDSCTL_OFF + 64); LAS int* mcnt = (LAS int*)(lds_ + LDSCTL_OFF + 192); moe_offsets(C, layer, boff, mcnt, tid_);
            pg8::Gemm g{(const bf16_t*)(C.ws + WS_H), (const bf16_t*)(C.ws + WS_WGU) + (size_t)layer * NE * 2 * FF * DM, 0, 2 * FF, DM};
            MoeOrder<true, 8> S{(const int*)(C.ws + WS_LIST), boff, mcnt, G, bx_};
            EpiGateUp E{(bf16_t*)(C.ws + WS_P)};
            pg8::gemm_phase<EpiGateUp, MoeOrder<true, 8>, true>(lds_, g, S, E, tid_);
        } SEAM(p0 + 7);
        if (IN(p0 + 8) && (PHMASK & 1024)) {
            PHASE_IDS(); LAS int* boff = (LAS int*)(lds_ + LDSCTL_OFF + 64); LAS int* mcnt = (LAS int*)(lds_ + LDSCTL_OFF + 192); moe_offsets(C, layer, boff, mcnt, tid_);
            pg8::Gemm g{(const bf16_t*)(C.ws + WS_P), (const bf16_t*)(C.ws + WS_WDN) + (size_t)layer * NE * DM * FF, 0, DM, FF};
            MoeOrder<false, 4> S{(const int*)(C.ws + WS_LIST), boff, mcnt, G, bx_};
            EpiDown E{(bf16_t*)(C.ws + WS_YP), (const float*)(C.ws + WS_GW), (const int*)(C.ws + WS_LIST), boff, mcnt};
            pg8::gemm_phase<EpiDown, MoeOrder<false, 4>, true>(lds_, g, S, E, tid_);
        } SEAM(p0 + 8);
    }
    if (IN(PH_FINAL) && (PHMASK & 2048)) { PHASE_IDS(); phase_final(C, gw_, NGW, lane_); }
#undef IN
#undef SEAM
}

extern "C" void kernel_launch(void* const* d_in, const int* in_sizes, int n_in, void* d_out, int out_size, void* d_ws, size_t ws_size, hipStream_t stream) {
    static int grid = 0;
    if (grid == 0) {
        if (n_in != 18 || in_sizes[0] != NB * SEQ * DM || out_size != NB * SEQ * DM || ws_size < WS_END) {
            fprintf(stderr, "kernel_launch: unexpected shapes (n_in %d, in0 %d, out %d, ws %zu, need %zu); nothing launched\n", n_in, n_in > 0 ? in_sizes[0] : -1, out_size, ws_size, (size_t)WS_END); grid = -1; return; }
        int dev = 0, cus = 0, per_cu = 0;
        if (hipGetDevice(&dev) != hipSuccess || hipDeviceGetAttribute(&cus, hipDeviceAttributeMultiprocessorCount, dev) != hipSuccess) { grid = -1; return; }
        if (hipFuncSetAttribute((const void*)mega_fwd, hipFuncAttributeMaxDynamicSharedMemorySize, LDS_BYTES) != hipSuccess) { fprintf(stderr, "kernel_launch: hipFuncSetAttribute failed\n"); grid = -1; return; }
        if (hipOccupancyMaxActiveBlocksPerMultiprocessor(&per_cu, (const void*)mega_fwd, 512, LDS_BYTES) != hipSuccess || per_cu < 1) fprintf(stderr, "kernel_launch: occupancy query says %d\n", per_cu);
        (void)hipGetLastError();
        grid = cus;
    }
    if (grid < 0) return;
    if (hipMemsetAsync((char*)d_ws + WS_CTL, 0, CTL_BYTES, stream) != hipSuccess) return;
    Args a{};
    for (int i = 0; i < 18; ++i) a.in[i] = (const float*)d_in[i];
    a.out = (float*)d_out; a.ws = (unsigned char*)d_ws;
#if MK_ONE_LAUNCH
    a.ph_lo = 0; a.ph_hi = PH_COUNT;
    hipLaunchKernelGGL(mega_fwd, dim3(grid), dim3(512), LDS_BYTES, stream, a);
#else
    for (int p = 0; p < PH_COUNT; ++p) { a.ph_lo = p; a.ph_hi = p + 1;
#if !defined(PROBE_P) || !PROBE_BEFORE
        hipLaunchKernelGGL(mega_fwd, dim3(grid), dim3(512), LDS_BYTES, stream, a);
#endif
#ifdef PROBE_P
        const bool hit = (PROBE_P < 2) ? (p == PROBE_P) : (p >= PH_LAYER0 && p < PH_FINAL && (p - PH_LAYER0) % PH_PER_LAYER == PROBE_P - 2 && (!PROBE_L0 || p < PH_LAYER0 + PH_PER_LAYER));
        if (hit) { a.flags = PROBE_FLAGS; for (int r = 0; r < PROBE_REP; ++r) hipLaunchKernelGGL(mega_fwd, dim3(grid), dim3(512), LDS_BYTES, stream, a); a.flags = 0; }
#if PROBE_BEFORE
        hipLaunchKernelGGL(mega_fwd, dim3(grid), dim3(512), LDS_BYTES, stream, a);
#endif
#endif
    }
#endif
}
```

```cpp
#define MK_ONE_LAUNCH 1
#include <hip/hip_runtime.h>
#include <cstdio>
#include <cstdint>

#define GAS __attribute__((address_space(1)))
#define LAS __attribute__((address_space(3)))
typedef unsigned short bf16_t;
typedef short bf16x8 __attribute__((ext_vector_type(8)));
typedef float f32x4 __attribute__((ext_vector_type(4)));
typedef float f32x2 __attribute__((ext_vector_type(2)));
typedef float f32x16 __attribute__((ext_vector_type(16)));
typedef unsigned u32x4 __attribute__((ext_vector_type(4)));
typedef unsigned u32x2 __attribute__((ext_vector_type(2)));

constexpr int DM = 1024, NB = 16, SEQ = 4096, CTX = 256, TPB = SEQ + CTX, MROWS = NB * TPB, DEPTH = 4;
constexpr int DIN = 2560;
constexpr int C_RQ = 0, C_RK = 256, C_RV = 512, C_RG = 1024, C_WQ = 1536, C_WK = 1792, C_WV = 1920, C_GQ = 2048, C_GK = 2304, C_GV = 2432;
constexpr int NE = 16, FF = 1024, NCH = TPB / 128;
constexpr float EPS = 1e-6f;
constexpr float LOG2E = 1.4426950408889634f;
constexpr float QSCALE = 0.125f * LOG2E;

__device__ __forceinline__ unsigned f2bf(float f) { unsigned u = __builtin_bit_cast(unsigned, f); return (u + 0x7fffu + ((u >> 16) & 1u)) >> 16; }
__device__ __forceinline__ unsigned pk2(float lo, float hi) { return f2bf(lo) | (f2bf(hi) << 16); }
__device__ __forceinline__ float bf2f(unsigned short h) { return __builtin_bit_cast(float, (unsigned)h << 16); }
__device__ __forceinline__ float bflo(unsigned w) { return __builtin_bit_cast(float, w << 16); }
__device__ __forceinline__ float bfhi(unsigned w) { return __builtin_bit_cast(float, w & 0xffff0000u); }

namespace pg8 {
constexpr int BM = 256, BK = 64, HALF = 128, HTB = HALF * BK * 2, STAGE_BYTES = 8 * HTB, NXCD = 8, WGM = 8;
__host__ __device__ __forceinline__ int lds_byte(int r, int c) { const int st = (r >> 4) * 2 + (c >> 5), rr = r & 15, cc = c & 31, ob = rr * 64 + cc * 2; return st * 1024 + (ob ^ (((ob >> 9) & 1) << 5)); }
__host__ __device__ __forceinline__ void stage_rc(int b, int& R, int& C) { const int st = b / 1024, sb = b % 1024, swz = sb ^ (((sb >> 9) & 1) << 5); R = (st >> 1) * 16 + swz / 64; C = (st & 1) * 32 + (swz % 64) / 2; }
__host__ __device__ __forceinline__ int perm32(int rho) { const int n = rho >> 4, i = rho & 15; return 8 * (i >> 2) + 4 * n + (i & 3); }

struct Unit { int pm, pn; };
struct Gemm { const bf16_t* A; const bf16_t* Bt; int M, N, K; };

struct StaticOrder {
    static constexpr bool GATHER = false;
    int nM, nN, nwg, G, c;
    __device__ void init(int M, int N, int G_, int c_) { nM = M / BM; nN = N / BM; nwg = nM * nN; G = G_; c = c_; }
    __device__ bool next(int i, Unit& u) const {
        const long L = (long)i * G + c; if (L >= nwg) return false;
        int wgid = (int)L; { const int q = nwg / NXCD, r = nwg % NXCD, xcd = wgid % NXCD, off = wgid / NXCD; wgid = (xcd < r ? xcd * (q + 1) : r * (q + 1) + (xcd - r) * q) + off; }
        const int nig = WGM * nN, gid = wgid / nig, fm = gid * WGM, gsz = (nM - fm) < WGM ? (nM - fm) : WGM;
        u.pm = fm + ((wgid % nig) % gsz); u.pn = (wgid % nig) / gsz; return true;
    }
    __device__ __forceinline__ unsigned arow(const Unit&, int) const { return 0u; }
};

__device__ __forceinline__ unsigned cvt_pk_bf16(float lo, float hi) { unsigned r; asm volatile("v_cvt_pk_bf16_f32 %0, %1, %2" : "=v"(r) : "v"(lo), "v"(hi)); return r; }

struct EpiBf16 {
    static constexpr bool PERM = true;
    bf16_t* O; int ldc;
    __device__ __forceinline__ void operator()(const f32x4 (&acc)[2][2][4][2], const Unit& u, int wr, int wc, int fr, int fq) const {
        const int row0 = u.pm * BM + wr * 64 + fr; const int col0 = u.pn * BM + wc * 32 + 8 * fq;
#pragma unroll
        for (int ai = 0; ai < 2; ++ai)
#pragma unroll
            for (int m = 0; m < 4; ++m) { const unsigned off = ((unsigned)(row0 + ai * HALF + m * 16) * (unsigned)ldc + (unsigned)col0) * 2u;
#pragma unroll
                for (int bj = 0; bj < 2; ++bj) { const f32x4 v0 = acc[ai][bj][m][0], v1 = acc[ai][bj][m][1];
                    u32x4 w; w.x = cvt_pk_bf16(v0[0], v0[1]); w.y = cvt_pk_bf16(v0[2], v0[3]); w.z = cvt_pk_bf16(v1[0], v1[1]); w.w = cvt_pk_bf16(v1[2], v1[3]);
                    *(u32x4*)((char*)O + off + bj * HALF * 2) = w; } }
    }
};

struct EpiResid {
    static constexpr bool PERM = true;
    bf16_t* X; const float* gate;
    __device__ __forceinline__ void operator()(const f32x4 (&acc)[2][2][4][2], const Unit& u, int wr, int wc, int fr, int fq) const {
        const int set = (u.pm % 17 == 0) ? 16 : (u.pm / 17);
        const float* gp = gate + (size_t)set * 6 * DM;
        const int col0 = u.pn * BM + wc * 32 + 8 * fq;
        f32x4 gv[2][2];
#pragma unroll
        for (int bj = 0; bj < 2; ++bj)
#pragma unroll
            for (int n = 0; n < 2; ++n) gv[bj][n] = *(const f32x4*)(gp + col0 + bj * HALF + n * 4);
#pragma unroll
        for (int ai = 0; ai < 2; ++ai) {
            u32x4 xin[4][2];
#pragma unroll
            for (int m = 0; m < 4; ++m) { const unsigned off = ((unsigned)(u.pm * BM + ai * HALF + wr * 64 + m * 16 + fr) * (unsigned)DM + (unsigned)col0) * 2u;
#pragma unroll
                for (int bj = 0; bj < 2; ++bj) xin[m][bj] = *(const u32x4*)((const char*)X + off + bj * HALF * 2); }
            asm volatile("" ::: "memory");
#pragma unroll
            for (int m = 0; m < 4; ++m) { const unsigned off = ((unsigned)(u.pm * BM + ai * HALF + wr * 64 + m * 16 + fr) * (unsigned)DM + (unsigned)col0) * 2u;
#pragma unroll
                for (int bj = 0; bj < 2; ++bj) { const u32x4 x = xin[m][bj]; const f32x4 a0 = acc[ai][bj][m][0] * gv[bj][0], a1 = acc[ai][bj][m][1] * gv[bj][1];
                    u32x4 w; w.x = cvt_pk_bf16(bflo(x.x) + a0[0], bfhi(x.x) + a0[1]); w.y = cvt_pk_bf16(bflo(x.y) + a0[2], bfhi(x.y) + a0[3]);
                    w.z = cvt_pk_bf16(bflo(x.z) + a1[0], bfhi(x.z) + a1[1]); w.w = cvt_pk_bf16(bflo(x.w) + a1[2], bfhi(x.w) + a1[3]);
                    *(u32x4*)((char*)X + off + bj * HALF * 2) = w; } }
            asm volatile("" ::: "memory");
        }
    }
};

template <class Epi, class Sched, bool ALIGN_EPI>
__device__ __forceinline__ void gemm_phase(LAS unsigned char* lds, const Gemm g, const Sched& S, const Epi& E, const int tid) {
    const int wid = __builtin_amdgcn_readfirstlane(tid >> 6), lane = tid & 63, wr = wid >> 2, wc = wid & 3, fr = lane & 15, fq = lane >> 4;
    const int K = g.K, nt = K / BK;
    unsigned voffB[2], vA[2][2], vAn[2][2]; int sR[2], sC[2];
#pragma unroll
    for (int i = 0; i < 2; ++i) { int R, C; stage_rc(tid * 16 + i * 8192, R, C); sR[i] = R; sC[i] = C; const int Rb = Epi::PERM ? ((R & ~31) + perm32(R & 31)) : R;
        voffB[i] = (unsigned)(Rb * K + C) * 2u; }
#define PG8_SETV(v, u) do { _Pragma("unroll") for (int h_ = 0; h_ < 2; ++h_) _Pragma("unroll") for (int i_ = 0; i_ < 2; ++i_) { \
        if constexpr (Sched::GATHER) v[h_][i_] = S.arow(u, h_ * HALF + sR[i_]) * (unsigned)(K * 2) + (unsigned)(sC[i_] * 2); \
        else v[h_][i_] = (unsigned)((h_ * HALF + sR[i_]) * K + sC[i_]) * 2u; } } while (0)
    const size_t kstep = (size_t)(BK * 2);
    const size_t hstep = (size_t)HALF * K * 2;
    const size_t tstep = 2 * hstep;
    const size_t atstep = Sched::GATHER ? (size_t)0 : tstep;
    const unsigned ldsw = (unsigned)wid * 1024u;
    const int aoff = lds_byte(wr * 64 + fr, fq * 8), boff = lds_byte(wc * 32 + fr, fq * 8);
#define PG8_SA(b, h) (((b) * 2 + (h)) * HTB)
#define PG8_SB(b, h) ((4 + (b) * 2 + (h)) * HTB)
#define PG8_STAGE(bufoff, gbase, voff) do { _Pragma("unroll") for (int _i = 0; _i < 2; ++_i) \
        __builtin_amdgcn_global_load_lds((const unsigned*)((const char*)(gbase) + (voff)[_i]), (LAS unsigned*)(lds + (bufoff) + ldsw + _i * 8192), 16, 0, 0); } while (0)
#define PG8_LDA(dst, b, h) do { _Pragma("unroll") for (int m = 0; m < 4; ++m) _Pragma("unroll") for (int k = 0; k < 2; ++k) dst[m][k] = *(const LAS bf16x8*)(lds + PG8_SA(b, h) + aoff + m * 2048 + k * 1024); } while (0)
#define PG8_LDB(dst, b, h) do { _Pragma("unroll") for (int n = 0; n < 2; ++n) _Pragma("unroll") for (int k = 0; k < 2; ++k) dst[n][k] = *(const LAS bf16x8*)(lds + PG8_SB(b, h) + boff + n * 2048 + k * 1024); } while (0)
#define PG8_MMA(ai, bj, At, Bt) do { __builtin_amdgcn_s_setprio(1); _Pragma("unroll") for (int m = 0; m < 4; ++m) _Pragma("unroll") for (int n = 0; n < 2; ++n) _Pragma("unroll") for (int k = 0; k < 2; ++k) \
        acc[ai][bj][m][n] = __builtin_amdgcn_mfma_f32_16x16x32_bf16(Bt[n][k], At[m][k], acc[ai][bj][m][n], 0, 0, 0); __builtin_amdgcn_s_setprio(0); } while (0)
#define PG8_WAIT_V(n) asm volatile("s_waitcnt vmcnt(" #n ")" ::: "memory")
#define PG8_WAIT_L(n) asm volatile("s_waitcnt lgkmcnt(" #n ")" ::: "memory")
#define PG8_BAR __builtin_amdgcn_s_barrier()
#define PG8_SCHED __builtin_amdgcn_sched_barrier(0)
    Unit cur, nxt; int ui = 0;
    if (!S.next(0, cur)) return;
    float z0 = 0.f; asm volatile("" : "+v"(z0));
    f32x4 acc[2][2][4][2];
#pragma unroll
    for (int a = 0; a < 2; ++a)
#pragma unroll
        for (int b = 0; b < 2; ++b)
#pragma unroll
            for (int m = 0; m < 4; ++m)
#pragma unroll
                for (int n = 0; n < 2; ++n) acc[a][b][m][n] = (f32x4){z0, z0, z0, z0};
    bf16x8 At[4][2], B0[2][2], B1[2][2];
    const char* cA = (const char*)g.A + (size_t)cur.pm * atstep; const char* cB = (const char*)g.Bt + (size_t)cur.pn * tstep;
    PG8_SETV(vA, cur);
    PG8_STAGE(PG8_SB(0, 0), cB, voffB); PG8_STAGE(PG8_SB(0, 1), cB + hstep, voffB); PG8_STAGE(PG8_SA(0, 0), cA, vA[0]); PG8_STAGE(PG8_SA(0, 1), cA, vA[1]);
    if (wr == 1) PG8_BAR;
    PG8_WAIT_V(2); PG8_BAR;
    PG8_STAGE(PG8_SB(1, 0), cB + kstep, voffB); PG8_STAGE(PG8_SA(1, 0), cA + kstep, vA[0]); PG8_STAGE(PG8_SB(1, 1), cB + hstep + kstep, voffB);
    PG8_WAIT_V(6); PG8_BAR;
    for (;;) {
        const bool has_next = S.next(ui + 1, nxt);
        const char* nA = has_next ? (const char*)g.A + (size_t)nxt.pm * atstep : cA; const char* nB = has_next ? (const char*)g.Bt + (size_t)nxt.pn * tstep : cB;
        if (has_next) { PG8_SETV(vAn, nxt); } else {
#pragma unroll
            for (int h_ = 0; h_ < 2; ++h_)
#pragma unroll
                for (int i_ = 0; i_ < 2; ++i_) vAn[h_][i_] = vA[h_][i_]; }
        for (int t = 0; t < nt; t += 2) {
            const bool last = (t == nt - 2);
            const char* a1 = cA + (size_t)(t + 1) * kstep;
            const char* a2 = last ? nA : cA + (size_t)(t + 2) * kstep; const char* b2 = last ? nB : cB + (size_t)(t + 2) * kstep;
            const char* a3 = a2 + kstep; const char* b3 = b2 + kstep;
            unsigned o2[2][2];
#pragma unroll
            for (int h_ = 0; h_ < 2; ++h_)
#pragma unroll
                for (int i_ = 0; i_ < 2; ++i_) o2[h_][i_] = last ? vAn[h_][i_] : vA[h_][i_];
            PG8_LDB(B0, 0, 0); PG8_LDB(B1, 0, 1); PG8_SCHED; PG8_LDA(At, 0, 0); PG8_STAGE(PG8_SA(1, 1), a1, vA[1]);
            PG8_WAIT_V(8); PG8_WAIT_L(0); PG8_BAR; PG8_MMA(0, 0, At, B0); PG8_MMA(0, 1, At, B1); PG8_BAR; PG8_SCHED;
            PG8_LDA(At, 0, 1); PG8_STAGE(PG8_SB(0, 0), b2, voffB); PG8_STAGE(PG8_SB(0, 1), b2 + hstep, voffB); PG8_STAGE(PG8_SA(0, 0), a2, o2[0]);
            PG8_WAIT_V(8); PG8_WAIT_L(0); PG8_BAR; PG8_MMA(1, 0, At, B0); PG8_MMA(1, 1, At, B1); PG8_BAR; PG8_SCHED;
            PG8_LDB(B0, 1, 0); PG8_LDB(B1, 1, 1); PG8_SCHED; PG8_LDA(At, 1, 0); PG8_STAGE(PG8_SA(0, 1), a2, o2[1]);
            PG8_WAIT_V(8); PG8_WAIT_L(0); PG8_BAR; PG8_MMA(0, 0, At, B0); PG8_MMA(0, 1, At, B1); PG8_BAR; PG8_SCHED;
            PG8_LDA(At, 1, 1); PG8_STAGE(PG8_SB(1, 0), b3, voffB); PG8_STAGE(PG8_SB(1, 1), b3 + hstep, voffB); PG8_STAGE(PG8_SA(1, 0), a3, o2[0]);
            PG8_WAIT_V(8); PG8_WAIT_L(0); PG8_BAR; PG8_MMA(1, 0, At, B0); PG8_MMA(1, 1, At, B1); PG8_BAR; PG8_SCHED;
        }
        if constexpr (ALIGN_EPI) { if (wr == 0) PG8_BAR; }
        E(acc, cur, wr, wc, fr, fq);
        if (!has_next) break;
#pragma unroll
        for (int a = 0; a < 2; ++a)
#pragma unroll
            for (int b = 0; b < 2; ++b)
#pragma unroll
                for (int m = 0; m < 4; ++m)
#pragma unroll
                    for (int n = 0; n < 2; ++n) acc[a][b][m][n] = (f32x4){z0, z0, z0, z0};
        cur = nxt; cA = nA; cB = nB; ++ui;
#pragma unroll
        for (int h_ = 0; h_ < 2; ++h_)
#pragma unroll
            for (int i_ = 0; i_ < 2; ++i_) vA[h_][i_] = vAn[h_][i_];
        if constexpr (ALIGN_EPI) { if (wr == 1) PG8_BAR; }
    }
    PG8_WAIT_V(0);
    if constexpr (!ALIGN_EPI) { if (wr == 0) PG8_BAR; }
    PG8_BAR;
#undef PG8_SETV
#undef PG8_SA
#undef PG8_SB
#undef PG8_STAGE
#undef PG8_LDA
#undef PG8_LDB
#undef PG8_MMA
#undef PG8_WAIT_V
#undef PG8_WAIT_L
#undef PG8_BAR
#undef PG8_SCHED
}
}
#include <hip/hip_bf16.h>
#include <cmath>
namespace attn_body {
using bf16=__hip_bfloat16;
using s16x4=__attribute__((ext_vector_type(4)))short;
constexpr int D=64,QP=DIN,OP=1024;
constexpr int NW=8,QBLK=32,QB=QBLK*NW,KVBLK=64;
__device__ __forceinline__ int crow(int r,int hi){return (r&3)+8*(r>>2)+4*hi;}
#define SBAR() __builtin_amdgcn_sched_barrier(0)
__device__ __forceinline__ void wmask(f32x16&p0,f32x16&p1,int kq,int hi){
  const float NEG=-INFINITY; const int kb=kq+4*hi;
  #pragma unroll
  for(int r=0;r<16;++r){const int d=kb+(r&3)+8*(r>>2); if(d>128||d<-128)p0[r]=NEG; if(d+32>128||d+32<-128)p1[r]=NEG;}
}

constexpr int NSLOT=3, SLOTB=8192;
constexpr int LDS_K=0, LDS_V=NSLOT*SLOTB, LDS_WS=2*NSLOT*SLOTB, LDS_OST=LDS_WS+NW*64*4, LDS_BYTES=LDS_OST+NW*4096;
constexpr float C2=0.125f*1.4426950408889634f;
__device__ __forceinline__ void glds16(const void*gsrc,unsigned lds_dst){unsigned keep;
  asm volatile("s_mov_b32 %0, m0\n\ts_mov_b32 m0, %2\n\ts_nop 0\n\tglobal_load_lds_dwordx4 %1, off\n\ts_mov_b32 m0, %0":"=&s"(keep):"v"(gsrc),"s"(lds_dst):"memory");}
__device__ __forceinline__ float max3f(float a,float b,float c){float r;asm("v_max3_f32 %0, %1, %2, %3":"=v"(r):"v"(a),"v"(b),"v"(c));return r;}
__device__ __forceinline__ float max2f(float a,float b){float r;asm("v_max_f32_e32 %0, %1, %2":"=v"(r):"v"(a),"v"(b));return r;}
__device__ __forceinline__ float fadd_s(float a,float b){float r;asm("v_add_f32_e32 %0, %1, %2":"=v"(r):"v"(a),"v"(b));return r;}
__device__ __forceinline__ float fsub_s(float a,float b){float r;asm("v_sub_f32_e32 %0, %1, %2":"=v"(r):"v"(a),"v"(b));return r;}
typedef float f32x2_t __attribute__((ext_vector_type(2))); typedef __bf16 bf16x2_t __attribute__((ext_vector_type(2)));
__device__ __forceinline__ unsigned cvtpk_s(float lo,float hi){f32x2_t v={lo,hi};bf16x2_t b=__builtin_convertvector(v,bf16x2_t);return __builtin_bit_cast(unsigned,b);}
#define WAIT_BAR(N) asm volatile("s_waitcnt vmcnt(" #N ") lgkmcnt(0)\n\ts_barrier":::"memory")

__device__ __forceinline__ void qkt(f32x16&p0,f32x16&p1,const char*Kslot,const bf16x8*qr,const f32x16&negm,int r32,int hi){
  const char*kb=Kslot+hi*1024+r32*16;
  #pragma unroll
  for(int d0=0;d0<4;++d0){
    const bf16x8 b0=*reinterpret_cast<const bf16x8*>(kb+d0*2048);
    const bf16x8 b1=*reinterpret_cast<const bf16x8*>(kb+d0*2048+512);
    if(d0==0){p0=__builtin_amdgcn_mfma_f32_32x32x16_bf16(b0,qr[0],negm,0,0,0);p1=__builtin_amdgcn_mfma_f32_32x32x16_bf16(b1,qr[0],negm,0,0,0);}
    else{p0=__builtin_amdgcn_mfma_f32_32x32x16_bf16(b0,qr[d0],p0,0,0,0);p1=__builtin_amdgcn_mfma_f32_32x32x16_bf16(b1,qr[d0],p1,0,0,0);}}
}
typedef __attribute__((address_space(3))) const char* lds_cptr;
typedef short v4i16_t __attribute__((ext_vector_type(4)));
__device__ __forceinline__ void kload8(bf16x8*kf,lds_cptr kp){
  kf[0]=*(const __attribute__((address_space(3))) bf16x8*)(kp);      kf[1]=*(const __attribute__((address_space(3))) bf16x8*)(kp+512);
  kf[2]=*(const __attribute__((address_space(3))) bf16x8*)(kp+2048); kf[3]=*(const __attribute__((address_space(3))) bf16x8*)(kp+2560);
  kf[4]=*(const __attribute__((address_space(3))) bf16x8*)(kp+4096); kf[5]=*(const __attribute__((address_space(3))) bf16x8*)(kp+4608);
  kf[6]=*(const __attribute__((address_space(3))) bf16x8*)(kp+6144); kf[7]=*(const __attribute__((address_space(3))) bf16x8*)(kp+6656);
}
__device__ __forceinline__ void kload2(bf16x8*kf,lds_cptr kp,int j){ kf[2*j]=*(const __attribute__((address_space(3))) bf16x8*)(kp+j*2048); kf[2*j+1]=*(const __attribute__((address_space(3))) bf16x8*)(kp+j*2048+512); }
__device__ __forceinline__ s16x4 vtr(lds_cptr p){ return __builtin_bit_cast(s16x4,__builtin_amdgcn_ds_read_tr16_b64_v4i16((__attribute__((address_space(3))) v4i16_t*)p)); }
__device__ __forceinline__ float rowmax(const f32x16&p0,const f32x16&p1){
  float a=max3f(p0[0],p0[1],p1[0]),b=max3f(p0[2],p0[3],p1[1]);a=max3f(a,p1[2],p1[3]);
  #pragma unroll
  for(int r=4;r<16;r+=4){a=max3f(a,p0[r],p0[r+1]);b=max3f(b,p0[r+2],p0[r+3]);a=max3f(a,p1[r],p1[r+1]);b=max3f(b,p1[r+2],p1[r+3]);}
  const float m=max2f(a,b);
  auto rr=__builtin_amdgcn_permlane32_swap(__float_as_uint(m),__float_as_uint(m),false,false);
  return max2f(__uint_as_float(rr[0]),__uint_as_float(rr[1]));
}
__device__ __forceinline__ void pv(f32x16*o,int vb,bf16x8 pa0,bf16x8 pa1,bf16x8 pa2,bf16x8 pa3){
  #pragma unroll
  for(int d0=0;d0<2;++d0){s16x4 lo[4],hi[4];
    #pragma unroll
    for(int ks=0;ks<4;++ks){
      asm volatile("ds_read_b64_tr_b16 %0,%1 offset:%c2":"=&v"(lo[ks]):"v"(vb),"i"(d0*4096+ks*1024):"memory");
      asm volatile("ds_read_b64_tr_b16 %0,%1 offset:%c2":"=&v"(hi[ks]):"v"(vb),"i"(d0*4096+ks*1024+512):"memory");}
    asm volatile("s_waitcnt lgkmcnt(0)":::"memory");SBAR();
    #define PK(k) (bf16x8){lo[k][0],lo[k][1],lo[k][2],lo[k][3],hi[k][0],hi[k][1],hi[k][2],hi[k][3]}
    o[d0]=__builtin_amdgcn_mfma_f32_32x32x16_bf16(pa0,PK(0),o[d0],0,0,0);
    o[d0]=__builtin_amdgcn_mfma_f32_32x32x16_bf16(pa1,PK(1),o[d0],0,0,0);
    o[d0]=__builtin_amdgcn_mfma_f32_32x32x16_bf16(pa2,PK(2),o[d0],0,0,0);
    o[d0]=__builtin_amdgcn_mfma_f32_32x32x16_bf16(pa3,PK(3),o[d0],0,0,0);
    #undef PK
  }
}

#ifndef ATTN_STORE16
#define ATTN_STORE16(p,v) (*(u32x4*)(p)=(v))
#endif
template<int THRL,bool WIN> __device__ __forceinline__ void attn_unit(const bf16*Qb,const bf16*__restrict__ Kb,const bf16*__restrict__ Vb,bf16*Ob,int q0,int NT,int tdelta,float sink_l2,int tid,char*shm){
  const int lane=tid&63,r32=lane&31,hi=lane>>5; const int wid=__builtin_amdgcn_readfirstlane(tid>>6);
  const bf16*Qw=Qb+(long)(q0+wid*QBLK)*QP;
  const bf16*Kh=Kb,*Vh=Vb;
  const unsigned lds0=(unsigned)(uintptr_t)shm;
  float*wsf=(float*)(shm+LDS_WS)+wid*64;
  const bf16*ksrc=Kh+(long)lane*QP+wid*8;
  const bf16*vsrc=Vh+(long)(16*(wid&3)+(lane>>2))*QP+(wid>>2)*32+(lane&3)*8;
  const unsigned kdst=lds0+LDS_K+wid*1024, vdst=lds0+LDS_V+wid*1024;
  #define TM(t) ((t)<4?(t):(t)+tdelta)
  #define DMA_K(t,slot) glds16(ksrc+(long)TM(t)*KVBLK*QP,(unsigned)__builtin_amdgcn_readfirstlane(kdst+(slot)))
  #define DMA_V(t,slot) glds16(vsrc+(long)TM(t)*KVBLK*QP,(unsigned)__builtin_amdgcn_readfirstlane(vdst+(slot)))
  const int vb0=(int)(lds0+LDS_V)+((lane>>4)&1)*32+(lane&3)*8+(4*hi+((lane&15)>>2))*64;
  const char*Kbase=shm+LDS_K; bf16x8 kf[8];
  const lds_cptr shm3=(lds_cptr)shm; const lds_cptr kp0=shm3+LDS_K+hi*1024+r32*16; const lds_cptr vp0=shm3+LDS_V+((lane>>4)&1)*32+(lane&3)*8+(4*hi+((lane&15)>>2))*64;
  DMA_K(0,0);DMA_V(0,0);DMA_K(1,SLOTB);
  bf16x8 qr[4];
  #pragma unroll
  for(int d0=0;d0<4;++d0)qr[d0]=*reinterpret_cast<const bf16x8*>(&Qw[(long)r32*QP+d0*16+hi*8]);
  float mhat=0.f,l_reg=0.f;float z0_=0.f;asm volatile("":"+v"(z0_));f32x16 o[2];
  #pragma unroll
  for(int r_=0;r_<16;++r_){o[0][r_]=z0_;o[1][r_]=z0_;}
  f32x16 negm;
  #pragma unroll
  for(int r_=0;r_<16;++r_)negm[r_]=z0_;
  asm volatile("":"+v"(negm));
  const int qrow=q0+wid*QBLK+r32;
  #define CMASK(P0,P1,t) do{ if(WIN&&(t)>=4)wmask(P0,P1,TM(t)*KVBLK-qrow,hi); }while(0)
  bool resc=false;
  #define START(P0,P1) do{ const float rm=rowmax(P0,P1); resc=false; \
    { const float dl=rm; mhat=fadd_s(mhat,dl); \
      _Pragma("unroll") for(int r=0;r<16;++r){P0[r]=fsub_s(P0[r],dl);P1[r]=fsub_s(P1[r],dl);} \
      _Pragma("unroll") for(int r=0;r<16;++r)negm[r]=-mhat; asm volatile("":"+v"(negm)); } \
    _Pragma("unroll") for(int r=0;r<16;++r)P0[r]=__builtin_amdgcn_exp2f(P0[r]); }while(0)
  #define RESC() do{ if(resc){ asm volatile("s_waitcnt lgkmcnt(0)":::"memory"); \
      _Pragma("unroll") for(int d_=0;d_<2;++d_) _Pragma("unroll") for(int r=0;r<16;++r)o[d_][r]*=wsf[crow(r,hi)]; } }while(0)
  f32x16 pA0,pA1,pB0,pB1;
  int sl_prev=0,sl_cur=0,sl_next=SLOTB;
  #define ROT() do{sl_prev=sl_cur;sl_cur=sl_next;sl_next=(sl_next==(NSLOT-1)*SLOTB)?0:sl_next+SLOTB;}while(0)
  DMA_K(2,2*SLOTB);
  WAIT_BAR(3);
  qkt(pA0,pA1,Kbase,qr,negm,r32,hi);asm volatile("s_nop 15\n\ts_nop 7":"+v"(pA0),"+v"(pA1));CMASK(pA0,pA1,0);
  START(pA0,pA1);
  _Pragma("unroll") for(int r=0;r<16;++r)pA1[r]=__builtin_amdgcn_exp2f(pA1[r]);
  WAIT_BAR(0);
  DMA_K(3,0);DMA_V(1,SLOTB);
  ROT();
  kload8(kf,kp0+sl_cur);
  WAIT_BAR(2);
  s16x4 vlo[8],vhi[8]; u32x4 pw0,pw1,pw2,pw3;
  #define PKW(P,B) cvtpk_s(P[B],P[B+1])
  #define PAF(k) __builtin_bit_cast(bf16x8,pw##k)
  #define VFR(i) (bf16x8){vlo[i][0],vlo[i][1],vlo[i][2],vlo[i][3],vhi[i][0],vhi[i][1],vhi[i][2],vhi[i][3]}
  #define PIN(x) asm volatile("":"+v"(x))
  #define MX3(a,b,c) __builtin_fmaxf(__builtin_fmaxf((a),(b)),(c))
  #define GAPA(MF,A0,A1,A2,A3,W0,W1,PW) do{ MF; sacc+=A0; sacc+=A1; sacc+=A2; sacc+=A3; PIN(sacc); W0; W1; PIN(PW); SBAR(); }while(0)
  #define EX(v) __builtin_amdgcn_exp2f(v)
  #define GAPB(MF,X,B) do{ MF; X[B]=EX(X[B]); X[B+1]=EX(X[B+1]); X[B+2]=EX(X[B+2]); X[B+3]=EX(X[B+3]); PIN(X); SBAR(); }while(0)
  #define VRD(i) do{ vlo[i]=vtr(vp_+(((i)>>2)*4096+((i)&3)*1024)); vhi[i]=vtr(vp_+(((i)>>2)*4096+((i)&3)*1024+512)); }while(0)
  #define KRD(G,j) do{ if(G){ kload2(kf,kp0+sl_next,j); SBAR(); } }while(0)
  #define STEP(C0,C1,P0,P1,t,GK,GV,GL) do{ SBAR(); \
    const lds_cptr vp_=vp0+sl_prev; \
    VRD(0); SBAR(); float sacc=(P0[0]+P0[1]); \
    GAPA(C0=__builtin_amdgcn_mfma_f32_32x32x16_bf16(kf[0],qr[0],negm,0,0,0), P0[2],P0[3],P0[4],P0[5],     pw0[0]=PKW(P0,0), pw0[1]=PKW(P0,2), pw0); \
    VRD(4); SBAR(); GAPA(C1=__builtin_amdgcn_mfma_f32_32x32x16_bf16(kf[1],qr[0],negm,0,0,0), P0[6],P0[7],P0[8],P0[9],     pw0[2]=PKW(P0,4), pw0[3]=PKW(P0,6), pw0); \
    VRD(1); SBAR(); GAPA(C0=__builtin_amdgcn_mfma_f32_32x32x16_bf16(kf[2],qr[1],C0,0,0,0),   P0[10],P0[11],P0[12],P0[13], pw1[0]=PKW(P0,8), pw1[1]=PKW(P0,10), pw1); \
    VRD(5); SBAR(); GAPA(C1=__builtin_amdgcn_mfma_f32_32x32x16_bf16(kf[3],qr[1],C1,0,0,0),   P0[14],P0[15],P1[0],P1[1],   pw1[2]=PKW(P0,12),pw1[3]=PKW(P0,14), pw1); \
    VRD(2); SBAR(); GAPA(C0=__builtin_amdgcn_mfma_f32_32x32x16_bf16(kf[4],qr[2],C0,0,0,0),   P1[2],P1[3],P1[4],P1[5],     pw2[0]=PKW(P1,0), pw2[1]=PKW(P1,2), pw2); \
    VRD(6); SBAR(); GAPA(C1=__builtin_amdgcn_mfma_f32_32x32x16_bf16(kf[5],qr[2],C1,0,0,0),   P1[6],P1[7],P1[8],P1[9],     pw2[2]=PKW(P1,4), pw2[3]=PKW(P1,6), pw2); \
    VRD(3); SBAR(); GAPA(C0=__builtin_amdgcn_mfma_f32_32x32x16_bf16(kf[6],qr[3],C0,0,0,0),   P1[10],P1[11],P1[12],P1[13], pw3[0]=PKW(P1,8), pw3[1]=PKW(P1,10), pw3); \
    VRD(7); SBAR(); GAPA(C1=__builtin_amdgcn_mfma_f32_32x32x16_bf16(kf[7],qr[3],C1,0,0,0),   P1[14],P1[15],0.f,0.f,       pw3[2]=PKW(P1,12),pw3[3]=PKW(P1,14), pw3); \
    l_reg+=sacc; \
    if(GK){DMA_K((t)+3,sl_cur);} if(GV){DMA_V((t)+1,sl_next);} \
    CMASK(C0,C1,t); \
    { float a=MX3(C0[0],C0[1],C1[0]),b=MX3(C0[2],C0[3],C1[1]); a=MX3(a,C1[2],C1[3]); \
      _Pragma("unroll") for(int r=4;r<16;r+=4){a=MX3(a,C0[r],C0[r+1]);b=MX3(b,C0[r+2],C0[r+3]);a=MX3(a,C1[r],C1[r+1]);b=MX3(b,C1[r+2],C1[r+3]);} \
      float rm=__builtin_fmaxf(a,b); { auto rr=__builtin_amdgcn_permlane32_swap(__float_as_uint(rm),__float_as_uint(rm),false,false); rm=__builtin_fmaxf(__uint_as_float(rr[0]),__uint_as_float(rr[1])); } \
      resc=false; \
      if(__builtin_expect(__any(rm>(float)THRL),0)){ const float dl=__builtin_fmaxf(rm,0.f); mhat+=dl; \
        _Pragma("unroll") for(int r=0;r<16;++r){C0[r]-=dl;C1[r]-=dl;} \
        _Pragma("unroll") for(int r=0;r<16;++r)negm[r]=-mhat; asm volatile("":"+v"(negm)); \
        const float f=__builtin_amdgcn_exp2f(-dl); l_reg*=f; if(hi==0)wsf[r32]=f; resc=true; } } \
    SBAR(); \
    GAPB(o[0]=__builtin_amdgcn_mfma_f32_32x32x16_bf16(PAF(0),VFR(0),o[0],0,0,0), C0,0); \
    GAPB(o[1]=__builtin_amdgcn_mfma_f32_32x32x16_bf16(PAF(0),VFR(4),o[1],0,0,0), C0,4); \
    KRD(GL,0); GAPB(o[0]=__builtin_amdgcn_mfma_f32_32x32x16_bf16(PAF(1),VFR(1),o[0],0,0,0), C0,8); \
    KRD(GL,1); GAPB(o[1]=__builtin_amdgcn_mfma_f32_32x32x16_bf16(PAF(1),VFR(5),o[1],0,0,0), C0,12); \
    KRD(GL,2); GAPB(o[0]=__builtin_amdgcn_mfma_f32_32x32x16_bf16(PAF(2),VFR(2),o[0],0,0,0), C1,0); \
    KRD(GL,3); GAPB(o[1]=__builtin_amdgcn_mfma_f32_32x32x16_bf16(PAF(2),VFR(6),o[1],0,0,0), C1,4); \
    GAPB(o[0]=__builtin_amdgcn_mfma_f32_32x32x16_bf16(PAF(3),VFR(3),o[0],0,0,0), C1,8); \
    GAPB(o[1]=__builtin_amdgcn_mfma_f32_32x32x16_bf16(PAF(3),VFR(7),o[1],0,0,0), C1,12); \
    }while(0)
  int t=1;
  for(;t+5<NT;t+=2){
    STEP(pB0,pB1,pA0,pA1,t,true,true,true);     WAIT_BAR(2); RESC(); ROT();
    STEP(pA0,pA1,pB0,pB1,t+1,true,true,true);   WAIT_BAR(2); RESC(); ROT();
  }
  #define ENDW(tt) do{ if((tt)+3<NT){WAIT_BAR(2);} else if((tt)+2<NT){WAIT_BAR(1);} else {WAIT_BAR(0);} }while(0)
  for(;t+1<NT;t+=2){
    STEP(pB0,pB1,pA0,pA1,t,(t+3<NT),(t+1<NT),(t+1<NT));       ENDW(t);   RESC(); ROT();
    STEP(pA0,pA1,pB0,pB1,t+1,(t+4<NT),(t+2<NT),(t+2<NT));     ENDW(t+1); RESC(); ROT();
  }
  STEP(pB0,pB1,pA0,pA1,NT-1,false,false,false); RESC();
  { float sacc=pB0[0]+pB0[1]; _Pragma("unroll") for(int r=2;r<16;++r)sacc+=pB0[r]; _Pragma("unroll") for(int r=0;r<16;++r)sacc+=pB1[r]; l_reg+=sacc;
    pw0=(u32x4){PKW(pB0,0),PKW(pB0,2),PKW(pB0,4),PKW(pB0,6)};pw1=(u32x4){PKW(pB0,8),PKW(pB0,10),PKW(pB0,12),PKW(pB0,14)};pw2=(u32x4){PKW(pB1,0),PKW(pB1,2),PKW(pB1,4),PKW(pB1,6)};pw3=(u32x4){PKW(pB1,8),PKW(pB1,10),PKW(pB1,12),PKW(pB1,14)};
    SBAR(); pv(o,vb0+sl_cur,PAF(0),PAF(1),PAF(2),PAF(3)); }
  #undef PKW
  #undef PAF
  #undef VFR
  #undef PIN
  #undef MX3
  #undef GAPA
  #undef GAPB
  #undef EX
  #undef VRD
  #undef KRD
  #undef STEP
  #undef ENDW
  {auto rr=__builtin_amdgcn_permlane32_swap(__float_as_uint(l_reg),__float_as_uint(l_reg),false,false);l_reg=__uint_as_float(rr[0])+__uint_as_float(rr[1]);}
  if(WIN)l_reg+=__builtin_amdgcn_exp2f(sink_l2-mhat);
  if(hi==0)wsf[32+r32]=l_reg;asm volatile("s_waitcnt lgkmcnt(0)":::"memory");
  float rli[16];
  #pragma unroll
  for(int r=0;r<16;++r)rli[r]=__builtin_amdgcn_rcpf(wsf[32+crow(r,hi)]);
  bf16*Ow=Ob+(long)(q0+wid*QBLK)*OP;
  { bf16*stg=(bf16*)(shm+LDS_OST)+wid*2048;
    #pragma unroll
    for(int r=0;r<16;++r){const int orow=crow(r,hi);
      #pragma unroll
      for(int d0=0;d0<2;++d0)stg[orow*64+d0*32+r32]=__float2bfloat16(o[d0][r]*rli[r]);}
    asm volatile("s_waitcnt lgkmcnt(0)":::"memory");
    #pragma unroll
    for(int i=0;i<4;++i){const int row=i*8+(lane>>3),ch=lane&7; const u32x4 v=*(const u32x4*)(stg+row*64+ch*8); ATTN_STORE16(Ow+(long)row*OP+ch*8,v);} }
  asm volatile("s_waitcnt lgkmcnt(0)\n\ts_barrier":::"memory");
  #undef TM
  #undef DMA_K
  #undef DMA_V
  #undef CMASK
  #undef START
  #undef RESC
  #undef ROT
}
constexpr int ATTN_LDS_BYTES=LDS_BYTES;
#undef SBAR
#undef WAIT_BAR
}
#define XB_TMO      128
#define XB_XCNT(j)  (256  + 64 * (j))
#define XB_XSUB(j)  (1280 + 64 * (j))
#define XB_XGEN(j)  (2304 + 64 * (j))
#define XB_TOP      3328
#define XB_TOPGEN   3392
#define XCD_BAR_WORDS 3456
#define XB_SPIN_CAP (1u << 21)

__device__ __forceinline__ unsigned xb_ld(unsigned* p)              { return __hip_atomic_load(p, __ATOMIC_RELAXED, __HIP_MEMORY_SCOPE_AGENT); }
__device__ __forceinline__ unsigned xb_add(unsigned* p, unsigned v) { return __hip_atomic_fetch_add(p, v, __ATOMIC_RELAXED, __HIP_MEMORY_SCOPE_AGENT); }
__device__ __forceinline__ unsigned xb_xcc_id() { return (unsigned)__builtin_amdgcn_s_getreg((3 << 11) | 20) & 0xFu; }
#define XB_SPIN(cond, bar) do { unsigned _sp = 0; while (cond) { __builtin_amdgcn_s_sleep(1); \
    if ((++_sp & 255u) == 0u) { if (xb_ld(&(bar)[XB_TMO])) break; if (_sp > XB_SPIN_CAP) { atomicAdd(&(bar)[XB_TMO], 1u); break; } } } } while (0)

struct XcdBarrier {
    unsigned* bar; unsigned x;
    volatile LAS unsigned* st;
};

__device__ __forceinline__ XcdBarrier xcd_barrier_post(unsigned* bar, volatile LAS unsigned* st) {
    XcdBarrier b; b.bar = bar; b.x = xb_xcc_id(); b.st = st;
    if (threadIdx.x == 0) (void)xb_add(&bar[XB_XCNT(b.x)], 1u);
    return b;
}
__device__ __forceinline__ void xcd_barrier_complete(unsigned* bar, unsigned x, unsigned& nloc, unsigned& nx) {
    const unsigned G = gridDim.x * gridDim.y * gridDim.z;
    unsigned sum, cnt, mine, sp = 0u;
    for (;;) {
        sum = 0u; cnt = 0u; mine = 0u;
#pragma unroll
        for (unsigned j = 0; j < 16; ++j) { const unsigned c = xb_ld(&bar[XB_XCNT(j)]); sum += c; cnt += (c > 0u) ? 1u : 0u; mine = (j == x) ? c : mine; }
        if (sum == G) break;
        __builtin_amdgcn_s_sleep(1);
        if ((++sp & 255u) == 0u) { if (xb_ld(&bar[XB_TMO])) break; if (sp > XB_SPIN_CAP) { atomicAdd(&bar[XB_TMO], 1u); break; } }
    }
    nloc = mine > 0u ? mine : 1u; nx = cnt > 0u ? cnt : 1u;
}

__device__ __forceinline__ void xcd_barrier(const XcdBarrier& b) {
    asm volatile("s_waitcnt vmcnt(0)" ::: "memory");
    __syncthreads();
    if (threadIdx.x == 0) {
        unsigned* bar = b.bar; unsigned bx_ = b.x; asm volatile("" : "+s"(bar), "+s"(bx_));
        __builtin_amdgcn_s_waitcnt(0);
        unsigned nloc = b.st[0], nx = b.st[1];
        if (nloc == 0u) { xcd_barrier_complete(bar, bx_, nloc, nx); b.st[0] = nloc; b.st[1] = nx; }
        const unsigned old = xb_add(&bar[XB_XSUB(bx_)], 1u);
        const unsigned gen = old / nloc;
        if (old + 1u == (gen + 1u) * nloc) {
            __builtin_amdgcn_fence(__ATOMIC_RELEASE, "agent");
            asm volatile("s_waitcnt vmcnt(0)" ::: "memory");
            const unsigned og = xb_add(&bar[XB_TOP], 1u);
            const unsigned tg = og / nx;
            if (og + 1u == (tg + 1u) * nx) xb_add(&bar[XB_TOPGEN], 1u);
            else XB_SPIN(xb_ld(&bar[XB_TOPGEN]) == tg, bar);
            __builtin_amdgcn_fence(__ATOMIC_ACQUIRE, "agent");
            xb_add(&bar[XB_XGEN(bx_)], 1u);
            asm volatile("s_waitcnt vmcnt(0)" ::: "memory");
        } else {
            XB_SPIN(xb_ld(&bar[XB_XGEN(bx_)]) == gen, bar);
            __builtin_amdgcn_fence(__ATOMIC_ACQUIRE, "agent");
            asm volatile("s_waitcnt vmcnt(0)" ::: "memory");
        }
    }
    __syncthreads();
}

constexpr size_t alup(size_t x) { return (x + 4095) & ~(size_t)4095; }
constexpr size_t CTL_BYTES = 1u << 20;
constexpr size_t SZ_WIN = (size_t)DEPTH * DIN * DM * 2, SZ_WOUT = (size_t)DEPTH * DM * DM * 2, SZ_WGU = (size_t)DEPTH * NE * 2 * FF * DM * 2, SZ_WDN = (size_t)DEPTH * NE * DM * FF * 2;
constexpr size_t SZ_MODP = (size_t)DEPTH * 16 * 17 * 6144 * 4, SZ_MOD = (size_t)DEPTH * 17 * 6144 * 4;
constexpr size_t SZ_X32 = (size_t)MROWS * DM * 2  , SZ_H = (size_t)MROWS * DM * 2, SZ_P = (size_t)MROWS * DIN * 2, SZ_Y = (size_t)MROWS * DM * 2, SZ_YP = (size_t)MROWS * 2 * DM * 2;
constexpr size_t SZ_LIST = (size_t)NE * MROWS * 4, SZ_GW = (size_t)MROWS * 2 * 4;
constexpr int MAXBLK = (MROWS * 2) / 256 + NE;
static_assert((size_t)MAXBLK * 256 * FF * 2 <= SZ_P, "HMID overlays P");
static_assert((size_t)2 * NB * 4 * NCH * 128 * 64 * 4 <= SZ_H, "KVT overlays H");
static_assert((size_t)2 * NB * 4 * NCH * 128 * 64 * 2 <= SZ_YP, "ST overlays YP");
constexpr size_t WS_CTL = 0;
constexpr size_t WS_WIN = CTL_BYTES, WS_WOUT = WS_WIN + alup(SZ_WIN), WS_WGU = WS_WOUT + alup(SZ_WOUT), WS_WDN = WS_WGU + alup(SZ_WGU);
constexpr size_t WS_MODP = WS_WDN + alup(SZ_WDN), WS_MOD = WS_MODP + alup(SZ_MODP);
constexpr size_t WS_X32 = WS_MOD + alup(SZ_MOD), WS_H = WS_X32 + alup(SZ_X32), WS_P = WS_H + alup(SZ_H), WS_Y = WS_P + alup(SZ_P), WS_YP = WS_Y + alup(SZ_Y);
constexpr size_t WS_LIST = WS_YP + alup(SZ_YP), WS_GW = WS_LIST + alup(SZ_LIST), WS_END = WS_GW + alup(SZ_GW);
constexpr int CW_BAR = 4096;
constexpr int CW_CNT = 16384;

constexpr int RING_BYTES = 131072;
constexpr int LDSCTL_OFF = RING_BYTES;
constexpr int LDS_BYTES = 147456;

#define ATTN_STORE16(p,v) (*(u32x4*)(p)=(v))

#define CAS __attribute__((address_space(4)))
__device__ __forceinline__ const float* inp(int i) {
    const CAS unsigned char* k = (const CAS unsigned char*)__builtin_amdgcn_kernarg_segment_ptr();
    asm volatile("" : "+s"(k));
    return *(const float* const CAS*)(k + 8 * i);
}
#define CBAR() do { asm volatile("" ::: "memory"); __builtin_amdgcn_sched_barrier(0); } while (0)
struct Ctx {
    float* out; unsigned char* ws;
    __device__ __forceinline__ const float* x() const { return inp(0); }
    __device__ __forceinline__ const float* c() const { return inp(1); }
    __device__ __forceinline__ const float* ctx() const { return inp(2); }
    __device__ __forceinline__ const float* c_ctx() const { return inp(3); }
    __device__ __forceinline__ const float* ada_w() const { return inp(4); }
    __device__ __forceinline__ const float* ada_b() const { return inp(5); }
    __device__ __forceinline__ const float* norm1() const { return inp(6); }
    __device__ __forceinline__ const float* norm2() const { return inp(7); }
    __device__ __forceinline__ const float* w_in() const { return inp(8); }
    __device__ __forceinline__ const float* w_out() const { return inp(9); }
    __device__ __forceinline__ const float* ret_decay() const { return inp(10); }
    __device__ __forceinline__ const float* win_gain() const { return inp(11); }
    __device__ __forceinline__ const float* win_sink() const { return inp(12); }
    __device__ __forceinline__ const float* glb_gain() const { return inp(13); }
    __device__ __forceinline__ const float* w_router() const { return inp(14); }
    __device__ __forceinline__ const float* b_router() const { return inp(15); }
    __device__ __forceinline__ const float* w_gu() const { return inp(16); }
    __device__ __forceinline__ const float* w_dn() const { return inp(17); }
};

template <int CTRL> __device__ __forceinline__ float dppx(float v) { return __builtin_bit_cast(float, __builtin_amdgcn_update_dpp(0, __builtin_bit_cast(int, v), CTRL, 0xF, 0xF, true)); }
__device__ __forceinline__ float xor1(float v) { return dppx<0xB1>(v); }
__device__ __forceinline__ float xor2(float v) { return dppx<0x4E>(v); }
__device__ __forceinline__ float wave_sum(float v) {
    v += dppx<0xB1>(v); v += dppx<0x4E>(v); v += dppx<0x141>(v); v += dppx<0x140>(v);
    { const unsigned u = __builtin_bit_cast(unsigned, v); auto r = __builtin_amdgcn_permlane16_swap(u, u, false, false); v = __builtin_bit_cast(float, (unsigned)r[0]) + __builtin_bit_cast(float, (unsigned)r[1]); }
    { const unsigned u = __builtin_bit_cast(unsigned, v); auto r = __builtin_amdgcn_permlane32_swap(u, u, false, false); v = __builtin_bit_cast(float, (unsigned)r[0]) + __builtin_bit_cast(float, (unsigned)r[1]); }
    return v;
}
__device__ __forceinline__ float xor16(float v, int lane) { const unsigned u = __builtin_bit_cast(unsigned, v); auto r = __builtin_amdgcn_permlane16_swap(u, u, false, false);
    return __builtin_bit_cast(float, (lane & 16) ? (unsigned)r[0] : (unsigned)r[1]); }
__device__ __forceinline__ float silu_f(float v) { return v * __builtin_amdgcn_rcpf(1.f + __builtin_amdgcn_exp2f(-LOG2E * v)); }
__device__ __forceinline__ float log2_sigmoid(float x) { return -log1pf(expf(-x)) * LOG2E; }

__device__ __forceinline__ void transpose_item(const float* W, int N, int nsrc0, int k0, bf16_t* WT, int K, int nrow0, LAS float* scr, int lane) {
#pragma unroll 8
    for (int i = 0; i < 32; ++i) { const int kk = 2 * i + (lane >> 5); scr[kk * 33 + (lane & 31)] = W[(size_t)(k0 + kk) * N + nsrc0 + (lane & 31)]; }
    asm volatile("s_waitcnt lgkmcnt(0)" ::: "memory");
    const int c = lane & 7;
#pragma unroll
    for (int j = 0; j < 4; ++j) { const int n = (lane >> 3) + 8 * j; const LAS float* s = scr + (8 * c) * 33 + n;
        u32x4 o; o.x = pk2(s[0 * 33], s[1 * 33]); o.y = pk2(s[2 * 33], s[3 * 33]); o.z = pk2(s[4 * 33], s[5 * 33]); o.w = pk2(s[6 * 33], s[7 * 33]);
        *(u32x4*)(WT + (size_t)(nrow0 + n) * K + k0 + 8 * c) = o; }
    asm volatile("s_waitcnt lgkmcnt(0)" ::: "memory");
}
constexpr int IT_WIN = 16 * 80, IT_WOUT = 16 * 32, IT_GU = 16 * 64, IT_DN = 16 * 32, IT_LAYER = IT_WIN + IT_WOUT + NE * (IT_GU + IT_DN);
__device__ __forceinline__ void phase_prologue(const Ctx& C, LAS unsigned char* lds, int G, int vcu, int bx, int tid) {
    const int lane = tid & 63, wave = tid >> 6;
    {
        LAS float* scs = (LAS float*)lds;
        bool have = false;
        for (int it = bx; it < DEPTH * 12 * 16; it += G) {
            if (!have) {
                for (int i = tid; i < 17 * DM; i += 512) { const int r = i >> 10, k = i & 1023; const float v = r < 16 ? C.c()[r * DM + k] : C.c_ctx()[k]; scs[i] = v / (1.f + expf(-v)); }
                __syncthreads(); have = true;
            }
            const int l = it / 192, rem = it % 192, cb = rem / 16, kc = rem % 16;
            const float* w = C.ada_w() + ((size_t)l * DM + kc * 64) * 6144 + cb * 512 + tid;
            float acc[17];
#pragma unroll
            for (int r = 0; r < 17; ++r) acc[r] = 0.f;
#pragma unroll 4
            for (int kk = 0; kk < 64; ++kk) { const float wv = w[(size_t)kk * 6144];
#pragma unroll
                for (int r = 0; r < 17; ++r) acc[r] += scs[r * DM + kc * 64 + kk] * wv; }
            float* mp = (float*)(C.ws + WS_MODP) + ((size_t)(l * 16 + kc) * 17) * 6144 + cb * 512 + tid;
#pragma unroll
            for (int r = 0; r < 17; ++r) mp[(size_t)r * 6144] = acc[r];
        }
        __syncthreads();
    }
    LAS float* scr = (LAS float*)(lds + wave * 16384);
    const int gw = vcu * 8 + wave, NGW = G * 8;
    for (int it = gw; it < DEPTH * IT_LAYER; it += NGW) {
        const int l = it / IT_LAYER; int r = it % IT_LAYER;
        if (r < IT_WIN) { const int kb = r / 80, nb = r % 80;
            transpose_item(C.w_in() + (size_t)l * DM * DIN, DIN, 32 * nb, 64 * kb, (bf16_t*)(C.ws + WS_WIN) + (size_t)l * DIN * DM, DM, 32 * nb, scr, lane); continue; }
        r -= IT_WIN;
        if (r < IT_WOUT) { const int kb = r / 32, nb = r % 32;
            transpose_item(C.w_out() + (size_t)l * DM * DM, DM, 32 * nb, 64 * kb, (bf16_t*)(C.ws + WS_WOUT) + (size_t)l * DM * DM, DM, 32 * nb, scr, lane); continue; }
        r -= IT_WOUT;
        if (r < NE * IT_GU) { const int e = r / IT_GU, q = r % IT_GU, kb = q / 64, nb = q % 64;
            const int np = 32 * nb, tile = np >> 8, within = np & 255, nsrc = within < 128 ? tile * 128 + within : FF + tile * 128 + within - 128;
            transpose_item(C.w_gu() + (size_t)(l * NE + e) * DM * 2 * FF, 2 * FF, nsrc, 64 * kb, (bf16_t*)(C.ws + WS_WGU) + (size_t)(l * NE + e) * 2 * FF * DM, DM, np, scr, lane); continue; }
        r -= NE * IT_GU;
        { const int e = r / IT_DN, q = r % IT_DN, kb = q / 32, nb = q % 32;
            transpose_item(C.w_dn() + (size_t)(l * NE + e) * FF * DM, DM, 32 * nb, 64 * kb, (bf16_t*)(C.ws + WS_WDN) + (size_t)(l * NE + e) * DM * FF, FF, 32 * nb, scr, lane); }
    }
}
__device__ __forceinline__ void phase_modsum(const Ctx& C, int G, int bx, int tid) {
    const float* mp = (const float*)(C.ws + WS_MODP); float* mod = (float*)(C.ws + WS_MOD);
    for (int i = bx * 512 + tid; i < DEPTH * 17 * 6144; i += G * 512) {
        const int l = i / (17 * 6144), rem = i % (17 * 6144), r = rem / 6144, n = rem % 6144;
        float s = C.ada_b()[l * 6144 + n];
#pragma unroll
        for (int kc = 0; kc < 16; ++kc) s += mp[((size_t)(l * 16 + kc) * 17 + r) * 6144 + n];
        mod[i] = s;
    }
}

__device__ __forceinline__ f32x4 bf4(u32x2 a) { return (f32x4){bflo(a.x), bfhi(a.x), bflo(a.y), bfhi(a.y)}; }
__device__ __forceinline__ u32x2 pk4(f32x4 v) { u32x2 w; w.x = pk2(v[0], v[1]); w.y = pk2(v[2], v[3]); return w; }
__device__ __forceinline__ void phase_norm1(const Ctx& C, int layer, int gw, int NGW, int lane) {
    const float* mod = (const float*)(C.ws + WS_MOD) + (size_t)layer * 17 * 6144;
    const float* gain = C.norm1() + layer * DM;
    bf16_t* XR = (bf16_t*)(C.ws + WS_X32); bf16_t* H = (bf16_t*)(C.ws + WS_H); const bf16_t* YP = (const bf16_t*)(C.ws + WS_YP);
    const float* xin = C.x(); const float* cin = C.ctx();
    f32x4 nx[4]; u32x2 nr[4], na[4], nb[4];
#define N1_LOAD(mm) do { const int b_ = (mm) / TPB, t_ = (mm) - b_ * TPB; \
        if (layer == 0) { const f32x4* s_ = (const f32x4*)(t_ < CTX ? cin + ((size_t)b_ * CTX + t_) * DM : xin + ((size_t)b_ * SEQ + (t_ - CTX)) * DM) + lane; \
            _Pragma("unroll") for (int j = 0; j < 4; ++j) nx[j] = s_[64 * j]; } \
        else { const u32x2* s_ = (const u32x2*)(XR + (size_t)(mm) * DM) + lane; const u32x2* y0_ = (const u32x2*)(YP + (size_t)(mm) * 2 * DM) + lane; \
            _Pragma("unroll") for (int j = 0; j < 4; ++j) { nr[j] = s_[64 * j]; na[j] = y0_[64 * j]; nb[j] = y0_[DM / 4 + 64 * j]; } } } while (0)
    if (gw < MROWS) N1_LOAD(gw);
    for (int m = gw; m < MROWS; m += NGW) {
        const int b = m / TPB, t = m - b * TPB, set = t < CTX ? 16 : b;
        f32x4 v[4];
        if (layer == 0) {
#pragma unroll
            for (int j = 0; j < 4; ++j) v[j] = nx[j];
        } else {
            const f32x4* g2 = (const f32x4*)(mod - 17 * 6144 + (size_t)set * 6144 + 5 * DM) + lane;
#pragma unroll
            for (int j = 0; j < 4; ++j) v[j] = bf4(nr[j]) + g2[64 * j] * (bf4(na[j]) + bf4(nb[j]));
        }
        if (m + NGW < MROWS) N1_LOAD(m + NGW);
        u32x2* xo = (u32x2*)(XR + (size_t)m * DM) + lane;
        float ss = 0.f;
#pragma unroll
        for (int j = 0; j < 4; ++j) { xo[64 * j] = pk4(v[j]); ss += (v[j][0] * v[j][0] + v[j][1] * v[j][1]) + (v[j][2] * v[j][2] + v[j][3] * v[j][3]); }
        const float rstd = 1.0f / sqrtf(wave_sum(ss) * (1.f / DM) + EPS);
        const f32x4* gp = (const f32x4*)gain + lane; const f32x4* shp = (const f32x4*)(mod + (size_t)set * 6144) + lane; const f32x4* scp = shp + DM / 4;
        u32x2* ho = (u32x2*)(H + (size_t)m * DM) + lane;
#pragma unroll
        for (int j = 0; j < 4; ++j) ho[64 * j] = pk4((v[j] * rstd) * gp[64 * j] * (scp[64 * j] + 1.0f) + shp[64 * j]);
    }
#undef N1_LOAD
}

__device__ __forceinline__ float swz_xor4(float v) { return __builtin_bit_cast(float, __builtin_amdgcn_ds_swizzle(__builtin_bit_cast(int, v), 0x101F)); }
__device__ __forceinline__ float swz_xor8(float v) { return __builtin_bit_cast(float, __builtin_amdgcn_ds_swizzle(__builtin_bit_cast(int, v), 0x201F)); }
__device__ __forceinline__ void phase_qkprep(const Ctx& C, int layer, int gw, int NGW, int lane, bf16_t* PO) {
    const bf16_t* P = (const bf16_t*)(C.ws + WS_P);
    const int hs = lane >> 3, j = lane & 7;
    const int col0 = (hs < 4 ? C_WQ + 64 * hs : hs < 6 ? C_WK + 64 * (hs - 4) : C_GQ + 64 * (hs - 6)) + 8 * j;
    const int col1 = (hs < 2 ? C_GQ + 128 + 64 * hs : C_GK + 64 * ((hs - 2) & 1)) + 8 * j;
    float g0[8], g1[8], inv[8];
    { const float* wg = C.win_gain() + layer * 128; const float* gg = C.glb_gain() + layer * 128;
      const float* s0p = hs < 4 ? wg : hs < 6 ? wg + 64 : gg; const float sc0 = (hs < 4 || hs >= 6) ? QSCALE : 1.f;
      const float* s1p = hs < 2 ? gg : gg + 64; const float sc1 = hs < 2 ? QSCALE : 1.f;
#pragma unroll
      for (int i = 0; i < 8; ++i) { g0[i] = s0p[8 * j + i] * sc0; g1[i] = s1p[8 * j + i] * sc1; inv[i] = exp2f(-(float)(8 * (j & 1) + i) * (13.287712379549449f / 16.0f)); } }
    const bool x2 = (j & 2) != 0, colax = (j & 4) != 0, act1 = lane < 32;
    u32x4 w0 = {0u, 0u, 0u, 0u}, w1 = {0u, 0u, 0u, 0u};
    if (gw < MROWS) { const bf16_t* row = P + (size_t)gw * DIN; w0 = *(const u32x4*)(row + col0); if (act1) w1 = *(const u32x4*)(row + col1); }
    for (int m = gw; m < MROWS; m += NGW) {
        const u32x4 c0 = w0, c1 = w1;
        if (m + NGW < MROWS) { const bf16_t* row = P + (size_t)(m + NGW) * DIN; w0 = *(const u32x4*)(row + col0); if (act1) w1 = *(const u32x4*)(row + col1); }
        const int b = m / TPB, t = m - b * TPB; const bool isx = t >= CTX; const int pos = t - CTX;
        float cs[8], sn[8];
        if (isx) { const float pv = (float)(colax ? (pos & 63) : (pos >> 6));
#pragma unroll
            for (int i = 0; i < 8; ++i) { const float ang = pv * inv[i]; cs[i] = __cosf(ang); sn[i] = x2 ? __sinf(ang) : -__sinf(ang); } }
        else {
#pragma unroll
            for (int i = 0; i < 8; ++i) { cs[i] = 1.f; sn[i] = 0.f; } }
        bf16_t* orow = PO + (size_t)m * (PO == P ? DIN : 256);
#pragma unroll
        for (int pass = 0; pass < 2; ++pass) {
            const u32x4 w = pass ? c1 : c0;
            float x[8] = {bflo(w.x), bfhi(w.x), bflo(w.y), bfhi(w.y), bflo(w.z), bfhi(w.z), bflo(w.w), bfhi(w.w)};
            float ss = 0.f;
#pragma unroll
            for (int i = 0; i < 8; ++i) ss += x[i] * x[i];
            ss += xor1(ss); ss += xor2(ss); ss += swz_xor4(ss);
            const float r = 1.0f / sqrtf(ss * (1.f / 64.f) + EPS);
            float y[8];
#pragma unroll
            for (int i = 0; i < 8; ++i) { x[i] = x[i] * r * (pass ? g1[i] : g0[i]); }
#pragma unroll
            for (int i = 0; i < 8; ++i) { const float pr = xor2(x[i]); y[i] = x[i] * cs[i] + pr * sn[i]; }
            u32x4 o; o.x = pk2(y[0], y[1]); o.y = pk2(y[2], y[3]); o.z = pk2(y[4], y[5]); o.w = pk2(y[6], y[7]);
            const int col = pass ? col1 : col0;
            if (pass == 0 || act1) *(u32x4*)(orow + (PO == P ? col : (col & 127))) = o;
        }
    }
}

__device__ __forceinline__ void stage_vt(const bf16_t* P, size_t r0, int h, LAS bf16_t* VT, int tid) {
#pragma unroll
    for (int i = 0; i < 4; ++i) { const int p = tid + 512 * i, j = p >> 4, dv0 = (p & 15) * 8;
        const u32x4 w = *(const u32x4*)(P + (r0 + j) * DIN + C_RV + h * 128 + dv0);
        VT[(dv0 + 0) * 136 + j] = (bf16_t)(w.x & 0xffffu); VT[(dv0 + 1) * 136 + j] = (bf16_t)(w.x >> 16);
        VT[(dv0 + 2) * 136 + j] = (bf16_t)(w.y & 0xffffu); VT[(dv0 + 3) * 136 + j] = (bf16_t)(w.y >> 16);
        VT[(dv0 + 4) * 136 + j] = (bf16_t)(w.z & 0xffffu); VT[(dv0 + 5) * 136 + j] = (bf16_t)(w.z >> 16);
        VT[(dv0 + 6) * 136 + j] = (bf16_t)(w.w & 0xffffu); VT[(dv0 + 7) * 136 + j] = (bf16_t)(w.w >> 16); }
}
__device__ __forceinline__ void ret_r1_unit(const Ctx& C, int layer, int b, int h, int c, LAS unsigned char* lds, int tid) {
    const int lane = tid & 63, wid = tid >> 6;
    const bf16_t* P = (const bf16_t*)(C.ws + WS_P); float* KVT = (float*)(C.ws + WS_H);
    LAS bf16_t* KzfT = (LAS bf16_t*)lds; LAS bf16_t* KzbT = KzfT + 64 * 136; LAS bf16_t* VT = KzbT + 64 * 136;
    const float lf = log2_sigmoid(C.ret_decay()[(layer * 2 + 0) * 4 + h]), lb = log2_sigmoid(C.ret_decay()[(layer * 2 + 1) * 4 + h]);
    const size_t r0 = (size_t)b * TPB + c * 128;
#pragma unroll
    for (int i = 0; i < 2; ++i) { const int p = tid + 512 * i, j = p >> 3, dk0 = (p & 7) * 8;
        const u32x4 w = *(const u32x4*)(P + (r0 + j) * DIN + C_RK + h * 64 + dk0);
        const float zf = exp2f((float)(127 - j) * lf) * 0.125f, zb = exp2f((float)j * lb) * 0.125f;
        const float x[8] = {bflo(w.x), bfhi(w.x), bflo(w.y), bfhi(w.y), bflo(w.z), bfhi(w.z), bflo(w.w), bfhi(w.w)};
#pragma unroll
        for (int e = 0; e < 8; ++e) { KzfT[(dk0 + e) * 136 + j] = (bf16_t)f2bf(x[e] * zf); KzbT[(dk0 + e) * 136 + j] = (bf16_t)f2bf(x[e] * zb); } }
    stage_vt(P, r0, h, VT, tid);
    __syncthreads();
    const int mb = wid >> 1, nb = wid & 1, r = lane & 31, hh = lane >> 5;
    float z0 = 0.f; asm volatile("" : "+v"(z0)); f32x16 af, ab;
#pragma unroll
    for (int i = 0; i < 16; ++i) { af[i] = z0; ab[i] = z0; }
#pragma unroll
    for (int ks = 0; ks < 8; ++ks) {
        const bf16x8 a = *(const LAS bf16x8*)(VT + (32 * mb + r) * 136 + 16 * ks + 8 * hh);
        const bf16x8 bf = *(const LAS bf16x8*)(KzfT + (32 * nb + r) * 136 + 16 * ks + 8 * hh);
        const bf16x8 bb = *(const LAS bf16x8*)(KzbT + (32 * nb + r) * 136 + 16 * ks + 8 * hh);
        af = __builtin_amdgcn_mfma_f32_32x32x16_bf16(a, bf, af, 0, 0, 0);
        ab = __builtin_amdgcn_mfma_f32_32x32x16_bf16(a, bb, ab, 0, 0, 0);
    }
    float* of = KVT + ((size_t)((0 * NB + b) * 4 + h) * NCH + c) * 8192; float* ob = KVT + ((size_t)((1 * NB + b) * 4 + h) * NCH + c) * 8192;
#pragma unroll
    for (int reg = 0; reg < 16; ++reg) { const int dv = 32 * mb + (reg & 3) + 8 * (reg >> 2) + 4 * hh, dk = 32 * nb + r; of[dv * 64 + dk] = af[reg]; ob[dv * 64 + dk] = ab[reg]; }
    __syncthreads();
}
__device__ __forceinline__ void ret_r2_unit(const Ctx& C, int layer, int u, int tid) {
    const int q = u & 3, bh = (u >> 2) & 63, dir = u >> 8, b = bh >> 2, h = bh & 3;
    const float G = exp2f(128.f * log2_sigmoid(C.ret_decay()[(layer * 2 + dir) * 4 + h]));
    const size_t base = ((size_t)((dir * NB + b) * 4 + h) * NCH) * 8192 + q * 2048 + tid * 4;
    const float* KVT = (const float*)(C.ws + WS_H) + base; bf16_t* ST = (bf16_t*)(C.ws + WS_YP) + base;
    float z0 = 0.f; asm volatile("" : "+v"(z0)); f32x4 S = {z0, z0, z0, z0};
#pragma unroll
    for (int half = 0; half < 2; ++half) {
        f32x4 kv[17];
#pragma unroll
        for (int s = 0; s < 17; ++s) { const int step = half * 17 + s; const int c = dir == 0 ? step : (step < 2 ? 1 - step : 35 - step); kv[s] = *(const f32x4*)(KVT + (size_t)c * 8192); }
#pragma unroll
        for (int s = 0; s < 17; ++s) { const int step = half * 17 + s; const int c = dir == 0 ? step : (step < 2 ? 1 - step : 35 - step);
            u32x2 w; w.x = pk2(S[0], S[1]); w.y = pk2(S[2], S[3]); *(u32x2*)(ST + (size_t)c * 8192) = w;
            S = S * G + kv[s]; }
    }
}
__device__ __forceinline__ void ret_r3_unit(const Ctx& C, int layer, int b, int h, int c, LAS unsigned char* lds, int tid) {
    const int lane = tid & 63, wid = tid >> 6, r = lane & 31, hh = lane >> 5, wr = wid >> 1, wc = wid & 1;
    const bf16_t* P = (const bf16_t*)(C.ws + WS_P);
    LAS float* tab = (LAS float*)lds;
    LAS bf16_t* VT = (LAS bf16_t*)(lds + 2048); LAS bf16_t* Pl = VT + 128 * 136;
    LAS float* Ol = (LAS float*)(lds + 2048);
    const size_t r0 = (size_t)b * TPB + c * 128;
    if (tid < 128) { const float* dec = C.ret_decay(); const float lf = log2_sigmoid(dec[(layer * 2 + 0) * 4 + h]), lb = log2_sigmoid(dec[(layer * 2 + 1) * 4 + h]);
        tab[tid] = exp2f((float)tid * lf) * 0.125f; tab[128 + tid] = exp2f((float)tid * lb) * 0.125f; tab[256 + tid] = exp2f((float)(tid + 1) * lf); tab[384 + tid] = exp2f((float)(128 - tid) * lb); }
    stage_vt(P, r0, h, VT, tid);
    CBAR();
    bf16x8 qf[4];
    { const bf16_t* Qp = P + (r0 + 32 * wr + r) * DIN + C_RQ + h * 64 + 8 * hh;
#pragma unroll
      for (int ks = 0; ks < 4; ++ks) qf[ks] = *(const bf16x8*)(Qp + 16 * ks); }
    float z0 = 0.f; asm volatile("" : "+v"(z0)); f32x16 zv;
#pragma unroll
    for (int i = 0; i < 16; ++i) zv[i] = z0;
    f32x16 acc[2];
    { const bf16_t* Kp = P + (r0 + 64 * wc + r) * DIN + C_RK + h * 64 + 8 * hh;
#pragma unroll
      for (int t = 0; t < 2; ++t) { acc[t] = zv;
#pragma unroll
        for (int ks = 0; ks < 4; ++ks) acc[t] = __builtin_amdgcn_mfma_f32_32x32x16_bf16(qf[ks], *(const bf16x8*)(Kp + (size_t)t * 32 * DIN + 16 * ks), acc[t], 0, 0, 0); } }
    __syncthreads();
#pragma unroll
    for (int t = 0; t < 2; ++t)
#pragma unroll
        for (int reg = 0; reg < 16; ++reg) { const int i = 32 * wr + (reg & 3) + 8 * (reg >> 2) + 4 * hh, j = 64 * wc + 32 * t + r, d = i - j;
            const float D = d > 0 ? tab[d] : (d < 0 ? tab[128 - d] : tab[0] + tab[128]);
            Pl[i * 136 + j] = (bf16_t)f2bf(acc[t][reg] * D); }
    __syncthreads();
    f32x16 o1[2];
    o1[0] = zv; o1[1] = zv;
#pragma unroll
    for (int ks = 0; ks < 8; ++ks) { const bf16x8 a = *(const LAS bf16x8*)(Pl + (32 * wr + r) * 136 + 16 * ks + 8 * hh);
#pragma unroll
        for (int t = 0; t < 2; ++t) o1[t] = __builtin_amdgcn_mfma_f32_32x32x16_bf16(a, *(const LAS bf16x8*)(VT + (64 * wc + 32 * t + r) * 136 + 16 * ks + 8 * hh), o1[t], 0, 0, 0); }
    CBAR();
#pragma unroll
    for (int dir = 0; dir < 2; ++dir) {
        const bf16_t* sp = (const bf16_t*)(C.ws + WS_YP) + ((size_t)((dir * NB + b) * 4 + h) * NCH + c) * 8192 + (64 * wc + r) * 64 + 8 * hh;
#pragma unroll
        for (int t = 0; t < 2; ++t) { acc[t] = zv;
#pragma unroll
            for (int ks = 0; ks < 4; ++ks) acc[t] = __builtin_amdgcn_mfma_f32_32x32x16_bf16(qf[ks], *(const bf16x8*)(sp + t * 32 * 64 + 16 * ks), acc[t], 0, 0, 0); }
#pragma unroll
        for (int t = 0; t < 2; ++t)
#pragma unroll
            for (int reg = 0; reg < 16; ++reg) { const int i = 32 * wr + (reg & 3) + 8 * (reg >> 2) + 4 * hh; o1[t][reg] += tab[256 + 128 * dir + i] * acc[t][reg]; }
        CBAR();
    }
    __syncthreads();
#pragma unroll
    for (int t = 0; t < 2; ++t)
#pragma unroll
        for (int reg = 0; reg < 16; ++reg) { const int i = 32 * wr + (reg & 3) + 8 * (reg >> 2) + 4 * hh, dv = 64 * wc + 32 * t + r; Ol[i * 132 + dv] = o1[t][reg]; }
    __syncthreads();
    { const int row = tid >> 2, q = tid & 3; f32x4 x[8]; float sm = 0.f;
#pragma unroll
      for (int e = 0; e < 8; ++e) { x[e] = *(const LAS f32x4*)(Ol + row * 132 + 32 * q + 4 * e); sm += (x[e][0] + x[e][1]) + (x[e][2] + x[e][3]); }
      sm += xor1(sm); sm += xor2(sm);
      const float mu = sm * (1.f / 128.f); float vs = 0.f;
#pragma unroll
      for (int e = 0; e < 8; ++e) { x[e] = x[e] - mu; vs += (x[e][0] * x[e][0] + x[e][1] * x[e][1]) + (x[e][2] * x[e][2] + x[e][3] * x[e][3]); }
      vs += xor1(vs); vs += xor2(vs);
      const float rstd = 1.0f / sqrtf(vs * (1.f / 128.f) + EPS);
      const bf16_t* gp = P + (r0 + row) * DIN + C_RG + h * 128 + 32 * q; bf16_t* yp = (bf16_t*)(C.ws + WS_Y) + (r0 + row) * DM + h * 128 + 32 * q;
#pragma unroll
      for (int e2 = 0; e2 < 4; ++e2) { const u32x4 gw = *(const u32x4*)(gp + 8 * e2); const f32x4 a = x[2 * e2] * rstd, bq = x[2 * e2 + 1] * rstd;
          u32x4 o; o.x = pk2(a[0] * silu_f(bflo(gw.x)), a[1] * silu_f(bfhi(gw.x))); o.y = pk2(a[2] * silu_f(bflo(gw.y)), a[3] * silu_f(bfhi(gw.y)));
          o.z = pk2(bq[0] * silu_f(bflo(gw.z)), bq[1] * silu_f(bfhi(gw.z))); o.w = pk2(bq[2] * silu_f(bflo(gw.w)), bq[3] * silu_f(bfhi(gw.w)));
          *(u32x4*)(yp + 8 * e2) = o; } }
    __syncthreads();
}

template <bool WIN>
__device__ __forceinline__ void attn_dispatch(const Ctx& C, int layer, int U, int tid, char* lds) {
    using attn_body::bf16;
    int b, h, q0, NT, tdelta;
    if (U < 1024) { b = U >> 6; h = ((U >> 5) & 1) * 2 + ((U >> 4) & 1); q0 = CTX + 256 * (U & 15);
        if (WIN) { const int ts = (q0 / 64 - 2) > 4 ? (q0 / 64 - 2) : 4, te = (q0 / 64 + 6) < 68 ? (q0 / 64 + 6) : 68; NT = 4 + te - ts; tdelta = ts - 4; } else { NT = 68; tdelta = 0; } }
    else { b = (U - 1024) >> 2; h = (U - 1024) & 3; q0 = 0; NT = 4; tdelta = 0; }
    const int kvh = h >> 1;
    const bf16* Pb = (const bf16*)(C.ws + WS_P) + (size_t)b * TPB * DIN; bf16* Yb = (bf16*)(C.ws + WS_Y) + (size_t)b * TPB * DM;
    if (WIN) attn_body::attn_unit<8, true>(Pb + C_WQ + 64 * h, Pb + C_WK + 64 * kvh, Pb + C_WV + 64 * kvh, Yb + 512 + 64 * h, q0, NT, tdelta, C.win_sink()[layer * 4 + h] * LOG2E, tid, lds);
    else     attn_body::attn_unit<8, false>(Pb + C_GQ + 64 * h, Pb + C_GK + 64 * kvh, Pb + C_GV + 64 * kvh, Yb + 768 + 64 * h, q0, NT, tdelta, 0.f, tid, lds);
}
template <bool WIN>
__device__ __forceinline__ void attn_units(const Ctx& C, int layer, int G, int vcu, int bx, int tid, char* lds) {
    const int nctx = (layer == DEPTH - 1) ? 0 : 64;
    if (G == 256) {
        for (int k = 0; k < 4; ++k) attn_dispatch<WIN>(C, layer, vcu * 4 + k, tid, lds);
        if (vcu < nctx) attn_dispatch<WIN>(C, layer, 1024 + vcu, tid, lds);
    } else {
        for (int U = bx; U < 1024 + nctx; U += G) attn_dispatch<WIN>(C, layer, U, tid, lds);
    }
}

__device__ __forceinline__ f32x2 swap32(float a, float b) { auto r = __builtin_amdgcn_permlane32_swap(__builtin_bit_cast(unsigned, a), __builtin_bit_cast(unsigned, b), false, false);
    return (f32x2){__builtin_bit_cast(float, (unsigned)r[0]), __builtin_bit_cast(float, (unsigned)r[1])}; }
__device__ __forceinline__ f32x2 swap16(float a, float b) { auto r = __builtin_amdgcn_permlane16_swap(__builtin_bit_cast(unsigned, a), __builtin_bit_cast(unsigned, b), false, false);
    return (f32x2){__builtin_bit_cast(float, (unsigned)r[0]), __builtin_bit_cast(float, (unsigned)r[1])}; }
__device__ __forceinline__ void phase_norm2_route(const Ctx& C, int layer_c, LAS unsigned char* lds, int G, int bx, int tid) {
    const int layer = layer_c & 3;
    const int lane = tid & 63, wave = tid >> 6;
    const float* mod = (const float*)(C.ws + WS_MOD) + (size_t)layer * 17 * 6144;
    const float* gain = C.norm2() + layer * DM;
    const bf16_t* XR = (const bf16_t*)(C.ws + WS_X32); bf16_t* H = (bf16_t*)(C.ws + WS_H);
    int* list = (int*)(C.ws + WS_LIST); float* GW = (float*)(C.ws + WS_GW);
    unsigned* gcnt = (unsigned*)(C.ws + WS_CTL) + CW_CNT + 64 * layer_c;
    constexpr int RPC = MROWS / 256, RPW = RPC / 8;
    LAS float* wrT = (LAS float*)lds;
    LAS float* lgs = (LAS float*)(lds + 65536);
    LAS int* lcnt = (LAS int*)(lds + 65536 + RPC * 64);
    LAS int* lbase = lcnt + 16;
    LAS int* rec_e = lcnt + 32;
    LAS float* rec_w = (LAS float*)(rec_e + 2 * RPC);
    { const float* wr = C.w_router(); for (int i = tid; i < DM * NE; i += 512) { const int k = i >> 4, e = i & 15; wrT[e * DM + k] = wr[i]; } }
    if (tid < 16) lcnt[tid] = 0;
    __syncthreads();
    const unsigned lo8 = (unsigned)lane * 8u, lo16 = (unsigned)lane * 16u;
#define E_LOADROW(dst, mm) do { const char* xr_ = (const char*)(XR + (size_t)(mm) * DM); _Pragma("unroll") for (int j = 0; j < 4; ++j) dst[j] = *(const u32x2*)(xr_ + (lo8 + 512u * j)); } while (0)
#define E_NORMROW(v, nxr, mm) do { float ss_ = 0.f; _Pragma("unroll") for (int j = 0; j < 4; ++j) { v[j] = bf4(nxr[j]); ss_ += (v[j][0] * v[j][0] + v[j][1] * v[j][1]) + (v[j][2] * v[j][2] + v[j][3] * v[j][3]); } \
        const int b_ = (mm) / TPB, t_ = (mm) - b_ * TPB, set_ = t_ < CTX ? 16 : b_; const float rstd_ = 1.0f / sqrtf(wave_sum(ss_) * (1.f / DM) + EPS); \
        const char* gp_ = (const char*)gain; const char* shp_ = (const char*)(mod + (size_t)set_ * 6144 + 3 * DM); const char* scp_ = shp_ + DM * 4; \
        char* ho_ = (char*)(H + (size_t)(mm) * DM); \
        _Pragma("unroll") for (int j = 0; j < 4; ++j) { v[j] = (v[j] * rstd_) * *(const f32x4*)(gp_ + (lo16 + 1024u * j)) * (*(const f32x4*)(scp_ + (lo16 + 1024u * j)) + 1.0f) + *(const f32x4*)(shp_ + (lo16 + 1024u * j)); \
            *(u32x2*)(ho_ + (lo8 + 512u * j)) = pk4(v[j]); } } while (0)
#define E_REDUCE(pe, rowl) do { float q8_[8], q4_[4], q2_[2]; \
        _Pragma("unroll") for (int e = 0; e < 8; ++e) { const f32x2 r_ = swap32(pe[e], pe[e + 8]); q8_[e] = r_[0] + r_[1]; } \
        _Pragma("unroll") for (int e = 0; e < 4; ++e) { const f32x2 r_ = swap16(q8_[e], q8_[e + 4]); q4_[e] = r_[0] + r_[1]; } \
        _Pragma("unroll") for (int e = 0; e < 2; ++e) { const float keep_ = b3 ? q4_[e + 2] : q4_[e], send_ = b3 ? q4_[e] : q4_[e + 2]; q2_[e] = keep_ + swz_xor8(send_); } \
        float lg_ = (b2 ? q2_[1] : q2_[0]) + swz_xor4(b2 ? q2_[0] : q2_[1]); lg_ += xor2(lg_); lg_ += xor1(lg_); \
        if ((lane & 3) == 0) lgs[(rowl) * 16 + (lane >> 2)] = lg_; } while (0)
    const bool b3 = (lane & 8) != 0, b2 = (lane & 4) != 0;
    for (int chunk = bx; chunk < 256; chunk += G) {
        const int m0 = chunk * RPC + wave * RPW;
        u32x2 nxA[4], nxB[4];
        E_LOADROW(nxA, m0); E_LOADROW(nxB, m0 + 1);
        for (int i = 0; i < RPW; i += 2) {
            f32x4 vA[4], vB[4];
            E_NORMROW(vA, nxA, m0 + i);
            if (i + 2 < RPW) E_LOADROW(nxA, m0 + i + 2);
            E_NORMROW(vB, nxB, m0 + i + 1);
            if (i + 2 < RPW) E_LOADROW(nxB, m0 + i + 3);
            float peA[16], peB[16];
            f32x2 hv[4][4];
#pragma unroll
            for (int j = 0; j < 4; ++j)
#pragma unroll
                for (int c = 0; c < 4; ++c) hv[j][c] = (f32x2){vA[j][c], vB[j][c]};
            const LAS float* wl = wrT + 4 * lane; asm volatile("" : "+v"(wl));
#pragma unroll
            for (int e = 0; e < 16; ++e) { f32x2 a2 = {0.f, 0.f};
#pragma unroll
                for (int j = 0; j < 4; ++j) { const f32x4 w = *(const LAS f32x4*)(wl + e * DM + 256 * j);
#pragma unroll
                    for (int c = 0; c < 4; ++c) a2 = __builtin_elementwise_fma(hv[j][c], (f32x2){w[c], w[c]}, a2); }
                peA[e] = a2[0]; peB[e] = a2[1]; }
            E_REDUCE(peA, wave * RPW + i); E_REDUCE(peB, wave * RPW + i + 1);
        }
#undef E_LOADROW
#undef E_NORMROW
#undef E_REDUCE
        asm volatile("s_waitcnt lgkmcnt(0)" ::: "memory");
        if (lane < RPW) {
            const int rl = wave * RPW + lane; const float* br = C.b_router();
            float sg[16], bs[16];
#pragma unroll
            for (int e4 = 0; e4 < 4; ++e4) { const f32x4 l4 = *(const LAS f32x4*)(lgs + rl * 16 + 4 * e4);
#pragma unroll
                for (int k = 0; k < 4; ++k) { sg[4 * e4 + k] = 1.f / (1.f + expf(-l4[k])); bs[4 * e4 + k] = sg[4 * e4 + k] + br[4 * e4 + k]; } }
            int grp = 0; float best = -1e30f;
#pragma unroll
            for (int g = 0; g < 4; ++g) { const float a0 = bs[4 * g], a1 = bs[4 * g + 1], a2 = bs[4 * g + 2], a3 = bs[4 * g + 3];
                const float hi01 = fmaxf(a0, a1), lo01 = fminf(a0, a1), hi23 = fmaxf(a2, a3), lo23 = fminf(a2, a3);
                const float top = fmaxf(hi01, hi23), second = fmaxf(fminf(hi01, hi23), hi01 >= hi23 ? lo01 : lo23);
                const float sc = top + second; if (sc > best) { best = sc; grp = g; } }
            float c4[4], s4[4];
#pragma unroll
            for (int k = 0; k < 4; ++k) { c4[k] = grp == 0 ? bs[k] : grp == 1 ? bs[4 + k] : grp == 2 ? bs[8 + k] : bs[12 + k]; s4[k] = grp == 0 ? sg[k] : grp == 1 ? sg[4 + k] : grp == 2 ? sg[8 + k] : sg[12 + k]; }
            int l0 = 0; float mx0 = c4[0];
#pragma unroll
            for (int k = 1; k < 4; ++k) if (c4[k] > mx0) { mx0 = c4[k]; l0 = k; }
            int l1 = -1; float mx1 = -1e30f;
#pragma unroll
            for (int k = 0; k < 4; ++k) if (k != l0 && c4[k] > mx1) { mx1 = c4[k]; l1 = k; }
            const float w0 = l0 == 0 ? s4[0] : l0 == 1 ? s4[1] : l0 == 2 ? s4[2] : s4[3], w1 = l1 == 0 ? s4[0] : l1 == 1 ? s4[1] : l1 == 2 ? s4[2] : s4[3];
            const float wn = 1.f / (w0 + w1);
            const int e0 = grp * 4 + l0, e1 = grp * 4 + l1;
            const int p0 = __hip_atomic_fetch_add(lcnt + e0, 1, __ATOMIC_RELAXED, __HIP_MEMORY_SCOPE_WORKGROUP);
            const int p1 = __hip_atomic_fetch_add(lcnt + e1, 1, __ATOMIC_RELAXED, __HIP_MEMORY_SCOPE_WORKGROUP);
            rec_e[2 * rl] = e0 | (p0 << 8); rec_e[2 * rl + 1] = e1 | (p1 << 8); rec_w[2 * rl] = w0 * wn; rec_w[2 * rl + 1] = w1 * wn;
        }
        __syncthreads();
        if (tid < 16) lbase[tid] = (int)__hip_atomic_fetch_add(gcnt + tid, (unsigned)lcnt[tid], __ATOMIC_RELAXED, __HIP_MEMORY_SCOPE_AGENT);
        __syncthreads();
        for (int i = tid; i < 2 * RPC; i += 512) { const int re = rec_e[i], e = re & 255, pp = re >> 8; const int id = (chunk * RPC + (i >> 1)) * 2 + (i & 1);
            list[e * MROWS + lbase[e] + pp] = id; GW[id] = rec_w[i]; }
        __syncthreads();
        if (tid < 16) lcnt[tid] = 0;
        __syncthreads();
    }
}

template <bool GATHER_, int NT>
struct MoeOrder {
    static constexpr bool GATHER = GATHER_;
    const int* list; const LAS int* boff; const LAS int* cnt; int G, c;
    __device__ __forceinline__ bool next(int i, pg8::Unit& u) const {
        const int L = i * G + c; if (L >= boff[16] * NT) return false;
        const int blk = L / NT, pn = L - blk * NT; int e = 0;
#pragma unroll
        for (int k = 1; k < 16; ++k) e += (blk >= boff[k]) ? 1 : 0;
        u.pm = blk; u.pn = e * NT + pn; return true;
    }
    __device__ __forceinline__ unsigned arow(const pg8::Unit& u, int r) const {
        const int e = u.pn / NT, li = (u.pm - boff[e]) * 256 + r;
        const int id = li < cnt[e] ? list[e * MROWS + li] : 0;
        return (unsigned)(id >> 1);
    }
};
struct EpiGateUp {
    static constexpr bool PERM = true;
    bf16_t* O;
    __device__ __forceinline__ void operator()(const f32x4 (&acc)[2][2][4][2], const pg8::Unit& u, int wr, int wc, int fr, int fq) const {
        const int row0 = u.pm * 256 + wr * 64 + fr, col0 = (u.pn & 7) * 128 + wc * 32 + 8 * fq;
#pragma unroll
        for (int ai = 0; ai < 2; ++ai)
#pragma unroll
            for (int m = 0; m < 4; ++m) { const f32x4 a0 = acc[ai][0][m][0], a1 = acc[ai][0][m][1], u0 = acc[ai][1][m][0], u1 = acc[ai][1][m][1];
                u32x4 w; w.x = pk2(silu_f(a0[0]) * u0[0], silu_f(a0[1]) * u0[1]); w.y = pk2(silu_f(a0[2]) * u0[2], silu_f(a0[3]) * u0[3]);
                w.z = pk2(silu_f(a1[0]) * u1[0], silu_f(a1[1]) * u1[1]); w.w = pk2(silu_f(a1[2]) * u1[2], silu_f(a1[3]) * u1[3]);
                *(u32x4*)((char*)O + ((unsigned)(row0 + ai * 128 + m * 16) * (unsigned)FF + (unsigned)col0) * 2u) = w; }
    }
};
struct EpiDown {
    static constexpr bool PERM = true;
    bf16_t* YP; const float* GW; const int* list; const LAS int* boff; const LAS int* cnt;
    __device__ __forceinline__ void operator()(const f32x4 (&acc)[2][2][4][2], const pg8::Unit& u, int wr, int wc, int fr, int fq) const {
        const int e = u.pn >> 2, lb = (u.pm - boff[e]) * 256, n = cnt[e]; const int col0 = (u.pn & 3) * 256 + wc * 32 + 8 * fq;
#pragma unroll
        for (int ai = 0; ai < 2; ++ai)
#pragma unroll
            for (int m = 0; m < 4; ++m) { const int li = lb + ai * 128 + wr * 64 + m * 16 + fr;
                if (li < n) { const int id = list[e * MROWS + li]; const float g = GW[id]; const unsigned off = ((unsigned)id * (unsigned)DM + (unsigned)col0) * 2u;
#pragma unroll
                    for (int bj = 0; bj < 2; ++bj) { const f32x4 v0 = acc[ai][bj][m][0] * g, v1 = acc[ai][bj][m][1] * g;
                        u32x4 w; w.x = pk2(v0[0], v0[1]); w.y = pk2(v0[2], v0[3]); w.z = pk2(v1[0], v1[1]); w.w = pk2(v1[2], v1[3]); *(u32x4*)((char*)YP + off + bj * 256) = w; } } }
    }
};
__device__ __forceinline__ void moe_offsets(const Ctx& C, int layer, LAS int* boff, LAS int* cnt, int tid) {
    if (tid == 0) { const unsigned* gcnt = (const unsigned*)(C.ws + WS_CTL) + CW_CNT + 64 * layer; int acc = 0;
        for (int e = 0; e < 16; ++e) { const int n = (int)__hip_atomic_load(gcnt + e, __ATOMIC_RELAXED, __HIP_MEMORY_SCOPE_AGENT); cnt[e] = n; boff[e] = acc; acc += (n + 255) >> 8; }
        boff[16] = acc; }
    __syncthreads();
}

__device__ __forceinline__ void phase_final(const Ctx& C, int gw, int NGW, int lane) {
    const float* mod = (const float*)(C.ws + WS_MOD) + (size_t)(DEPTH - 1) * 17 * 6144;
    const bf16_t* XR = (const bf16_t*)(C.ws + WS_X32); const bf16_t* YP = (const bf16_t*)(C.ws + WS_YP);
    for (int r = gw; r < NB * SEQ; r += NGW) {
        const int b = r / SEQ, t = r - b * SEQ; const size_t m = (size_t)b * TPB + CTX + t;
        const u32x2* xr = (const u32x2*)(XR + m * DM) + lane; const u32x2* y0 = (const u32x2*)(YP + m * 2 * DM) + lane; const u32x2* y1 = y0 + DM / 4;
        const f32x4* g2 = (const f32x4*)(mod + (size_t)b * 6144 + 5 * DM) + lane; f32x4* o = (f32x4*)(C.out + (size_t)r * DM) + lane;
        u32x2 a[4], bb[4], x[4];
#pragma unroll
        for (int j = 0; j < 4; ++j) { x[j] = xr[64 * j]; a[j] = y0[64 * j]; bb[j] = y1[64 * j]; }
#pragma unroll
        for (int j = 0; j < 4; ++j) o[64 * j] = bf4(x[j]) + g2[64 * j] * (bf4(a[j]) + bf4(bb[j]));
    }
}

#ifndef PHMASK
#define PHMASK 0xFFFF
#endif
#ifndef MK_ONE_LAUNCH
#define MK_ONE_LAUNCH 1
#endif
constexpr int PH_PER_LAYER = 9, PH_LAYER0 = 2, PH_FINAL = PH_LAYER0 + DEPTH * PH_PER_LAYER, PH_COUNT = PH_FINAL + 1;
struct Args { const float* in[18]; float* out; unsigned char* ws; int ph_lo, ph_hi, flags, pad; };
__global__ void __launch_bounds__(512, 2) mega_fwd(Args args) {
    extern __shared__ __attribute__((aligned(16))) unsigned char lds_raw[];
    LAS unsigned char* lds = (LAS unsigned char*)lds_raw;
    Ctx C; C.out = args.out; C.ws = args.ws;
    const int tid = threadIdx.x, lane = tid & 63, wave = __builtin_amdgcn_readfirstlane(tid >> 6);
    const int G = gridDim.x; const int bx = blockIdx.x; const int vcu = (G % 8 == 0) ? (bx % 8) * (G / 8) + bx / 8 : bx;
    const int gw = vcu * 8 + wave, NGW = G * 8;
    volatile LAS unsigned* MISC = (volatile LAS unsigned*)(lds + LDSCTL_OFF);
    for (int u = tid; u < (LDS_BYTES - LDSCTL_OFF) / 4; u += 512) ((LAS unsigned*)(lds + LDSCTL_OFF))[u] = 0u;
    __syncthreads();
    const int lo = args.ph_lo, hi = args.ph_hi;
    XcdBarrier bar; bar.bar = (unsigned*)(C.ws + WS_CTL) + CW_BAR; bar.x = 0; bar.st = nullptr;
    if (hi - lo > 1) bar = xcd_barrier_post((unsigned*)(C.ws + WS_CTL) + CW_BAR, MISC);
#define IN(k) (lo <= (k) && (k) < hi)
#define PHASE_IDS() int bx_ = bx, wave_ = wave; LAS unsigned char* lds_ = lds; asm volatile("" : "+s"(bx_), "+s"(wave_), "+s"(lds_)); int lane_; asm volatile("v_mbcnt_lo_u32_b32 %0, -1, 0\n\tv_mbcnt_hi_u32_b32 %0, -1, %0" : "=v"(lane_)); const int tid_ = wave_ * 64 + lane_; \
    const int vcu_ = (G % 8 == 0) ? (bx_ % 8) * (G / 8) + bx_ / 8 : bx_; const int gw_ = vcu_ * 8 + wave_; (void)lane_; (void)gw_; (void)vcu_
#define SEAM(k) do { if (IN(k) && IN((k) + 1)) xcd_barrier(bar); } while (0)

    if (IN(0) && (PHMASK & 1)) { PHASE_IDS(); phase_prologue(C, lds_, G, vcu_, bx_, tid_); } SEAM(0);
    if (IN(1) && (PHMASK & 2)) { PHASE_IDS(); phase_modsum(C, G, bx_, tid_); } SEAM(1);

#ifdef LAYER_UNROLL
#pragma unroll
#else
#pragma nounroll
#endif
    for (int layer = 0; layer < DEPTH; ++layer) {
        const int p0 = PH_LAYER0 + layer * PH_PER_LAYER;
        if (IN(p0 + 0) && (PHMASK & 4)) { PHASE_IDS(); phase_norm1(C, layer, gw_, NGW, lane_); } SEAM(p0 + 0);
        if (IN(p0 + 1) && (PHMASK & 8)) {
            pg8::Gemm g{(const bf16_t*)(C.ws + WS_H), (const bf16_t*)(C.ws + WS_WIN) + (size_t)layer * DIN * DM, MROWS, DIN, DM};
            PHASE_IDS(); pg8::StaticOrder S; S.init(MROWS, DIN, G, bx_);
            pg8::EpiBf16 E{(bf16_t*)(C.ws + WS_P), DIN};
            pg8::gemm_phase<pg8::EpiBf16, pg8::StaticOrder, true>(lds_, g, S, E, tid_);
        } SEAM(p0 + 1);
        if (IN(p0 + 2) && (PHMASK & 16)) {
            PHASE_IDS(); if (!(args.flags & 1)) phase_qkprep(C, layer, gw_, NGW, lane_, (args.flags & 8) ? (bf16_t*)(C.ws + WS_Y) : (bf16_t*)(C.ws + WS_P));
            if (!(args.flags & 8)) for (int u = bx_; u < NB * 4 * NCH; u += G) { const int c = u % NCH, bh = u / NCH; ret_r1_unit(C, layer, bh >> 2, bh & 3, c, lds_, tid_); }
        } SEAM(p0 + 2);
        if (IN(p0 + 3) && (PHMASK & 32)) {
            PHASE_IDS(); for (int u = bx_; u < 512; u += G) ret_r2_unit(C, layer, u, tid_);
            attn_units<false>(C, layer, G, vcu_, bx_, tid_, (char*)lds_);
        } SEAM(p0 + 3);
        if (IN(p0 + 4) && (PHMASK & 64)) {
            PHASE_IDS();
#ifndef NO_WIN
            attn_units<true>(C, layer, G, vcu_, bx_, tid_, (char*)lds_);
#endif
#ifndef NO_R3
            for (int u = bx_; u < NB * 4 * NCH; u += G) { const int c = u % NCH, bh = u / NCH; ret_r3_unit(C, layer, bh >> 2, bh & 3, c, lds_, tid_); }
#endif
        } SEAM(p0 + 4);
        if (IN(p0 + 5) && (PHMASK & 128)) {
            pg8::Gemm g{(const bf16_t*)(C.ws + WS_Y), (const bf16_t*)(C.ws + WS_WOUT) + (size_t)layer * DM * DM, MROWS, DM, DM};
            PHASE_IDS(); pg8::StaticOrder S; S.init(MROWS, DM, G, bx_);
            pg8::EpiResid E{(bf16_t*)(C.ws + ((args.flags & 4) ? WS_P : WS_X32)), (const float*)(C.ws + WS_MOD) + (size_t)layer * 17 * 6144 + 2 * DM};
            pg8::gemm_phase<pg8::EpiResid, pg8::StaticOrder, true>(lds_, g, S, E, tid_);
        } SEAM(p0 + 5);
        if (IN(p0 + 6) && (PHMASK & 256)) { PHASE_IDS(); phase_norm2_route(C, layer + ((args.flags & 2) ? 4 : 0), lds_, G, bx_, tid_); } SEAM(p0 + 6);
        if (IN(p0 + 7) && (PHMASK & 512)) {
            PHASE_IDS(); LAS int* boff = (LAS int*)(lds_ + LDSCTL_OFF + 64); LAS int* mcnt = (LAS int*)(lds_ + LDSCTL_OFF + 192); moe_offsets(C, layer, boff, mcnt, tid_);
            pg8::Gemm g{(const bf16_t*)(C.ws + WS_H), (const bf16_t*)(C.ws + WS_WGU) + (size_t)layer * NE * 2 * FF * DM, 0, 2 * FF, DM};
            MoeOrder<true, 8> S{(const int*)(C.ws + WS_LIST), boff, mcnt, G, bx_};
            EpiGateUp E{(bf16_t*)(C.ws + WS_P)};
            pg8::gemm_phase<EpiGateUp, MoeOrder<true, 8>, true>(lds_, g, S, E, tid_);
        } SEAM(p0 + 7);
        if (IN(p0 + 8) && (PHMASK & 1024)) {
            PHASE_IDS(); LAS int* boff = (LAS int*)(lds_ + LDSCTL_OFF + 64); LAS int* mcnt = (LAS int*)(lds_ + LDSCTL_OFF + 192); moe_offsets(C, layer, boff, mcnt, tid_);
            pg8::Gemm g{(const bf16_t*)(C.ws + WS_P), (const bf16_t*)(C.ws + WS_WDN) + (size_t)layer * NE * DM * FF, 0, DM, FF};
            MoeOrder<false, 4> S{(const int*)(C.ws + WS_LIST), boff, mcnt, G, bx_};
            EpiDown E{(bf16_t*)(C.ws + WS_YP), (const float*)(C.ws + WS_GW), (const int*)(C.ws + WS_LIST), boff, mcnt};
            pg8::gemm_phase<EpiDown, MoeOrder<false, 4>, true>(lds_, g, S, E, tid_);
        } SEAM(p0 + 8);
    }
    if (IN(PH_FINAL) && (PHMASK & 2048)) { PHASE_IDS(); phase_final(C, gw_, NGW, lane_); }
#undef IN
#undef SEAM
}

extern "C" void kernel_launch(void* const* d_in, const int* in_sizes, int n_in, void* d_out, int out_size, void* d_ws, size_t ws_size, hipStream_t stream) {
    static int grid = 0;
    if (grid == 0) {
        if (n_in != 18 || in_sizes[0] != NB * SEQ * DM || out_size != NB * SEQ * DM || ws_size < WS_END) {
            fprintf(stderr, "kernel_launch: unexpected shapes (n_in %d, in0 %d, out %d, ws %zu, need %zu); nothing launched\n", n_in, n_in > 0 ? in_sizes[0] : -1, out_size, ws_size, (size_t)WS_END); grid = -1; return; }
        int dev = 0, cus = 0, per_cu = 0;
        if (hipGetDevice(&dev) != hipSuccess || hipDeviceGetAttribute(&cus, hipDeviceAttributeMultiprocessorCount, dev) != hipSuccess) { grid = -1; return; }
        if (hipFuncSetAttribute((const void*)mega_fwd, hipFuncAttributeMaxDynamicSharedMemorySize, LDS_BYTES) != hipSuccess) { fprintf(stderr, "kernel_launch: hipFuncSetAttribute failed\n"); grid = -1; return; }
        if (hipOccupancyMaxActiveBlocksPerMultiprocessor(&per_cu, (const void*)mega_fwd, 512, LDS_BYTES) != hipSuccess || per_cu < 1) fprintf(stderr, "kernel_launch: occupancy query says %d\n", per_cu);
        (void)hipGetLastError();
        grid = cus;
    }
    if (grid < 0) return;
    if (hipMemsetAsync((char*)d_ws + WS_CTL, 0, CTL_BYTES, stream) != hipSuccess) return;
    Args a{};
    for (int i = 0; i < 18; ++i) a.in[i] = (const float*)d_in[i];
    a.out = (float*)d_out; a.ws = (unsigned char*)d_ws;
#if MK_ONE_LAUNCH
    a.ph_lo = 0; a.ph_hi = PH_COUNT;
    hipLaunchKernelGGL(mega_fwd, dim3(grid), dim3(512), LDS_BYTES, stream, a);
#else
    for (int p = 0; p < PH_COUNT; ++p) { a.ph_lo = p; a.ph_hi = p + 1;
#if !defined(PROBE_P) || !PROBE_BEFORE
        hipLaunchKernelGGL(mega_fwd, dim3(grid), dim3(512), LDS_BYTES, stream, a);
#endif
#ifdef PROBE_P
        const bool hit = (PROBE_P < 2) ? (p == PROBE_P) : (p >= PH_LAYER0 && p < PH_FINAL && (p - PH_LAYER0) % PH_PER_LAYER == PROBE_P - 2 && (!PROBE_L0 || p < PH_LAYER0 + PH_PER_LAYER));
        if (hit) { a.flags = PROBE_FLAGS; for (int r = 0; r < PROBE_REP; ++r) hipLaunchKernelGGL(mega_fwd, dim3(grid), dim3(512), LDS_BYTES, stream, a); a.flags = 0; }
#if PROBE_BEFORE
        hipLaunchKernelGGL(mega_fwd, dim3(grid), dim3(512), LDS_BYTES, stream, a);
#endif
#endif
    }
#endif
}
```

```cpp
#define MK_ONE_LAUNCH 1
#include <hip/hip_runtime.h>
#include <cstdio>
#include <cstdint>

#define GAS __attribute__((address_space(1)))
#define LAS __attribute__((address_space(3)))
typedef unsigned short bf16_t;
typedef short bf16x8 __attribute__((ext_vector_type(8)));
typedef float f32x4 __attribute__((ext_vector_type(4)));
typedef float f32x2 __attribute__((ext_vector_type(2)));
typedef float f32x16 __attribute__((ext_vector_type(16)));
typedef unsigned u32x4 __attribute__((ext_vector_type(4)));
typedef unsigned u32x2 __attribute__((ext_vector_type(2)));

constexpr int DM = 1024, NB = 16, SEQ = 4096, CTX = 256, TPB = SEQ + CTX, MROWS = NB * TPB, DEPTH = 4;
constexpr int DIN = 2560;
constexpr int C_RQ = 0, C_RK = 256, C_RV = 512, C_RG = 1024, C_WQ = 1536, C_WK = 1792, C_WV = 1920, C_GQ = 2048, C_GK = 2304, C_GV = 2432;
constexpr int NE = 16, FF = 1024, NCH = TPB / 128;
constexpr float EPS = 1e-6f;
constexpr float LOG2E = 1.4426950408889634f;
constexpr float QSCALE = 0.125f * LOG2E;

__device__ __forceinline__ unsigned f2bf(float f) { unsigned u = __builtin_bit_cast(unsigned, f); return (u + 0x7fffu + ((u >> 16) & 1u)) >> 16; }
__device__ __forceinline__ unsigned pk2(float lo, float hi) { return f2bf(lo) | (f2bf(hi) << 16); }
__device__ __forceinline__ float bf2f(unsigned short h) { return __builtin_bit_cast(float, (unsigned)h << 16); }
__device__ __forceinline__ float bflo(unsigned w) { return __builtin_bit_cast(float, w << 16); }
__device__ __forceinline__ float bfhi(unsigned w) { return __builtin_bit_cast(float, w & 0xffff0000u); }

namespace pg8 {
constexpr int BM = 256, BK = 64, HALF = 128, HTB = HALF * BK * 2, STAGE_BYTES = 8 * HTB, NXCD = 8, WGM = 8;
__host__ __device__ __forceinline__ int lds_byte(int r, int c) { const int st = (r >> 4) * 2 + (c >> 5), rr = r & 15, cc = c & 31, ob = rr * 64 + cc * 2; return st * 1024 + (ob ^ (((ob >> 9) & 1) << 5)); }
__host__ __device__ __forceinline__ void stage_rc(int b, int& R, int& C) { const int st = b / 1024, sb = b % 1024, swz = sb ^ (((sb >> 9) & 1) << 5); R = (st >> 1) * 16 + swz / 64; C = (st & 1) * 32 + (swz % 64) / 2; }
__host__ __device__ __forceinline__ int perm32(int rho) { const int n = rho >> 4, i = rho & 15; return 8 * (i >> 2) + 4 * n + (i & 3); }

struct Unit { int pm, pn; };
struct Gemm { const bf16_t* A; const bf16_t* Bt; int M, N, K; };

struct StaticOrder {
    static constexpr bool GATHER = false;
    int nM, nN, nwg, G, c;
    __device__ void init(int M, int N, int G_, int c_) { nM = M / BM; nN = N / BM; nwg = nM * nN; G = G_; c = c_; }
    __device__ bool next(int i, Unit& u) const {
        const long L = (long)i * G + c; if (L >= nwg) return false;
        int wgid = (int)L; { const int q = nwg / NXCD, r = nwg % NXCD, xcd = wgid % NXCD, off = wgid / NXCD; wgid = (xcd < r ? xcd * (q + 1) : r * (q + 1) + (xcd - r) * q) + off; }
        const int nig = WGM * nN, gid = wgid / nig, fm = gid * WGM, gsz = (nM - fm) < WGM ? (nM - fm) : WGM;
        u.pm = fm + ((wgid % nig) % gsz); u.pn = (wgid % nig) / gsz; return true;
    }
    __device__ __forceinline__ unsigned arow(const Unit&, int) const { return 0u; }
};

__device__ __forceinline__ unsigned cvt_pk_bf16(float lo, float hi) { unsigned r; asm volatile("v_cvt_pk_bf16_f32 %0, %1, %2" : "=v"(r) : "v"(lo), "v"(hi)); return r; }

struct EpiBf16 {
    static constexpr bool PERM = true;
    bf16_t* O; int ldc;
    __device__ __forceinline__ void operator()(const f32x4 (&acc)[2][2][4][2], const Unit& u, int wr, int wc, int fr, int fq) const {
        const int row0 = u.pm * BM + wr * 64 + fr; const int col0 = u.pn * BM + wc * 32 + 8 * fq;
#pragma unroll
        for (int ai = 0; ai < 2; ++ai)
#pragma unroll
            for (int m = 0; m < 4; ++m) { const unsigned off = ((unsigned)(row0 + ai * HALF + m * 16) * (unsigned)ldc + (unsigned)col0) * 2u;
#pragma unroll
                for (int bj = 0; bj < 2; ++bj) { const f32x4 v0 = acc[ai][bj][m][0], v1 = acc[ai][bj][m][1];
                    u32x4 w; w.x = cvt_pk_bf16(v0[0], v0[1]); w.y = cvt_pk_bf16(v0[2], v0[3]); w.z = cvt_pk_bf16(v1[0], v1[1]); w.w = cvt_pk_bf16(v1[2], v1[3]);
                    *(u32x4*)((char*)O + off + bj * HALF * 2) = w; } }
    }
};

struct EpiResid {
    static constexpr bool PERM = true;
    bf16_t* X; const float* gate;
    __device__ __forceinline__ void operator()(const f32x4 (&acc)[2][2][4][2], const Unit& u, int wr, int wc, int fr, int fq) const {
        const int set = (u.pm % 17 == 0) ? 16 : (u.pm / 17);
        const float* gp = gate + (size_t)set * 6 * DM;
        const int col0 = u.pn * BM + wc * 32 + 8 * fq;
        f32x4 gv[2][2];
#pragma unroll
        for (int bj = 0; bj < 2; ++bj)
#pragma unroll
            for (int n = 0; n < 2; ++n) gv[bj][n] = *(const f32x4*)(gp + col0 + bj * HALF + n * 4);
#pragma unroll
        for (int ai = 0; ai < 2; ++ai) {
            u32x4 xin[4][2];
#pragma unroll
            for (int m = 0; m < 4; ++m) { const unsigned off = ((unsigned)(u.pm * BM + ai * HALF + wr * 64 + m * 16 + fr) * (unsigned)DM + (unsigned)col0) * 2u;
#pragma unroll
                for (int bj = 0; bj < 2; ++bj) xin[m][bj] = *(const u32x4*)((const char*)X + off + bj * HALF * 2); }
            asm volatile("" ::: "memory");
#pragma unroll
            for (int m = 0; m < 4; ++m) { const unsigned off = ((unsigned)(u.pm * BM + ai * HALF + wr * 64 + m * 16 + fr) * (unsigned)DM + (unsigned)col0) * 2u;
#pragma unroll
                for (int bj = 0; bj < 2; ++bj) { const u32x4 x = xin[m][bj]; const f32x4 a0 = acc[ai][bj][m][0] * gv[bj][0], a1 = acc[ai][bj][m][1] * gv[bj][1];
                    u32x4 w; w.x = cvt_pk_bf16(bflo(x.x) + a0[0], bfhi(x.x) + a0[1]); w.y = cvt_pk_bf16(bflo(x.y) + a0[2], bfhi(x.y) + a0[3]);
                    w.z = cvt_pk_bf16(bflo(x.z) + a1[0], bfhi(x.z) + a1[1]); w.w = cvt_pk_bf16(bflo(x.w) + a1[2], bfhi(x.w) + a1[3]);
                    *(u32x4*)((char*)X + off + bj * HALF * 2) = w; } }
            asm volatile("" ::: "memory");
        }
    }
};

template <class Epi, class Sched, bool ALIGN_EPI, bool FP8 = false>
__device__ __forceinline__ void gemm_phase(LAS unsigned char* lds, const Gemm g, const Sched& S, const Epi& E, const int tid) {
    const int wid = __builtin_amdgcn_readfirstlane(tid >> 6), lane = tid & 63, wr = wid >> 2, wc = wid & 3, fr = lane & 15, fq = lane >> 4;
    const int K = g.K, KB = FP8 ? K : 2 * K  , nt = KB / (BK * 2);
    unsigned voffB[2], vA[2][2], vAn[2][2]; int sR[2], sC[2];
#pragma unroll
    for (int i = 0; i < 2; ++i) { int R, C; stage_rc(tid * 16 + i * 8192, R, C); sR[i] = R; sC[i] = C; const int Rb = Epi::PERM ? ((R & ~31) + perm32(R & 31)) : R;
        voffB[i] = (unsigned)(Rb * KB + C * 2); }
#define PG8_SETV(v, u) do { _Pragma("unroll") for (int h_ = 0; h_ < 2; ++h_) _Pragma("unroll") for (int i_ = 0; i_ < 2; ++i_) { \
        if constexpr (Sched::GATHER) v[h_][i_] = S.arow(u, h_ * HALF + sR[i_]) * (unsigned)KB + (unsigned)(sC[i_] * 2); \
        else v[h_][i_] = (unsigned)((h_ * HALF + sR[i_]) * KB + sC[i_] * 2); } } while (0)
    const size_t kstep = (size_t)(BK * 2);
    const size_t hstep = (size_t)HALF * KB;
    const size_t tstep = 2 * hstep;
    const size_t atstep = Sched::GATHER ? (size_t)0 : tstep;
    const unsigned ldsw = (unsigned)wid * 1024u;
    const int aoff = lds_byte(wr * 64 + fr, fq * 8), boff = lds_byte(wc * 32 + fr, fq * 8);
#define PG8_SA(b, h) (((b) * 2 + (h)) * HTB)
#define PG8_SB(b, h) ((4 + (b) * 2 + (h)) * HTB)
#define PG8_STAGE(bufoff, gbase, voff) do { _Pragma("unroll") for (int _i = 0; _i < 2; ++_i) \
        __builtin_amdgcn_global_load_lds((const unsigned*)((const char*)(gbase) + (voff)[_i]), (LAS unsigned*)(lds + (bufoff) + ldsw + _i * 8192), 16, 0, 0); } while (0)
#define PG8_LDA(dst, b, h) do { _Pragma("unroll") for (int m = 0; m < 4; ++m) _Pragma("unroll") for (int k = 0; k < 2; ++k) dst[m][k] = *(const LAS bf16x8*)(lds + PG8_SA(b, h) + aoff + m * 2048 + k * 1024); } while (0)
#define PG8_LDB(dst, b, h) do { _Pragma("unroll") for (int n = 0; n < 2; ++n) _Pragma("unroll") for (int k = 0; k < 2; ++k) dst[n][k] = *(const LAS bf16x8*)(lds + PG8_SB(b, h) + boff + n * 2048 + k * 1024); } while (0)
    typedef long i64x2_ __attribute__((ext_vector_type(2)));
#define PG8_MMA(ai, bj, At, Bt) do { __builtin_amdgcn_s_setprio(1); _Pragma("unroll") for (int m = 0; m < 4; ++m) _Pragma("unroll") for (int n = 0; n < 2; ++n) _Pragma("unroll") for (int k = 0; k < 2; ++k) { \
        if constexpr (FP8) { const i64x2_ b2_ = __builtin_bit_cast(i64x2_, Bt[n][k]), a2_ = __builtin_bit_cast(i64x2_, At[m][k]); \
            acc[ai][bj][m][n] = __builtin_amdgcn_mfma_f32_16x16x32_fp8_fp8(b2_[0], a2_[0], acc[ai][bj][m][n], 0, 0, 0); \
            acc[ai][bj][m][n] = __builtin_amdgcn_mfma_f32_16x16x32_fp8_fp8(b2_[1], a2_[1], acc[ai][bj][m][n], 0, 0, 0); } \
        else acc[ai][bj][m][n] = __builtin_amdgcn_mfma_f32_16x16x32_bf16(Bt[n][k], At[m][k], acc[ai][bj][m][n], 0, 0, 0); } \
        __builtin_amdgcn_s_setprio(0); } while (0)
#define PG8_WAIT_V(n) asm volatile("s_waitcnt vmcnt(" #n ")" ::: "memory")
#define PG8_WAIT_L(n) asm volatile("s_waitcnt lgkmcnt(" #n ")" ::: "memory")
#define PG8_BAR __builtin_amdgcn_s_barrier()
#define PG8_SCHED __builtin_amdgcn_sched_barrier(0)
    Unit cur, nxt; int ui = 0;
    if (!S.next(0, cur)) return;
    float z0 = 0.f; asm volatile("" : "+v"(z0));
    f32x4 acc[2][2][4][2];
#pragma unroll
    for (int a = 0; a < 2; ++a)
#pragma unroll
        for (int b = 0; b < 2; ++b)
#pragma unroll
            for (int m = 0; m < 4; ++m)
#pragma unroll
                for (int n = 0; n < 2; ++n) acc[a][b][m][n] = (f32x4){z0, z0, z0, z0};
    bf16x8 At[4][2], B0[2][2], B1[2][2];
    const char* cA = (const char*)g.A + (size_t)cur.pm * atstep; const char* cB = (const char*)g.Bt + (size_t)cur.pn * tstep;
    PG8_SETV(vA, cur);
    PG8_STAGE(PG8_SB(0, 0), cB, voffB); PG8_STAGE(PG8_SB(0, 1), cB + hstep, voffB); PG8_STAGE(PG8_SA(0, 0), cA, vA[0]); PG8_STAGE(PG8_SA(0, 1), cA, vA[1]);
    if (wr == 1) PG8_BAR;
    PG8_WAIT_V(2); PG8_BAR;
    PG8_STAGE(PG8_SB(1, 0), cB + kstep, voffB); PG8_STAGE(PG8_SA(1, 0), cA + kstep, vA[0]); PG8_STAGE(PG8_SB(1, 1), cB + hstep + kstep, voffB);
    PG8_WAIT_V(6); PG8_BAR;
    for (;;) {
        const bool has_next = S.next(ui + 1, nxt);
        const char* nA = has_next ? (const char*)g.A + (size_t)nxt.pm * atstep : cA; const char* nB = has_next ? (const char*)g.Bt + (size_t)nxt.pn * tstep : cB;
        if (has_next) { PG8_SETV(vAn, nxt); } else {
#pragma unroll
            for (int h_ = 0; h_ < 2; ++h_)
#pragma unroll
                for (int i_ = 0; i_ < 2; ++i_) vAn[h_][i_] = vA[h_][i_]; }
        for (int t = 0; t < nt; t += 2) {
            const bool last = (t == nt - 2);
            const char* a1 = cA + (size_t)(t + 1) * kstep;
            const char* a2 = last ? nA : cA + (size_t)(t + 2) * kstep; const char* b2 = last ? nB : cB + (size_t)(t + 2) * kstep;
            const char* a3 = a2 + kstep; const char* b3 = b2 + kstep;
            unsigned o2[2][2];
#pragma unroll
            for (int h_ = 0; h_ < 2; ++h_)
#pragma unroll
                for (int i_ = 0; i_ < 2; ++i_) o2[h_][i_] = last ? vAn[h_][i_] : vA[h_][i_];
            PG8_LDB(B0, 0, 0); PG8_LDB(B1, 0, 1); PG8_SCHED; PG8_LDA(At, 0, 0); PG8_STAGE(PG8_SA(1, 1), a1, vA[1]);
            PG8_WAIT_V(8); PG8_WAIT_L(0); PG8_BAR; PG8_MMA(0, 0, At, B0); PG8_MMA(0, 1, At, B1); PG8_BAR; PG8_SCHED;
            PG8_LDA(At, 0, 1); PG8_STAGE(PG8_SB(0, 0), b2, voffB); PG8_STAGE(PG8_SB(0, 1), b2 + hstep, voffB); PG8_STAGE(PG8_SA(0, 0), a2, o2[0]);
            PG8_WAIT_V(8); PG8_WAIT_L(0); PG8_BAR; PG8_MMA(1, 0, At, B0); PG8_MMA(1, 1, At, B1); PG8_BAR; PG8_SCHED;
            PG8_LDB(B0, 1, 0); PG8_LDB(B1, 1, 1); PG8_SCHED; PG8_LDA(At, 1, 0); PG8_STAGE(PG8_SA(0, 1), a2, o2[1]);
            PG8_WAIT_V(8); PG8_WAIT_L(0); PG8_BAR; PG8_MMA(0, 0, At, B0); PG8_MMA(0, 1, At, B1); PG8_BAR; PG8_SCHED;
            PG8_LDA(At, 1, 1); PG8_STAGE(PG8_SB(1, 0), b3, voffB); PG8_STAGE(PG8_SB(1, 1), b3 + hstep, voffB); PG8_STAGE(PG8_SA(1, 0), a3, o2[0]);
            PG8_WAIT_V(8); PG8_WAIT_L(0); PG8_BAR; PG8_MMA(1, 0, At, B0); PG8_MMA(1, 1, At, B1); PG8_BAR; PG8_SCHED;
        }
        if constexpr (ALIGN_EPI) { if (wr == 0) PG8_BAR; }
        E(acc, cur, wr, wc, fr, fq);
        if (!has_next) break;
#pragma unroll
        for (int a = 0; a < 2; ++a)
#pragma unroll
            for (int b = 0; b < 2; ++b)
#pragma unroll
                for (int m = 0; m < 4; ++m)
#pragma unroll
                    for (int n = 0; n < 2; ++n) acc[a][b][m][n] = (f32x4){z0, z0, z0, z0};
        cur = nxt; cA = nA; cB = nB; ++ui;
#pragma unroll
        for (int h_ = 0; h_ < 2; ++h_)
#pragma unroll
            for (int i_ = 0; i_ < 2; ++i_) vA[h_][i_] = vAn[h_][i_];
        if constexpr (ALIGN_EPI) { if (wr == 1) PG8_BAR; }
    }
    PG8_WAIT_V(0);
    if constexpr (!ALIGN_EPI) { if (wr == 0) PG8_BAR; }
    PG8_BAR;
#undef PG8_SETV
#undef PG8_SA
#undef PG8_SB
#undef PG8_STAGE
#undef PG8_LDA
#undef PG8_LDB
#undef PG8_MMA
#undef PG8_WAIT_V
#undef PG8_WAIT_L
#undef PG8_BAR
#undef PG8_SCHED
}
}
#include <hip/hip_bf16.h>
#include <cmath>
namespace attn_body {
using bf16=__hip_bfloat16;
using s16x4=__attribute__((ext_vector_type(4)))short;
constexpr int D=64,QP=DIN,OP=1024;
constexpr int NW=8,QBLK=32,QB=QBLK*NW,KVBLK=64;
__device__ __forceinline__ int crow(int r,int hi){return (r&3)+8*(r>>2)+4*hi;}
#define SBAR() __builtin_amdgcn_sched_barrier(0)
__device__ __forceinline__ void wmask(f32x16&p0,f32x16&p1,int kq,int hi){
  const float NEG=-INFINITY; const int kb=kq+4*hi;
  #pragma unroll
  for(int r=0;r<16;++r){const int d=kb+(r&3)+8*(r>>2); if(d>128||d<-128)p0[r]=NEG; if(d+32>128||d+32<-128)p1[r]=NEG;}
}

constexpr int NSLOT=3, SLOTB=8192;
constexpr int LDS_K=0, LDS_V=NSLOT*SLOTB, LDS_WS=2*NSLOT*SLOTB, LDS_OST=LDS_WS+NW*64*4, LDS_BYTES=LDS_OST+NW*4096;
constexpr float C2=0.125f*1.4426950408889634f;
__device__ __forceinline__ void glds16(const void*gsrc,unsigned lds_dst){unsigned keep;
  asm volatile("s_mov_b32 %0, m0\n\ts_mov_b32 m0, %2\n\ts_nop 0\n\tglobal_load_lds_dwordx4 %1, off\n\ts_mov_b32 m0, %0":"=&s"(keep):"v"(gsrc),"s"(lds_dst):"memory");}
__device__ __forceinline__ float max3f(float a,float b,float c){float r;asm("v_max3_f32 %0, %1, %2, %3":"=v"(r):"v"(a),"v"(b),"v"(c));return r;}
__device__ __forceinline__ float max2f(float a,float b){float r;asm("v_max_f32_e32 %0, %1, %2":"=v"(r):"v"(a),"v"(b));return r;}
__device__ __forceinline__ float fadd_s(float a,float b){float r;asm("v_add_f32_e32 %0, %1, %2":"=v"(r):"v"(a),"v"(b));return r;}
__device__ __forceinline__ float fsub_s(float a,float b){float r;asm("v_sub_f32_e32 %0, %1, %2":"=v"(r):"v"(a),"v"(b));return r;}
typedef float f32x2_t __attribute__((ext_vector_type(2))); typedef __bf16 bf16x2_t __attribute__((ext_vector_type(2)));
__device__ __forceinline__ unsigned cvtpk_s(float lo,float hi){f32x2_t v={lo,hi};bf16x2_t b=__builtin_convertvector(v,bf16x2_t);return __builtin_bit_cast(unsigned,b);}
#define WAIT_BAR(N) asm volatile("s_waitcnt vmcnt(" #N ") lgkmcnt(0)\n\ts_barrier":::"memory")

__device__ __forceinline__ void qkt(f32x16&p0,f32x16&p1,const char*Kslot,const bf16x8*qr,const f32x16&negm,int r32,int hi){
  const char*kb=Kslot+hi*1024+r32*16;
  #pragma unroll
  for(int d0=0;d0<4;++d0){
    const bf16x8 b0=*reinterpret_cast<const bf16x8*>(kb+d0*2048);
    const bf16x8 b1=*reinterpret_cast<const bf16x8*>(kb+d0*2048+512);
    if(d0==0){p0=__builtin_amdgcn_mfma_f32_32x32x16_bf16(b0,qr[0],negm,0,0,0);p1=__builtin_amdgcn_mfma_f32_32x32x16_bf16(b1,qr[0],negm,0,0,0);}
    else{p0=__builtin_amdgcn_mfma_f32_32x32x16_bf16(b0,qr[d0],p0,0,0,0);p1=__builtin_amdgcn_mfma_f32_32x32x16_bf16(b1,qr[d0],p1,0,0,0);}}
}
typedef __attribute__((address_space(3))) const char* lds_cptr;
typedef short v4i16_t __attribute__((ext_vector_type(4)));
__device__ __forceinline__ void kload8(bf16x8*kf,lds_cptr kp){
  kf[0]=*(const __attribute__((address_space(3))) bf16x8*)(kp);      kf[1]=*(const __attribute__((address_space(3))) bf16x8*)(kp+512);
  kf[2]=*(const __attribute__((address_space(3))) bf16x8*)(kp+2048); kf[3]=*(const __attribute__((address_space(3))) bf16x8*)(kp+2560);
  kf[4]=*(const __attribute__((address_space(3))) bf16x8*)(kp+4096); kf[5]=*(const __attribute__((address_space(3))) bf16x8*)(kp+4608);
  kf[6]=*(const __attribute__((address_space(3))) bf16x8*)(kp+6144); kf[7]=*(const __attribute__((address_space(3))) bf16x8*)(kp+6656);
}
__device__ __forceinline__ void kload2(bf16x8*kf,lds_cptr kp,int j){ kf[2*j]=*(const __attribute__((address_space(3))) bf16x8*)(kp+j*2048); kf[2*j+1]=*(const __attribute__((address_space(3))) bf16x8*)(kp+j*2048+512); }
__device__ __forceinline__ s16x4 vtr(lds_cptr p){ return __builtin_bit_cast(s16x4,__builtin_amdgcn_ds_read_tr16_b64_v4i16((__attribute__((address_space(3))) v4i16_t*)p)); }
__device__ __forceinline__ float rowmax(const f32x16&p0,const f32x16&p1){
  float a=max3f(p0[0],p0[1],p1[0]),b=max3f(p0[2],p0[3],p1[1]);a=max3f(a,p1[2],p1[3]);
  #pragma unroll
  for(int r=4;r<16;r+=4){a=max3f(a,p0[r],p0[r+1]);b=max3f(b,p0[r+2],p0[r+3]);a=max3f(a,p1[r],p1[r+1]);b=max3f(b,p1[r+2],p1[r+3]);}
  const float m=max2f(a,b);
  auto rr=__builtin_amdgcn_permlane32_swap(__float_as_uint(m),__float_as_uint(m),false,false);
  return max2f(__uint_as_float(rr[0]),__uint_as_float(rr[1]));
}
__device__ __forceinline__ void pv(f32x16*o,int vb,bf16x8 pa0,bf16x8 pa1,bf16x8 pa2,bf16x8 pa3){
  #pragma unroll
  for(int d0=0;d0<2;++d0){s16x4 lo[4],hi[4];
    #pragma unroll
    for(int ks=0;ks<4;++ks){
      asm volatile("ds_read_b64_tr_b16 %0,%1 offset:%c2":"=&v"(lo[ks]):"v"(vb),"i"(d0*4096+ks*1024):"memory");
      asm volatile("ds_read_b64_tr_b16 %0,%1 offset:%c2":"=&v"(hi[ks]):"v"(vb),"i"(d0*4096+ks*1024+512):"memory");}
    asm volatile("s_waitcnt lgkmcnt(0)":::"memory");SBAR();
    #define PK(k) (bf16x8){lo[k][0],lo[k][1],lo[k][2],lo[k][3],hi[k][0],hi[k][1],hi[k][2],hi[k][3]}
    o[d0]=__builtin_amdgcn_mfma_f32_32x32x16_bf16(pa0,PK(0),o[d0],0,0,0);
    o[d0]=__builtin_amdgcn_mfma_f32_32x32x16_bf16(pa1,PK(1),o[d0],0,0,0);
    o[d0]=__builtin_amdgcn_mfma_f32_32x32x16_bf16(pa2,PK(2),o[d0],0,0,0);
    o[d0]=__builtin_amdgcn_mfma_f32_32x32x16_bf16(pa3,PK(3),o[d0],0,0,0);
    #undef PK
  }
}

#ifndef ATTN_STORE16
#define ATTN_STORE16(p,v) (*(u32x4*)(p)=(v))
#endif
template<int THRL,bool WIN> __device__ __forceinline__ void attn_unit(const bf16*Qb,const bf16*__restrict__ Kb,const bf16*__restrict__ Vb,bf16*Ob,int q0,int NT,int tdelta,float sink_l2,int tid,char*shm){
  const int lane=tid&63,r32=lane&31,hi=lane>>5; const int wid=__builtin_amdgcn_readfirstlane(tid>>6);
  const bf16*Qw=Qb+(long)(q0+wid*QBLK)*QP;
  const bf16*Kh=Kb,*Vh=Vb;
  const unsigned lds0=(unsigned)(uintptr_t)shm;
  float*wsf=(float*)(shm+LDS_WS)+wid*64;
  const bf16*ksrc=Kh+(long)lane*QP+wid*8;
  const bf16*vsrc=Vh+(long)(16*(wid&3)+(lane>>2))*QP+(wid>>2)*32+(lane&3)*8;
  const unsigned kdst=lds0+LDS_K+wid*1024, vdst=lds0+LDS_V+wid*1024;
  #define TM(t) ((t)<4?(t):(t)+tdelta)
  #define DMA_K(t,slot) glds16(ksrc+(long)TM(t)*KVBLK*QP,(unsigned)__builtin_amdgcn_readfirstlane(kdst+(slot)))
  #define DMA_V(t,slot) glds16(vsrc+(long)TM(t)*KVBLK*QP,(unsigned)__builtin_amdgcn_readfirstlane(vdst+(slot)))
  const int vb0=(int)(lds0+LDS_V)+((lane>>4)&1)*32+(lane&3)*8+(4*hi+((lane&15)>>2))*64;
  const char*Kbase=shm+LDS_K; bf16x8 kf[8];
  const lds_cptr shm3=(lds_cptr)shm; const lds_cptr kp0=shm3+LDS_K+hi*1024+r32*16; const lds_cptr vp0=shm3+LDS_V+((lane>>4)&1)*32+(lane&3)*8+(4*hi+((lane&15)>>2))*64;
  DMA_K(0,0);DMA_V(0,0);DMA_K(1,SLOTB);
  bf16x8 qr[4];
  #pragma unroll
  for(int d0=0;d0<4;++d0)qr[d0]=*reinterpret_cast<const bf16x8*>(&Qw[(long)r32*QP+d0*16+hi*8]);
  float mhat=0.f,l_reg=0.f;float z0_=0.f;asm volatile("":"+v"(z0_));f32x16 o[2];
  #pragma unroll
  for(int r_=0;r_<16;++r_){o[0][r_]=z0_;o[1][r_]=z0_;}
  f32x16 negm;
  #pragma unroll
  for(int r_=0;r_<16;++r_)negm[r_]=z0_;
  asm volatile("":"+v"(negm));
  const int qrow=q0+wid*QBLK+r32;
  #define CMASK(P0,P1,t) do{ if(WIN&&(t)>=4)wmask(P0,P1,TM(t)*KVBLK-qrow,hi); }while(0)
  bool resc=false;
  #define START(P0,P1) do{ const float rm=rowmax(P0,P1); resc=false; \
    { const float dl=rm; mhat=fadd_s(mhat,dl); \
      _Pragma("unroll") for(int r=0;r<16;++r){P0[r]=fsub_s(P0[r],dl);P1[r]=fsub_s(P1[r],dl);} \
      _Pragma("unroll") for(int r=0;r<16;++r)negm[r]=-mhat; asm volatile("":"+v"(negm)); } \
    _Pragma("unroll") for(int r=0;r<16;++r)P0[r]=__builtin_amdgcn_exp2f(P0[r]); }while(0)
  #define RESC() do{ if(resc){ asm volatile("s_waitcnt lgkmcnt(0)":::"memory"); \
      _Pragma("unroll") for(int d_=0;d_<2;++d_) _Pragma("unroll") for(int r=0;r<16;++r)o[d_][r]*=wsf[crow(r,hi)]; } }while(0)
  f32x16 pA0,pA1,pB0,pB1;
  int sl_prev=0,sl_cur=0,sl_next=SLOTB;
  #define ROT() do{sl_prev=sl_cur;sl_cur=sl_next;sl_next=(sl_next==(NSLOT-1)*SLOTB)?0:sl_next+SLOTB;}while(0)
  DMA_K(2,2*SLOTB);
  WAIT_BAR(3);
  qkt(pA0,pA1,Kbase,qr,negm,r32,hi);asm volatile("s_nop 15\n\ts_nop 7":"+v"(pA0),"+v"(pA1));CMASK(pA0,pA1,0);
  START(pA0,pA1);
  _Pragma("unroll") for(int r=0;r<16;++r)pA1[r]=__builtin_amdgcn_exp2f(pA1[r]);
  WAIT_BAR(0);
  DMA_K(3,0);DMA_V(1,SLOTB);
  ROT();
  kload8(kf,kp0+sl_cur);
  WAIT_BAR(2);
  s16x4 vlo[8],vhi[8]; u32x4 pw0,pw1,pw2,pw3;
  #define PKW(P,B) cvtpk_s(P[B],P[B+1])
  #define PAF(k) __builtin_bit_cast(bf16x8,pw##k)
  #define VFR(i) (bf16x8){vlo[i][0],vlo[i][1],vlo[i][2],vlo[i][3],vhi[i][0],vhi[i][1],vhi[i][2],vhi[i][3]}
  #define PIN(x) asm volatile("":"+v"(x))
  #define MX3(a,b,c) __builtin_fmaxf(__builtin_fmaxf((a),(b)),(c))
  #define GAPA(MF,A0,A1,A2,A3,W0,W1,PW) do{ MF; sacc+=A0; sacc+=A1; sacc+=A2; sacc+=A3; PIN(sacc); W0; W1; PIN(PW); SBAR(); }while(0)
  #define EX(v) __builtin_amdgcn_exp2f(v)
  #define GAPB(MF,X,B) do{ MF; X[B]=EX(X[B]); X[B+1]=EX(X[B+1]); X[B+2]=EX(X[B+2]); X[B+3]=EX(X[B+3]); PIN(X); SBAR(); }while(0)
  #define VRD(i) do{ vlo[i]=vtr(vp_+(((i)>>2)*4096+((i)&3)*1024)); vhi[i]=vtr(vp_+(((i)>>2)*4096+((i)&3)*1024+512)); }while(0)
  #define KRD(G,j) do{ if(G){ kload2(kf,kp0+sl_next,j); SBAR(); } }while(0)
  #define STEP(C0,C1,P0,P1,t,GK,GV,GL) do{ SBAR(); \
    const lds_cptr vp_=vp0+sl_prev; \
    VRD(0); SBAR(); float sacc=(P0[0]+P0[1]); \
    GAPA(C0=__builtin_amdgcn_mfma_f32_32x32x16_bf16(kf[0],qr[0],negm,0,0,0), P0[2],P0[3],P0[4],P0[5],     pw0[0]=PKW(P0,0), pw0[1]=PKW(P0,2), pw0); \
    VRD(4); SBAR(); GAPA(C1=__builtin_amdgcn_mfma_f32_32x32x16_bf16(kf[1],qr[0],negm,0,0,0), P0[6],P0[7],P0[8],P0[9],     pw0[2]=PKW(P0,4), pw0[3]=PKW(P0,6), pw0); \
    VRD(1); SBAR(); GAPA(C0=__builtin_amdgcn_mfma_f32_32x32x16_bf16(kf[2],qr[1],C0,0,0,0),   P0[10],P0[11],P0[12],P0[13], pw1[0]=PKW(P0,8), pw1[1]=PKW(P0,10), pw1); \
    VRD(5); SBAR(); GAPA(C1=__builtin_amdgcn_mfma_f32_32x32x16_bf16(kf[3],qr[1],C1,0,0,0),   P0[14],P0[15],P1[0],P1[1],   pw1[2]=PKW(P0,12),pw1[3]=PKW(P0,14), pw1); \
    VRD(2); SBAR(); GAPA(C0=__builtin_amdgcn_mfma_f32_32x32x16_bf16(kf[4],qr[2],C0,0,0,0),   P1[2],P1[3],P1[4],P1[5],     pw2[0]=PKW(P1,0), pw2[1]=PKW(P1,2), pw2); \
    VRD(6); SBAR(); GAPA(C1=__builtin_amdgcn_mfma_f32_32x32x16_bf16(kf[5],qr[2],C1,0,0,0),   P1[6],P1[7],P1[8],P1[9],     pw2[2]=PKW(P1,4), pw2[3]=PKW(P1,6), pw2); \
    VRD(3); SBAR(); GAPA(C0=__builtin_amdgcn_mfma_f32_32x32x16_bf16(kf[6],qr[3],C0,0,0,0),   P1[10],P1[11],P1[12],P1[13], pw3[0]=PKW(P1,8), pw3[1]=PKW(P1,10), pw3); \
    VRD(7); SBAR(); GAPA(C1=__builtin_amdgcn_mfma_f32_32x32x16_bf16(kf[7],qr[3],C1,0,0,0),   P1[14],P1[15],0.f,0.f,       pw3[2]=PKW(P1,12),pw3[3]=PKW(P1,14), pw3); \
    l_reg+=sacc; \
    if(GK){DMA_K((t)+3,sl_cur);} if(GV){DMA_V((t)+1,sl_next);} \
    CMASK(C0,C1,t); \
    { float a=MX3(C0[0],C0[1],C1[0]),b=MX3(C0[2],C0[3],C1[1]); a=MX3(a,C1[2],C1[3]); \
      _Pragma("unroll") for(int r=4;r<16;r+=4){a=MX3(a,C0[r],C0[r+1]);b=MX3(b,C0[r+2],C0[r+3]);a=MX3(a,C1[r],C1[r+1]);b=MX3(b,C1[r+2],C1[r+3]);} \
      float rm=__builtin_fmaxf(a,b); { auto rr=__builtin_amdgcn_permlane32_swap(__float_as_uint(rm),__float_as_uint(rm),false,false); rm=__builtin_fmaxf(__uint_as_float(rr[0]),__uint_as_float(rr[1])); } \
      resc=false; \
      if(__builtin_expect(__any(rm>(float)THRL),0)){ const float dl=__builtin_fmaxf(rm,0.f); mhat+=dl; \
        _Pragma("unroll") for(int r=0;r<16;++r){C0[r]-=dl;C1[r]-=dl;} \
        _Pragma("unroll") for(int r=0;r<16;++r)negm[r]=-mhat; asm volatile("":"+v"(negm)); \
        const float f=__builtin_amdgcn_exp2f(-dl); l_reg*=f; if(hi==0)wsf[r32]=f; resc=true; } } \
    SBAR(); \
    GAPB(o[0]=__builtin_amdgcn_mfma_f32_32x32x16_bf16(PAF(0),VFR(0),o[0],0,0,0), C0,0); \
    GAPB(o[1]=__builtin_amdgcn_mfma_f32_32x32x16_bf16(PAF(0),VFR(4),o[1],0,0,0), C0,4); \
    KRD(GL,0); GAPB(o[0]=__builtin_amdgcn_mfma_f32_32x32x16_bf16(PAF(1),VFR(1),o[0],0,0,0), C0,8); \
    KRD(GL,1); GAPB(o[1]=__builtin_amdgcn_mfma_f32_32x32x16_bf16(PAF(1),VFR(5),o[1],0,0,0), C0,12); \
    KRD(GL,2); GAPB(o[0]=__builtin_amdgcn_mfma_f32_32x32x16_bf16(PAF(2),VFR(2),o[0],0,0,0), C1,0); \
    KRD(GL,3); GAPB(o[1]=__builtin_amdgcn_mfma_f32_32x32x16_bf16(PAF(2),VFR(6),o[1],0,0,0), C1,4); \
    GAPB(o[0]=__builtin_amdgcn_mfma_f32_32x32x16_bf16(PAF(3),VFR(3),o[0],0,0,0), C1,8); \
    GAPB(o[1]=__builtin_amdgcn_mfma_f32_32x32x16_bf16(PAF(3),VFR(7),o[1],0,0,0), C1,12); \
    }while(0)
  int t=1;
  for(;t+5<NT;t+=2){
    STEP(pB0,pB1,pA0,pA1,t,true,true,true);     WAIT_BAR(2); RESC(); ROT();
    STEP(pA0,pA1,pB0,pB1,t+1,true,true,true);   WAIT_BAR(2); RESC(); ROT();
  }
  #define ENDW(tt) do{ if((tt)+3<NT){WAIT_BAR(2);} else if((tt)+2<NT){WAIT_BAR(1);} else {WAIT_BAR(0);} }while(0)
  for(;t+1<NT;t+=2){
    STEP(pB0,pB1,pA0,pA1,t,(t+3<NT),(t+1<NT),(t+1<NT));       ENDW(t);   RESC(); ROT();
    STEP(pA0,pA1,pB0,pB1,t+1,(t+4<NT),(t+2<NT),(t+2<NT));     ENDW(t+1); RESC(); ROT();
  }
  STEP(pB0,pB1,pA0,pA1,NT-1,false,false,false); RESC();
  { float sacc=pB0[0]+pB0[1]; _Pragma("unroll") for(int r=2;r<16;++r)sacc+=pB0[r]; _Pragma("unroll") for(int r=0;r<16;++r)sacc+=pB1[r]; l_reg+=sacc;
    pw0=(u32x4){PKW(pB0,0),PKW(pB0,2),PKW(pB0,4),PKW(pB0,6)};pw1=(u32x4){PKW(pB0,8),PKW(pB0,10),PKW(pB0,12),PKW(pB0,14)};pw2=(u32x4){PKW(pB1,0),PKW(pB1,2),PKW(pB1,4),PKW(pB1,6)};pw3=(u32x4){PKW(pB1,8),PKW(pB1,10),PKW(pB1,12),PKW(pB1,14)};
    SBAR(); pv(o,vb0+sl_cur,PAF(0),PAF(1),PAF(2),PAF(3)); }
  #undef PKW
  #undef PAF
  #undef VFR
  #undef PIN
  #undef MX3
  #undef GAPA
  #undef GAPB
  #undef EX
  #undef VRD
  #undef KRD
  #undef STEP
  #undef ENDW
  {auto rr=__builtin_amdgcn_permlane32_swap(__float_as_uint(l_reg),__float_as_uint(l_reg),false,false);l_reg=__uint_as_float(rr[0])+__uint_as_float(rr[1]);}
  if(WIN)l_reg+=__builtin_amdgcn_exp2f(sink_l2-mhat);
  if(hi==0)wsf[32+r32]=l_reg;asm volatile("s_waitcnt lgkmcnt(0)":::"memory");
  float rli[16];
  #pragma unroll
  for(int r=0;r<16;++r)rli[r]=__builtin_amdgcn_rcpf(wsf[32+crow(r,hi)]);
  bf16*Ow=Ob+(long)(q0+wid*QBLK)*OP;
  { bf16*stg=(bf16*)(shm+LDS_OST)+wid*2048;
    #pragma unroll
    for(int r=0;r<16;++r){const int orow=crow(r,hi);
      #pragma unroll
      for(int d0=0;d0<2;++d0)stg[orow*64+d0*32+r32]=__float2bfloat16(o[d0][r]*rli[r]);}
    asm volatile("s_waitcnt lgkmcnt(0)":::"memory");
    #pragma unroll
    for(int i=0;i<4;++i){const int row=i*8+(lane>>3),ch=lane&7; const u32x4 v=*(const u32x4*)(stg+row*64+ch*8); ATTN_STORE16(Ow+(long)row*OP+ch*8,v);} }
  asm volatile("s_waitcnt lgkmcnt(0)\n\ts_barrier":::"memory");
  #undef TM
  #undef DMA_K
  #undef DMA_V
  #undef CMASK
  #undef START
  #undef RESC
  #undef ROT
}
constexpr int ATTN_LDS_BYTES=LDS_BYTES;
#undef SBAR
#undef WAIT_BAR
}
#define XB_TMO      128
#define XB_XCNT(j)  (256  + 64 * (j))
#define XB_XSUB(j)  (1280 + 64 * (j))
#define XB_XGEN(j)  (2304 + 64 * (j))
#define XB_TOP      3328
#define XB_TOPGEN   3392
#define XCD_BAR_WORDS 3456
#define XB_SPIN_CAP (1u << 21)

__device__ __forceinline__ unsigned xb_ld(unsigned* p)              { return __hip_atomic_load(p, __ATOMIC_RELAXED, __HIP_MEMORY_SCOPE_AGENT); }
__device__ __forceinline__ unsigned xb_add(unsigned* p, unsigned v) { return __hip_atomic_fetch_add(p, v, __ATOMIC_RELAXED, __HIP_MEMORY_SCOPE_AGENT); }
__device__ __forceinline__ unsigned xb_xcc_id() { return (unsigned)__builtin_amdgcn_s_getreg((3 << 11) | 20) & 0xFu; }
#define XB_SPIN(cond, bar) do { unsigned _sp = 0; while (cond) { __builtin_amdgcn_s_sleep(1); \
    if ((++_sp & 255u) == 0u) { if (xb_ld(&(bar)[XB_TMO])) break; if (_sp > XB_SPIN_CAP) { atomicAdd(&(bar)[XB_TMO], 1u); break; } } } } while (0)

struct XcdBarrier {
    unsigned* bar; unsigned x;
    volatile LAS unsigned* st;
};

__device__ __forceinline__ XcdBarrier xcd_barrier_post(unsigned* bar, volatile LAS unsigned* st) {
    XcdBarrier b; b.bar = bar; b.x = xb_xcc_id(); b.st = st;
    if (threadIdx.x == 0) (void)xb_add(&bar[XB_XCNT(b.x)], 1u);
    return b;
}
__device__ __forceinline__ void xcd_barrier_complete(unsigned* bar, unsigned x, unsigned& nloc, unsigned& nx) {
    const unsigned G = gridDim.x * gridDim.y * gridDim.z;
    unsigned sum, cnt, mine, sp = 0u;
    for (;;) {
        sum = 0u; cnt = 0u; mine = 0u;
#pragma unroll
        for (unsigned j = 0; j < 16; ++j) { const unsigned c = xb_ld(&bar[XB_XCNT(j)]); sum += c; cnt += (c > 0u) ? 1u : 0u; mine = (j == x) ? c : mine; }
        if (sum == G) break;
        __builtin_amdgcn_s_sleep(1);
        if ((++sp & 255u) == 0u) { if (xb_ld(&bar[XB_TMO])) break; if (sp > XB_SPIN_CAP) { atomicAdd(&bar[XB_TMO], 1u); break; } }
    }
    nloc = mine > 0u ? mine : 1u; nx = cnt > 0u ? cnt : 1u;
}

__device__ __forceinline__ void xcd_barrier(const XcdBarrier& b) {
    asm volatile("s_waitcnt vmcnt(0)" ::: "memory");
    __syncthreads();
    if (threadIdx.x == 0) {
        unsigned* bar = b.bar; unsigned bx_ = b.x; asm volatile("" : "+s"(bar), "+s"(bx_));
        __builtin_amdgcn_s_waitcnt(0);
        unsigned nloc = b.st[0], nx = b.st[1];
        if (nloc == 0u) { xcd_barrier_complete(bar, bx_, nloc, nx); b.st[0] = nloc; b.st[1] = nx; }
        const unsigned old = xb_add(&bar[XB_XSUB(bx_)], 1u);
        const unsigned gen = old / nloc;
        if (old + 1u == (gen + 1u) * nloc) {
            __builtin_amdgcn_fence(__ATOMIC_RELEASE, "agent");
            asm volatile("s_waitcnt vmcnt(0)" ::: "memory");
            const unsigned og = xb_add(&bar[XB_TOP], 1u);
            const unsigned tg = og / nx;
            if (og + 1u == (tg + 1u) * nx) xb_add(&bar[XB_TOPGEN], 1u);
            else XB_SPIN(xb_ld(&bar[XB_TOPGEN]) == tg, bar);
            __builtin_amdgcn_fence(__ATOMIC_ACQUIRE, "agent");
            xb_add(&bar[XB_XGEN(bx_)], 1u);
            asm volatile("s_waitcnt vmcnt(0)" ::: "memory");
        } else {
            XB_SPIN(xb_ld(&bar[XB_XGEN(bx_)]) == gen, bar);
            __builtin_amdgcn_fence(__ATOMIC_ACQUIRE, "agent");
            asm volatile("s_waitcnt vmcnt(0)" ::: "memory");
        }
    }
    __syncthreads();
}

constexpr size_t alup(size_t x) { return (x + 4095) & ~(size_t)4095; }
constexpr size_t CTL_BYTES = 1u << 20;
constexpr size_t SZ_WIN = (size_t)DEPTH * DIN * DM * 2, SZ_WOUT = (size_t)DEPTH * DM * DM * 2, SZ_WGU = (size_t)DEPTH * NE * 2 * FF * DM  , SZ_WDN = (size_t)DEPTH * NE * DM * FF  ;
constexpr size_t SZ_MODP = (size_t)DEPTH * 16 * 17 * 6144 * 4, SZ_MOD = (size_t)DEPTH * 17 * 6144 * 4;
constexpr size_t SZ_X32 = (size_t)MROWS * DM * 2  , SZ_H = (size_t)MROWS * DM * 2, SZ_P = (size_t)MROWS * DIN * 2, SZ_Y = (size_t)MROWS * DM * 2, SZ_YP = (size_t)MROWS * 2 * DM * 2;
constexpr size_t SZ_LIST = (size_t)NE * MROWS * 4, SZ_GW = (size_t)MROWS * 2 * 4;
constexpr int MAXBLK = (MROWS * 2) / 256 + NE;
static_assert((size_t)MAXBLK * 256 * FF * 2 <= SZ_P, "HMID overlays P");
static_assert((size_t)2 * NB * 4 * NCH * 128 * 64 * 4 <= SZ_H, "KVT overlays H");
static_assert((size_t)2 * NB * 4 * NCH * 128 * 64 * 2 <= SZ_YP, "ST overlays YP");
constexpr size_t WS_CTL = 0;
constexpr size_t WS_WIN = CTL_BYTES, WS_WOUT = WS_WIN + alup(SZ_WIN), WS_WGU = WS_WOUT + alup(SZ_WOUT), WS_WDN = WS_WGU + alup(SZ_WGU);
constexpr size_t WS_MODP = WS_WDN + alup(SZ_WDN), WS_MOD = WS_MODP + alup(SZ_MODP);
constexpr size_t WS_X32 = WS_MOD + alup(SZ_MOD), WS_H = WS_X32 + alup(SZ_X32), WS_P = WS_H + alup(SZ_H), WS_Y = WS_P + alup(SZ_P), WS_YP = WS_Y + alup(SZ_Y);
constexpr size_t WS_LIST = WS_YP + alup(SZ_YP), WS_GW = WS_LIST + alup(SZ_LIST), WS_END = WS_GW + alup(SZ_GW);
constexpr int CW_BAR = 4096;
constexpr int CW_CNT = 16384;

constexpr int RING_BYTES = 131072;
constexpr int LDSCTL_OFF = RING_BYTES;
constexpr int LDS_BYTES = 147456;

#define ATTN_STORE16(p,v) (*(u32x4*)(p)=(v))

#define CAS __attribute__((address_space(4)))
__device__ __forceinline__ const float* inp(int i) {
    const CAS unsigned char* k = (const CAS unsigned char*)__builtin_amdgcn_kernarg_segment_ptr();
    asm volatile("" : "+s"(k));
    return *(const float* const CAS*)(k + 8 * i);
}
#define CBAR() do { asm volatile("" ::: "memory"); __builtin_amdgcn_sched_barrier(0); } while (0)
struct Ctx {
    float* out; unsigned char* ws;
    __device__ __forceinline__ const float* x() const { return inp(0); }
    __device__ __forceinline__ const float* c() const { return inp(1); }
    __device__ __forceinline__ const float* ctx() const { return inp(2); }
    __device__ __forceinline__ const float* c_ctx() const { return inp(3); }
    __device__ __forceinline__ const float* ada_w() const { return inp(4); }
    __device__ __forceinline__ const float* ada_b() const { return inp(5); }
    __device__ __forceinline__ const float* norm1() const { return inp(6); }
    __device__ __forceinline__ const float* norm2() const { return inp(7); }
    __device__ __forceinline__ const float* w_in() const { return inp(8); }
    __device__ __forceinline__ const float* w_out() const { return inp(9); }
    __device__ __forceinline__ const float* ret_decay() const { return inp(10); }
    __device__ __forceinline__ const float* win_gain() const { return inp(11); }
    __device__ __forceinline__ const float* win_sink() const { return inp(12); }
    __device__ __forceinline__ const float* glb_gain() const { return inp(13); }
    __device__ __forceinline__ const float* w_router() const { return inp(14); }
    __device__ __forceinline__ const float* b_router() const { return inp(15); }
    __device__ __forceinline__ const float* w_gu() const { return inp(16); }
    __device__ __forceinline__ const float* w_dn() const { return inp(17); }
};

template <int CTRL> __device__ __forceinline__ float dppx(float v) { return __builtin_bit_cast(float, __builtin_amdgcn_update_dpp(0, __builtin_bit_cast(int, v), CTRL, 0xF, 0xF, true)); }
__device__ __forceinline__ float xor1(float v) { return dppx<0xB1>(v); }
__device__ __forceinline__ float xor2(float v) { return dppx<0x4E>(v); }
__device__ __forceinline__ float wave_sum(float v) {
    v += dppx<0xB1>(v); v += dppx<0x4E>(v); v += dppx<0x141>(v); v += dppx<0x140>(v);
    { const unsigned u = __builtin_bit_cast(unsigned, v); auto r = __builtin_amdgcn_permlane16_swap(u, u, false, false); v = __builtin_bit_cast(float, (unsigned)r[0]) + __builtin_bit_cast(float, (unsigned)r[1]); }
    { const unsigned u = __builtin_bit_cast(unsigned, v); auto r = __builtin_amdgcn_permlane32_swap(u, u, false, false); v = __builtin_bit_cast(float, (unsigned)r[0]) + __builtin_bit_cast(float, (unsigned)r[1]); }
    return v;
}
__device__ __forceinline__ float xor16(float v, int lane) { const unsigned u = __builtin_bit_cast(unsigned, v); auto r = __builtin_amdgcn_permlane16_swap(u, u, false, false);
    return __builtin_bit_cast(float, (lane & 16) ? (unsigned)r[0] : (unsigned)r[1]); }
__device__ __forceinline__ float silu_f(float v) { return v * __builtin_amdgcn_rcpf(1.f + __builtin_amdgcn_exp2f(-LOG2E * v)); }
__device__ __forceinline__ float log2_sigmoid(float x) { return -log1pf(expf(-x)) * LOG2E; }

__device__ __forceinline__ void transpose_item(const float* W, int N, int nsrc0, int k0, bf16_t* WT, int K, int nrow0, LAS float* scr, int lane) {
#pragma unroll 8
    for (int i = 0; i < 32; ++i) { const int kk = 2 * i + (lane >> 5); scr[kk * 33 + (lane & 31)] = W[(size_t)(k0 + kk) * N + nsrc0 + (lane & 31)]; }
    asm volatile("s_waitcnt lgkmcnt(0)" ::: "memory");
    const int c = lane & 7;
#pragma unroll
    for (int j = 0; j < 4; ++j) { const int n = (lane >> 3) + 8 * j; const LAS float* s = scr + (8 * c) * 33 + n;
        u32x4 o; o.x = pk2(s[0 * 33], s[1 * 33]); o.y = pk2(s[2 * 33], s[3 * 33]); o.z = pk2(s[4 * 33], s[5 * 33]); o.w = pk2(s[6 * 33], s[7 * 33]);
        *(u32x4*)(WT + (size_t)(nrow0 + n) * K + k0 + 8 * c) = o; }
    asm volatile("s_waitcnt lgkmcnt(0)" ::: "memory");
}
__device__ __forceinline__ unsigned pk4_fp8(float a, float b, float c, float d) { int w = 0; w = __builtin_amdgcn_cvt_pk_fp8_f32(a, b, w, false); w = __builtin_amdgcn_cvt_pk_fp8_f32(c, d, w, true); return (unsigned)w; }
constexpr float W8_SCALE = 64.0f, W8_INV = 1.0f / 64.0f;
__device__ __forceinline__ void transpose_item8(const float* W, int N, int nsrc0, int k0, unsigned char* WT, int K, int nrow0, LAS float* scr, int lane) {
#pragma unroll 8
    for (int i = 0; i < 32; ++i) { const int kk = 2 * i + (lane >> 5); scr[kk * 33 + (lane & 31)] = W[(size_t)(k0 + kk) * N + nsrc0 + (lane & 31)]; }
    asm volatile("s_waitcnt lgkmcnt(0)" ::: "memory");
    const int c = lane & 7;
#pragma unroll
    for (int j = 0; j < 4; ++j) { const int n = (lane >> 3) + 8 * j; const LAS float* s = scr + (8 * c) * 33 + n;
        u32x2 o; o.x = pk4_fp8(s[0 * 33] * W8_SCALE, s[1 * 33] * W8_SCALE, s[2 * 33] * W8_SCALE, s[3 * 33] * W8_SCALE); o.y = pk4_fp8(s[4 * 33] * W8_SCALE, s[5 * 33] * W8_SCALE, s[6 * 33] * W8_SCALE, s[7 * 33] * W8_SCALE);
        *(u32x2*)(WT + (size_t)(nrow0 + n) * K + k0 + 8 * c) = o; }
    asm volatile("s_waitcnt lgkmcnt(0)" ::: "memory");
}
constexpr int IT_WIN = 16 * 80, IT_WOUT = 16 * 32, IT_GU = 16 * 64, IT_DN = 16 * 32, IT_LAYER = IT_WIN + IT_WOUT + NE * (IT_GU + IT_DN);
__device__ __forceinline__ void phase_prologue(const Ctx& C, LAS unsigned char* lds, int G, int vcu, int bx, int tid) {
    const int lane = tid & 63, wave = tid >> 6;
    {
        LAS float* scs = (LAS float*)lds;
        bool have = false;
        for (int it = bx; it < DEPTH * 12 * 16; it += G) {
            if (!have) {
                for (int i = tid; i < 17 * DM; i += 512) { const int r = i >> 10, k = i & 1023; const float v = r < 16 ? C.c()[r * DM + k] : C.c_ctx()[k]; scs[i] = v / (1.f + expf(-v)); }
                __syncthreads(); have = true;
            }
            const int l = it / 192, rem = it % 192, cb = rem / 16, kc = rem % 16;
            const float* w = C.ada_w() + ((size_t)l * DM + kc * 64) * 6144 + cb * 512 + tid;
            float acc[17];
#pragma unroll
            for (int r = 0; r < 17; ++r) acc[r] = 0.f;
#pragma unroll 4
            for (int kk = 0; kk < 64; ++kk) { const float wv = w[(size_t)kk * 6144];
#pragma unroll
                for (int r = 0; r < 17; ++r) acc[r] += scs[r * DM + kc * 64 + kk] * wv; }
            float* mp = (float*)(C.ws + WS_MODP) + ((size_t)(l * 16 + kc) * 17) * 6144 + cb * 512 + tid;
#pragma unroll
            for (int r = 0; r < 17; ++r) mp[(size_t)r * 6144] = acc[r];
        }
        __syncthreads();
    }
    LAS float* scr = (LAS float*)(lds + wave * 16384);
    const int gw = vcu * 8 + wave, NGW = G * 8;
    for (int it = gw; it < DEPTH * IT_LAYER; it += NGW) {
        const int l = it / IT_LAYER; int r = it % IT_LAYER;
        if (r < IT_WIN) { const int kb = r / 80, nb = r % 80;
            transpose_item(C.w_in() + (size_t)l * DM * DIN, DIN, 32 * nb, 64 * kb, (bf16_t*)(C.ws + WS_WIN) + (size_t)l * DIN * DM, DM, 32 * nb, scr, lane); continue; }
        r -= IT_WIN;
        if (r < IT_WOUT) { const int kb = r / 32, nb = r % 32;
            transpose_item(C.w_out() + (size_t)l * DM * DM, DM, 32 * nb, 64 * kb, (bf16_t*)(C.ws + WS_WOUT) + (size_t)l * DM * DM, DM, 32 * nb, scr, lane); continue; }
        r -= IT_WOUT;
        if (r < NE * IT_GU) { const int e = r / IT_GU, q = r % IT_GU, kb = q / 64, nb = q % 64;
            const int np = 32 * nb, tile = np >> 8, within = np & 255, nsrc = within < 128 ? tile * 128 + within : FF + tile * 128 + within - 128;
            transpose_item8(C.w_gu() + (size_t)(l * NE + e) * DM * 2 * FF, 2 * FF, nsrc, 64 * kb, (unsigned char*)(C.ws + WS_WGU) + (size_t)(l * NE + e) * 2 * FF * DM, DM, np, scr, lane); continue; }
        r -= NE * IT_GU;
        { const int e = r / IT_DN, q = r % IT_DN, kb = q / 32, nb = q % 32;
            transpose_item8(C.w_dn() + (size_t)(l * NE + e) * FF * DM, DM, 32 * nb, 64 * kb, (unsigned char*)(C.ws + WS_WDN) + (size_t)(l * NE + e) * DM * FF, FF, 32 * nb, scr, lane); }
    }
}
__device__ __forceinline__ void phase_modsum(const Ctx& C, int G, int bx, int tid) {
    const float* mp = (const float*)(C.ws + WS_MODP); float* mod = (float*)(C.ws + WS_MOD);
    for (int i = bx * 512 + tid; i < DEPTH * 17 * 6144; i += G * 512) {
        const int l = i / (17 * 6144), rem = i % (17 * 6144), r = rem / 6144, n = rem % 6144;
        float s = C.ada_b()[l * 6144 + n];
#pragma unroll
        for (int kc = 0; kc < 16; ++kc) s += mp[((size_t)(l * 16 + kc) * 17 + r) * 6144 + n];
        mod[i] = s;
    }
}

__device__ __forceinline__ f32x4 bf4(u32x2 a) { return (f32x4){bflo(a.x), bfhi(a.x), bflo(a.y), bfhi(a.y)}; }
__device__ __forceinline__ u32x2 pk4(f32x4 v) { u32x2 w; w.x = pk2(v[0], v[1]); w.y = pk2(v[2], v[3]); return w; }
__device__ __forceinline__ void phase_norm1(const Ctx& C, int layer, int gw, int NGW, int lane) {
    const float* mod = (const float*)(C.ws + WS_MOD) + (size_t)layer * 17 * 6144;
    const float* gain = C.norm1() + layer * DM;
    bf16_t* XR = (bf16_t*)(C.ws + WS_X32); bf16_t* H = (bf16_t*)(C.ws + WS_H); const bf16_t* YP = (const bf16_t*)(C.ws + WS_YP);
    const float* xin = C.x(); const float* cin = C.ctx();
    f32x4 nx[4]; u32x2 nr[4], na[4], nb[4];
#define N1_LOAD(mm) do { const int b_ = (mm) / TPB, t_ = (mm) - b_ * TPB; \
        if (layer == 0) { const f32x4* s_ = (const f32x4*)(t_ < CTX ? cin + ((size_t)b_ * CTX + t_) * DM : xin + ((size_t)b_ * SEQ + (t_ - CTX)) * DM) + lane; \
            _Pragma("unroll") for (int j = 0; j < 4; ++j) nx[j] = s_[64 * j]; } \
        else { const u32x2* s_ = (const u32x2*)(XR + (size_t)(mm) * DM) + lane; const u32x2* y0_ = (const u32x2*)(YP + (size_t)(mm) * 2 * DM) + lane; \
            _Pragma("unroll") for (int j = 0; j < 4; ++j) { nr[j] = s_[64 * j]; na[j] = y0_[64 * j]; nb[j] = y0_[DM / 4 + 64 * j]; } } } while (0)
    if (gw < MROWS) N1_LOAD(gw);
    for (int m = gw; m < MROWS; m += NGW) {
        const int b = m / TPB, t = m - b * TPB, set = t < CTX ? 16 : b;
        f32x4 v[4];
        if (layer == 0) {
#pragma unroll
            for (int j = 0; j < 4; ++j) v[j] = nx[j];
        } else {
            const f32x4* g2 = (const f32x4*)(mod - 17 * 6144 + (size_t)set * 6144 + 5 * DM) + lane;
#pragma unroll
            for (int j = 0; j < 4; ++j) v[j] = bf4(nr[j]) + g2[64 * j] * (bf4(na[j]) + bf4(nb[j]));
        }
        if (m + NGW < MROWS) N1_LOAD(m + NGW);
        u32x2* xo = (u32x2*)(XR + (size_t)m * DM) + lane;
        float ss = 0.f;
#pragma unroll
        for (int j = 0; j < 4; ++j) { xo[64 * j] = pk4(v[j]); ss += (v[j][0] * v[j][0] + v[j][1] * v[j][1]) + (v[j][2] * v[j][2] + v[j][3] * v[j][3]); }
        const float rstd = 1.0f / sqrtf(wave_sum(ss) * (1.f / DM) + EPS);
        const f32x4* gp = (const f32x4*)gain + lane; const f32x4* shp = (const f32x4*)(mod + (size_t)set * 6144) + lane; const f32x4* scp = shp + DM / 4;
        u32x2* ho = (u32x2*)(H + (size_t)m * DM) + lane;
#pragma unroll
        for (int j = 0; j < 4; ++j) ho[64 * j] = pk4((v[j] * rstd) * gp[64 * j] * (scp[64 * j] + 1.0f) + shp[64 * j]);
    }
#undef N1_LOAD
}

__device__ __forceinline__ float swz_xor4(float v) { return __builtin_bit_cast(float, __builtin_amdgcn_ds_swizzle(__builtin_bit_cast(int, v), 0x101F)); }
__device__ __forceinline__ float swz_xor8(float v) { return __builtin_bit_cast(float, __builtin_amdgcn_ds_swizzle(__builtin_bit_cast(int, v), 0x201F)); }
__device__ __forceinline__ void phase_qkprep(const Ctx& C, int layer, int gw, int NGW, int lane, bf16_t* PO) {
    const bf16_t* P = (const bf16_t*)(C.ws + WS_P);
    const int hs = lane >> 3, j = lane & 7;
    const int col0 = (hs < 4 ? C_WQ + 64 * hs : hs < 6 ? C_WK + 64 * (hs - 4) : C_GQ + 64 * (hs - 6)) + 8 * j;
    const int col1 = (hs < 2 ? C_GQ + 128 + 64 * hs : C_GK + 64 * ((hs - 2) & 1)) + 8 * j;
    float g0[8], g1[8], inv[8];
    { const float* wg = C.win_gain() + layer * 128; const float* gg = C.glb_gain() + layer * 128;
      const float* s0p = hs < 4 ? wg : hs < 6 ? wg + 64 : gg; const float sc0 = (hs < 4 || hs >= 6) ? QSCALE : 1.f;
      const float* s1p = hs < 2 ? gg : gg + 64; const float sc1 = hs < 2 ? QSCALE : 1.f;
#pragma unroll
      for (int i = 0; i < 8; ++i) { g0[i] = s0p[8 * j + i] * sc0; g1[i] = s1p[8 * j + i] * sc1; inv[i] = exp2f(-(float)(8 * (j & 1) + i) * (13.287712379549449f / 16.0f)); } }
    const bool x2 = (j & 2) != 0, colax = (j & 4) != 0, act1 = lane < 32;
    u32x4 w0 = {0u, 0u, 0u, 0u}, w1 = {0u, 0u, 0u, 0u};
    if (gw < MROWS) { const bf16_t* row = P + (size_t)gw * DIN; w0 = *(const u32x4*)(row + col0); if (act1) w1 = *(const u32x4*)(row + col1); }
    for (int m = gw; m < MROWS; m += NGW) {
        const u32x4 c0 = w0, c1 = w1;
        if (m + NGW < MROWS) { const bf16_t* row = P + (size_t)(m + NGW) * DIN; w0 = *(const u32x4*)(row + col0); if (act1) w1 = *(const u32x4*)(row + col1); }
        const int b = m / TPB, t = m - b * TPB; const bool isx = t >= CTX; const int pos = t - CTX;
        float cs[8], sn[8];
        if (isx) { const float pv = (float)(colax ? (pos & 63) : (pos >> 6));
#pragma unroll
            for (int i = 0; i < 8; ++i) { const float ang = pv * inv[i]; cs[i] = __cosf(ang); sn[i] = x2 ? __sinf(ang) : -__sinf(ang); } }
        else {
#pragma unroll
            for (int i = 0; i < 8; ++i) { cs[i] = 1.f; sn[i] = 0.f; } }
        bf16_t* orow = PO + (size_t)m * (PO == P ? DIN : 256);
#pragma unroll
        for (int pass = 0; pass < 2; ++pass) {
            const u32x4 w = pass ? c1 : c0;
            float x[8] = {bflo(w.x), bfhi(w.x), bflo(w.y), bfhi(w.y), bflo(w.z), bfhi(w.z), bflo(w.w), bfhi(w.w)};
            float ss = 0.f;
#pragma unroll
            for (int i = 0; i < 8; ++i) ss += x[i] * x[i];
            ss += xor1(ss); ss += xor2(ss); ss += swz_xor4(ss);
            const float r = 1.0f / sqrtf(ss * (1.f / 64.f) + EPS);
            float y[8];
#pragma unroll
            for (int i = 0; i < 8; ++i) { x[i] = x[i] * r * (pass ? g1[i] : g0[i]); }
#pragma unroll
            for (int i = 0; i < 8; ++i) { const float pr = xor2(x[i]); y[i] = x[i] * cs[i] + pr * sn[i]; }
            u32x4 o; o.x = pk2(y[0], y[1]); o.y = pk2(y[2], y[3]); o.z = pk2(y[4], y[5]); o.w = pk2(y[6], y[7]);
            const int col = pass ? col1 : col0;
            if (pass == 0 || act1) *(u32x4*)(orow + (PO == P ? col : (col & 127))) = o;
        }
    }
}

__device__ __forceinline__ void stage_vt(const bf16_t* P, size_t r0, int h, LAS bf16_t* VT, int tid) {
#pragma unroll
    for (int i = 0; i < 4; ++i) { const int p = tid + 512 * i, j = p >> 4, dv0 = (p & 15) * 8;
        const u32x4 w = *(const u32x4*)(P + (r0 + j) * DIN + C_RV + h * 128 + dv0);
        VT[(dv0 + 0) * 136 + j] = (bf16_t)(w.x & 0xffffu); VT[(dv0 + 1) * 136 + j] = (bf16_t)(w.x >> 16);
        VT[(dv0 + 2) * 136 + j] = (bf16_t)(w.y & 0xffffu); VT[(dv0 + 3) * 136 + j] = (bf16_t)(w.y >> 16);
        VT[(dv0 + 4) * 136 + j] = (bf16_t)(w.z & 0xffffu); VT[(dv0 + 5) * 136 + j] = (bf16_t)(w.z >> 16);
        VT[(dv0 + 6) * 136 + j] = (bf16_t)(w.w & 0xffffu); VT[(dv0 + 7) * 136 + j] = (bf16_t)(w.w >> 16); }
}
__device__ __forceinline__ void ret_r1_unit(const Ctx& C, int layer, int b, int h, int c, LAS unsigned char* lds, int tid) {
    const int lane = tid & 63, wid = tid >> 6;
    const bf16_t* P = (const bf16_t*)(C.ws + WS_P); float* KVT = (float*)(C.ws + WS_H);
    LAS bf16_t* KzfT = (LAS bf16_t*)lds; LAS bf16_t* KzbT = KzfT + 64 * 136; LAS bf16_t* VT = KzbT + 64 * 136;
    const float lf = log2_sigmoid(C.ret_decay()[(layer * 2 + 0) * 4 + h]), lb = log2_sigmoid(C.ret_decay()[(layer * 2 + 1) * 4 + h]);
    const size_t r0 = (size_t)b * TPB + c * 128;
#pragma unroll
    for (int i = 0; i < 2; ++i) { const int p = tid + 512 * i, j = p >> 3, dk0 = (p & 7) * 8;
        const u32x4 w = *(const u32x4*)(P + (r0 + j) * DIN + C_RK + h * 64 + dk0);
        const float zf = exp2f((float)(127 - j) * lf) * 0.125f, zb = exp2f((float)j * lb) * 0.125f;
        const float x[8] = {bflo(w.x), bfhi(w.x), bflo(w.y), bfhi(w.y), bflo(w.z), bfhi(w.z), bflo(w.w), bfhi(w.w)};
#pragma unroll
        for (int e = 0; e < 8; ++e) { KzfT[(dk0 + e) * 136 + j] = (bf16_t)f2bf(x[e] * zf); KzbT[(dk0 + e) * 136 + j] = (bf16_t)f2bf(x[e] * zb); } }
    stage_vt(P, r0, h, VT, tid);
    __syncthreads();
    const int mb = wid >> 1, nb = wid & 1, r = lane & 31, hh = lane >> 5;
    float z0 = 0.f; asm volatile("" : "+v"(z0)); f32x16 af, ab;
#pragma unroll
    for (int i = 0; i < 16; ++i) { af[i] = z0; ab[i] = z0; }
#pragma unroll
    for (int ks = 0; ks < 8; ++ks) {
        const bf16x8 a = *(const LAS bf16x8*)(VT + (32 * mb + r) * 136 + 16 * ks + 8 * hh);
        const bf16x8 bf = *(const LAS bf16x8*)(KzfT + (32 * nb + r) * 136 + 16 * ks + 8 * hh);
        const bf16x8 bb = *(const LAS bf16x8*)(KzbT + (32 * nb + r) * 136 + 16 * ks + 8 * hh);
        af = __builtin_amdgcn_mfma_f32_32x32x16_bf16(a, bf, af, 0, 0, 0);
        ab = __builtin_amdgcn_mfma_f32_32x32x16_bf16(a, bb, ab, 0, 0, 0);
    }
    float* of = KVT + ((size_t)((0 * NB + b) * 4 + h) * NCH + c) * 8192; float* ob = KVT + ((size_t)((1 * NB + b) * 4 + h) * NCH + c) * 8192;
#pragma unroll
    for (int reg = 0; reg < 16; ++reg) { const int dv = 32 * mb + (reg & 3) + 8 * (reg >> 2) + 4 * hh, dk = 32 * nb + r; of[dv * 64 + dk] = af[reg]; ob[dv * 64 + dk] = ab[reg]; }
    __syncthreads();
}
__device__ __forceinline__ void ret_r2_unit(const Ctx& C, int layer, int u, int tid) {
    const int q = u & 3, bh = (u >> 2) & 63, dir = u >> 8, b = bh >> 2, h = bh & 3;
    const float G = exp2f(128.f * log2_sigmoid(C.ret_decay()[(layer * 2 + dir) * 4 + h]));
    const size_t base = ((size_t)((dir * NB + b) * 4 + h) * NCH) * 8192 + q * 2048 + tid * 4;
    const float* KVT = (const float*)(C.ws + WS_H) + base; bf16_t* ST = (bf16_t*)(C.ws + WS_YP) + base;
    float z0 = 0.f; asm volatile("" : "+v"(z0)); f32x4 S = {z0, z0, z0, z0};
#pragma unroll
    for (int half = 0; half < 2; ++half) {
        f32x4 kv[17];
#pragma unroll
        for (int s = 0; s < 17; ++s) { const int step = half * 17 + s; const int c = dir == 0 ? step : (step < 2 ? 1 - step : 35 - step); kv[s] = *(const f32x4*)(KVT + (size_t)c * 8192); }
#pragma unroll
        for (int s = 0; s < 17; ++s) { const int step = half * 17 + s; const int c = dir == 0 ? step : (step < 2 ? 1 - step : 35 - step);
            u32x2 w; w.x = pk2(S[0], S[1]); w.y = pk2(S[2], S[3]); *(u32x2*)(ST + (size_t)c * 8192) = w;
            S = S * G + kv[s]; }
    }
}
__device__ __forceinline__ void ret_r3_unit(const Ctx& C, int layer, int b, int h, int c, LAS unsigned char* lds, int tid) {
    const int lane = tid & 63, wid = tid >> 6, r = lane & 31, hh = lane >> 5, wr = wid >> 1, wc = wid & 1;
    const bf16_t* P = (const bf16_t*)(C.ws + WS_P);
    LAS float* tab = (LAS float*)lds;
    LAS bf16_t* VT = (LAS bf16_t*)(lds + 2048); LAS bf16_t* Pl = VT + 128 * 136;
    LAS float* Ol = (LAS float*)(lds + 2048);
    const size_t r0 = (size_t)b * TPB + c * 128;
    if (tid < 128) { const float* dec = C.ret_decay(); const float lf = log2_sigmoid(dec[(layer * 2 + 0) * 4 + h]), lb = log2_sigmoid(dec[(layer * 2 + 1) * 4 + h]);
        tab[tid] = exp2f((float)tid * lf) * 0.125f; tab[128 + tid] = exp2f((float)tid * lb) * 0.125f; tab[256 + tid] = exp2f((float)(tid + 1) * lf); tab[384 + tid] = exp2f((float)(128 - tid) * lb); }
    stage_vt(P, r0, h, VT, tid);
    CBAR();
    bf16x8 qf[4];
    { const bf16_t* Qp = P + (r0 + 32 * wr + r) * DIN + C_RQ + h * 64 + 8 * hh;
#pragma unroll
      for (int ks = 0; ks < 4; ++ks) qf[ks] = *(const bf16x8*)(Qp + 16 * ks); }
    float z0 = 0.f; asm volatile("" : "+v"(z0)); f32x16 zv;
#pragma unroll
    for (int i = 0; i < 16; ++i) zv[i] = z0;
    f32x16 acc[2];
    { const bf16_t* Kp = P + (r0 + 64 * wc + r) * DIN + C_RK + h * 64 + 8 * hh;
#pragma unroll
      for (int t = 0; t < 2; ++t) { acc[t] = zv;
#pragma unroll
        for (int ks = 0; ks < 4; ++ks) acc[t] = __builtin_amdgcn_mfma_f32_32x32x16_bf16(qf[ks], *(const bf16x8*)(Kp + (size_t)t * 32 * DIN + 16 * ks), acc[t], 0, 0, 0); } }
    __syncthreads();
#pragma unroll
    for (int t = 0; t < 2; ++t)
#pragma unroll
        for (int reg = 0; reg < 16; ++reg) { const int i = 32 * wr + (reg & 3) + 8 * (reg >> 2) + 4 * hh, j = 64 * wc + 32 * t + r, d = i - j;
            const float D = d > 0 ? tab[d] : (d < 0 ? tab[128 - d] : tab[0] + tab[128]);
            Pl[i * 136 + j] = (bf16_t)f2bf(acc[t][reg] * D); }
    __syncthreads();
    f32x16 o1[2];
    o1[0] = zv; o1[1] = zv;
#pragma unroll
    for (int ks = 0; ks < 8; ++ks) { const bf16x8 a = *(const LAS bf16x8*)(Pl + (32 * wr + r) * 136 + 16 * ks + 8 * hh);
#pragma unroll
        for (int t = 0; t < 2; ++t) o1[t] = __builtin_amdgcn_mfma_f32_32x32x16_bf16(a, *(const LAS bf16x8*)(VT + (64 * wc + 32 * t + r) * 136 + 16 * ks + 8 * hh), o1[t], 0, 0, 0); }
    CBAR();
#pragma unroll
    for (int dir = 0; dir < 2; ++dir) {
        const bf16_t* sp = (const bf16_t*)(C.ws + WS_YP) + ((size_t)((dir * NB + b) * 4 + h) * NCH + c) * 8192 + (64 * wc + r) * 64 + 8 * hh;
#pragma unroll
        for (int t = 0; t < 2; ++t) { acc[t] = zv;
#pragma unroll
            for (int ks = 0; ks < 4; ++ks) acc[t] = __builtin_amdgcn_mfma_f32_32x32x16_bf16(qf[ks], *(const bf16x8*)(sp + t * 32 * 64 + 16 * ks), acc[t], 0, 0, 0); }
#pragma unroll
        for (int t = 0; t < 2; ++t)
#pragma unroll
            for (int reg = 0; reg < 16; ++reg) { const int i = 32 * wr + (reg & 3) + 8 * (reg >> 2) + 4 * hh; o1[t][reg] += tab[256 + 128 * dir + i] * acc[t][reg]; }
        CBAR();
    }
    __syncthreads();
#pragma unroll
    for (int t = 0; t < 2; ++t)
#pragma unroll
        for (int reg = 0; reg < 16; ++reg) { const int i = 32 * wr + (reg & 3) + 8 * (reg >> 2) + 4 * hh, dv = 64 * wc + 32 * t + r; Ol[i * 132 + dv] = o1[t][reg]; }
    __syncthreads();
    { const int row = tid >> 2, q = tid & 3; f32x4 x[8]; float sm = 0.f;
#pragma unroll
      for (int e = 0; e < 8; ++e) { x[e] = *(const LAS f32x4*)(Ol + row * 132 + 32 * q + 4 * e); sm += (x[e][0] + x[e][1]) + (x[e][2] + x[e][3]); }
      sm += xor1(sm); sm += xor2(sm);
      const float mu = sm * (1.f / 128.f); float vs = 0.f;
#pragma unroll
      for (int e = 0; e < 8; ++e) { x[e] = x[e] - mu; vs += (x[e][0] * x[e][0] + x[e][1] * x[e][1]) + (x[e][2] * x[e][2] + x[e][3] * x[e][3]); }
      vs += xor1(vs); vs += xor2(vs);
      const float rstd = 1.0f / sqrtf(vs * (1.f / 128.f) + EPS);
      const bf16_t* gp = P + (r0 + row) * DIN + C_RG + h * 128 + 32 * q; bf16_t* yp = (bf16_t*)(C.ws + WS_Y) + (r0 + row) * DM + h * 128 + 32 * q;
#pragma unroll
      for (int e2 = 0; e2 < 4; ++e2) { const u32x4 gw = *(const u32x4*)(gp + 8 * e2); const f32x4 a = x[2 * e2] * rstd, bq = x[2 * e2 + 1] * rstd;
          u32x4 o; o.x = pk2(a[0] * silu_f(bflo(gw.x)), a[1] * silu_f(bfhi(gw.x))); o.y = pk2(a[2] * silu_f(bflo(gw.y)), a[3] * silu_f(bfhi(gw.y)));
          o.z = pk2(bq[0] * silu_f(bflo(gw.z)), bq[1] * silu_f(bfhi(gw.z))); o.w = pk2(bq[2] * silu_f(bflo(gw.w)), bq[3] * silu_f(bfhi(gw.w)));
          *(u32x4*)(yp + 8 * e2) = o; } }
    __syncthreads();
}

template <bool WIN>
__device__ __forceinline__ void attn_dispatch(const Ctx& C, int layer, int U, int tid, char* lds) {
    using attn_body::bf16;
    int b, h, q0, NT, tdelta;
    if (U < 1024) { b = U >> 6; h = ((U >> 5) & 1) * 2 + ((U >> 4) & 1); q0 = CTX + 256 * (U & 15);
        if (WIN) { const int ts = (q0 / 64 - 2) > 4 ? (q0 / 64 - 2) : 4, te = (q0 / 64 + 6) < 68 ? (q0 / 64 + 6) : 68; NT = 4 + te - ts; tdelta = ts - 4; } else { NT = 68; tdelta = 0; } }
    else { b = (U - 1024) >> 2; h = (U - 1024) & 3; q0 = 0; NT = 4; tdelta = 0; }
    const int kvh = h >> 1;
    const bf16* Pb = (const bf16*)(C.ws + WS_P) + (size_t)b * TPB * DIN; bf16* Yb = (bf16*)(C.ws + WS_Y) + (size_t)b * TPB * DM;
    if (WIN) attn_body::attn_unit<8, true>(Pb + C_WQ + 64 * h, Pb + C_WK + 64 * kvh, Pb + C_WV + 64 * kvh, Yb + 512 + 64 * h, q0, NT, tdelta, C.win_sink()[layer * 4 + h] * LOG2E, tid, lds);
    else     attn_body::attn_unit<8, false>(Pb + C_GQ + 64 * h, Pb + C_GK + 64 * kvh, Pb + C_GV + 64 * kvh, Yb + 768 + 64 * h, q0, NT, tdelta, 0.f, tid, lds);
}
template <bool WIN>
__device__ __forceinline__ void attn_units(const Ctx& C, int layer, int G, int vcu, int bx, int tid, char* lds) {
    const int nctx = (layer == DEPTH - 1) ? 0 : 64;
    if (G == 256) {
        for (int k = 0; k < 4; ++k) attn_dispatch<WIN>(C, layer, vcu * 4 + k, tid, lds);
        if (vcu < nctx) attn_dispatch<WIN>(C, layer, 1024 + vcu, tid, lds);
    } else {
        for (int U = bx; U < 1024 + nctx; U += G) attn_dispatch<WIN>(C, layer, U, tid, lds);
    }
}

__device__ __forceinline__ f32x2 swap32(float a, float b) { auto r = __builtin_amdgcn_permlane32_swap(__builtin_bit_cast(unsigned, a), __builtin_bit_cast(unsigned, b), false, false);
    return (f32x2){__builtin_bit_cast(float, (unsigned)r[0]), __builtin_bit_cast(float, (unsigned)r[1])}; }
__device__ __forceinline__ f32x2 swap16(float a, float b) { auto r = __builtin_amdgcn_permlane16_swap(__builtin_bit_cast(unsigned, a), __builtin_bit_cast(unsigned, b), false, false);
    return (f32x2){__builtin_bit_cast(float, (unsigned)r[0]), __builtin_bit_cast(float, (unsigned)r[1])}; }
__device__ __forceinline__ void phase_norm2_route(const Ctx& C, int layer_c, LAS unsigned char* lds, int G, int bx, int tid) {
    const int layer = layer_c & 3;
    const int lane = tid & 63, wave = tid >> 6;
    const float* mod = (const float*)(C.ws + WS_MOD) + (size_t)layer * 17 * 6144;
    const float* gain = C.norm2() + layer * DM;
    const bf16_t* XR = (const bf16_t*)(C.ws + WS_X32); unsigned char* H = (unsigned char*)(C.ws + WS_H);
    int* list = (int*)(C.ws + WS_LIST); float* GW = (float*)(C.ws + WS_GW);
    unsigned* gcnt = (unsigned*)(C.ws + WS_CTL) + CW_CNT + 64 * layer_c;
    constexpr int RPC = MROWS / 256, RPW = RPC / 8;
    LAS float* wrT = (LAS float*)lds;
    LAS float* lgs = (LAS float*)(lds + 65536);
    LAS int* lcnt = (LAS int*)(lds + 65536 + RPC * 64);
    LAS int* lbase = lcnt + 16;
    LAS int* rec_e = lcnt + 32;
    LAS float* rec_w = (LAS float*)(rec_e + 2 * RPC);
    { const float* wr = C.w_router(); for (int i = tid; i < DM * NE; i += 512) { const int k = i >> 4, e = i & 15; wrT[e * DM + k] = wr[i]; } }
    if (tid < 16) lcnt[tid] = 0;
    __syncthreads();
    const unsigned lo4 = (unsigned)lane * 4u, lo8 = (unsigned)lane * 8u, lo16 = (unsigned)lane * 16u;
#define E_LOADROW(dst, mm) do { const char* xr_ = (const char*)(XR + (size_t)(mm) * DM); _Pragma("unroll") for (int j = 0; j < 4; ++j) dst[j] = *(const u32x2*)(xr_ + (lo8 + 512u * j)); } while (0)
#define E_NORMROW(v, nxr, mm) do { float ss_ = 0.f; _Pragma("unroll") for (int j = 0; j < 4; ++j) { v[j] = bf4(nxr[j]); ss_ += (v[j][0] * v[j][0] + v[j][1] * v[j][1]) + (v[j][2] * v[j][2] + v[j][3] * v[j][3]); } \
        const int b_ = (mm) / TPB, t_ = (mm) - b_ * TPB, set_ = t_ < CTX ? 16 : b_; const float rstd_ = 1.0f / sqrtf(wave_sum(ss_) * (1.f / DM) + EPS); \
        const char* gp_ = (const char*)gain; const char* shp_ = (const char*)(mod + (size_t)set_ * 6144 + 3 * DM); const char* scp_ = shp_ + DM * 4; \
        char* ho_ = (char*)(H + (size_t)(mm) * DM); \
        _Pragma("unroll") for (int j = 0; j < 4; ++j) { v[j] = (v[j] * rstd_) * *(const f32x4*)(gp_ + (lo16 + 1024u * j)) * (*(const f32x4*)(scp_ + (lo16 + 1024u * j)) + 1.0f) + *(const f32x4*)(shp_ + (lo16 + 1024u * j)); \
            *(unsigned*)(ho_ + (lo4 + 256u * j)) = pk4_fp8(v[j][0], v[j][1], v[j][2], v[j][3]); } } while (0)
#define E_REDUCE(pe, rowl) do { float q8_[8], q4_[4], q2_[2]; \
        _Pragma("unroll") for (int e = 0; e < 8; ++e) { const f32x2 r_ = swap32(pe[e], pe[e + 8]); q8_[e] = r_[0] + r_[1]; } \
        _Pragma("unroll") for (int e = 0; e < 4; ++e) { const f32x2 r_ = swap16(q8_[e], q8_[e + 4]); q4_[e] = r_[0] + r_[1]; } \
        _Pragma("unroll") for (int e = 0; e < 2; ++e) { const float keep_ = b3 ? q4_[e + 2] : q4_[e], send_ = b3 ? q4_[e] : q4_[e + 2]; q2_[e] = keep_ + swz_xor8(send_); } \
        float lg_ = (b2 ? q2_[1] : q2_[0]) + swz_xor4(b2 ? q2_[0] : q2_[1]); lg_ += xor2(lg_); lg_ += xor1(lg_); \
        if ((lane & 3) == 0) lgs[(rowl) * 16 + (lane >> 2)] = lg_; } while (0)
    const bool b3 = (lane & 8) != 0, b2 = (lane & 4) != 0;
    for (int chunk = bx; chunk < 256; chunk += G) {
        const int m0 = chunk * RPC + wave * RPW;
        u32x2 nxA[4], nxB[4];
        E_LOADROW(nxA, m0); E_LOADROW(nxB, m0 + 1);
        for (int i = 0; i < RPW; i += 2) {
            f32x4 vA[4], vB[4];
            E_NORMROW(vA, nxA, m0 + i);
            if (i + 2 < RPW) E_LOADROW(nxA, m0 + i + 2);
            E_NORMROW(vB, nxB, m0 + i + 1);
            if (i + 2 < RPW) E_LOADROW(nxB, m0 + i + 3);
            float peA[16], peB[16];
            f32x2 hv[4][4];
#pragma unroll
            for (int j = 0; j < 4; ++j)
#pragma unroll
                for (int c = 0; c < 4; ++c) hv[j][c] = (f32x2){vA[j][c], vB[j][c]};
            const LAS float* wl = wrT + 4 * lane; asm volatile("" : "+v"(wl));
#pragma unroll
            for (int e = 0; e < 16; ++e) { f32x2 a2 = {0.f, 0.f};
#pragma unroll
                for (int j = 0; j < 4; ++j) { const f32x4 w = *(const LAS f32x4*)(wl + e * DM + 256 * j);
#pragma unroll
                    for (int c = 0; c < 4; ++c) a2 = __builtin_elementwise_fma(hv[j][c], (f32x2){w[c], w[c]}, a2); }
                peA[e] = a2[0]; peB[e] = a2[1]; }
            E_REDUCE(peA, wave * RPW + i); E_REDUCE(peB, wave * RPW + i + 1);
        }
#undef E_LOADROW
#undef E_NORMROW
#undef E_REDUCE
        asm volatile("s_waitcnt lgkmcnt(0)" ::: "memory");
        if (lane < RPW) {
            const int rl = wave * RPW + lane; const float* br = C.b_router();
            float sg[16], bs[16];
#pragma unroll
            for (int e4 = 0; e4 < 4; ++e4) { const f32x4 l4 = *(const LAS f32x4*)(lgs + rl * 16 + 4 * e4);
#pragma unroll
                for (int k = 0; k < 4; ++k) { sg[4 * e4 + k] = 1.f / (1.f + expf(-l4[k])); bs[4 * e4 + k] = sg[4 * e4 + k] + br[4 * e4 + k]; } }
            int grp = 0; float best = -1e30f;
#pragma unroll
            for (int g = 0; g < 4; ++g) { const float a0 = bs[4 * g], a1 = bs[4 * g + 1], a2 = bs[4 * g + 2], a3 = bs[4 * g + 3];
                const float hi01 = fmaxf(a0, a1), lo01 = fminf(a0, a1), hi23 = fmaxf(a2, a3), lo23 = fminf(a2, a3);
                const float top = fmaxf(hi01, hi23), second = fmaxf(fminf(hi01, hi23), hi01 >= hi23 ? lo01 : lo23);
                const float sc = top + second; if (sc > best) { best = sc; grp = g; } }
            float c4[4], s4[4];
#pragma unroll
            for (int k = 0; k < 4; ++k) { c4[k] = grp == 0 ? bs[k] : grp == 1 ? bs[4 + k] : grp == 2 ? bs[8 + k] : bs[12 + k]; s4[k] = grp == 0 ? sg[k] : grp == 1 ? sg[4 + k] : grp == 2 ? sg[8 + k] : sg[12 + k]; }
            int l0 = 0; float mx0 = c4[0];
#pragma unroll
            for (int k = 1; k < 4; ++k) if (c4[k] > mx0) { mx0 = c4[k]; l0 = k; }
            int l1 = -1; float mx1 = -1e30f;
#pragma unroll
            for (int k = 0; k < 4; ++k) if (k != l0 && c4[k] > mx1) { mx1 = c4[k]; l1 = k; }
            const float w0 = l0 == 0 ? s4[0] : l0 == 1 ? s4[1] : l0 == 2 ? s4[2] : s4[3], w1 = l1 == 0 ? s4[0] : l1 == 1 ? s4[1] : l1 == 2 ? s4[2] : s4[3];
            const float wn = 1.f / (w0 + w1);
            const int e0 = grp * 4 + l0, e1 = grp * 4 + l1;
            const int p0 = __hip_atomic_fetch_add(lcnt + e0, 1, __ATOMIC_RELAXED, __HIP_MEMORY_SCOPE_WORKGROUP);
            const int p1 = __hip_atomic_fetch_add(lcnt + e1, 1, __ATOMIC_RELAXED, __HIP_MEMORY_SCOPE_WORKGROUP);
            rec_e[2 * rl] = e0 | (p0 << 8); rec_e[2 * rl + 1] = e1 | (p1 << 8); rec_w[2 * rl] = w0 * wn; rec_w[2 * rl + 1] = w1 * wn;
        }
        __syncthreads();
        if (tid < 16) lbase[tid] = (int)__hip_atomic_fetch_add(gcnt + tid, (unsigned)lcnt[tid], __ATOMIC_RELAXED, __HIP_MEMORY_SCOPE_AGENT);
        __syncthreads();
        for (int i = tid; i < 2 * RPC; i += 512) { const int re = rec_e[i], e = re & 255, pp = re >> 8; const int id = (chunk * RPC + (i >> 1)) * 2 + (i & 1);
            list[e * MROWS + lbase[e] + pp] = id; GW[id] = rec_w[i]; }
        __syncthreads();
        if (tid < 16) lcnt[tid] = 0;
        __syncthreads();
    }
}

template <bool GATHER_, int NT>
struct MoeOrder {
    static constexpr bool GATHER = GATHER_;
    const int* list; const LAS int* boff; const LAS int* cnt; int G, c;
    __device__ __forceinline__ bool next(int i, pg8::Unit& u) const {
        const int L = i * G + c; if (L >= boff[16] * NT) return false;
        const int blk = L / NT, pn = L - blk * NT; int e = 0;
#pragma unroll
        for (int k = 1; k < 16; ++k) e += (blk >= boff[k]) ? 1 : 0;
        u.pm = blk; u.pn = e * NT + pn; return true;
    }
    __device__ __forceinline__ unsigned arow(const pg8::Unit& u, int r) const {
        const int e = u.pn / NT, li = (u.pm - boff[e]) * 256 + r;
        const int id = li < cnt[e] ? list[e * MROWS + li] : 0;
        return (unsigned)(id >> 1);
    }
};
struct EpiGateUp {
    static constexpr bool PERM = true;
    unsigned char* O;
    __device__ __forceinline__ void operator()(const f32x4 (&acc)[2][2][4][2], const pg8::Unit& u, int wr, int wc, int fr, int fq) const {
        const int row0 = u.pm * 256 + wr * 64 + fr, col0 = (u.pn & 7) * 128 + wc * 32 + 8 * fq;
#pragma unroll
        for (int ai = 0; ai < 2; ++ai)
#pragma unroll
            for (int m = 0; m < 4; ++m) { const f32x4 a0 = acc[ai][0][m][0] * W8_INV, a1 = acc[ai][0][m][1] * W8_INV, u0 = acc[ai][1][m][0] * W8_INV, u1 = acc[ai][1][m][1] * W8_INV;
                u32x2 w; w.x = pk4_fp8(silu_f(a0[0]) * u0[0], silu_f(a0[1]) * u0[1], silu_f(a0[2]) * u0[2], silu_f(a0[3]) * u0[3]);
                w.y = pk4_fp8(silu_f(a1[0]) * u1[0], silu_f(a1[1]) * u1[1], silu_f(a1[2]) * u1[2], silu_f(a1[3]) * u1[3]);
                *(u32x2*)(O + ((unsigned)(row0 + ai * 128 + m * 16) * (unsigned)FF + (unsigned)col0)) = w; }
    }
};
struct EpiDown {
    static constexpr bool PERM = true;
    bf16_t* YP; const float* GW; const int* list; const LAS int* boff; const LAS int* cnt;
    __device__ __forceinline__ void operator()(const f32x4 (&acc)[2][2][4][2], const pg8::Unit& u, int wr, int wc, int fr, int fq) const {
        const int e = u.pn >> 2, lb = (u.pm - boff[e]) * 256, n = cnt[e]; const int col0 = (u.pn & 3) * 256 + wc * 32 + 8 * fq;
#pragma unroll
        for (int ai = 0; ai < 2; ++ai)
#pragma unroll
            for (int m = 0; m < 4; ++m) { const int li = lb + ai * 128 + wr * 64 + m * 16 + fr;
                if (li < n) { const int id = list[e * MROWS + li]; const float g = GW[id] * W8_INV; const unsigned off = ((unsigned)id * (unsigned)DM + (unsigned)col0) * 2u;
#pragma unroll
                    for (int bj = 0; bj < 2; ++bj) { const f32x4 v0 = acc[ai][bj][m][0] * g, v1 = acc[ai][bj][m][1] * g;
                        u32x4 w; w.x = pk2(v0[0], v0[1]); w.y = pk2(v0[2], v0[3]); w.z = pk2(v1[0], v1[1]); w.w = pk2(v1[2], v1[3]); *(u32x4*)((char*)YP + off + bj * 256) = w; } } }
    }
};
__device__ __forceinline__ void moe_offsets(const Ctx& C, int layer, LAS int* boff, LAS int* cnt, int tid) {
    if (tid == 0) { const unsigned* gcnt = (const unsigned*)(C.ws + WS_CTL) + CW_CNT + 64 * layer; int acc = 0;
        for (int e = 0; e < 16; ++e) { const int n = (int)__hip_atomic_load(gcnt + e, __ATOMIC_RELAXED, __HIP_MEMORY_SCOPE_AGENT); cnt[e] = n; boff[e] = acc; acc += (n + 255) >> 8; }
        boff[16] = acc; }
    __syncthreads();
}

__device__ __forceinline__ void phase_final(const Ctx& C, int gw, int NGW, int lane) {
    const float* mod = (const float*)(C.ws + WS_MOD) + (size_t)(DEPTH - 1) * 17 * 6144;
    const bf16_t* XR = (const bf16_t*)(C.ws + WS_X32); const bf16_t* YP = (const bf16_t*)(C.ws + WS_YP);
    for (int r = gw; r < NB * SEQ; r += NGW) {
        const int b = r / SEQ, t = r - b * SEQ; const size_t m = (size_t)b * TPB + CTX + t;
        const u32x2* xr = (const u32x2*)(XR + m * DM) + lane; const u32x2* y0 = (const u32x2*)(YP + m * 2 * DM) + lane; const u32x2* y1 = y0 + DM / 4;
        const f32x4* g2 = (const f32x4*)(mod + (size_t)b * 6144 + 5 * DM) + lane; f32x4* o = (f32x4*)(C.out + (size_t)r * DM) + lane;
        u32x2 a[4], bb[4], x[4];
#pragma unroll
        for (int j = 0; j < 4; ++j) { x[j] = xr[64 * j]; a[j] = y0[64 * j]; bb[j] = y1[64 * j]; }
#pragma unroll
        for (int j = 0; j < 4; ++j) o[64 * j] = bf4(x[j]) + g2[64 * j] * (bf4(a[j]) + bf4(bb[j]));
    }
}

#ifndef PHMASK
#define PHMASK 0xFFFF
#endif
#ifndef MK_ONE_LAUNCH
#define MK_ONE_LAUNCH 1
#endif
constexpr int PH_PER_LAYER = 9, PH_LAYER0 = 2, PH_FINAL = PH_LAYER0 + DEPTH * PH_PER_LAYER, PH_COUNT = PH_FINAL + 1;
struct Args { const float* in[18]; float* out; unsigned char* ws; int ph_lo, ph_hi, flags, pad; };
__global__ void __launch_bounds__(512, 2) mega_fwd(Args args) {
    extern __shared__ __attribute__((aligned(16))) unsigned char lds_raw[];
    LAS unsigned char* lds = (LAS unsigned char*)lds_raw;
    Ctx C; C.out = args.out; C.ws = args.ws;
    const int tid = threadIdx.x, lane = tid & 63, wave = __builtin_amdgcn_readfirstlane(tid >> 6);
    const int G = gridDim.x; const int bx = blockIdx.x; const int vcu = (G % 8 == 0) ? (bx % 8) * (G / 8) + bx / 8 : bx;
    const int gw = vcu * 8 + wave, NGW = G * 8;
    volatile LAS unsigned* MISC = (volatile LAS unsigned*)(lds + LDSCTL_OFF);
    for (int u = tid; u < (LDS_BYTES - LDSCTL_OFF) / 4; u += 512) ((LAS unsigned*)(lds + LDSCTL_OFF))[u] = 0u;
    __syncthreads();
    const int lo = args.ph_lo, hi = args.ph_hi;
    XcdBarrier bar; bar.bar = (unsigned*)(C.ws + WS_CTL) + CW_BAR; bar.x = 0; bar.st = nullptr;
    if (hi - lo > 1) bar = xcd_barrier_post((unsigned*)(C.ws + WS_CTL) + CW_BAR, MISC);
#define IN(k) (lo <= (k) && (k) < hi)
#define PHASE_IDS() int bx_ = bx, wave_ = wave; LAS unsigned char* lds_ = lds; asm volatile("" : "+s"(bx_), "+s"(wave_), "+s"(lds_)); int lane_; asm volatile("v_mbcnt_lo_u32_b32 %0, -1, 0\n\tv_mbcnt_hi_u32_b32 %0, -1, %0" : "=v"(lane_)); const int tid_ = wave_ * 64 + lane_; \
    const int vcu_ = (G % 8 == 0) ? (bx_ % 8) * (G / 8) + bx_ / 8 : bx_; const int gw_ = vcu_ * 8 + wave_; (void)lane_; (void)gw_; (void)vcu_
#define SEAM(k) do { if (IN(k) && IN((k) + 1)) xcd_barrier(bar); } while (0)

    if (IN(0) && (PHMASK & 1)) { PHASE_IDS(); phase_prologue(C, lds_, G, vcu_, bx_, tid_); } SEAM(0);
    if (IN(1) && (PHMASK & 2)) { PHASE_IDS(); phase_modsum(C, G, bx_, tid_); } SEAM(1);

#ifdef LAYER_UNROLL
#pragma unroll
#else
#pragma nounroll
#endif
    for (int layer = 0; layer < DEPTH; ++layer) {
        const int p0 = PH_LAYER0 + layer * PH_PER_LAYER;
        if (IN(p0 + 0) && (PHMASK & 4)) { PHASE_IDS(); phase_norm1(C, layer, gw_, NGW, lane_); } SEAM(p0 + 0);
        if (IN(p0 + 1) && (PHMASK & 8)) {
            pg8::Gemm g{(const bf16_t*)(C.ws + WS_H), (const bf16_t*)(C.ws + WS_WIN) + (size_t)layer * DIN * DM, MROWS, DIN, DM};
            PHASE_IDS(); pg8::StaticOrder S; S.init(MROWS, DIN, G, bx_);
            pg8::EpiBf16 E{(bf16_t*)(C.ws + WS_P), DIN};
            pg8::gemm_phase<pg8::EpiBf16, pg8::StaticOrder, true>(lds_, g, S, E, tid_);
        } SEAM(p0 + 1);
        if (IN(p0 + 2) && (PHMASK & 16)) {
            PHASE_IDS(); if (!(args.flags & 1)) phase_qkprep(C, layer, gw_, NGW, lane_, (args.flags & 8) ? (bf16_t*)(C.ws + WS_Y) : (bf16_t*)(C.ws + WS_P));
            if (!(args.flags & 8)) for (int u = bx_; u < NB * 4 * NCH; u += G) { const int c = u % NCH, bh = u / NCH; ret_r1_unit(C, layer, bh >> 2, bh & 3, c, lds_, tid_); }
        } SEAM(p0 + 2);
        if (IN(p0 + 3) && (PHMASK & 32)) {
            PHASE_IDS(); for (int u = bx_; u < 512; u += G) ret_r2_unit(C, layer, u, tid_);
            attn_units<false>(C, layer, G, vcu_, bx_, tid_, (char*)lds_);
        } SEAM(p0 + 3);
        if (IN(p0 + 4) && (PHMASK & 64)) {
            PHASE_IDS();
#ifndef NO_WIN
            attn_units<true>(C, layer, G, vcu_, bx_, tid_, (char*)lds_);
#endif
#ifndef NO_R3
            for (int u = bx_; u < NB * 4 * NCH; u += G) { const int c = u % NCH, bh = u / NCH; ret_r3_unit(C, layer, bh >> 2, bh & 3, c, lds_, tid_); }
#endif
        } SEAM(p0 + 4);
        if (IN(p0 + 5) && (PHMASK & 128)) {
            pg8::Gemm g{(const bf16_t*)(C.ws + WS_Y), (const bf16_t*)(C.ws + WS_WOUT) + (size_t)layer * DM * DM, MROWS, DM, DM};
            PHASE_IDS(); pg8::StaticOrder S; S.init(MROWS, DM, G, bx_);
            pg8::EpiResid E{(bf16_t*)(C.ws + ((args.flags & 4) ? WS_P : WS_X32)), (const float*)(C.ws + WS_MOD) + (size_t)layer * 17 * 6144 + 2 * DM};
            pg8::gemm_phase<pg8::EpiResid, pg8::StaticOrder, true>(lds_, g, S, E, tid_);
        } SEAM(p0 + 5);
        if (IN(p0 + 6) && (PHMASK & 256)) { PHASE_IDS(); phase_norm2_route(C, layer + ((args.flags & 2) ? 4 : 0), lds_, G, bx_, tid_); } SEAM(p0 + 6);
        if (IN(p0 + 7) && (PHMASK & 512)) {
            PHASE_IDS(); LAS int* boff = (LAS int*)(lds_ + LDSCTL_OFF + 64); LAS int* mcnt = (LAS int*)(lds_ + LDSCTL_OFF + 192); moe_offsets(C, layer, boff, mcnt, tid_);
            pg8::Gemm g{(const bf16_t*)(C.ws + WS_H), (const bf16_t*)(C.ws + WS_WGU + (size_t)layer * NE * 2 * FF * DM), 0, 2 * FF, DM};
            MoeOrder<true, 8> S{(const int*)(C.ws + WS_LIST), boff, mcnt, G, bx_};
            EpiGateUp E{(unsigned char*)(C.ws + WS_P)};
            pg8::gemm_phase<EpiGateUp, MoeOrder<true, 8>, true, true>(lds_, g, S, E, tid_);
        } SEAM(p0 + 7);
        if (IN(p0 + 8) && (PHMASK & 1024)) {
            PHASE_IDS(); LAS int* boff = (LAS int*)(lds_ + LDSCTL_OFF + 64); LAS int* mcnt = (LAS int*)(lds_ + LDSCTL_OFF + 192); moe_offsets(C, layer, boff, mcnt, tid_);
            pg8::Gemm g{(const bf16_t*)(C.ws + WS_P), (const bf16_t*)(C.ws + WS_WDN + (size_t)layer * NE * DM * FF), 0, DM, FF};
            MoeOrder<false, 4> S{(const int*)(C.ws + WS_LIST), boff, mcnt, G, bx_};
            EpiDown E{(bf16_t*)(C.ws + WS_YP), (const float*)(C.ws + WS_GW), (const int*)(C.ws + WS_LIST), boff, mcnt};
            pg8::gemm_phase<EpiDown, MoeOrder<false, 4>, true, true>(lds_, g, S, E, tid_);
        } SEAM(p0 + 8);
    }
    if (IN(PH_FINAL) && (PHMASK & 2048)) { PHASE_IDS(); phase_final(C, gw_, NGW, lane_); }
#undef IN
#undef SEAM
}

extern "C" void kernel_launch(void* const* d_in, const int* in_sizes, int n_in, void* d_out, int out_size, void* d_ws, size_t ws_size, hipStream_t stream) {
    static int grid = 0;
    if (grid == 0) {
        if (n_in != 18 || in_sizes[0] != NB * SEQ * DM || out_size != NB * SEQ * DM || ws_size < WS_END) {
            fprintf(stderr, "kernel_launch: unexpected shapes (n_in %d, in0 %d, out %d, ws %zu, need %zu); nothing launched\n", n_in, n_in > 0 ? in_sizes[0] : -1, out_size, ws_size, (size_t)WS_END); grid = -1; return; }
        int dev = 0, cus = 0, per_cu = 0;
        if (hipGetDevice(&dev) != hipSuccess || hipDeviceGetAttribute(&cus, hipDeviceAttributeMultiprocessorCount, dev) != hipSuccess) { grid = -1; return; }
        if (hipFuncSetAttribute((const void*)mega_fwd, hipFuncAttributeMaxDynamicSharedMemorySize, LDS_BYTES) != hipSuccess) { fprintf(stderr, "kernel_launch: hipFuncSetAttribute failed\n"); grid = -1; return; }
        if (hipOccupancyMaxActiveBlocksPerMultiprocessor(&per_cu, (const void*)mega_fwd, 512, LDS_BYTES) != hipSuccess || per_cu < 1) fprintf(stderr, "kernel_launch: occupancy query says %d\n", per_cu);
        (void)hipGetLastError();
        grid = cus;
    }
    if (grid < 0) return;
    if (hipMemsetAsync((char*)d_ws + WS_CTL, 0, CTL_BYTES, stream) != hipSuccess) return;
    Args a{};
    for (int i = 0; i < 18; ++i) a.in[i] = (const float*)d_in[i];
    a.out = (float*)d_out; a.ws = (unsigned char*)d_ws;
#if MK_ONE_LAUNCH
    a.ph_lo = 0; a.ph_hi = PH_COUNT;
    hipLaunchKernelGGL(mega_fwd, dim3(grid), dim3(512), LDS_BYTES, stream, a);
#else
    for (int p = 0; p < PH_COUNT; ++p) { a.ph_lo = p; a.ph_hi = p + 1;
#if !defined(PROBE_P) || !PROBE_BEFORE
        hipLaunchKernelGGL(mega_fwd, dim3(grid), dim3(512), LDS_BYTES, stream, a);
#endif
#ifdef PROBE_P
        const bool hit = (PROBE_P < 2) ? (p == PROBE_P) : (p >= PH_LAYER0 && p < PH_FINAL && (p - PH_LAYER0) % PH_PER_LAYER == PROBE_P - 2 && (!PROBE_L0 || p < PH_LAYER0 + PH_PER_LAYER));
        if (hit) { a.flags = PROBE_FLAGS; for (int r = 0; r < PROBE_REP; ++r) hipLaunchKernelGGL(mega_fwd, dim3(grid), dim3(512), LDS_BYTES, stream, a); a.flags = 0; }
#if PROBE_BEFORE
        hipLaunchKernelGGL(mega_fwd, dim3(grid), dim3(512), LDS_BYTES, stream, a);
#endif
#endif
    }
#endif
}
```

```cpp
#define MK_ONE_LAUNCH 1
#include <hip/hip_runtime.h>
#include <cstdio>
#include <cstdint>

#define GAS __attribute__((address_space(1)))
#define LAS __attribute__((address_space(3)))
typedef unsigned short bf16_t;
typedef short bf16x8 __attribute__((ext_vector_type(8)));
typedef float f32x4 __attribute__((ext_vector_type(4)));
typedef float f32x2 __attribute__((ext_vector_type(2)));
typedef float f32x16 __attribute__((ext_vector_type(16)));
typedef unsigned u32x4 __attribute__((ext_vector_type(4)));
typedef unsigned u32x2 __attribute__((ext_vector_type(2)));

constexpr int DM = 1024, NB = 16, SEQ = 4096, CTX = 256, TPB = SEQ + CTX, MROWS = NB * TPB, DEPTH = 4;
constexpr int DIN = 2560;
constexpr int C_RQ = 0, C_RK = 256, C_RV = 512, C_RG = 1024, C_WQ = 1536, C_WK = 1792, C_WV = 1920, C_GQ = 2048, C_GK = 2304, C_GV = 2432;
constexpr int NE = 16, FF = 1024, NCH = TPB / 128;
constexpr float EPS = 1e-6f;
constexpr float LOG2E = 1.4426950408889634f;
constexpr float QSCALE = 0.125f * LOG2E;

__device__ __forceinline__ unsigned f2bf(float f) { unsigned u = __builtin_bit_cast(unsigned, f); return (u + 0x7fffu + ((u >> 16) & 1u)) >> 16; }
__device__ __forceinline__ unsigned pk2(float lo, float hi) { return f2bf(lo) | (f2bf(hi) << 16); }
__device__ __forceinline__ float bf2f(unsigned short h) { return __builtin_bit_cast(float, (unsigned)h << 16); }
__device__ __forceinline__ float bflo(unsigned w) { return __builtin_bit_cast(float, w << 16); }
__device__ __forceinline__ float bfhi(unsigned w) { return __builtin_bit_cast(float, w & 0xffff0000u); }

namespace pg8 {
constexpr int BM = 256, BK = 64, HALF = 128, HTB = HALF * BK * 2, STAGE_BYTES = 8 * HTB, NXCD = 8, WGM = 8;
__host__ __device__ __forceinline__ int lds_byte(int r, int c) { const int st = (r >> 4) * 2 + (c >> 5), rr = r & 15, cc = c & 31, ob = rr * 64 + cc * 2; return st * 1024 + (ob ^ (((ob >> 9) & 1) << 5)); }
__host__ __device__ __forceinline__ void stage_rc(int b, int& R, int& C) { const int st = b / 1024, sb = b % 1024, swz = sb ^ (((sb >> 9) & 1) << 5); R = (st >> 1) * 16 + swz / 64; C = (st & 1) * 32 + (swz % 64) / 2; }
__host__ __device__ __forceinline__ int perm32(int rho) { const int n = rho >> 4, i = rho & 15; return 8 * (i >> 2) + 4 * n + (i & 3); }

struct Unit { int pm, pn; };
struct Gemm { const bf16_t* A; const bf16_t* Bt; int M, N, K; };

struct StaticOrder {
    static constexpr bool GATHER = false;
    int nM, nN, nwg, G, c;
    __device__ void init(int M, int N, int G_, int c_) { nM = M / BM; nN = N / BM; nwg = nM * nN; G = G_; c = c_; }
    __device__ bool next(int i, Unit& u) const {
        const long L = (long)i * G + c; if (L >= nwg) return false;
        int wgid = (int)L; { const int q = nwg / NXCD, r = nwg % NXCD, xcd = wgid % NXCD, off = wgid / NXCD; wgid = (xcd < r ? xcd * (q + 1) : r * (q + 1) + (xcd - r) * q) + off; }
        const int nig = WGM * nN, gid = wgid / nig, fm = gid * WGM, gsz = (nM - fm) < WGM ? (nM - fm) : WGM;
        u.pm = fm + ((wgid % nig) % gsz); u.pn = (wgid % nig) / gsz; return true;
    }
    __device__ __forceinline__ unsigned arow(const Unit&, int) const { return 0u; }
};

__device__ __forceinline__ unsigned cvt_pk_bf16(float lo, float hi) { unsigned r; asm volatile("v_cvt_pk_bf16_f32 %0, %1, %2" : "=v"(r) : "v"(lo), "v"(hi)); return r; }

struct EpiBf16 {
    static constexpr bool PERM = true;
    bf16_t* O; int ldc;
    __device__ __forceinline__ void operator()(const f32x4 (&acc)[2][2][4][2], const Unit& u, int wr, int wc, int fr, int fq) const {
        const int row0 = u.pm * BM + wr * 64 + fr; const int col0 = u.pn * BM + wc * 32 + 8 * fq;
#pragma unroll
        for (int ai = 0; ai < 2; ++ai)
#pragma unroll
            for (int m = 0; m < 4; ++m) { const unsigned off = ((unsigned)(row0 + ai * HALF + m * 16) * (unsigned)ldc + (unsigned)col0) * 2u;
#pragma unroll
                for (int bj = 0; bj < 2; ++bj) { const f32x4 v0 = acc[ai][bj][m][0], v1 = acc[ai][bj][m][1];
                    u32x4 w; w.x = cvt_pk_bf16(v0[0], v0[1]); w.y = cvt_pk_bf16(v0[2], v0[3]); w.z = cvt_pk_bf16(v1[0], v1[1]); w.w = cvt_pk_bf16(v1[2], v1[3]);
                    *(u32x4*)((char*)O + off + bj * HALF * 2) = w; } }
    }
};

struct EpiResid {
    static constexpr bool PERM = true;
    bf16_t* X; const float* gate;
    __device__ __forceinline__ void operator()(const f32x4 (&acc)[2][2][4][2], const Unit& u, int wr, int wc, int fr, int fq) const {
        const int set = (u.pm % 17 == 0) ? 16 : (u.pm / 17);
        const float* gp = gate + (size_t)set * 6 * DM;
        const int col0 = u.pn * BM + wc * 32 + 8 * fq;
        f32x4 gv[2][2];
#pragma unroll
        for (int bj = 0; bj < 2; ++bj)
#pragma unroll
            for (int n = 0; n < 2; ++n) gv[bj][n] = *(const f32x4*)(gp + col0 + bj * HALF + n * 4);
#pragma unroll
        for (int ai = 0; ai < 2; ++ai) {
            u32x4 xin[4][2];
#pragma unroll
            for (int m = 0; m < 4; ++m) { const unsigned off = ((unsigned)(u.pm * BM + ai * HALF + wr * 64 + m * 16 + fr) * (unsigned)DM + (unsigned)col0) * 2u;
#pragma unroll
                for (int bj = 0; bj < 2; ++bj) xin[m][bj] = *(const u32x4*)((const char*)X + off + bj * HALF * 2); }
            asm volatile("" ::: "memory");
#pragma unroll
            for (int m = 0; m < 4; ++m) { const unsigned off = ((unsigned)(u.pm * BM + ai * HALF + wr * 64 + m * 16 + fr) * (unsigned)DM + (unsigned)col0) * 2u;
#pragma unroll
                for (int bj = 0; bj < 2; ++bj) { const u32x4 x = xin[m][bj]; const f32x4 a0 = acc[ai][bj][m][0] * gv[bj][0], a1 = acc[ai][bj][m][1] * gv[bj][1];
                    u32x4 w; w.x = cvt_pk_bf16(bflo(x.x) + a0[0], bfhi(x.x) + a0[1]); w.y = cvt_pk_bf16(bflo(x.y) + a0[2], bfhi(x.y) + a0[3]);
                    w.z = cvt_pk_bf16(bflo(x.z) + a1[0], bfhi(x.z) + a1[1]); w.w = cvt_pk_bf16(bflo(x.w) + a1[2], bfhi(x.w) + a1[3]);
                    *(u32x4*)((char*)X + off + bj * HALF * 2) = w; } }
            asm volatile("" ::: "memory");
        }
    }
};

template <class Epi, class Sched, bool ALIGN_EPI, bool FP8 = false>
__device__ __forceinline__ void gemm_phase(LAS unsigned char* lds, const Gemm g, const Sched& S, const Epi& E, const int tid) {
    const int wid = __builtin_amdgcn_readfirstlane(tid >> 6), lane = tid & 63, wr = wid >> 2, wc = wid & 3, fr = lane & 15, fq = lane >> 4;
    const int K = g.K, KB = FP8 ? K : 2 * K  , nt = KB / (BK * 2);
    unsigned voffB[2], vA[2][2], vAn[2][2]; int sR[2], sC[2];
#pragma unroll
    for (int i = 0; i < 2; ++i) { int R, C; stage_rc(tid * 16 + i * 8192, R, C); sR[i] = R; sC[i] = C; const int Rb = Epi::PERM ? ((R & ~31) + perm32(R & 31)) : R;
        voffB[i] = (unsigned)(Rb * KB + C * 2); }
#define PG8_SETV(v, u) do { _Pragma("unroll") for (int h_ = 0; h_ < 2; ++h_) _Pragma("unroll") for (int i_ = 0; i_ < 2; ++i_) { \
        if constexpr (Sched::GATHER) v[h_][i_] = S.arow(u, h_ * HALF + sR[i_]) * (unsigned)KB + (unsigned)(sC[i_] * 2); \
        else v[h_][i_] = (unsigned)((h_ * HALF + sR[i_]) * KB + sC[i_] * 2); } } while (0)
    const size_t kstep = (size_t)(BK * 2);
    const size_t hstep = (size_t)HALF * KB;
    const size_t tstep = 2 * hstep;
    const size_t atstep = Sched::GATHER ? (size_t)0 : tstep;
    const unsigned ldsw = (unsigned)wid * 1024u;
    const int aoff = lds_byte(wr * 64 + fr, fq * 8), boff = lds_byte(wc * 32 + fr, fq * 8);
#define PG8_SA(b, h) (((b) * 2 + (h)) * HTB)
#define PG8_SB(b, h) ((4 + (b) * 2 + (h)) * HTB)
#define PG8_STAGE(bufoff, gbase, voff) do { _Pragma("unroll") for (int _i = 0; _i < 2; ++_i) \
        __builtin_amdgcn_global_load_lds((const unsigned*)((const char*)(gbase) + (voff)[_i]), (LAS unsigned*)(lds + (bufoff) + ldsw + _i * 8192), 16, 0, 0); } while (0)
#define PG8_LDA(dst, b, h) do { _Pragma("unroll") for (int m = 0; m < 4; ++m) _Pragma("unroll") for (int k = 0; k < 2; ++k) dst[m][k] = *(const LAS bf16x8*)(lds + PG8_SA(b, h) + aoff + m * 2048 + k * 1024); } while (0)
#define PG8_LDB(dst, b, h) do { _Pragma("unroll") for (int n = 0; n < 2; ++n) _Pragma("unroll") for (int k = 0; k < 2; ++k) dst[n][k] = *(const LAS bf16x8*)(lds + PG8_SB(b, h) + boff + n * 2048 + k * 1024); } while (0)
    typedef long i64x2_ __attribute__((ext_vector_type(2)));
#define PG8_MMA(ai, bj, At, Bt) do { __builtin_amdgcn_s_setprio(1); _Pragma("unroll") for (int m = 0; m < 4; ++m) _Pragma("unroll") for (int n = 0; n < 2; ++n) _Pragma("unroll") for (int k = 0; k < 2; ++k) { \
        if constexpr (FP8) { const i64x2_ b2_ = __builtin_bit_cast(i64x2_, Bt[n][k]), a2_ = __builtin_bit_cast(i64x2_, At[m][k]); \
            acc[ai][bj][m][n] = __builtin_amdgcn_mfma_f32_16x16x32_fp8_fp8(b2_[0], a2_[0], acc[ai][bj][m][n], 0, 0, 0); \
            acc[ai][bj][m][n] = __builtin_amdgcn_mfma_f32_16x16x32_fp8_fp8(b2_[1], a2_[1], acc[ai][bj][m][n], 0, 0, 0); } \
        else acc[ai][bj][m][n] = __builtin_amdgcn_mfma_f32_16x16x32_bf16(Bt[n][k], At[m][k], acc[ai][bj][m][n], 0, 0, 0); } \
        __builtin_amdgcn_s_setprio(0); } while (0)
#define PG8_WAIT_V(n) asm volatile("s_waitcnt vmcnt(" #n ")" ::: "memory")
#define PG8_WAIT_L(n) asm volatile("s_waitcnt lgkmcnt(" #n ")" ::: "memory")
#define PG8_BAR __builtin_amdgcn_s_barrier()
#define PG8_SCHED __builtin_amdgcn_sched_barrier(0)
    Unit cur, nxt; int ui = 0;
    if (!S.next(0, cur)) return;
    float z0 = 0.f; asm volatile("" : "+v"(z0));
    f32x4 acc[2][2][4][2];
#pragma unroll
    for (int a = 0; a < 2; ++a)
#pragma unroll
        for (int b = 0; b < 2; ++b)
#pragma unroll
            for (int m = 0; m < 4; ++m)
#pragma unroll
                for (int n = 0; n < 2; ++n) acc[a][b][m][n] = (f32x4){z0, z0, z0, z0};
    bf16x8 At[4][2], B0[2][2], B1[2][2];
    const char* cA = (const char*)g.A + (size_t)cur.pm * atstep; const char* cB = (const char*)g.Bt + (size_t)cur.pn * tstep;
    PG8_SETV(vA, cur);
    PG8_STAGE(PG8_SB(0, 0), cB, voffB); PG8_STAGE(PG8_SB(0, 1), cB + hstep, voffB); PG8_STAGE(PG8_SA(0, 0), cA, vA[0]); PG8_STAGE(PG8_SA(0, 1), cA, vA[1]);
    if (wr == 1) PG8_BAR;
    PG8_WAIT_V(2); PG8_BAR;
    PG8_STAGE(PG8_SB(1, 0), cB + kstep, voffB); PG8_STAGE(PG8_SA(1, 0), cA + kstep, vA[0]); PG8_STAGE(PG8_SB(1, 1), cB + hstep + kstep, voffB);
    PG8_WAIT_V(6); PG8_BAR;
    for (;;) {
        const bool has_next = S.next(ui + 1, nxt);
        const char* nA = has_next ? (const char*)g.A + (size_t)nxt.pm * atstep : cA; const char* nB = has_next ? (const char*)g.Bt + (size_t)nxt.pn * tstep : cB;
        if (has_next) { PG8_SETV(vAn, nxt); } else {
#pragma unroll
            for (int h_ = 0; h_ < 2; ++h_)
#pragma unroll
                for (int i_ = 0; i_ < 2; ++i_) vAn[h_][i_] = vA[h_][i_]; }
        for (int t = 0; t < nt; t += 2) {
            const bool last = (t == nt - 2);
            const char* a1 = cA + (size_t)(t + 1) * kstep;
            const char* a2 = last ? nA : cA + (size_t)(t + 2) * kstep; const char* b2 = last ? nB : cB + (size_t)(t + 2) * kstep;
            const char* a3 = a2 + kstep; const char* b3 = b2 + kstep;
            unsigned o2[2][2];
#pragma unroll
            for (int h_ = 0; h_ < 2; ++h_)
#pragma unroll
                for (int i_ = 0; i_ < 2; ++i_) o2[h_][i_] = last ? vAn[h_][i_] : vA[h_][i_];
            PG8_LDB(B0, 0, 0); PG8_LDB(B1, 0, 1); PG8_SCHED; PG8_LDA(At, 0, 0); PG8_STAGE(PG8_SA(1, 1), a1, vA[1]);
            PG8_WAIT_V(8); PG8_WAIT_L(0); PG8_BAR; PG8_MMA(0, 0, At, B0); PG8_MMA(0, 1, At, B1); PG8_BAR; PG8_SCHED;
            PG8_LDA(At, 0, 1); PG8_STAGE(PG8_SB(0, 0), b2, voffB); PG8_STAGE(PG8_SB(0, 1), b2 + hstep, voffB); PG8_STAGE(PG8_SA(0, 0), a2, o2[0]);
            PG8_WAIT_V(8); PG8_WAIT_L(0); PG8_BAR; PG8_MMA(1, 0, At, B0); PG8_MMA(1, 1, At, B1); PG8_BAR; PG8_SCHED;
            PG8_LDB(B0, 1, 0); PG8_LDB(B1, 1, 1); PG8_SCHED; PG8_LDA(At, 1, 0); PG8_STAGE(PG8_SA(0, 1), a2, o2[1]);
            PG8_WAIT_V(8); PG8_WAIT_L(0); PG8_BAR; PG8_MMA(0, 0, At, B0); PG8_MMA(0, 1, At, B1); PG8_BAR; PG8_SCHED;
            PG8_LDA(At, 1, 1); PG8_STAGE(PG8_SB(1, 0), b3, voffB); PG8_STAGE(PG8_SB(1, 1), b3 + hstep, voffB); PG8_STAGE(PG8_SA(1, 0), a3, o2[0]);
            PG8_WAIT_V(8); PG8_WAIT_L(0); PG8_BAR; PG8_MMA(1, 0, At, B0); PG8_MMA(1, 1, At, B1); PG8_BAR; PG8_SCHED;
        }
        if constexpr (ALIGN_EPI) { if (wr == 0) PG8_BAR; }
        E(acc, cur, wr, wc, fr, fq);
        if (!has_next) break;
#pragma unroll
        for (int a = 0; a < 2; ++a)
#pragma unroll
            for (int b = 0; b < 2; ++b)
#pragma unroll
                for (int m = 0; m < 4; ++m)
#pragma unroll
                    for (int n = 0; n < 2; ++n) acc[a][b][m][n] = (f32x4){z0, z0, z0, z0};
        cur = nxt; cA = nA; cB = nB; ++ui;
#pragma unroll
        for (int h_ = 0; h_ < 2; ++h_)
#pragma unroll
            for (int i_ = 0; i_ < 2; ++i_) vA[h_][i_] = vAn[h_][i_];
        if constexpr (ALIGN_EPI) { if (wr == 1) PG8_BAR; }
    }
    PG8_WAIT_V(0);
    if constexpr (!ALIGN_EPI) { if (wr == 0) PG8_BAR; }
    PG8_BAR;
#undef PG8_SETV
#undef PG8_SA
#undef PG8_SB
#undef PG8_STAGE
#undef PG8_LDA
#undef PG8_LDB
#undef PG8_MMA
#undef PG8_WAIT_V
#undef PG8_WAIT_L
#undef PG8_BAR
#undef PG8_SCHED
}
}
#include <hip/hip_bf16.h>
#include <cmath>
namespace attn_body {
using bf16=__hip_bfloat16;
using s16x4=__attribute__((ext_vector_type(4)))short;
constexpr int D=64,QP=DIN,OP=1024;
constexpr int NW=8,QBLK=32,QB=QBLK*NW,KVBLK=64;
__device__ __forceinline__ int crow(int r,int hi){return (r&3)+8*(r>>2)+4*hi;}
#define SBAR() __builtin_amdgcn_sched_barrier(0)
__device__ __forceinline__ void wmask(f32x16&p0,f32x16&p1,int kq,int hi){
  const float NEG=-INFINITY; const int kb=kq+4*hi;
  #pragma unroll
  for(int r=0;r<16;++r){const int d=kb+(r&3)+8*(r>>2); if(d>128||d<-128)p0[r]=NEG; if(d+32>128||d+32<-128)p1[r]=NEG;}
}

constexpr int NSLOT=3, SLOTB=8192;
constexpr int LDS_K=0, LDS_V=NSLOT*SLOTB, LDS_WS=2*NSLOT*SLOTB, LDS_OST=LDS_WS+NW*64*4, LDS_BYTES=LDS_OST+NW*4096;
constexpr float C2=0.125f*1.4426950408889634f;
__device__ __forceinline__ void glds16(const void*gsrc,unsigned lds_dst){unsigned keep;
  asm volatile("s_mov_b32 %0, m0\n\ts_mov_b32 m0, %2\n\ts_nop 0\n\tglobal_load_lds_dwordx4 %1, off\n\ts_mov_b32 m0, %0":"=&s"(keep):"v"(gsrc),"s"(lds_dst):"memory");}
__device__ __forceinline__ float max3f(float a,float b,float c){float r;asm("v_max3_f32 %0, %1, %2, %3":"=v"(r):"v"(a),"v"(b),"v"(c));return r;}
__device__ __forceinline__ float max2f(float a,float b){float r;asm("v_max_f32_e32 %0, %1, %2":"=v"(r):"v"(a),"v"(b));return r;}
__device__ __forceinline__ float fadd_s(float a,float b){float r;asm("v_add_f32_e32 %0, %1, %2":"=v"(r):"v"(a),"v"(b));return r;}
__device__ __forceinline__ float fsub_s(float a,float b){float r;asm("v_sub_f32_e32 %0, %1, %2":"=v"(r):"v"(a),"v"(b));return r;}
typedef float f32x2_t __attribute__((ext_vector_type(2))); typedef __bf16 bf16x2_t __attribute__((ext_vector_type(2)));
__device__ __forceinline__ unsigned cvtpk_s(float lo,float hi){f32x2_t v={lo,hi};bf16x2_t b=__builtin_convertvector(v,bf16x2_t);return __builtin_bit_cast(unsigned,b);}
#define WAIT_BAR(N) asm volatile("s_waitcnt vmcnt(" #N ") lgkmcnt(0)\n\ts_barrier":::"memory")

__device__ __forceinline__ void qkt(f32x16&p0,f32x16&p1,const char*Kslot,const bf16x8*qr,const f32x16&negm,int r32,int hi){
  const char*kb=Kslot+hi*1024+r32*16;
  #pragma unroll
  for(int d0=0;d0<4;++d0){
    const bf16x8 b0=*reinterpret_cast<const bf16x8*>(kb+d0*2048);
    const bf16x8 b1=*reinterpret_cast<const bf16x8*>(kb+d0*2048+512);
    if(d0==0){p0=__builtin_amdgcn_mfma_f32_32x32x16_bf16(b0,qr[0],negm,0,0,0);p1=__builtin_amdgcn_mfma_f32_32x32x16_bf16(b1,qr[0],negm,0,0,0);}
    else{p0=__builtin_amdgcn_mfma_f32_32x32x16_bf16(b0,qr[d0],p0,0,0,0);p1=__builtin_amdgcn_mfma_f32_32x32x16_bf16(b1,qr[d0],p1,0,0,0);}}
}
typedef __attribute__((address_space(3))) const char* lds_cptr;
typedef short v4i16_t __attribute__((ext_vector_type(4)));
__device__ __forceinline__ void kload8(bf16x8*kf,lds_cptr kp){
  kf[0]=*(const __attribute__((address_space(3))) bf16x8*)(kp);      kf[1]=*(const __attribute__((address_space(3))) bf16x8*)(kp+512);
  kf[2]=*(const __attribute__((address_space(3))) bf16x8*)(kp+2048); kf[3]=*(const __attribute__((address_space(3))) bf16x8*)(kp+2560);
  kf[4]=*(const __attribute__((address_space(3))) bf16x8*)(kp+4096); kf[5]=*(const __attribute__((address_space(3))) bf16x8*)(kp+4608);
  kf[6]=*(const __attribute__((address_space(3))) bf16x8*)(kp+6144); kf[7]=*(const __attribute__((address_space(3))) bf16x8*)(kp+6656);
}
__device__ __forceinline__ void kload2(bf16x8*kf,lds_cptr kp,int j){ kf[2*j]=*(const __attribute__((address_space(3))) bf16x8*)(kp+j*2048); kf[2*j+1]=*(const __attribute__((address_space(3))) bf16x8*)(kp+j*2048+512); }
__device__ __forceinline__ s16x4 vtr(lds_cptr p){ return __builtin_bit_cast(s16x4,__builtin_amdgcn_ds_read_tr16_b64_v4i16((__attribute__((address_space(3))) v4i16_t*)p)); }
__device__ __forceinline__ float rowmax(const f32x16&p0,const f32x16&p1){
  float a=max3f(p0[0],p0[1],p1[0]),b=max3f(p0[2],p0[3],p1[1]);a=max3f(a,p1[2],p1[3]);
  #pragma unroll
  for(int r=4;r<16;r+=4){a=max3f(a,p0[r],p0[r+1]);b=max3f(b,p0[r+2],p0[r+3]);a=max3f(a,p1[r],p1[r+1]);b=max3f(b,p1[r+2],p1[r+3]);}
  const float m=max2f(a,b);
  auto rr=__builtin_amdgcn_permlane32_swap(__float_as_uint(m),__float_as_uint(m),false,false);
  return max2f(__uint_as_float(rr[0]),__uint_as_float(rr[1]));
}
__device__ __forceinline__ void pv(f32x16*o,int vb,bf16x8 pa0,bf16x8 pa1,bf16x8 pa2,bf16x8 pa3){
  #pragma unroll
  for(int d0=0;d0<2;++d0){s16x4 lo[4],hi[4];
    #pragma unroll
    for(int ks=0;ks<4;++ks){
      asm volatile("ds_read_b64_tr_b16 %0,%1 offset:%c2":"=&v"(lo[ks]):"v"(vb),"i"(d0*4096+ks*1024):"memory");
      asm volatile("ds_read_b64_tr_b16 %0,%1 offset:%c2":"=&v"(hi[ks]):"v"(vb),"i"(d0*4096+ks*1024+512):"memory");}
    asm volatile("s_waitcnt lgkmcnt(0)":::"memory");SBAR();
    #define PK(k) (bf16x8){lo[k][0],lo[k][1],lo[k][2],lo[k][3],hi[k][0],hi[k][1],hi[k][2],hi[k][3]}
    o[d0]=__builtin_amdgcn_mfma_f32_32x32x16_bf16(pa0,PK(0),o[d0],0,0,0);
    o[d0]=__builtin_amdgcn_mfma_f32_32x32x16_bf16(pa1,PK(1),o[d0],0,0,0);
    o[d0]=__builtin_amdgcn_mfma_f32_32x32x16_bf16(pa2,PK(2),o[d0],0,0,0);
    o[d0]=__builtin_amdgcn_mfma_f32_32x32x16_bf16(pa3,PK(3),o[d0],0,0,0);
    #undef PK
  }
}

#ifndef ATTN_STORE16
#define ATTN_STORE16(p,v) (*(u32x4*)(p)=(v))
#endif
template<int THRL,bool WIN> __device__ __forceinline__ void attn_unit(const bf16*Qb,const bf16*__restrict__ Kb,const bf16*__restrict__ Vb,bf16*Ob,int q0,int NT,int tdelta,float sink_l2,int tid,char*shm){
  const int lane=tid&63,r32=lane&31,hi=lane>>5; const int wid=__builtin_amdgcn_readfirstlane(tid>>6);
  const bf16*Qw=Qb+(long)(q0+wid*QBLK)*QP;
  const bf16*Kh=Kb,*Vh=Vb;
  const unsigned lds0=(unsigned)(uintptr_t)shm;
  float*wsf=(float*)(shm+LDS_WS)+wid*64;
  const bf16*ksrc=Kh+(long)lane*QP+wid*8;
  const bf16*vsrc=Vh+(long)(16*(wid&3)+(lane>>2))*QP+(wid>>2)*32+(lane&3)*8;
  const unsigned kdst=lds0+LDS_K+wid*1024, vdst=lds0+LDS_V+wid*1024;
  #define TM(t) ((t)<4?(t):(t)+tdelta)
  #define DMA_K(t,slot) glds16(ksrc+(long)TM(t)*KVBLK*QP,(unsigned)__builtin_amdgcn_readfirstlane(kdst+(slot)))
  #define DMA_V(t,slot) glds16(vsrc+(long)TM(t)*KVBLK*QP,(unsigned)__builtin_amdgcn_readfirstlane(vdst+(slot)))
  const int vb0=(int)(lds0+LDS_V)+((lane>>4)&1)*32+(lane&3)*8+(4*hi+((lane&15)>>2))*64;
  const char*Kbase=shm+LDS_K; bf16x8 kf[8];
  const lds_cptr shm3=(lds_cptr)shm; const lds_cptr kp0=shm3+LDS_K+hi*1024+r32*16; const lds_cptr vp0=shm3+LDS_V+((lane>>4)&1)*32+(lane&3)*8+(4*hi+((lane&15)>>2))*64;
  DMA_K(0,0);DMA_V(0,0);DMA_K(1,SLOTB);
  bf16x8 qr[4];
  #pragma unroll
  for(int d0=0;d0<4;++d0)qr[d0]=*reinterpret_cast<const bf16x8*>(&Qw[(long)r32*QP+d0*16+hi*8]);
  float mhat=0.f,l_reg=0.f;float z0_=0.f;asm volatile("":"+v"(z0_));f32x16 o[2];
  #pragma unroll
  for(int r_=0;r_<16;++r_){o[0][r_]=z0_;o[1][r_]=z0_;}
  f32x16 negm;
  #pragma unroll
  for(int r_=0;r_<16;++r_)negm[r_]=z0_;
  asm volatile("":"+v"(negm));
  const int qrow=q0+wid*QBLK+r32;
  #define CMASK(P0,P1,t) do{ if(WIN&&(t)>=4)wmask(P0,P1,TM(t)*KVBLK-qrow,hi); }while(0)
  bool resc=false;
  #define START(P0,P1) do{ const float rm=rowmax(P0,P1); resc=false; \
    { const float dl=rm; mhat=fadd_s(mhat,dl); \
      _Pragma("unroll") for(int r=0;r<16;++r){P0[r]=fsub_s(P0[r],dl);P1[r]=fsub_s(P1[r],dl);} \
      _Pragma("unroll") for(int r=0;r<16;++r)negm[r]=-mhat; asm volatile("":"+v"(negm)); } \
    _Pragma("unroll") for(int r=0;r<16;++r)P0[r]=__builtin_amdgcn_exp2f(P0[r]); }while(0)
  #define RESC() do{ if(resc){ asm volatile("s_waitcnt lgkmcnt(0)":::"memory"); \
      _Pragma("unroll") for(int d_=0;d_<2;++d_) _Pragma("unroll") for(int r=0;r<16;++r)o[d_][r]*=wsf[crow(r,hi)]; } }while(0)
  f32x16 pA0,pA1,pB0,pB1;
  int sl_prev=0,sl_cur=0,sl_next=SLOTB;
  #define ROT() do{sl_prev=sl_cur;sl_cur=sl_next;sl_next=(sl_next==(NSLOT-1)*SLOTB)?0:sl_next+SLOTB;}while(0)
  DMA_K(2,2*SLOTB);
  WAIT_BAR(3);
  qkt(pA0,pA1,Kbase,qr,negm,r32,hi);asm volatile("s_nop 15\n\ts_nop 7":"+v"(pA0),"+v"(pA1));CMASK(pA0,pA1,0);
  START(pA0,pA1);
  _Pragma("unroll") for(int r=0;r<16;++r)pA1[r]=__builtin_amdgcn_exp2f(pA1[r]);
  WAIT_BAR(0);
  DMA_K(3,0);DMA_V(1,SLOTB);
  ROT();
  kload8(kf,kp0+sl_cur);
  WAIT_BAR(2);
  s16x4 vlo[8],vhi[8]; u32x4 pw0,pw1,pw2,pw3;
  #define PKW(P,B) cvtpk_s(P[B],P[B+1])
  #define PAF(k) __builtin_bit_cast(bf16x8,pw##k)
  #define VFR(i) (bf16x8){vlo[i][0],vlo[i][1],vlo[i][2],vlo[i][3],vhi[i][0],vhi[i][1],vhi[i][2],vhi[i][3]}
  #define PIN(x) asm volatile("":"+v"(x))
  #define MX3(a,b,c) __builtin_fmaxf(__builtin_fmaxf((a),(b)),(c))
  #define GAPA(MF,A0,A1,A2,A3,W0,W1,PW) do{ MF; sacc+=A0; sacc+=A1; sacc+=A2; sacc+=A3; PIN(sacc); W0; W1; PIN(PW); SBAR(); }while(0)
  #define EX(v) __builtin_amdgcn_exp2f(v)
  #define GAPB(MF,X,B) do{ MF; X[B]=EX(X[B]); X[B+1]=EX(X[B+1]); X[B+2]=EX(X[B+2]); X[B+3]=EX(X[B+3]); PIN(X); SBAR(); }while(0)
  #define VRD(i) do{ vlo[i]=vtr(vp_+(((i)>>2)*4096+((i)&3)*1024)); vhi[i]=vtr(vp_+(((i)>>2)*4096+((i)&3)*1024+512)); }while(0)
  #define KRD(G,j) do{ if(G){ kload2(kf,kp0+sl_next,j); SBAR(); } }while(0)
  #define STEP(C0,C1,P0,P1,t,GK,GV,GL) do{ SBAR(); \
    const lds_cptr vp_=vp0+sl_prev; \
    VRD(0); SBAR(); float sacc=(P0[0]+P0[1]); \
    GAPA(C0=__builtin_amdgcn_mfma_f32_32x32x16_bf16(kf[0],qr[0],negm,0,0,0), P0[2],P0[3],P0[4],P0[5],     pw0[0]=PKW(P0,0), pw0[1]=PKW(P0,2), pw0); \
    VRD(4); SBAR(); GAPA(C1=__builtin_amdgcn_mfma_f32_32x32x16_bf16(kf[1],qr[0],negm,0,0,0), P0[6],P0[7],P0[8],P0[9],     pw0[2]=PKW(P0,4), pw0[3]=PKW(P0,6), pw0); \
    VRD(1); SBAR(); GAPA(C0=__builtin_amdgcn_mfma_f32_32x32x16_bf16(kf[2],qr[1],C0,0,0,0),   P0[10],P0[11],P0[12],P0[13], pw1[0]=PKW(P0,8), pw1[1]=PKW(P0,10), pw1); \
    VRD(5); SBAR(); GAPA(C1=__builtin_amdgcn_mfma_f32_32x32x16_bf16(kf[3],qr[1],C1,0,0,0),   P0[14],P0[15],P1[0],P1[1],   pw1[2]=PKW(P0,12),pw1[3]=PKW(P0,14), pw1); \
    VRD(2); SBAR(); GAPA(C0=__builtin_amdgcn_mfma_f32_32x32x16_bf16(kf[4],qr[2],C0,0,0,0),   P1[2],P1[3],P1[4],P1[5],     pw2[0]=PKW(P1,0), pw2[1]=PKW(P1,2), pw2); \
    VRD(6); SBAR(); GAPA(C1=__builtin_amdgcn_mfma_f32_32x32x16_bf16(kf[5],qr[2],C1,0,0,0),   P1[6],P1[7],P1[8],P1[9],     pw2[2]=PKW(P1,4), pw2[3]=PKW(P1,6), pw2); \
    VRD(3); SBAR(); GAPA(C0=__builtin_amdgcn_mfma_f32_32x32x16_bf16(kf[6],qr[3],C0,0,0,0),   P1[10],P1[11],P1[12],P1[13], pw3[0]=PKW(P1,8), pw3[1]=PKW(P1,10), pw3); \
    VRD(7); SBAR(); GAPA(C1=__builtin_amdgcn_mfma_f32_32x32x16_bf16(kf[7],qr[3],C1,0,0,0),   P1[14],P1[15],0.f,0.f,       pw3[2]=PKW(P1,12),pw3[3]=PKW(P1,14), pw3); \
    l_reg+=sacc; \
    if(GK){DMA_K((t)+3,sl_cur);} if(GV){DMA_V((t)+1,sl_next);} \
    CMASK(C0,C1,t); \
    { float a=MX3(C0[0],C0[1],C1[0]),b=MX3(C0[2],C0[3],C1[1]); a=MX3(a,C1[2],C1[3]); \
      _Pragma("unroll") for(int r=4;r<16;r+=4){a=MX3(a,C0[r],C0[r+1]);b=MX3(b,C0[r+2],C0[r+3]);a=MX3(a,C1[r],C1[r+1]);b=MX3(b,C1[r+2],C1[r+3]);} \
      float rm=__builtin_fmaxf(a,b); { auto rr=__builtin_amdgcn_permlane32_swap(__float_as_uint(rm),__float_as_uint(rm),false,false); rm=__builtin_fmaxf(__uint_as_float(rr[0]),__uint_as_float(rr[1])); } \
      resc=false; \
      if(__builtin_expect(__any(rm>(float)THRL),0)){ const float dl=__builtin_fmaxf(rm,0.f); mhat+=dl; \
        _Pragma("unroll") for(int r=0;r<16;++r){C0[r]-=dl;C1[r]-=dl;} \
        _Pragma("unroll") for(int r=0;r<16;++r)negm[r]=-mhat; asm volatile("":"+v"(negm)); \
        const float f=__builtin_amdgcn_exp2f(-dl); l_reg*=f; if(hi==0)wsf[r32]=f; resc=true; } } \
    SBAR(); \
    GAPB(o[0]=__builtin_amdgcn_mfma_f32_32x32x16_bf16(PAF(0),VFR(0),o[0],0,0,0), C0,0); \
    GAPB(o[1]=__builtin_amdgcn_mfma_f32_32x32x16_bf16(PAF(0),VFR(4),o[1],0,0,0), C0,4); \
    KRD(GL,0); GAPB(o[0]=__builtin_amdgcn_mfma_f32_32x32x16_bf16(PAF(1),VFR(1),o[0],0,0,0), C0,8); \
    KRD(GL,1); GAPB(o[1]=__builtin_amdgcn_mfma_f32_32x32x16_bf16(PAF(1),VFR(5),o[1],0,0,0), C0,12); \
    KRD(GL,2); GAPB(o[0]=__builtin_amdgcn_mfma_f32_32x32x16_bf16(PAF(2),VFR(2),o[0],0,0,0), C1,0); \
    KRD(GL,3); GAPB(o[1]=__builtin_amdgcn_mfma_f32_32x32x16_bf16(PAF(2),VFR(6),o[1],0,0,0), C1,4); \
    GAPB(o[0]=__builtin_amdgcn_mfma_f32_32x32x16_bf16(PAF(3),VFR(3),o[0],0,0,0), C1,8); \
    GAPB(o[1]=__builtin_amdgcn_mfma_f32_32x32x16_bf16(PAF(3),VFR(7),o[1],0,0,0), C1,12); \
    }while(0)
  int t=1;
  for(;t+5<NT;t+=2){
    STEP(pB0,pB1,pA0,pA1,t,true,true,true);     WAIT_BAR(2); RESC(); ROT();
    STEP(pA0,pA1,pB0,pB1,t+1,true,true,true);   WAIT_BAR(2); RESC(); ROT();
  }
  #define ENDW(tt) do{ if((tt)+3<NT){WAIT_BAR(2);} else if((tt)+2<NT){WAIT_BAR(1);} else {WAIT_BAR(0);} }while(0)
  for(;t+1<NT;t+=2){
    STEP(pB0,pB1,pA0,pA1,t,(t+3<NT),(t+1<NT),(t+1<NT));       ENDW(t);   RESC(); ROT();
    STEP(pA0,pA1,pB0,pB1,t+1,(t+4<NT),(t+2<NT),(t+2<NT));     ENDW(t+1); RESC(); ROT();
  }
  STEP(pB0,pB1,pA0,pA1,NT-1,false,false,false); RESC();
  { float sacc=pB0[0]+pB0[1]; _Pragma("unroll") for(int r=2;r<16;++r)sacc+=pB0[r]; _Pragma("unroll") for(int r=0;r<16;++r)sacc+=pB1[r]; l_reg+=sacc;
    pw0=(u32x4){PKW(pB0,0),PKW(pB0,2),PKW(pB0,4),PKW(pB0,6)};pw1=(u32x4){PKW(pB0,8),PKW(pB0,10),PKW(pB0,12),PKW(pB0,14)};pw2=(u32x4){PKW(pB1,0),PKW(pB1,2),PKW(pB1,4),PKW(pB1,6)};pw3=(u32x4){PKW(pB1,8),PKW(pB1,10),PKW(pB1,12),PKW(pB1,14)};
    SBAR(); pv(o,vb0+sl_cur,PAF(0),PAF(1),PAF(2),PAF(3)); }
  #undef PKW
  #undef PAF
  #undef VFR
  #undef PIN
  #undef MX3
  #undef GAPA
  #undef GAPB
  #undef EX
  #undef VRD
  #undef KRD
  #undef STEP
  #undef ENDW
  {auto rr=__builtin_amdgcn_permlane32_swap(__float_as_uint(l_reg),__float_as_uint(l_reg),false,false);l_reg=__uint_as_float(rr[0])+__uint_as_float(rr[1]);}
  if(WIN)l_reg+=__builtin_amdgcn_exp2f(sink_l2-mhat);
  if(hi==0)wsf[32+r32]=l_reg;asm volatile("s_waitcnt lgkmcnt(0)":::"memory");
  float rli[16];
  #pragma unroll
  for(int r=0;r<16;++r)rli[r]=__builtin_amdgcn_rcpf(wsf[32+crow(r,hi)]);
  bf16*Ow=Ob+(long)(q0+wid*QBLK)*OP;
  { bf16*stg=(bf16*)(shm+LDS_OST)+wid*2048;
    #pragma unroll
    for(int r=0;r<16;++r){const int orow=crow(r,hi);
      #pragma unroll
      for(int d0=0;d0<2;++d0)stg[orow*64+d0*32+r32]=__float2bfloat16(o[d0][r]*rli[r]);}
    asm volatile("s_waitcnt lgkmcnt(0)":::"memory");
    #pragma unroll
    for(int i=0;i<4;++i){const int row=i*8+(lane>>3),ch=lane&7; const u32x4 v=*(const u32x4*)(stg+row*64+ch*8); ATTN_STORE16(Ow+(long)row*OP+ch*8,v);} }
  asm volatile("s_waitcnt lgkmcnt(0)\n\ts_barrier":::"memory");
  #undef TM
  #undef DMA_K
  #undef DMA_V
  #undef CMASK
  #undef START
  #undef RESC
  #undef ROT
}
constexpr int ATTN_LDS_BYTES=LDS_BYTES;
#undef SBAR
#undef WAIT_BAR
}
#define XB_TMO      128
#define XB_XCNT(j)  (256  + 64 * (j))
#define XB_XSUB(j)  (1280 + 64 * (j))
#define XB_XGEN(j)  (2304 + 64 * (j))
#define XB_TOP      3328
#define XB_TOPGEN   3392
#define XCD_BAR_WORDS 3456
#define XB_SPIN_CAP (1u << 21)

__device__ __forceinline__ unsigned xb_ld(unsigned* p)              { return __hip_atomic_load(p, __ATOMIC_RELAXED, __HIP_MEMORY_SCOPE_AGENT); }
__device__ __forceinline__ unsigned xb_add(unsigned* p, unsigned v) { return __hip_atomic_fetch_add(p, v, __ATOMIC_RELAXED, __HIP_MEMORY_SCOPE_AGENT); }
__device__ __forceinline__ unsigned xb_xcc_id() { return (unsigned)__builtin_amdgcn_s_getreg((3 << 11) | 20) & 0xFu; }
#define XB_SPIN(cond, bar) do { unsigned _sp = 0; while (cond) { __builtin_amdgcn_s_sleep(1); \
    if ((++_sp & 255u) == 0u) { if (xb_ld(&(bar)[XB_TMO])) break; if (_sp > XB_SPIN_CAP) { atomicAdd(&(bar)[XB_TMO], 1u); break; } } } } while (0)

struct XcdBarrier {
    unsigned* bar; unsigned x;
    volatile LAS unsigned* st;
};

__device__ __forceinline__ XcdBarrier xcd_barrier_post(unsigned* bar, volatile LAS unsigned* st) {
    XcdBarrier b; b.bar = bar; b.x = xb_xcc_id(); b.st = st;
    if (threadIdx.x == 0) (void)xb_add(&bar[XB_XCNT(b.x)], 1u);
    return b;
}
__device__ __forceinline__ void xcd_barrier_complete(unsigned* bar, unsigned x, unsigned& nloc, unsigned& nx) {
    const unsigned G = gridDim.x * gridDim.y * gridDim.z;
    unsigned sum, cnt, mine, sp = 0u;
    for (;;) {
        sum = 0u; cnt = 0u; mine = 0u;
#pragma unroll
        for (unsigned j = 0; j < 16; ++j) { const unsigned c = xb_ld(&bar[XB_XCNT(j)]); sum += c; cnt += (c > 0u) ? 1u : 0u; mine = (j == x) ? c : mine; }
        if (sum == G) break;
        __builtin_amdgcn_s_sleep(1);
        if ((++sp & 255u) == 0u) { if (xb_ld(&bar[XB_TMO])) break; if (sp > XB_SPIN_CAP) { atomicAdd(&bar[XB_TMO], 1u); break; } }
    }
    nloc = mine > 0u ? mine : 1u; nx = cnt > 0u ? cnt : 1u;
}

__device__ __forceinline__ void xcd_barrier(const XcdBarrier& b) {
    asm volatile("s_waitcnt vmcnt(0)" ::: "memory");
    __syncthreads();
    if (threadIdx.x == 0) {
        unsigned* bar = b.bar; unsigned bx_ = b.x; asm volatile("" : "+s"(bar), "+s"(bx_));
        __builtin_amdgcn_s_waitcnt(0);
        unsigned nloc = b.st[0], nx = b.st[1];
        if (nloc == 0u) { xcd_barrier_complete(bar, bx_, nloc, nx); b.st[0] = nloc; b.st[1] = nx; }
        const unsigned old = xb_add(&bar[XB_XSUB(bx_)], 1u);
        const unsigned gen = old / nloc;
        if (old + 1u == (gen + 1u) * nloc) {
            __builtin_amdgcn_fence(__ATOMIC_RELEASE, "agent");
            asm volatile("s_waitcnt vmcnt(0)" ::: "memory");
            const unsigned og = xb_add(&bar[XB_TOP], 1u);
            const unsigned tg = og / nx;
            if (og + 1u == (tg + 1u) * nx) xb_add(&bar[XB_TOPGEN], 1u);
            else XB_SPIN(xb_ld(&bar[XB_TOPGEN]) == tg, bar);
            __builtin_amdgcn_fence(__ATOMIC_ACQUIRE, "agent");
            xb_add(&bar[XB_XGEN(bx_)], 1u);
            asm volatile("s_waitcnt vmcnt(0)" ::: "memory");
        } else {
            XB_SPIN(xb_ld(&bar[XB_XGEN(bx_)]) == gen, bar);
            __builtin_amdgcn_fence(__ATOMIC_ACQUIRE, "agent");
            asm volatile("s_waitcnt vmcnt(0)" ::: "memory");
        }
    }
    __syncthreads();
}

constexpr size_t alup(size_t x) { return (x + 4095) & ~(size_t)4095; }
constexpr size_t CTL_BYTES = 1u << 20;
constexpr size_t SZ_WIN = (size_t)DEPTH * DIN * DM * 2, SZ_WOUT = (size_t)DEPTH * DM * DM * 2, SZ_WGU = (size_t)DEPTH * NE * 2 * FF * DM  , SZ_WDN = (size_t)DEPTH * NE * DM * FF  ;
constexpr size_t SZ_MODP = (size_t)DEPTH * 16 * 17 * 6144 * 4, SZ_MOD = (size_t)DEPTH * 17 * 6144 * 4;
constexpr size_t SZ_X32 = (size_t)MROWS * DM * 2  , SZ_H = (size_t)MROWS * DM * 2, SZ_P = (size_t)MROWS * DIN * 2, SZ_Y = (size_t)MROWS * DM * 2, SZ_YP = (size_t)MROWS * 2 * DM * 2;
constexpr size_t SZ_LIST = (size_t)NE * MROWS * 4, SZ_GW = (size_t)MROWS * 2 * 4;
constexpr int MAXBLK = (MROWS * 2) / 256 + NE;
static_assert((size_t)MAXBLK * 256 * FF * 2 <= SZ_P, "HMID overlays P");
static_assert((size_t)2 * NB * 4 * NCH * 128 * 64 * 4 <= SZ_H, "KVT overlays H");
static_assert((size_t)2 * NB * 4 * NCH * 128 * 64 * 2 <= SZ_YP, "ST overlays YP");
constexpr size_t WS_CTL = 0;
constexpr size_t WS_WIN = CTL_BYTES, WS_WOUT = WS_WIN + alup(SZ_WIN), WS_WGU = WS_WOUT + alup(SZ_WOUT), WS_WDN = WS_WGU + alup(SZ_WGU);
constexpr size_t WS_MODP = WS_WDN + alup(SZ_WDN), WS_MOD = WS_MODP + alup(SZ_MODP);
constexpr size_t WS_X32 = WS_MOD + alup(SZ_MOD), WS_H = WS_X32 + alup(SZ_X32), WS_P = WS_H + alup(SZ_H), WS_Y = WS_P + alup(SZ_P), WS_YP = WS_Y + alup(SZ_Y);
constexpr size_t WS_LIST = WS_YP + alup(SZ_YP), WS_GW = WS_LIST + alup(SZ_LIST), WS_END = WS_GW + alup(SZ_GW);
constexpr int CW_BAR = 4096;
constexpr int CW_CNT = 16384;

constexpr int RING_BYTES = 131072;
constexpr int LDSCTL_OFF = RING_BYTES;
constexpr int LDS_BYTES = 147456;

#define ATTN_STORE16(p,v) (*(u32x4*)(p)=(v))

#define CAS __attribute__((address_space(4)))
__device__ __forceinline__ const float* inp(int i) {
    const CAS unsigned char* k = (const CAS unsigned char*)__builtin_amdgcn_kernarg_segment_ptr();
    asm volatile("" : "+s"(k));
    return *(const float* const CAS*)(k + 8 * i);
}
#define CBAR() do { asm volatile("" ::: "memory"); __builtin_amdgcn_sched_barrier(0); } while (0)
struct Ctx {
    float* out; unsigned char* ws;
    __device__ __forceinline__ const float* x() const { return inp(0); }
    __device__ __forceinline__ const float* c() const { return inp(1); }
    __device__ __forceinline__ const float* ctx() const { return inp(2); }
    __device__ __forceinline__ const float* c_ctx() const { return inp(3); }
    __device__ __forceinline__ const float* ada_w() const { return inp(4); }
    __device__ __forceinline__ const float* ada_b() const { return inp(5); }
    __device__ __forceinline__ const float* norm1() const { return inp(6); }
    __device__ __forceinline__ const float* norm2() const { return inp(7); }
    __device__ __forceinline__ const float* w_in() const { return inp(8); }
    __device__ __forceinline__ const float* w_out() const { return inp(9); }
    __device__ __forceinline__ const float* ret_decay() const { return inp(10); }
    __device__ __forceinline__ const float* win_gain() const { return inp(11); }
    __device__ __forceinline__ const float* win_sink() const { return inp(12); }
    __device__ __forceinline__ const float* glb_gain() const { return inp(13); }
    __device__ __forceinline__ const float* w_router() const { return inp(14); }
    __device__ __forceinline__ const float* b_router() const { return inp(15); }
    __device__ __forceinline__ const float* w_gu() const { return inp(16); }
    __device__ __forceinline__ const float* w_dn() const { return inp(17); }
};

template <int CTRL> __device__ __forceinline__ float dppx(float v) { return __builtin_bit_cast(float, __builtin_amdgcn_update_dpp(0, __builtin_bit_cast(int, v), CTRL, 0xF, 0xF, true)); }
__device__ __forceinline__ float xor1(float v) { return dppx<0xB1>(v); }
__device__ __forceinline__ float xor2(float v) { return dppx<0x4E>(v); }
__device__ __forceinline__ float wave_sum(float v) {
    v += dppx<0xB1>(v); v += dppx<0x4E>(v); v += dppx<0x141>(v); v += dppx<0x140>(v);
    { const unsigned u = __builtin_bit_cast(unsigned, v); auto r = __builtin_amdgcn_permlane16_swap(u, u, false, false); v = __builtin_bit_cast(float, (unsigned)r[0]) + __builtin_bit_cast(float, (unsigned)r[1]); }
    { const unsigned u = __builtin_bit_cast(unsigned, v); auto r = __builtin_amdgcn_permlane32_swap(u, u, false, false); v = __builtin_bit_cast(float, (unsigned)r[0]) + __builtin_bit_cast(float, (unsigned)r[1]); }
    return v;
}
__device__ __forceinline__ float xor16(float v, int lane) { const unsigned u = __builtin_bit_cast(unsigned, v); auto r = __builtin_amdgcn_permlane16_swap(u, u, false, false);
    return __builtin_bit_cast(float, (lane & 16) ? (unsigned)r[0] : (unsigned)r[1]); }
__device__ __forceinline__ float silu_f(float v) { return v * __builtin_amdgcn_rcpf(1.f + __builtin_amdgcn_exp2f(-LOG2E * v)); }
__device__ __forceinline__ float log2_sigmoid(float x) { return -log1pf(expf(-x)) * LOG2E; }

__device__ __forceinline__ void transpose_item(const float* W, int N, int nsrc0, int k0, bf16_t* WT, int K, int nrow0, LAS float* scr, int lane) {
#pragma unroll 8
    for (int i = 0; i < 32; ++i) { const int kk = 2 * i + (lane >> 5); scr[kk * 33 + (lane & 31)] = W[(size_t)(k0 + kk) * N + nsrc0 + (lane & 31)]; }
    asm volatile("s_waitcnt lgkmcnt(0)" ::: "memory");
    const int c = lane & 7;
#pragma unroll
    for (int j = 0; j < 4; ++j) { const int n = (lane >> 3) + 8 * j; const LAS float* s = scr + (8 * c) * 33 + n;
        u32x4 o; o.x = pk2(s[0 * 33], s[1 * 33]); o.y = pk2(s[2 * 33], s[3 * 33]); o.z = pk2(s[4 * 33], s[5 * 33]); o.w = pk2(s[6 * 33], s[7 * 33]);
        *(u32x4*)(WT + (size_t)(nrow0 + n) * K + k0 + 8 * c) = o; }
    asm volatile("s_waitcnt lgkmcnt(0)" ::: "memory");
}
__device__ __forceinline__ unsigned pk4_fp8(float a, float b, float c, float d) { int w = 0; w = __builtin_amdgcn_cvt_pk_fp8_f32(a, b, w, false); w = __builtin_amdgcn_cvt_pk_fp8_f32(c, d, w, true); return (unsigned)w; }
constexpr float W8_SCALE = 64.0f, W8_INV = 1.0f / 64.0f;
__device__ __forceinline__ void transpose_item8(const float* W, int N, int nsrc0, int k0, unsigned char* WT, int K, int nrow0, LAS float* scr, int lane) {
#pragma unroll 8
    for (int i = 0; i < 32; ++i) { const int kk = 2 * i + (lane >> 5); scr[kk * 33 + (lane & 31)] = W[(size_t)(k0 + kk) * N + nsrc0 + (lane & 31)]; }
    asm volatile("s_waitcnt lgkmcnt(0)" ::: "memory");
    const int c = lane & 7;
#pragma unroll
    for (int j = 0; j < 4; ++j) { const int n = (lane >> 3) + 8 * j; const LAS float* s = scr + (8 * c) * 33 + n;
        u32x2 o; o.x = pk4_fp8(s[0 * 33] * W8_SCALE, s[1 * 33] * W8_SCALE, s[2 * 33] * W8_SCALE, s[3 * 33] * W8_SCALE); o.y = pk4_fp8(s[4 * 33] * W8_SCALE, s[5 * 33] * W8_SCALE, s[6 * 33] * W8_SCALE, s[7 * 33] * W8_SCALE);
        *(u32x2*)(WT + (size_t)(nrow0 + n) * K + k0 + 8 * c) = o; }
    asm volatile("s_waitcnt lgkmcnt(0)" ::: "memory");
}
constexpr int IT_WIN = 16 * 80, IT_WOUT = 16 * 32, IT_GU = 16 * 64, IT_DN = 16 * 32, IT_LAYER = IT_WIN + IT_WOUT + NE * (IT_GU + IT_DN);
__device__ __forceinline__ void phase_prologue(const Ctx& C, LAS unsigned char* lds, int G, int vcu, int bx, int tid) {
    const int lane = tid & 63, wave = tid >> 6;
    {
        LAS float* scs = (LAS float*)lds;
        bool have = false;
        for (int it = bx; it < DEPTH * 12 * 16; it += G) {
            if (!have) {
                for (int i = tid; i < 17 * DM; i += 512) { const int r = i >> 10, k = i & 1023; const float v = r < 16 ? C.c()[r * DM + k] : C.c_ctx()[k]; scs[i] = v / (1.f + expf(-v)); }
                __syncthreads(); have = true;
            }
            const int l = it / 192, rem = it % 192, cb = rem / 16, kc = rem % 16;
            const float* w = C.ada_w() + ((size_t)l * DM + kc * 64) * 6144 + cb * 512 + tid;
            float acc[17];
#pragma unroll
            for (int r = 0; r < 17; ++r) acc[r] = 0.f;
#pragma unroll 4
            for (int kk = 0; kk < 64; ++kk) { const float wv = w[(size_t)kk * 6144];
#pragma unroll
                for (int r = 0; r < 17; ++r) acc[r] += scs[r * DM + kc * 64 + kk] * wv; }
            float* mp = (float*)(C.ws + WS_MODP) + ((size_t)(l * 16 + kc) * 17) * 6144 + cb * 512 + tid;
#pragma unroll
            for (int r = 0; r < 17; ++r) mp[(size_t)r * 6144] = acc[r];
        }
        __syncthreads();
    }
    LAS float* scr = (LAS float*)(lds + wave * 16384);
    const int gw = vcu * 8 + wave, NGW = G * 8;
    for (int it = gw; it < DEPTH * IT_LAYER; it += NGW) {
        const int l = it / IT_LAYER; int r = it % IT_LAYER;
        if (r < IT_WIN) { const int kb = r / 80, nb = r % 80;
            transpose_item(C.w_in() + (size_t)l * DM * DIN, DIN, 32 * nb, 64 * kb, (bf16_t*)(C.ws + WS_WIN) + (size_t)l * DIN * DM, DM, 32 * nb, scr, lane); continue; }
        r -= IT_WIN;
        if (r < IT_WOUT) { const int kb = r / 32, nb = r % 32;
            transpose_item(C.w_out() + (size_t)l * DM * DM, DM, 32 * nb, 64 * kb, (bf16_t*)(C.ws + WS_WOUT) + (size_t)l * DM * DM, DM, 32 * nb, scr, lane); continue; }
        r -= IT_WOUT;
        if (r < NE * IT_GU) { const int e = r / IT_GU, q = r % IT_GU, kb = q / 64, nb = q % 64;
            const int np = 32 * nb, tile = np >> 8, within = np & 255, nsrc = within < 128 ? tile * 128 + within : FF + tile * 128 + within - 128;
            transpose_item8(C.w_gu() + (size_t)(l * NE + e) * DM * 2 * FF, 2 * FF, nsrc, 64 * kb, (unsigned char*)(C.ws + WS_WGU) + (size_t)(l * NE + e) * 2 * FF * DM, DM, np, scr, lane); continue; }
        r -= NE * IT_GU;
        { const int e = r / IT_DN, q = r % IT_DN, kb = q / 32, nb = q % 32;
            transpose_item8(C.w_dn() + (size_t)(l * NE + e) * FF * DM, DM, 32 * nb, 64 * kb, (unsigned char*)(C.ws + WS_WDN) + (size_t)(l * NE + e) * DM * FF, FF, 32 * nb, scr, lane); }
    }
}
__device__ __forceinline__ void phase_modsum(const Ctx& C, int G, int bx, int tid) {
    const float* mp = (const float*)(C.ws + WS_MODP); float* mod = (float*)(C.ws + WS_MOD);
    for (int i = bx * 512 + tid; i < DEPTH * 17 * 6144; i += G * 512) {
        const int l = i / (17 * 6144), rem = i % (17 * 6144), r = rem / 6144, n = rem % 6144;
        float s = C.ada_b()[l * 6144 + n];
#pragma unroll
        for (int kc = 0; kc < 16; ++kc) s += mp[((size_t)(l * 16 + kc) * 17 + r) * 6144 + n];
        mod[i] = s;
    }
}

__device__ __forceinline__ f32x4 bf4(u32x2 a) { return (f32x4){bflo(a.x), bfhi(a.x), bflo(a.y), bfhi(a.y)}; }
__device__ __forceinline__ u32x2 pk4(f32x4 v) { u32x2 w; w.x = pk2(v[0], v[1]); w.y = pk2(v[2], v[3]); return w; }
__device__ __forceinline__ void phase_norm1(const Ctx& C, int layer, int gw, int NGW, int lane, bf16_t* XO) {
    const float* mod = (const float*)(C.ws + WS_MOD) + (size_t)layer * 17 * 6144;
    const float* gain = C.norm1() + layer * DM;
    bf16_t* XR = (bf16_t*)(C.ws + WS_X32); bf16_t* H = (bf16_t*)(C.ws + WS_H); const bf16_t* YP = (const bf16_t*)(C.ws + WS_YP);
    const float* xin = C.x(); const float* cin = C.ctx();
    f32x4 nx[4]; u32x2 nr[4], na[4], nb[4];
#define N1_LOAD(mm) do { const int b_ = (mm) / TPB, t_ = (mm) - b_ * TPB; \
        if (layer == 0) { const f32x4* s_ = (const f32x4*)(t_ < CTX ? cin + ((size_t)b_ * CTX + t_) * DM : xin + ((size_t)b_ * SEQ + (t_ - CTX)) * DM) + lane; \
            _Pragma("unroll") for (int j = 0; j < 4; ++j) nx[j] = s_[64 * j]; } \
        else { const u32x2* s_ = (const u32x2*)(XR + (size_t)(mm) * DM) + lane; const u32x2* y0_ = (const u32x2*)(YP + (size_t)(mm) * 2 * DM) + lane; \
            _Pragma("unroll") for (int j = 0; j < 4; ++j) { nr[j] = s_[64 * j]; na[j] = y0_[64 * j]; nb[j] = y0_[DM / 4 + 64 * j]; } } } while (0)
    if (gw < MROWS) N1_LOAD(gw);
    for (int m = gw; m < MROWS; m += NGW) {
        const int b = m / TPB, t = m - b * TPB, set = t < CTX ? 16 : b;
        f32x4 v[4];
        if (layer == 0) {
#pragma unroll
            for (int j = 0; j < 4; ++j) v[j] = nx[j];
        } else {
            const f32x4* g2 = (const f32x4*)(mod - 17 * 6144 + (size_t)set * 6144 + 5 * DM) + lane;
#pragma unroll
            for (int j = 0; j < 4; ++j) v[j] = bf4(nr[j]) + g2[64 * j] * (bf4(na[j]) + bf4(nb[j]));
        }
        if (m + NGW < MROWS) N1_LOAD(m + NGW);
        u32x2* xo = (u32x2*)(XO + (size_t)m * DM) + lane;
        float ss = 0.f;
#pragma unroll
        for (int j = 0; j < 4; ++j) { xo[64 * j] = pk4(v[j]); ss += (v[j][0] * v[j][0] + v[j][1] * v[j][1]) + (v[j][2] * v[j][2] + v[j][3] * v[j][3]); }
        const float rstd = 1.0f / sqrtf(wave_sum(ss) * (1.f / DM) + EPS);
        const f32x4* gp = (const f32x4*)gain + lane; const f32x4* shp = (const f32x4*)(mod + (size_t)set * 6144) + lane; const f32x4* scp = shp + DM / 4;
        u32x2* ho = (u32x2*)(H + (size_t)m * DM) + lane;
#pragma unroll
        for (int j = 0; j < 4; ++j) ho[64 * j] = pk4((v[j] * rstd) * gp[64 * j] * (scp[64 * j] + 1.0f) + shp[64 * j]);
    }
#undef N1_LOAD
}

__device__ __forceinline__ float swz_xor4(float v) { return __builtin_bit_cast(float, __builtin_amdgcn_ds_swizzle(__builtin_bit_cast(int, v), 0x101F)); }
__device__ __forceinline__ float swz_xor8(float v) { return __builtin_bit_cast(float, __builtin_amdgcn_ds_swizzle(__builtin_bit_cast(int, v), 0x201F)); }
__device__ __forceinline__ void phase_qkprep(const Ctx& C, int layer, int gw, int NGW, int lane, bf16_t* PO) {
    const bf16_t* P = (const bf16_t*)(C.ws + WS_P);
    const int hs = lane >> 3, j = lane & 7;
    const int col0 = (hs < 4 ? C_WQ + 64 * hs : hs < 6 ? C_WK + 64 * (hs - 4) : C_GQ + 64 * (hs - 6)) + 8 * j;
    const int col1 = (hs < 2 ? C_GQ + 128 + 64 * hs : C_GK + 64 * ((hs - 2) & 1)) + 8 * j;
    float g0[8], g1[8], inv[8];
    { const float* wg = C.win_gain() + layer * 128; const float* gg = C.glb_gain() + layer * 128;
      const float* s0p = hs < 4 ? wg : hs < 6 ? wg + 64 : gg; const float sc0 = (hs < 4 || hs >= 6) ? QSCALE : 1.f;
      const float* s1p = hs < 2 ? gg : gg + 64; const float sc1 = hs < 2 ? QSCALE : 1.f;
#pragma unroll
      for (int i = 0; i < 8; ++i) { g0[i] = s0p[8 * j + i] * sc0; g1[i] = s1p[8 * j + i] * sc1; inv[i] = exp2f(-(float)(8 * (j & 1) + i) * (13.287712379549449f / 16.0f)); } }
    const bool x2 = (j & 2) != 0, colax = (j & 4) != 0, act1 = lane < 32;
    u32x4 w0 = {0u, 0u, 0u, 0u}, w1 = {0u, 0u, 0u, 0u};
    if (gw < MROWS) { const bf16_t* row = P + (size_t)gw * DIN; w0 = *(const u32x4*)(row + col0); if (act1) w1 = *(const u32x4*)(row + col1); }
    for (int m = gw; m < MROWS; m += NGW) {
        const u32x4 c0 = w0, c1 = w1;
        if (m + NGW < MROWS) { const bf16_t* row = P + (size_t)(m + NGW) * DIN; w0 = *(const u32x4*)(row + col0); if (act1) w1 = *(const u32x4*)(row + col1); }
        const int b = m / TPB, t = m - b * TPB; const bool isx = t >= CTX; const int pos = t - CTX;
        float cs[8], sn[8];
        if (isx) { const float pv = (float)(colax ? (pos & 63) : (pos >> 6));
#pragma unroll
            for (int i = 0; i < 8; ++i) { const float ang = pv * inv[i]; cs[i] = __cosf(ang); sn[i] = x2 ? __sinf(ang) : -__sinf(ang); } }
        else {
#pragma unroll
            for (int i = 0; i < 8; ++i) { cs[i] = 1.f; sn[i] = 0.f; } }
        bf16_t* orow = PO + (size_t)m * (PO == P ? DIN : 256);
#pragma unroll
        for (int pass = 0; pass < 2; ++pass) {
            const u32x4 w = pass ? c1 : c0;
            float x[8] = {bflo(w.x), bfhi(w.x), bflo(w.y), bfhi(w.y), bflo(w.z), bfhi(w.z), bflo(w.w), bfhi(w.w)};
            float ss = 0.f;
#pragma unroll
            for (int i = 0; i < 8; ++i) ss += x[i] * x[i];
            ss += xor1(ss); ss += xor2(ss); ss += swz_xor4(ss);
            const float r = 1.0f / sqrtf(ss * (1.f / 64.f) + EPS);
            float y[8];
#pragma unroll
            for (int i = 0; i < 8; ++i) { x[i] = x[i] * r * (pass ? g1[i] : g0[i]); }
#pragma unroll
            for (int i = 0; i < 8; ++i) { const float pr = xor2(x[i]); y[i] = x[i] * cs[i] + pr * sn[i]; }
            u32x4 o; o.x = pk2(y[0], y[1]); o.y = pk2(y[2], y[3]); o.z = pk2(y[4], y[5]); o.w = pk2(y[6], y[7]);
            const int col = pass ? col1 : col0;
            if (pass == 0 || act1) *(u32x4*)(orow + (PO == P ? col : (col & 127))) = o;
        }
    }
}

__device__ __forceinline__ unsigned off_v(unsigned row, unsigned ch) { return 256u * row + 16u * (ch ^ (((row & 3) << 2) | ((row >> 2) & 3))); }
__device__ __forceinline__ unsigned off_k(unsigned row, unsigned ch) { return 128u * row + 16u * (ch ^ (row & 7)); }
typedef short s16x4_t __attribute__((ext_vector_type(4)));
__device__ __forceinline__ s16x4_t tr_rd(const LAS unsigned char* p) { return __builtin_bit_cast(s16x4_t, __builtin_amdgcn_ds_read_tr16_b64_v4i16((LAS s16x4_t*)p)); }
template <bool KIMG> __device__ __forceinline__ bf16x8 tr_frag(const LAS unsigned char* img, int lane, int rbase, int r0off, int r1off, int cblk) {
    const unsigned blk = (lane >> 4) & 1, q = (lane & 15) >> 2, pp = lane & 3, ch = 4 * cblk + 2 * blk + (pp >> 1);
    const unsigned ra = rbase + r0off + q, rb = rbase + r1off + q;
    const s16x4_t lo = tr_rd(img + (KIMG ? off_k(ra, ch) : off_v(ra, ch)) + 8 * (pp & 1)), hi = tr_rd(img + (KIMG ? off_k(rb, ch) : off_v(rb, ch)) + 8 * (pp & 1));
    return (bf16x8){lo[0], lo[1], lo[2], lo[3], hi[0], hi[1], hi[2], hi[3]};
}
__device__ __forceinline__ void stage_v(const bf16_t* P, size_t r0, int h, LAS unsigned char* img, int tid) {
#pragma unroll
    for (int i = 0; i < 4; ++i) { const int p_ = tid + 512 * i, j = p_ >> 4, ch = p_ & 15;
        *(LAS u32x4*)(img + off_v(j, ch)) = *(const u32x4*)(P + (r0 + j) * DIN + C_RV + h * 128 + 8 * ch); }
}
__device__ __forceinline__ void ret_r1_unit(const Ctx& C, int layer, int b, int h, int c, LAS unsigned char* lds, int tid) {
    const int lane = tid & 63, wid = tid >> 6;
    const bf16_t* P = (const bf16_t*)(C.ws + WS_P); float* KVT = (float*)(C.ws + WS_H);
    LAS unsigned char* Vi = lds; LAS unsigned char* Kf = lds + 32768; LAS unsigned char* Kb = lds + 49152;
    const float* dec = C.ret_decay(); const float lf = log2_sigmoid(dec[(layer * 2 + 0) * 4 + h]), lb = log2_sigmoid(dec[(layer * 2 + 1) * 4 + h]);
    const size_t r0 = (size_t)b * TPB + c * 128;
#pragma unroll
    for (int i = 0; i < 2; ++i) { const int p_ = tid + 512 * i, j = p_ >> 3, ch = p_ & 7;
        const u32x4 w = *(const u32x4*)(P + (r0 + j) * DIN + C_RK + h * 64 + 8 * ch);
        const float zf = exp2f((float)(127 - j) * lf) * 0.125f, zb = exp2f((float)j * lb) * 0.125f;
        const float x[8] = {bflo(w.x), bfhi(w.x), bflo(w.y), bfhi(w.y), bflo(w.z), bfhi(w.z), bflo(w.w), bfhi(w.w)};
        u32x4 of, ob; of.x = pk2(x[0] * zf, x[1] * zf); of.y = pk2(x[2] * zf, x[3] * zf); of.z = pk2(x[4] * zf, x[5] * zf); of.w = pk2(x[6] * zf, x[7] * zf);
        ob.x = pk2(x[0] * zb, x[1] * zb); ob.y = pk2(x[2] * zb, x[3] * zb); ob.z = pk2(x[4] * zb, x[5] * zb); ob.w = pk2(x[6] * zb, x[7] * zb);
        *(LAS u32x4*)(Kf + off_k(j, ch)) = of; *(LAS u32x4*)(Kb + off_k(j, ch)) = ob; }
    stage_v(P, r0, h, Vi, tid);
    __syncthreads();
    const int mb = wid >> 1, nb = wid & 1, r = lane & 31, hh = lane >> 5;
    float z0 = 0.f; asm volatile("" : "+v"(z0)); f32x16 af, ab;
#pragma unroll
    for (int i = 0; i < 16; ++i) { af[i] = z0; ab[i] = z0; }
#pragma unroll
    for (int ks = 0; ks < 8; ++ks) {
        const bf16x8 a = tr_frag<false>(Vi, lane, 16 * ks + 8 * hh, 0, 4, mb);
        const bf16x8 bf = tr_frag<true>(Kf, lane, 16 * ks + 8 * hh, 0, 4, nb);
        const bf16x8 bb = tr_frag<true>(Kb, lane, 16 * ks + 8 * hh, 0, 4, nb);
        af = __builtin_amdgcn_mfma_f32_32x32x16_bf16(a, bf, af, 0, 0, 0);
        ab = __builtin_amdgcn_mfma_f32_32x32x16_bf16(a, bb, ab, 0, 0, 0);
    }
    float* of = KVT + ((size_t)((0 * NB + b) * 4 + h) * NCH + c) * 8192; float* ob = KVT + ((size_t)((1 * NB + b) * 4 + h) * NCH + c) * 8192;
#pragma unroll
    for (int reg = 0; reg < 16; ++reg) { const int dv = 32 * mb + (reg & 3) + 8 * (reg >> 2) + 4 * hh, dk = 32 * nb + r; of[dv * 64 + dk] = af[reg]; ob[dv * 64 + dk] = ab[reg]; }
    __syncthreads();
}
__device__ __forceinline__ void ret_r2_unit(const Ctx& C, int layer, int u, int tid) {
    const int q = u & 3, bh = (u >> 2) & 63, dir = u >> 8, b = bh >> 2, h = bh & 3;
    const float G = exp2f(128.f * log2_sigmoid(C.ret_decay()[(layer * 2 + dir) * 4 + h]));
    const size_t base = ((size_t)((dir * NB + b) * 4 + h) * NCH) * 8192 + q * 2048 + tid * 4;
    const float* KVT = (const float*)(C.ws + WS_H) + base; bf16_t* ST = (bf16_t*)(C.ws + WS_YP) + base;
    float z0 = 0.f; asm volatile("" : "+v"(z0)); f32x4 S = {z0, z0, z0, z0};
#pragma unroll
    for (int half = 0; half < 2; ++half) {
        f32x4 kv[17];
#pragma unroll
        for (int s = 0; s < 17; ++s) { const int step = half * 17 + s; const int c = dir == 0 ? step : (step < 2 ? 1 - step : 35 - step); kv[s] = *(const f32x4*)(KVT + (size_t)c * 8192); }
#pragma unroll
        for (int s = 0; s < 17; ++s) { const int step = half * 17 + s; const int c = dir == 0 ? step : (step < 2 ? 1 - step : 35 - step);
            u32x2 w; w.x = pk2(S[0], S[1]); w.y = pk2(S[2], S[3]); *(u32x2*)(ST + (size_t)c * 8192) = w;
            S = S * G + kv[s]; }
    }
}
__device__ __forceinline__ void ret_r3_unit(const Ctx& C, int layer, int b, int h, int c, LAS unsigned char* lds, int tid) {
    int lane = tid & 63; asm volatile("" : "+v"(lane));
    const int wid = tid >> 6, r = lane & 31, hh = lane >> 5, ib = wid & 3, dh = wid >> 2;
    const bf16_t* P = (const bf16_t*)(C.ws + WS_P);
    LAS unsigned char* Vi = lds;
    LAS float* Ol = (LAS float*)(lds + 32768);
    const float* dec = C.ret_decay(); const float lf = log2_sigmoid(dec[(layer * 2 + 0) * 4 + h]), lb = log2_sigmoid(dec[(layer * 2 + 1) * 4 + h]);
    const size_t r0 = (size_t)b * TPB + c * 128;
    stage_v(P, r0, h, Vi, tid);
#define R3_ZERO(v) do { float z_ = 0.f; asm volatile("" : "+v"(z_)); _Pragma("unroll") for (int i_ = 0; i_ < 16; ++i_) v[i_] = z_; } while (0)
    bf16x8 qf[4];
    { const bf16_t* Qp = P + (r0 + 32 * ib + r) * DIN + C_RQ + h * 64 + 8 * hh;
#pragma unroll
      for (int ks = 0; ks < 4; ++ks) qf[ks] = *(const bf16x8*)(Qp + 16 * ks); }
    bf16x8 kf[4][4]; u32x4 gwv[4];
#pragma unroll
    for (int jb = 0; jb < 2; ++jb) { const bf16_t* Kp = P + (r0 + 32 * jb + r) * DIN + C_RK + h * 64 + 8 * hh;
#pragma unroll
        for (int ks = 0; ks < 4; ++ks) kf[jb][ks] = *(const bf16x8*)(Kp + 16 * ks); }
    { const bf16_t* gp = P + (r0 + (tid >> 2)) * DIN + C_RG + h * 128 + 32 * (tid & 3);
#pragma unroll
      for (int e2 = 0; e2 < 4; ++e2) gwv[e2] = *(const u32x4*)(gp + 8 * e2); }
    f32x16 o[2]; R3_ZERO(o[0]); R3_ZERO(o[1]);
#pragma unroll
    for (int dir = 0; dir < 2; ++dir) {
        const bf16_t* sp = (const bf16_t*)(C.ws + WS_YP) + ((size_t)((dir * NB + b) * 4 + h) * NCH + c) * 8192 + (64 * dh + r) * 64 + 8 * hh;
        f32x16 acc[2];
#pragma unroll
        for (int t = 0; t < 2; ++t) { R3_ZERO(acc[t]);
#pragma unroll
            for (int ks = 0; ks < 4; ++ks) acc[t] = __builtin_amdgcn_mfma_f32_32x32x16_bf16(qf[ks], *(const bf16x8*)(sp + t * 32 * 64 + 16 * ks), acc[t], 0, 0, 0); }
#pragma unroll
        for (int reg = 0; reg < 16; ++reg) { const int i = 32 * ib + (reg & 3) + 8 * (reg >> 2) + 4 * hh; const float xi = dir == 0 ? __builtin_amdgcn_exp2f((float)(i + 1) * lf) : __builtin_amdgcn_exp2f((float)(128 - i) * lb);
            o[0][reg] += xi * acc[0][reg]; o[1][reg] += xi * acc[1][reg]; }
        CBAR();
    }
#pragma unroll
    for (int jb = 2; jb < 4; ++jb) { const bf16_t* Kp = P + (r0 + 32 * jb + r) * DIN + C_RK + h * 64 + 8 * hh;
#pragma unroll
        for (int ks = 0; ks < 4; ++ks) kf[jb][ks] = *(const bf16x8*)(Kp + 16 * ks); }
    __syncthreads();
    unsigned lp[2][2];
    { const unsigned blk = (lane >> 4) & 1, q = (lane & 15) >> 2, pp = lane & 3;
#pragma unroll
      for (int t = 0; t < 2; ++t)
#pragma unroll
          for (int cb = 0; cb < 2; ++cb) lp[t][cb] = off_v(4 * hh + 8 * t + q, 4 * (2 * dh + cb) + 2 * blk + (pp >> 1)) + 8 * (pp & 1); }
#pragma unroll
    for (int jb = 0; jb < 4; ++jb) {
        f32x16 x; R3_ZERO(x);
#pragma unroll
        for (int ks = 0; ks < 4; ++ks) x = __builtin_amdgcn_mfma_f32_32x32x16_bf16(kf[jb][ks], qf[ks], x, 0, 0, 0);
#pragma unroll
        for (int reg = 0; reg < 16; ++reg) { const int d = (32 * ib + r) - (32 * jb + (reg & 3) + 8 * (reg >> 2) + 4 * hh);
            const float D = d > 0 ? __builtin_amdgcn_exp2f((float)d * lf) : (d < 0 ? __builtin_amdgcn_exp2f((float)(-d) * lb) : 2.0f); x[reg] *= 0.125f * D; }
#pragma unroll
        for (int s = 0; s < 2; ++s) {
            u32x4 pw; pw.x = pk2(x[8 * s + 0], x[8 * s + 1]); pw.y = pk2(x[8 * s + 2], x[8 * s + 3]); pw.z = pk2(x[8 * s + 4], x[8 * s + 5]); pw.w = pk2(x[8 * s + 6], x[8 * s + 7]);
            const bf16x8 pa = __builtin_bit_cast(bf16x8, pw);
#pragma unroll
            for (int cb = 0; cb < 2; ++cb) { const s16x4_t lo = tr_rd(Vi + lp[0][cb] + (8192 * jb + 4096 * s)), hi = tr_rd(Vi + lp[1][cb] + (8192 * jb + 4096 * s));
                const bf16x8 vb = (bf16x8){lo[0], lo[1], lo[2], lo[3], hi[0], hi[1], hi[2], hi[3]};
                o[cb] = __builtin_amdgcn_mfma_f32_32x32x16_bf16(pa, vb, o[cb], 0, 0, 0); }
        }
        CBAR();
    }
#pragma unroll
    for (int cb = 0; cb < 2; ++cb)
#pragma unroll
        for (int reg = 0; reg < 16; ++reg) { const int i = 32 * ib + (reg & 3) + 8 * (reg >> 2) + 4 * hh, dv = 64 * dh + 32 * cb + r; Ol[i * 132 + dv] = o[cb][reg]; }
    __syncthreads();
    { const int row = tid >> 2, q = tid & 3; f32x4 x[8]; float sm = 0.f;
#pragma unroll
      for (int e = 0; e < 8; ++e) { x[e] = *(const LAS f32x4*)(Ol + row * 132 + 32 * q + 4 * e); sm += (x[e][0] + x[e][1]) + (x[e][2] + x[e][3]); }
      sm += xor1(sm); sm += xor2(sm);
      const float mu = sm * (1.f / 128.f); float vs = 0.f;
#pragma unroll
      for (int e = 0; e < 8; ++e) { x[e] = x[e] - mu; vs += (x[e][0] * x[e][0] + x[e][1] * x[e][1]) + (x[e][2] * x[e][2] + x[e][3] * x[e][3]); }
      vs += xor1(vs); vs += xor2(vs);
      const float rstd = 1.0f / sqrtf(vs * (1.f / 128.f) + EPS);
      bf16_t* yp = (bf16_t*)(C.ws + WS_Y) + (r0 + row) * DM + h * 128 + 32 * q;
#pragma unroll
      for (int e2 = 0; e2 < 4; ++e2) { const u32x4 gw = gwv[e2]; const f32x4 a = x[2 * e2] * rstd, bq = x[2 * e2 + 1] * rstd;
          u32x4 ow; ow.x = pk2(a[0] * silu_f(bflo(gw.x)), a[1] * silu_f(bfhi(gw.x))); ow.y = pk2(a[2] * silu_f(bflo(gw.y)), a[3] * silu_f(bfhi(gw.y)));
          ow.z = pk2(bq[0] * silu_f(bflo(gw.z)), bq[1] * silu_f(bfhi(gw.z))); ow.w = pk2(bq[2] * silu_f(bflo(gw.w)), bq[3] * silu_f(bfhi(gw.w)));
          *(u32x4*)(yp + 8 * e2) = ow; } }
#undef R3_ZERO
}

template <bool WIN>
__device__ __forceinline__ void attn_dispatch(const Ctx& C, int layer, int U, int tid, char* lds) {
    using attn_body::bf16;
    int b, h, q0, NT, tdelta;
    if (U < 1024) { b = U >> 6; h = ((U >> 5) & 1) * 2 + ((U >> 4) & 1); q0 = CTX + 256 * (U & 15);
        if (WIN) { const int ts = (q0 / 64 - 2) > 4 ? (q0 / 64 - 2) : 4, te = (q0 / 64 + 6) < 68 ? (q0 / 64 + 6) : 68; NT = 4 + te - ts; tdelta = ts - 4; } else { NT = 68; tdelta = 0; } }
    else { b = (U - 1024) >> 2; h = (U - 1024) & 3; q0 = 0; NT = 4; tdelta = 0; }
    const int kvh = h >> 1;
    const bf16* Pb = (const bf16*)(C.ws + WS_P) + (size_t)b * TPB * DIN; bf16* Yb = (bf16*)(C.ws + WS_Y) + (size_t)b * TPB * DM;
    if (WIN) attn_body::attn_unit<8, true>(Pb + C_WQ + 64 * h, Pb + C_WK + 64 * kvh, Pb + C_WV + 64 * kvh, Yb + 512 + 64 * h, q0, NT, tdelta, C.win_sink()[layer * 4 + h] * LOG2E, tid, lds);
    else     attn_body::attn_unit<8, false>(Pb + C_GQ + 64 * h, Pb + C_GK + 64 * kvh, Pb + C_GV + 64 * kvh, Yb + 768 + 64 * h, q0, NT, tdelta, 0.f, tid, lds);
}
template <bool WIN>
__device__ __forceinline__ void attn_units(const Ctx& C, int layer, int G, int vcu, int bx, int tid, char* lds) {
    const int nctx = (layer == DEPTH - 1) ? 0 : 64;
    if (G == 256) {
        for (int k = 0; k < 4; ++k) attn_dispatch<WIN>(C, layer, vcu * 4 + k, tid, lds);
        if (vcu < nctx) attn_dispatch<WIN>(C, layer, 1024 + vcu, tid, lds);
    } else {
        for (int U = bx; U < 1024 + nctx; U += G) attn_dispatch<WIN>(C, layer, U, tid, lds);
    }
}

__device__ __forceinline__ f32x2 swap32(float a, float b) { auto r = __builtin_amdgcn_permlane32_swap(__builtin_bit_cast(unsigned, a), __builtin_bit_cast(unsigned, b), false, false);
    return (f32x2){__builtin_bit_cast(float, (unsigned)r[0]), __builtin_bit_cast(float, (unsigned)r[1])}; }
__device__ __forceinline__ f32x2 swap16(float a, float b) { auto r = __builtin_amdgcn_permlane16_swap(__builtin_bit_cast(unsigned, a), __builtin_bit_cast(unsigned, b), false, false);
    return (f32x2){__builtin_bit_cast(float, (unsigned)r[0]), __builtin_bit_cast(float, (unsigned)r[1])}; }
__device__ __forceinline__ void phase_norm2_route(const Ctx& C, int layer_c, LAS unsigned char* lds, int G, int bx, int tid) {
    const int layer = layer_c & 3;
    const int lane = tid & 63, wave = tid >> 6;
    const float* mod = (const float*)(C.ws + WS_MOD) + (size_t)layer * 17 * 6144;
    const float* gain = C.norm2() + layer * DM;
    const bf16_t* XR = (const bf16_t*)(C.ws + WS_X32); unsigned char* H = (unsigned char*)(C.ws + WS_H);
    int* list = (int*)(C.ws + WS_LIST); float* GW = (float*)(C.ws + WS_GW);
    unsigned* gcnt = (unsigned*)(C.ws + WS_CTL) + CW_CNT + 64 * layer_c;
    constexpr int RPC = MROWS / 256, RPW = RPC / 8;
    LAS float* wrT = (LAS float*)lds;
    LAS float* lgs = (LAS float*)(lds + 65536);
    LAS int* lcnt = (LAS int*)(lds + 65536 + RPC * 64);
    LAS int* lbase = lcnt + 16;
    LAS int* rec_e = lcnt + 32;
    LAS float* rec_w = (LAS float*)(rec_e + 2 * RPC);
    { const float* wr = C.w_router(); for (int i = tid; i < DM * NE; i += 512) { const int k = i >> 4, e = i & 15; wrT[e * DM + k] = wr[i]; } }
    if (tid < 16) lcnt[tid] = 0;
    __syncthreads();
    const unsigned lo4 = (unsigned)lane * 4u, lo8 = (unsigned)lane * 8u, lo16 = (unsigned)lane * 16u;
#define E_LOADROW(dst, mm) do { const char* xr_ = (const char*)(XR + (size_t)(mm) * DM); _Pragma("unroll") for (int j = 0; j < 4; ++j) dst[j] = *(const u32x2*)(xr_ + (lo8 + 512u * j)); } while (0)
#define E_NORMROW(v, nxr, mm) do { float ss_ = 0.f; _Pragma("unroll") for (int j = 0; j < 4; ++j) { v[j] = bf4(nxr[j]); ss_ += (v[j][0] * v[j][0] + v[j][1] * v[j][1]) + (v[j][2] * v[j][2] + v[j][3] * v[j][3]); } \
        const int b_ = (mm) / TPB, t_ = (mm) - b_ * TPB, set_ = t_ < CTX ? 16 : b_; const float rstd_ = 1.0f / sqrtf(wave_sum(ss_) * (1.f / DM) + EPS); \
        const char* gp_ = (const char*)gain; const char* shp_ = (const char*)(mod + (size_t)set_ * 6144 + 3 * DM); const char* scp_ = shp_ + DM * 4; \
        char* ho_ = (char*)(H + (size_t)(mm) * DM); \
        _Pragma("unroll") for (int j = 0; j < 4; ++j) { v[j] = (v[j] * rstd_) * *(const f32x4*)(gp_ + (lo16 + 1024u * j)) * (*(const f32x4*)(scp_ + (lo16 + 1024u * j)) + 1.0f) + *(const f32x4*)(shp_ + (lo16 + 1024u * j)); \
            *(unsigned*)(ho_ + (lo4 + 256u * j)) = pk4_fp8(v[j][0], v[j][1], v[j][2], v[j][3]); } } while (0)
#define E_REDUCE(pe, rowl) do { float q8_[8], q4_[4], q2_[2]; \
        _Pragma("unroll") for (int e = 0; e < 8; ++e) { const f32x2 r_ = swap32(pe[e], pe[e + 8]); q8_[e] = r_[0] + r_[1]; } \
        _Pragma("unroll") for (int e = 0; e < 4; ++e) { const f32x2 r_ = swap16(q8_[e], q8_[e + 4]); q4_[e] = r_[0] + r_[1]; } \
        _Pragma("unroll") for (int e = 0; e < 2; ++e) { const float keep_ = b3 ? q4_[e + 2] : q4_[e], send_ = b3 ? q4_[e] : q4_[e + 2]; q2_[e] = keep_ + swz_xor8(send_); } \
        float lg_ = (b2 ? q2_[1] : q2_[0]) + swz_xor4(b2 ? q2_[0] : q2_[1]); lg_ += xor2(lg_); lg_ += xor1(lg_); \
        if ((lane & 3) == 0) lgs[(rowl) * 16 + (lane >> 2)] = lg_; } while (0)
    const bool b3 = (lane & 8) != 0, b2 = (lane & 4) != 0;
    for (int chunk = bx; chunk < 256; chunk += G) {
        const int m0 = chunk * RPC + wave * RPW;
        u32x2 nxA[4], nxB[4], fxA[4], fxB[4];
        E_LOADROW(nxA, m0); E_LOADROW(nxB, m0 + 1); E_LOADROW(fxA, m0 + 2); E_LOADROW(fxB, m0 + 3);
        for (int i = 0; i < RPW; i += 2) {
            f32x4 vA[4], vB[4];
            E_NORMROW(vA, nxA, m0 + i);
            E_NORMROW(vB, nxB, m0 + i + 1);
#pragma unroll
            for (int j = 0; j < 4; ++j) { nxA[j] = fxA[j]; nxB[j] = fxB[j]; }
            if (i + 4 < RPW) { E_LOADROW(fxA, m0 + i + 4); E_LOADROW(fxB, m0 + i + 5); }
            float peA[16], peB[16];
            f32x2 hv[4][4];
#pragma unroll
            for (int j = 0; j < 4; ++j)
#pragma unroll
                for (int c = 0; c < 4; ++c) hv[j][c] = (f32x2){vA[j][c], vB[j][c]};
            const LAS float* wl = wrT + 4 * lane; asm volatile("" : "+v"(wl));
#pragma unroll
            for (int e = 0; e < 16; ++e) { f32x2 a2 = {0.f, 0.f};
#pragma unroll
                for (int j = 0; j < 4; ++j) { const f32x4 w = *(const LAS f32x4*)(wl + e * DM + 256 * j);
#pragma unroll
                    for (int c = 0; c < 4; ++c) a2 = __builtin_elementwise_fma(hv[j][c], (f32x2){w[c], w[c]}, a2); }
                peA[e] = a2[0]; peB[e] = a2[1]; }
            E_REDUCE(peA, wave * RPW + i); E_REDUCE(peB, wave * RPW + i + 1);
        }
#undef E_LOADROW
#undef E_NORMROW
#undef E_REDUCE
        asm volatile("s_waitcnt lgkmcnt(0)" ::: "memory");
        if (lane < RPW) {
            const int rl = wave * RPW + lane; const float* br = C.b_router();
            float sg[16], bs[16];
#pragma unroll
            for (int e4 = 0; e4 < 4; ++e4) { const f32x4 l4 = *(const LAS f32x4*)(lgs + rl * 16 + 4 * e4);
#pragma unroll
                for (int k = 0; k < 4; ++k) { sg[4 * e4 + k] = 1.f / (1.f + expf(-l4[k])); bs[4 * e4 + k] = sg[4 * e4 + k] + br[4 * e4 + k]; } }
            int grp = 0; float best = -1e30f;
#pragma unroll
            for (int g = 0; g < 4; ++g) { const float a0 = bs[4 * g], a1 = bs[4 * g + 1], a2 = bs[4 * g + 2], a3 = bs[4 * g + 3];
                const float hi01 = fmaxf(a0, a1), lo01 = fminf(a0, a1), hi23 = fmaxf(a2, a3), lo23 = fminf(a2, a3);
                const float top = fmaxf(hi01, hi23), second = fmaxf(fminf(hi01, hi23), hi01 >= hi23 ? lo01 : lo23);
                const float sc = top + second; if (sc > best) { best = sc; grp = g; } }
            float c4[4], s4[4];
#pragma unroll
            for (int k = 0; k < 4; ++k) { c4[k] = grp == 0 ? bs[k] : grp == 1 ? bs[4 + k] : grp == 2 ? bs[8 + k] : bs[12 + k]; s4[k] = grp == 0 ? sg[k] : grp == 1 ? sg[4 + k] : grp == 2 ? sg[8 + k] : sg[12 + k]; }
            int l0 = 0; float mx0 = c4[0];
#pragma unroll
            for (int k = 1; k < 4; ++k) if (c4[k] > mx0) { mx0 = c4[k]; l0 = k; }
            int l1 = -1; float mx1 = -1e30f;
#pragma unroll
            for (int k = 0; k < 4; ++k) if (k != l0 && c4[k] > mx1) { mx1 = c4[k]; l1 = k; }
            const float w0 = l0 == 0 ? s4[0] : l0 == 1 ? s4[1] : l0 == 2 ? s4[2] : s4[3], w1 = l1 == 0 ? s4[0] : l1 == 1 ? s4[1] : l1 == 2 ? s4[2] : s4[3];
            const float wn = 1.f / (w0 + w1);
            const int e0 = grp * 4 + l0, e1 = grp * 4 + l1;
            const int p0 = __hip_atomic_fetch_add(lcnt + e0, 1, __ATOMIC_RELAXED, __HIP_MEMORY_SCOPE_WORKGROUP);
            const int p1 = __hip_atomic_fetch_add(lcnt + e1, 1, __ATOMIC_RELAXED, __HIP_MEMORY_SCOPE_WORKGROUP);
            rec_e[2 * rl] = e0 | (p0 << 8); rec_e[2 * rl + 1] = e1 | (p1 << 8); rec_w[2 * rl] = w0 * wn; rec_w[2 * rl + 1] = w1 * wn;
        }
        __syncthreads();
        if (tid < 16) lbase[tid] = (int)__hip_atomic_fetch_add(gcnt + tid, (unsigned)lcnt[tid], __ATOMIC_RELAXED, __HIP_MEMORY_SCOPE_AGENT);
        __syncthreads();
        for (int i = tid; i < 2 * RPC; i += 512) { const int re = rec_e[i], e = re & 255, pp = re >> 8; const int id = (chunk * RPC + (i >> 1)) * 2 + (i & 1);
            list[e * MROWS + lbase[e] + pp] = id; GW[id] = rec_w[i]; }
        __syncthreads();
        if (tid < 16) lcnt[tid] = 0;
        __syncthreads();
    }
}

template <bool GATHER_, int NT>
struct MoeOrder {
    static constexpr bool GATHER = GATHER_;
    const int* list; const LAS int* boff; const LAS int* cnt; int G, c;
    __device__ __forceinline__ bool next(int i, pg8::Unit& u) const {
        const int L = i * G + c; if (L >= boff[16] * NT) return false;
        const int blk = L / NT, pn = L - blk * NT; int e = 0;
#pragma unroll
        for (int k = 1; k < 16; ++k) e += (blk >= boff[k]) ? 1 : 0;
        u.pm = blk; u.pn = e * NT + pn; return true;
    }
    __device__ __forceinline__ unsigned arow(const pg8::Unit& u, int r) const {
        const int e = u.pn / NT, li = (u.pm - boff[e]) * 256 + r;
        const int id = li < cnt[e] ? list[e * MROWS + li] : 0;
        return (unsigned)(id >> 1);
    }
};
struct EpiGateUp {
    static constexpr bool PERM = true;
    unsigned char* O;
    __device__ __forceinline__ void operator()(const f32x4 (&acc)[2][2][4][2], const pg8::Unit& u, int wr, int wc, int fr, int fq) const {
        const int row0 = u.pm * 256 + wr * 64 + fr, col0 = (u.pn & 7) * 128 + wc * 32 + 8 * fq;
#pragma unroll
        for (int ai = 0; ai < 2; ++ai)
#pragma unroll
            for (int m = 0; m < 4; ++m) { const f32x4 a0 = acc[ai][0][m][0] * W8_INV, a1 = acc[ai][0][m][1] * W8_INV, u0 = acc[ai][1][m][0] * W8_INV, u1 = acc[ai][1][m][1] * W8_INV;
                u32x2 w; w.x = pk4_fp8(silu_f(a0[0]) * u0[0], silu_f(a0[1]) * u0[1], silu_f(a0[2]) * u0[2], silu_f(a0[3]) * u0[3]);
                w.y = pk4_fp8(silu_f(a1[0]) * u1[0], silu_f(a1[1]) * u1[1], silu_f(a1[2]) * u1[2], silu_f(a1[3]) * u1[3]);
                *(u32x2*)(O + ((unsigned)(row0 + ai * 128 + m * 16) * (unsigned)FF + (unsigned)col0)) = w; }
    }
};
struct EpiDown {
    static constexpr bool PERM = true;
    bf16_t* YP; const float* GW; const int* list; const LAS int* boff; const LAS int* cnt;
    __device__ __forceinline__ void operator()(const f32x4 (&acc)[2][2][4][2], const pg8::Unit& u, int wr, int wc, int fr, int fq) const {
        const int e = u.pn >> 2, lb = (u.pm - boff[e]) * 256, n = cnt[e]; const int col0 = (u.pn & 3) * 256 + wc * 32 + 8 * fq;
#pragma unroll
        for (int ai = 0; ai < 2; ++ai)
#pragma unroll
            for (int m = 0; m < 4; ++m) { const int li = lb + ai * 128 + wr * 64 + m * 16 + fr;
                if (li < n) { const int id = list[e * MROWS + li]; const float g = GW[id] * W8_INV; const unsigned off = ((unsigned)id * (unsigned)DM + (unsigned)col0) * 2u;
#pragma unroll
                    for (int bj = 0; bj < 2; ++bj) { const f32x4 v0 = acc[ai][bj][m][0] * g, v1 = acc[ai][bj][m][1] * g;
                        u32x4 w; w.x = pk2(v0[0], v0[1]); w.y = pk2(v0[2], v0[3]); w.z = pk2(v1[0], v1[1]); w.w = pk2(v1[2], v1[3]); *(u32x4*)((char*)YP + off + bj * 256) = w; } } }
    }
};
__device__ __forceinline__ void moe_offsets(const Ctx& C, int layer, LAS int* boff, LAS int* cnt, int tid) {
    if (tid == 0) { const unsigned* gcnt = (const unsigned*)(C.ws + WS_CTL) + CW_CNT + 64 * layer; int acc = 0;
        for (int e = 0; e < 16; ++e) { const int n = (int)__hip_atomic_load(gcnt + e, __ATOMIC_RELAXED, __HIP_MEMORY_SCOPE_AGENT); cnt[e] = n; boff[e] = acc; acc += (n + 255) >> 8; }
        boff[16] = acc; }
    __syncthreads();
}

__device__ __forceinline__ void phase_final(const Ctx& C, int gw, int NGW, int lane) {
    const float* mod = (const float*)(C.ws + WS_MOD) + (size_t)(DEPTH - 1) * 17 * 6144;
    const bf16_t* XR = (const bf16_t*)(C.ws + WS_X32); const bf16_t* YP = (const bf16_t*)(C.ws + WS_YP);
    for (int r = gw; r < NB * SEQ; r += NGW) {
        const int b = r / SEQ, t = r - b * SEQ; const size_t m = (size_t)b * TPB + CTX + t;
        const u32x2* xr = (const u32x2*)(XR + m * DM) + lane; const u32x2* y0 = (const u32x2*)(YP + m * 2 * DM) + lane; const u32x2* y1 = y0 + DM / 4;
        const f32x4* g2 = (const f32x4*)(mod + (size_t)b * 6144 + 5 * DM) + lane; f32x4* o = (f32x4*)(C.out + (size_t)r * DM) + lane;
        u32x2 a[4], bb[4], x[4];
#pragma unroll
        for (int j = 0; j < 4; ++j) { x[j] = xr[64 * j]; a[j] = y0[64 * j]; bb[j] = y1[64 * j]; }
#pragma unroll
        for (int j = 0; j < 4; ++j) o[64 * j] = bf4(x[j]) + g2[64 * j] * (bf4(a[j]) + bf4(bb[j]));
    }
}

#ifndef R3OFF
#define R3OFF 0
#endif
#ifndef WINOFF
#define WINOFF 0
#endif
#ifndef PHMASK
#define PHMASK 0xFFFF
#endif
#ifndef MK_ONE_LAUNCH
#define MK_ONE_LAUNCH 1
#endif
constexpr int PH_PER_LAYER = 9, PH_LAYER0 = 2, PH_FINAL = PH_LAYER0 + DEPTH * PH_PER_LAYER, PH_COUNT = PH_FINAL + 1;
struct Args { const float* in[18]; float* out; unsigned char* ws; int ph_lo, ph_hi, flags, pad; };
__global__ void __launch_bounds__(512, 2) mega_fwd(Args args) {
    extern __shared__ __attribute__((aligned(16))) unsigned char lds_raw[];
    LAS unsigned char* lds = (LAS unsigned char*)lds_raw;
    Ctx C; C.out = args.out; C.ws = args.ws;
    const int tid = threadIdx.x, lane = tid & 63, wave = __builtin_amdgcn_readfirstlane(tid >> 6);
    const int G = gridDim.x; const int bx = blockIdx.x; const int vcu = (G % 8 == 0) ? (bx % 8) * (G / 8) + bx / 8 : bx;
    const int gw = vcu * 8 + wave, NGW = G * 8;
    volatile LAS unsigned* MISC = (volatile LAS unsigned*)(lds + LDSCTL_OFF);
    for (int u = tid; u < (LDS_BYTES - LDSCTL_OFF) / 4; u += 512) ((LAS unsigned*)(lds + LDSCTL_OFF))[u] = 0u;
    __syncthreads();
    const int lo = args.ph_lo, hi = args.ph_hi;
    XcdBarrier bar; bar.bar = (unsigned*)(C.ws + WS_CTL) + CW_BAR; bar.x = 0; bar.st = nullptr;
    if (hi - lo > 1) bar = xcd_barrier_post((unsigned*)(C.ws + WS_CTL) + CW_BAR, MISC);
#define IN(k) (lo <= (k) && (k) < hi)
#define PHASE_IDS() int bx_ = bx, wave_ = wave; LAS unsigned char* lds_ = lds; asm volatile("" : "+s"(bx_), "+s"(wave_), "+s"(lds_)); int lane_; asm volatile("v_mbcnt_lo_u32_b32 %0, -1, 0\n\tv_mbcnt_hi_u32_b32 %0, -1, %0" : "=v"(lane_)); const int tid_ = wave_ * 64 + lane_; \
    const int vcu_ = (G % 8 == 0) ? (bx_ % 8) * (G / 8) + bx_ / 8 : bx_; const int gw_ = vcu_ * 8 + wave_; (void)lane_; (void)gw_; (void)vcu_
#define SEAM(k) do { if (IN(k) && IN((k) + 1)) xcd_barrier(bar); } while (0)

    if (IN(0) && (PHMASK & 1)) { PHASE_IDS(); phase_prologue(C, lds_, G, vcu_, bx_, tid_); } SEAM(0);
    if (IN(1) && (PHMASK & 2)) { PHASE_IDS(); phase_modsum(C, G, bx_, tid_); } SEAM(1);
#ifdef EXTRA_BARS
    if (hi - lo > 1) for (int eb = 0; eb < EXTRA_BARS; ++eb) xcd_barrier(bar);
#endif

#ifdef LAYER_UNROLL
#pragma unroll
#else
#pragma nounroll
#endif
    for (int layer = 0; layer < DEPTH; ++layer) {
        const int p0 = PH_LAYER0 + layer * PH_PER_LAYER;
        if (IN(p0 + 0) && (PHMASK & 4)) { PHASE_IDS(); phase_norm1(C, layer, gw_, NGW, lane_, (args.flags & 16) ? (bf16_t*)(C.ws + WS_Y) : (bf16_t*)(C.ws + WS_X32)); } SEAM(p0 + 0);
        if (IN(p0 + 1) && (PHMASK & 8)) {
            pg8::Gemm g{(const bf16_t*)(C.ws + WS_H), (const bf16_t*)(C.ws + WS_WIN) + (size_t)layer * DIN * DM, MROWS, DIN, DM};
            PHASE_IDS(); pg8::StaticOrder S; S.init(MROWS, DIN, G, bx_);
            pg8::EpiBf16 E{(bf16_t*)(C.ws + WS_P), DIN};
            pg8::gemm_phase<pg8::EpiBf16, pg8::StaticOrder, true>(lds_, g, S, E, tid_);
        } SEAM(p0 + 1);
        if (IN(p0 + 2) && (PHMASK & 16)) {
            PHASE_IDS(); if (!(args.flags & 1)) phase_qkprep(C, layer, gw_, NGW, lane_, (args.flags & 8) ? (bf16_t*)(C.ws + WS_Y) : (bf16_t*)(C.ws + WS_P));
            if (!(args.flags & 8)) for (int u = bx_; u < NB * 4 * NCH; u += G) { const int c = u % NCH, bh = u / NCH; ret_r1_unit(C, layer, bh >> 2, bh & 3, c, lds_, tid_); }
        } SEAM(p0 + 2);
        if (IN(p0 + 3) && (PHMASK & 32)) {
            PHASE_IDS(); for (int u = bx_; u < 512; u += G) ret_r2_unit(C, layer, u, tid_);
            attn_units<false>(C, layer, G, vcu_, bx_, tid_, (char*)lds_);
        } SEAM(p0 + 3);
        if (IN(p0 + 4) && (PHMASK & 64)) {
            PHASE_IDS();
            if (!WINOFF && !(args.flags & 32)) attn_units<true>(C, layer, G, vcu_, bx_, tid_, (char*)lds_);
            if (!R3OFF && !(args.flags & 64))
            for (int u = bx_; u < NB * 4 * NCH; u += G) { const int c = u % NCH, bh = u / NCH; ret_r3_unit(C, layer, bh >> 2, bh & 3, c, lds_, tid_); }
        } SEAM(p0 + 4);
        if (IN(p0 + 5) && (PHMASK & 128)) {
            pg8::Gemm g{(const bf16_t*)(C.ws + WS_Y), (const bf16_t*)(C.ws + WS_WOUT) + (size_t)layer * DM * DM, MROWS, DM, DM};
            PHASE_IDS(); pg8::StaticOrder S; S.init(MROWS, DM, G, bx_);
            pg8::EpiResid E{(bf16_t*)(C.ws + ((args.flags & 4) ? WS_P : WS_X32)), (const float*)(C.ws + WS_MOD) + (size_t)layer * 17 * 6144 + 2 * DM};
            pg8::gemm_phase<pg8::EpiResid, pg8::StaticOrder, true>(lds_, g, S, E, tid_);
        } SEAM(p0 + 5);
        if (IN(p0 + 6) && (PHMASK & 256)) { PHASE_IDS(); phase_norm2_route(C, layer + ((args.flags & 2) ? 4 : 0), lds_, G, bx_, tid_); } SEAM(p0 + 6);
        if (IN(p0 + 7) && (PHMASK & 512)) {
            PHASE_IDS(); LAS int* boff = (LAS int*)(lds_ + LDSCTL_OFF + 64); LAS int* mcnt = (LAS int*)(lds_ + LDSCTL_OFF + 192); moe_offsets(C, layer, boff, mcnt, tid_);
            pg8::Gemm g{(const bf16_t*)(C.ws + WS_H), (const bf16_t*)(C.ws + WS_WGU + (size_t)layer * NE * 2 * FF * DM), 0, 2 * FF, DM};
            MoeOrder<true, 8> S{(const int*)(C.ws + WS_LIST), boff, mcnt, G, bx_};
            EpiGateUp E{(unsigned char*)(C.ws + WS_P)};
            pg8::gemm_phase<EpiGateUp, MoeOrder<true, 8>, true, true>(lds_, g, S, E, tid_);
        } SEAM(p0 + 7);
        if (IN(p0 + 8) && (PHMASK & 1024)) {
            PHASE_IDS(); LAS int* boff = (LAS int*)(lds_ + LDSCTL_OFF + 64); LAS int* mcnt = (LAS int*)(lds_ + LDSCTL_OFF + 192); moe_offsets(C, layer, boff, mcnt, tid_);
            pg8::Gemm g{(const bf16_t*)(C.ws + WS_P), (const bf16_t*)(C.ws + WS_WDN + (size_t)layer * NE * DM * FF), 0, DM, FF};
            MoeOrder<false, 4> S{(const int*)(C.ws + WS_LIST), boff, mcnt, G, bx_};
            EpiDown E{(bf16_t*)(C.ws + WS_YP), (const float*)(C.ws + WS_GW), (const int*)(C.ws + WS_LIST), boff, mcnt};
            pg8::gemm_phase<EpiDown, MoeOrder<false, 4>, true, true>(lds_, g, S, E, tid_);
        } SEAM(p0 + 8);
    }
    if (IN(PH_FINAL) && (PHMASK & 2048)) { PHASE_IDS(); phase_final(C, gw_, NGW, lane_); }
#undef IN
#undef SEAM
}

extern "C" void kernel_launch(void* const* d_in, const int* in_sizes, int n_in, void* d_out, int out_size, void* d_ws, size_t ws_size, hipStream_t stream) {
    static int grid = 0;
    if (grid == 0) {
        if (n_in != 18 || in_sizes[0] != NB * SEQ * DM || out_size != NB * SEQ * DM || ws_size < WS_END) {
            fprintf(stderr, "kernel_launch: unexpected shapes (n_in %d, in0 %d, out %d, ws %zu, need %zu); nothing launched\n", n_in, n_in > 0 ? in_sizes[0] : -1, out_size, ws_size, (size_t)WS_END); grid = -1; return; }
        int dev = 0, cus = 0, per_cu = 0;
        if (hipGetDevice(&dev) != hipSuccess || hipDeviceGetAttribute(&cus, hipDeviceAttributeMultiprocessorCount, dev) != hipSuccess) { grid = -1; return; }
        if (hipFuncSetAttribute((const void*)mega_fwd, hipFuncAttributeMaxDynamicSharedMemorySize, LDS_BYTES) != hipSuccess) { fprintf(stderr, "kernel_launch: hipFuncSetAttribute failed\n"); grid = -1; return; }
        if (hipOccupancyMaxActiveBlocksPerMultiprocessor(&per_cu, (const void*)mega_fwd, 512, LDS_BYTES) != hipSuccess || per_cu < 1) fprintf(stderr, "kernel_launch: occupancy query says %d\n", per_cu);
        (void)hipGetLastError();
        grid = cus;
    }
    if (grid < 0) return;
    if (hipMemsetAsync((char*)d_ws + WS_CTL, 0, CTL_BYTES, stream) != hipSuccess) return;
    Args a{};
    for (int i = 0; i < 18; ++i) a.in[i] = (const float*)d_in[i];
    a.out = (float*)d_out; a.ws = (unsigned char*)d_ws;
#if MK_ONE_LAUNCH
    a.ph_lo = 0; a.ph_hi = PH_COUNT;
    hipLaunchKernelGGL(mega_fwd, dim3(grid), dim3(512), LDS_BYTES, stream, a);
#else
    for (int p = 0; p < PH_COUNT; ++p) { a.ph_lo = p; a.ph_hi = p + 1;
#if !defined(PROBE_P) || !PROBE_BEFORE
        hipLaunchKernelGGL(mega_fwd, dim3(grid), dim3(512), LDS_BYTES, stream, a);
#endif
#ifdef PROBE_P
        const bool hit = (PROBE_P < 2) ? (p == PROBE_P) : (p >= PH_LAYER0 && p < PH_FINAL && (p - PH_LAYER0) % PH_PER_LAYER == PROBE_P - 2 && (!PROBE_L0 || p < PH_LAYER0 + PH_PER_LAYER));
        if (hit) { a.flags = PROBE_FLAGS; for (int r = 0; r < PROBE_REP; ++r) hipLaunchKernelGGL(mega_fwd, dim3(grid), dim3(512), LDS_BYTES, stream, a); a.flags = 0; }
#if PROBE_BEFORE
        hipLaunchKernelGGL(mega_fwd, dim3(grid), dim3(512), LDS_BYTES, stream, a);
#endif
#endif
    }
#endif
}
```

```cpp
#define MK_ONE_LAUNCH 1
#include <hip/hip_runtime.h>
#include <cstdio>
#include <cstdint>

#define GAS __attribute__((address_space(1)))
#define LAS __attribute__((address_space(3)))
typedef unsigned short bf16_t;
typedef short bf16x8 __attribute__((ext_vector_type(8)));
typedef float f32x4 __attribute__((ext_vector_type(4)));
typedef float f32x2 __attribute__((ext_vector_type(2)));
typedef float f32x16 __attribute__((ext_vector_type(16)));
typedef unsigned u32x4 __attribute__((ext_vector_type(4)));
typedef unsigned u32x2 __attribute__((ext_vector_type(2)));

constexpr int DM = 1024, NB = 16, SEQ = 4096, CTX = 256, TPB = SEQ + CTX, MROWS = NB * TPB, DEPTH = 4;
constexpr int DIN = 2560;
constexpr int C_RQ = 0, C_RK = 256, C_RV = 512, C_RG = 1024, C_WQ = 1536, C_WK = 1792, C_WV = 1920, C_GQ = 2048, C_GK = 2304, C_GV = 2432;
constexpr int NE = 16, FF = 1024, NCH = TPB / 128;
constexpr float EPS = 1e-6f;
constexpr float LOG2E = 1.4426950408889634f;
constexpr float QSCALE = 0.125f * LOG2E;

__device__ __forceinline__ unsigned f2bf(float f) { unsigned u = __builtin_bit_cast(unsigned, f); return (u + 0x7fffu + ((u >> 16) & 1u)) >> 16; }
__device__ __forceinline__ unsigned pk2(float lo, float hi) { return f2bf(lo) | (f2bf(hi) << 16); }
__device__ __forceinline__ float bf2f(unsigned short h) { return __builtin_bit_cast(float, (unsigned)h << 16); }
__device__ __forceinline__ float bflo(unsigned w) { return __builtin_bit_cast(float, w << 16); }
__device__ __forceinline__ float bfhi(unsigned w) { return __builtin_bit_cast(float, w & 0xffff0000u); }

namespace pg8 {
constexpr int BM = 256, BK = 64, HALF = 128, HTB = HALF * BK * 2, STAGE_BYTES = 8 * HTB, NXCD = 8, WGM = 8;
__host__ __device__ __forceinline__ int lds_byte(int r, int c) { const int st = (r >> 4) * 2 + (c >> 5), rr = r & 15, cc = c & 31, ob = rr * 64 + cc * 2; return st * 1024 + (ob ^ (((ob >> 9) & 1) << 5)); }
__host__ __device__ __forceinline__ void stage_rc(int b, int& R, int& C) { const int st = b / 1024, sb = b % 1024, swz = sb ^ (((sb >> 9) & 1) << 5); R = (st >> 1) * 16 + swz / 64; C = (st & 1) * 32 + (swz % 64) / 2; }
__host__ __device__ __forceinline__ int perm32(int rho) { const int n = rho >> 4, i = rho & 15; return 8 * (i >> 2) + 4 * n + (i & 3); }

struct Unit { int pm, pn; };
struct Gemm { const bf16_t* A; const bf16_t* Bt; int M, N, K; };

struct StaticOrder {
    static constexpr bool GATHER = false;
    int nM, nN, nwg, G, c;
    __device__ void init(int M, int N, int G_, int c_) { nM = M / BM; nN = N / BM; nwg = nM * nN; G = G_; c = c_; }
    __device__ bool next(int i, Unit& u) const {
        const long L = (long)i * G + c; if (L >= nwg) return false;
        int wgid = (int)L; { const int q = nwg / NXCD, r = nwg % NXCD, xcd = wgid % NXCD, off = wgid / NXCD; wgid = (xcd < r ? xcd * (q + 1) : r * (q + 1) + (xcd - r) * q) + off; }
        const int nig = WGM * nN, gid = wgid / nig, fm = gid * WGM, gsz = (nM - fm) < WGM ? (nM - fm) : WGM;
        u.pm = fm + ((wgid % nig) % gsz); u.pn = (wgid % nig) / gsz; return true;
    }
    __device__ __forceinline__ unsigned arow(const Unit&, int) const { return 0u; }
};

__device__ __forceinline__ unsigned cvt_pk_bf16(float lo, float hi) { unsigned r; asm volatile("v_cvt_pk_bf16_f32 %0, %1, %2" : "=v"(r) : "v"(lo), "v"(hi)); return r; }

struct EpiBf16 {
    static constexpr bool PERM = true;
    bf16_t* O; int ldc;
    __device__ __forceinline__ void operator()(const f32x4 (&acc)[2][2][4][2], const Unit& u, int wr, int wc, int fr, int fq) const {
        const int row0 = u.pm * BM + wr * 64 + fr; const int col0 = u.pn * BM + wc * 32 + 8 * fq;
#pragma unroll
        for (int ai = 0; ai < 2; ++ai)
#pragma unroll
            for (int m = 0; m < 4; ++m) { const unsigned off = ((unsigned)(row0 + ai * HALF + m * 16) * (unsigned)ldc + (unsigned)col0) * 2u;
#pragma unroll
                for (int bj = 0; bj < 2; ++bj) { const f32x4 v0 = acc[ai][bj][m][0], v1 = acc[ai][bj][m][1];
                    u32x4 w; w.x = cvt_pk_bf16(v0[0], v0[1]); w.y = cvt_pk_bf16(v0[2], v0[3]); w.z = cvt_pk_bf16(v1[0], v1[1]); w.w = cvt_pk_bf16(v1[2], v1[3]);
                    *(u32x4*)((char*)O + off + bj * HALF * 2) = w; } }
    }
};

struct EpiResid {
    static constexpr bool PERM = true;
    bf16_t* X; const float* gate;
    __device__ __forceinline__ void operator()(const f32x4 (&acc)[2][2][4][2], const Unit& u, int wr, int wc, int fr, int fq) const {
        const int set = (u.pm % 17 == 0) ? 16 : (u.pm / 17);
        const float* gp = gate + (size_t)set * 6 * DM;
        const int col0 = u.pn * BM + wc * 32 + 8 * fq;
        f32x4 gv[2][2];
#pragma unroll
        for (int bj = 0; bj < 2; ++bj)
#pragma unroll
            for (int n = 0; n < 2; ++n) gv[bj][n] = *(const f32x4*)(gp + col0 + bj * HALF + n * 4);
#pragma unroll
        for (int ai = 0; ai < 2; ++ai) {
            u32x4 xin[4][2];
#pragma unroll
            for (int m = 0; m < 4; ++m) { const unsigned off = ((unsigned)(u.pm * BM + ai * HALF + wr * 64 + m * 16 + fr) * (unsigned)DM + (unsigned)col0) * 2u;
#pragma unroll
                for (int bj = 0; bj < 2; ++bj) xin[m][bj] = *(const u32x4*)((const char*)X + off + bj * HALF * 2); }
            asm volatile("" ::: "memory");
#pragma unroll
            for (int m = 0; m < 4; ++m) { const unsigned off = ((unsigned)(u.pm * BM + ai * HALF + wr * 64 + m * 16 + fr) * (unsigned)DM + (unsigned)col0) * 2u;
#pragma unroll
                for (int bj = 0; bj < 2; ++bj) { const u32x4 x = xin[m][bj]; const f32x4 a0 = acc[ai][bj][m][0] * gv[bj][0], a1 = acc[ai][bj][m][1] * gv[bj][1];
                    u32x4 w; w.x = cvt_pk_bf16(bflo(x.x) + a0[0], bfhi(x.x) + a0[1]); w.y = cvt_pk_bf16(bflo(x.y) + a0[2], bfhi(x.y) + a0[3]);
                    w.z = cvt_pk_bf16(bflo(x.z) + a1[0], bfhi(x.z) + a1[1]); w.w = cvt_pk_bf16(bflo(x.w) + a1[2], bfhi(x.w) + a1[3]);
                    *(u32x4*)((char*)X + off + bj * HALF * 2) = w; } }
            asm volatile("" ::: "memory");
        }
    }
};

template <class Epi, class Sched, bool ALIGN_EPI, bool FP8 = false>
__device__ __forceinline__ void gemm_phase(LAS unsigned char* lds, const Gemm g, const Sched& S, const Epi& E, const int tid) {
    const int wid = __builtin_amdgcn_readfirstlane(tid >> 6), lane = tid & 63, wr = wid >> 2, wc = wid & 3, fr = lane & 15, fq = lane >> 4;
    const int K = g.K, KB = FP8 ? K : 2 * K  , nt = KB / (BK * 2);
    unsigned voffB[2], vA[2][2], vAn[2][2]; int sR[2], sC[2];
#pragma unroll
    for (int i = 0; i < 2; ++i) { int R, C; stage_rc(tid * 16 + i * 8192, R, C); sR[i] = R; sC[i] = C; const int Rb = Epi::PERM ? ((R & ~31) + perm32(R & 31)) : R;
        voffB[i] = (unsigned)(Rb * KB + C * 2); }
#define PG8_SETV(v, u) do { _Pragma("unroll") for (int h_ = 0; h_ < 2; ++h_) _Pragma("unroll") for (int i_ = 0; i_ < 2; ++i_) { \
        if constexpr (Sched::GATHER) v[h_][i_] = S.arow(u, h_ * HALF + sR[i_]) * (unsigned)KB + (unsigned)(sC[i_] * 2); \
        else v[h_][i_] = (unsigned)((h_ * HALF + sR[i_]) * KB + sC[i_] * 2); } } while (0)
    const size_t kstep = (size_t)(BK * 2);
    const size_t hstep = (size_t)HALF * KB;
    const size_t tstep = 2 * hstep;
    const size_t atstep = Sched::GATHER ? (size_t)0 : tstep;
    const unsigned ldsw = (unsigned)wid * 1024u;
    const int aoff = lds_byte(wr * 64 + fr, fq * 8), boff = lds_byte(wc * 32 + fr, fq * 8);
#define PG8_SA(b, h) (((b) * 2 + (h)) * HTB)
#define PG8_SB(b, h) ((4 + (b) * 2 + (h)) * HTB)
#define PG8_STAGE(bufoff, gbase, voff) do { _Pragma("unroll") for (int _i = 0; _i < 2; ++_i) \
        __builtin_amdgcn_global_load_lds((const unsigned*)((const char*)(gbase) + (voff)[_i]), (LAS unsigned*)(lds + (bufoff) + ldsw + _i * 8192), 16, 0, 0); } while (0)
#define PG8_LDA(dst, b, h) do { _Pragma("unroll") for (int m = 0; m < 4; ++m) _Pragma("unroll") for (int k = 0; k < 2; ++k) dst[m][k] = *(const LAS bf16x8*)(lds + PG8_SA(b, h) + aoff + m * 2048 + k * 1024); } while (0)
#define PG8_LDB(dst, b, h) do { _Pragma("unroll") for (int n = 0; n < 2; ++n) _Pragma("unroll") for (int k = 0; k < 2; ++k) dst[n][k] = *(const LAS bf16x8*)(lds + PG8_SB(b, h) + boff + n * 2048 + k * 1024); } while (0)
    typedef long i64x2_ __attribute__((ext_vector_type(2)));
#define PG8_MMA(ai, bj, At, Bt) do { __builtin_amdgcn_s_setprio(1); _Pragma("unroll") for (int m = 0; m < 4; ++m) _Pragma("unroll") for (int n = 0; n < 2; ++n) _Pragma("unroll") for (int k = 0; k < 2; ++k) { \
        if constexpr (FP8) { const i64x2_ b2_ = __builtin_bit_cast(i64x2_, Bt[n][k]), a2_ = __builtin_bit_cast(i64x2_, At[m][k]); \
            acc[ai][bj][m][n] = __builtin_amdgcn_mfma_f32_16x16x32_fp8_fp8(b2_[0], a2_[0], acc[ai][bj][m][n], 0, 0, 0); \
            acc[ai][bj][m][n] = __builtin_amdgcn_mfma_f32_16x16x32_fp8_fp8(b2_[1], a2_[1], acc[ai][bj][m][n], 0, 0, 0); } \
        else acc[ai][bj][m][n] = __builtin_amdgcn_mfma_f32_16x16x32_bf16(Bt[n][k], At[m][k], acc[ai][bj][m][n], 0, 0, 0); } \
        __builtin_amdgcn_s_setprio(0); } while (0)
#define PG8_WAIT_V(n) asm volatile("s_waitcnt vmcnt(" #n ")" ::: "memory")
#define PG8_WAIT_L(n) asm volatile("s_waitcnt lgkmcnt(" #n ")" ::: "memory")
#define PG8_BAR __builtin_amdgcn_s_barrier()
#define PG8_SCHED __builtin_amdgcn_sched_barrier(0)
    Unit cur, nxt; int ui = 0;
    if (!S.next(0, cur)) return;
    float z0 = 0.f; asm volatile("" : "+v"(z0));
    f32x4 acc[2][2][4][2];
#pragma unroll
    for (int a = 0; a < 2; ++a)
#pragma unroll
        for (int b = 0; b < 2; ++b)
#pragma unroll
            for (int m = 0; m < 4; ++m)
#pragma unroll
                for (int n = 0; n < 2; ++n) acc[a][b][m][n] = (f32x4){z0, z0, z0, z0};
    bf16x8 At[4][2], B0[2][2], B1[2][2];
    const char* cA = (const char*)g.A + (size_t)cur.pm * atstep; const char* cB = (const char*)g.Bt + (size_t)cur.pn * tstep;
    PG8_SETV(vA, cur);
    PG8_STAGE(PG8_SB(0, 0), cB, voffB); PG8_STAGE(PG8_SB(0, 1), cB + hstep, voffB); PG8_STAGE(PG8_SA(0, 0), cA, vA[0]); PG8_STAGE(PG8_SA(0, 1), cA, vA[1]);
    if (wr == 1) PG8_BAR;
    PG8_WAIT_V(2); PG8_BAR;
    PG8_STAGE(PG8_SB(1, 0), cB + kstep, voffB); PG8_STAGE(PG8_SA(1, 0), cA + kstep, vA[0]); PG8_STAGE(PG8_SB(1, 1), cB + hstep + kstep, voffB);
    PG8_WAIT_V(6); PG8_BAR;
    for (;;) {
        const bool has_next = S.next(ui + 1, nxt);
        const char* nA = has_next ? (const char*)g.A + (size_t)nxt.pm * atstep : cA; const char* nB = has_next ? (const char*)g.Bt + (size_t)nxt.pn * tstep : cB;
        if (has_next) { PG8_SETV(vAn, nxt); } else {
#pragma unroll
            for (int h_ = 0; h_ < 2; ++h_)
#pragma unroll
                for (int i_ = 0; i_ < 2; ++i_) vAn[h_][i_] = vA[h_][i_]; }
        for (int t = 0; t < nt; t += 2) {
            const bool last = (t == nt - 2);
            const char* a1 = cA + (size_t)(t + 1) * kstep;
            const char* a2 = last ? nA : cA + (size_t)(t + 2) * kstep; const char* b2 = last ? nB : cB + (size_t)(t + 2) * kstep;
            const char* a3 = a2 + kstep; const char* b3 = b2 + kstep;
            unsigned o2[2][2];
#pragma unroll
            for (int h_ = 0; h_ < 2; ++h_)
#pragma unroll
                for (int i_ = 0; i_ < 2; ++i_) o2[h_][i_] = last ? vAn[h_][i_] : vA[h_][i_];
            PG8_LDB(B0, 0, 0); PG8_LDB(B1, 0, 1); PG8_SCHED; PG8_LDA(At, 0, 0); PG8_STAGE(PG8_SA(1, 1), a1, vA[1]);
            PG8_WAIT_V(8); PG8_WAIT_L(0); PG8_BAR; PG8_MMA(0, 0, At, B0); PG8_MMA(0, 1, At, B1); PG8_BAR; PG8_SCHED;
            PG8_LDA(At, 0, 1); PG8_STAGE(PG8_SB(0, 0), b2, voffB); PG8_STAGE(PG8_SB(0, 1), b2 + hstep, voffB); PG8_STAGE(PG8_SA(0, 0), a2, o2[0]);
            PG8_WAIT_V(8); PG8_WAIT_L(0); PG8_BAR; PG8_MMA(1, 0, At, B0); PG8_MMA(1, 1, At, B1); PG8_BAR; PG8_SCHED;
            PG8_LDB(B0, 1, 0); PG8_LDB(B1, 1, 1); PG8_SCHED; PG8_LDA(At, 1, 0); PG8_STAGE(PG8_SA(0, 1), a2, o2[1]);
            PG8_WAIT_V(8); PG8_WAIT_L(0); PG8_BAR; PG8_MMA(0, 0, At, B0); PG8_MMA(0, 1, At, B1); PG8_BAR; PG8_SCHED;
            PG8_LDA(At, 1, 1); PG8_STAGE(PG8_SB(1, 0), b3, voffB); PG8_STAGE(PG8_SB(1, 1), b3 + hstep, voffB); PG8_STAGE(PG8_SA(1, 0), a3, o2[0]);
            PG8_WAIT_V(8); PG8_WAIT_L(0); PG8_BAR; PG8_MMA(1, 0, At, B0); PG8_MMA(1, 1, At, B1); PG8_BAR; PG8_SCHED;
        }
        if constexpr (ALIGN_EPI) { if (wr == 0) PG8_BAR; }
        E(acc, cur, wr, wc, fr, fq);
        if (!has_next) break;
#pragma unroll
        for (int a = 0; a < 2; ++a)
#pragma unroll
            for (int b = 0; b < 2; ++b)
#pragma unroll
                for (int m = 0; m < 4; ++m)
#pragma unroll
                    for (int n = 0; n < 2; ++n) acc[a][b][m][n] = (f32x4){z0, z0, z0, z0};
        cur = nxt; cA = nA; cB = nB; ++ui;
#pragma unroll
        for (int h_ = 0; h_ < 2; ++h_)
#pragma unroll
            for (int i_ = 0; i_ < 2; ++i_) vA[h_][i_] = vAn[h_][i_];
        if constexpr (ALIGN_EPI) { if (wr == 1) PG8_BAR; }
    }
    PG8_WAIT_V(0);
    if constexpr (!ALIGN_EPI) { if (wr == 0) PG8_BAR; }
    PG8_BAR;
#undef PG8_SETV
#undef PG8_SA
#undef PG8_SB
#undef PG8_STAGE
#undef PG8_LDA
#undef PG8_LDB
#undef PG8_MMA
#undef PG8_WAIT_V
#undef PG8_WAIT_L
#undef PG8_BAR
#undef PG8_SCHED
}
}
#include <hip/hip_bf16.h>
#include <cmath>
namespace attn_body {
using bf16=__hip_bfloat16;
using s16x4=__attribute__((ext_vector_type(4)))short;
constexpr int D=64,QP=DIN,OP=1024;
constexpr int NW=8,QBLK=32,QB=QBLK*NW,KVBLK=64;
__device__ __forceinline__ int crow(int r,int hi){return (r&3)+8*(r>>2)+4*hi;}
#define SBAR() __builtin_amdgcn_sched_barrier(0)
__device__ __forceinline__ void wmask(f32x16&p0,f32x16&p1,int kq,int hi){
  const float NEG=-INFINITY; const int kb=kq+4*hi;
  #pragma unroll
  for(int r=0;r<16;++r){const int d=kb+(r&3)+8*(r>>2); if(d>128||d<-128)p0[r]=NEG; if(d+32>128||d+32<-128)p1[r]=NEG;}
}

constexpr int NSLOT=3, SLOTB=8192;
constexpr int LDS_K=0, LDS_V=NSLOT*SLOTB, LDS_WS=2*NSLOT*SLOTB, LDS_OST=LDS_WS+NW*64*4, LDS_BYTES=LDS_OST+NW*4096;
constexpr float C2=0.125f*1.4426950408889634f;
__device__ __forceinline__ void glds16(const void*gsrc,unsigned lds_dst){unsigned keep;
  asm volatile("s_mov_b32 %0, m0\n\ts_mov_b32 m0, %2\n\ts_nop 0\n\tglobal_load_lds_dwordx4 %1, off\n\ts_mov_b32 m0, %0":"=&s"(keep):"v"(gsrc),"s"(lds_dst):"memory");}
__device__ __forceinline__ float max3f(float a,float b,float c){float r;asm("v_max3_f32 %0, %1, %2, %3":"=v"(r):"v"(a),"v"(b),"v"(c));return r;}
__device__ __forceinline__ float max2f(float a,float b){float r;asm("v_max_f32_e32 %0, %1, %2":"=v"(r):"v"(a),"v"(b));return r;}
__device__ __forceinline__ float fadd_s(float a,float b){float r;asm("v_add_f32_e32 %0, %1, %2":"=v"(r):"v"(a),"v"(b));return r;}
__device__ __forceinline__ float fsub_s(float a,float b){float r;asm("v_sub_f32_e32 %0, %1, %2":"=v"(r):"v"(a),"v"(b));return r;}
typedef float f32x2_t __attribute__((ext_vector_type(2))); typedef __bf16 bf16x2_t __attribute__((ext_vector_type(2)));
__device__ __forceinline__ unsigned cvtpk_s(float lo,float hi){f32x2_t v={lo,hi};bf16x2_t b=__builtin_convertvector(v,bf16x2_t);return __builtin_bit_cast(unsigned,b);}
#define WAIT_BAR(N) asm volatile("s_waitcnt vmcnt(" #N ") lgkmcnt(0)\n\ts_barrier":::"memory")

__device__ __forceinline__ void qkt(f32x16&p0,f32x16&p1,const char*Kslot,const bf16x8*qr,const f32x16&negm,int r32,int hi){
  const char*kb=Kslot+hi*1024+r32*16;
  #pragma unroll
  for(int d0=0;d0<4;++d0){
    const bf16x8 b0=*reinterpret_cast<const bf16x8*>(kb+d0*2048);
    const bf16x8 b1=*reinterpret_cast<const bf16x8*>(kb+d0*2048+512);
    if(d0==0){p0=__builtin_amdgcn_mfma_f32_32x32x16_bf16(b0,qr[0],negm,0,0,0);p1=__builtin_amdgcn_mfma_f32_32x32x16_bf16(b1,qr[0],negm,0,0,0);}
    else{p0=__builtin_amdgcn_mfma_f32_32x32x16_bf16(b0,qr[d0],p0,0,0,0);p1=__builtin_amdgcn_mfma_f32_32x32x16_bf16(b1,qr[d0],p1,0,0,0);}}
}
typedef __attribute__((address_space(3))) const char* lds_cptr;
typedef short v4i16_t __attribute__((ext_vector_type(4)));
__device__ __forceinline__ void kload8(bf16x8*kf,lds_cptr kp){
  kf[0]=*(const __attribute__((address_space(3))) bf16x8*)(kp);      kf[1]=*(const __attribute__((address_space(3))) bf16x8*)(kp+512);
  kf[2]=*(const __attribute__((address_space(3))) bf16x8*)(kp+2048); kf[3]=*(const __attribute__((address_space(3))) bf16x8*)(kp+2560);
  kf[4]=*(const __attribute__((address_space(3))) bf16x8*)(kp+4096); kf[5]=*(const __attribute__((address_space(3))) bf16x8*)(kp+4608);
  kf[6]=*(const __attribute__((address_space(3))) bf16x8*)(kp+6144); kf[7]=*(const __attribute__((address_space(3))) bf16x8*)(kp+6656);
}
__device__ __forceinline__ void kload2(bf16x8*kf,lds_cptr kp,int j){ kf[2*j]=*(const __attribute__((address_space(3))) bf16x8*)(kp+j*2048); kf[2*j+1]=*(const __attribute__((address_space(3))) bf16x8*)(kp+j*2048+512); }
__device__ __forceinline__ s16x4 vtr(lds_cptr p){ return __builtin_bit_cast(s16x4,__builtin_amdgcn_ds_read_tr16_b64_v4i16((__attribute__((address_space(3))) v4i16_t*)p)); }
__device__ __forceinline__ float rowmax(const f32x16&p0,const f32x16&p1){
  float a=max3f(p0[0],p0[1],p1[0]),b=max3f(p0[2],p0[3],p1[1]);a=max3f(a,p1[2],p1[3]);
  #pragma unroll
  for(int r=4;r<16;r+=4){a=max3f(a,p0[r],p0[r+1]);b=max3f(b,p0[r+2],p0[r+3]);a=max3f(a,p1[r],p1[r+1]);b=max3f(b,p1[r+2],p1[r+3]);}
  const float m=max2f(a,b);
  auto rr=__builtin_amdgcn_permlane32_swap(__float_as_uint(m),__float_as_uint(m),false,false);
  return max2f(__uint_as_float(rr[0]),__uint_as_float(rr[1]));
}
__device__ __forceinline__ void pv(f32x16*o,int vb,bf16x8 pa0,bf16x8 pa1,bf16x8 pa2,bf16x8 pa3){
  #pragma unroll
  for(int d0=0;d0<2;++d0){s16x4 lo[4],hi[4];
    #pragma unroll
    for(int ks=0;ks<4;++ks){
      asm volatile("ds_read_b64_tr_b16 %0,%1 offset:%c2":"=&v"(lo[ks]):"v"(vb),"i"(d0*4096+ks*1024):"memory");
      asm volatile("ds_read_b64_tr_b16 %0,%1 offset:%c2":"=&v"(hi[ks]):"v"(vb),"i"(d0*4096+ks*1024+512):"memory");}
    asm volatile("s_waitcnt lgkmcnt(0)":::"memory");SBAR();
    #define PK(k) (bf16x8){lo[k][0],lo[k][1],lo[k][2],lo[k][3],hi[k][0],hi[k][1],hi[k][2],hi[k][3]}
    o[d0]=__builtin_amdgcn_mfma_f32_32x32x16_bf16(pa0,PK(0),o[d0],0,0,0);
    o[d0]=__builtin_amdgcn_mfma_f32_32x32x16_bf16(pa1,PK(1),o[d0],0,0,0);
    o[d0]=__builtin_amdgcn_mfma_f32_32x32x16_bf16(pa2,PK(2),o[d0],0,0,0);
    o[d0]=__builtin_amdgcn_mfma_f32_32x32x16_bf16(pa3,PK(3),o[d0],0,0,0);
    #undef PK
  }
}

#ifndef ATTN_STORE16
#define ATTN_STORE16(p,v) (*(u32x4*)(p)=(v))
#endif
template<int THRL,bool WIN> __device__ __forceinline__ void attn_unit(const bf16*Qb,const bf16*__restrict__ Kb,const bf16*__restrict__ Vb,bf16*Ob,int q0,int NT,int tdelta,float sink_l2,int tid,char*shm){
  const int lane=tid&63,r32=lane&31,hi=lane>>5; const int wid=__builtin_amdgcn_readfirstlane(tid>>6);
  const bf16*Qw=Qb+(long)(q0+wid*QBLK)*QP;
  const bf16*Kh=Kb,*Vh=Vb;
  const unsigned lds0=(unsigned)(uintptr_t)shm;
  float*wsf=(float*)(shm+LDS_WS)+wid*64;
  const bf16*ksrc=Kh+(long)lane*QP+wid*8;
  const bf16*vsrc=Vh+(long)(16*(wid&3)+(lane>>2))*QP+(wid>>2)*32+(lane&3)*8;
  const unsigned kdst=lds0+LDS_K+wid*1024, vdst=lds0+LDS_V+wid*1024;
  #define TM(t) ((t)<4?(t):(t)+tdelta)
  #define DMA_K(t,slot) glds16(ksrc+(long)TM(t)*KVBLK*QP,(unsigned)__builtin_amdgcn_readfirstlane(kdst+(slot)))
  #define DMA_V(t,slot) glds16(vsrc+(long)TM(t)*KVBLK*QP,(unsigned)__builtin_amdgcn_readfirstlane(vdst+(slot)))
  const int vb0=(int)(lds0+LDS_V)+((lane>>4)&1)*32+(lane&3)*8+(4*hi+((lane&15)>>2))*64;
  const char*Kbase=shm+LDS_K; bf16x8 kf[8];
  const lds_cptr shm3=(lds_cptr)shm; const lds_cptr kp0=shm3+LDS_K+hi*1024+r32*16; const lds_cptr vp0=shm3+LDS_V+((lane>>4)&1)*32+(lane&3)*8+(4*hi+((lane&15)>>2))*64;
  DMA_K(0,0);DMA_V(0,0);DMA_K(1,SLOTB);
  bf16x8 qr[4];
  #pragma unroll
  for(int d0=0;d0<4;++d0)qr[d0]=*reinterpret_cast<const bf16x8*>(&Qw[(long)r32*QP+d0*16+hi*8]);
  float mhat=0.f,l_reg=0.f;float z0_=0.f;asm volatile("":"+v"(z0_));f32x16 o[2];
  #pragma unroll
  for(int r_=0;r_<16;++r_){o[0][r_]=z0_;o[1][r_]=z0_;}
  f32x16 negm;
  #pragma unroll
  for(int r_=0;r_<16;++r_)negm[r_]=z0_;
  asm volatile("":"+v"(negm));
  const int qrow=q0+wid*QBLK+r32;
  #define CMASK(P0,P1,t) do{ if(WIN&&(t)>=4)wmask(P0,P1,TM(t)*KVBLK-qrow,hi); }while(0)
  bool resc=false;
  #define START(P0,P1) do{ const float rm=rowmax(P0,P1); resc=false; \
    { const float dl=rm; mhat=fadd_s(mhat,dl); \
      _Pragma("unroll") for(int r=0;r<16;++r){P0[r]=fsub_s(P0[r],dl);P1[r]=fsub_s(P1[r],dl);} \
      _Pragma("unroll") for(int r=0;r<16;++r)negm[r]=-mhat; asm volatile("":"+v"(negm)); } \
    _Pragma("unroll") for(int r=0;r<16;++r)P0[r]=__builtin_amdgcn_exp2f(P0[r]); }while(0)
  #define RESC() do{ if(resc){ asm volatile("s_waitcnt lgkmcnt(0)":::"memory"); \
      _Pragma("unroll") for(int d_=0;d_<2;++d_) _Pragma("unroll") for(int r=0;r<16;++r)o[d_][r]*=wsf[crow(r,hi)]; } }while(0)
  f32x16 pA0,pA1,pB0,pB1;
  int sl_prev=0,sl_cur=0,sl_next=SLOTB;
  #define ROT() do{sl_prev=sl_cur;sl_cur=sl_next;sl_next=(sl_next==(NSLOT-1)*SLOTB)?0:sl_next+SLOTB;}while(0)
  DMA_K(2,2*SLOTB);
  WAIT_BAR(3);
  qkt(pA0,pA1,Kbase,qr,negm,r32,hi);asm volatile("s_nop 15\n\ts_nop 7":"+v"(pA0),"+v"(pA1));CMASK(pA0,pA1,0);
  START(pA0,pA1);
  _Pragma("unroll") for(int r=0;r<16;++r)pA1[r]=__builtin_amdgcn_exp2f(pA1[r]);
  WAIT_BAR(0);
  DMA_K(3,0);DMA_V(1,SLOTB);
  ROT();
  kload8(kf,kp0+sl_cur);
  WAIT_BAR(2);
  s16x4 vlo[8],vhi[8]; u32x4 pw0,pw1,pw2,pw3;
  #define PKW(P,B) cvtpk_s(P[B],P[B+1])
  #define PAF(k) __builtin_bit_cast(bf16x8,pw##k)
  #define VFR(i) (bf16x8){vlo[i][0],vlo[i][1],vlo[i][2],vlo[i][3],vhi[i][0],vhi[i][1],vhi[i][2],vhi[i][3]}
  #define PIN(x) asm volatile("":"+v"(x))
  #define MX3(a,b,c) __builtin_fmaxf(__builtin_fmaxf((a),(b)),(c))
  #define GAPA(MF,A0,A1,A2,A3,W0,W1,PW) do{ MF; sacc+=A0; sacc+=A1; sacc+=A2; sacc+=A3; PIN(sacc); W0; W1; PIN(PW); SBAR(); }while(0)
  #define EX(v) __builtin_amdgcn_exp2f(v)
  #define GAPB(MF,X,B) do{ MF; X[B]=EX(X[B]); X[B+1]=EX(X[B+1]); X[B+2]=EX(X[B+2]); X[B+3]=EX(X[B+3]); PIN(X); SBAR(); }while(0)
  #define VRD(i) do{ vlo[i]=vtr(vp_+(((i)>>2)*4096+((i)&3)*1024)); vhi[i]=vtr(vp_+(((i)>>2)*4096+((i)&3)*1024+512)); }while(0)
  #define KRD(G,j) do{ if(G){ kload2(kf,kp0+sl_next,j); SBAR(); } }while(0)
  #define STEP(C0,C1,P0,P1,t,GK,GV,GL) do{ SBAR(); \
    const lds_cptr vp_=vp0+sl_prev; \
    VRD(0); SBAR(); float sacc=(P0[0]+P0[1]); \
    GAPA(C0=__builtin_amdgcn_mfma_f32_32x32x16_bf16(kf[0],qr[0],negm,0,0,0), P0[2],P0[3],P0[4],P0[5],     pw0[0]=PKW(P0,0), pw0[1]=PKW(P0,2), pw0); \
    VRD(4); SBAR(); GAPA(C1=__builtin_amdgcn_mfma_f32_32x32x16_bf16(kf[1],qr[0],negm,0,0,0), P0[6],P0[7],P0[8],P0[9],     pw0[2]=PKW(P0,4), pw0[3]=PKW(P0,6), pw0); \
    VRD(1); SBAR(); GAPA(C0=__builtin_amdgcn_mfma_f32_32x32x16_bf16(kf[2],qr[1],C0,0,0,0),   P0[10],P0[11],P0[12],P0[13], pw1[0]=PKW(P0,8), pw1[1]=PKW(P0,10), pw1); \
    VRD(5); SBAR(); GAPA(C1=__builtin_amdgcn_mfma_f32_32x32x16_bf16(kf[3],qr[1],C1,0,0,0),   P0[14],P0[15],P1[0],P1[1],   pw1[2]=PKW(P0,12),pw1[3]=PKW(P0,14), pw1); \
    VRD(2); SBAR(); GAPA(C0=__builtin_amdgcn_mfma_f32_32x32x16_bf16(kf[4],qr[2],C0,0,0,0),   P1[2],P1[3],P1[4],P1[5],     pw2[0]=PKW(P1,0), pw2[1]=PKW(P1,2), pw2); \
    VRD(6); SBAR(); GAPA(C1=__builtin_amdgcn_mfma_f32_32x32x16_bf16(kf[5],qr[2],C1,0,0,0),   P1[6],P1[7],P1[8],P1[9],     pw2[2]=PKW(P1,4), pw2[3]=PKW(P1,6), pw2); \
    VRD(3); SBAR(); GAPA(C0=__builtin_amdgcn_mfma_f32_32x32x16_bf16(kf[6],qr[3],C0,0,0,0),   P1[10],P1[11],P1[12],P1[13], pw3[0]=PKW(P1,8), pw3[1]=PKW(P1,10), pw3); \
    VRD(7); SBAR(); GAPA(C1=__builtin_amdgcn_mfma_f32_32x32x16_bf16(kf[7],qr[3],C1,0,0,0),   P1[14],P1[15],0.f,0.f,       pw3[2]=PKW(P1,12),pw3[3]=PKW(P1,14), pw3); \
    l_reg+=sacc; \
    if(GK){DMA_K((t)+3,sl_cur);} if(GV){DMA_V((t)+1,sl_next);} \
    CMASK(C0,C1,t); \
    { float a=MX3(C0[0],C0[1],C1[0]),b=MX3(C0[2],C0[3],C1[1]); a=MX3(a,C1[2],C1[3]); \
      _Pragma("unroll") for(int r=4;r<16;r+=4){a=MX3(a,C0[r],C0[r+1]);b=MX3(b,C0[r+2],C0[r+3]);a=MX3(a,C1[r],C1[r+1]);b=MX3(b,C1[r+2],C1[r+3]);} \
      float rm=__builtin_fmaxf(a,b); { auto rr=__builtin_amdgcn_permlane32_swap(__float_as_uint(rm),__float_as_uint(rm),false,false); rm=__builtin_fmaxf(__uint_as_float(rr[0]),__uint_as_float(rr[1])); } \
      resc=false; \
      if(__builtin_expect(__any(rm>(float)THRL),0)){ const float dl=__builtin_fmaxf(rm,0.f); mhat+=dl; \
        _Pragma("unroll") for(int r=0;r<16;++r){C0[r]-=dl;C1[r]-=dl;} \
        _Pragma("unroll") for(int r=0;r<16;++r)negm[r]=-mhat; asm volatile("":"+v"(negm)); \
        const float f=__builtin_amdgcn_exp2f(-dl); l_reg*=f; if(hi==0)wsf[r32]=f; resc=true; } } \
    SBAR(); \
    GAPB(o[0]=__builtin_amdgcn_mfma_f32_32x32x16_bf16(PAF(0),VFR(0),o[0],0,0,0), C0,0); \
    GAPB(o[1]=__builtin_amdgcn_mfma_f32_32x32x16_bf16(PAF(0),VFR(4),o[1],0,0,0), C0,4); \
    KRD(GL,0); GAPB(o[0]=__builtin_amdgcn_mfma_f32_32x32x16_bf16(PAF(1),VFR(1),o[0],0,0,0), C0,8); \
    KRD(GL,1); GAPB(o[1]=__builtin_amdgcn_mfma_f32_32x32x16_bf16(PAF(1),VFR(5),o[1],0,0,0), C0,12); \
    KRD(GL,2); GAPB(o[0]=__builtin_amdgcn_mfma_f32_32x32x16_bf16(PAF(2),VFR(2),o[0],0,0,0), C1,0); \
    KRD(GL,3); GAPB(o[1]=__builtin_amdgcn_mfma_f32_32x32x16_bf16(PAF(2),VFR(6),o[1],0,0,0), C1,4); \
    GAPB(o[0]=__builtin_amdgcn_mfma_f32_32x32x16_bf16(PAF(3),VFR(3),o[0],0,0,0), C1,8); \
    GAPB(o[1]=__builtin_amdgcn_mfma_f32_32x32x16_bf16(PAF(3),VFR(7),o[1],0,0,0), C1,12); \
    }while(0)
  int t=1;
  for(;t+5<NT;t+=2){
    STEP(pB0,pB1,pA0,pA1,t,true,true,true);     WAIT_BAR(2); RESC(); ROT();
    STEP(pA0,pA1,pB0,pB1,t+1,true,true,true);   WAIT_BAR(2); RESC(); ROT();
  }
  #define ENDW(tt) do{ if((tt)+3<NT){WAIT_BAR(2);} else if((tt)+2<NT){WAIT_BAR(1);} else {WAIT_BAR(0);} }while(0)
  for(;t+1<NT;t+=2){
    STEP(pB0,pB1,pA0,pA1,t,(t+3<NT),(t+1<NT),(t+1<NT));       ENDW(t);   RESC(); ROT();
    STEP(pA0,pA1,pB0,pB1,t+1,(t+4<NT),(t+2<NT),(t+2<NT));     ENDW(t+1); RESC(); ROT();
  }
  STEP(pB0,pB1,pA0,pA1,NT-1,false,false,false); RESC();
  { float sacc=pB0[0]+pB0[1]; _Pragma("unroll") for(int r=2;r<16;++r)sacc+=pB0[r]; _Pragma("unroll") for(int r=0;r<16;++r)sacc+=pB1[r]; l_reg+=sacc;
    pw0=(u32x4){PKW(pB0,0),PKW(pB0,2),PKW(pB0,4),PKW(pB0,6)};pw1=(u32x4){PKW(pB0,8),PKW(pB0,10),PKW(pB0,12),PKW(pB0,14)};pw2=(u32x4){PKW(pB1,0),PKW(pB1,2),PKW(pB1,4),PKW(pB1,6)};pw3=(u32x4){PKW(pB1,8),PKW(pB1,10),PKW(pB1,12),PKW(pB1,14)};
    SBAR(); pv(o,vb0+sl_cur,PAF(0),PAF(1),PAF(2),PAF(3)); }
  #undef PKW
  #undef PAF
  #undef VFR
  #undef PIN
  #undef MX3
  #undef GAPA
  #undef GAPB
  #undef EX
  #undef VRD
  #undef KRD
  #undef STEP
  #undef ENDW
  {auto rr=__builtin_amdgcn_permlane32_swap(__float_as_uint(l_reg),__float_as_uint(l_reg),false,false);l_reg=__uint_as_float(rr[0])+__uint_as_float(rr[1]);}
  if(WIN)l_reg+=__builtin_amdgcn_exp2f(sink_l2-mhat);
  if(hi==0)wsf[32+r32]=l_reg;asm volatile("s_waitcnt lgkmcnt(0)":::"memory");
  float rli[16];
  #pragma unroll
  for(int r=0;r<16;++r)rli[r]=__builtin_amdgcn_rcpf(wsf[32+crow(r,hi)]);
  bf16*Ow=Ob+(long)(q0+wid*QBLK)*OP;
  { bf16*stg=(bf16*)(shm+LDS_OST)+wid*2048;
    #pragma unroll
    for(int r=0;r<16;++r){const int orow=crow(r,hi);
      #pragma unroll
      for(int d0=0;d0<2;++d0)stg[orow*64+d0*32+r32]=__float2bfloat16(o[d0][r]*rli[r]);}
    asm volatile("s_waitcnt lgkmcnt(0)":::"memory");
    #pragma unroll
    for(int i=0;i<4;++i){const int row=i*8+(lane>>3),ch=lane&7; const u32x4 v=*(const u32x4*)(stg+row*64+ch*8); ATTN_STORE16(Ow+(long)row*OP+ch*8,v);} }
  asm volatile("s_waitcnt lgkmcnt(0)\n\ts_barrier":::"memory");
  #undef TM
  #undef DMA_K
  #undef DMA_V
  #undef CMASK
  #undef START
  #undef RESC
  #undef ROT
}
constexpr int ATTN_LDS_BYTES=LDS_BYTES;
#undef SBAR
#undef WAIT_BAR
}
#define XB_TMO      128
#define XB_XCNT(j)  (256  + 64 * (j))
#define XB_XSUB(j)  (1280 + 64 * (j))
#define XB_XGEN(j)  (2304 + 64 * (j))
#define XB_TOP      3328
#define XB_TOPGEN   3392
#define XCD_BAR_WORDS 3456
#define XB_SPIN_CAP (1u << 21)

__device__ __forceinline__ unsigned xb_ld(unsigned* p)              { return __hip_atomic_load(p, __ATOMIC_RELAXED, __HIP_MEMORY_SCOPE_AGENT); }
__device__ __forceinline__ unsigned xb_add(unsigned* p, unsigned v) { return __hip_atomic_fetch_add(p, v, __ATOMIC_RELAXED, __HIP_MEMORY_SCOPE_AGENT); }
__device__ __forceinline__ unsigned xb_xcc_id() { return (unsigned)__builtin_amdgcn_s_getreg((3 << 11) | 20) & 0xFu; }
#define XB_SPIN(cond, bar) do { unsigned _sp = 0; while (cond) { __builtin_amdgcn_s_sleep(1); \
    if ((++_sp & 255u) == 0u) { if (xb_ld(&(bar)[XB_TMO])) break; if (_sp > XB_SPIN_CAP) { atomicAdd(&(bar)[XB_TMO], 1u); break; } } } } while (0)

struct XcdBarrier {
    unsigned* bar; unsigned x;
    volatile LAS unsigned* st;
};

__device__ __forceinline__ XcdBarrier xcd_barrier_post(unsigned* bar, volatile LAS unsigned* st) {
    XcdBarrier b; b.bar = bar; b.x = xb_xcc_id(); b.st = st;
    if (threadIdx.x == 0) (void)xb_add(&bar[XB_XCNT(b.x)], 1u);
    return b;
}
__device__ __forceinline__ void xcd_barrier_complete(unsigned* bar, unsigned x, unsigned& nloc, unsigned& nx) {
    const unsigned G = gridDim.x * gridDim.y * gridDim.z;
    unsigned sum, cnt, mine, sp = 0u;
    for (;;) {
        sum = 0u; cnt = 0u; mine = 0u;
#pragma unroll
        for (unsigned j = 0; j < 16; ++j) { const unsigned c = xb_ld(&bar[XB_XCNT(j)]); sum += c; cnt += (c > 0u) ? 1u : 0u; mine = (j == x) ? c : mine; }
        if (sum == G) break;
        __builtin_amdgcn_s_sleep(1);
        if ((++sp & 255u) == 0u) { if (xb_ld(&bar[XB_TMO])) break; if (sp > XB_SPIN_CAP) { atomicAdd(&bar[XB_TMO], 1u); break; } }
    }
    nloc = mine > 0u ? mine : 1u; nx = cnt > 0u ? cnt : 1u;
}

__device__ __forceinline__ void xcd_barrier(const XcdBarrier& b) {
    asm volatile("s_waitcnt vmcnt(0)" ::: "memory");
    __syncthreads();
    if (threadIdx.x == 0) {
        unsigned* bar = b.bar; unsigned bx_ = b.x; asm volatile("" : "+s"(bar), "+s"(bx_));
        __builtin_amdgcn_s_waitcnt(0);
        unsigned nloc = b.st[0], nx = b.st[1];
        if (nloc == 0u) { xcd_barrier_complete(bar, bx_, nloc, nx); b.st[0] = nloc; b.st[1] = nx; }
        const unsigned old = xb_add(&bar[XB_XSUB(bx_)], 1u);
        const unsigned gen = old / nloc;
        if (old + 1u == (gen + 1u) * nloc) {
            __builtin_amdgcn_fence(__ATOMIC_RELEASE, "agent");
            asm volatile("s_waitcnt vmcnt(0)" ::: "memory");
            const unsigned og = xb_add(&bar[XB_TOP], 1u);
            const unsigned tg = og / nx;
            if (og + 1u == (tg + 1u) * nx) xb_add(&bar[XB_TOPGEN], 1u);
            else XB_SPIN(xb_ld(&bar[XB_TOPGEN]) == tg, bar);
            __builtin_amdgcn_fence(__ATOMIC_ACQUIRE, "agent");
            xb_add(&bar[XB_XGEN(bx_)], 1u);
            asm volatile("s_waitcnt vmcnt(0)" ::: "memory");
        } else {
            XB_SPIN(xb_ld(&bar[XB_XGEN(bx_)]) == gen, bar);
            __builtin_amdgcn_fence(__ATOMIC_ACQUIRE, "agent");
            asm volatile("s_waitcnt vmcnt(0)" ::: "memory");
        }
    }
    __syncthreads();
}

constexpr size_t alup(size_t x) { return (x + 4095) & ~(size_t)4095; }
constexpr size_t CTL_BYTES = 1u << 20;
constexpr size_t SZ_WIN = (size_t)DEPTH * DIN * DM * 2, SZ_WOUT = (size_t)DEPTH * DM * DM * 2, SZ_WGU = (size_t)DEPTH * NE * 2 * FF * DM  , SZ_WDN = (size_t)DEPTH * NE * DM * FF  ;
constexpr size_t SZ_MODP = (size_t)DEPTH * 16 * 17 * 6144 * 4, SZ_MOD = (size_t)DEPTH * 17 * 6144 * 4;
constexpr size_t SZ_X32 = (size_t)MROWS * DM * 2  , SZ_H = (size_t)MROWS * DM * 2, SZ_P = (size_t)MROWS * DIN * 2, SZ_Y = (size_t)MROWS * DM * 2, SZ_YP = (size_t)MROWS * 2 * DM  ;
constexpr size_t SZ_LIST = (size_t)NE * MROWS * 4, SZ_GW = (size_t)MROWS * 2 * 4;
constexpr int MAXBLK = (MROWS * 2) / 256 + NE;
static_assert((size_t)MAXBLK * 256 * FF * 2 <= SZ_P, "HMID overlays P");
static_assert((size_t)2 * NB * 4 * NCH * 128 * 64 * 4 <= SZ_H, "KVT overlays H");
static_assert((size_t)2 * NB * 4 * NCH * 128 * 64 * 2 <= SZ_YP, "ST overlays YP");
constexpr size_t WS_CTL = 0;
constexpr size_t WS_WIN = CTL_BYTES, WS_WOUT = WS_WIN + alup(SZ_WIN), WS_WGU = WS_WOUT + alup(SZ_WOUT), WS_WDN = WS_WGU + alup(SZ_WGU);
constexpr size_t WS_MODP = WS_WDN + alup(SZ_WDN), WS_MOD = WS_MODP + alup(SZ_MODP);
constexpr size_t WS_X32 = WS_MOD + alup(SZ_MOD), WS_H = WS_X32 + alup(SZ_X32), WS_P = WS_H + alup(SZ_H), WS_Y = WS_P + alup(SZ_P), WS_YP = WS_Y + alup(SZ_Y);
constexpr size_t WS_LIST = WS_YP + alup(SZ_YP), WS_GW = WS_LIST + alup(SZ_LIST), WS_END = WS_GW + alup(SZ_GW);
constexpr int CW_BAR = 4096;
constexpr int CW_CNT = 16384;

constexpr int RING_BYTES = 131072;
constexpr int LDSCTL_OFF = RING_BYTES;
constexpr int LDS_BYTES = 147456;

#define ATTN_STORE16(p,v) (*(u32x4*)(p)=(v))

#define CAS __attribute__((address_space(4)))
__device__ __forceinline__ const float* inp(int i) {
    const CAS unsigned char* k = (const CAS unsigned char*)__builtin_amdgcn_kernarg_segment_ptr();
    asm volatile("" : "+s"(k));
    return *(const float* const CAS*)(k + 8 * i);
}
#define CBAR() do { asm volatile("" ::: "memory"); __builtin_amdgcn_sched_barrier(0); } while (0)
struct Ctx {
    float* out; unsigned char* ws;
    __device__ __forceinline__ const float* x() const { return inp(0); }
    __device__ __forceinline__ const float* c() const { return inp(1); }
    __device__ __forceinline__ const float* ctx() const { return inp(2); }
    __device__ __forceinline__ const float* c_ctx() const { return inp(3); }
    __device__ __forceinline__ const float* ada_w() const { return inp(4); }
    __device__ __forceinline__ const float* ada_b() const { return inp(5); }
    __device__ __forceinline__ const float* norm1() const { return inp(6); }
    __device__ __forceinline__ const float* norm2() const { return inp(7); }
    __device__ __forceinline__ const float* w_in() const { return inp(8); }
    __device__ __forceinline__ const float* w_out() const { return inp(9); }
    __device__ __forceinline__ const float* ret_decay() const { return inp(10); }
    __device__ __forceinline__ const float* win_gain() const { return inp(11); }
    __device__ __forceinline__ const float* win_sink() const { return inp(12); }
    __device__ __forceinline__ const float* glb_gain() const { return inp(13); }
    __device__ __forceinline__ const float* w_router() const { return inp(14); }
    __device__ __forceinline__ const float* b_router() const { return inp(15); }
    __device__ __forceinline__ const float* w_gu() const { return inp(16); }
    __device__ __forceinline__ const float* w_dn() const { return inp(17); }
};

template <int CTRL> __device__ __forceinline__ float dppx(float v) { return __builtin_bit_cast(float, __builtin_amdgcn_update_dpp(0, __builtin_bit_cast(int, v), CTRL, 0xF, 0xF, true)); }
__device__ __forceinline__ float xor1(float v) { return dppx<0xB1>(v); }
__device__ __forceinline__ float xor2(float v) { return dppx<0x4E>(v); }
__device__ __forceinline__ float wave_sum(float v) {
    v += dppx<0xB1>(v); v += dppx<0x4E>(v); v += dppx<0x141>(v); v += dppx<0x140>(v);
    { const unsigned u = __builtin_bit_cast(unsigned, v); auto r = __builtin_amdgcn_permlane16_swap(u, u, false, false); v = __builtin_bit_cast(float, (unsigned)r[0]) + __builtin_bit_cast(float, (unsigned)r[1]); }
    { const unsigned u = __builtin_bit_cast(unsigned, v); auto r = __builtin_amdgcn_permlane32_swap(u, u, false, false); v = __builtin_bit_cast(float, (unsigned)r[0]) + __builtin_bit_cast(float, (unsigned)r[1]); }
    return v;
}
__device__ __forceinline__ float xor16(float v, int lane) { const unsigned u = __builtin_bit_cast(unsigned, v); auto r = __builtin_amdgcn_permlane16_swap(u, u, false, false);
    return __builtin_bit_cast(float, (lane & 16) ? (unsigned)r[0] : (unsigned)r[1]); }
__device__ __forceinline__ float silu_f(float v) { return v * __builtin_amdgcn_rcpf(1.f + __builtin_amdgcn_exp2f(-LOG2E * v)); }
__device__ __forceinline__ float log2_sigmoid(float x) { return -log1pf(expf(-x)) * LOG2E; }

__device__ __forceinline__ void transpose_item(const float* W, int N, int nsrc0, int k0, bf16_t* WT, int K, int nrow0, LAS float* scr, int lane) {
#pragma unroll 8
    for (int i = 0; i < 32; ++i) { const int kk = 2 * i + (lane >> 5); scr[kk * 33 + (lane & 31)] = W[(size_t)(k0 + kk) * N + nsrc0 + (lane & 31)]; }
    asm volatile("s_waitcnt lgkmcnt(0)" ::: "memory");
    const int c = lane & 7;
#pragma unroll
    for (int j = 0; j < 4; ++j) { const int n = (lane >> 3) + 8 * j; const LAS float* s = scr + (8 * c) * 33 + n;
        u32x4 o; o.x = pk2(s[0 * 33], s[1 * 33]); o.y = pk2(s[2 * 33], s[3 * 33]); o.z = pk2(s[4 * 33], s[5 * 33]); o.w = pk2(s[6 * 33], s[7 * 33]);
        *(u32x4*)(WT + (size_t)(nrow0 + n) * K + k0 + 8 * c) = o; }
    asm volatile("s_waitcnt lgkmcnt(0)" ::: "memory");
}
__device__ __forceinline__ unsigned pk4_fp8(float a, float b, float c, float d) { int w = 0; w = __builtin_amdgcn_cvt_pk_fp8_f32(a, b, w, false); w = __builtin_amdgcn_cvt_pk_fp8_f32(c, d, w, true); return (unsigned)w; }
__device__ __forceinline__ f32x4 fp8x4_f32(unsigned w) { typedef float f2_ __attribute__((ext_vector_type(2))); const f2_ lo = __builtin_amdgcn_cvt_pk_f32_fp8((int)w, false), hi = __builtin_amdgcn_cvt_pk_f32_fp8((int)w, true); return (f32x4){lo[0], lo[1], hi[0], hi[1]}; }
constexpr float YP_SCALE = 16.0f, YP_INV = 1.0f / 16.0f;
constexpr float W8_SCALE = 64.0f, W8_INV = 1.0f / 64.0f;
__device__ __forceinline__ void transpose_item8(const float* W, int N, int nsrc0, int k0, unsigned char* WT, int K, int nrow0, LAS float* scr, int lane) {
#pragma unroll 8
    for (int i = 0; i < 32; ++i) { const int kk = 2 * i + (lane >> 5); scr[kk * 33 + (lane & 31)] = W[(size_t)(k0 + kk) * N + nsrc0 + (lane & 31)]; }
    asm volatile("s_waitcnt lgkmcnt(0)" ::: "memory");
    const int c = lane & 7;
#pragma unroll
    for (int j = 0; j < 4; ++j) { const int n = (lane >> 3) + 8 * j; const LAS float* s = scr + (8 * c) * 33 + n;
        u32x2 o; o.x = pk4_fp8(s[0 * 33] * W8_SCALE, s[1 * 33] * W8_SCALE, s[2 * 33] * W8_SCALE, s[3 * 33] * W8_SCALE); o.y = pk4_fp8(s[4 * 33] * W8_SCALE, s[5 * 33] * W8_SCALE, s[6 * 33] * W8_SCALE, s[7 * 33] * W8_SCALE);
        *(u32x2*)(WT + (size_t)(nrow0 + n) * K + k0 + 8 * c) = o; }
    asm volatile("s_waitcnt lgkmcnt(0)" ::: "memory");
}
constexpr int IT_WIN = 16 * 80, IT_WOUT = 16 * 32, IT_GU = 16 * 64, IT_DN = 16 * 32, IT_LAYER = IT_WIN + IT_WOUT + NE * (IT_GU + IT_DN);
__device__ __forceinline__ void phase_prologue(const Ctx& C, LAS unsigned char* lds, int G, int vcu, int bx, int tid) {
    const int lane = tid & 63, wave = tid >> 6;
    {
        LAS float* scs = (LAS float*)lds;
        bool have = false;
        for (int it = bx; it < DEPTH * 12 * 16; it += G) {
            if (!have) {
                for (int i = tid; i < 17 * DM; i += 512) { const int r = i >> 10, k = i & 1023; const float v = r < 16 ? C.c()[r * DM + k] : C.c_ctx()[k]; scs[i] = v / (1.f + expf(-v)); }
                __syncthreads(); have = true;
            }
            const int l = it / 192, rem = it % 192, cb = rem / 16, kc = rem % 16;
            const float* w = C.ada_w() + ((size_t)l * DM + kc * 64) * 6144 + cb * 512 + tid;
            float acc[17];
#pragma unroll
            for (int r = 0; r < 17; ++r) acc[r] = 0.f;
#pragma unroll 4
            for (int kk = 0; kk < 64; ++kk) { const float wv = w[(size_t)kk * 6144];
#pragma unroll
                for (int r = 0; r < 17; ++r) acc[r] += scs[r * DM + kc * 64 + kk] * wv; }
            float* mp = (float*)(C.ws + WS_MODP) + ((size_t)(l * 16 + kc) * 17) * 6144 + cb * 512 + tid;
#pragma unroll
            for (int r = 0; r < 17; ++r) mp[(size_t)r * 6144] = acc[r];
        }
        __syncthreads();
    }
    LAS float* scr = (LAS float*)(lds + wave * 16384);
    const int gw = vcu * 8 + wave, NGW = G * 8;
    for (int it = gw; it < DEPTH * IT_LAYER; it += NGW) {
        const int l = it / IT_LAYER; int r = it % IT_LAYER;
        if (r < IT_WIN) { const int kb = r / 80, nb = r % 80;
            transpose_item(C.w_in() + (size_t)l * DM * DIN, DIN, 32 * nb, 64 * kb, (bf16_t*)(C.ws + WS_WIN) + (size_t)l * DIN * DM, DM, 32 * nb, scr, lane); continue; }
        r -= IT_WIN;
        if (r < IT_WOUT) { const int kb = r / 32, nb = r % 32;
            transpose_item(C.w_out() + (size_t)l * DM * DM, DM, 32 * nb, 64 * kb, (bf16_t*)(C.ws + WS_WOUT) + (size_t)l * DM * DM, DM, 32 * nb, scr, lane); continue; }
        r -= IT_WOUT;
        if (r < NE * IT_GU) { const int e = r / IT_GU, q = r % IT_GU, kb = q / 64, nb = q % 64;
            const int np = 32 * nb, tile = np >> 8, within = np & 255, nsrc = within < 128 ? tile * 128 + within : FF + tile * 128 + within - 128;
            transpose_item8(C.w_gu() + (size_t)(l * NE + e) * DM * 2 * FF, 2 * FF, nsrc, 64 * kb, (unsigned char*)(C.ws + WS_WGU) + (size_t)(l * NE + e) * 2 * FF * DM, DM, np, scr, lane); continue; }
        r -= NE * IT_GU;
        { const int e = r / IT_DN, q = r % IT_DN, kb = q / 32, nb = q % 32;
            transpose_item8(C.w_dn() + (size_t)(l * NE + e) * FF * DM, DM, 32 * nb, 64 * kb, (unsigned char*)(C.ws + WS_WDN) + (size_t)(l * NE + e) * DM * FF, FF, 32 * nb, scr, lane); }
    }
}
__device__ __forceinline__ void phase_modsum(const Ctx& C, int G, int bx, int tid) {
    const float* mp = (const float*)(C.ws + WS_MODP); float* mod = (float*)(C.ws + WS_MOD);
    for (int i = bx * 512 + tid; i < DEPTH * 17 * 6144; i += G * 512) {
        const int l = i / (17 * 6144), rem = i % (17 * 6144), r = rem / 6144, n = rem % 6144;
        float s = C.ada_b()[l * 6144 + n];
#pragma unroll
        for (int kc = 0; kc < 16; ++kc) s += mp[((size_t)(l * 16 + kc) * 17 + r) * 6144 + n];
        mod[i] = s;
    }
}

__device__ __forceinline__ f32x4 bf4(u32x2 a) { return (f32x4){bflo(a.x), bfhi(a.x), bflo(a.y), bfhi(a.y)}; }
__device__ __forceinline__ u32x2 pk4(f32x4 v) { u32x2 w; w.x = pk2(v[0], v[1]); w.y = pk2(v[2], v[3]); return w; }
__device__ __forceinline__ void phase_norm1(const Ctx& C, int layer, int gw, int NGW, int lane, bf16_t* XO) {
    const float* mod = (const float*)(C.ws + WS_MOD) + (size_t)layer * 17 * 6144;
    const float* gain = C.norm1() + layer * DM;
    bf16_t* XR = (bf16_t*)(C.ws + WS_X32); bf16_t* H = (bf16_t*)(C.ws + WS_H); const unsigned char* YP = (const unsigned char*)(C.ws + WS_YP);
    const float* xin = C.x(); const float* cin = C.ctx();
    f32x4 nx[4]; u32x2 nr[4]; unsigned na[4], nb[4];
#define N1_LOAD(mm) do { const int b_ = (mm) / TPB, t_ = (mm) - b_ * TPB; \
        if (layer == 0) { const f32x4* s_ = (const f32x4*)(t_ < CTX ? cin + ((size_t)b_ * CTX + t_) * DM : xin + ((size_t)b_ * SEQ + (t_ - CTX)) * DM) + lane; \
            _Pragma("unroll") for (int j = 0; j < 4; ++j) nx[j] = s_[64 * j]; } \
        else { const u32x2* s_ = (const u32x2*)(XR + (size_t)(mm) * DM) + lane; const unsigned* y0_ = (const unsigned*)(YP + (size_t)(mm) * 2 * DM) + lane; \
            _Pragma("unroll") for (int j = 0; j < 4; ++j) { nr[j] = s_[64 * j]; na[j] = y0_[64 * j]; nb[j] = y0_[DM / 4 + 64 * j]; } } } while (0)
    if (gw < MROWS) N1_LOAD(gw);
    for (int m = gw; m < MROWS; m += NGW) {
        const int b = m / TPB, t = m - b * TPB, set = t < CTX ? 16 : b;
        f32x4 v[4];
        if (layer == 0) {
#pragma unroll
            for (int j = 0; j < 4; ++j) v[j] = nx[j];
        } else {
            const f32x4* g2 = (const f32x4*)(mod - 17 * 6144 + (size_t)set * 6144 + 5 * DM) + lane;
#pragma unroll
            for (int j = 0; j < 4; ++j) v[j] = bf4(nr[j]) + (g2[64 * j] * YP_INV) * (fp8x4_f32(na[j]) + fp8x4_f32(nb[j]));
        }
        if (m + NGW < MROWS) N1_LOAD(m + NGW);
        u32x2* xo = (u32x2*)(XO + (size_t)m * DM) + lane;
        float ss = 0.f;
#pragma unroll
        for (int j = 0; j < 4; ++j) { xo[64 * j] = pk4(v[j]); ss += (v[j][0] * v[j][0] + v[j][1] * v[j][1]) + (v[j][2] * v[j][2] + v[j][3] * v[j][3]); }
        const float rstd = 1.0f / sqrtf(wave_sum(ss) * (1.f / DM) + EPS);
        const f32x4* gp = (const f32x4*)gain + lane; const f32x4* shp = (const f32x4*)(mod + (size_t)set * 6144) + lane; const f32x4* scp = shp + DM / 4;
        u32x2* ho = (u32x2*)(H + (size_t)m * DM) + lane;
#pragma unroll
        for (int j = 0; j < 4; ++j) ho[64 * j] = pk4((v[j] * rstd) * gp[64 * j] * (scp[64 * j] + 1.0f) + shp[64 * j]);
    }
#undef N1_LOAD
}

__device__ __forceinline__ float swz_xor4(float v) { return __builtin_bit_cast(float, __builtin_amdgcn_ds_swizzle(__builtin_bit_cast(int, v), 0x101F)); }
__device__ __forceinline__ float swz_xor8(float v) { return __builtin_bit_cast(float, __builtin_amdgcn_ds_swizzle(__builtin_bit_cast(int, v), 0x201F)); }
__device__ __forceinline__ void phase_qkprep(const Ctx& C, int layer, int gw, int NGW, int lane, bf16_t* PO) {
    const bf16_t* P = (const bf16_t*)(C.ws + WS_P);
    const int hs = lane >> 3, j = lane & 7;
    const int col0 = (hs < 4 ? C_WQ + 64 * hs : hs < 6 ? C_WK + 64 * (hs - 4) : C_GQ + 64 * (hs - 6)) + 8 * j;
    const int col1 = (hs < 2 ? C_GQ + 128 + 64 * hs : C_GK + 64 * ((hs - 2) & 1)) + 8 * j;
    float g0[8], g1[8], inv[8];
    { const float* wg = C.win_gain() + layer * 128; const float* gg = C.glb_gain() + layer * 128;
      const float* s0p = hs < 4 ? wg : hs < 6 ? wg + 64 : gg; const float sc0 = (hs < 4 || hs >= 6) ? QSCALE : 1.f;
      const float* s1p = hs < 2 ? gg : gg + 64; const float sc1 = hs < 2 ? QSCALE : 1.f;
#pragma unroll
      for (int i = 0; i < 8; ++i) { g0[i] = s0p[8 * j + i] * sc0; g1[i] = s1p[8 * j + i] * sc1; inv[i] = exp2f(-(float)(8 * (j & 1) + i) * (13.287712379549449f / 16.0f)); } }
    const bool x2 = (j & 2) != 0, colax = (j & 4) != 0, act1 = lane < 32;
    u32x4 w0 = {0u, 0u, 0u, 0u}, w1 = {0u, 0u, 0u, 0u};
    if (gw < MROWS) { const bf16_t* row = P + (size_t)gw * DIN; w0 = *(const u32x4*)(row + col0); if (act1) w1 = *(const u32x4*)(row + col1); }
    for (int m = gw; m < MROWS; m += NGW) {
        const u32x4 c0 = w0, c1 = w1;
        if (m + NGW < MROWS) { const bf16_t* row = P + (size_t)(m + NGW) * DIN; w0 = *(const u32x4*)(row + col0); if (act1) w1 = *(const u32x4*)(row + col1); }
        const int b = m / TPB, t = m - b * TPB; const bool isx = t >= CTX; const int pos = t - CTX;
        float cs[8], sn[8];
        if (isx) { const float pv = (float)(colax ? (pos & 63) : (pos >> 6));
#pragma unroll
            for (int i = 0; i < 8; ++i) { const float ang = pv * inv[i]; cs[i] = __cosf(ang); sn[i] = x2 ? __sinf(ang) : -__sinf(ang); } }
        else {
#pragma unroll
            for (int i = 0; i < 8; ++i) { cs[i] = 1.f; sn[i] = 0.f; } }
        bf16_t* orow = PO + (size_t)m * (PO == P ? DIN : 256);
#pragma unroll
        for (int pass = 0; pass < 2; ++pass) {
            const u32x4 w = pass ? c1 : c0;
            float x[8] = {bflo(w.x), bfhi(w.x), bflo(w.y), bfhi(w.y), bflo(w.z), bfhi(w.z), bflo(w.w), bfhi(w.w)};
            float ss = 0.f;
#pragma unroll
            for (int i = 0; i < 8; ++i) ss += x[i] * x[i];
            ss += xor1(ss); ss += xor2(ss); ss += swz_xor4(ss);
            const float r = 1.0f / sqrtf(ss * (1.f / 64.f) + EPS);
            float y[8];
#pragma unroll
            for (int i = 0; i < 8; ++i) { x[i] = x[i] * r * (pass ? g1[i] : g0[i]); }
#pragma unroll
            for (int i = 0; i < 8; ++i) { const float pr = xor2(x[i]); y[i] = x[i] * cs[i] + pr * sn[i]; }
            u32x4 o; o.x = pk2(y[0], y[1]); o.y = pk2(y[2], y[3]); o.z = pk2(y[4], y[5]); o.w = pk2(y[6], y[7]);
            const int col = pass ? col1 : col0;
            if (pass == 0 || act1) *(u32x4*)(orow + (PO == P ? col : (col & 127))) = o;
        }
    }
}

__device__ __forceinline__ unsigned off_v(unsigned row, unsigned ch) { return 256u * row + 16u * (ch ^ (((row & 3) << 2) | ((row >> 2) & 3))); }
__device__ __forceinline__ unsigned off_k(unsigned row, unsigned ch) { return 128u * row + 16u * (ch ^ (row & 7)); }
typedef short s16x4_t __attribute__((ext_vector_type(4)));
__device__ __forceinline__ s16x4_t tr_rd(const LAS unsigned char* p) { return __builtin_bit_cast(s16x4_t, __builtin_amdgcn_ds_read_tr16_b64_v4i16((LAS s16x4_t*)p)); }
template <bool KIMG> __device__ __forceinline__ bf16x8 tr_frag(const LAS unsigned char* img, int lane, int rbase, int r0off, int r1off, int cblk) {
    const unsigned blk = (lane >> 4) & 1, q = (lane & 15) >> 2, pp = lane & 3, ch = 4 * cblk + 2 * blk + (pp >> 1);
    const unsigned ra = rbase + r0off + q, rb = rbase + r1off + q;
    const s16x4_t lo = tr_rd(img + (KIMG ? off_k(ra, ch) : off_v(ra, ch)) + 8 * (pp & 1)), hi = tr_rd(img + (KIMG ? off_k(rb, ch) : off_v(rb, ch)) + 8 * (pp & 1));
    return (bf16x8){lo[0], lo[1], lo[2], lo[3], hi[0], hi[1], hi[2], hi[3]};
}
__device__ __forceinline__ void stage_v(const bf16_t* P, size_t r0, int h, LAS unsigned char* img, int tid) {
#pragma unroll
    for (int i = 0; i < 4; ++i) { const int p_ = tid + 512 * i, j = p_ >> 4, ch = p_ & 15;
        *(LAS u32x4*)(img + off_v(j, ch)) = *(const u32x4*)(P + (r0 + j) * DIN + C_RV + h * 128 + 8 * ch); }
}
__device__ __forceinline__ void ret_r1_unit(const Ctx& C, int layer, int b, int h, int c, LAS unsigned char* lds, int tid) {
    const int lane = tid & 63, wid = tid >> 6;
    const bf16_t* P = (const bf16_t*)(C.ws + WS_P); float* KVT = (float*)(C.ws + WS_H);
    LAS unsigned char* Vi = lds; LAS unsigned char* Kf = lds + 32768; LAS unsigned char* Kb = lds + 49152;
    const float* dec = C.ret_decay(); const float lf = log2_sigmoid(dec[(layer * 2 + 0) * 4 + h]), lb = log2_sigmoid(dec[(layer * 2 + 1) * 4 + h]);
    const size_t r0 = (size_t)b * TPB + c * 128;
#pragma unroll
    for (int i = 0; i < 2; ++i) { const int p_ = tid + 512 * i, j = p_ >> 3, ch = p_ & 7;
        const u32x4 w = *(const u32x4*)(P + (r0 + j) * DIN + C_RK + h * 64 + 8 * ch);
        const float zf = exp2f((float)(127 - j) * lf) * 0.125f, zb = exp2f((float)j * lb) * 0.125f;
        const float x[8] = {bflo(w.x), bfhi(w.x), bflo(w.y), bfhi(w.y), bflo(w.z), bfhi(w.z), bflo(w.w), bfhi(w.w)};
        u32x4 of, ob; of.x = pk2(x[0] * zf, x[1] * zf); of.y = pk2(x[2] * zf, x[3] * zf); of.z = pk2(x[4] * zf, x[5] * zf); of.w = pk2(x[6] * zf, x[7] * zf);
        ob.x = pk2(x[0] * zb, x[1] * zb); ob.y = pk2(x[2] * zb, x[3] * zb); ob.z = pk2(x[4] * zb, x[5] * zb); ob.w = pk2(x[6] * zb, x[7] * zb);
        *(LAS u32x4*)(Kf + off_k(j, ch)) = of; *(LAS u32x4*)(Kb + off_k(j, ch)) = ob; }
    stage_v(P, r0, h, Vi, tid);
    __syncthreads();
    const int mb = wid >> 1, nb = wid & 1, r = lane & 31, hh = lane >> 5;
    float z0 = 0.f; asm volatile("" : "+v"(z0)); f32x16 af, ab;
#pragma unroll
    for (int i = 0; i < 16; ++i) { af[i] = z0; ab[i] = z0; }
#pragma unroll
    for (int ks = 0; ks < 8; ++ks) {
        const bf16x8 a = tr_frag<false>(Vi, lane, 16 * ks + 8 * hh, 0, 4, mb);
        const bf16x8 bf = tr_frag<true>(Kf, lane, 16 * ks + 8 * hh, 0, 4, nb);
        const bf16x8 bb = tr_frag<true>(Kb, lane, 16 * ks + 8 * hh, 0, 4, nb);
        af = __builtin_amdgcn_mfma_f32_32x32x16_bf16(a, bf, af, 0, 0, 0);
        ab = __builtin_amdgcn_mfma_f32_32x32x16_bf16(a, bb, ab, 0, 0, 0);
    }
    float* of = KVT + ((size_t)((0 * NB + b) * 4 + h) * NCH + c) * 8192; float* ob = KVT + ((size_t)((1 * NB + b) * 4 + h) * NCH + c) * 8192;
#pragma unroll
    for (int reg = 0; reg < 16; ++reg) { const int dv = 32 * mb + (reg & 3) + 8 * (reg >> 2) + 4 * hh, dk = 32 * nb + r; of[dv * 64 + dk] = af[reg]; ob[dv * 64 + dk] = ab[reg]; }
    __syncthreads();
}
__device__ __forceinline__ void ret_r2_unit(const Ctx& C, int layer, int u, int tid) {
    const int q = u & 3, bh = (u >> 2) & 63, dir = u >> 8, b = bh >> 2, h = bh & 3;
    const float G = exp2f(128.f * log2_sigmoid(C.ret_decay()[(layer * 2 + dir) * 4 + h]));
    const size_t base = ((size_t)((dir * NB + b) * 4 + h) * NCH) * 8192 + q * 2048 + tid * 4;
    const float* KVT = (const float*)(C.ws + WS_H) + base; bf16_t* ST = (bf16_t*)(C.ws + WS_YP) + base;
    float z0 = 0.f; asm volatile("" : "+v"(z0)); f32x4 S = {z0, z0, z0, z0};
#pragma unroll
    for (int half = 0; half < 2; ++half) {
        f32x4 kv[17];
#pragma unroll
        for (int s = 0; s < 17; ++s) { const int step = half * 17 + s; const int c = dir == 0 ? step : (step < 2 ? 1 - step : 35 - step); kv[s] = *(const f32x4*)(KVT + (size_t)c * 8192); }
#pragma unroll
        for (int s = 0; s < 17; ++s) { const int step = half * 17 + s; const int c = dir == 0 ? step : (step < 2 ? 1 - step : 35 - step);
            u32x2 w; w.x = pk2(S[0], S[1]); w.y = pk2(S[2], S[3]); *(u32x2*)(ST + (size_t)c * 8192) = w;
            S = S * G + kv[s]; }
    }
}
__device__ __forceinline__ void ret_r3_unit(const Ctx& C, int layer, int b, int h, int c, LAS unsigned char* lds, int tid) {
    int lane = tid & 63; asm volatile("" : "+v"(lane));
    const int wid = tid >> 6, r = lane & 31, hh = lane >> 5, ib = wid & 3, dh = wid >> 2;
    const bf16_t* P = (const bf16_t*)(C.ws + WS_P);
    LAS unsigned char* Vi = lds;
    LAS float* Ol = (LAS float*)(lds + 32768);
    const float* dec = C.ret_decay(); const float lf = log2_sigmoid(dec[(layer * 2 + 0) * 4 + h]), lb = log2_sigmoid(dec[(layer * 2 + 1) * 4 + h]);
    const size_t r0 = (size_t)b * TPB + c * 128;
    stage_v(P, r0, h, Vi, tid);
#define R3_ZERO(v) do { float z_ = 0.f; asm volatile("" : "+v"(z_)); _Pragma("unroll") for (int i_ = 0; i_ < 16; ++i_) v[i_] = z_; } while (0)
    bf16x8 qf[4];
    { const bf16_t* Qp = P + (r0 + 32 * ib + r) * DIN + C_RQ + h * 64 + 8 * hh;
#pragma unroll
      for (int ks = 0; ks < 4; ++ks) qf[ks] = *(const bf16x8*)(Qp + 16 * ks); }
    bf16x8 kf[4][4]; u32x4 gwv[4];
#pragma unroll
    for (int jb = 0; jb < 2; ++jb) { const bf16_t* Kp = P + (r0 + 32 * jb + r) * DIN + C_RK + h * 64 + 8 * hh;
#pragma unroll
        for (int ks = 0; ks < 4; ++ks) kf[jb][ks] = *(const bf16x8*)(Kp + 16 * ks); }
    { const bf16_t* gp = P + (r0 + (tid >> 2)) * DIN + C_RG + h * 128 + 32 * (tid & 3);
#pragma unroll
      for (int e2 = 0; e2 < 4; ++e2) gwv[e2] = *(const u32x4*)(gp + 8 * e2); }
    f32x16 o[2]; R3_ZERO(o[0]); R3_ZERO(o[1]);
#pragma unroll
    for (int dir = 0; dir < 2; ++dir) {
        const bf16_t* sp = (const bf16_t*)(C.ws + WS_YP) + ((size_t)((dir * NB + b) * 4 + h) * NCH + c) * 8192 + (64 * dh + r) * 64 + 8 * hh;
        f32x16 acc[2];
#pragma unroll
        for (int t = 0; t < 2; ++t) { R3_ZERO(acc[t]);
#pragma unroll
            for (int ks = 0; ks < 4; ++ks) acc[t] = __builtin_amdgcn_mfma_f32_32x32x16_bf16(qf[ks], *(const bf16x8*)(sp + t * 32 * 64 + 16 * ks), acc[t], 0, 0, 0); }
#pragma unroll
        for (int reg = 0; reg < 16; ++reg) { const int i = 32 * ib + (reg & 3) + 8 * (reg >> 2) + 4 * hh; const float xi = dir == 0 ? __builtin_amdgcn_exp2f((float)(i + 1) * lf) : __builtin_amdgcn_exp2f((float)(128 - i) * lb);
            o[0][reg] += xi * acc[0][reg]; o[1][reg] += xi * acc[1][reg]; }
        CBAR();
    }
#pragma unroll
    for (int jb = 2; jb < 4; ++jb) { const bf16_t* Kp = P + (r0 + 32 * jb + r) * DIN + C_RK + h * 64 + 8 * hh;
#pragma unroll
        for (int ks = 0; ks < 4; ++ks) kf[jb][ks] = *(const bf16x8*)(Kp + 16 * ks); }
    __syncthreads();
    unsigned lp[2][2];
    { const unsigned blk = (lane >> 4) & 1, q = (lane & 15) >> 2, pp = lane & 3;
#pragma unroll
      for (int t = 0; t < 2; ++t)
#pragma unroll
          for (int cb = 0; cb < 2; ++cb) lp[t][cb] = off_v(4 * hh + 8 * t + q, 4 * (2 * dh + cb) + 2 * blk + (pp >> 1)) + 8 * (pp & 1); }
#pragma unroll
    for (int jb = 0; jb < 4; ++jb) {
        f32x16 x; R3_ZERO(x);
#pragma unroll
        for (int ks = 0; ks < 4; ++ks) x = __builtin_amdgcn_mfma_f32_32x32x16_bf16(kf[jb][ks], qf[ks], x, 0, 0, 0);
#pragma unroll
        for (int reg = 0; reg < 16; ++reg) { const int d = (32 * ib + r) - (32 * jb + (reg & 3) + 8 * (reg >> 2) + 4 * hh);
            const float D = d > 0 ? __builtin_amdgcn_exp2f((float)d * lf) : (d < 0 ? __builtin_amdgcn_exp2f((float)(-d) * lb) : 2.0f); x[reg] *= 0.125f * D; }
#pragma unroll
        for (int s = 0; s < 2; ++s) {
            u32x4 pw; pw.x = pk2(x[8 * s + 0], x[8 * s + 1]); pw.y = pk2(x[8 * s + 2], x[8 * s + 3]); pw.z = pk2(x[8 * s + 4], x[8 * s + 5]); pw.w = pk2(x[8 * s + 6], x[8 * s + 7]);
            const bf16x8 pa = __builtin_bit_cast(bf16x8, pw);
#pragma unroll
            for (int cb = 0; cb < 2; ++cb) { const s16x4_t lo = tr_rd(Vi + lp[0][cb] + (8192 * jb + 4096 * s)), hi = tr_rd(Vi + lp[1][cb] + (8192 * jb + 4096 * s));
                const bf16x8 vb = (bf16x8){lo[0], lo[1], lo[2], lo[3], hi[0], hi[1], hi[2], hi[3]};
                o[cb] = __builtin_amdgcn_mfma_f32_32x32x16_bf16(pa, vb, o[cb], 0, 0, 0); }
        }
        CBAR();
    }
#pragma unroll
    for (int cb = 0; cb < 2; ++cb)
#pragma unroll
        for (int reg = 0; reg < 16; ++reg) { const int i = 32 * ib + (reg & 3) + 8 * (reg >> 2) + 4 * hh, dv = 64 * dh + 32 * cb + r; Ol[i * 132 + dv] = o[cb][reg]; }
    __syncthreads();
    { const int row = tid >> 2, q = tid & 3; f32x4 x[8]; float sm = 0.f;
#pragma unroll
      for (int e = 0; e < 8; ++e) { x[e] = *(const LAS f32x4*)(Ol + row * 132 + 32 * q + 4 * e); sm += (x[e][0] + x[e][1]) + (x[e][2] + x[e][3]); }
      sm += xor1(sm); sm += xor2(sm);
      const float mu = sm * (1.f / 128.f); float vs = 0.f;
#pragma unroll
      for (int e = 0; e < 8; ++e) { x[e] = x[e] - mu; vs += (x[e][0] * x[e][0] + x[e][1] * x[e][1]) + (x[e][2] * x[e][2] + x[e][3] * x[e][3]); }
      vs += xor1(vs); vs += xor2(vs);
      const float rstd = 1.0f / sqrtf(vs * (1.f / 128.f) + EPS);
      bf16_t* yp = (bf16_t*)(C.ws + WS_Y) + (r0 + row) * DM + h * 128 + 32 * q;
#pragma unroll
      for (int e2 = 0; e2 < 4; ++e2) { const u32x4 gw = gwv[e2]; const f32x4 a = x[2 * e2] * rstd, bq = x[2 * e2 + 1] * rstd;
          u32x4 ow; ow.x = pk2(a[0] * silu_f(bflo(gw.x)), a[1] * silu_f(bfhi(gw.x))); ow.y = pk2(a[2] * silu_f(bflo(gw.y)), a[3] * silu_f(bfhi(gw.y)));
          ow.z = pk2(bq[0] * silu_f(bflo(gw.z)), bq[1] * silu_f(bfhi(gw.z))); ow.w = pk2(bq[2] * silu_f(bflo(gw.w)), bq[3] * silu_f(bfhi(gw.w)));
          *(u32x4*)(yp + 8 * e2) = ow; } }
#undef R3_ZERO
}

template <bool WIN>
__device__ __forceinline__ void attn_dispatch(const Ctx& C, int layer, int U, int tid, char* lds) {
    using attn_body::bf16;
    int b, h, q0, NT, tdelta;
    if (U < 1024) { b = U >> 6; h = ((U >> 5) & 1) * 2 + ((U >> 4) & 1); q0 = CTX + 256 * (U & 15);
        if (WIN) { const int ts = (q0 / 64 - 2) > 4 ? (q0 / 64 - 2) : 4, te = (q0 / 64 + 6) < 68 ? (q0 / 64 + 6) : 68; NT = 4 + te - ts; tdelta = ts - 4; } else { NT = 68; tdelta = 0; } }
    else { b = (U - 1024) >> 2; h = (U - 1024) & 3; q0 = 0; NT = 4; tdelta = 0; }
    const int kvh = h >> 1;
    const bf16* Pb = (const bf16*)(C.ws + WS_P) + (size_t)b * TPB * DIN; bf16* Yb = (bf16*)(C.ws + WS_Y) + (size_t)b * TPB * DM;
    if (WIN) attn_body::attn_unit<8, true>(Pb + C_WQ + 64 * h, Pb + C_WK + 64 * kvh, Pb + C_WV + 64 * kvh, Yb + 512 + 64 * h, q0, NT, tdelta, C.win_sink()[layer * 4 + h] * LOG2E, tid, lds);
    else     attn_body::attn_unit<8, false>(Pb + C_GQ + 64 * h, Pb + C_GK + 64 * kvh, Pb + C_GV + 64 * kvh, Yb + 768 + 64 * h, q0, NT, tdelta, 0.f, tid, lds);
}
template <bool WIN>
__device__ __forceinline__ void attn_units(const Ctx& C, int layer, int G, int vcu, int bx, int tid, char* lds) {
    const int nctx = (layer == DEPTH - 1) ? 0 : 64;
    if (G == 256) {
        for (int k = 0; k < 4; ++k) attn_dispatch<WIN>(C, layer, vcu * 4 + k, tid, lds);
        if (vcu < nctx) attn_dispatch<WIN>(C, layer, 1024 + vcu, tid, lds);
    } else {
        for (int U = bx; U < 1024 + nctx; U += G) attn_dispatch<WIN>(C, layer, U, tid, lds);
    }
}

__device__ __forceinline__ f32x2 swap32(float a, float b) { auto r = __builtin_amdgcn_permlane32_swap(__builtin_bit_cast(unsigned, a), __builtin_bit_cast(unsigned, b), false, false);
    return (f32x2){__builtin_bit_cast(float, (unsigned)r[0]), __builtin_bit_cast(float, (unsigned)r[1])}; }
__device__ __forceinline__ f32x2 swap16(float a, float b) { auto r = __builtin_amdgcn_permlane16_swap(__builtin_bit_cast(unsigned, a), __builtin_bit_cast(unsigned, b), false, false);
    return (f32x2){__builtin_bit_cast(float, (unsigned)r[0]), __builtin_bit_cast(float, (unsigned)r[1])}; }
__device__ __forceinline__ void phase_norm2_route(const Ctx& C, int layer_c, LAS unsigned char* lds, int G, int bx, int tid) {
    const int layer = layer_c & 3;
    const int lane = tid & 63, wave = tid >> 6;
    const float* mod = (const float*)(C.ws + WS_MOD) + (size_t)layer * 17 * 6144;
    const float* gain = C.norm2() + layer * DM;
    const bf16_t* XR = (const bf16_t*)(C.ws + WS_X32); unsigned char* H = (unsigned char*)(C.ws + WS_H);
    int* list = (int*)(C.ws + WS_LIST); float* GW = (float*)(C.ws + WS_GW);
    unsigned* gcnt = (unsigned*)(C.ws + WS_CTL) + CW_CNT + 64 * layer_c;
    constexpr int RPC = MROWS / 256, RPW = RPC / 8;
    LAS float* wrT = (LAS float*)lds;
    LAS float* lgs = (LAS float*)(lds + 65536);
    LAS int* lcnt = (LAS int*)(lds + 65536 + RPC * 64);
    LAS int* lbase = lcnt + 16;
    LAS int* rec_e = lcnt + 32;
    LAS float* rec_w = (LAS float*)(rec_e + 2 * RPC);
    { const float* wr = C.w_router(); for (int i = tid; i < DM * NE; i += 512) { const int k = i >> 4, e = i & 15; wrT[e * DM + k] = wr[i]; } }
    if (tid < 16) lcnt[tid] = 0;
    __syncthreads();
    const unsigned lo4 = (unsigned)lane * 4u, lo8 = (unsigned)lane * 8u, lo16 = (unsigned)lane * 16u;
#define E_LOADROW(dst, mm) do { const char* xr_ = (const char*)(XR + (size_t)(mm) * DM); _Pragma("unroll") for (int j = 0; j < 4; ++j) dst[j] = *(const u32x2*)(xr_ + (lo8 + 512u * j)); } while (0)
#define E_NORMROW(v, nxr, mm) do { float ss_ = 0.f; _Pragma("unroll") for (int j = 0; j < 4; ++j) { v[j] = bf4(nxr[j]); ss_ += (v[j][0] * v[j][0] + v[j][1] * v[j][1]) + (v[j][2] * v[j][2] + v[j][3] * v[j][3]); } \
        const int b_ = (mm) / TPB, t_ = (mm) - b_ * TPB, set_ = t_ < CTX ? 16 : b_; const float rstd_ = 1.0f / sqrtf(wave_sum(ss_) * (1.f / DM) + EPS); \
        const char* gp_ = (const char*)gain; const char* shp_ = (const char*)(mod + (size_t)set_ * 6144 + 3 * DM); const char* scp_ = shp_ + DM * 4; \
        char* ho_ = (char*)(H + (size_t)(mm) * DM); \
        _Pragma("unroll") for (int j = 0; j < 4; ++j) { v[j] = (v[j] * rstd_) * *(const f32x4*)(gp_ + (lo16 + 1024u * j)) * (*(const f32x4*)(scp_ + (lo16 + 1024u * j)) + 1.0f) + *(const f32x4*)(shp_ + (lo16 + 1024u * j)); \
            *(unsigned*)(ho_ + (lo4 + 256u * j)) = pk4_fp8(v[j][0], v[j][1], v[j][2], v[j][3]); } } while (0)
#define E_REDUCE(pe, rowl) do { float q8_[8], q4_[4], q2_[2]; \
        _Pragma("unroll") for (int e = 0; e < 8; ++e) { const f32x2 r_ = swap32(pe[e], pe[e + 8]); q8_[e] = r_[0] + r_[1]; } \
        _Pragma("unroll") for (int e = 0; e < 4; ++e) { const f32x2 r_ = swap16(q8_[e], q8_[e + 4]); q4_[e] = r_[0] + r_[1]; } \
        _Pragma("unroll") for (int e = 0; e < 2; ++e) { const float keep_ = b3 ? q4_[e + 2] : q4_[e], send_ = b3 ? q4_[e] : q4_[e + 2]; q2_[e] = keep_ + swz_xor8(send_); } \
        float lg_ = (b2 ? q2_[1] : q2_[0]) + swz_xor4(b2 ? q2_[0] : q2_[1]); lg_ += xor2(lg_); lg_ += xor1(lg_); \
        if ((lane & 3) == 0) lgs[(rowl) * 16 + (lane >> 2)] = lg_; } while (0)
    const bool b3 = (lane & 8) != 0, b2 = (lane & 4) != 0;
    for (int chunk = bx; chunk < 256; chunk += G) {
        const int m0 = chunk * RPC + wave * RPW;
        u32x2 nxA[4], nxB[4], fxA[4], fxB[4];
        E_LOADROW(nxA, m0); E_LOADROW(nxB, m0 + 1); E_LOADROW(fxA, m0 + 2); E_LOADROW(fxB, m0 + 3);
        for (int i = 0; i < RPW; i += 2) {
            f32x4 vA[4], vB[4];
            E_NORMROW(vA, nxA, m0 + i);
            E_NORMROW(vB, nxB, m0 + i + 1);
#pragma unroll
            for (int j = 0; j < 4; ++j) { nxA[j] = fxA[j]; nxB[j] = fxB[j]; }
            if (i + 4 < RPW) { E_LOADROW(fxA, m0 + i + 4); E_LOADROW(fxB, m0 + i + 5); }
            float peA[16], peB[16];
            f32x2 hv[4][4];
#pragma unroll
            for (int j = 0; j < 4; ++j)
#pragma unroll
                for (int c = 0; c < 4; ++c) hv[j][c] = (f32x2){vA[j][c], vB[j][c]};
            const LAS float* wl = wrT + 4 * lane; asm volatile("" : "+v"(wl));
#pragma unroll
            for (int e = 0; e < 16; ++e) { f32x2 a2 = {0.f, 0.f};
#pragma unroll
                for (int j = 0; j < 4; ++j) { const f32x4 w = *(const LAS f32x4*)(wl + e * DM + 256 * j);
#pragma unroll
                    for (int c = 0; c < 4; ++c) a2 = __builtin_elementwise_fma(hv[j][c], (f32x2){w[c], w[c]}, a2); }
                peA[e] = a2[0]; peB[e] = a2[1]; }
            E_REDUCE(peA, wave * RPW + i); E_REDUCE(peB, wave * RPW + i + 1);
        }
#undef E_LOADROW
#undef E_NORMROW
#undef E_REDUCE
        asm volatile("s_waitcnt lgkmcnt(0)" ::: "memory");
        if (lane < RPW) {
            const int rl = wave * RPW + lane; const float* br = C.b_router();
            float sg[16], bs[16];
#pragma unroll
            for (int e4 = 0; e4 < 4; ++e4) { const f32x4 l4 = *(const LAS f32x4*)(lgs + rl * 16 + 4 * e4);
#pragma unroll
                for (int k = 0; k < 4; ++k) { sg[4 * e4 + k] = 1.f / (1.f + expf(-l4[k])); bs[4 * e4 + k] = sg[4 * e4 + k] + br[4 * e4 + k]; } }
            int grp = 0; float best = -1e30f;
#pragma unroll
            for (int g = 0; g < 4; ++g) { const float a0 = bs[4 * g], a1 = bs[4 * g + 1], a2 = bs[4 * g + 2], a3 = bs[4 * g + 3];
                const float hi01 = fmaxf(a0, a1), lo01 = fminf(a0, a1), hi23 = fmaxf(a2, a3), lo23 = fminf(a2, a3);
                const float top = fmaxf(hi01, hi23), second = fmaxf(fminf(hi01, hi23), hi01 >= hi23 ? lo01 : lo23);
                const float sc = top + second; if (sc > best) { best = sc; grp = g; } }
            float c4[4], s4[4];
#pragma unroll
            for (int k = 0; k < 4; ++k) { c4[k] = grp == 0 ? bs[k] : grp == 1 ? bs[4 + k] : grp == 2 ? bs[8 + k] : bs[12 + k]; s4[k] = grp == 0 ? sg[k] : grp == 1 ? sg[4 + k] : grp == 2 ? sg[8 + k] : sg[12 + k]; }
            int l0 = 0; float mx0 = c4[0];
#pragma unroll
            for (int k = 1; k < 4; ++k) if (c4[k] > mx0) { mx0 = c4[k]; l0 = k; }
            int l1 = -1; float mx1 = -1e30f;
#pragma unroll
            for (int k = 0; k < 4; ++k) if (k != l0 && c4[k] > mx1) { mx1 = c4[k]; l1 = k; }
            const float w0 = l0 == 0 ? s4[0] : l0 == 1 ? s4[1] : l0 == 2 ? s4[2] : s4[3], w1 = l1 == 0 ? s4[0] : l1 == 1 ? s4[1] : l1 == 2 ? s4[2] : s4[3];
            const float wn = 1.f / (w0 + w1);
            const int e0 = grp * 4 + l0, e1 = grp * 4 + l1;
            const int p0 = __hip_atomic_fetch_add(lcnt + e0, 1, __ATOMIC_RELAXED, __HIP_MEMORY_SCOPE_WORKGROUP);
            const int p1 = __hip_atomic_fetch_add(lcnt + e1, 1, __ATOMIC_RELAXED, __HIP_MEMORY_SCOPE_WORKGROUP);
            rec_e[2 * rl] = e0 | (p0 << 8); rec_e[2 * rl + 1] = e1 | (p1 << 8); rec_w[2 * rl] = w0 * wn; rec_w[2 * rl + 1] = w1 * wn;
        }
        __syncthreads();
        if (tid < 16) lbase[tid] = (int)__hip_atomic_fetch_add(gcnt + tid, (unsigned)lcnt[tid], __ATOMIC_RELAXED, __HIP_MEMORY_SCOPE_AGENT);
        __syncthreads();
        for (int i = tid; i < 2 * RPC; i += 512) { const int re = rec_e[i], e = re & 255, pp = re >> 8; const int id = (chunk * RPC + (i >> 1)) * 2 + (i & 1);
            list[e * MROWS + lbase[e] + pp] = id; GW[id] = rec_w[i]; }
        __syncthreads();
        if (tid < 16) lcnt[tid] = 0;
        __syncthreads();
    }
}

template <bool GATHER_, int NT>
struct MoeOrder {
    static constexpr bool GATHER = GATHER_;
    const int* list; const LAS int* boff; const LAS int* cnt; int G, c;
    __device__ __forceinline__ bool next(int i, pg8::Unit& u) const {
        const int L = i * G + c; if (L >= boff[16] * NT) return false;
        const int blk = L / NT, pn = L - blk * NT; int e = 0;
#pragma unroll
        for (int k = 1; k < 16; ++k) e += (blk >= boff[k]) ? 1 : 0;
        u.pm = blk; u.pn = e * NT + pn; return true;
    }
    __device__ __forceinline__ unsigned arow(const pg8::Unit& u, int r) const {
        const int e = u.pn / NT, li = (u.pm - boff[e]) * 256 + r;
        const int id = li < cnt[e] ? list[e * MROWS + li] : 0;
        return (unsigned)(id >> 1);
    }
};
struct EpiGateUp {
    static constexpr bool PERM = true;
    unsigned char* O;
    __device__ __forceinline__ void operator()(const f32x4 (&acc)[2][2][4][2], const pg8::Unit& u, int wr, int wc, int fr, int fq) const {
        const int row0 = u.pm * 256 + wr * 64 + fr, col0 = (u.pn & 7) * 128 + wc * 32 + 8 * fq;
#pragma unroll
        for (int ai = 0; ai < 2; ++ai)
#pragma unroll
            for (int m = 0; m < 4; ++m) { const f32x4 a0 = acc[ai][0][m][0] * W8_INV, a1 = acc[ai][0][m][1] * W8_INV, u0 = acc[ai][1][m][0] * W8_INV, u1 = acc[ai][1][m][1] * W8_INV;
                u32x2 w; w.x = pk4_fp8(silu_f(a0[0]) * u0[0], silu_f(a0[1]) * u0[1], silu_f(a0[2]) * u0[2], silu_f(a0[3]) * u0[3]);
                w.y = pk4_fp8(silu_f(a1[0]) * u1[0], silu_f(a1[1]) * u1[1], silu_f(a1[2]) * u1[2], silu_f(a1[3]) * u1[3]);
                *(u32x2*)(O + ((unsigned)(row0 + ai * 128 + m * 16) * (unsigned)FF + (unsigned)col0)) = w; }
    }
};
struct EpiDown {
    static constexpr bool PERM = true;
    unsigned char* YP; const float* GW; const int* list; const LAS int* boff; const LAS int* cnt;
    __device__ __forceinline__ void operator()(const f32x4 (&acc)[2][2][4][2], const pg8::Unit& u, int wr, int wc, int fr, int fq) const {
        const int e = u.pn >> 2, lb = (u.pm - boff[e]) * 256, n = cnt[e]; const int col0 = (u.pn & 3) * 256 + wc * 32 + 8 * fq;
#pragma unroll
        for (int ai = 0; ai < 2; ++ai)
#pragma unroll
            for (int m = 0; m < 4; ++m) { const int li = lb + ai * 128 + wr * 64 + m * 16 + fr;
                if (li < n) { const int id = list[e * MROWS + li]; const float g = GW[id] * (W8_INV * YP_SCALE); const unsigned off = (unsigned)id * (unsigned)DM + (unsigned)col0;
#pragma unroll
                    for (int bj = 0; bj < 2; ++bj) { const f32x4 v0 = acc[ai][bj][m][0] * g, v1 = acc[ai][bj][m][1] * g;
                        u32x2 w; w.x = pk4_fp8(v0[0], v0[1], v0[2], v0[3]); w.y = pk4_fp8(v1[0], v1[1], v1[2], v1[3]); *(u32x2*)(YP + off + bj * 128) = w; } } }
    }
};
__device__ __forceinline__ void moe_offsets(const Ctx& C, int layer, LAS int* boff, LAS int* cnt, int tid) {
    if (tid == 0) { const unsigned* gcnt = (const unsigned*)(C.ws + WS_CTL) + CW_CNT + 64 * layer; int acc = 0;
        for (int e = 0; e < 16; ++e) { const int n = (int)__hip_atomic_load(gcnt + e, __ATOMIC_RELAXED, __HIP_MEMORY_SCOPE_AGENT); cnt[e] = n; boff[e] = acc; acc += (n + 255) >> 8; }
        boff[16] = acc; }
    __syncthreads();
}

__device__ __forceinline__ void phase_final(const Ctx& C, int gw, int NGW, int lane) {
    const float* mod = (const float*)(C.ws + WS_MOD) + (size_t)(DEPTH - 1) * 17 * 6144;
    const bf16_t* XR = (const bf16_t*)(C.ws + WS_X32); const unsigned char* YP = (const unsigned char*)(C.ws + WS_YP);
    for (int r = gw; r < NB * SEQ; r += NGW) {
        const int b = r / SEQ, t = r - b * SEQ; const size_t m = (size_t)b * TPB + CTX + t;
        const u32x2* xr = (const u32x2*)(XR + m * DM) + lane; const unsigned* y0 = (const unsigned*)(YP + m * 2 * DM) + lane; const unsigned* y1 = y0 + DM / 4;
        const f32x4* g2 = (const f32x4*)(mod + (size_t)b * 6144 + 5 * DM) + lane; f32x4* o = (f32x4*)(C.out + (size_t)r * DM) + lane;
        unsigned a[4], bb[4]; u32x2 x[4];
#pragma unroll
        for (int j = 0; j < 4; ++j) { x[j] = xr[64 * j]; a[j] = y0[64 * j]; bb[j] = y1[64 * j]; }
#pragma unroll
        for (int j = 0; j < 4; ++j) o[64 * j] = bf4(x[j]) + (g2[64 * j] * YP_INV) * (fp8x4_f32(a[j]) + fp8x4_f32(bb[j]));
    }
}

#ifndef R3OFF
#define R3OFF 0
#endif
#ifndef WINOFF
#define WINOFF 0
#endif
#ifndef PHMASK
#define PHMASK 0xFFFF
#endif
#ifndef MK_ONE_LAUNCH
#define MK_ONE_LAUNCH 1
#endif
constexpr int PH_PER_LAYER = 9, PH_LAYER0 = 2, PH_FINAL = PH_LAYER0 + DEPTH * PH_PER_LAYER, PH_COUNT = PH_FINAL + 1;
struct Args { const float* in[18]; float* out; unsigned char* ws; int ph_lo, ph_hi, flags, pad; };
__global__ void __launch_bounds__(512, 2) mega_fwd(Args args) {
    extern __shared__ __attribute__((aligned(16))) unsigned char lds_raw[];
    LAS unsigned char* lds = (LAS unsigned char*)lds_raw;
    Ctx C; C.out = args.out; C.ws = args.ws;
    const int tid = threadIdx.x, lane = tid & 63, wave = __builtin_amdgcn_readfirstlane(tid >> 6);
    const int G = gridDim.x; const int bx = blockIdx.x; const int vcu = (G % 8 == 0) ? (bx % 8) * (G / 8) + bx / 8 : bx;
    const int gw = vcu * 8 + wave, NGW = G * 8;
    volatile LAS unsigned* MISC = (volatile LAS unsigned*)(lds + LDSCTL_OFF);
    for (int u = tid; u < (LDS_BYTES - LDSCTL_OFF) / 4; u += 512) ((LAS unsigned*)(lds + LDSCTL_OFF))[u] = 0u;
    __syncthreads();
    const int lo = args.ph_lo, hi = args.ph_hi;
    XcdBarrier bar; bar.bar = (unsigned*)(C.ws + WS_CTL) + CW_BAR; bar.x = 0; bar.st = nullptr;
    if (hi - lo > 1) bar = xcd_barrier_post((unsigned*)(C.ws + WS_CTL) + CW_BAR, MISC);
#define IN(k) (lo <= (k) && (k) < hi)
#define PHASE_IDS() int bx_ = bx, wave_ = wave; LAS unsigned char* lds_ = lds; asm volatile("" : "+s"(bx_), "+s"(wave_), "+s"(lds_)); int lane_; asm volatile("v_mbcnt_lo_u32_b32 %0, -1, 0\n\tv_mbcnt_hi_u32_b32 %0, -1, %0" : "=v"(lane_)); const int tid_ = wave_ * 64 + lane_; \
    const int vcu_ = (G % 8 == 0) ? (bx_ % 8) * (G / 8) + bx_ / 8 : bx_; const int gw_ = vcu_ * 8 + wave_; (void)lane_; (void)gw_; (void)vcu_
#define SEAM(k) do { if (IN(k) && IN((k) + 1)) xcd_barrier(bar); } while (0)

    if (IN(0) && (PHMASK & 1)) { PHASE_IDS(); phase_prologue(C, lds_, G, vcu_, bx_, tid_); } SEAM(0);
    if (IN(1) && (PHMASK & 2)) { PHASE_IDS(); phase_modsum(C, G, bx_, tid_); } SEAM(1);
#ifdef EXTRA_BARS
    if (hi - lo > 1) for (int eb = 0; eb < EXTRA_BARS; ++eb) xcd_barrier(bar);
#endif

#ifdef LAYER_UNROLL
#pragma unroll
#else
#pragma nounroll
#endif
    for (int layer = 0; layer < DEPTH; ++layer) {
        const int p0 = PH_LAYER0 + layer * PH_PER_LAYER;
        if (IN(p0 + 0) && (PHMASK & 4)) { PHASE_IDS(); phase_norm1(C, layer, gw_, NGW, lane_, (args.flags & 16) ? (bf16_t*)(C.ws + WS_Y) : (bf16_t*)(C.ws + WS_X32)); } SEAM(p0 + 0);
        if (IN(p0 + 1) && (PHMASK & 8)) {
            pg8::Gemm g{(const bf16_t*)(C.ws + WS_H), (const bf16_t*)(C.ws + WS_WIN) + (size_t)layer * DIN * DM, MROWS, DIN, DM};
            PHASE_IDS(); pg8::StaticOrder S; S.init(MROWS, DIN, G, bx_);
            pg8::EpiBf16 E{(bf16_t*)(C.ws + WS_P), DIN};
            pg8::gemm_phase<pg8::EpiBf16, pg8::StaticOrder, true>(lds_, g, S, E, tid_);
        } SEAM(p0 + 1);
        if (IN(p0 + 2) && (PHMASK & 16)) {
            PHASE_IDS(); if (!(args.flags & 1)) phase_qkprep(C, layer, gw_, NGW, lane_, (args.flags & 8) ? (bf16_t*)(C.ws + WS_Y) : (bf16_t*)(C.ws + WS_P));
            if (!(args.flags & 8)) for (int u = bx_; u < NB * 4 * NCH; u += G) { const int c = u % NCH, bh = u / NCH; ret_r1_unit(C, layer, bh >> 2, bh & 3, c, lds_, tid_); }
        } SEAM(p0 + 2);
        if (IN(p0 + 3) && (PHMASK & 32)) {
            PHASE_IDS(); for (int u = bx_; u < 512; u += G) ret_r2_unit(C, layer, u, tid_);
            attn_units<false>(C, layer, G, vcu_, bx_, tid_, (char*)lds_);
        } SEAM(p0 + 3);
        if (IN(p0 + 4) && (PHMASK & 64)) {
            PHASE_IDS();
            if (!WINOFF && !(args.flags & 32)) attn_units<true>(C, layer, G, vcu_, bx_, tid_, (char*)lds_);
            if (!R3OFF && !(args.flags & 64))
            for (int u = bx_; u < NB * 4 * NCH; u += G) { const int c = u % NCH, bh = u / NCH; ret_r3_unit(C, layer, bh >> 2, bh & 3, c, lds_, tid_); }
        } SEAM(p0 + 4);
        if (IN(p0 + 5) && (PHMASK & 128)) {
            pg8::Gemm g{(const bf16_t*)(C.ws + WS_Y), (const bf16_t*)(C.ws + WS_WOUT) + (size_t)layer * DM * DM, MROWS, DM, DM};
            PHASE_IDS(); pg8::StaticOrder S; S.init(MROWS, DM, G, bx_);
            pg8::EpiResid E{(bf16_t*)(C.ws + ((args.flags & 4) ? WS_P : WS_X32)), (const float*)(C.ws + WS_MOD) + (size_t)layer * 17 * 6144 + 2 * DM};
            pg8::gemm_phase<pg8::EpiResid, pg8::StaticOrder, true>(lds_, g, S, E, tid_);
        } SEAM(p0 + 5);
        if (IN(p0 + 6) && (PHMASK & 256)) { PHASE_IDS(); phase_norm2_route(C, layer + ((args.flags & 2) ? 4 : 0), lds_, G, bx_, tid_); } SEAM(p0 + 6);
        if (IN(p0 + 7) && (PHMASK & 512)) {
            PHASE_IDS(); LAS int* boff = (LAS int*)(lds_ + LDSCTL_OFF + 64); LAS int* mcnt = (LAS int*)(lds_ + LDSCTL_OFF + 192); moe_offsets(C, layer, boff, mcnt, tid_);
            pg8::Gemm g{(const bf16_t*)(C.ws + WS_H), (const bf16_t*)(C.ws + WS_WGU + (size_t)layer * NE * 2 * FF * DM), 0, 2 * FF, DM};
            MoeOrder<true, 8> S{(const int*)(C.ws + WS_LIST), boff, mcnt, G, bx_};
            EpiGateUp E{(unsigned char*)(C.ws + WS_P)};
            pg8::gemm_phase<EpiGateUp, MoeOrder<true, 8>, true, true>(lds_, g, S, E, tid_);
        } SEAM(p0 + 7);
        if (IN(p0 + 8) && (PHMASK & 1024)) {
            PHASE_IDS(); LAS int* boff = (LAS int*)(lds_ + LDSCTL_OFF + 64); LAS int* mcnt = (LAS int*)(lds_ + LDSCTL_OFF + 192); moe_offsets(C, layer, boff, mcnt, tid_);
            pg8::Gemm g{(const bf16_t*)(C.ws + WS_P), (const bf16_t*)(C.ws + WS_WDN + (size_t)layer * NE * DM * FF), 0, DM, FF};
            MoeOrder<false, 4> S{(const int*)(C.ws + WS_LIST), boff, mcnt, G, bx_};
            EpiDown E{(unsigned char*)(C.ws + WS_YP), (const float*)(C.ws + WS_GW), (const int*)(C.ws + WS_LIST), boff, mcnt};
            pg8::gemm_phase<EpiDown, MoeOrder<false, 4>, true, true>(lds_, g, S, E, tid_);
        } SEAM(p0 + 8);
    }
    if (IN(PH_FINAL) && (PHMASK & 2048)) { PHASE_IDS(); phase_final(C, gw_, NGW, lane_); }
#undef IN
#undef SEAM
}

extern "C" void kernel_launch(void* const* d_in, const int* in_sizes, int n_in, void* d_out, int out_size, void* d_ws, size_t ws_size, hipStream_t stream) {
    static int grid = 0;
    if (grid == 0) {
        if (n_in != 18 || in_sizes[0] != NB * SEQ * DM || out_size != NB * SEQ * DM || ws_size < WS_END) {
            fprintf(stderr, "kernel_launch: unexpected shapes (n_in %d, in0 %d, out %d, ws %zu, need %zu); nothing launched\n", n_in, n_in > 0 ? in_sizes[0] : -1, out_size, ws_size, (size_t)WS_END); grid = -1; return; }
        int dev = 0, cus = 0, per_cu = 0;
        if (hipGetDevice(&dev) != hipSuccess || hipDeviceGetAttribute(&cus, hipDeviceAttributeMultiprocessorCount, dev) != hipSuccess) { grid = -1; return; }
        if (hipFuncSetAttribute((const void*)mega_fwd, hipFuncAttributeMaxDynamicSharedMemorySize, LDS_BYTES) != hipSuccess) { fprintf(stderr, "kernel_launch: hipFuncSetAttribute failed\n"); grid = -1; return; }
        if (hipOccupancyMaxActiveBlocksPerMultiprocessor(&per_cu, (const void*)mega_fwd, 512, LDS_BYTES) != hipSuccess || per_cu < 1) fprintf(stderr, "kernel_launch: occupancy query says %d\n", per_cu);
        (void)hipGetLastError();
        grid = cus;
    }
    if (grid < 0) return;
    if (hipMemsetAsync((char*)d_ws + WS_CTL, 0, CTL_BYTES, stream) != hipSuccess) return;
    Args a{};
    for (int i = 0; i < 18; ++i) a.in[i] = (const float*)d_in[i];
    a.out = (float*)d_out; a.ws = (unsigned char*)d_ws;
#if MK_ONE_LAUNCH
    a.ph_lo = 0; a.ph_hi = PH_COUNT;
    hipLaunchKernelGGL(mega_fwd, dim3(grid), dim3(512), LDS_BYTES, stream, a);
#else
    for (int p = 0; p < PH_COUNT; ++p) { a.ph_lo = p; a.ph_hi = p + 1;
#if !defined(PROBE_P) || !PROBE_BEFORE
        hipLaunchKernelGGL(mega_fwd, dim3(grid), dim3(512), LDS_BYTES, stream, a);
#endif
#ifdef PROBE_P
        const bool hit = (PROBE_P < 2) ? (p == PROBE_P) : (p >= PH_LAYER0 && p < PH_FINAL && (p - PH_LAYER0) % PH_PER_LAYER == PROBE_P - 2 && (!PROBE_L0 || p < PH_LAYER0 + PH_PER_LAYER));
        if (hit) { a.flags = PROBE_FLAGS; for (int r = 0; r < PROBE_REP; ++r) hipLaunchKernelGGL(mega_fwd, dim3(grid), dim3(512), LDS_BYTES, stream, a); a.flags = 0; }
#if PROBE_BEFORE
        hipLaunchKernelGGL(mega_fwd, dim3(grid), dim3(512), LDS_BYTES, stream, a);
#endif
#endif
    }
#endif
}
```

```cpp
#define MK_ONE_LAUNCH 1
#include <hip/hip_runtime.h>
#include <cstdio>
#include <cstdint>

#define GAS __attribute__((address_space(1)))
#define LAS __attribute__((address_space(3)))
typedef unsigned short bf16_t;
typedef short bf16x8 __attribute__((ext_vector_type(8)));
typedef float f32x4 __attribute__((ext_vector_type(4)));
typedef float f32x2 __attribute__((ext_vector_type(2)));
typedef float f32x16 __attribute__((ext_vector_type(16)));
typedef unsigned u32x4 __attribute__((ext_vector_type(4)));
typedef unsigned u32x2 __attribute__((ext_vector_type(2)));

constexpr int DM = 1024, NB = 16, SEQ = 4096, CTX = 256, TPB = SEQ + CTX, MROWS = NB * TPB, DEPTH = 4;
constexpr int DIN = 2560;
constexpr int C_RQ = 0, C_RK = 256, C_RV = 512, C_RG = 1024, C_WQ = 1536, C_WK = 1792, C_WV = 1920, C_GQ = 2048, C_GK = 2304, C_GV = 2432;
constexpr int NE = 16, FF = 1024, NCH = TPB / 128;
constexpr float EPS = 1e-6f;
constexpr float LOG2E = 1.4426950408889634f;
constexpr float QSCALE = 0.125f * LOG2E;

__device__ __forceinline__ unsigned f2bf(float f) { unsigned u = __builtin_bit_cast(unsigned, f); return (u + 0x7fffu + ((u >> 16) & 1u)) >> 16; }
__device__ __forceinline__ unsigned pk2(float lo, float hi) { return f2bf(lo) | (f2bf(hi) << 16); }
__device__ __forceinline__ float bf2f(unsigned short h) { return __builtin_bit_cast(float, (unsigned)h << 16); }
__device__ __forceinline__ float bflo(unsigned w) { return __builtin_bit_cast(float, w << 16); }
__device__ __forceinline__ float bfhi(unsigned w) { return __builtin_bit_cast(float, w & 0xffff0000u); }

namespace pg8 {
constexpr int BM = 256, BK = 64, HALF = 128, HTB = HALF * BK * 2, STAGE_BYTES = 8 * HTB, NXCD = 8, WGM = 8;
__host__ __device__ __forceinline__ int lds_byte(int r, int c) { const int st = (r >> 4) * 2 + (c >> 5), rr = r & 15, cc = c & 31, ob = rr * 64 + cc * 2; return st * 1024 + (ob ^ (((ob >> 9) & 1) << 5)); }
__host__ __device__ __forceinline__ void stage_rc(int b, int& R, int& C) { const int st = b / 1024, sb = b % 1024, swz = sb ^ (((sb >> 9) & 1) << 5); R = (st >> 1) * 16 + swz / 64; C = (st & 1) * 32 + (swz % 64) / 2; }
__host__ __device__ __forceinline__ int perm32(int rho) { const int n = rho >> 4, i = rho & 15; return 8 * (i >> 2) + 4 * n + (i & 3); }

struct Unit { int pm, pn; };
struct Gemm { const bf16_t* A; const bf16_t* Bt; int M, N, K; };

struct StaticOrder {
    static constexpr bool GATHER = false;
    int nM, nN, nwg, G, c; bool skipctx;
    __device__ void init(int M, int N, int G_, int c_, bool skipctx_ = false) { skipctx = skipctx_; nM = skipctx_ ? (M / BM) / 17 * 16 : M / BM; nN = N / BM; nwg = nM * nN; G = G_; c = c_; }
    __device__ bool next(int i, Unit& u) const {
        const long L = (long)i * G + c; if (L >= nwg) return false;
        int wgid = (int)L; { const int q = nwg / NXCD, r = nwg % NXCD, xcd = wgid % NXCD, off = wgid / NXCD; wgid = (xcd < r ? xcd * (q + 1) : r * (q + 1) + (xcd - r) * q) + off; }
        const int nig = WGM * nN, gid = wgid / nig, fm = gid * WGM, gsz = (nM - fm) < WGM ? (nM - fm) : WGM;
        u.pm = fm + ((wgid % nig) % gsz); u.pn = (wgid % nig) / gsz; if (skipctx) u.pm += (u.pm >> 4) + 1; return true;
    }
    __device__ __forceinline__ unsigned arow(const Unit&, int) const { return 0u; }
};

__device__ __forceinline__ unsigned cvt_pk_bf16(float lo, float hi) { unsigned r; asm volatile("v_cvt_pk_bf16_f32 %0, %1, %2" : "=v"(r) : "v"(lo), "v"(hi)); return r; }

struct EpiBf16 {
    static constexpr bool PERM = true;
    bf16_t* O; int ldc;
    __device__ __forceinline__ void operator()(const f32x4 (&acc)[2][2][4][2], const Unit& u, int wr, int wc, int fr, int fq) const {
        const int row0 = u.pm * BM + wr * 64 + fr; const int col0 = u.pn * BM + wc * 32 + 8 * fq;
#pragma unroll
        for (int ai = 0; ai < 2; ++ai)
#pragma unroll
            for (int m = 0; m < 4; ++m) { const unsigned off = ((unsigned)(row0 + ai * HALF + m * 16) * (unsigned)ldc + (unsigned)col0) * 2u;
#pragma unroll
                for (int bj = 0; bj < 2; ++bj) { const f32x4 v0 = acc[ai][bj][m][0], v1 = acc[ai][bj][m][1];
                    u32x4 w; w.x = cvt_pk_bf16(v0[0], v0[1]); w.y = cvt_pk_bf16(v0[2], v0[3]); w.z = cvt_pk_bf16(v1[0], v1[1]); w.w = cvt_pk_bf16(v1[2], v1[3]);
                    *(u32x4*)((char*)O + off + bj * HALF * 2) = w; } }
    }
};

struct EpiResid {
    static constexpr bool PERM = true;
    bf16_t* X; const float* gate;
    __device__ __forceinline__ void operator()(const f32x4 (&acc)[2][2][4][2], const Unit& u, int wr, int wc, int fr, int fq) const {
        const int set = (u.pm % 17 == 0) ? 16 : (u.pm / 17);
        const float* gp = gate + (size_t)set * 6 * DM;
        const int col0 = u.pn * BM + wc * 32 + 8 * fq;
        f32x4 gv[2][2];
#pragma unroll
        for (int bj = 0; bj < 2; ++bj)
#pragma unroll
            for (int n = 0; n < 2; ++n) gv[bj][n] = *(const f32x4*)(gp + col0 + bj * HALF + n * 4);
#pragma unroll
        for (int ai = 0; ai < 2; ++ai) {
            u32x4 xin[4][2];
#pragma unroll
            for (int m = 0; m < 4; ++m) { const unsigned off = ((unsigned)(u.pm * BM + ai * HALF + wr * 64 + m * 16 + fr) * (unsigned)DM + (unsigned)col0) * 2u;
#pragma unroll
                for (int bj = 0; bj < 2; ++bj) xin[m][bj] = *(const u32x4*)((const char*)X + off + bj * HALF * 2); }
            asm volatile("" ::: "memory");
#pragma unroll
            for (int m = 0; m < 4; ++m) { const unsigned off = ((unsigned)(u.pm * BM + ai * HALF + wr * 64 + m * 16 + fr) * (unsigned)DM + (unsigned)col0) * 2u;
#pragma unroll
                for (int bj = 0; bj < 2; ++bj) { const u32x4 x = xin[m][bj]; const f32x4 a0 = acc[ai][bj][m][0] * gv[bj][0], a1 = acc[ai][bj][m][1] * gv[bj][1];
                    u32x4 w; w.x = cvt_pk_bf16(bflo(x.x) + a0[0], bfhi(x.x) + a0[1]); w.y = cvt_pk_bf16(bflo(x.y) + a0[2], bfhi(x.y) + a0[3]);
                    w.z = cvt_pk_bf16(bflo(x.z) + a1[0], bfhi(x.z) + a1[1]); w.w = cvt_pk_bf16(bflo(x.w) + a1[2], bfhi(x.w) + a1[3]);
                    *(u32x4*)((char*)X + off + bj * HALF * 2) = w; } }
            asm volatile("" ::: "memory");
        }
    }
};

template <class Epi, class Sched, bool ALIGN_EPI, bool FP8 = false>
__device__ __forceinline__ void gemm_phase(LAS unsigned char* lds, const Gemm g, const Sched& S, const Epi& E, const int tid) {
    const int wid = __builtin_amdgcn_readfirstlane(tid >> 6), lane = tid & 63, wr = wid >> 2, wc = wid & 3, fr = lane & 15, fq = lane >> 4;
    const int K = g.K, KB = FP8 ? K : 2 * K  , nt = KB / (BK * 2);
    unsigned voffB[2], vA[2][2], vAn[2][2]; int sR[2], sC[2];
#pragma unroll
    for (int i = 0; i < 2; ++i) { int R, C; stage_rc(tid * 16 + i * 8192, R, C); sR[i] = R; sC[i] = C; const int Rb = Epi::PERM ? ((R & ~31) + perm32(R & 31)) : R;
        voffB[i] = (unsigned)(Rb * KB + C * 2); }
#define PG8_SETV(v, u) do { _Pragma("unroll") for (int h_ = 0; h_ < 2; ++h_) _Pragma("unroll") for (int i_ = 0; i_ < 2; ++i_) { \
        if constexpr (Sched::GATHER) v[h_][i_] = S.arow(u, h_ * HALF + sR[i_]) * (unsigned)KB + (unsigned)(sC[i_] * 2); \
        else v[h_][i_] = (unsigned)((h_ * HALF + sR[i_]) * KB + sC[i_] * 2); } } while (0)
    const size_t kstep = (size_t)(BK * 2);
    const size_t hstep = (size_t)HALF * KB;
    const size_t tstep = 2 * hstep;
    const size_t atstep = Sched::GATHER ? (size_t)0 : tstep;
    const unsigned ldsw = (unsigned)wid * 1024u;
    const int aoff = lds_byte(wr * 64 + fr, fq * 8), boff = lds_byte(wc * 32 + fr, fq * 8);
#define PG8_SA(b, h) (((b) * 2 + (h)) * HTB)
#define PG8_SB(b, h) ((4 + (b) * 2 + (h)) * HTB)
#define PG8_STAGE(bufoff, gbase, voff) do { _Pragma("unroll") for (int _i = 0; _i < 2; ++_i) \
        __builtin_amdgcn_global_load_lds((const unsigned*)((const char*)(gbase) + (voff)[_i]), (LAS unsigned*)(lds + (bufoff) + ldsw + _i * 8192), 16, 0, 0); } while (0)
#define PG8_LDA(dst, b, h) do { _Pragma("unroll") for (int m = 0; m < 4; ++m) _Pragma("unroll") for (int k = 0; k < 2; ++k) dst[m][k] = *(const LAS bf16x8*)(lds + PG8_SA(b, h) + aoff + m * 2048 + k * 1024); } while (0)
#define PG8_LDB(dst, b, h) do { _Pragma("unroll") for (int n = 0; n < 2; ++n) _Pragma("unroll") for (int k = 0; k < 2; ++k) dst[n][k] = *(const LAS bf16x8*)(lds + PG8_SB(b, h) + boff + n * 2048 + k * 1024); } while (0)
    typedef long i64x2_ __attribute__((ext_vector_type(2)));
#define PG8_MMA(ai, bj, At, Bt) do { __builtin_amdgcn_s_setprio(1); _Pragma("unroll") for (int m = 0; m < 4; ++m) _Pragma("unroll") for (int n = 0; n < 2; ++n) _Pragma("unroll") for (int k = 0; k < 2; ++k) { \
        if constexpr (FP8) { const i64x2_ b2_ = __builtin_bit_cast(i64x2_, Bt[n][k]), a2_ = __builtin_bit_cast(i64x2_, At[m][k]); \
            acc[ai][bj][m][n] = __builtin_amdgcn_mfma_f32_16x16x32_fp8_fp8(b2_[0], a2_[0], acc[ai][bj][m][n], 0, 0, 0); \
            acc[ai][bj][m][n] = __builtin_amdgcn_mfma_f32_16x16x32_fp8_fp8(b2_[1], a2_[1], acc[ai][bj][m][n], 0, 0, 0); } \
        else acc[ai][bj][m][n] = __builtin_amdgcn_mfma_f32_16x16x32_bf16(Bt[n][k], At[m][k], acc[ai][bj][m][n], 0, 0, 0); } \
        __builtin_amdgcn_s_setprio(0); } while (0)
#define PG8_WAIT_V(n) asm volatile("s_waitcnt vmcnt(" #n ")" ::: "memory")
#define PG8_WAIT_L(n) asm volatile("s_waitcnt lgkmcnt(" #n ")" ::: "memory")
#define PG8_BAR __builtin_amdgcn_s_barrier()
#define PG8_SCHED __builtin_amdgcn_sched_barrier(0)
    Unit cur, nxt; int ui = 0;
    if (!S.next(0, cur)) return;
    float z0 = 0.f; asm volatile("" : "+v"(z0));
    f32x4 acc[2][2][4][2];
#pragma unroll
    for (int a = 0; a < 2; ++a)
#pragma unroll
        for (int b = 0; b < 2; ++b)
#pragma unroll
            for (int m = 0; m < 4; ++m)
#pragma unroll
                for (int n = 0; n < 2; ++n) acc[a][b][m][n] = (f32x4){z0, z0, z0, z0};
    bf16x8 At[4][2], B0[2][2], B1[2][2];
    const char* cA = (const char*)g.A + (size_t)cur.pm * atstep; const char* cB = (const char*)g.Bt + (size_t)cur.pn * tstep;
    PG8_SETV(vA, cur);
    PG8_STAGE(PG8_SB(0, 0), cB, voffB); PG8_STAGE(PG8_SB(0, 1), cB + hstep, voffB); PG8_STAGE(PG8_SA(0, 0), cA, vA[0]); PG8_STAGE(PG8_SA(0, 1), cA, vA[1]);
    if (wr == 1) PG8_BAR;
    PG8_WAIT_V(2); PG8_BAR;
    PG8_STAGE(PG8_SB(1, 0), cB + kstep, voffB); PG8_STAGE(PG8_SA(1, 0), cA + kstep, vA[0]); PG8_STAGE(PG8_SB(1, 1), cB + hstep + kstep, voffB);
    PG8_WAIT_V(6); PG8_BAR;
    for (;;) {
        const bool has_next = S.next(ui + 1, nxt);
        const char* nA = has_next ? (const char*)g.A + (size_t)nxt.pm * atstep : cA; const char* nB = has_next ? (const char*)g.Bt + (size_t)nxt.pn * tstep : cB;
        if (has_next) { PG8_SETV(vAn, nxt); } else {
#pragma unroll
            for (int h_ = 0; h_ < 2; ++h_)
#pragma unroll
                for (int i_ = 0; i_ < 2; ++i_) vAn[h_][i_] = vA[h_][i_]; }
        for (int t = 0; t < nt; t += 2) {
            const bool last = (t == nt - 2);
            const char* a1 = cA + (size_t)(t + 1) * kstep;
            const char* a2 = last ? nA : cA + (size_t)(t + 2) * kstep; const char* b2 = last ? nB : cB + (size_t)(t + 2) * kstep;
            const char* a3 = a2 + kstep; const char* b3 = b2 + kstep;
            unsigned o2[2][2];
#pragma unroll
            for (int h_ = 0; h_ < 2; ++h_)
#pragma unroll
                for (int i_ = 0; i_ < 2; ++i_) o2[h_][i_] = last ? vAn[h_][i_] : vA[h_][i_];
            PG8_LDB(B0, 0, 0); PG8_LDB(B1, 0, 1); PG8_SCHED; PG8_LDA(At, 0, 0); PG8_STAGE(PG8_SA(1, 1), a1, vA[1]);
            PG8_WAIT_V(8); PG8_WAIT_L(0); PG8_BAR; PG8_MMA(0, 0, At, B0); PG8_MMA(0, 1, At, B1); PG8_BAR; PG8_SCHED;
            PG8_LDA(At, 0, 1); PG8_STAGE(PG8_SB(0, 0), b2, voffB); PG8_STAGE(PG8_SB(0, 1), b2 + hstep, voffB); PG8_STAGE(PG8_SA(0, 0), a2, o2[0]);
            PG8_WAIT_V(8); PG8_WAIT_L(0); PG8_BAR; PG8_MMA(1, 0, At, B0); PG8_MMA(1, 1, At, B1); PG8_BAR; PG8_SCHED;
            PG8_LDB(B0, 1, 0); PG8_LDB(B1, 1, 1); PG8_SCHED; PG8_LDA(At, 1, 0); PG8_STAGE(PG8_SA(0, 1), a2, o2[1]);
            PG8_WAIT_V(8); PG8_WAIT_L(0); PG8_BAR; PG8_MMA(0, 0, At, B0); PG8_MMA(0, 1, At, B1); PG8_BAR; PG8_SCHED;
            PG8_LDA(At, 1, 1); PG8_STAGE(PG8_SB(1, 0), b3, voffB); PG8_STAGE(PG8_SB(1, 1), b3 + hstep, voffB); PG8_STAGE(PG8_SA(1, 0), a3, o2[0]);
            PG8_WAIT_V(8); PG8_WAIT_L(0); PG8_BAR; PG8_MMA(1, 0, At, B0); PG8_MMA(1, 1, At, B1); PG8_BAR; PG8_SCHED;
        }
        if constexpr (ALIGN_EPI) { if (wr == 0) PG8_BAR; }
        E(acc, cur, wr, wc, fr, fq);
        if (!has_next) break;
#pragma unroll
        for (int a = 0; a < 2; ++a)
#pragma unroll
            for (int b = 0; b < 2; ++b)
#pragma unroll
                for (int m = 0; m < 4; ++m)
#pragma unroll
                    for (int n = 0; n < 2; ++n) acc[a][b][m][n] = (f32x4){z0, z0, z0, z0};
        cur = nxt; cA = nA; cB = nB; ++ui;
#pragma unroll
        for (int h_ = 0; h_ < 2; ++h_)
#pragma unroll
            for (int i_ = 0; i_ < 2; ++i_) vA[h_][i_] = vAn[h_][i_];
        if constexpr (ALIGN_EPI) { if (wr == 1) PG8_BAR; }
    }
    PG8_WAIT_V(0);
    if constexpr (!ALIGN_EPI) { if (wr == 0) PG8_BAR; }
    PG8_BAR;
#undef PG8_SETV
#undef PG8_SA
#undef PG8_SB
#undef PG8_STAGE
#undef PG8_LDA
#undef PG8_LDB
#undef PG8_MMA
#undef PG8_WAIT_V
#undef PG8_WAIT_L
#undef PG8_BAR
#undef PG8_SCHED
}
}
#include <hip/hip_bf16.h>
#include <cmath>
namespace attn_body {
using bf16=__hip_bfloat16;
using s16x4=__attribute__((ext_vector_type(4)))short;
constexpr int D=64,QP=DIN,OP=1024;
constexpr int NW=8,QBLK=32,QB=QBLK*NW,KVBLK=64;
__device__ __forceinline__ int crow(int r,int hi){return (r&3)+8*(r>>2)+4*hi;}
#define SBAR() __builtin_amdgcn_sched_barrier(0)
__device__ __forceinline__ void wmask(f32x16&p0,f32x16&p1,int kq,int hi){
  const float NEG=-INFINITY; const int kb=kq+4*hi;
  #pragma unroll
  for(int r=0;r<16;++r){const int d=kb+(r&3)+8*(r>>2); if(d>128||d<-128)p0[r]=NEG; if(d+32>128||d+32<-128)p1[r]=NEG;}
}

constexpr int NSLOT=3, SLOTB=8192;
constexpr int LDS_K=0, LDS_V=NSLOT*SLOTB, LDS_WS=2*NSLOT*SLOTB, LDS_OST=LDS_WS+NW*64*4, LDS_BYTES=LDS_OST+NW*4096;
constexpr float C2=0.125f*1.4426950408889634f;
__device__ __forceinline__ void glds16(const void*gsrc,unsigned lds_dst){unsigned keep;
  asm volatile("s_mov_b32 %0, m0\n\ts_mov_b32 m0, %2\n\ts_nop 0\n\tglobal_load_lds_dwordx4 %1, off\n\ts_mov_b32 m0, %0":"=&s"(keep):"v"(gsrc),"s"(lds_dst):"memory");}
__device__ __forceinline__ float max3f(float a,float b,float c){float r;asm("v_max3_f32 %0, %1, %2, %3":"=v"(r):"v"(a),"v"(b),"v"(c));return r;}
__device__ __forceinline__ float max2f(float a,float b){float r;asm("v_max_f32_e32 %0, %1, %2":"=v"(r):"v"(a),"v"(b));return r;}
__device__ __forceinline__ float fadd_s(float a,float b){float r;asm("v_add_f32_e32 %0, %1, %2":"=v"(r):"v"(a),"v"(b));return r;}
__device__ __forceinline__ float fsub_s(float a,float b){float r;asm("v_sub_f32_e32 %0, %1, %2":"=v"(r):"v"(a),"v"(b));return r;}
typedef float f32x2_t __attribute__((ext_vector_type(2))); typedef __bf16 bf16x2_t __attribute__((ext_vector_type(2)));
__device__ __forceinline__ unsigned cvtpk_s(float lo,float hi){f32x2_t v={lo,hi};bf16x2_t b=__builtin_convertvector(v,bf16x2_t);return __builtin_bit_cast(unsigned,b);}
#define WAIT_BAR(N) asm volatile("s_waitcnt vmcnt(" #N ") lgkmcnt(0)\n\ts_barrier":::"memory")

__device__ __forceinline__ void qkt(f32x16&p0,f32x16&p1,const char*Kslot,const bf16x8*qr,const f32x16&negm,int r32,int hi){
  const char*kb=Kslot+hi*1024+r32*16;
  #pragma unroll
  for(int d0=0;d0<4;++d0){
    const bf16x8 b0=*reinterpret_cast<const bf16x8*>(kb+d0*2048);
    const bf16x8 b1=*reinterpret_cast<const bf16x8*>(kb+d0*2048+512);
    if(d0==0){p0=__builtin_amdgcn_mfma_f32_32x32x16_bf16(b0,qr[0],negm,0,0,0);p1=__builtin_amdgcn_mfma_f32_32x32x16_bf16(b1,qr[0],negm,0,0,0);}
    else{p0=__builtin_amdgcn_mfma_f32_32x32x16_bf16(b0,qr[d0],p0,0,0,0);p1=__builtin_amdgcn_mfma_f32_32x32x16_bf16(b1,qr[d0],p1,0,0,0);}}
}
typedef __attribute__((address_space(3))) const char* lds_cptr;
typedef short v4i16_t __attribute__((ext_vector_type(4)));
__device__ __forceinline__ void kload8(bf16x8*kf,lds_cptr kp){
  kf[0]=*(const __attribute__((address_space(3))) bf16x8*)(kp);      kf[1]=*(const __attribute__((address_space(3))) bf16x8*)(kp+512);
  kf[2]=*(const __attribute__((address_space(3))) bf16x8*)(kp+2048); kf[3]=*(const __attribute__((address_space(3))) bf16x8*)(kp+2560);
  kf[4]=*(const __attribute__((address_space(3))) bf16x8*)(kp+4096); kf[5]=*(const __attribute__((address_space(3))) bf16x8*)(kp+4608);
  kf[6]=*(const __attribute__((address_space(3))) bf16x8*)(kp+6144); kf[7]=*(const __attribute__((address_space(3))) bf16x8*)(kp+6656);
}
__device__ __forceinline__ void kload2(bf16x8*kf,lds_cptr kp,int j){ kf[2*j]=*(const __attribute__((address_space(3))) bf16x8*)(kp+j*2048); kf[2*j+1]=*(const __attribute__((address_space(3))) bf16x8*)(kp+j*2048+512); }
__device__ __forceinline__ s16x4 vtr(lds_cptr p){ return __builtin_bit_cast(s16x4,__builtin_amdgcn_ds_read_tr16_b64_v4i16((__attribute__((address_space(3))) v4i16_t*)p)); }
__device__ __forceinline__ float rowmax(const f32x16&p0,const f32x16&p1){
  float a=max3f(p0[0],p0[1],p1[0]),b=max3f(p0[2],p0[3],p1[1]);a=max3f(a,p1[2],p1[3]);
  #pragma unroll
  for(int r=4;r<16;r+=4){a=max3f(a,p0[r],p0[r+1]);b=max3f(b,p0[r+2],p0[r+3]);a=max3f(a,p1[r],p1[r+1]);b=max3f(b,p1[r+2],p1[r+3]);}
  const float m=max2f(a,b);
  auto rr=__builtin_amdgcn_permlane32_swap(__float_as_uint(m),__float_as_uint(m),false,false);
  return max2f(__uint_as_float(rr[0]),__uint_as_float(rr[1]));
}
__device__ __forceinline__ void pv(f32x16*o,int vb,bf16x8 pa0,bf16x8 pa1,bf16x8 pa2,bf16x8 pa3){
  #pragma unroll
  for(int d0=0;d0<2;++d0){s16x4 lo[4],hi[4];
    #pragma unroll
    for(int ks=0;ks<4;++ks){
      asm volatile("ds_read_b64_tr_b16 %0,%1 offset:%c2":"=&v"(lo[ks]):"v"(vb),"i"(d0*4096+ks*1024):"memory");
      asm volatile("ds_read_b64_tr_b16 %0,%1 offset:%c2":"=&v"(hi[ks]):"v"(vb),"i"(d0*4096+ks*1024+512):"memory");}
    asm volatile("s_waitcnt lgkmcnt(0)":::"memory");SBAR();
    #define PK(k) (bf16x8){lo[k][0],lo[k][1],lo[k][2],lo[k][3],hi[k][0],hi[k][1],hi[k][2],hi[k][3]}
    o[d0]=__builtin_amdgcn_mfma_f32_32x32x16_bf16(pa0,PK(0),o[d0],0,0,0);
    o[d0]=__builtin_amdgcn_mfma_f32_32x32x16_bf16(pa1,PK(1),o[d0],0,0,0);
    o[d0]=__builtin_amdgcn_mfma_f32_32x32x16_bf16(pa2,PK(2),o[d0],0,0,0);
    o[d0]=__builtin_amdgcn_mfma_f32_32x32x16_bf16(pa3,PK(3),o[d0],0,0,0);
    #undef PK
  }
}

#ifndef ATTN_STORE16
#define ATTN_STORE16(p,v) (*(u32x4*)(p)=(v))
#endif
template<int THRL,bool WIN> __device__ __forceinline__ void attn_unit(const bf16*Qb,const bf16*__restrict__ Kb,const bf16*__restrict__ Vb,bf16*Ob,int q0,int NT,int tdelta,float sink_l2,int tid,char*shm){
  const int lane=tid&63,r32=lane&31,hi=lane>>5; const int wid=__builtin_amdgcn_readfirstlane(tid>>6);
  const bf16*Qw=Qb+(long)(q0+wid*QBLK)*QP;
  const bf16*Kh=Kb,*Vh=Vb;
  const unsigned lds0=(unsigned)(uintptr_t)shm;
  float*wsf=(float*)(shm+LDS_WS)+wid*64;
  const bf16*ksrc=Kh+(long)lane*QP+wid*8;
  const bf16*vsrc=Vh+(long)(16*(wid&3)+(lane>>2))*QP+(wid>>2)*32+(lane&3)*8;
  const unsigned kdst=lds0+LDS_K+wid*1024, vdst=lds0+LDS_V+wid*1024;
  #define TM(t) ((t)<4?(t):(t)+tdelta)
  #define DMA_K(t,slot) glds16(ksrc+(long)TM(t)*KVBLK*QP,(unsigned)__builtin_amdgcn_readfirstlane(kdst+(slot)))
  #define DMA_V(t,slot) glds16(vsrc+(long)TM(t)*KVBLK*QP,(unsigned)__builtin_amdgcn_readfirstlane(vdst+(slot)))
  const int vb0=(int)(lds0+LDS_V)+((lane>>4)&1)*32+(lane&3)*8+(4*hi+((lane&15)>>2))*64;
  const char*Kbase=shm+LDS_K; bf16x8 kf[8];
  const lds_cptr shm3=(lds_cptr)shm; const lds_cptr kp0=shm3+LDS_K+hi*1024+r32*16; const lds_cptr vp0=shm3+LDS_V+((lane>>4)&1)*32+(lane&3)*8+(4*hi+((lane&15)>>2))*64;
  DMA_K(0,0);DMA_V(0,0);DMA_K(1,SLOTB);
  bf16x8 qr[4];
  #pragma unroll
  for(int d0=0;d0<4;++d0)qr[d0]=*reinterpret_cast<const bf16x8*>(&Qw[(long)r32*QP+d0*16+hi*8]);
  float mhat=0.f,l_reg=0.f;float z0_=0.f;asm volatile("":"+v"(z0_));f32x16 o[2];
  #pragma unroll
  for(int r_=0;r_<16;++r_){o[0][r_]=z0_;o[1][r_]=z0_;}
  f32x16 negm;
  #pragma unroll
  for(int r_=0;r_<16;++r_)negm[r_]=z0_;
  asm volatile("":"+v"(negm));
  const int qrow=q0+wid*QBLK+r32;
  #define CMASK(P0,P1,t) do{ if(WIN&&(t)>=4)wmask(P0,P1,TM(t)*KVBLK-qrow,hi); }while(0)
  bool resc=false;
  #define START(P0,P1) do{ const float rm=rowmax(P0,P1); resc=false; \
    { const float dl=rm; mhat=fadd_s(mhat,dl); \
      _Pragma("unroll") for(int r=0;r<16;++r){P0[r]=fsub_s(P0[r],dl);P1[r]=fsub_s(P1[r],dl);} \
      _Pragma("unroll") for(int r=0;r<16;++r)negm[r]=-mhat; asm volatile("":"+v"(negm)); } \
    _Pragma("unroll") for(int r=0;r<16;++r)P0[r]=__builtin_amdgcn_exp2f(P0[r]); }while(0)
  #define RESC() do{ if(resc){ asm volatile("s_waitcnt lgkmcnt(0)":::"memory"); \
      _Pragma("unroll") for(int d_=0;d_<2;++d_) _Pragma("unroll") for(int r=0;r<16;++r)o[d_][r]*=wsf[crow(r,hi)]; } }while(0)
  f32x16 pA0,pA1,pB0,pB1;
  int sl_prev=0,sl_cur=0,sl_next=SLOTB;
  #define ROT() do{sl_prev=sl_cur;sl_cur=sl_next;sl_next=(sl_next==(NSLOT-1)*SLOTB)?0:sl_next+SLOTB;}while(0)
  DMA_K(2,2*SLOTB);
  WAIT_BAR(3);
  qkt(pA0,pA1,Kbase,qr,negm,r32,hi);asm volatile("s_nop 15\n\ts_nop 7":"+v"(pA0),"+v"(pA1));CMASK(pA0,pA1,0);
  START(pA0,pA1);
  _Pragma("unroll") for(int r=0;r<16;++r)pA1[r]=__builtin_amdgcn_exp2f(pA1[r]);
  WAIT_BAR(0);
  DMA_K(3,0);DMA_V(1,SLOTB);
  ROT();
  kload8(kf,kp0+sl_cur);
  WAIT_BAR(2);
  s16x4 vlo[8],vhi[8]; u32x4 pw0,pw1,pw2,pw3;
  #define PKW(P,B) cvtpk_s(P[B],P[B+1])
  #define PAF(k) __builtin_bit_cast(bf16x8,pw##k)
  #define VFR(i) (bf16x8){vlo[i][0],vlo[i][1],vlo[i][2],vlo[i][3],vhi[i][0],vhi[i][1],vhi[i][2],vhi[i][3]}
  #define PIN(x) asm volatile("":"+v"(x))
  #define MX3(a,b,c) __builtin_fmaxf(__builtin_fmaxf((a),(b)),(c))
  #define GAPA(MF,A0,A1,A2,A3,W0,W1,PW) do{ MF; sacc+=A0; sacc+=A1; sacc+=A2; sacc+=A3; PIN(sacc); W0; W1; PIN(PW); SBAR(); }while(0)
  #define EX(v) __builtin_amdgcn_exp2f(v)
  #define GAPB(MF,X,B) do{ MF; X[B]=EX(X[B]); X[B+1]=EX(X[B+1]); X[B+2]=EX(X[B+2]); X[B+3]=EX(X[B+3]); PIN(X); SBAR(); }while(0)
  #define VRD(i) do{ vlo[i]=vtr(vp_+(((i)>>2)*4096+((i)&3)*1024)); vhi[i]=vtr(vp_+(((i)>>2)*4096+((i)&3)*1024+512)); }while(0)
  #define KRD(G,j) do{ if(G){ kload2(kf,kp0+sl_next,j); SBAR(); } }while(0)
  #define STEP(C0,C1,P0,P1,t,GK,GV,GL) do{ SBAR(); \
    const lds_cptr vp_=vp0+sl_prev; \
    VRD(0); SBAR(); float sacc=(P0[0]+P0[1]); \
    GAPA(C0=__builtin_amdgcn_mfma_f32_32x32x16_bf16(kf[0],qr[0],negm,0,0,0), P0[2],P0[3],P0[4],P0[5],     pw0[0]=PKW(P0,0), pw0[1]=PKW(P0,2), pw0); \
    VRD(4); SBAR(); GAPA(C1=__builtin_amdgcn_mfma_f32_32x32x16_bf16(kf[1],qr[0],negm,0,0,0), P0[6],P0[7],P0[8],P0[9],     pw0[2]=PKW(P0,4), pw0[3]=PKW(P0,6), pw0); \
    VRD(1); SBAR(); GAPA(C0=__builtin_amdgcn_mfma_f32_32x32x16_bf16(kf[2],qr[1],C0,0,0,0),   P0[10],P0[11],P0[12],P0[13], pw1[0]=PKW(P0,8), pw1[1]=PKW(P0,10), pw1); \
    VRD(5); SBAR(); GAPA(C1=__builtin_amdgcn_mfma_f32_32x32x16_bf16(kf[3],qr[1],C1,0,0,0),   P0[14],P0[15],P1[0],P1[1],   pw1[2]=PKW(P0,12),pw1[3]=PKW(P0,14), pw1); \
    VRD(2); SBAR(); GAPA(C0=__builtin_amdgcn_mfma_f32_32x32x16_bf16(kf[4],qr[2],C0,0,0,0),   P1[2],P1[3],P1[4],P1[5],     pw2[0]=PKW(P1,0), pw2[1]=PKW(P1,2), pw2); \
    VRD(6); SBAR(); GAPA(C1=__builtin_amdgcn_mfma_f32_32x32x16_bf16(kf[5],qr[2],C1,0,0,0),   P1[6],P1[7],P1[8],P1[9],     pw2[2]=PKW(P1,4), pw2[3]=PKW(P1,6), pw2); \
    VRD(3); SBAR(); GAPA(C0=__builtin_amdgcn_mfma_f32_32x32x16_bf16(kf[6],qr[3],C0,0,0,0),   P1[10],P1[11],P1[12],P1[13], pw3[0]=PKW(P1,8), pw3[1]=PKW(P1,10), pw3); \
    VRD(7); SBAR(); GAPA(C1=__builtin_amdgcn_mfma_f32_32x32x16_bf16(kf[7],qr[3],C1,0,0,0),   P1[14],P1[15],0.f,0.f,       pw3[2]=PKW(P1,12),pw3[3]=PKW(P1,14), pw3); \
    l_reg+=sacc; \
    if(GK){DMA_K((t)+3,sl_cur);} if(GV){DMA_V((t)+1,sl_next);} \
    CMASK(C0,C1,t); \
    { float a=MX3(C0[0],C0[1],C1[0]),b=MX3(C0[2],C0[3],C1[1]); a=MX3(a,C1[2],C1[3]); \
      _Pragma("unroll") for(int r=4;r<16;r+=4){a=MX3(a,C0[r],C0[r+1]);b=MX3(b,C0[r+2],C0[r+3]);a=MX3(a,C1[r],C1[r+1]);b=MX3(b,C1[r+2],C1[r+3]);} \
      float rm=__builtin_fmaxf(a,b); { auto rr=__builtin_amdgcn_permlane32_swap(__float_as_uint(rm),__float_as_uint(rm),false,false); rm=__builtin_fmaxf(__uint_as_float(rr[0]),__uint_as_float(rr[1])); } \
      resc=false; \
      if(__builtin_expect(__any(rm>(float)THRL),0)){ const float dl=__builtin_fmaxf(rm,0.f); mhat+=dl; \
        _Pragma("unroll") for(int r=0;r<16;++r){C0[r]-=dl;C1[r]-=dl;} \
        _Pragma("unroll") for(int r=0;r<16;++r)negm[r]=-mhat; asm volatile("":"+v"(negm)); \
        const float f=__builtin_amdgcn_exp2f(-dl); l_reg*=f; if(hi==0)wsf[r32]=f; resc=true; } } \
    SBAR(); \
    GAPB(o[0]=__builtin_amdgcn_mfma_f32_32x32x16_bf16(PAF(0),VFR(0),o[0],0,0,0), C0,0); \
    GAPB(o[1]=__builtin_amdgcn_mfma_f32_32x32x16_bf16(PAF(0),VFR(4),o[1],0,0,0), C0,4); \
    KRD(GL,0); GAPB(o[0]=__builtin_amdgcn_mfma_f32_32x32x16_bf16(PAF(1),VFR(1),o[0],0,0,0), C0,8); \
    KRD(GL,1); GAPB(o[1]=__builtin_amdgcn_mfma_f32_32x32x16_bf16(PAF(1),VFR(5),o[1],0,0,0), C0,12); \
    KRD(GL,2); GAPB(o[0]=__builtin_amdgcn_mfma_f32_32x32x16_bf16(PAF(2),VFR(2),o[0],0,0,0), C1,0); \
    KRD(GL,3); GAPB(o[1]=__builtin_amdgcn_mfma_f32_32x32x16_bf16(PAF(2),VFR(6),o[1],0,0,0), C1,4); \
    GAPB(o[0]=__builtin_amdgcn_mfma_f32_32x32x16_bf16(PAF(3),VFR(3),o[0],0,0,0), C1,8); \
    GAPB(o[1]=__builtin_amdgcn_mfma_f32_32x32x16_bf16(PAF(3),VFR(7),o[1],0,0,0), C1,12); \
    }while(0)
  int t=1;
  for(;t+5<NT;t+=2){
    STEP(pB0,pB1,pA0,pA1,t,true,true,true);     WAIT_BAR(2); RESC(); ROT();
    STEP(pA0,pA1,pB0,pB1,t+1,true,true,true);   WAIT_BAR(2); RESC(); ROT();
  }
  #define ENDW(tt) do{ if((tt)+3<NT){WAIT_BAR(2);} else if((tt)+2<NT){WAIT_BAR(1);} else {WAIT_BAR(0);} }while(0)
  for(;t+1<NT;t+=2){
    STEP(pB0,pB1,pA0,pA1,t,(t+3<NT),(t+1<NT),(t+1<NT));       ENDW(t);   RESC(); ROT();
    STEP(pA0,pA1,pB0,pB1,t+1,(t+4<NT),(t+2<NT),(t+2<NT));     ENDW(t+1); RESC(); ROT();
  }
  STEP(pB0,pB1,pA0,pA1,NT-1,false,false,false); RESC();
  { float sacc=pB0[0]+pB0[1]; _Pragma("unroll") for(int r=2;r<16;++r)sacc+=pB0[r]; _Pragma("unroll") for(int r=0;r<16;++r)sacc+=pB1[r]; l_reg+=sacc;
    pw0=(u32x4){PKW(pB0,0),PKW(pB0,2),PKW(pB0,4),PKW(pB0,6)};pw1=(u32x4){PKW(pB0,8),PKW(pB0,10),PKW(pB0,12),PKW(pB0,14)};pw2=(u32x4){PKW(pB1,0),PKW(pB1,2),PKW(pB1,4),PKW(pB1,6)};pw3=(u32x4){PKW(pB1,8),PKW(pB1,10),PKW(pB1,12),PKW(pB1,14)};
    SBAR(); pv(o,vb0+sl_cur,PAF(0),PAF(1),PAF(2),PAF(3)); }
  #undef PKW
  #undef PAF
  #undef VFR
  #undef PIN
  #undef MX3
  #undef GAPA
  #undef GAPB
  #undef EX
  #undef VRD
  #undef KRD
  #undef STEP
  #undef ENDW
  {auto rr=__builtin_amdgcn_permlane32_swap(__float_as_uint(l_reg),__float_as_uint(l_reg),false,false);l_reg=__uint_as_float(rr[0])+__uint_as_float(rr[1]);}
  if(WIN)l_reg+=__builtin_amdgcn_exp2f(sink_l2-mhat);
  if(hi==0)wsf[32+r32]=l_reg;asm volatile("s_waitcnt lgkmcnt(0)":::"memory");
  float rli[16];
  #pragma unroll
  for(int r=0;r<16;++r)rli[r]=__builtin_amdgcn_rcpf(wsf[32+crow(r,hi)]);
  bf16*Ow=Ob+(long)(q0+wid*QBLK)*OP;
  { bf16*stg=(bf16*)(shm+LDS_OST)+wid*2048;
    #pragma unroll
    for(int r=0;r<16;++r){const int orow=crow(r,hi);
      #pragma unroll
      for(int d0=0;d0<2;++d0)stg[orow*64+d0*32+r32]=__float2bfloat16(o[d0][r]*rli[r]);}
    asm volatile("s_waitcnt lgkmcnt(0)":::"memory");
    #pragma unroll
    for(int i=0;i<4;++i){const int row=i*8+(lane>>3),ch=lane&7; const u32x4 v=*(const u32x4*)(stg+row*64+ch*8); ATTN_STORE16(Ow+(long)row*OP+ch*8,v);} }
  asm volatile("s_waitcnt lgkmcnt(0)\n\ts_barrier":::"memory");
  #undef TM
  #undef DMA_K
  #undef DMA_V
  #undef CMASK
  #undef START
  #undef RESC
  #undef ROT
}
constexpr int ATTN_LDS_BYTES=LDS_BYTES;
#undef SBAR
#undef WAIT_BAR
}
#define XB_TMO      128
#define XB_XCNT(j)  (256  + 64 * (j))
#define XB_XSUB(j)  (1280 + 64 * (j))
#define XB_XGEN(j)  (2304 + 64 * (j))
#define XB_TOP      3328
#define XB_TOPGEN   3392
#define XCD_BAR_WORDS 3456
#define XB_SPIN_CAP (1u << 21)

__device__ __forceinline__ unsigned xb_ld(unsigned* p)              { return __hip_atomic_load(p, __ATOMIC_RELAXED, __HIP_MEMORY_SCOPE_AGENT); }
__device__ __forceinline__ unsigned xb_add(unsigned* p, unsigned v) { return __hip_atomic_fetch_add(p, v, __ATOMIC_RELAXED, __HIP_MEMORY_SCOPE_AGENT); }
__device__ __forceinline__ unsigned xb_xcc_id() { return (unsigned)__builtin_amdgcn_s_getreg((3 << 11) | 20) & 0xFu; }
#define XB_SPIN(cond, bar) do { unsigned _sp = 0; while (cond) { __builtin_amdgcn_s_sleep(1); \
    if ((++_sp & 255u) == 0u) { if (xb_ld(&(bar)[XB_TMO])) break; if (_sp > XB_SPIN_CAP) { atomicAdd(&(bar)[XB_TMO], 1u); break; } } } } while (0)

struct XcdBarrier {
    unsigned* bar; unsigned x;
    volatile LAS unsigned* st;
};

__device__ __forceinline__ XcdBarrier xcd_barrier_post(unsigned* bar, volatile LAS unsigned* st) {
    XcdBarrier b; b.bar = bar; b.x = xb_xcc_id(); b.st = st;
    if (threadIdx.x == 0) (void)xb_add(&bar[XB_XCNT(b.x)], 1u);
    return b;
}
__device__ __forceinline__ void xcd_barrier_complete(unsigned* bar, unsigned x, unsigned& nloc, unsigned& nx) {
    const unsigned G = gridDim.x * gridDim.y * gridDim.z;
    unsigned sum, cnt, mine, sp = 0u;
    for (;;) {
        sum = 0u; cnt = 0u; mine = 0u;
#pragma unroll
        for (unsigned j = 0; j < 16; ++j) { const unsigned c = xb_ld(&bar[XB_XCNT(j)]); sum += c; cnt += (c > 0u) ? 1u : 0u; mine = (j == x) ? c : mine; }
        if (sum == G) break;
        __builtin_amdgcn_s_sleep(1);
        if ((++sp & 255u) == 0u) { if (xb_ld(&bar[XB_TMO])) break; if (sp > XB_SPIN_CAP) { atomicAdd(&bar[XB_TMO], 1u); break; } }
    }
    nloc = mine > 0u ? mine : 1u; nx = cnt > 0u ? cnt : 1u;
}

__device__ __forceinline__ void xcd_barrier(const XcdBarrier& b) {
    asm volatile("s_waitcnt vmcnt(0)" ::: "memory");
    __syncthreads();
    if (threadIdx.x == 0) {
        unsigned* bar = b.bar; unsigned bx_ = b.x; asm volatile("" : "+s"(bar), "+s"(bx_));
        __builtin_amdgcn_s_waitcnt(0);
        unsigned nloc = b.st[0], nx = b.st[1];
        if (nloc == 0u) { xcd_barrier_complete(bar, bx_, nloc, nx); b.st[0] = nloc; b.st[1] = nx; }
        const unsigned old = xb_add(&bar[XB_XSUB(bx_)], 1u);
        const unsigned gen = old / nloc;
        if (old + 1u == (gen + 1u) * nloc) {
            __builtin_amdgcn_fence(__ATOMIC_RELEASE, "agent");
            asm volatile("s_waitcnt vmcnt(0)" ::: "memory");
            const unsigned og = xb_add(&bar[XB_TOP], 1u);
            const unsigned tg = og / nx;
            if (og + 1u == (tg + 1u) * nx) xb_add(&bar[XB_TOPGEN], 1u);
            else XB_SPIN(xb_ld(&bar[XB_TOPGEN]) == tg, bar);
            __builtin_amdgcn_fence(__ATOMIC_ACQUIRE, "agent");
            xb_add(&bar[XB_XGEN(bx_)], 1u);
            asm volatile("s_waitcnt vmcnt(0)" ::: "memory");
        } else {
            XB_SPIN(xb_ld(&bar[XB_XGEN(bx_)]) == gen, bar);
            __builtin_amdgcn_fence(__ATOMIC_ACQUIRE, "agent");
            asm volatile("s_waitcnt vmcnt(0)" ::: "memory");
        }
    }
    __syncthreads();
}

#ifndef CVQ0
#define CVQ0 3
#define CVQ1 4
#define CVQ2 3
#define CVQ3 3
#endif
constexpr size_t alup(size_t x) { return (x + 4095) & ~(size_t)4095; }
constexpr size_t CTL_BYTES = 1u << 20;
constexpr size_t SZ_WIN = (size_t)DEPTH * DIN * DM * 2, SZ_WOUT = (size_t)DEPTH * DM * DM * 2, SZ_WGU = (size_t)DEPTH * NE * 2 * FF * DM  , SZ_WDN = (size_t)DEPTH * NE * DM * FF  ;
constexpr size_t SZ_MODP = (size_t)DEPTH * 16 * 17 * 6144 * 4, SZ_MOD = (size_t)DEPTH * 17 * 6144 * 4;
constexpr size_t SZ_X32 = (size_t)MROWS * DM * 2  , SZ_H = (size_t)MROWS * DM * 2, SZ_P = (size_t)MROWS * DIN * 2, SZ_Y = (size_t)MROWS * DM * 2, SZ_YP = (size_t)MROWS * 2 * DM  ;
constexpr size_t SZ_LIST = (size_t)NE * MROWS * 4, SZ_GW = (size_t)MROWS * 2 * 4;
constexpr int MAXBLK = (MROWS * 2) / 256 + NE;
static_assert((size_t)MAXBLK * 256 * FF * 2 <= SZ_P, "HMID overlays P");
static_assert((size_t)2 * NB * 4 * NCH * 128 * 64 * 4 <= SZ_H, "KVT overlays H");
static_assert((size_t)2 * NB * 4 * NCH * 128 * 64 * 2 <= SZ_YP, "ST overlays YP");
constexpr size_t WS_CTL = 0;
constexpr size_t WS_WIN = CTL_BYTES, WS_WOUT = WS_WIN + alup(SZ_WIN), WS_WGU = WS_WOUT + alup(SZ_WOUT), WS_WDN = WS_WGU + alup(SZ_WGU);
constexpr size_t WS_MODP = WS_WDN + alup(SZ_WDN), WS_MOD = WS_MODP + alup(SZ_MODP);
constexpr size_t WS_X32 = WS_MOD + alup(SZ_MOD), WS_H = WS_X32 + alup(SZ_X32), WS_P = WS_H + alup(SZ_H), WS_Y = WS_P + alup(SZ_P), WS_YP = WS_Y + alup(SZ_Y);
constexpr size_t WS_LIST = WS_YP + alup(SZ_YP), WS_GW = WS_LIST + alup(SZ_LIST), WS_END = WS_GW + alup(SZ_GW);
constexpr int CW_BAR = 4096;
constexpr int CW_CNT = 16384;

constexpr int RING_BYTES = 131072;
constexpr int LDSCTL_OFF = RING_BYTES;
constexpr int LDS_BYTES = 147456;

#define ATTN_STORE16(p,v) (*(u32x4*)(p)=(v))

#define CAS __attribute__((address_space(4)))
__device__ __forceinline__ const float* inp(int i) {
    const CAS unsigned char* k = (const CAS unsigned char*)__builtin_amdgcn_kernarg_segment_ptr();
    asm volatile("" : "+s"(k));
    return *(const float* const CAS*)(k + 8 * i);
}
#define CBAR() do { asm volatile("" ::: "memory"); __builtin_amdgcn_sched_barrier(0); } while (0)
struct Ctx {
    float* out; unsigned char* ws;
    __device__ __forceinline__ const float* x() const { return inp(0); }
    __device__ __forceinline__ const float* c() const { return inp(1); }
    __device__ __forceinline__ const float* ctx() const { return inp(2); }
    __device__ __forceinline__ const float* c_ctx() const { return inp(3); }
    __device__ __forceinline__ const float* ada_w() const { return inp(4); }
    __device__ __forceinline__ const float* ada_b() const { return inp(5); }
    __device__ __forceinline__ const float* norm1() const { return inp(6); }
    __device__ __forceinline__ const float* norm2() const { return inp(7); }
    __device__ __forceinline__ const float* w_in() const { return inp(8); }
    __device__ __forceinline__ const float* w_out() const { return inp(9); }
    __device__ __forceinline__ const float* ret_decay() const { return inp(10); }
    __device__ __forceinline__ const float* win_gain() const { return inp(11); }
    __device__ __forceinline__ const float* win_sink() const { return inp(12); }
    __device__ __forceinline__ const float* glb_gain() const { return inp(13); }
    __device__ __forceinline__ const float* w_router() const { return inp(14); }
    __device__ __forceinline__ const float* b_router() const { return inp(15); }
    __device__ __forceinline__ const float* w_gu() const { return inp(16); }
    __device__ __forceinline__ const float* w_dn() const { return inp(17); }
};

template <int CTRL> __device__ __forceinline__ float dppx(float v) { return __builtin_bit_cast(float, __builtin_amdgcn_update_dpp(0, __builtin_bit_cast(int, v), CTRL, 0xF, 0xF, true)); }
__device__ __forceinline__ float xor1(float v) { return dppx<0xB1>(v); }
__device__ __forceinline__ float xor2(float v) { return dppx<0x4E>(v); }
__device__ __forceinline__ float wave_sum(float v) {
    v += dppx<0xB1>(v); v += dppx<0x4E>(v); v += dppx<0x141>(v); v += dppx<0x140>(v);
    { const unsigned u = __builtin_bit_cast(unsigned, v); auto r = __builtin_amdgcn_permlane16_swap(u, u, false, false); v = __builtin_bit_cast(float, (unsigned)r[0]) + __builtin_bit_cast(float, (unsigned)r[1]); }
    { const unsigned u = __builtin_bit_cast(unsigned, v); auto r = __builtin_amdgcn_permlane32_swap(u, u, false, false); v = __builtin_bit_cast(float, (unsigned)r[0]) + __builtin_bit_cast(float, (unsigned)r[1]); }
    return v;
}
__device__ __forceinline__ float xor16(float v, int lane) { const unsigned u = __builtin_bit_cast(unsigned, v); auto r = __builtin_amdgcn_permlane16_swap(u, u, false, false);
    return __builtin_bit_cast(float, (lane & 16) ? (unsigned)r[0] : (unsigned)r[1]); }
__device__ __forceinline__ float silu_f(float v) { return v * __builtin_amdgcn_rcpf(1.f + __builtin_amdgcn_exp2f(-LOG2E * v)); }
__device__ __forceinline__ float log2_sigmoid(float x) { return -log1pf(expf(-x)) * LOG2E; }

__device__ __forceinline__ void transpose_item(const float* W, int N, int nsrc0, int k0, bf16_t* WT, int K, int nrow0, LAS float* scr, int lane) {
    float ld_[32];
#pragma unroll
    for (int i = 0; i < 32; ++i) ld_[i] = W[(size_t)(k0 + 2 * i + (lane >> 5)) * N + nsrc0 + (lane & 31)];
#pragma unroll
    for (int i = 0; i < 32; ++i) scr[(2 * i + (lane >> 5)) * 33 + (lane & 31)] = ld_[i];
    asm volatile("s_waitcnt lgkmcnt(0)" ::: "memory");
    const int c = lane & 7;
#pragma unroll
    for (int j = 0; j < 4; ++j) { const int n = (lane >> 3) + 8 * j; const LAS float* s = scr + (8 * c) * 33 + n;
        u32x4 o; o.x = pk2(s[0 * 33], s[1 * 33]); o.y = pk2(s[2 * 33], s[3 * 33]); o.z = pk2(s[4 * 33], s[5 * 33]); o.w = pk2(s[6 * 33], s[7 * 33]);
        *(u32x4*)(WT + (size_t)(nrow0 + n) * K + k0 + 8 * c) = o; }
    asm volatile("s_waitcnt lgkmcnt(0)" ::: "memory");
}
__device__ __forceinline__ unsigned pk4_fp8(float a, float b, float c, float d) { int w = 0; w = __builtin_amdgcn_cvt_pk_fp8_f32(a, b, w, false); w = __builtin_amdgcn_cvt_pk_fp8_f32(c, d, w, true); return (unsigned)w; }
__device__ __forceinline__ f32x4 fp8x4_f32(unsigned w) { typedef float f2_ __attribute__((ext_vector_type(2))); const f2_ lo = __builtin_amdgcn_cvt_pk_f32_fp8((int)w, false), hi = __builtin_amdgcn_cvt_pk_f32_fp8((int)w, true); return (f32x4){lo[0], lo[1], hi[0], hi[1]}; }
constexpr float YP_SCALE = 16.0f, YP_INV = 1.0f / 16.0f;
constexpr float W8_SCALE = 64.0f, W8_INV = 1.0f / 64.0f;
__device__ __forceinline__ void transpose_item8(const float* W, int N, int nsrc0, int k0, unsigned char* WT, int K, int nrow0, LAS float* scr, int lane) {
    float ld_[32];
#pragma unroll
    for (int i = 0; i < 32; ++i) ld_[i] = W[(size_t)(k0 + 2 * i + (lane >> 5)) * N + nsrc0 + (lane & 31)];
#pragma unroll
    for (int i = 0; i < 32; ++i) scr[(2 * i + (lane >> 5)) * 33 + (lane & 31)] = ld_[i];
    asm volatile("s_waitcnt lgkmcnt(0)" ::: "memory");
    const int c = lane & 7;
#pragma unroll
    for (int j = 0; j < 4; ++j) { const int n = (lane >> 3) + 8 * j; const LAS float* s = scr + (8 * c) * 33 + n;
        u32x2 o; o.x = pk4_fp8(s[0 * 33] * W8_SCALE, s[1 * 33] * W8_SCALE, s[2 * 33] * W8_SCALE, s[3 * 33] * W8_SCALE); o.y = pk4_fp8(s[4 * 33] * W8_SCALE, s[5 * 33] * W8_SCALE, s[6 * 33] * W8_SCALE, s[7 * 33] * W8_SCALE);
        *(u32x2*)(WT + (size_t)(nrow0 + n) * K + k0 + 8 * c) = o; }
    asm volatile("s_waitcnt lgkmcnt(0)" ::: "memory");
}
constexpr int IT_WIN = 16 * 80, IT_WOUT = 16 * 32, IT_GU = 16 * 64, IT_DN = 16 * 32, IT_LAYER = IT_WIN + IT_WOUT + NE * (IT_GU + IT_DN);
__device__ __forceinline__ void convert_item(const Ctx& C, int l, int r, LAS float* scr, int lane) {
    if (r < IT_WIN) { const int kb = r / 80, nb = r % 80;
        transpose_item(C.w_in() + (size_t)l * DM * DIN, DIN, 32 * nb, 64 * kb, (bf16_t*)(C.ws + WS_WIN) + (size_t)l * DIN * DM, DM, 32 * nb, scr, lane); return; }
    r -= IT_WIN;
    if (r < IT_WOUT) { const int kb = r / 32, nb = r % 32;
        transpose_item(C.w_out() + (size_t)l * DM * DM, DM, 32 * nb, 64 * kb, (bf16_t*)(C.ws + WS_WOUT) + (size_t)l * DM * DM, DM, 32 * nb, scr, lane); return; }
    r -= IT_WOUT;
    if (r < NE * IT_GU) { const int e = r / IT_GU, q = r % IT_GU, kb = q / 64, nb = q % 64;
        const int np = 32 * nb, tile = np >> 8, within = np & 255, nsrc = within < 128 ? tile * 128 + within : FF + tile * 128 + within - 128;
        transpose_item8(C.w_gu() + (size_t)(l * NE + e) * DM * 2 * FF, 2 * FF, nsrc, 64 * kb, (unsigned char*)(C.ws + WS_WGU) + (size_t)(l * NE + e) * 2 * FF * DM, DM, np, scr, lane); return; }
    r -= NE * IT_GU;
    { const int e = r / IT_DN, q = r % IT_DN, kb = q / 32, nb = q % 32;
        transpose_item8(C.w_dn() + (size_t)(l * NE + e) * FF * DM, DM, 32 * nb, 64 * kb, (unsigned char*)(C.ws + WS_WDN) + (size_t)(l * NE + e) * DM * FF, FF, 32 * nb, scr, lane); }
}
__device__ __forceinline__ int cv_lo(int p) { return p == 0 ? 0 : p == 1 ? 3840 : p == 2 ? 13056 : p == 3 ? 19712 : IT_LAYER; }
__device__ __forceinline__ int cv_q(int p) { return p == 0 ? CVQ0 : p == 1 ? CVQ1 : p == 2 ? CVQ2 : CVQ3; }
__device__ __forceinline__ int cv_covered(int p, int units, int G) { const int rem = units % G; if (rem == 0) return 0; const int n = (G - rem) * 8 * cv_q(p), len = cv_lo(p + 1) - cv_lo(p); return n < len ? n : len; }
__device__ __forceinline__ void convert_tail(const Ctx& C, int lnext, int p, int units, int G, int c, LAS unsigned char* lds, int wave, int lane) {
    const int rem = units % G; if (rem == 0 || c < rem) return;
    const int nidle = G - rem, k = c - rem, lo = cv_lo(p), hi = cv_lo(p + 1);
    LAS float* scr = (LAS float*)(lds + wave * 16384);
    for (int j = 0; j < cv_q(p); ++j) { const int it = lo + (j * nidle + k) * 8 + wave; if (it < hi) convert_item(C, lnext, it, scr, lane); }
}
__device__ __forceinline__ void convert_rest(const Ctx& C, int l, int G, int vcu, LAS unsigned char* lds, int wave, int lane, int units2, int units3) {
    LAS float* scr = (LAS float*)(lds + wave * 16384);
    const int gw = vcu * 8 + wave, NGW = G * 8;
    const int lo0 = cv_lo(0) + cv_covered(0, (MROWS / 256) * (DIN / 256), G), lo1 = cv_lo(1) + cv_covered(1, (MROWS / 256) * (DM / 256), G), lo2 = cv_lo(2) + cv_covered(2, units2, G), lo3 = cv_lo(3) + cv_covered(3, units3, G);
    const int n0 = cv_lo(1) - lo0, n1 = cv_lo(2) - lo1, n2 = cv_lo(3) - lo2, n3 = cv_lo(4) - lo3;
    for (int v = gw; v < n0 + n1 + n2 + n3; v += NGW) { int r = v, it;
        if (r < n0) it = lo0 + r; else { r -= n0; if (r < n1) it = lo1 + r; else { r -= n1; if (r < n2) it = lo2 + r; else it = lo3 + (r - n2); } }
        convert_item(C, l, it, scr, lane); }
}
__device__ __forceinline__ void phase_prologue(const Ctx& C, LAS unsigned char* lds, int G, int vcu, int bx, int tid) {
    const int lane = tid & 63, wave = tid >> 6;
    {
        LAS float* scs = (LAS float*)lds;
        bool have = false;
        for (int it = bx; it < DEPTH * 12 * 16; it += G) {
            if (!have) {
                for (int i = tid; i < 17 * DM; i += 512) { const int r = i >> 10, k = i & 1023; const float v = r < 16 ? C.c()[r * DM + k] : C.c_ctx()[k]; scs[i] = v / (1.f + expf(-v)); }
                __syncthreads(); have = true;
            }
            const int l = it / 192, rem = it % 192, cb = rem / 16, kc = rem % 16;
            const float* w = C.ada_w() + ((size_t)l * DM + kc * 64) * 6144 + cb * 512 + tid;
            float acc[17];
#pragma unroll
            for (int r = 0; r < 17; ++r) acc[r] = 0.f;
#pragma unroll 4
            for (int kk = 0; kk < 64; ++kk) { const float wv = w[(size_t)kk * 6144];
#pragma unroll
                for (int r = 0; r < 17; ++r) acc[r] += scs[r * DM + kc * 64 + kk] * wv; }
            float* mp = (float*)(C.ws + WS_MODP) + ((size_t)(l * 16 + kc) * 17) * 6144 + cb * 512 + tid;
#pragma unroll
            for (int r = 0; r < 17; ++r) mp[(size_t)r * 6144] = acc[r];
        }
        __syncthreads();
    }
    LAS float* scr = (LAS float*)(lds + wave * 16384);
    const int gw = vcu * 8 + wave, NGW = G * 8;
    for (int it = gw; it < IT_LAYER; it += NGW) convert_item(C, 0, it, scr, lane);
}
__device__ __forceinline__ void phase_modsum(const Ctx& C, int G, int bx, int tid) {
    const float* mp = (const float*)(C.ws + WS_MODP); float* mod = (float*)(C.ws + WS_MOD);
    for (int i = bx * 512 + tid; i < DEPTH * 17 * 6144; i += G * 512) {
        const int l = i / (17 * 6144), rem = i % (17 * 6144), r = rem / 6144, n = rem % 6144;
        float s = C.ada_b()[l * 6144 + n];
#pragma unroll
        for (int kc = 0; kc < 16; ++kc) s += mp[((size_t)(l * 16 + kc) * 17 + r) * 6144 + n];
        mod[i] = s;
    }
}

__device__ __forceinline__ f32x4 bf4(u32x2 a) { return (f32x4){bflo(a.x), bfhi(a.x), bflo(a.y), bfhi(a.y)}; }
__device__ __forceinline__ u32x2 pk4(f32x4 v) { u32x2 w; w.x = pk2(v[0], v[1]); w.y = pk2(v[2], v[3]); return w; }
__device__ __forceinline__ void phase_norm1(const Ctx& C, int layer, int gw, int NGW, int lane, bf16_t* XO) {
    const float* mod = (const float*)(C.ws + WS_MOD) + (size_t)layer * 17 * 6144;
    const float* gain = C.norm1() + layer * DM;
    bf16_t* XR = (bf16_t*)(C.ws + WS_X32); bf16_t* H = (bf16_t*)(C.ws + WS_H); const unsigned char* YP = (const unsigned char*)(C.ws + WS_YP);
    const float* xin = C.x(); const float* cin = C.ctx();
    f32x4 nx[4]; u32x2 nr[4]; unsigned na[4], nb[4];
#define N1_LOAD(mm) do { const int b_ = (mm) / TPB, t_ = (mm) - b_ * TPB; \
        if (layer == 0) { const f32x4* s_ = (const f32x4*)(t_ < CTX ? cin + ((size_t)b_ * CTX + t_) * DM : xin + ((size_t)b_ * SEQ + (t_ - CTX)) * DM) + lane; \
            _Pragma("unroll") for (int j = 0; j < 4; ++j) nx[j] = s_[64 * j]; } \
        else { const u32x2* s_ = (const u32x2*)(XR + (size_t)(mm) * DM) + lane; const unsigned* y0_ = (const unsigned*)(YP + (size_t)(mm) * 2 * DM) + lane; \
            _Pragma("unroll") for (int j = 0; j < 4; ++j) { nr[j] = s_[64 * j]; na[j] = y0_[64 * j]; nb[j] = y0_[DM / 4 + 64 * j]; } } } while (0)
    if (gw < MROWS) N1_LOAD(gw);
    for (int m = gw; m < MROWS; m += NGW) {
        const int b = m / TPB, t = m - b * TPB, set = t < CTX ? 16 : b;
        f32x4 v[4];
        if (layer == 0) {
#pragma unroll
            for (int j = 0; j < 4; ++j) v[j] = nx[j];
        } else {
            const f32x4* g2 = (const f32x4*)(mod - 17 * 6144 + (size_t)set * 6144 + 5 * DM) + lane;
#pragma unroll
            for (int j = 0; j < 4; ++j) v[j] = bf4(nr[j]) + (g2[64 * j] * YP_INV) * (fp8x4_f32(na[j]) + fp8x4_f32(nb[j]));
        }
        if (m + NGW < MROWS) N1_LOAD(m + NGW);
        u32x2* xo = (u32x2*)(XO + (size_t)m * DM) + lane;
        float ss = 0.f;
#pragma unroll
        for (int j = 0; j < 4; ++j) { xo[64 * j] = pk4(v[j]); ss += (v[j][0] * v[j][0] + v[j][1] * v[j][1]) + (v[j][2] * v[j][2] + v[j][3] * v[j][3]); }
        const float rstd = 1.0f / sqrtf(wave_sum(ss) * (1.f / DM) + EPS);
        const f32x4* gp = (const f32x4*)gain + lane; const f32x4* shp = (const f32x4*)(mod + (size_t)set * 6144) + lane; const f32x4* scp = shp + DM / 4;
        u32x2* ho = (u32x2*)(H + (size_t)m * DM) + lane;
#pragma unroll
        for (int j = 0; j < 4; ++j) ho[64 * j] = pk4((v[j] * rstd) * gp[64 * j] * (scp[64 * j] + 1.0f) + shp[64 * j]);
    }
#undef N1_LOAD
}

__device__ __forceinline__ float swz_xor4(float v) { return __builtin_bit_cast(float, __builtin_amdgcn_ds_swizzle(__builtin_bit_cast(int, v), 0x101F)); }
__device__ __forceinline__ float swz_xor8(float v) { return __builtin_bit_cast(float, __builtin_amdgcn_ds_swizzle(__builtin_bit_cast(int, v), 0x201F)); }
__device__ __forceinline__ void phase_qkprep(const Ctx& C, int layer, int gw, int NGW, int lane, bf16_t* PO) {
    const bf16_t* P = (const bf16_t*)(C.ws + WS_P);
    const int hs = lane >> 3, j = lane & 7;
    const int col0 = (hs < 4 ? C_WQ + 64 * hs : hs < 6 ? C_WK + 64 * (hs - 4) : C_GQ + 64 * (hs - 6)) + 8 * j;
    const int col1 = (hs < 2 ? C_GQ + 128 + 64 * hs : C_GK + 64 * ((hs - 2) & 1)) + 8 * j;
    float g0[8], g1[8], inv[8];
    { const float* wg = C.win_gain() + layer * 128; const float* gg = C.glb_gain() + layer * 128;
      const float* s0p = hs < 4 ? wg : hs < 6 ? wg + 64 : gg; const float sc0 = (hs < 4 || hs >= 6) ? QSCALE : 1.f;
      const float* s1p = hs < 2 ? gg : gg + 64; const float sc1 = hs < 2 ? QSCALE : 1.f;
#pragma unroll
      for (int i = 0; i < 8; ++i) { g0[i] = s0p[8 * j + i] * sc0; g1[i] = s1p[8 * j + i] * sc1; inv[i] = exp2f(-(float)(8 * (j & 1) + i) * (13.287712379549449f / 16.0f)); } }
    const bool x2 = (j & 2) != 0, colax = (j & 4) != 0, act1 = lane < 32;
    u32x4 w0 = {0u, 0u, 0u, 0u}, w1 = {0u, 0u, 0u, 0u};
    if (gw < MROWS) { const bf16_t* row = P + (size_t)gw * DIN; w0 = *(const u32x4*)(row + col0); if (act1) w1 = *(const u32x4*)(row + col1); }
    for (int m = gw; m < MROWS; m += NGW) {
        const u32x4 c0 = w0, c1 = w1;
        if (m + NGW < MROWS) { const bf16_t* row = P + (size_t)(m + NGW) * DIN; w0 = *(const u32x4*)(row + col0); if (act1) w1 = *(const u32x4*)(row + col1); }
        const int b = m / TPB, t = m - b * TPB; const bool isx = t >= CTX; const int pos = t - CTX;
        float cs[8], sn[8];
        if (isx) { const float pv = (float)(colax ? (pos & 63) : (pos >> 6));
#pragma unroll
            for (int i = 0; i < 8; ++i) { const float ang = pv * inv[i]; cs[i] = __cosf(ang); sn[i] = x2 ? __sinf(ang) : -__sinf(ang); } }
        else {
#pragma unroll
            for (int i = 0; i < 8; ++i) { cs[i] = 1.f; sn[i] = 0.f; } }
        bf16_t* orow = PO + (size_t)m * (PO == P ? DIN : 256);
#pragma unroll
        for (int pass = 0; pass < 2; ++pass) {
            const u32x4 w = pass ? c1 : c0;
            float x[8] = {bflo(w.x), bfhi(w.x), bflo(w.y), bfhi(w.y), bflo(w.z), bfhi(w.z), bflo(w.w), bfhi(w.w)};
            float ss = 0.f;
#pragma unroll
            for (int i = 0; i < 8; ++i) ss += x[i] * x[i];
            ss += xor1(ss); ss += xor2(ss); ss += swz_xor4(ss);
            const float r = 1.0f / sqrtf(ss * (1.f / 64.f) + EPS);
            float y[8];
#pragma unroll
            for (int i = 0; i < 8; ++i) { x[i] = x[i] * r * (pass ? g1[i] : g0[i]); }
#pragma unroll
            for (int i = 0; i < 8; ++i) { const float pr = xor2(x[i]); y[i] = x[i] * cs[i] + pr * sn[i]; }
            u32x4 o; o.x = pk2(y[0], y[1]); o.y = pk2(y[2], y[3]); o.z = pk2(y[4], y[5]); o.w = pk2(y[6], y[7]);
            const int col = pass ? col1 : col0;
            if (pass == 0 || act1) *(u32x4*)(orow + (PO == P ? col : (col & 127))) = o;
        }
    }
}

__device__ __forceinline__ unsigned off_v(unsigned row, unsigned ch) { return 256u * row + 16u * (ch ^ (((row & 3) << 2) | ((row >> 2) & 3))); }
__device__ __forceinline__ unsigned off_k(unsigned row, unsigned ch) { return 128u * row + 16u * (ch ^ (row & 7)); }
typedef short s16x4_t __attribute__((ext_vector_type(4)));
__device__ __forceinline__ s16x4_t tr_rd(const LAS unsigned char* p) { return __builtin_bit_cast(s16x4_t, __builtin_amdgcn_ds_read_tr16_b64_v4i16((LAS s16x4_t*)p)); }
template <bool KIMG> __device__ __forceinline__ bf16x8 tr_frag(const LAS unsigned char* img, int lane, int rbase, int r0off, int r1off, int cblk) {
    const unsigned blk = (lane >> 4) & 1, q = (lane & 15) >> 2, pp = lane & 3, ch = 4 * cblk + 2 * blk + (pp >> 1);
    const unsigned ra = rbase + r0off + q, rb = rbase + r1off + q;
    const s16x4_t lo = tr_rd(img + (KIMG ? off_k(ra, ch) : off_v(ra, ch)) + 8 * (pp & 1)), hi = tr_rd(img + (KIMG ? off_k(rb, ch) : off_v(rb, ch)) + 8 * (pp & 1));
    return (bf16x8){lo[0], lo[1], lo[2], lo[3], hi[0], hi[1], hi[2], hi[3]};
}
__device__ __forceinline__ void stage_v(const bf16_t* P, size_t r0, int h, LAS unsigned char* img, int tid) {
#pragma unroll
    for (int i = 0; i < 4; ++i) { const int p_ = tid + 512 * i, j = p_ >> 4, ch = p_ & 15;
        *(LAS u32x4*)(img + off_v(j, ch)) = *(const u32x4*)(P + (r0 + j) * DIN + C_RV + h * 128 + 8 * ch); }
}
__device__ __forceinline__ void ret_r1_unit(const Ctx& C, int layer, int b, int h, int c, LAS unsigned char* lds, int tid) {
    const int lane = tid & 63, wid = tid >> 6;
    const bf16_t* P = (const bf16_t*)(C.ws + WS_P); float* KVT = (float*)(C.ws + WS_H);
    LAS unsigned char* Vi = lds; LAS unsigned char* Kf = lds + 32768; LAS unsigned char* Kb = lds + 49152;
    const float* dec = C.ret_decay(); const float lf = log2_sigmoid(dec[(layer * 2 + 0) * 4 + h]), lb = log2_sigmoid(dec[(layer * 2 + 1) * 4 + h]);
    const size_t r0 = (size_t)b * TPB + c * 128;
#pragma unroll
    for (int i = 0; i < 2; ++i) { const int p_ = tid + 512 * i, j = p_ >> 3, ch = p_ & 7;
        const u32x4 w = *(const u32x4*)(P + (r0 + j) * DIN + C_RK + h * 64 + 8 * ch);
        const float zf = exp2f((float)(127 - j) * lf) * 0.125f, zb = exp2f((float)j * lb) * 0.125f;
        const float x[8] = {bflo(w.x), bfhi(w.x), bflo(w.y), bfhi(w.y), bflo(w.z), bfhi(w.z), bflo(w.w), bfhi(w.w)};
        u32x4 of, ob; of.x = pk2(x[0] * zf, x[1] * zf); of.y = pk2(x[2] * zf, x[3] * zf); of.z = pk2(x[4] * zf, x[5] * zf); of.w = pk2(x[6] * zf, x[7] * zf);
        ob.x = pk2(x[0] * zb, x[1] * zb); ob.y = pk2(x[2] * zb, x[3] * zb); ob.z = pk2(x[4] * zb, x[5] * zb); ob.w = pk2(x[6] * zb, x[7] * zb);
        *(LAS u32x4*)(Kf + off_k(j, ch)) = of; *(LAS u32x4*)(Kb + off_k(j, ch)) = ob; }
    stage_v(P, r0, h, Vi, tid);
    __syncthreads();
    const int mb = wid >> 1, nb = wid & 1, r = lane & 31, hh = lane >> 5;
    float z0 = 0.f; asm volatile("" : "+v"(z0)); f32x16 af, ab;
#pragma unroll
    for (int i = 0; i < 16; ++i) { af[i] = z0; ab[i] = z0; }
#pragma unroll
    for (int ks = 0; ks < 8; ++ks) {
        const bf16x8 a = tr_frag<false>(Vi, lane, 16 * ks + 8 * hh, 0, 4, mb);
        const bf16x8 bf = tr_frag<true>(Kf, lane, 16 * ks + 8 * hh, 0, 4, nb);
        const bf16x8 bb = tr_frag<true>(Kb, lane, 16 * ks + 8 * hh, 0, 4, nb);
        af = __builtin_amdgcn_mfma_f32_32x32x16_bf16(a, bf, af, 0, 0, 0);
        ab = __builtin_amdgcn_mfma_f32_32x32x16_bf16(a, bb, ab, 0, 0, 0);
    }
    float* of = KVT + ((size_t)((0 * NB + b) * 4 + h) * NCH + c) * 8192; float* ob = KVT + ((size_t)((1 * NB + b) * 4 + h) * NCH + c) * 8192;
#pragma unroll
    for (int reg = 0; reg < 16; ++reg) { const int dv = 32 * mb + (reg & 3) + 8 * (reg >> 2) + 4 * hh, dk = 32 * nb + r; of[dv * 64 + dk] = af[reg]; ob[dv * 64 + dk] = ab[reg]; }
    __syncthreads();
}
__device__ __forceinline__ void ret_r2_unit(const Ctx& C, int layer, int u, int tid) {
    const int q = u & 3, bh = (u >> 2) & 63, dir = u >> 8, b = bh >> 2, h = bh & 3;
    const float G = exp2f(128.f * log2_sigmoid(C.ret_decay()[(layer * 2 + dir) * 4 + h]));
    const size_t base = ((size_t)((dir * NB + b) * 4 + h) * NCH) * 8192 + q * 2048 + tid * 4;
    const float* KVT = (const float*)(C.ws + WS_H) + base; bf16_t* ST = (bf16_t*)(C.ws + WS_YP) + base;
    float z0 = 0.f; asm volatile("" : "+v"(z0)); f32x4 S = {z0, z0, z0, z0};
#pragma unroll
    for (int half = 0; half < 2; ++half) {
        f32x4 kv[17];
#pragma unroll
        for (int s = 0; s < 17; ++s) { const int step = half * 17 + s; const int c = dir == 0 ? step : (step < 2 ? 1 - step : 35 - step); kv[s] = *(const f32x4*)(KVT + (size_t)c * 8192); }
#pragma unroll
        for (int s = 0; s < 17; ++s) { const int step = half * 17 + s; const int c = dir == 0 ? step : (step < 2 ? 1 - step : 35 - step);
            u32x2 w; w.x = pk2(S[0], S[1]); w.y = pk2(S[2], S[3]); *(u32x2*)(ST + (size_t)c * 8192) = w;
            S = S * G + kv[s]; }
    }
}
__device__ __forceinline__ void ret_r3_unit(const Ctx& C, int layer, int b, int h, int c, LAS unsigned char* lds, int tid) {
    int lane = tid & 63; asm volatile("" : "+v"(lane));
    const int wid = tid >> 6, r = lane & 31, hh = lane >> 5, ib = wid & 3, dh = wid >> 2;
    const bf16_t* P = (const bf16_t*)(C.ws + WS_P);
    LAS unsigned char* Vi = lds;
    LAS float* Ol = (LAS float*)(lds + 32768);
    const float* dec = C.ret_decay(); const float lf = log2_sigmoid(dec[(layer * 2 + 0) * 4 + h]), lb = log2_sigmoid(dec[(layer * 2 + 1) * 4 + h]);
    const size_t r0 = (size_t)b * TPB + c * 128;
    stage_v(P, r0, h, Vi, tid);
#define R3_ZERO(v) do { float z_ = 0.f; asm volatile("" : "+v"(z_)); _Pragma("unroll") for (int i_ = 0; i_ < 16; ++i_) v[i_] = z_; } while (0)
    bf16x8 qf[4];
    { const bf16_t* Qp = P + (r0 + 32 * ib + r) * DIN + C_RQ + h * 64 + 8 * hh;
#pragma unroll
      for (int ks = 0; ks < 4; ++ks) qf[ks] = *(const bf16x8*)(Qp + 16 * ks); }
    bf16x8 kf[4][4]; u32x4 gwv[4];
#pragma unroll
    for (int jb = 0; jb < 2; ++jb) { const bf16_t* Kp = P + (r0 + 32 * jb + r) * DIN + C_RK + h * 64 + 8 * hh;
#pragma unroll
        for (int ks = 0; ks < 4; ++ks) kf[jb][ks] = *(const bf16x8*)(Kp + 16 * ks); }
    { const bf16_t* gp = P + (r0 + (tid >> 2)) * DIN + C_RG + h * 128 + 32 * (tid & 3);
#pragma unroll
      for (int e2 = 0; e2 < 4; ++e2) gwv[e2] = *(const u32x4*)(gp + 8 * e2); }
    f32x16 o[2]; R3_ZERO(o[0]); R3_ZERO(o[1]);
#pragma unroll
    for (int dir = 0; dir < 2; ++dir) {
        const bf16_t* sp = (const bf16_t*)(C.ws + WS_YP) + ((size_t)((dir * NB + b) * 4 + h) * NCH + c) * 8192 + (64 * dh + r) * 64 + 8 * hh;
        f32x16 acc[2];
#pragma unroll
        for (int t = 0; t < 2; ++t) { R3_ZERO(acc[t]);
#pragma unroll
            for (int ks = 0; ks < 4; ++ks) acc[t] = __builtin_amdgcn_mfma_f32_32x32x16_bf16(qf[ks], *(const bf16x8*)(sp + t * 32 * 64 + 16 * ks), acc[t], 0, 0, 0); }
#pragma unroll
        for (int reg = 0; reg < 16; ++reg) { const int i = 32 * ib + (reg & 3) + 8 * (reg >> 2) + 4 * hh; const float xi = dir == 0 ? __builtin_amdgcn_exp2f((float)(i + 1) * lf) : __builtin_amdgcn_exp2f((float)(128 - i) * lb);
            o[0][reg] += xi * acc[0][reg]; o[1][reg] += xi * acc[1][reg]; }
        CBAR();
    }
#pragma unroll
    for (int jb = 2; jb < 4; ++jb) { const bf16_t* Kp = P + (r0 + 32 * jb + r) * DIN + C_RK + h * 64 + 8 * hh;
#pragma unroll
        for (int ks = 0; ks < 4; ++ks) kf[jb][ks] = *(const bf16x8*)(Kp + 16 * ks); }
    __syncthreads();
    unsigned lp[2][2];
    { const unsigned blk = (lane >> 4) & 1, q = (lane & 15) >> 2, pp = lane & 3;
#pragma unroll
      for (int t = 0; t < 2; ++t)
#pragma unroll
          for (int cb = 0; cb < 2; ++cb) lp[t][cb] = off_v(4 * hh + 8 * t + q, 4 * (2 * dh + cb) + 2 * blk + (pp >> 1)) + 8 * (pp & 1); }
#pragma unroll
    for (int jb = 0; jb < 4; ++jb) {
        f32x16 x; R3_ZERO(x);
#pragma unroll
        for (int ks = 0; ks < 4; ++ks) x = __builtin_amdgcn_mfma_f32_32x32x16_bf16(kf[jb][ks], qf[ks], x, 0, 0, 0);
#pragma unroll
        for (int reg = 0; reg < 16; ++reg) { const int d = (32 * ib + r) - (32 * jb + (reg & 3) + 8 * (reg >> 2) + 4 * hh);
            const float D = d > 0 ? __builtin_amdgcn_exp2f((float)d * lf) : (d < 0 ? __builtin_amdgcn_exp2f((float)(-d) * lb) : 2.0f); x[reg] *= 0.125f * D; }
#pragma unroll
        for (int s = 0; s < 2; ++s) {
            u32x4 pw; pw.x = pk2(x[8 * s + 0], x[8 * s + 1]); pw.y = pk2(x[8 * s + 2], x[8 * s + 3]); pw.z = pk2(x[8 * s + 4], x[8 * s + 5]); pw.w = pk2(x[8 * s + 6], x[8 * s + 7]);
            const bf16x8 pa = __builtin_bit_cast(bf16x8, pw);
#pragma unroll
            for (int cb = 0; cb < 2; ++cb) { const s16x4_t lo = tr_rd(Vi + lp[0][cb] + (8192 * jb + 4096 * s)), hi = tr_rd(Vi + lp[1][cb] + (8192 * jb + 4096 * s));
                const bf16x8 vb = (bf16x8){lo[0], lo[1], lo[2], lo[3], hi[0], hi[1], hi[2], hi[3]};
                o[cb] = __builtin_amdgcn_mfma_f32_32x32x16_bf16(pa, vb, o[cb], 0, 0, 0); }
        }
        CBAR();
    }
#pragma unroll
    for (int cb = 0; cb < 2; ++cb)
#pragma unroll
        for (int reg = 0; reg < 16; ++reg) { const int i = 32 * ib + (reg & 3) + 8 * (reg >> 2) + 4 * hh, dv = 64 * dh + 32 * cb + r; Ol[i * 132 + dv] = o[cb][reg]; }
    __syncthreads();
    { const int row = tid >> 2, q = tid & 3; f32x4 x[8]; float sm = 0.f;
#pragma unroll
      for (int e = 0; e < 8; ++e) { x[e] = *(const LAS f32x4*)(Ol + row * 132 + 32 * q + 4 * e); sm += (x[e][0] + x[e][1]) + (x[e][2] + x[e][3]); }
      sm += xor1(sm); sm += xor2(sm);
      const float mu = sm * (1.f / 128.f); float vs = 0.f;
#pragma unroll
      for (int e = 0; e < 8; ++e) { x[e] = x[e] - mu; vs += (x[e][0] * x[e][0] + x[e][1] * x[e][1]) + (x[e][2] * x[e][2] + x[e][3] * x[e][3]); }
      vs += xor1(vs); vs += xor2(vs);
      const float rstd = 1.0f / sqrtf(vs * (1.f / 128.f) + EPS);
      bf16_t* yp = (bf16_t*)(C.ws + WS_Y) + (r0 + row) * DM + h * 128 + 32 * q;
#pragma unroll
      for (int e2 = 0; e2 < 4; ++e2) { const u32x4 gw = gwv[e2]; const f32x4 a = x[2 * e2] * rstd, bq = x[2 * e2 + 1] * rstd;
          u32x4 ow; ow.x = pk2(a[0] * silu_f(bflo(gw.x)), a[1] * silu_f(bfhi(gw.x))); ow.y = pk2(a[2] * silu_f(bflo(gw.y)), a[3] * silu_f(bfhi(gw.y)));
          ow.z = pk2(bq[0] * silu_f(bflo(gw.z)), bq[1] * silu_f(bfhi(gw.z))); ow.w = pk2(bq[2] * silu_f(bflo(gw.w)), bq[3] * silu_f(bfhi(gw.w)));
          *(u32x4*)(yp + 8 * e2) = ow; } }
#undef R3_ZERO
}

template <bool WIN>
__device__ __forceinline__ void attn_dispatch(const Ctx& C, int layer, int U, int tid, char* lds) {
    using attn_body::bf16;
    int b, h, q0, NT, tdelta;
    if (U < 1024) { b = U >> 6; h = ((U >> 5) & 1) * 2 + ((U >> 4) & 1); q0 = CTX + 256 * (U & 15);
        if (WIN) { const int ts = (q0 / 64 - 2) > 4 ? (q0 / 64 - 2) : 4, te = (q0 / 64 + 6) < 68 ? (q0 / 64 + 6) : 68; NT = 4 + te - ts; tdelta = ts - 4; } else { NT = 68; tdelta = 0; } }
    else { b = (U - 1024) >> 2; h = (U - 1024) & 3; q0 = 0; NT = 4; tdelta = 0; }
    const int kvh = h >> 1;
    const bf16* Pb = (const bf16*)(C.ws + WS_P) + (size_t)b * TPB * DIN; bf16* Yb = (bf16*)(C.ws + WS_Y) + (size_t)b * TPB * DM;
    if (WIN) attn_body::attn_unit<8, true>(Pb + C_WQ + 64 * h, Pb + C_WK + 64 * kvh, Pb + C_WV + 64 * kvh, Yb + 512 + 64 * h, q0, NT, tdelta, C.win_sink()[layer * 4 + h] * LOG2E, tid, lds);
    else     attn_body::attn_unit<8, false>(Pb + C_GQ + 64 * h, Pb + C_GK + 64 * kvh, Pb + C_GV + 64 * kvh, Yb + 768 + 64 * h, q0, NT, tdelta, 0.f, tid, lds);
}
template <bool WIN>
__device__ __forceinline__ void attn_units(const Ctx& C, int layer, int G, int vcu, int bx, int tid, char* lds) {
    const int nctx = (layer == DEPTH - 1) ? 0 : 64;
    if (G == 256) {
        for (int k = 0; k < 4; ++k) attn_dispatch<WIN>(C, layer, vcu * 4 + k, tid, lds);
        if (vcu < nctx) attn_dispatch<WIN>(C, layer, 1024 + vcu, tid, lds);
    } else {
        for (int U = bx; U < 1024 + nctx; U += G) attn_dispatch<WIN>(C, layer, U, tid, lds);
    }
}

__device__ __forceinline__ f32x2 swap32(float a, float b) { auto r = __builtin_amdgcn_permlane32_swap(__builtin_bit_cast(unsigned, a), __builtin_bit_cast(unsigned, b), false, false);
    return (f32x2){__builtin_bit_cast(float, (unsigned)r[0]), __builtin_bit_cast(float, (unsigned)r[1])}; }
__device__ __forceinline__ f32x2 swap16(float a, float b) { auto r = __builtin_amdgcn_permlane16_swap(__builtin_bit_cast(unsigned, a), __builtin_bit_cast(unsigned, b), false, false);
    return (f32x2){__builtin_bit_cast(float, (unsigned)r[0]), __builtin_bit_cast(float, (unsigned)r[1])}; }
__device__ __forceinline__ void phase_norm2_route(const Ctx& C, int layer_c, LAS unsigned char* lds, int G, int bx, int tid) {
    const int layer = layer_c & 3;
    const int lane = tid & 63, wave = tid >> 6;
    const float* mod = (const float*)(C.ws + WS_MOD) + (size_t)layer * 17 * 6144;
    const float* gain = C.norm2() + layer * DM;
    const bf16_t* XR = (const bf16_t*)(C.ws + WS_X32); unsigned char* H = (unsigned char*)(C.ws + WS_H);
    int* list = (int*)(C.ws + WS_LIST); float* GW = (float*)(C.ws + WS_GW);
    unsigned* gcnt = (unsigned*)(C.ws + WS_CTL) + CW_CNT + 64 * layer_c;
    constexpr int RPC = MROWS / 256, RPW = RPC / 8;
    LAS float* wrT = (LAS float*)lds;
    LAS float* lgs = (LAS float*)(lds + 65536);
    LAS int* lcnt = (LAS int*)(lds + 65536 + RPC * 64);
    LAS int* lbase = lcnt + 16;
    LAS int* rec_e = lcnt + 32;
    LAS float* rec_w = (LAS float*)(rec_e + 2 * RPC);
    { const float* wr = C.w_router(); for (int i = tid; i < DM * NE; i += 512) { const int k = i >> 4, e = i & 15; wrT[e * DM + k] = wr[i]; } }
    if (tid < 16) lcnt[tid] = 0;
    __syncthreads();
    const unsigned lo4 = (unsigned)lane * 4u, lo8 = (unsigned)lane * 8u, lo16 = (unsigned)lane * 16u;
#define E_LOADROW(dst, mm) do { const char* xr_ = (const char*)(XR + (size_t)(mm) * DM); _Pragma("unroll") for (int j = 0; j < 4; ++j) dst[j] = *(const u32x2*)(xr_ + (lo8 + 512u * j)); } while (0)
#define E_NORMROW(v, nxr, mm) do { float ss_ = 0.f; _Pragma("unroll") for (int j = 0; j < 4; ++j) { v[j] = bf4(nxr[j]); ss_ += (v[j][0] * v[j][0] + v[j][1] * v[j][1]) + (v[j][2] * v[j][2] + v[j][3] * v[j][3]); } \
        const int b_ = (mm) / TPB, t_ = (mm) - b_ * TPB, set_ = t_ < CTX ? 16 : b_; const float rstd_ = 1.0f / sqrtf(wave_sum(ss_) * (1.f / DM) + EPS); \
        const char* gp_ = (const char*)gain; const char* shp_ = (const char*)(mod + (size_t)set_ * 6144 + 3 * DM); const char* scp_ = shp_ + DM * 4; \
        char* ho_ = (char*)(H + (size_t)(mm) * DM); \
        _Pragma("unroll") for (int j = 0; j < 4; ++j) { v[j] = (v[j] * rstd_) * *(const f32x4*)(gp_ + (lo16 + 1024u * j)) * (*(const f32x4*)(scp_ + (lo16 + 1024u * j)) + 1.0f) + *(const f32x4*)(shp_ + (lo16 + 1024u * j)); \
            *(unsigned*)(ho_ + (lo4 + 256u * j)) = pk4_fp8(v[j][0], v[j][1], v[j][2], v[j][3]); } } while (0)
#define E_REDUCE(pe, rowl) do { float q8_[8], q4_[4], q2_[2]; \
        _Pragma("unroll") for (int e = 0; e < 8; ++e) { const f32x2 r_ = swap32(pe[e], pe[e + 8]); q8_[e] = r_[0] + r_[1]; } \
        _Pragma("unroll") for (int e = 0; e < 4; ++e) { const f32x2 r_ = swap16(q8_[e], q8_[e + 4]); q4_[e] = r_[0] + r_[1]; } \
        _Pragma("unroll") for (int e = 0; e < 2; ++e) { const float keep_ = b3 ? q4_[e + 2] : q4_[e], send_ = b3 ? q4_[e] : q4_[e + 2]; q2_[e] = keep_ + swz_xor8(send_); } \
        float lg_ = (b2 ? q2_[1] : q2_[0]) + swz_xor4(b2 ? q2_[0] : q2_[1]); lg_ += xor2(lg_); lg_ += xor1(lg_); \
        if ((lane & 3) == 0) lgs[(rowl) * 16 + (lane >> 2)] = lg_; } while (0)
    const bool b3 = (lane & 8) != 0, b2 = (lane & 4) != 0;
    for (int chunk = bx; chunk < 256; chunk += G) {
        const int m0 = chunk * RPC + wave * RPW;
        u32x2 nxA[4], nxB[4], fxA[4], fxB[4];
        E_LOADROW(nxA, m0); E_LOADROW(nxB, m0 + 1); E_LOADROW(fxA, m0 + 2); E_LOADROW(fxB, m0 + 3);
        for (int i = 0; i < RPW; i += 2) {
            f32x4 vA[4], vB[4];
            E_NORMROW(vA, nxA, m0 + i);
            E_NORMROW(vB, nxB, m0 + i + 1);
#pragma unroll
            for (int j = 0; j < 4; ++j) { nxA[j] = fxA[j]; nxB[j] = fxB[j]; }
            if (i + 4 < RPW) { E_LOADROW(fxA, m0 + i + 4); E_LOADROW(fxB, m0 + i + 5); }
            float peA[16], peB[16];
            f32x2 hv[4][4];
#pragma unroll
            for (int j = 0; j < 4; ++j)
#pragma unroll
                for (int c = 0; c < 4; ++c) hv[j][c] = (f32x2){vA[j][c], vB[j][c]};
            const LAS float* wl = wrT + 4 * lane; asm volatile("" : "+v"(wl));
#pragma unroll
            for (int e = 0; e < 16; ++e) { f32x2 a2 = {0.f, 0.f};
#pragma unroll
                for (int j = 0; j < 4; ++j) { const f32x4 w = *(const LAS f32x4*)(wl + e * DM + 256 * j);
#pragma unroll
                    for (int c = 0; c < 4; ++c) a2 = __builtin_elementwise_fma(hv[j][c], (f32x2){w[c], w[c]}, a2); }
                peA[e] = a2[0]; peB[e] = a2[1]; }
            E_REDUCE(peA, wave * RPW + i); E_REDUCE(peB, wave * RPW + i + 1);
        }
#undef E_LOADROW
#undef E_NORMROW
#undef E_REDUCE
        asm volatile("s_waitcnt lgkmcnt(0)" ::: "memory");
        const int mrow_ = chunk * RPC + wave * RPW + lane;
        if (lane < RPW && !(layer == DEPTH - 1 && (mrow_ % TPB) < CTX)) {
            const int rl = wave * RPW + lane; const float* br = C.b_router();
            float sg[16], bs[16];
#pragma unroll
            for (int e4 = 0; e4 < 4; ++e4) { const f32x4 l4 = *(const LAS f32x4*)(lgs + rl * 16 + 4 * e4);
#pragma unroll
                for (int k = 0; k < 4; ++k) { sg[4 * e4 + k] = 1.f / (1.f + expf(-l4[k])); bs[4 * e4 + k] = sg[4 * e4 + k] + br[4 * e4 + k]; } }
            int grp = 0; float best = -1e30f;
#pragma unroll
            for (int g = 0; g < 4; ++g) { const float a0 = bs[4 * g], a1 = bs[4 * g + 1], a2 = bs[4 * g + 2], a3 = bs[4 * g + 3];
                const float hi01 = fmaxf(a0, a1), lo01 = fminf(a0, a1), hi23 = fmaxf(a2, a3), lo23 = fminf(a2, a3);
                const float top = fmaxf(hi01, hi23), second = fmaxf(fminf(hi01, hi23), hi01 >= hi23 ? lo01 : lo23);
                const float sc = top + second; if (sc > best) { best = sc; grp = g; } }
            float c4[4], s4[4];
#pragma unroll
            for (int k = 0; k < 4; ++k) { c4[k] = grp == 0 ? bs[k] : grp == 1 ? bs[4 + k] : grp == 2 ? bs[8 + k] : bs[12 + k]; s4[k] = grp == 0 ? sg[k] : grp == 1 ? sg[4 + k] : grp == 2 ? sg[8 + k] : sg[12 + k]; }
            int l0 = 0; float mx0 = c4[0];
#pragma unroll
            for (int k = 1; k < 4; ++k) if (c4[k] > mx0) { mx0 = c4[k]; l0 = k; }
            int l1 = -1; float mx1 = -1e30f;
#pragma unroll
            for (int k = 0; k < 4; ++k) if (k != l0 && c4[k] > mx1) { mx1 = c4[k]; l1 = k; }
            const float w0 = l0 == 0 ? s4[0] : l0 == 1 ? s4[1] : l0 == 2 ? s4[2] : s4[3], w1 = l1 == 0 ? s4[0] : l1 == 1 ? s4[1] : l1 == 2 ? s4[2] : s4[3];
            const float wn = 1.f / (w0 + w1);
            const int e0 = grp * 4 + l0, e1 = grp * 4 + l1;
            const int p0 = __hip_atomic_fetch_add(lcnt + e0, 1, __ATOMIC_RELAXED, __HIP_MEMORY_SCOPE_WORKGROUP);
            const int p1 = __hip_atomic_fetch_add(lcnt + e1, 1, __ATOMIC_RELAXED, __HIP_MEMORY_SCOPE_WORKGROUP);
            rec_e[2 * rl] = e0 | (p0 << 8); rec_e[2 * rl + 1] = e1 | (p1 << 8); rec_w[2 * rl] = w0 * wn; rec_w[2 * rl + 1] = w1 * wn;
        } else if (lane < RPW) { const int rl = wave * RPW + lane; rec_e[2 * rl] = -1; rec_e[2 * rl + 1] = -1; }
        __syncthreads();
        if (tid < 16) lbase[tid] = (int)__hip_atomic_fetch_add(gcnt + tid, (unsigned)lcnt[tid], __ATOMIC_RELAXED, __HIP_MEMORY_SCOPE_AGENT);
        __syncthreads();
        for (int i = tid; i < 2 * RPC; i += 512) { const int re = rec_e[i]; if (re < 0) continue; const int e = re & 255, pp = re >> 8; const int id = (chunk * RPC + (i >> 1)) * 2 + (i & 1);
            list[e * MROWS + lbase[e] + pp] = id; GW[id] = rec_w[i]; }
        __syncthreads();
        if (tid < 16) lcnt[tid] = 0;
        __syncthreads();
    }
}

template <bool GATHER_, int NT>
struct MoeOrder {
    static constexpr bool GATHER = GATHER_;
    const int* list; const LAS int* boff; const LAS int* cnt; int G, c;
    __device__ __forceinline__ bool next(int i, pg8::Unit& u) const {
        const int L = i * G + c; if (L >= boff[16] * NT) return false;
        const int blk = L / NT, pn = L - blk * NT; int e = 0;
#pragma unroll
        for (int k = 1; k < 16; ++k) e += (blk >= boff[k]) ? 1 : 0;
        u.pm = blk; u.pn = e * NT + pn; return true;
    }
    __device__ __forceinline__ unsigned arow(const pg8::Unit& u, int r) const {
        const int e = u.pn / NT, li = (u.pm - boff[e]) * 256 + r;
        const int id = li < cnt[e] ? list[e * MROWS + li] : 0;
        return (unsigned)(id >> 1);
    }
};
struct EpiGateUp {
    static constexpr bool PERM = true;
    unsigned char* O;
    __device__ __forceinline__ void operator()(const f32x4 (&acc)[2][2][4][2], const pg8::Unit& u, int wr, int wc, int fr, int fq) const {
        const int row0 = u.pm * 256 + wr * 64 + fr, col0 = (u.pn & 7) * 128 + wc * 32 + 8 * fq;
#pragma unroll
        for (int ai = 0; ai < 2; ++ai)
#pragma unroll
            for (int m = 0; m < 4; ++m) { const f32x4 a0 = acc[ai][0][m][0] * W8_INV, a1 = acc[ai][0][m][1] * W8_INV, u0 = acc[ai][1][m][0] * W8_INV, u1 = acc[ai][1][m][1] * W8_INV;
                u32x2 w; w.x = pk4_fp8(silu_f(a0[0]) * u0[0], silu_f(a0[1]) * u0[1], silu_f(a0[2]) * u0[2], silu_f(a0[3]) * u0[3]);
                w.y = pk4_fp8(silu_f(a1[0]) * u1[0], silu_f(a1[1]) * u1[1], silu_f(a1[2]) * u1[2], silu_f(a1[3]) * u1[3]);
                *(u32x2*)(O + ((unsigned)(row0 + ai * 128 + m * 16) * (unsigned)FF + (unsigned)col0)) = w; }
    }
};
struct EpiDown {
    static constexpr bool PERM = true;
    unsigned char* YP; const float* GW; const int* list; const LAS int* boff; const LAS int* cnt;
    __device__ __forceinline__ void operator()(const f32x4 (&acc)[2][2][4][2], const pg8::Unit& u, int wr, int wc, int fr, int fq) const {
        const int e = u.pn >> 2, lb = (u.pm - boff[e]) * 256, n = cnt[e]; const int col0 = (u.pn & 3) * 256 + wc * 32 + 8 * fq;
#pragma unroll
        for (int ai = 0; ai < 2; ++ai)
#pragma unroll
            for (int m = 0; m < 4; ++m) { const int li = lb + ai * 128 + wr * 64 + m * 16 + fr;
                if (li < n) { const int id = list[e * MROWS + li]; const float g = GW[id] * (W8_INV * YP_SCALE); const unsigned off = (unsigned)id * (unsigned)DM + (unsigned)col0;
#pragma unroll
                    for (int bj = 0; bj < 2; ++bj) { const f32x4 v0 = acc[ai][bj][m][0] * g, v1 = acc[ai][bj][m][1] * g;
                        u32x2 w; w.x = pk4_fp8(v0[0], v0[1], v0[2], v0[3]); w.y = pk4_fp8(v1[0], v1[1], v1[2], v1[3]); *(u32x2*)(YP + off + bj * 128) = w; } } }
    }
};
__device__ __forceinline__ void moe_offsets(const Ctx& C, int layer, LAS int* boff, LAS int* cnt, int tid) {
    if (tid == 0) { const unsigned* gcnt = (const unsigned*)(C.ws + WS_CTL) + CW_CNT + 64 * layer; int acc = 0;
        for (int e = 0; e < 16; ++e) { const int n = (int)__hip_atomic_load(gcnt + e, __ATOMIC_RELAXED, __HIP_MEMORY_SCOPE_AGENT); cnt[e] = n; boff[e] = acc; acc += (n + 255) >> 8; }
        boff[16] = acc; }
    __syncthreads();
}

__device__ __forceinline__ void phase_final(const Ctx& C, int gw, int NGW, int lane) {
    const float* mod = (const float*)(C.ws + WS_MOD) + (size_t)(DEPTH - 1) * 17 * 6144;
    const bf16_t* XR = (const bf16_t*)(C.ws + WS_X32); const unsigned char* YP = (const unsigned char*)(C.ws + WS_YP);
    for (int r = gw; r < NB * SEQ; r += NGW) {
        const int b = r / SEQ, t = r - b * SEQ; const size_t m = (size_t)b * TPB + CTX + t;
        const u32x2* xr = (const u32x2*)(XR + m * DM) + lane; const unsigned* y0 = (const unsigned*)(YP + m * 2 * DM) + lane; const unsigned* y1 = y0 + DM / 4;
        const f32x4* g2 = (const f32x4*)(mod + (size_t)b * 6144 + 5 * DM) + lane; f32x4* o = (f32x4*)(C.out + (size_t)r * DM) + lane;
        unsigned a[4], bb[4]; u32x2 x[4];
#pragma unroll
        for (int j = 0; j < 4; ++j) { x[j] = xr[64 * j]; a[j] = y0[64 * j]; bb[j] = y1[64 * j]; }
#pragma unroll
        for (int j = 0; j < 4; ++j) o[64 * j] = bf4(x[j]) + (g2[64 * j] * YP_INV) * (fp8x4_f32(a[j]) + fp8x4_f32(bb[j]));
    }
}

#ifndef R3OFF
#define R3OFF 0
#endif
#ifndef WINOFF
#define WINOFF 0
#endif
#ifndef PHMASK
#define PHMASK 0xFFFF
#endif
#ifndef MK_ONE_LAUNCH
#define MK_ONE_LAUNCH 1
#endif
constexpr int PH_PER_LAYER = 9, PH_LAYER0 = 2, PH_FINAL = PH_LAYER0 + DEPTH * PH_PER_LAYER, PH_COUNT = PH_FINAL + 1;
struct Args { const float* in[18]; float* out; unsigned char* ws; int ph_lo, ph_hi, flags, pad; };
__global__ void __launch_bounds__(512, 2) mega_fwd(Args args) {
    extern __shared__ __attribute__((aligned(16))) unsigned char lds_raw[];
    LAS unsigned char* lds = (LAS unsigned char*)lds_raw;
    Ctx C; C.out = args.out; C.ws = args.ws;
    const int tid = threadIdx.x, lane = tid & 63, wave = __builtin_amdgcn_readfirstlane(tid >> 6);
    const int G = gridDim.x; const int bx = blockIdx.x; const int vcu = (G % 8 == 0) ? (bx % 8) * (G / 8) + bx / 8 : bx;
    const int gw = vcu * 8 + wave, NGW = G * 8;
    volatile LAS unsigned* MISC = (volatile LAS unsigned*)(lds + LDSCTL_OFF);
    for (int u = tid; u < (LDS_BYTES - LDSCTL_OFF) / 4; u += 512) ((LAS unsigned*)(lds + LDSCTL_OFF))[u] = 0u;
    __syncthreads();
    const int lo = args.ph_lo, hi = args.ph_hi;
    XcdBarrier bar; bar.bar = (unsigned*)(C.ws + WS_CTL) + CW_BAR; bar.x = 0; bar.st = nullptr;
    if (hi - lo > 1) bar = xcd_barrier_post((unsigned*)(C.ws + WS_CTL) + CW_BAR, MISC);
#define IN(k) (lo <= (k) && (k) < hi)
#define PHASE_IDS() int bx_ = bx, wave_ = wave; LAS unsigned char* lds_ = lds; asm volatile("" : "+s"(bx_), "+s"(wave_), "+s"(lds_)); int lane_; asm volatile("v_mbcnt_lo_u32_b32 %0, -1, 0\n\tv_mbcnt_hi_u32_b32 %0, -1, %0" : "=v"(lane_)); const int tid_ = wave_ * 64 + lane_; \
    const int vcu_ = (G % 8 == 0) ? (bx_ % 8) * (G / 8) + bx_ / 8 : bx_; const int gw_ = vcu_ * 8 + wave_; (void)lane_; (void)gw_; (void)vcu_
#define SEAM(k) do { if (IN(k) && IN((k) + 1)) xcd_barrier(bar); } while (0)

    if (IN(0) && (PHMASK & 1)) { PHASE_IDS(); phase_prologue(C, lds_, G, vcu_, bx_, tid_); } SEAM(0);
    if (IN(1) && (PHMASK & 2)) { PHASE_IDS(); phase_modsum(C, G, bx_, tid_); } SEAM(1);
#ifdef EXTRA_BARS
    if (hi - lo > 1) for (int eb = 0; eb < EXTRA_BARS; ++eb) xcd_barrier(bar);
#endif

#ifdef LAYER_UNROLL
#pragma unroll
#else
#pragma nounroll
#endif
    for (int layer = 0; layer < DEPTH; ++layer) {
        const int p0 = PH_LAYER0 + layer * PH_PER_LAYER;
        if (IN(p0 + 0) && (PHMASK & 4)) { PHASE_IDS();
            if (layer > 0 && !(args.flags & 16)) {
                const unsigned* gc = (const unsigned*)(C.ws + WS_CTL) + CW_CNT + 64 * (layer - 1); int nblk = 0;
                for (int e = 0; e < 16; ++e) nblk += ((int)__hip_atomic_load(gc + e, __ATOMIC_RELAXED, __HIP_MEMORY_SCOPE_AGENT) + 255) >> 8;
                convert_rest(C, layer, G, vcu_, lds_, wave_, lane_, nblk * 8, nblk * 4); }
            phase_norm1(C, layer, gw_, NGW, lane_, (args.flags & 16) ? (bf16_t*)(C.ws + WS_Y) : (bf16_t*)(C.ws + WS_X32)); } SEAM(p0 + 0);
        if (IN(p0 + 1) && (PHMASK & 8)) {
            pg8::Gemm g{(const bf16_t*)(C.ws + WS_H), (const bf16_t*)(C.ws + WS_WIN) + (size_t)layer * DIN * DM, MROWS, DIN, DM};
            PHASE_IDS(); pg8::StaticOrder S; S.init(MROWS, DIN, G, bx_);
            pg8::EpiBf16 E{(bf16_t*)(C.ws + WS_P), DIN};
            pg8::gemm_phase<pg8::EpiBf16, pg8::StaticOrder, true>(lds_, g, S, E, tid_);
            if (layer + 1 < DEPTH && !args.flags) convert_tail(C, layer + 1, 0, (MROWS / 256) * (DIN / 256), G, bx_, lds_, wave_, lane_);
        } SEAM(p0 + 1);
        if (IN(p0 + 2) && (PHMASK & 16)) {
            PHASE_IDS(); if (!(args.flags & 1)) phase_qkprep(C, layer, gw_, NGW, lane_, (args.flags & 8) ? (bf16_t*)(C.ws + WS_Y) : (bf16_t*)(C.ws + WS_P));
            if (!(args.flags & 8)) for (int u = bx_; u < NB * 4 * NCH; u += G) { const int c = u % NCH, bh = u / NCH; ret_r1_unit(C, layer, bh >> 2, bh & 3, c, lds_, tid_); }
        } SEAM(p0 + 2);
        if (IN(p0 + 3) && (PHMASK & 32)) {
            PHASE_IDS(); for (int u = bx_; u < 512; u += G) ret_r2_unit(C, layer, u, tid_);
            attn_units<false>(C, layer, G, vcu_, bx_, tid_, (char*)lds_);
        } SEAM(p0 + 3);
        if (IN(p0 + 4) && (PHMASK & 64)) {
            PHASE_IDS();
            if (!WINOFF && !(args.flags & 32)) attn_units<true>(C, layer, G, vcu_, bx_, tid_, (char*)lds_);
            if (!R3OFF && !(args.flags & 64))
            for (int u = bx_; u < NB * 4 * NCH; u += G) { const int c = u % NCH, bh = u / NCH; if (layer == DEPTH - 1 && c < 2) continue; ret_r3_unit(C, layer, bh >> 2, bh & 3, c, lds_, tid_); }
        } SEAM(p0 + 4);
        if (IN(p0 + 5) && (PHMASK & 128)) {
            pg8::Gemm g{(const bf16_t*)(C.ws + WS_Y), (const bf16_t*)(C.ws + WS_WOUT) + (size_t)layer * DM * DM, MROWS, DM, DM};
            PHASE_IDS(); pg8::StaticOrder S; S.init(MROWS, DM, G, bx_, layer == DEPTH - 1);
            pg8::EpiResid E{(bf16_t*)(C.ws + ((args.flags & 4) ? WS_P : WS_X32)), (const float*)(C.ws + WS_MOD) + (size_t)layer * 17 * 6144 + 2 * DM};
            pg8::gemm_phase<pg8::EpiResid, pg8::StaticOrder, true>(lds_, g, S, E, tid_);
            if (layer + 1 < DEPTH && !args.flags) convert_tail(C, layer + 1, 1, (MROWS / 256) * (DM / 256), G, bx_, lds_, wave_, lane_);
        } SEAM(p0 + 5);
        if (IN(p0 + 6) && (PHMASK & 256)) { PHASE_IDS(); phase_norm2_route(C, layer + ((args.flags & 2) ? 4 : 0), lds_, G, bx_, tid_); } SEAM(p0 + 6);
        if (IN(p0 + 7) && (PHMASK & 512)) {
            PHASE_IDS(); LAS int* boff = (LAS int*)(lds_ + LDSCTL_OFF + 64); LAS int* mcnt = (LAS int*)(lds_ + LDSCTL_OFF + 192); moe_offsets(C, layer, boff, mcnt, tid_);
            pg8::Gemm g{(const bf16_t*)(C.ws + WS_H), (const bf16_t*)(C.ws + WS_WGU + (size_t)layer * NE * 2 * FF * DM), 0, 2 * FF, DM};
            MoeOrder<true, 8> S{(const int*)(C.ws + WS_LIST), boff, mcnt, G, bx_};
            EpiGateUp E{(unsigned char*)(C.ws + WS_P)};
            pg8::gemm_phase<EpiGateUp, MoeOrder<true, 8>, true, true>(lds_, g, S, E, tid_);
            if (layer + 1 < DEPTH && !args.flags) convert_tail(C, layer + 1, 2, boff[16] * 8, G, bx_, lds_, wave_, lane_);
        } SEAM(p0 + 7);
        if (IN(p0 + 8) && (PHMASK & 1024)) {
            PHASE_IDS(); LAS int* boff = (LAS int*)(lds_ + LDSCTL_OFF + 64); LAS int* mcnt = (LAS int*)(lds_ + LDSCTL_OFF + 192); moe_offsets(C, layer, boff, mcnt, tid_);
            pg8::Gemm g{(const bf16_t*)(C.ws + WS_P), (const bf16_t*)(C.ws + WS_WDN + (size_t)layer * NE * DM * FF), 0, DM, FF};
            MoeOrder<false, 4> S{(const int*)(C.ws + WS_LIST), boff, mcnt, G, bx_};
            EpiDown E{(unsigned char*)(C.ws + WS_YP), (const float*)(C.ws + WS_GW), (const int*)(C.ws + WS_LIST), boff, mcnt};
            pg8::gemm_phase<EpiDown, MoeOrder<false, 4>, true, true>(lds_, g, S, E, tid_);
            if (layer + 1 < DEPTH && !args.flags) convert_tail(C, layer + 1, 3, boff[16] * 4, G, bx_, lds_, wave_, lane_);
        } SEAM(p0 + 8);
    }
    if (IN(PH_FINAL) && (PHMASK & 2048)) { PHASE_IDS(); phase_final(C, gw_, NGW, lane_); }
#undef IN
#undef SEAM
}

extern "C" void kernel_launch(void* const* d_in, const int* in_sizes, int n_in, void* d_out, int out_size, void* d_ws, size_t ws_size, hipStream_t stream) {
    static int grid = 0;
    if (grid == 0) {
        if (n_in != 18 || in_sizes[0] != NB * SEQ * DM || out_size != NB * SEQ * DM || ws_size < WS_END) {
            fprintf(stderr, "kernel_launch: unexpected shapes (n_in %d, in0 %d, out %d, ws %zu, need %zu); nothing launched\n", n_in, n_in > 0 ? in_sizes[0] : -1, out_size, ws_size, (size_t)WS_END); grid = -1; return; }
        int dev = 0, cus = 0, per_cu = 0;
        if (hipGetDevice(&dev) != hipSuccess || hipDeviceGetAttribute(&cus, hipDeviceAttributeMultiprocessorCount, dev) != hipSuccess) { grid = -1; return; }
        if (hipFuncSetAttribute((const void*)mega_fwd, hipFuncAttributeMaxDynamicSharedMemorySize, LDS_BYTES) != hipSuccess) { fprintf(stderr, "kernel_launch: hipFuncSetAttribute failed\n"); grid = -1; return; }
        if (hipOccupancyMaxActiveBlocksPerMultiprocessor(&per_cu, (const void*)mega_fwd, 512, LDS_BYTES) != hipSuccess || per_cu < 1) fprintf(stderr, "kernel_launch: occupancy query says %d\n", per_cu);
        (void)hipGetLastError();
        grid = cus;
    }
    if (grid < 0) return;
    if (hipMemsetAsync((char*)d_ws + WS_CTL, 0, CTL_BYTES, stream) != hipSuccess) return;
    Args a{};
    for (int i = 0; i < 18; ++i) a.in[i] = (const float*)d_in[i];
    a.out = (float*)d_out; a.ws = (unsigned char*)d_ws;
#if MK_ONE_LAUNCH
    a.ph_lo = 0; a.ph_hi = PH_COUNT;
    hipLaunchKernelGGL(mega_fwd, dim3(grid), dim3(512), LDS_BYTES, stream, a);
#else
    for (int p = 0; p < PH_COUNT; ++p) { a.ph_lo = p; a.ph_hi = p + 1;
#if !defined(PROBE_P) || !PROBE_BEFORE
        hipLaunchKernelGGL(mega_fwd, dim3(grid), dim3(512), LDS_BYTES, stream, a);
#endif
#ifdef PROBE_P
        const bool hit = (PROBE_P < 2) ? (p == PROBE_P) : (p >= PH_LAYER0 && p < PH_FINAL && (p - PH_LAYER0) % PH_PER_LAYER == PROBE_P - 2 && (!PROBE_L0 || p < PH_LAYER0 + PH_PER_LAYER));
        if (hit) { a.flags = PROBE_FLAGS; for (int r = 0; r < PROBE_REP; ++r) hipLaunchKernelGGL(mega_fwd, dim3(grid), dim3(512), LDS_BYTES, stream, a); a.flags = 0; }
#if PROBE_BEFORE
        hipLaunchKernelGGL(mega_fwd, dim3(grid), dim3(512), LDS_BYTES, stream, a);
#endif
#endif
    }
#endif
}
```

```cpp
#define MK_ONE_LAUNCH 1
#include <hip/hip_runtime.h>
#include <cstdio>
#include <cstdint>

#define GAS __attribute__((address_space(1)))
#define LAS __attribute__((address_space(3)))
typedef unsigned short bf16_t;
typedef short bf16x8 __attribute__((ext_vector_type(8)));
typedef float f32x4 __attribute__((ext_vector_type(4)));
typedef float f32x2 __attribute__((ext_vector_type(2)));
typedef float f32x16 __attribute__((ext_vector_type(16)));
typedef unsigned u32x4 __attribute__((ext_vector_type(4)));
typedef unsigned u32x2 __attribute__((ext_vector_type(2)));

constexpr int DM = 1024, NB = 16, SEQ = 4096, CTX = 256, TPB = SEQ + CTX, MROWS = NB * TPB, DEPTH = 4;
constexpr int DIN = 2560;
constexpr int C_RQ = 0, C_RK = 256, C_RV = 512, C_RG = 1024, C_WQ = 1536, C_WK = 1792, C_WV = 1920, C_GQ = 2048, C_GK = 2304, C_GV = 2432;
constexpr int NE = 16, FF = 1024, NCH = TPB / 128;
constexpr float EPS = 1e-6f;
constexpr float LOG2E = 1.4426950408889634f;
constexpr float QSCALE = 0.125f * LOG2E;

__device__ __forceinline__ unsigned f2bf(float f) { unsigned u = __builtin_bit_cast(unsigned, f); return (u + 0x7fffu + ((u >> 16) & 1u)) >> 16; }
__device__ __forceinline__ unsigned pk2(float lo, float hi) { return f2bf(lo) | (f2bf(hi) << 16); }
__device__ __forceinline__ float bf2f(unsigned short h) { return __builtin_bit_cast(float, (unsigned)h << 16); }
__device__ __forceinline__ float bflo(unsigned w) { return __builtin_bit_cast(float, w << 16); }
__device__ __forceinline__ float bfhi(unsigned w) { return __builtin_bit_cast(float, w & 0xffff0000u); }

namespace pg8 {
constexpr int BM = 256, BK = 64, HALF = 128, HTB = HALF * BK * 2, STAGE_BYTES = 8 * HTB, NXCD = 8, WGM = 8;
__host__ __device__ __forceinline__ int lds_byte(int r, int c) { const int st = (r >> 4) * 2 + (c >> 5), rr = r & 15, cc = c & 31, ob = rr * 64 + cc * 2; return st * 1024 + (ob ^ (((ob >> 9) & 1) << 5)); }
__host__ __device__ __forceinline__ void stage_rc(int b, int& R, int& C) { const int st = b / 1024, sb = b % 1024, swz = sb ^ (((sb >> 9) & 1) << 5); R = (st >> 1) * 16 + swz / 64; C = (st & 1) * 32 + (swz % 64) / 2; }
__host__ __device__ __forceinline__ int perm32(int rho) { const int n = rho >> 4, i = rho & 15; return 8 * (i >> 2) + 4 * n + (i & 3); }

struct Unit { int pm, pn; };
struct Gemm { const bf16_t* A; const bf16_t* Bt; int M, N, K; };

struct StaticOrder {
    static constexpr bool GATHER = false;
    int nM, nN, nwg, G, c; bool skipctx;
    __device__ void init(int M, int N, int G_, int c_, bool skipctx_ = false) { skipctx = skipctx_; nM = skipctx_ ? (M / BM) / 17 * 16 : M / BM; nN = N / BM; nwg = nM * nN; G = G_; c = c_; }
    __device__ bool next(int i, Unit& u) const {
        const long L = (long)i * G + c; if (L >= nwg) return false;
        int wgid = (int)L; { const int q = nwg / NXCD, r = nwg % NXCD, xcd = wgid % NXCD, off = wgid / NXCD; wgid = (xcd < r ? xcd * (q + 1) : r * (q + 1) + (xcd - r) * q) + off; }
        const int nig = WGM * nN, gid = wgid / nig, fm = gid * WGM, gsz = (nM - fm) < WGM ? (nM - fm) : WGM;
        u.pm = fm + ((wgid % nig) % gsz); u.pn = (wgid % nig) / gsz; if (skipctx) u.pm += (u.pm >> 4) + 1; return true;
    }
    __device__ __forceinline__ unsigned arow(const Unit&, int) const { return 0u; }
    __device__ __forceinline__ const int* aptr(const Unit&, int) const { return nullptr; }
    __device__ __forceinline__ unsigned tokrow(unsigned) const { return 0u; }
};

__device__ __forceinline__ unsigned cvt_pk_bf16(float lo, float hi) { unsigned r; asm volatile("v_cvt_pk_bf16_f32 %0, %1, %2" : "=v"(r) : "v"(lo), "v"(hi)); return r; }

struct EpiBf16 {
    static constexpr bool PERM = true, HAS_PRE = false;
    bf16_t* O; int ldc;
    __device__ __forceinline__ void operator()(const f32x4 (&acc)[2][2][4][2], const Unit& u, int wr, int wc, int fr, int fq) const {
        const int row0 = u.pm * BM + wr * 64 + fr; const int col0 = u.pn * BM + wc * 32 + 8 * fq;
#pragma unroll
        for (int ai = 0; ai < 2; ++ai)
#pragma unroll
            for (int m = 0; m < 4; ++m) { const unsigned off = ((unsigned)(row0 + ai * HALF + m * 16) * (unsigned)ldc + (unsigned)col0) * 2u;
#pragma unroll
                for (int bj = 0; bj < 2; ++bj) { const f32x4 v0 = acc[ai][bj][m][0], v1 = acc[ai][bj][m][1];
                    u32x4 w; w.x = cvt_pk_bf16(v0[0], v0[1]); w.y = cvt_pk_bf16(v0[2], v0[3]); w.z = cvt_pk_bf16(v1[0], v1[1]); w.w = cvt_pk_bf16(v1[2], v1[3]);
                    *(u32x4*)((char*)O + off + bj * HALF * 2) = w; } }
    }
};

struct EpiResid {
    static constexpr bool PERM = true, HAS_PRE = false;
    bf16_t* X; const float* gate;
    __device__ __forceinline__ void operator()(const f32x4 (&acc)[2][2][4][2], const Unit& u, int wr, int wc, int fr, int fq) const {
        const int set = (u.pm % 17 == 0) ? 16 : (u.pm / 17);
        const float* gp = gate + (size_t)set * 6 * DM;
        const int col0 = u.pn * BM + wc * 32 + 8 * fq;
        f32x4 gv[2][2];
#pragma unroll
        for (int bj = 0; bj < 2; ++bj)
#pragma unroll
            for (int n = 0; n < 2; ++n) gv[bj][n] = *(const f32x4*)(gp + col0 + bj * HALF + n * 4);
#pragma unroll
        for (int ai = 0; ai < 2; ++ai) {
            u32x4 xin[4][2];
#pragma unroll
            for (int m = 0; m < 4; ++m) { const unsigned off = ((unsigned)(u.pm * BM + ai * HALF + wr * 64 + m * 16 + fr) * (unsigned)DM + (unsigned)col0) * 2u;
#pragma unroll
                for (int bj = 0; bj < 2; ++bj) xin[m][bj] = *(const u32x4*)((const char*)X + off + bj * HALF * 2); }
            asm volatile("" ::: "memory");
#pragma unroll
            for (int m = 0; m < 4; ++m) { const unsigned off = ((unsigned)(u.pm * BM + ai * HALF + wr * 64 + m * 16 + fr) * (unsigned)DM + (unsigned)col0) * 2u;
#pragma unroll
                for (int bj = 0; bj < 2; ++bj) { const u32x4 x = xin[m][bj]; const f32x4 a0 = acc[ai][bj][m][0] * gv[bj][0], a1 = acc[ai][bj][m][1] * gv[bj][1];
                    u32x4 w; w.x = cvt_pk_bf16(bflo(x.x) + a0[0], bfhi(x.x) + a0[1]); w.y = cvt_pk_bf16(bflo(x.y) + a0[2], bfhi(x.y) + a0[3]);
                    w.z = cvt_pk_bf16(bflo(x.z) + a1[0], bfhi(x.z) + a1[1]); w.w = cvt_pk_bf16(bflo(x.w) + a1[2], bfhi(x.w) + a1[3]);
                    *(u32x4*)((char*)X + off + bj * HALF * 2) = w; } }
            asm volatile("" ::: "memory");
        }
    }
};

template <class Epi, class Sched, bool ALIGN_EPI, bool FP8 = false>
__device__ __forceinline__ void gemm_phase(LAS unsigned char* lds, const Gemm g, const Sched& S, Epi& E, const int tid) {
    const int wid = __builtin_amdgcn_readfirstlane(tid >> 6), lane = tid & 63, wr = wid >> 2, wc = wid & 3, fr = lane & 15, fq = lane >> 4;
    const int K = g.K, KB = FP8 ? K : 2 * K  , nt = KB / (BK * 2);
    unsigned voffB[2], vA[2][2], vAn[2][2]; int sR[2], sC[2];
#pragma unroll
    for (int i = 0; i < 2; ++i) { int R, C; stage_rc(tid * 16 + i * 8192, R, C); sR[i] = R; sC[i] = C; const int Rb = Epi::PERM ? ((R & ~31) + perm32(R & 31)) : R;
        voffB[i] = (unsigned)(Rb * KB + C * 2); }
#define PG8_SETV(v, u) do { _Pragma("unroll") for (int h_ = 0; h_ < 2; ++h_) _Pragma("unroll") for (int i_ = 0; i_ < 2; ++i_) { \
        if constexpr (Sched::GATHER) v[h_][i_] = S.arow(u, h_ * HALF + sR[i_]) * (unsigned)KB + (unsigned)(sC[i_] * 2); \
        else v[h_][i_] = (unsigned)((h_ * HALF + sR[i_]) * KB + sC[i_] * 2); } } while (0)
    const size_t kstep = (size_t)(BK * 2);
    const size_t hstep = (size_t)HALF * KB;
    const size_t tstep = 2 * hstep;
    const size_t atstep = Sched::GATHER ? (size_t)0 : tstep;
    const unsigned ldsw = (unsigned)wid * 1024u;
    const int aoff = lds_byte(wr * 64 + fr, fq * 8), boff = lds_byte(wc * 32 + fr, fq * 8);
#define PG8_SA(b, h) (((b) * 2 + (h)) * HTB)
#define PG8_SB(b, h) ((4 + (b) * 2 + (h)) * HTB)
#define PG8_STAGE(bufoff, gbase, voff) do { _Pragma("unroll") for (int _i = 0; _i < 2; ++_i) \
        __builtin_amdgcn_global_load_lds((const unsigned*)((const char*)(gbase) + (voff)[_i]), (LAS unsigned*)(lds + (bufoff) + ldsw + _i * 8192), 16, 0, 0); } while (0)
#define PG8_LDA(dst, b, h) do { _Pragma("unroll") for (int m = 0; m < 4; ++m) _Pragma("unroll") for (int k = 0; k < 2; ++k) dst[m][k] = *(const LAS bf16x8*)(lds + PG8_SA(b, h) + aoff + m * 2048 + k * 1024); } while (0)
#define PG8_LDB(dst, b, h) do { _Pragma("unroll") for (int n = 0; n < 2; ++n) _Pragma("unroll") for (int k = 0; k < 2; ++k) dst[n][k] = *(const LAS bf16x8*)(lds + PG8_SB(b, h) + boff + n * 2048 + k * 1024); } while (0)
    typedef long i64x2_ __attribute__((ext_vector_type(2)));
#define PG8_MMA(ai, bj, At, Bt) do { __builtin_amdgcn_s_setprio(1); _Pragma("unroll") for (int m = 0; m < 4; ++m) _Pragma("unroll") for (int n = 0; n < 2; ++n) _Pragma("unroll") for (int k = 0; k < 2; ++k) { \
        if constexpr (FP8) { const i64x2_ b2_ = __builtin_bit_cast(i64x2_, Bt[n][k]), a2_ = __builtin_bit_cast(i64x2_, At[m][k]); \
            acc[ai][bj][m][n] = __builtin_amdgcn_mfma_f32_16x16x32_fp8_fp8(b2_[0], a2_[0], acc[ai][bj][m][n], 0, 0, 0); \
            acc[ai][bj][m][n] = __builtin_amdgcn_mfma_f32_16x16x32_fp8_fp8(b2_[1], a2_[1], acc[ai][bj][m][n], 0, 0, 0); } \
        else acc[ai][bj][m][n] = __builtin_amdgcn_mfma_f32_16x16x32_bf16(Bt[n][k], At[m][k], acc[ai][bj][m][n], 0, 0, 0); } \
        __builtin_amdgcn_s_setprio(0); } while (0)
#define PG8_WAIT_V(n) asm volatile("s_waitcnt vmcnt(" #n ")" ::: "memory")
#define PG8_WAIT_L(n) asm volatile("s_waitcnt lgkmcnt(" #n ")" ::: "memory")
#define PG8_BAR __builtin_amdgcn_s_barrier()
#define PG8_SCHED __builtin_amdgcn_sched_barrier(0)
    Unit cur, nxt; int ui = 0;
    if (!S.next(0, cur)) return;
    float z0 = 0.f; asm volatile("" : "+v"(z0));
    f32x4 acc[2][2][4][2];
#pragma unroll
    for (int a = 0; a < 2; ++a)
#pragma unroll
        for (int b = 0; b < 2; ++b)
#pragma unroll
            for (int m = 0; m < 4; ++m)
#pragma unroll
                for (int n = 0; n < 2; ++n) acc[a][b][m][n] = (f32x4){z0, z0, z0, z0};
    bf16x8 At[4][2], B0[2][2], B1[2][2];
    const char* cA = (const char*)g.A + (size_t)cur.pm * atstep; const char* cB = (const char*)g.Bt + (size_t)cur.pn * tstep;
    PG8_SETV(vA, cur);
    PG8_STAGE(PG8_SB(0, 0), cB, voffB); PG8_STAGE(PG8_SB(0, 1), cB + hstep, voffB); PG8_STAGE(PG8_SA(0, 0), cA, vA[0]); PG8_STAGE(PG8_SA(0, 1), cA, vA[1]);
    if (wr == 1) PG8_BAR;
    PG8_WAIT_V(2); PG8_BAR;
    PG8_STAGE(PG8_SB(1, 0), cB + kstep, voffB); PG8_STAGE(PG8_SA(1, 0), cA + kstep, vA[0]); PG8_STAGE(PG8_SB(1, 1), cB + hstep + kstep, voffB);
    PG8_WAIT_V(6); PG8_BAR;
    for (;;) {
        if constexpr (Epi::HAS_PRE) E.pre(cur, wr, fr);
        const bool has_next = S.next(ui + 1, nxt);
        const char* nA = has_next ? (const char*)g.A + (size_t)nxt.pm * atstep : cA; const char* nB = has_next ? (const char*)g.Bt + (size_t)nxt.pn * tstep : cB;
        if constexpr (Sched::GATHER) { if (has_next) {
#pragma unroll
            for (int h_ = 0; h_ < 2; ++h_)
#pragma unroll
                for (int i_ = 0; i_ < 2; ++i_) { const int* ap_ = S.aptr(nxt, h_ * HALF + sR[i_]); asm volatile("global_load_dword %0, %1, off" : "=v"(vAn[h_][i_]) : "v"(ap_) : "memory"); } } }
        if (has_next) { if constexpr (!Sched::GATHER) { PG8_SETV(vAn, nxt); } } else {
#pragma unroll
            for (int h_ = 0; h_ < 2; ++h_)
#pragma unroll
                for (int i_ = 0; i_ < 2; ++i_) vAn[h_][i_] = vA[h_][i_]; }
        for (int t = 0; t < nt; t += 2) {
            const bool last = (t == nt - 2);
            const char* a1 = cA + (size_t)(t + 1) * kstep;
            const char* a2 = last ? nA : cA + (size_t)(t + 2) * kstep; const char* b2 = last ? nB : cB + (size_t)(t + 2) * kstep;
            const char* a3 = a2 + kstep; const char* b3 = b2 + kstep;
            if constexpr (Sched::GATHER) { if (t == 2 && has_next) {
#pragma unroll
                for (int h_ = 0; h_ < 2; ++h_)
#pragma unroll
                    for (int i_ = 0; i_ < 2; ++i_) { asm volatile("" : "+v"(vAn[h_][i_])); vAn[h_][i_] = S.tokrow(vAn[h_][i_]) * (unsigned)KB + (unsigned)(sC[i_] * 2); } } }
            unsigned o2[2][2];
#pragma unroll
            for (int h_ = 0; h_ < 2; ++h_)
#pragma unroll
                for (int i_ = 0; i_ < 2; ++i_) o2[h_][i_] = last ? vAn[h_][i_] : vA[h_][i_];
            PG8_LDB(B0, 0, 0); PG8_LDB(B1, 0, 1); PG8_SCHED; PG8_LDA(At, 0, 0); PG8_STAGE(PG8_SA(1, 1), a1, vA[1]);
            PG8_WAIT_V(8); PG8_WAIT_L(0); PG8_BAR; PG8_MMA(0, 0, At, B0); PG8_MMA(0, 1, At, B1); PG8_BAR; PG8_SCHED;
            PG8_LDA(At, 0, 1); PG8_STAGE(PG8_SB(0, 0), b2, voffB); PG8_STAGE(PG8_SB(0, 1), b2 + hstep, voffB); PG8_STAGE(PG8_SA(0, 0), a2, o2[0]);
            PG8_WAIT_V(8); PG8_WAIT_L(0); PG8_BAR; PG8_MMA(1, 0, At, B0); PG8_MMA(1, 1, At, B1); PG8_BAR; PG8_SCHED;
            PG8_LDB(B0, 1, 0); PG8_LDB(B1, 1, 1); PG8_SCHED; PG8_LDA(At, 1, 0); PG8_STAGE(PG8_SA(0, 1), a2, o2[1]);
            PG8_WAIT_V(8); PG8_WAIT_L(0); PG8_BAR; PG8_MMA(0, 0, At, B0); PG8_MMA(0, 1, At, B1); PG8_BAR; PG8_SCHED;
            PG8_LDA(At, 1, 1); PG8_STAGE(PG8_SB(1, 0), b3, voffB); PG8_STAGE(PG8_SB(1, 1), b3 + hstep, voffB); PG8_STAGE(PG8_SA(1, 0), a3, o2[0]);
            PG8_WAIT_V(8); PG8_WAIT_L(0); PG8_BAR; PG8_MMA(1, 0, At, B0); PG8_MMA(1, 1, At, B1); PG8_BAR; PG8_SCHED;
        }
        if constexpr (ALIGN_EPI) { if (wr == 0) PG8_BAR; }
        E(acc, cur, wr, wc, fr, fq);
        if (!has_next) break;
#pragma unroll
        for (int a = 0; a < 2; ++a)
#pragma unroll
            for (int b = 0; b < 2; ++b)
#pragma unroll
                for (int m = 0; m < 4; ++m)
#pragma unroll
                    for (int n = 0; n < 2; ++n) acc[a][b][m][n] = (f32x4){z0, z0, z0, z0};
        cur = nxt; cA = nA; cB = nB; ++ui;
#pragma unroll
        for (int h_ = 0; h_ < 2; ++h_)
#pragma unroll
            for (int i_ = 0; i_ < 2; ++i_) vA[h_][i_] = vAn[h_][i_];
        if constexpr (ALIGN_EPI) { if (wr == 1) PG8_BAR; }
    }
    PG8_WAIT_V(0);
    if constexpr (!ALIGN_EPI) { if (wr == 0) PG8_BAR; }
    PG8_BAR;
#undef PG8_SETV
#undef PG8_SA
#undef PG8_SB
#undef PG8_STAGE
#undef PG8_LDA
#undef PG8_LDB
#undef PG8_MMA
#undef PG8_WAIT_V
#undef PG8_WAIT_L
#undef PG8_BAR
#undef PG8_SCHED
}
}
#include <hip/hip_bf16.h>
#include <cmath>
namespace attn_body {
using bf16=__hip_bfloat16;
using s16x4=__attribute__((ext_vector_type(4)))short;
constexpr int D=64,QP=DIN,OP=1024;
constexpr int NW=8,QBLK=32,QB=QBLK*NW,KVBLK=64;
__device__ __forceinline__ int crow(int r,int hi){return (r&3)+8*(r>>2)+4*hi;}
#define SBAR() __builtin_amdgcn_sched_barrier(0)
__device__ __forceinline__ void wmask(f32x16&p0,f32x16&p1,int kq,int hi){
  const float NEG=-INFINITY; const int kb=kq+4*hi;
  #pragma unroll
  for(int r=0;r<16;++r){const int d=kb+(r&3)+8*(r>>2); if(d>128||d<-128)p0[r]=NEG; if(d+32>128||d+32<-128)p1[r]=NEG;}
}

constexpr int NSLOT=3, SLOTB=8192;
constexpr int LDS_K=0, LDS_V=NSLOT*SLOTB, LDS_WS=2*NSLOT*SLOTB, LDS_OST=LDS_WS+NW*64*4, LDS_BYTES=LDS_OST+NW*4096;
constexpr float C2=0.125f*1.4426950408889634f;
__device__ __forceinline__ void glds16(const void*gsrc,unsigned lds_dst){unsigned keep;
  asm volatile("s_mov_b32 %0, m0\n\ts_mov_b32 m0, %2\n\ts_nop 0\n\tglobal_load_lds_dwordx4 %1, off\n\ts_mov_b32 m0, %0":"=&s"(keep):"v"(gsrc),"s"(lds_dst):"memory");}
__device__ __forceinline__ float max3f(float a,float b,float c){float r;asm("v_max3_f32 %0, %1, %2, %3":"=v"(r):"v"(a),"v"(b),"v"(c));return r;}
__device__ __forceinline__ float max2f(float a,float b){float r;asm("v_max_f32_e32 %0, %1, %2":"=v"(r):"v"(a),"v"(b));return r;}
__device__ __forceinline__ float fadd_s(float a,float b){float r;asm("v_add_f32_e32 %0, %1, %2":"=v"(r):"v"(a),"v"(b));return r;}
__device__ __forceinline__ float fsub_s(float a,float b){float r;asm("v_sub_f32_e32 %0, %1, %2":"=v"(r):"v"(a),"v"(b));return r;}
typedef float f32x2_t __attribute__((ext_vector_type(2))); typedef __bf16 bf16x2_t __attribute__((ext_vector_type(2)));
__device__ __forceinline__ unsigned cvtpk_s(float lo,float hi){f32x2_t v={lo,hi};bf16x2_t b=__builtin_convertvector(v,bf16x2_t);return __builtin_bit_cast(unsigned,b);}
#define WAIT_BAR(N) asm volatile("s_waitcnt vmcnt(" #N ") lgkmcnt(0)\n\ts_barrier":::"memory")

__device__ __forceinline__ void qkt(f32x16&p0,f32x16&p1,const char*Kslot,const bf16x8*qr,const f32x16&negm,int r32,int hi){
  const char*kb=Kslot+hi*1024+r32*16;
  #pragma unroll
  for(int d0=0;d0<4;++d0){
    const bf16x8 b0=*reinterpret_cast<const bf16x8*>(kb+d0*2048);
    const bf16x8 b1=*reinterpret_cast<const bf16x8*>(kb+d0*2048+512);
    if(d0==0){p0=__builtin_amdgcn_mfma_f32_32x32x16_bf16(b0,qr[0],negm,0,0,0);p1=__builtin_amdgcn_mfma_f32_32x32x16_bf16(b1,qr[0],negm,0,0,0);}
    else{p0=__builtin_amdgcn_mfma_f32_32x32x16_bf16(b0,qr[d0],p0,0,0,0);p1=__builtin_amdgcn_mfma_f32_32x32x16_bf16(b1,qr[d0],p1,0,0,0);}}
}
typedef __attribute__((address_space(3))) const char* lds_cptr;
typedef short v4i16_t __attribute__((ext_vector_type(4)));
__device__ __forceinline__ void kload8(bf16x8*kf,lds_cptr kp){
  kf[0]=*(const __attribute__((address_space(3))) bf16x8*)(kp);      kf[1]=*(const __attribute__((address_space(3))) bf16x8*)(kp+512);
  kf[2]=*(const __attribute__((address_space(3))) bf16x8*)(kp+2048); kf[3]=*(const __attribute__((address_space(3))) bf16x8*)(kp+2560);
  kf[4]=*(const __attribute__((address_space(3))) bf16x8*)(kp+4096); kf[5]=*(const __attribute__((address_space(3))) bf16x8*)(kp+4608);
  kf[6]=*(const __attribute__((address_space(3))) bf16x8*)(kp+6144); kf[7]=*(const __attribute__((address_space(3))) bf16x8*)(kp+6656);
}
__device__ __forceinline__ void kload2(bf16x8*kf,lds_cptr kp,int j){ kf[2*j]=*(const __attribute__((address_space(3))) bf16x8*)(kp+j*2048); kf[2*j+1]=*(const __attribute__((address_space(3))) bf16x8*)(kp+j*2048+512); }
__device__ __forceinline__ s16x4 vtr(lds_cptr p){ return __builtin_bit_cast(s16x4,__builtin_amdgcn_ds_read_tr16_b64_v4i16((__attribute__((address_space(3))) v4i16_t*)p)); }
__device__ __forceinline__ float rowmax(const f32x16&p0,const f32x16&p1){
  float a=max3f(p0[0],p0[1],p1[0]),b=max3f(p0[2],p0[3],p1[1]);a=max3f(a,p1[2],p1[3]);
  #pragma unroll
  for(int r=4;r<16;r+=4){a=max3f(a,p0[r],p0[r+1]);b=max3f(b,p0[r+2],p0[r+3]);a=max3f(a,p1[r],p1[r+1]);b=max3f(b,p1[r+2],p1[r+3]);}
  const float m=max2f(a,b);
  auto rr=__builtin_amdgcn_permlane32_swap(__float_as_uint(m),__float_as_uint(m),false,false);
  return max2f(__uint_as_float(rr[0]),__uint_as_float(rr[1]));
}
__device__ __forceinline__ void pv(f32x16*o,int vb,bf16x8 pa0,bf16x8 pa1,bf16x8 pa2,bf16x8 pa3){
  #pragma unroll
  for(int d0=0;d0<2;++d0){s16x4 lo[4],hi[4];
    #pragma unroll
    for(int ks=0;ks<4;++ks){
      asm volatile("ds_read_b64_tr_b16 %0,%1 offset:%c2":"=&v"(lo[ks]):"v"(vb),"i"(d0*4096+ks*1024):"memory");
      asm volatile("ds_read_b64_tr_b16 %0,%1 offset:%c2":"=&v"(hi[ks]):"v"(vb),"i"(d0*4096+ks*1024+512):"memory");}
    asm volatile("s_waitcnt lgkmcnt(0)":::"memory");SBAR();
    #define PK(k) (bf16x8){lo[k][0],lo[k][1],lo[k][2],lo[k][3],hi[k][0],hi[k][1],hi[k][2],hi[k][3]}
    o[d0]=__builtin_amdgcn_mfma_f32_32x32x16_bf16(pa0,PK(0),o[d0],0,0,0);
    o[d0]=__builtin_amdgcn_mfma_f32_32x32x16_bf16(pa1,PK(1),o[d0],0,0,0);
    o[d0]=__builtin_amdgcn_mfma_f32_32x32x16_bf16(pa2,PK(2),o[d0],0,0,0);
    o[d0]=__builtin_amdgcn_mfma_f32_32x32x16_bf16(pa3,PK(3),o[d0],0,0,0);
    #undef PK
  }
}

#ifndef ATTN_STORE16
#define ATTN_STORE16(p,v) (*(u32x4*)(p)=(v))
#endif
template<int THRL,bool WIN> __device__ __forceinline__ void attn_unit(const bf16*Qb,const bf16*__restrict__ Kb,const bf16*__restrict__ Vb,bf16*Ob,int q0,int NT,int tdelta,float sink_l2,int tid,char*shm){
  const int lane=tid&63,r32=lane&31,hi=lane>>5; const int wid=__builtin_amdgcn_readfirstlane(tid>>6);
  const bf16*Qw=Qb+(long)(q0+wid*QBLK)*QP;
  const bf16*Kh=Kb,*Vh=Vb;
  const unsigned lds0=(unsigned)(uintptr_t)shm;
  float*wsf=(float*)(shm+LDS_WS)+wid*64;
  const bf16*ksrc=Kh+(long)lane*QP+wid*8;
  const bf16*vsrc=Vh+(long)(16*(wid&3)+(lane>>2))*QP+(wid>>2)*32+(lane&3)*8;
  const unsigned kdst=lds0+LDS_K+wid*1024, vdst=lds0+LDS_V+wid*1024;
  #define TM(t) ((t)<4?(t):(t)+tdelta)
  #define DMA_K(t,slot) glds16(ksrc+(long)TM(t)*KVBLK*QP,(unsigned)__builtin_amdgcn_readfirstlane(kdst+(slot)))
  #define DMA_V(t,slot) glds16(vsrc+(long)TM(t)*KVBLK*QP,(unsigned)__builtin_amdgcn_readfirstlane(vdst+(slot)))
  const int vb0=(int)(lds0+LDS_V)+((lane>>4)&1)*32+(lane&3)*8+(4*hi+((lane&15)>>2))*64;
  const char*Kbase=shm+LDS_K; bf16x8 kf[8];
  const lds_cptr shm3=(lds_cptr)shm; const lds_cptr kp0=shm3+LDS_K+hi*1024+r32*16; const lds_cptr vp0=shm3+LDS_V+((lane>>4)&1)*32+(lane&3)*8+(4*hi+((lane&15)>>2))*64;
  DMA_K(0,0);DMA_V(0,0);DMA_K(1,SLOTB);
  bf16x8 qr[4];
  #pragma unroll
  for(int d0=0;d0<4;++d0)qr[d0]=*reinterpret_cast<const bf16x8*>(&Qw[(long)r32*QP+d0*16+hi*8]);
  float mhat=0.f,l_reg=0.f;float z0_=0.f;asm volatile("":"+v"(z0_));f32x16 o[2];
  #pragma unroll
  for(int r_=0;r_<16;++r_){o[0][r_]=z0_;o[1][r_]=z0_;}
  f32x16 negm;
  #pragma unroll
  for(int r_=0;r_<16;++r_)negm[r_]=z0_;
  asm volatile("":"+v"(negm));
  const int qrow=q0+wid*QBLK+r32;
  #define CMASK(P0,P1,t) do{ if(WIN&&(t)>=4)wmask(P0,P1,TM(t)*KVBLK-qrow,hi); }while(0)
  bool resc=false;
  #define START(P0,P1) do{ const float rm=rowmax(P0,P1); resc=false; \
    { const float dl=rm; mhat=fadd_s(mhat,dl); \
      _Pragma("unroll") for(int r=0;r<16;++r){P0[r]=fsub_s(P0[r],dl);P1[r]=fsub_s(P1[r],dl);} \
      _Pragma("unroll") for(int r=0;r<16;++r)negm[r]=-mhat; asm volatile("":"+v"(negm)); } \
    _Pragma("unroll") for(int r=0;r<16;++r)P0[r]=__builtin_amdgcn_exp2f(P0[r]); }while(0)
  #define RESC() do{ if(resc){ asm volatile("s_waitcnt lgkmcnt(0)":::"memory"); \
      _Pragma("unroll") for(int d_=0;d_<2;++d_) _Pragma("unroll") for(int r=0;r<16;++r)o[d_][r]*=wsf[crow(r,hi)]; } }while(0)
  f32x16 pA0,pA1,pB0,pB1;
  int sl_prev=0,sl_cur=0,sl_next=SLOTB;
  #define ROT() do{sl_prev=sl_cur;sl_cur=sl_next;sl_next=(sl_next==(NSLOT-1)*SLOTB)?0:sl_next+SLOTB;}while(0)
  DMA_K(2,2*SLOTB);
  WAIT_BAR(3);
  qkt(pA0,pA1,Kbase,qr,negm,r32,hi);asm volatile("s_nop 15\n\ts_nop 7":"+v"(pA0),"+v"(pA1));CMASK(pA0,pA1,0);
  START(pA0,pA1);
  _Pragma("unroll") for(int r=0;r<16;++r)pA1[r]=__builtin_amdgcn_exp2f(pA1[r]);
  WAIT_BAR(0);
  DMA_K(3,0);DMA_V(1,SLOTB);
  ROT();
  kload8(kf,kp0+sl_cur);
  WAIT_BAR(2);
  s16x4 vlo[8],vhi[8]; u32x4 pw0,pw1,pw2,pw3;
  #define PKW(P,B) cvtpk_s(P[B],P[B+1])
  #define PAF(k) __builtin_bit_cast(bf16x8,pw##k)
  #define VFR(i) (bf16x8){vlo[i][0],vlo[i][1],vlo[i][2],vlo[i][3],vhi[i][0],vhi[i][1],vhi[i][2],vhi[i][3]}
  #define PIN(x) asm volatile("":"+v"(x))
  #define MX3(a,b,c) __builtin_fmaxf(__builtin_fmaxf((a),(b)),(c))
  #define GAPA(MF,A0,A1,A2,A3,W0,W1,PW) do{ MF; sacc+=A0; sacc+=A1; sacc+=A2; sacc+=A3; PIN(sacc); W0; W1; PIN(PW); SBAR(); }while(0)
  #define EX(v) __builtin_amdgcn_exp2f(v)
  #define GAPB(MF,X,B) do{ MF; X[B]=EX(X[B]); X[B+1]=EX(X[B+1]); X[B+2]=EX(X[B+2]); X[B+3]=EX(X[B+3]); PIN(X); SBAR(); }while(0)
  #define VRD(i) do{ vlo[i]=vtr(vp_+(((i)>>2)*4096+((i)&3)*1024)); vhi[i]=vtr(vp_+(((i)>>2)*4096+((i)&3)*1024+512)); }while(0)
  #define KRD(G,j) do{ if(G){ kload2(kf,kp0+sl_next,j); SBAR(); } }while(0)
  #define STEP(C0,C1,P0,P1,t,GK,GV,GL) do{ SBAR(); \
    const lds_cptr vp_=vp0+sl_prev; \
    VRD(0); SBAR(); float sacc=(P0[0]+P0[1]); \
    GAPA(C0=__builtin_amdgcn_mfma_f32_32x32x16_bf16(kf[0],qr[0],negm,0,0,0), P0[2],P0[3],P0[4],P0[5],     pw0[0]=PKW(P0,0), pw0[1]=PKW(P0,2), pw0); \
    VRD(4); SBAR(); GAPA(C1=__builtin_amdgcn_mfma_f32_32x32x16_bf16(kf[1],qr[0],negm,0,0,0), P0[6],P0[7],P0[8],P0[9],     pw0[2]=PKW(P0,4), pw0[3]=PKW(P0,6), pw0); \
    VRD(1); SBAR(); GAPA(C0=__builtin_amdgcn_mfma_f32_32x32x16_bf16(kf[2],qr[1],C0,0,0,0),   P0[10],P0[11],P0[12],P0[13], pw1[0]=PKW(P0,8), pw1[1]=PKW(P0,10), pw1); \
    VRD(5); SBAR(); GAPA(C1=__builtin_amdgcn_mfma_f32_32x32x16_bf16(kf[3],qr[1],C1,0,0,0),   P0[14],P0[15],P1[0],P1[1],   pw1[2]=PKW(P0,12),pw1[3]=PKW(P0,14), pw1); \
    VRD(2); SBAR(); GAPA(C0=__builtin_amdgcn_mfma_f32_32x32x16_bf16(kf[4],qr[2],C0,0,0,0),   P1[2],P1[3],P1[4],P1[5],     pw2[0]=PKW(P1,0), pw2[1]=PKW(P1,2), pw2); \
    VRD(6); SBAR(); GAPA(C1=__builtin_amdgcn_mfma_f32_32x32x16_bf16(kf[5],qr[2],C1,0,0,0),   P1[6],P1[7],P1[8],P1[9],     pw2[2]=PKW(P1,4), pw2[3]=PKW(P1,6), pw2); \
    VRD(3); SBAR(); GAPA(C0=__builtin_amdgcn_mfma_f32_32x32x16_bf16(kf[6],qr[3],C0,0,0,0),   P1[10],P1[11],P1[12],P1[13], pw3[0]=PKW(P1,8), pw3[1]=PKW(P1,10), pw3); \
    VRD(7); SBAR(); GAPA(C1=__builtin_amdgcn_mfma_f32_32x32x16_bf16(kf[7],qr[3],C1,0,0,0),   P1[14],P1[15],0.f,0.f,       pw3[2]=PKW(P1,12),pw3[3]=PKW(P1,14), pw3); \
    l_reg+=sacc; \
    if(GK){DMA_K((t)+3,sl_cur);} if(GV){DMA_V((t)+1,sl_next);} \
    CMASK(C0,C1,t); \
    { float a=MX3(C0[0],C0[1],C1[0]),b=MX3(C0[2],C0[3],C1[1]); a=MX3(a,C1[2],C1[3]); \
      _Pragma("unroll") for(int r=4;r<16;r+=4){a=MX3(a,C0[r],C0[r+1]);b=MX3(b,C0[r+2],C0[r+3]);a=MX3(a,C1[r],C1[r+1]);b=MX3(b,C1[r+2],C1[r+3]);} \
      float rm=__builtin_fmaxf(a,b); { auto rr=__builtin_amdgcn_permlane32_swap(__float_as_uint(rm),__float_as_uint(rm),false,false); rm=__builtin_fmaxf(__uint_as_float(rr[0]),__uint_as_float(rr[1])); } \
      resc=false; \
      if(__builtin_expect(__any(rm>(float)THRL),0)){ const float dl=__builtin_fmaxf(rm,0.f); mhat+=dl; \
        _Pragma("unroll") for(int r=0;r<16;++r){C0[r]-=dl;C1[r]-=dl;} \
        _Pragma("unroll") for(int r=0;r<16;++r)negm[r]=-mhat; asm volatile("":"+v"(negm)); \
        const float f=__builtin_amdgcn_exp2f(-dl); l_reg*=f; if(hi==0)wsf[r32]=f; resc=true; } } \
    SBAR(); \
    GAPB(o[0]=__builtin_amdgcn_mfma_f32_32x32x16_bf16(PAF(0),VFR(0),o[0],0,0,0), C0,0); \
    GAPB(o[1]=__builtin_amdgcn_mfma_f32_32x32x16_bf16(PAF(0),VFR(4),o[1],0,0,0), C0,4); \
    KRD(GL,0); GAPB(o[0]=__builtin_amdgcn_mfma_f32_32x32x16_bf16(PAF(1),VFR(1),o[0],0,0,0), C0,8); \
    KRD(GL,1); GAPB(o[1]=__builtin_amdgcn_mfma_f32_32x32x16_bf16(PAF(1),VFR(5),o[1],0,0,0), C0,12); \
    KRD(GL,2); GAPB(o[0]=__builtin_amdgcn_mfma_f32_32x32x16_bf16(PAF(2),VFR(2),o[0],0,0,0), C1,0); \
    KRD(GL,3); GAPB(o[1]=__builtin_amdgcn_mfma_f32_32x32x16_bf16(PAF(2),VFR(6),o[1],0,0,0), C1,4); \
    GAPB(o[0]=__builtin_amdgcn_mfma_f32_32x32x16_bf16(PAF(3),VFR(3),o[0],0,0,0), C1,8); \
    GAPB(o[1]=__builtin_amdgcn_mfma_f32_32x32x16_bf16(PAF(3),VFR(7),o[1],0,0,0), C1,12); \
    }while(0)
  int t=1;
  for(;t+5<NT;t+=2){
    STEP(pB0,pB1,pA0,pA1,t,true,true,true);     WAIT_BAR(2); RESC(); ROT();
    STEP(pA0,pA1,pB0,pB1,t+1,true,true,true);   WAIT_BAR(2); RESC(); ROT();
  }
  #define ENDW(tt) do{ if((tt)+3<NT){WAIT_BAR(2);} else if((tt)+2<NT){WAIT_BAR(1);} else {WAIT_BAR(0);} }while(0)
  for(;t+1<NT;t+=2){
    STEP(pB0,pB1,pA0,pA1,t,(t+3<NT),(t+1<NT),(t+1<NT));       ENDW(t);   RESC(); ROT();
    STEP(pA0,pA1,pB0,pB1,t+1,(t+4<NT),(t+2<NT),(t+2<NT));     ENDW(t+1); RESC(); ROT();
  }
  STEP(pB0,pB1,pA0,pA1,NT-1,false,false,false); RESC();
  { float sacc=pB0[0]+pB0[1]; _Pragma("unroll") for(int r=2;r<16;++r)sacc+=pB0[r]; _Pragma("unroll") for(int r=0;r<16;++r)sacc+=pB1[r]; l_reg+=sacc;
    pw0=(u32x4){PKW(pB0,0),PKW(pB0,2),PKW(pB0,4),PKW(pB0,6)};pw1=(u32x4){PKW(pB0,8),PKW(pB0,10),PKW(pB0,12),PKW(pB0,14)};pw2=(u32x4){PKW(pB1,0),PKW(pB1,2),PKW(pB1,4),PKW(pB1,6)};pw3=(u32x4){PKW(pB1,8),PKW(pB1,10),PKW(pB1,12),PKW(pB1,14)};
    SBAR(); pv(o,vb0+sl_cur,PAF(0),PAF(1),PAF(2),PAF(3)); }
  #undef PKW
  #undef PAF
  #undef VFR
  #undef PIN
  #undef MX3
  #undef GAPA
  #undef GAPB
  #undef EX
  #undef VRD
  #undef KRD
  #undef STEP
  #undef ENDW
  {auto rr=__builtin_amdgcn_permlane32_swap(__float_as_uint(l_reg),__float_as_uint(l_reg),false,false);l_reg=__uint_as_float(rr[0])+__uint_as_float(rr[1]);}
  if(WIN)l_reg+=__builtin_amdgcn_exp2f(sink_l2-mhat);
  if(hi==0)wsf[32+r32]=l_reg;asm volatile("s_waitcnt lgkmcnt(0)":::"memory");
  float rli[16];
  #pragma unroll
  for(int r=0;r<16;++r)rli[r]=__builtin_amdgcn_rcpf(wsf[32+crow(r,hi)]);
  bf16*Ow=Ob+(long)(q0+wid*QBLK)*OP;
  { bf16*stg=(bf16*)(shm+LDS_OST)+wid*2048;
    #pragma unroll
    for(int r=0;r<16;++r){const int orow=crow(r,hi);
      #pragma unroll
      for(int d0=0;d0<2;++d0)stg[orow*64+d0*32+r32]=__float2bfloat16(o[d0][r]*rli[r]);}
    asm volatile("s_waitcnt lgkmcnt(0)":::"memory");
    #pragma unroll
    for(int i=0;i<4;++i){const int row=i*8+(lane>>3),ch=lane&7; const u32x4 v=*(const u32x4*)(stg+row*64+ch*8); ATTN_STORE16(Ow+(long)row*OP+ch*8,v);} }
  asm volatile("s_waitcnt lgkmcnt(0)\n\ts_barrier":::"memory");
  #undef TM
  #undef DMA_K
  #undef DMA_V
  #undef CMASK
  #undef START
  #undef RESC
  #undef ROT
}
constexpr int ATTN_LDS_BYTES=LDS_BYTES;
#undef SBAR
#undef WAIT_BAR
}
#define XB_TMO      128
#define XB_XCNT(j)  (256  + 64 * (j))
#define XB_XSUB(j)  (1280 + 64 * (j))
#define XB_XGEN(j)  (2304 + 64 * (j))
#define XB_TOP      3328
#define XB_TOPGEN   3392
#define XCD_BAR_WORDS 3456
#define XB_SPIN_CAP (1u << 21)

__device__ __forceinline__ unsigned xb_ld(unsigned* p)              { return __hip_atomic_load(p, __ATOMIC_RELAXED, __HIP_MEMORY_SCOPE_AGENT); }
__device__ __forceinline__ unsigned xb_add(unsigned* p, unsigned v) { return __hip_atomic_fetch_add(p, v, __ATOMIC_RELAXED, __HIP_MEMORY_SCOPE_AGENT); }
__device__ __forceinline__ unsigned xb_xcc_id() { return (unsigned)__builtin_amdgcn_s_getreg((3 << 11) | 20) & 0xFu; }
#define XB_SPIN(cond, bar) do { unsigned _sp = 0; while (cond) { __builtin_amdgcn_s_sleep(1); \
    if ((++_sp & 255u) == 0u) { if (xb_ld(&(bar)[XB_TMO])) break; if (_sp > XB_SPIN_CAP) { atomicAdd(&(bar)[XB_TMO], 1u); break; } } } } while (0)

struct XcdBarrier {
    unsigned* bar; unsigned x;
    volatile LAS unsigned* st;
};

__device__ __forceinline__ XcdBarrier xcd_barrier_post(unsigned* bar, volatile LAS unsigned* st) {
    XcdBarrier b; b.bar = bar; b.x = xb_xcc_id(); b.st = st;
    if (threadIdx.x == 0) (void)xb_add(&bar[XB_XCNT(b.x)], 1u);
    return b;
}
__device__ __forceinline__ void xcd_barrier_complete(unsigned* bar, unsigned x, unsigned& nloc, unsigned& nx) {
    const unsigned G = gridDim.x * gridDim.y * gridDim.z;
    unsigned sum, cnt, mine, sp = 0u;
    for (;;) {
        sum = 0u; cnt = 0u; mine = 0u;
#pragma unroll
        for (unsigned j = 0; j < 16; ++j) { const unsigned c = xb_ld(&bar[XB_XCNT(j)]); sum += c; cnt += (c > 0u) ? 1u : 0u; mine = (j == x) ? c : mine; }
        if (sum == G) break;
        __builtin_amdgcn_s_sleep(1);
        if ((++sp & 255u) == 0u) { if (xb_ld(&bar[XB_TMO])) break; if (sp > XB_SPIN_CAP) { atomicAdd(&bar[XB_TMO], 1u); break; } }
    }
    nloc = mine > 0u ? mine : 1u; nx = cnt > 0u ? cnt : 1u;
}

__device__ __forceinline__ void xcd_barrier(const XcdBarrier& b) {
    asm volatile("s_waitcnt vmcnt(0)" ::: "memory");
    __syncthreads();
    if (threadIdx.x == 0) {
        unsigned* bar = b.bar; unsigned bx_ = b.x; asm volatile("" : "+s"(bar), "+s"(bx_));
        __builtin_amdgcn_s_waitcnt(0);
        unsigned nloc = b.st[0], nx = b.st[1];
        if (nloc == 0u) { xcd_barrier_complete(bar, bx_, nloc, nx); b.st[0] = nloc; b.st[1] = nx; }
        const unsigned old = xb_add(&bar[XB_XSUB(bx_)], 1u);
        const unsigned gen = old / nloc;
        if (old + 1u == (gen + 1u) * nloc) {
            __builtin_amdgcn_fence(__ATOMIC_RELEASE, "agent");
            asm volatile("s_waitcnt vmcnt(0)" ::: "memory");
            const unsigned og = xb_add(&bar[XB_TOP], 1u);
            const unsigned tg = og / nx;
            if (og + 1u == (tg + 1u) * nx) xb_add(&bar[XB_TOPGEN], 1u);
            else XB_SPIN(xb_ld(&bar[XB_TOPGEN]) == tg, bar);
            __builtin_amdgcn_fence(__ATOMIC_ACQUIRE, "agent");
            xb_add(&bar[XB_XGEN(bx_)], 1u);
            asm volatile("s_waitcnt vmcnt(0)" ::: "memory");
        } else {
            XB_SPIN(xb_ld(&bar[XB_XGEN(bx_)]) == gen, bar);
            __builtin_amdgcn_fence(__ATOMIC_ACQUIRE, "agent");
            asm volatile("s_waitcnt vmcnt(0)" ::: "memory");
        }
    }
    __syncthreads();
}

#ifndef CVQ0
#define CVQ0 3
#define CVQ1 4
#define CVQ2 3
#define CVQ3 3
#endif
constexpr size_t alup(size_t x) { return (x + 4095) & ~(size_t)4095; }
constexpr size_t CTL_BYTES = 1u << 20;
constexpr size_t SZ_WIN = (size_t)DEPTH * DIN * DM * 2, SZ_WOUT = (size_t)DEPTH * DM * DM * 2, SZ_WGU = (size_t)DEPTH * NE * 2 * FF * DM  , SZ_WDN = (size_t)DEPTH * NE * DM * FF  ;
constexpr size_t SZ_MODP = (size_t)DEPTH * 16 * 17 * 6144 * 4, SZ_MOD = (size_t)DEPTH * 17 * 6144 * 4;
constexpr size_t SZ_X32 = (size_t)MROWS * DM * 2  , SZ_H = (size_t)MROWS * DM * 2, SZ_P = (size_t)MROWS * DIN * 2, SZ_Y = (size_t)MROWS * DM * 2, SZ_YP = (size_t)MROWS * 2 * DM  ;
constexpr size_t SZ_LIST = (size_t)NE * MROWS * 4, SZ_GW = (size_t)NE * MROWS * 4  ;
constexpr int MAXBLK = (MROWS * 2) / 256 + NE;
static_assert((size_t)MAXBLK * 256 * FF * 2 <= SZ_P, "HMID overlays P");
static_assert((size_t)2 * NB * 4 * NCH * 128 * 64 * 4 <= SZ_H, "KVT overlays H");
static_assert((size_t)2 * NB * 4 * NCH * 128 * 64 * 2 <= SZ_YP, "ST overlays YP");
constexpr size_t WS_CTL = 0;
constexpr size_t WS_WIN = CTL_BYTES, WS_WOUT = WS_WIN + alup(SZ_WIN), WS_WGU = WS_WOUT + alup(SZ_WOUT), WS_WDN = WS_WGU + alup(SZ_WGU);
constexpr size_t WS_MODP = WS_WDN + alup(SZ_WDN), WS_MOD = WS_MODP + alup(SZ_MODP);
constexpr size_t WS_X32 = WS_MOD + alup(SZ_MOD), WS_H = WS_X32 + alup(SZ_X32), WS_P = WS_H + alup(SZ_H), WS_Y = WS_P + alup(SZ_P), WS_YP = WS_Y + alup(SZ_Y);
constexpr size_t WS_LIST = WS_YP + alup(SZ_YP), WS_GW = WS_LIST + alup(SZ_LIST), WS_END = WS_GW + alup(SZ_GW);
constexpr int CW_BAR = 4096;
constexpr int CW_CNT = 16384;

constexpr int RING_BYTES = 131072;
constexpr int LDSCTL_OFF = RING_BYTES;
constexpr int LDS_BYTES = 147456;

#define ATTN_STORE16(p,v) (*(u32x4*)(p)=(v))

#define CAS __attribute__((address_space(4)))
__device__ __forceinline__ const float* inp(int i) {
    const CAS unsigned char* k = (const CAS unsigned char*)__builtin_amdgcn_kernarg_segment_ptr();
    asm volatile("" : "+s"(k));
    return *(const float* const CAS*)(k + 8 * i);
}
#define CBAR() do { asm volatile("" ::: "memory"); __builtin_amdgcn_sched_barrier(0); } while (0)
struct Ctx {
    float* out; unsigned char* ws;
    __device__ __forceinline__ const float* x() const { return inp(0); }
    __device__ __forceinline__ const float* c() const { return inp(1); }
    __device__ __forceinline__ const float* ctx() const { return inp(2); }
    __device__ __forceinline__ const float* c_ctx() const { return inp(3); }
    __device__ __forceinline__ const float* ada_w() const { return inp(4); }
    __device__ __forceinline__ const float* ada_b() const { return inp(5); }
    __device__ __forceinline__ const float* norm1() const { return inp(6); }
    __device__ __forceinline__ const float* norm2() const { return inp(7); }
    __device__ __forceinline__ const float* w_in() const { return inp(8); }
    __device__ __forceinline__ const float* w_out() const { return inp(9); }
    __device__ __forceinline__ const float* ret_decay() const { return inp(10); }
    __device__ __forceinline__ const float* win_gain() const { return inp(11); }
    __device__ __forceinline__ const float* win_sink() const { return inp(12); }
    __device__ __forceinline__ const float* glb_gain() const { return inp(13); }
    __device__ __forceinline__ const float* w_router() const { return inp(14); }
    __device__ __forceinline__ const float* b_router() const { return inp(15); }
    __device__ __forceinline__ const float* w_gu() const { return inp(16); }
    __device__ __forceinline__ const float* w_dn() const { return inp(17); }
};

template <int CTRL> __device__ __forceinline__ float dppx(float v) { return __builtin_bit_cast(float, __builtin_amdgcn_update_dpp(0, __builtin_bit_cast(int, v), CTRL, 0xF, 0xF, true)); }
__device__ __forceinline__ float xor1(float v) { return dppx<0xB1>(v); }
__device__ __forceinline__ float xor2(float v) { return dppx<0x4E>(v); }
__device__ __forceinline__ float wave_sum(float v) {
    v += dppx<0xB1>(v); v += dppx<0x4E>(v); v += dppx<0x141>(v); v += dppx<0x140>(v);
    { const unsigned u = __builtin_bit_cast(unsigned, v); auto r = __builtin_amdgcn_permlane16_swap(u, u, false, false); v = __builtin_bit_cast(float, (unsigned)r[0]) + __builtin_bit_cast(float, (unsigned)r[1]); }
    { const unsigned u = __builtin_bit_cast(unsigned, v); auto r = __builtin_amdgcn_permlane32_swap(u, u, false, false); v = __builtin_bit_cast(float, (unsigned)r[0]) + __builtin_bit_cast(float, (unsigned)r[1]); }
    return v;
}
__device__ __forceinline__ float xor16(float v, int lane) { const unsigned u = __builtin_bit_cast(unsigned, v); auto r = __builtin_amdgcn_permlane16_swap(u, u, false, false);
    return __builtin_bit_cast(float, (lane & 16) ? (unsigned)r[0] : (unsigned)r[1]); }
__device__ __forceinline__ float silu_f(float v) { return v * __builtin_amdgcn_rcpf(1.f + __builtin_amdgcn_exp2f(-LOG2E * v)); }
__device__ __forceinline__ float log2_sigmoid(float x) { return -log1pf(expf(-x)) * LOG2E; }

__device__ __forceinline__ void transpose_item(const float* W, int N, int nsrc0, int k0, bf16_t* WT, int K, int nrow0, LAS float* scr, int lane) {
    float ld_[32];
#pragma unroll
    for (int i = 0; i < 32; ++i) ld_[i] = W[(size_t)(k0 + 2 * i + (lane >> 5)) * N + nsrc0 + (lane & 31)];
#pragma unroll
    for (int i = 0; i < 32; ++i) scr[(2 * i + (lane >> 5)) * 33 + (lane & 31)] = ld_[i];
    asm volatile("s_waitcnt lgkmcnt(0)" ::: "memory");
    const int c = lane & 7;
#pragma unroll
    for (int j = 0; j < 4; ++j) { const int n = (lane >> 3) + 8 * j; const LAS float* s = scr + (8 * c) * 33 + n;
        u32x4 o; o.x = pk2(s[0 * 33], s[1 * 33]); o.y = pk2(s[2 * 33], s[3 * 33]); o.z = pk2(s[4 * 33], s[5 * 33]); o.w = pk2(s[6 * 33], s[7 * 33]);
        *(u32x4*)(WT + (size_t)(nrow0 + n) * K + k0 + 8 * c) = o; }
    asm volatile("s_waitcnt lgkmcnt(0)" ::: "memory");
}
__device__ __forceinline__ unsigned pk4_fp8(float a, float b, float c, float d) { int w = 0; w = __builtin_amdgcn_cvt_pk_fp8_f32(a, b, w, false); w = __builtin_amdgcn_cvt_pk_fp8_f32(c, d, w, true); return (unsigned)w; }
__device__ __forceinline__ f32x4 fp8x4_f32(unsigned w) { typedef float f2_ __attribute__((ext_vector_type(2))); const f2_ lo = __builtin_amdgcn_cvt_pk_f32_fp8((int)w, false), hi = __builtin_amdgcn_cvt_pk_f32_fp8((int)w, true); return (f32x4){lo[0], lo[1], hi[0], hi[1]}; }
constexpr float YP_SCALE = 16.0f, YP_INV = 1.0f / 16.0f;
constexpr float W8_SCALE = 64.0f, W8_INV = 1.0f / 64.0f;
__device__ __forceinline__ void transpose_item8(const float* W, int N, int nsrc0, int k0, unsigned char* WT, int K, int nrow0, LAS float* scr, int lane) {
    float ld_[32];
#pragma unroll
    for (int i = 0; i < 32; ++i) ld_[i] = W[(size_t)(k0 + 2 * i + (lane >> 5)) * N + nsrc0 + (lane & 31)];
#pragma unroll
    for (int i = 0; i < 32; ++i) scr[(2 * i + (lane >> 5)) * 33 + (lane & 31)] = ld_[i];
    asm volatile("s_waitcnt lgkmcnt(0)" ::: "memory");
    const int c = lane & 7;
#pragma unroll
    for (int j = 0; j < 4; ++j) { const int n = (lane >> 3) + 8 * j; const LAS float* s = scr + (8 * c) * 33 + n;
        u32x2 o; o.x = pk4_fp8(s[0 * 33] * W8_SCALE, s[1 * 33] * W8_SCALE, s[2 * 33] * W8_SCALE, s[3 * 33] * W8_SCALE); o.y = pk4_fp8(s[4 * 33] * W8_SCALE, s[5 * 33] * W8_SCALE, s[6 * 33] * W8_SCALE, s[7 * 33] * W8_SCALE);
        *(u32x2*)(WT + (size_t)(nrow0 + n) * K + k0 + 8 * c) = o; }
    asm volatile("s_waitcnt lgkmcnt(0)" ::: "memory");
}
constexpr int IT_WIN = 16 * 80, IT_WOUT = 16 * 32, IT_GU = 16 * 64, IT_DN = 16 * 32, IT_LAYER = IT_WIN + IT_WOUT + NE * (IT_GU + IT_DN);
__device__ __forceinline__ void convert_item(const Ctx& C, int l, int r, LAS float* scr, int lane) {
    if (r < IT_WIN) { const int kb = r / 80, nb = r % 80;
        transpose_item(C.w_in() + (size_t)l * DM * DIN, DIN, 32 * nb, 64 * kb, (bf16_t*)(C.ws + WS_WIN) + (size_t)l * DIN * DM, DM, 32 * nb, scr, lane); return; }
    r -= IT_WIN;
    if (r < IT_WOUT) { const int kb = r / 32, nb = r % 32;
        transpose_item(C.w_out() + (size_t)l * DM * DM, DM, 32 * nb, 64 * kb, (bf16_t*)(C.ws + WS_WOUT) + (size_t)l * DM * DM, DM, 32 * nb, scr, lane); return; }
    r -= IT_WOUT;
    if (r < NE * IT_GU) { const int e = r / IT_GU, q = r % IT_GU, kb = q / 64, nb = q % 64;
        const int np = 32 * nb, tile = np >> 8, within = np & 255, nsrc = within < 128 ? tile * 128 + within : FF + tile * 128 + within - 128;
        transpose_item8(C.w_gu() + (size_t)(l * NE + e) * DM * 2 * FF, 2 * FF, nsrc, 64 * kb, (unsigned char*)(C.ws + WS_WGU) + (size_t)(l * NE + e) * 2 * FF * DM, DM, np, scr, lane); return; }
    r -= NE * IT_GU;
    { const int e = r / IT_DN, q = r % IT_DN, kb = q / 32, nb = q % 32;
        transpose_item8(C.w_dn() + (size_t)(l * NE + e) * FF * DM, DM, 32 * nb, 64 * kb, (unsigned char*)(C.ws + WS_WDN) + (size_t)(l * NE + e) * DM * FF, FF, 32 * nb, scr, lane); }
}
__device__ __forceinline__ int cv_lo(int p) { return p == 0 ? 0 : p == 1 ? 3840 : p == 2 ? 13056 : p == 3 ? 19712 : IT_LAYER; }
__device__ __forceinline__ int cv_q(int p) { return p == 0 ? CVQ0 : p == 1 ? CVQ1 : p == 2 ? CVQ2 : CVQ3; }
__device__ __forceinline__ int cv_covered(int p, int units, int G) { const int rem = units % G; if (rem == 0) return 0; const int n = (G - rem) * 8 * cv_q(p), len = cv_lo(p + 1) - cv_lo(p); return n < len ? n : len; }
__device__ __forceinline__ void convert_tail(const Ctx& C, int lnext, int p, int units, int G, int c, LAS unsigned char* lds, int wave, int lane) {
    const int rem = units % G; if (rem == 0 || c < rem) return;
    const int nidle = G - rem, k = c - rem, lo = cv_lo(p), hi = cv_lo(p + 1);
    LAS float* scr = (LAS float*)(lds + wave * 16384);
    for (int j = 0; j < cv_q(p); ++j) { const int it = lo + (j * nidle + k) * 8 + wave; if (it < hi) convert_item(C, lnext, it, scr, lane); }
}
__device__ __forceinline__ void convert_rest(const Ctx& C, int l, int G, int vcu, LAS unsigned char* lds, int wave, int lane, int units2, int units3) {
    LAS float* scr = (LAS float*)(lds + wave * 16384);
    const int gw = vcu * 8 + wave, NGW = G * 8;
    const int lo0 = cv_lo(0) + cv_covered(0, (MROWS / 256) * (DIN / 256), G), lo1 = cv_lo(1) + cv_covered(1, (MROWS / 256) * (DM / 256), G), lo2 = cv_lo(2) + cv_covered(2, units2, G), lo3 = cv_lo(3) + cv_covered(3, units3, G);
    const int n0 = cv_lo(1) - lo0, n1 = cv_lo(2) - lo1, n2 = cv_lo(3) - lo2, n3 = cv_lo(4) - lo3;
    for (int v = gw; v < n0 + n1 + n2 + n3; v += NGW) { int r = v, it;
        if (r < n0) it = lo0 + r; else { r -= n0; if (r < n1) it = lo1 + r; else { r -= n1; if (r < n2) it = lo2 + r; else it = lo3 + (r - n2); } }
        convert_item(C, l, it, scr, lane); }
}
__device__ __forceinline__ void phase_prologue(const Ctx& C, LAS unsigned char* lds, int G, int vcu, int bx, int tid) {
    const int lane = tid & 63, wave = tid >> 6;
    {
        LAS float* scs = (LAS float*)lds;
        bool have = false;
        for (int it = bx; it < DEPTH * 12 * 16; it += G) {
            if (!have) {
                for (int i = tid; i < 17 * DM; i += 512) { const int r = i >> 10, k = i & 1023; const float v = r < 16 ? C.c()[r * DM + k] : C.c_ctx()[k]; scs[i] = v / (1.f + expf(-v)); }
                __syncthreads(); have = true;
            }
            const int l = it / 192, rem = it % 192, cb = rem / 16, kc = rem % 16;
            const float* w = C.ada_w() + ((size_t)l * DM + kc * 64) * 6144 + cb * 512 + tid;
            float acc[17];
#pragma unroll
            for (int r = 0; r < 17; ++r) acc[r] = 0.f;
#pragma unroll 4
            for (int kk = 0; kk < 64; ++kk) { const float wv = w[(size_t)kk * 6144];
#pragma unroll
                for (int r = 0; r < 17; ++r) acc[r] += scs[r * DM + kc * 64 + kk] * wv; }
            float* mp = (float*)(C.ws + WS_MODP) + ((size_t)(l * 16 + kc) * 17) * 6144 + cb * 512 + tid;
#pragma unroll
            for (int r = 0; r < 17; ++r) mp[(size_t)r * 6144] = acc[r];
        }
        __syncthreads();
    }
    LAS float* scr = (LAS float*)(lds + wave * 16384);
    const int gw = vcu * 8 + wave, NGW = G * 8;
    for (int it = gw; it < IT_LAYER; it += NGW) convert_item(C, 0, it, scr, lane);
}
__device__ __forceinline__ void phase_modsum(const Ctx& C, int G, int bx, int tid) {
    const float* mp = (const float*)(C.ws + WS_MODP); float* mod = (float*)(C.ws + WS_MOD);
    for (int i = bx * 512 + tid; i < DEPTH * 17 * 6144; i += G * 512) {
        const int l = i / (17 * 6144), rem = i % (17 * 6144), r = rem / 6144, n = rem % 6144;
        float s = C.ada_b()[l * 6144 + n];
#pragma unroll
        for (int kc = 0; kc < 16; ++kc) s += mp[((size_t)(l * 16 + kc) * 17 + r) * 6144 + n];
        mod[i] = s;
    }
}

__device__ __forceinline__ f32x4 bf4(u32x2 a) { return (f32x4){bflo(a.x), bfhi(a.x), bflo(a.y), bfhi(a.y)}; }
__device__ __forceinline__ u32x2 pk4(f32x4 v) { u32x2 w; w.x = pk2(v[0], v[1]); w.y = pk2(v[2], v[3]); return w; }
__device__ __forceinline__ void phase_norm1(const Ctx& C, int layer, int gw, int NGW, int lane, bf16_t* XO) {
    const float* mod = (const float*)(C.ws + WS_MOD) + (size_t)layer * 17 * 6144;
    const float* gain = C.norm1() + layer * DM;
    bf16_t* XR = (bf16_t*)(C.ws + WS_X32); bf16_t* H = (bf16_t*)(C.ws + WS_H); const unsigned char* YP = (const unsigned char*)(C.ws + WS_YP);
    const float* xin = C.x(); const float* cin = C.ctx();
    f32x4 nx[4]; u32x2 nr[4]; unsigned na[4], nb[4];
#define N1_LOAD(mm) do { const int b_ = (mm) / TPB, t_ = (mm) - b_ * TPB; \
        if (layer == 0) { const f32x4* s_ = (const f32x4*)(t_ < CTX ? cin + ((size_t)b_ * CTX + t_) * DM : xin + ((size_t)b_ * SEQ + (t_ - CTX)) * DM) + lane; \
            _Pragma("unroll") for (int j = 0; j < 4; ++j) nx[j] = s_[64 * j]; } \
        else { const u32x2* s_ = (const u32x2*)(XR + (size_t)(mm) * DM) + lane; const unsigned* y0_ = (const unsigned*)(YP + (size_t)(mm) * 2 * DM) + lane; \
            _Pragma("unroll") for (int j = 0; j < 4; ++j) { nr[j] = s_[64 * j]; na[j] = y0_[64 * j]; nb[j] = y0_[DM / 4 + 64 * j]; } } } while (0)
    if (gw < MROWS) N1_LOAD(gw);
    for (int m = gw; m < MROWS; m += NGW) {
        const int b = m / TPB, t = m - b * TPB, set = t < CTX ? 16 : b;
        f32x4 v[4];
        if (layer == 0) {
#pragma unroll
            for (int j = 0; j < 4; ++j) v[j] = nx[j];
        } else {
            const f32x4* g2 = (const f32x4*)(mod - 17 * 6144 + (size_t)set * 6144 + 5 * DM) + lane;
#pragma unroll
            for (int j = 0; j < 4; ++j) v[j] = bf4(nr[j]) + (g2[64 * j] * YP_INV) * (fp8x4_f32(na[j]) + fp8x4_f32(nb[j]));
        }
        if (m + NGW < MROWS) N1_LOAD(m + NGW);
        u32x2* xo = (u32x2*)(XO + (size_t)m * DM) + lane;
        float ss = 0.f;
#pragma unroll
        for (int j = 0; j < 4; ++j) { xo[64 * j] = pk4(v[j]); ss += (v[j][0] * v[j][0] + v[j][1] * v[j][1]) + (v[j][2] * v[j][2] + v[j][3] * v[j][3]); }
        const float rstd = 1.0f / sqrtf(wave_sum(ss) * (1.f / DM) + EPS);
        const f32x4* gp = (const f32x4*)gain + lane; const f32x4* shp = (const f32x4*)(mod + (size_t)set * 6144) + lane; const f32x4* scp = shp + DM / 4;
        u32x2* ho = (u32x2*)(H + (size_t)m * DM) + lane;
#pragma unroll
        for (int j = 0; j < 4; ++j) ho[64 * j] = pk4((v[j] * rstd) * gp[64 * j] * (scp[64 * j] + 1.0f) + shp[64 * j]);
    }
#undef N1_LOAD
}

__device__ __forceinline__ float swz_xor4(float v) { return __builtin_bit_cast(float, __builtin_amdgcn_ds_swizzle(__builtin_bit_cast(int, v), 0x101F)); }
__device__ __forceinline__ float swz_xor8(float v) { return __builtin_bit_cast(float, __builtin_amdgcn_ds_swizzle(__builtin_bit_cast(int, v), 0x201F)); }
__device__ __forceinline__ void phase_qkprep(const Ctx& C, int layer, int gw, int NGW, int lane, bf16_t* PO) {
    const bf16_t* P = (const bf16_t*)(C.ws + WS_P);
    const int hs = lane >> 3, j = lane & 7;
    const int col0 = (hs < 4 ? C_WQ + 64 * hs : hs < 6 ? C_WK + 64 * (hs - 4) : C_GQ + 64 * (hs - 6)) + 8 * j;
    const int col1 = (hs < 2 ? C_GQ + 128 + 64 * hs : C_GK + 64 * ((hs - 2) & 1)) + 8 * j;
    float g0[8], g1[8], inv[8];
    { const float* wg = C.win_gain() + layer * 128; const float* gg = C.glb_gain() + layer * 128;
      const float* s0p = hs < 4 ? wg : hs < 6 ? wg + 64 : gg; const float sc0 = (hs < 4 || hs >= 6) ? QSCALE : 1.f;
      const float* s1p = hs < 2 ? gg : gg + 64; const float sc1 = hs < 2 ? QSCALE : 1.f;
#pragma unroll
      for (int i = 0; i < 8; ++i) { g0[i] = s0p[8 * j + i] * sc0; g1[i] = s1p[8 * j + i] * sc1; inv[i] = exp2f(-(float)(8 * (j & 1) + i) * (13.287712379549449f / 16.0f)); } }
    const bool x2 = (j & 2) != 0, colax = (j & 4) != 0, act1 = lane < 32;
    u32x4 w0 = {0u, 0u, 0u, 0u}, w1 = {0u, 0u, 0u, 0u};
    if (gw < MROWS) { const bf16_t* row = P + (size_t)gw * DIN; w0 = *(const u32x4*)(row + col0); if (act1) w1 = *(const u32x4*)(row + col1); }
    for (int m = gw; m < MROWS; m += NGW) {
        const u32x4 c0 = w0, c1 = w1;
        if (m + NGW < MROWS) { const bf16_t* row = P + (size_t)(m + NGW) * DIN; w0 = *(const u32x4*)(row + col0); if (act1) w1 = *(const u32x4*)(row + col1); }
        const int b = m / TPB, t = m - b * TPB; const bool isx = t >= CTX; const int pos = t - CTX;
        float cs[8], sn[8];
        if (isx) { const float pv = (float)(colax ? (pos & 63) : (pos >> 6));
#pragma unroll
            for (int i = 0; i < 8; ++i) { const float ang = pv * inv[i]; cs[i] = __cosf(ang); sn[i] = x2 ? __sinf(ang) : -__sinf(ang); } }
        else {
#pragma unroll
            for (int i = 0; i < 8; ++i) { cs[i] = 1.f; sn[i] = 0.f; } }
        bf16_t* orow = PO + (size_t)m * (PO == P ? DIN : 256);
#pragma unroll
        for (int pass = 0; pass < 2; ++pass) {
            const u32x4 w = pass ? c1 : c0;
            float x[8] = {bflo(w.x), bfhi(w.x), bflo(w.y), bfhi(w.y), bflo(w.z), bfhi(w.z), bflo(w.w), bfhi(w.w)};
            float ss = 0.f;
#pragma unroll
            for (int i = 0; i < 8; ++i) ss += x[i] * x[i];
            ss += xor1(ss); ss += xor2(ss); ss += swz_xor4(ss);
            const float r = 1.0f / sqrtf(ss * (1.f / 64.f) + EPS);
            float y[8];
#pragma unroll
            for (int i = 0; i < 8; ++i) { x[i] = x[i] * r * (pass ? g1[i] : g0[i]); }
#pragma unroll
            for (int i = 0; i < 8; ++i) { const float pr = xor2(x[i]); y[i] = x[i] * cs[i] + pr * sn[i]; }
            u32x4 o; o.x = pk2(y[0], y[1]); o.y = pk2(y[2], y[3]); o.z = pk2(y[4], y[5]); o.w = pk2(y[6], y[7]);
            const int col = pass ? col1 : col0;
            if (pass == 0 || act1) *(u32x4*)(orow + (PO == P ? col : (col & 127))) = o;
        }
    }
}

__device__ __forceinline__ unsigned off_v(unsigned row, unsigned ch) { return 256u * row + 16u * (ch ^ (((row & 3) << 2) | ((row >> 2) & 3))); }
__device__ __forceinline__ unsigned off_k(unsigned row, unsigned ch) { return 128u * row + 16u * (ch ^ (row & 7)); }
typedef short s16x4_t __attribute__((ext_vector_type(4)));
__device__ __forceinline__ s16x4_t tr_rd(const LAS unsigned char* p) { return __builtin_bit_cast(s16x4_t, __builtin_amdgcn_ds_read_tr16_b64_v4i16((LAS s16x4_t*)p)); }
template <bool KIMG> __device__ __forceinline__ bf16x8 tr_frag(const LAS unsigned char* img, int lane, int rbase, int r0off, int r1off, int cblk) {
    const unsigned blk = (lane >> 4) & 1, q = (lane & 15) >> 2, pp = lane & 3, ch = 4 * cblk + 2 * blk + (pp >> 1);
    const unsigned ra = rbase + r0off + q, rb = rbase + r1off + q;
    const s16x4_t lo = tr_rd(img + (KIMG ? off_k(ra, ch) : off_v(ra, ch)) + 8 * (pp & 1)), hi = tr_rd(img + (KIMG ? off_k(rb, ch) : off_v(rb, ch)) + 8 * (pp & 1));
    return (bf16x8){lo[0], lo[1], lo[2], lo[3], hi[0], hi[1], hi[2], hi[3]};
}
__device__ __forceinline__ void stage_v(const bf16_t* P, size_t r0, int h, LAS unsigned char* img, int tid) {
#pragma unroll
    for (int i = 0; i < 4; ++i) { const int p_ = tid + 512 * i, j = p_ >> 4, ch = p_ & 15;
        *(LAS u32x4*)(img + off_v(j, ch)) = *(const u32x4*)(P + (r0 + j) * DIN + C_RV + h * 128 + 8 * ch); }
}
__device__ __forceinline__ void ret_r1_unit(const Ctx& C, int layer, int b, int h, int c, LAS unsigned char* lds, int tid) {
    const int lane = tid & 63, wid = tid >> 6;
    const bf16_t* P = (const bf16_t*)(C.ws + WS_P); float* KVT = (float*)(C.ws + WS_H);
    LAS unsigned char* Vi = lds; LAS unsigned char* Kf = lds + 32768; LAS unsigned char* Kb = lds + 49152;
    const float* dec = C.ret_decay(); const float lf = log2_sigmoid(dec[(layer * 2 + 0) * 4 + h]), lb = log2_sigmoid(dec[(layer * 2 + 1) * 4 + h]);
    const size_t r0 = (size_t)b * TPB + c * 128;
#pragma unroll
    for (int i = 0; i < 2; ++i) { const int p_ = tid + 512 * i, j = p_ >> 3, ch = p_ & 7;
        const u32x4 w = *(const u32x4*)(P + (r0 + j) * DIN + C_RK + h * 64 + 8 * ch);
        const float zf = exp2f((float)(127 - j) * lf) * 0.125f, zb = exp2f((float)j * lb) * 0.125f;
        const float x[8] = {bflo(w.x), bfhi(w.x), bflo(w.y), bfhi(w.y), bflo(w.z), bfhi(w.z), bflo(w.w), bfhi(w.w)};
        u32x4 of, ob; of.x = pk2(x[0] * zf, x[1] * zf); of.y = pk2(x[2] * zf, x[3] * zf); of.z = pk2(x[4] * zf, x[5] * zf); of.w = pk2(x[6] * zf, x[7] * zf);
        ob.x = pk2(x[0] * zb, x[1] * zb); ob.y = pk2(x[2] * zb, x[3] * zb); ob.z = pk2(x[4] * zb, x[5] * zb); ob.w = pk2(x[6] * zb, x[7] * zb);
        *(LAS u32x4*)(Kf + off_k(j, ch)) = of; *(LAS u32x4*)(Kb + off_k(j, ch)) = ob; }
    stage_v(P, r0, h, Vi, tid);
    __syncthreads();
    const int mb = wid >> 1, nb = wid & 1, r = lane & 31, hh = lane >> 5;
    float z0 = 0.f; asm volatile("" : "+v"(z0)); f32x16 af, ab;
#pragma unroll
    for (int i = 0; i < 16; ++i) { af[i] = z0; ab[i] = z0; }
#pragma unroll
    for (int ks = 0; ks < 8; ++ks) {
        const bf16x8 a = tr_frag<false>(Vi, lane, 16 * ks + 8 * hh, 0, 4, mb);
        const bf16x8 bf = tr_frag<true>(Kf, lane, 16 * ks + 8 * hh, 0, 4, nb);
        const bf16x8 bb = tr_frag<true>(Kb, lane, 16 * ks + 8 * hh, 0, 4, nb);
        af = __builtin_amdgcn_mfma_f32_32x32x16_bf16(a, bf, af, 0, 0, 0);
        ab = __builtin_amdgcn_mfma_f32_32x32x16_bf16(a, bb, ab, 0, 0, 0);
    }
    float* of = KVT + ((size_t)((0 * NB + b) * 4 + h) * NCH + c) * 8192; float* ob = KVT + ((size_t)((1 * NB + b) * 4 + h) * NCH + c) * 8192;
#pragma unroll
    for (int reg = 0; reg < 16; ++reg) { const int dv = 32 * mb + (reg & 3) + 8 * (reg >> 2) + 4 * hh, dk = 32 * nb + r; of[dv * 64 + dk] = af[reg]; ob[dv * 64 + dk] = ab[reg]; }
    __syncthreads();
}
__device__ __forceinline__ void ret_r2_unit(const Ctx& C, int layer, int u, int tid) {
    const int q = u & 3, bh = (u >> 2) & 63, dir = u >> 8, b = bh >> 2, h = bh & 3;
    const float G = exp2f(128.f * log2_sigmoid(C.ret_decay()[(layer * 2 + dir) * 4 + h]));
    const size_t base = ((size_t)((dir * NB + b) * 4 + h) * NCH) * 8192 + q * 2048 + tid * 4;
    const float* KVT = (const float*)(C.ws + WS_H) + base; bf16_t* ST = (bf16_t*)(C.ws + WS_YP) + base;
    float z0 = 0.f; asm volatile("" : "+v"(z0)); f32x4 S = {z0, z0, z0, z0};
#pragma unroll
    for (int half = 0; half < 2; ++half) {
        f32x4 kv[17];
#pragma unroll
        for (int s = 0; s < 17; ++s) { const int step = half * 17 + s; const int c = dir == 0 ? step : (step < 2 ? 1 - step : 35 - step); kv[s] = *(const f32x4*)(KVT + (size_t)c * 8192); }
#pragma unroll
        for (int s = 0; s < 17; ++s) { const int step = half * 17 + s; const int c = dir == 0 ? step : (step < 2 ? 1 - step : 35 - step);
            u32x2 w; w.x = pk2(S[0], S[1]); w.y = pk2(S[2], S[3]); *(u32x2*)(ST + (size_t)c * 8192) = w;
            S = S * G + kv[s]; }
    }
}
__device__ __forceinline__ void ret_r3_unit(const Ctx& C, int layer, int b, int h, int c, LAS unsigned char* lds, int tid) {
    int lane = tid & 63; asm volatile("" : "+v"(lane));
    const int wid = tid >> 6, r = lane & 31, hh = lane >> 5, ib = wid & 3, dh = wid >> 2;
    const bf16_t* P = (const bf16_t*)(C.ws + WS_P);
    LAS unsigned char* Vi = lds;
    LAS float* Ol = (LAS float*)(lds + 32768);
    const float* dec = C.ret_decay(); const float lf = log2_sigmoid(dec[(layer * 2 + 0) * 4 + h]), lb = log2_sigmoid(dec[(layer * 2 + 1) * 4 + h]);
    const size_t r0 = (size_t)b * TPB + c * 128;
    stage_v(P, r0, h, Vi, tid);
#define R3_ZERO(v) do { float z_ = 0.f; asm volatile("" : "+v"(z_)); _Pragma("unroll") for (int i_ = 0; i_ < 16; ++i_) v[i_] = z_; } while (0)
    bf16x8 qf[4];
    { const bf16_t* Qp = P + (r0 + 32 * ib + r) * DIN + C_RQ + h * 64 + 8 * hh;
#pragma unroll
      for (int ks = 0; ks < 4; ++ks) qf[ks] = *(const bf16x8*)(Qp + 16 * ks); }
    bf16x8 kf[4][4]; u32x4 gwv[4];
#pragma unroll
    for (int jb = 0; jb < 2; ++jb) { const bf16_t* Kp = P + (r0 + 32 * jb + r) * DIN + C_RK + h * 64 + 8 * hh;
#pragma unroll
        for (int ks = 0; ks < 4; ++ks) kf[jb][ks] = *(const bf16x8*)(Kp + 16 * ks); }
    { const bf16_t* gp = P + (r0 + (tid >> 2)) * DIN + C_RG + h * 128 + 32 * (tid & 3);
#pragma unroll
      for (int e2 = 0; e2 < 4; ++e2) gwv[e2] = *(const u32x4*)(gp + 8 * e2); }
    f32x16 o[2]; R3_ZERO(o[0]); R3_ZERO(o[1]);
#pragma unroll
    for (int dir = 0; dir < 2; ++dir) {
        const bf16_t* sp = (const bf16_t*)(C.ws + WS_YP) + ((size_t)((dir * NB + b) * 4 + h) * NCH + c) * 8192 + (64 * dh + r) * 64 + 8 * hh;
        f32x16 acc[2];
#pragma unroll
        for (int t = 0; t < 2; ++t) { R3_ZERO(acc[t]);
#pragma unroll
            for (int ks = 0; ks < 4; ++ks) acc[t] = __builtin_amdgcn_mfma_f32_32x32x16_bf16(qf[ks], *(const bf16x8*)(sp + t * 32 * 64 + 16 * ks), acc[t], 0, 0, 0); }
#pragma unroll
        for (int reg = 0; reg < 16; ++reg) { const int i = 32 * ib + (reg & 3) + 8 * (reg >> 2) + 4 * hh; const float xi = dir == 0 ? __builtin_amdgcn_exp2f((float)(i + 1) * lf) : __builtin_amdgcn_exp2f((float)(128 - i) * lb);
            o[0][reg] += xi * acc[0][reg]; o[1][reg] += xi * acc[1][reg]; }
        CBAR();
    }
#pragma unroll
    for (int jb = 2; jb < 4; ++jb) { const bf16_t* Kp = P + (r0 + 32 * jb + r) * DIN + C_RK + h * 64 + 8 * hh;
#pragma unroll
        for (int ks = 0; ks < 4; ++ks) kf[jb][ks] = *(const bf16x8*)(Kp + 16 * ks); }
    __syncthreads();
    unsigned lp[2][2];
    { const unsigned blk = (lane >> 4) & 1, q = (lane & 15) >> 2, pp = lane & 3;
#pragma unroll
      for (int t = 0; t < 2; ++t)
#pragma unroll
          for (int cb = 0; cb < 2; ++cb) lp[t][cb] = off_v(4 * hh + 8 * t + q, 4 * (2 * dh + cb) + 2 * blk + (pp >> 1)) + 8 * (pp & 1); }
#pragma unroll
    for (int jb = 0; jb < 4; ++jb) {
        f32x16 x; R3_ZERO(x);
#pragma unroll
        for (int ks = 0; ks < 4; ++ks) x = __builtin_amdgcn_mfma_f32_32x32x16_bf16(kf[jb][ks], qf[ks], x, 0, 0, 0);
#pragma unroll
        for (int reg = 0; reg < 16; ++reg) { const int d = (32 * ib + r) - (32 * jb + (reg & 3) + 8 * (reg >> 2) + 4 * hh);
            const float D = d > 0 ? __builtin_amdgcn_exp2f((float)d * lf) : (d < 0 ? __builtin_amdgcn_exp2f((float)(-d) * lb) : 2.0f); x[reg] *= 0.125f * D; }
#pragma unroll
        for (int s = 0; s < 2; ++s) {
            u32x4 pw; pw.x = pk2(x[8 * s + 0], x[8 * s + 1]); pw.y = pk2(x[8 * s + 2], x[8 * s + 3]); pw.z = pk2(x[8 * s + 4], x[8 * s + 5]); pw.w = pk2(x[8 * s + 6], x[8 * s + 7]);
            const bf16x8 pa = __builtin_bit_cast(bf16x8, pw);
#pragma unroll
            for (int cb = 0; cb < 2; ++cb) { const s16x4_t lo = tr_rd(Vi + lp[0][cb] + (8192 * jb + 4096 * s)), hi = tr_rd(Vi + lp[1][cb] + (8192 * jb + 4096 * s));
                const bf16x8 vb = (bf16x8){lo[0], lo[1], lo[2], lo[3], hi[0], hi[1], hi[2], hi[3]};
                o[cb] = __builtin_amdgcn_mfma_f32_32x32x16_bf16(pa, vb, o[cb], 0, 0, 0); }
        }
        CBAR();
    }
#pragma unroll
    for (int cb = 0; cb < 2; ++cb)
#pragma unroll
        for (int reg = 0; reg < 16; ++reg) { const int i = 32 * ib + (reg & 3) + 8 * (reg >> 2) + 4 * hh, dv = 64 * dh + 32 * cb + r; Ol[i * 132 + dv] = o[cb][reg]; }
    __syncthreads();
    { const int row = tid >> 2, q = tid & 3; f32x4 x[8]; float sm = 0.f;
#pragma unroll
      for (int e = 0; e < 8; ++e) { x[e] = *(const LAS f32x4*)(Ol + row * 132 + 32 * q + 4 * e); sm += (x[e][0] + x[e][1]) + (x[e][2] + x[e][3]); }
      sm += xor1(sm); sm += xor2(sm);
      const float mu = sm * (1.f / 128.f); float vs = 0.f;
#pragma unroll
      for (int e = 0; e < 8; ++e) { x[e] = x[e] - mu; vs += (x[e][0] * x[e][0] + x[e][1] * x[e][1]) + (x[e][2] * x[e][2] + x[e][3] * x[e][3]); }
      vs += xor1(vs); vs += xor2(vs);
      const float rstd = 1.0f / sqrtf(vs * (1.f / 128.f) + EPS);
      bf16_t* yp = (bf16_t*)(C.ws + WS_Y) + (r0 + row) * DM + h * 128 + 32 * q;
#pragma unroll
      for (int e2 = 0; e2 < 4; ++e2) { const u32x4 gw = gwv[e2]; const f32x4 a = x[2 * e2] * rstd, bq = x[2 * e2 + 1] * rstd;
          u32x4 ow; ow.x = pk2(a[0] * silu_f(bflo(gw.x)), a[1] * silu_f(bfhi(gw.x))); ow.y = pk2(a[2] * silu_f(bflo(gw.y)), a[3] * silu_f(bfhi(gw.y)));
          ow.z = pk2(bq[0] * silu_f(bflo(gw.z)), bq[1] * silu_f(bfhi(gw.z))); ow.w = pk2(bq[2] * silu_f(bflo(gw.w)), bq[3] * silu_f(bfhi(gw.w)));
          *(u32x4*)(yp + 8 * e2) = ow; } }
#undef R3_ZERO
}

template <bool WIN>
__device__ __forceinline__ void attn_dispatch(const Ctx& C, int layer, int U, int tid, char* lds) {
    using attn_body::bf16;
    int b, h, q0, NT, tdelta;
    if (U < 1024) { b = U >> 6; h = ((U >> 5) & 1) * 2 + ((U >> 4) & 1); q0 = CTX + 256 * (U & 15);
        if (WIN) { const int ts = (q0 / 64 - 2) > 4 ? (q0 / 64 - 2) : 4, te = (q0 / 64 + 6) < 68 ? (q0 / 64 + 6) : 68; NT = 4 + te - ts; tdelta = ts - 4; } else { NT = 68; tdelta = 0; } }
    else { b = (U - 1024) >> 2; h = (U - 1024) & 3; q0 = 0; NT = 4; tdelta = 0; }
    const int kvh = h >> 1;
    const bf16* Pb = (const bf16*)(C.ws + WS_P) + (size_t)b * TPB * DIN; bf16* Yb = (bf16*)(C.ws + WS_Y) + (size_t)b * TPB * DM;
    if (WIN) attn_body::attn_unit<8, true>(Pb + C_WQ + 64 * h, Pb + C_WK + 64 * kvh, Pb + C_WV + 64 * kvh, Yb + 512 + 64 * h, q0, NT, tdelta, C.win_sink()[layer * 4 + h] * LOG2E, tid, lds);
    else     attn_body::attn_unit<8, false>(Pb + C_GQ + 64 * h, Pb + C_GK + 64 * kvh, Pb + C_GV + 64 * kvh, Yb + 768 + 64 * h, q0, NT, tdelta, 0.f, tid, lds);
}
template <bool WIN>
__device__ __forceinline__ void attn_units(const Ctx& C, int layer, int G, int vcu, int bx, int tid, char* lds) {
    const int nctx = (layer == DEPTH - 1) ? 0 : 64;
    if (G == 256) {
        for (int k = 0; k < 4; ++k) attn_dispatch<WIN>(C, layer, vcu * 4 + k, tid, lds);
        if (vcu < nctx) attn_dispatch<WIN>(C, layer, 1024 + vcu, tid, lds);
    } else {
        for (int U = bx; U < 1024 + nctx; U += G) attn_dispatch<WIN>(C, layer, U, tid, lds);
    }
}

__device__ __forceinline__ f32x2 swap32(float a, float b) { auto r = __builtin_amdgcn_permlane32_swap(__builtin_bit_cast(unsigned, a), __builtin_bit_cast(unsigned, b), false, false);
    return (f32x2){__builtin_bit_cast(float, (unsigned)r[0]), __builtin_bit_cast(float, (unsigned)r[1])}; }
__device__ __forceinline__ f32x2 swap16(float a, float b) { auto r = __builtin_amdgcn_permlane16_swap(__builtin_bit_cast(unsigned, a), __builtin_bit_cast(unsigned, b), false, false);
    return (f32x2){__builtin_bit_cast(float, (unsigned)r[0]), __builtin_bit_cast(float, (unsigned)r[1])}; }
__device__ __forceinline__ void phase_norm2_route(const Ctx& C, int layer_c, LAS unsigned char* lds, int G, int bx, int tid) {
    const int layer = layer_c & 3;
    const int lane = tid & 63, wave = tid >> 6;
    const float* mod = (const float*)(C.ws + WS_MOD) + (size_t)layer * 17 * 6144;
    const float* gain = C.norm2() + layer * DM;
    const bf16_t* XR = (const bf16_t*)(C.ws + WS_X32); unsigned char* H = (unsigned char*)(C.ws + WS_H);
    int* list = (int*)(C.ws + WS_LIST);
    unsigned* gcnt = (unsigned*)(C.ws + WS_CTL) + CW_CNT + 64 * layer_c;
    constexpr int RPC = MROWS / 256, RPW = RPC / 8;
    LAS float* wrT = (LAS float*)lds;
    LAS float* lgs = (LAS float*)(lds + 65536);
    LAS int* lcnt = (LAS int*)(lds + 65536 + RPC * 64);
    LAS int* lbase = lcnt + 16;
    LAS int* rec_e = lcnt + 32;
    LAS float* rec_w = (LAS float*)(rec_e + 2 * RPC);
    { const float* wr = C.w_router(); for (int i = tid; i < DM * NE; i += 512) { const int k = i >> 4, e = i & 15; wrT[e * DM + k] = wr[i]; } }
    if (tid < 16) lcnt[tid] = 0;
    __syncthreads();
    const unsigned lo4 = (unsigned)lane * 4u, lo8 = (unsigned)lane * 8u, lo16 = (unsigned)lane * 16u;
#define E_LOADROW(dst, mm) do { const char* xr_ = (const char*)(XR + (size_t)(mm) * DM); _Pragma("unroll") for (int j = 0; j < 4; ++j) dst[j] = *(const u32x2*)(xr_ + (lo8 + 512u * j)); } while (0)
#define E_NORMROW(v, nxr, mm) do { float ss_ = 0.f; _Pragma("unroll") for (int j = 0; j < 4; ++j) { v[j] = bf4(nxr[j]); ss_ += (v[j][0] * v[j][0] + v[j][1] * v[j][1]) + (v[j][2] * v[j][2] + v[j][3] * v[j][3]); } \
        const int b_ = (mm) / TPB, t_ = (mm) - b_ * TPB, set_ = t_ < CTX ? 16 : b_; const float rstd_ = 1.0f / sqrtf(wave_sum(ss_) * (1.f / DM) + EPS); \
        const char* gp_ = (const char*)gain; const char* shp_ = (const char*)(mod + (size_t)set_ * 6144 + 3 * DM); const char* scp_ = shp_ + DM * 4; \
        char* ho_ = (char*)(H + (size_t)(mm) * DM); \
        _Pragma("unroll") for (int j = 0; j < 4; ++j) { v[j] = (v[j] * rstd_) * *(const f32x4*)(gp_ + (lo16 + 1024u * j)) * (*(const f32x4*)(scp_ + (lo16 + 1024u * j)) + 1.0f) + *(const f32x4*)(shp_ + (lo16 + 1024u * j)); \
            *(unsigned*)(ho_ + (lo4 + 256u * j)) = pk4_fp8(v[j][0], v[j][1], v[j][2], v[j][3]); } } while (0)
#define E_REDUCE(pe, rowl) do { float q8_[8], q4_[4], q2_[2]; \
        _Pragma("unroll") for (int e = 0; e < 8; ++e) { const f32x2 r_ = swap32(pe[e], pe[e + 8]); q8_[e] = r_[0] + r_[1]; } \
        _Pragma("unroll") for (int e = 0; e < 4; ++e) { const f32x2 r_ = swap16(q8_[e], q8_[e + 4]); q4_[e] = r_[0] + r_[1]; } \
        _Pragma("unroll") for (int e = 0; e < 2; ++e) { const float keep_ = b3 ? q4_[e + 2] : q4_[e], send_ = b3 ? q4_[e] : q4_[e + 2]; q2_[e] = keep_ + swz_xor8(send_); } \
        float lg_ = (b2 ? q2_[1] : q2_[0]) + swz_xor4(b2 ? q2_[0] : q2_[1]); lg_ += xor2(lg_); lg_ += xor1(lg_); \
        if ((lane & 3) == 0) lgs[(rowl) * 16 + (lane >> 2)] = lg_; } while (0)
    const bool b3 = (lane & 8) != 0, b2 = (lane & 4) != 0;
    for (int chunk = bx; chunk < 256; chunk += G) {
        const int m0 = chunk * RPC + wave * RPW;
        u32x2 nxA[4], nxB[4], fxA[4], fxB[4];
        E_LOADROW(nxA, m0); E_LOADROW(nxB, m0 + 1); E_LOADROW(fxA, m0 + 2); E_LOADROW(fxB, m0 + 3);
        for (int i = 0; i < RPW; i += 2) {
            f32x4 vA[4], vB[4];
            E_NORMROW(vA, nxA, m0 + i);
            E_NORMROW(vB, nxB, m0 + i + 1);
#pragma unroll
            for (int j = 0; j < 4; ++j) { nxA[j] = fxA[j]; nxB[j] = fxB[j]; }
            if (i + 4 < RPW) { E_LOADROW(fxA, m0 + i + 4); E_LOADROW(fxB, m0 + i + 5); }
            float peA[16], peB[16];
            f32x2 hv[4][4];
#pragma unroll
            for (int j = 0; j < 4; ++j)
#pragma unroll
                for (int c = 0; c < 4; ++c) hv[j][c] = (f32x2){vA[j][c], vB[j][c]};
            const LAS float* wl = wrT + 4 * lane; asm volatile("" : "+v"(wl));
#pragma unroll
            for (int e = 0; e < 16; ++e) { f32x2 a2 = {0.f, 0.f};
#pragma unroll
                for (int j = 0; j < 4; ++j) { const f32x4 w = *(const LAS f32x4*)(wl + e * DM + 256 * j);
#pragma unroll
                    for (int c = 0; c < 4; ++c) a2 = __builtin_elementwise_fma(hv[j][c], (f32x2){w[c], w[c]}, a2); }
                peA[e] = a2[0]; peB[e] = a2[1]; }
            E_REDUCE(peA, wave * RPW + i); E_REDUCE(peB, wave * RPW + i + 1);
        }
#undef E_LOADROW
#undef E_NORMROW
#undef E_REDUCE
        asm volatile("s_waitcnt lgkmcnt(0)" ::: "memory");
        const int mrow_ = chunk * RPC + wave * RPW + lane;
        if (lane < RPW && !(layer == DEPTH - 1 && (mrow_ % TPB) < CTX)) {
            const int rl = wave * RPW + lane; const float* br = C.b_router();
            float sg[16], bs[16];
#pragma unroll
            for (int e4 = 0; e4 < 4; ++e4) { const f32x4 l4 = *(const LAS f32x4*)(lgs + rl * 16 + 4 * e4);
#pragma unroll
                for (int k = 0; k < 4; ++k) { sg[4 * e4 + k] = 1.f / (1.f + expf(-l4[k])); bs[4 * e4 + k] = sg[4 * e4 + k] + br[4 * e4 + k]; } }
            int grp = 0; float best = -1e30f;
#pragma unroll
            for (int g = 0; g < 4; ++g) { const float a0 = bs[4 * g], a1 = bs[4 * g + 1], a2 = bs[4 * g + 2], a3 = bs[4 * g + 3];
                const float hi01 = fmaxf(a0, a1), lo01 = fminf(a0, a1), hi23 = fmaxf(a2, a3), lo23 = fminf(a2, a3);
                const float top = fmaxf(hi01, hi23), second = fmaxf(fminf(hi01, hi23), hi01 >= hi23 ? lo01 : lo23);
                const float sc = top + second; if (sc > best) { best = sc; grp = g; } }
            float c4[4], s4[4];
#pragma unroll
            for (int k = 0; k < 4; ++k) { c4[k] = grp == 0 ? bs[k] : grp == 1 ? bs[4 + k] : grp == 2 ? bs[8 + k] : bs[12 + k]; s4[k] = grp == 0 ? sg[k] : grp == 1 ? sg[4 + k] : grp == 2 ? sg[8 + k] : sg[12 + k]; }
            int l0 = 0; float mx0 = c4[0];
#pragma unroll
            for (int k = 1; k < 4; ++k) if (c4[k] > mx0) { mx0 = c4[k]; l0 = k; }
            int l1 = -1; float mx1 = -1e30f;
#pragma unroll
            for (int k = 0; k < 4; ++k) if (k != l0 && c4[k] > mx1) { mx1 = c4[k]; l1 = k; }
            const float w0 = l0 == 0 ? s4[0] : l0 == 1 ? s4[1] : l0 == 2 ? s4[2] : s4[3], w1 = l1 == 0 ? s4[0] : l1 == 1 ? s4[1] : l1 == 2 ? s4[2] : s4[3];
            const float wn = 1.f / (w0 + w1);
            const int e0 = grp * 4 + l0, e1 = grp * 4 + l1;
            const int p0 = __hip_atomic_fetch_add(lcnt + e0, 1, __ATOMIC_RELAXED, __HIP_MEMORY_SCOPE_WORKGROUP);
            const int p1 = __hip_atomic_fetch_add(lcnt + e1, 1, __ATOMIC_RELAXED, __HIP_MEMORY_SCOPE_WORKGROUP);
            rec_e[2 * rl] = e0 | (p0 << 8); rec_e[2 * rl + 1] = e1 | (p1 << 8); rec_w[2 * rl] = w0 * wn; rec_w[2 * rl + 1] = w1 * wn;
        } else if (lane < RPW) { const int rl = wave * RPW + lane; rec_e[2 * rl] = -1; rec_e[2 * rl + 1] = -1; }
        __syncthreads();
        if (tid < 16) lbase[tid] = (int)__hip_atomic_fetch_add(gcnt + tid, (unsigned)lcnt[tid], __ATOMIC_RELAXED, __HIP_MEMORY_SCOPE_AGENT);
        __syncthreads();
        for (int i = tid; i < 2 * RPC; i += 512) { const int re = rec_e[i]; if (re < 0) continue; const int e = re & 255, pp = re >> 8; const int id = (chunk * RPC + (i >> 1)) * 2 + (i & 1);
            list[e * MROWS + lbase[e] + pp] = id | ((int)(rec_w[i] * 16383.f + 0.5f) << 18); }
        __syncthreads();
        if (tid < 16) lcnt[tid] = 0;
        __syncthreads();
    }
}

template <bool GATHER_, int NT>
struct MoeOrder {
    static constexpr bool GATHER = GATHER_;
    const int* list; const LAS int* boff; const LAS int* cnt; int G, c;
    __device__ __forceinline__ bool next(int i, pg8::Unit& u) const {
        const int L = i * G + c; if (L >= boff[16] * NT) return false;
        const int blk = L / NT, pn = L - blk * NT; int e = 0;
#pragma unroll
        for (int k = 1; k < 16; ++k) e += (blk >= boff[k]) ? 1 : 0;
        u.pm = blk; u.pn = e * NT + pn; return true;
    }
    __device__ __forceinline__ unsigned arow(const pg8::Unit& u, int r) const {
        const int e = u.pn / NT, li = (u.pm - boff[e]) * 256 + r;
        const int id = li < cnt[e] ? (list[e * MROWS + li] & 0x3FFFF) : 0;
        return (unsigned)(id >> 1);
    }
    __device__ __forceinline__ const int* aptr(const pg8::Unit& u, int r) const { const int e = u.pn / NT, li = (u.pm - boff[e]) * 256 + r; return list + e * MROWS + (li < cnt[e] ? li : 0); }
    __device__ __forceinline__ unsigned tokrow(unsigned w) const { return (w & 0x3FFFFu) >> 1; }
};
struct EpiGateUp {
    static constexpr bool PERM = true, HAS_PRE = false;
    unsigned char* O;
    __device__ __forceinline__ void operator()(const f32x4 (&acc)[2][2][4][2], const pg8::Unit& u, int wr, int wc, int fr, int fq) const {
        const int row0 = u.pm * 256 + wr * 64 + fr, col0 = (u.pn & 7) * 128 + wc * 32 + 8 * fq;
#pragma unroll
        for (int ai = 0; ai < 2; ++ai)
#pragma unroll
            for (int m = 0; m < 4; ++m) { const f32x4 a0 = acc[ai][0][m][0] * W8_INV, a1 = acc[ai][0][m][1] * W8_INV, u0 = acc[ai][1][m][0] * W8_INV, u1 = acc[ai][1][m][1] * W8_INV;
                u32x2 w; w.x = pk4_fp8(silu_f(a0[0]) * u0[0], silu_f(a0[1]) * u0[1], silu_f(a0[2]) * u0[2], silu_f(a0[3]) * u0[3]);
                w.y = pk4_fp8(silu_f(a1[0]) * u1[0], silu_f(a1[1]) * u1[1], silu_f(a1[2]) * u1[2], silu_f(a1[3]) * u1[3]);
                *(u32x2*)(O + ((unsigned)(row0 + ai * 128 + m * 16) * (unsigned)FF + (unsigned)col0)) = w; }
    }
};
struct EpiDown {
    static constexpr bool PERM = true, HAS_PRE = true;
    unsigned char* YP; const int* list; const LAS int* boff; const LAS int* cnt;
    int ent[2][4];
    __device__ __forceinline__ void pre(const pg8::Unit& u, int wr, int fr) {
        const int e = u.pn >> 2, lb = (u.pm - boff[e]) * 256, n = cnt[e];
#pragma unroll
        for (int ai = 0; ai < 2; ++ai)
#pragma unroll
            for (int m = 0; m < 4; ++m) { const int li = lb + ai * 128 + wr * 64 + m * 16 + fr; const bool ok = li < n; const int w = list[e * MROWS + (ok ? li : 0)]; ent[ai][m] = ok ? w : -1; }
    }
    __device__ __forceinline__ void operator()(const f32x4 (&acc)[2][2][4][2], const pg8::Unit& u, int wr, int wc, int fr, int fq) const {
        const int col0 = (u.pn & 3) * 256 + wc * 32 + 8 * fq;
#pragma unroll
        for (int ai = 0; ai < 2; ++ai)
#pragma unroll
            for (int m = 0; m < 4; ++m) { const int w = ent[ai][m];
                if (w != -1) { const unsigned id = (unsigned)w & 0x3FFFFu; const float g = (float)((unsigned)w >> 18) * ((1.f / 16383.f) * W8_INV * YP_SCALE); const unsigned off = id * (unsigned)DM + (unsigned)col0;
#pragma unroll
                    for (int bj = 0; bj < 2; ++bj) { const f32x4 v0 = acc[ai][bj][m][0] * g, v1 = acc[ai][bj][m][1] * g;
                        u32x2 ww; ww.x = pk4_fp8(v0[0], v0[1], v0[2], v0[3]); ww.y = pk4_fp8(v1[0], v1[1], v1[2], v1[3]); *(u32x2*)(YP + off + bj * 128) = ww; } } }
    }
};
__device__ __forceinline__ void moe_offsets(const Ctx& C, int layer, LAS int* boff, LAS int* cnt, int tid) {
    if (tid == 0) { const unsigned* gcnt = (const unsigned*)(C.ws + WS_CTL) + CW_CNT + 64 * layer; int acc = 0;
        for (int e = 0; e < 16; ++e) { const int n = (int)__hip_atomic_load(gcnt + e, __ATOMIC_RELAXED, __HIP_MEMORY_SCOPE_AGENT); cnt[e] = n; boff[e] = acc; acc += (n + 255) >> 8; }
        boff[16] = acc; }
    __syncthreads();
}

__device__ __forceinline__ void phase_final(const Ctx& C, int gw, int NGW, int lane) {
    const float* mod = (const float*)(C.ws + WS_MOD) + (size_t)(DEPTH - 1) * 17 * 6144;
    const bf16_t* XR = (const bf16_t*)(C.ws + WS_X32); const unsigned char* YP = (const unsigned char*)(C.ws + WS_YP);
    for (int r = gw; r < NB * SEQ; r += NGW) {
        const int b = r / SEQ, t = r - b * SEQ; const size_t m = (size_t)b * TPB + CTX + t;
        const u32x2* xr = (const u32x2*)(XR + m * DM) + lane; const unsigned* y0 = (const unsigned*)(YP + m * 2 * DM) + lane; const unsigned* y1 = y0 + DM / 4;
        const f32x4* g2 = (const f32x4*)(mod + (size_t)b * 6144 + 5 * DM) + lane; f32x4* o = (f32x4*)(C.out + (size_t)r * DM) + lane;
        unsigned a[4], bb[4]; u32x2 x[4];
#pragma unroll
        for (int j = 0; j < 4; ++j) { x[j] = xr[64 * j]; a[j] = y0[64 * j]; bb[j] = y1[64 * j]; }
#pragma unroll
        for (int j = 0; j < 4; ++j) o[64 * j] = bf4(x[j]) + (g2[64 * j] * YP_INV) * (fp8x4_f32(a[j]) + fp8x4_f32(bb[j]));
    }
}

#ifndef R3OFF
#define R3OFF 0
#endif
#ifndef WINOFF
#define WINOFF 0
#endif
#ifndef PHMASK
#define PHMASK 0xFFFF
#endif
#ifndef MK_ONE_LAUNCH
#define MK_ONE_LAUNCH 1
#endif
constexpr int PH_PER_LAYER = 9, PH_LAYER0 = 2, PH_FINAL = PH_LAYER0 + DEPTH * PH_PER_LAYER, PH_COUNT = PH_FINAL + 1;
struct Args { const float* in[18]; float* out; unsigned char* ws; int ph_lo, ph_hi, flags, pad; };
__global__ void __launch_bounds__(512, 2) mega_fwd(Args args) {
    extern __shared__ __attribute__((aligned(16))) unsigned char lds_raw[];
    LAS unsigned char* lds = (LAS unsigned char*)lds_raw;
    Ctx C; C.out = args.out; C.ws = args.ws;
    const int tid = threadIdx.x, lane = tid & 63, wave = __builtin_amdgcn_readfirstlane(tid >> 6);
    const int G = gridDim.x; const int bx = blockIdx.x; const int vcu = (G % 8 == 0) ? (bx % 8) * (G / 8) + bx / 8 : bx;
    const int gw = vcu * 8 + wave, NGW = G * 8;
    volatile LAS unsigned* MISC = (volatile LAS unsigned*)(lds + LDSCTL_OFF);
    for (int u = tid; u < (LDS_BYTES - LDSCTL_OFF) / 4; u += 512) ((LAS unsigned*)(lds + LDSCTL_OFF))[u] = 0u;
    __syncthreads();
    const int lo = args.ph_lo, hi = args.ph_hi;
    XcdBarrier bar; bar.bar = (unsigned*)(C.ws + WS_CTL) + CW_BAR; bar.x = 0; bar.st = nullptr;
    if (hi - lo > 1) bar = xcd_barrier_post((unsigned*)(C.ws + WS_CTL) + CW_BAR, MISC);
#define IN(k) (lo <= (k) && (k) < hi)
#define PHASE_IDS() int bx_ = bx, wave_ = wave; LAS unsigned char* lds_ = lds; asm volatile("" : "+s"(bx_), "+s"(wave_), "+s"(lds_)); int lane_; asm volatile("v_mbcnt_lo_u32_b32 %0, -1, 0\n\tv_mbcnt_hi_u32_b32 %0, -1, %0" : "=v"(lane_)); const int tid_ = wave_ * 64 + lane_; \
    const int vcu_ = (G % 8 == 0) ? (bx_ % 8) * (G / 8) + bx_ / 8 : bx_; const int gw_ = vcu_ * 8 + wave_; (void)lane_; (void)gw_; (void)vcu_
#define SEAM(k) do { if (IN(k) && IN((k) + 1)) xcd_barrier(bar); } while (0)

    if (IN(0) && (PHMASK & 1)) { PHASE_IDS(); phase_prologue(C, lds_, G, vcu_, bx_, tid_); } SEAM(0);
    if (IN(1) && (PHMASK & 2)) { PHASE_IDS(); phase_modsum(C, G, bx_, tid_); } SEAM(1);
#ifdef EXTRA_BARS
    if (hi - lo > 1) for (int eb = 0; eb < EXTRA_BARS; ++eb) xcd_barrier(bar);
#endif

#ifdef LAYER_UNROLL
#pragma unroll
#else
#pragma nounroll
#endif
    for (int layer = 0; layer < DEPTH; ++layer) {
        const int p0 = PH_LAYER0 + layer * PH_PER_LAYER;
        if (IN(p0 + 0) && (PHMASK & 4)) { PHASE_IDS();
            if (layer > 0 && !(args.flags & 16)) {
                const unsigned* gc = (const unsigned*)(C.ws + WS_CTL) + CW_CNT + 64 * (layer - 1); int nblk = 0;
                for (int e = 0; e < 16; ++e) nblk += ((int)__hip_atomic_load(gc + e, __ATOMIC_RELAXED, __HIP_MEMORY_SCOPE_AGENT) + 255) >> 8;
                convert_rest(C, layer, G, vcu_, lds_, wave_, lane_, nblk * 8, nblk * 4); }
            phase_norm1(C, layer, gw_, NGW, lane_, (args.flags & 16) ? (bf16_t*)(C.ws + WS_Y) : (bf16_t*)(C.ws + WS_X32)); } SEAM(p0 + 0);
        if (IN(p0 + 1) && (PHMASK & 8)) {
            pg8::Gemm g{(const bf16_t*)(C.ws + WS_H), (const bf16_t*)(C.ws + WS_WIN) + (size_t)layer * DIN * DM, MROWS, DIN, DM};
            PHASE_IDS(); pg8::StaticOrder S; S.init(MROWS, DIN, G, bx_);
            pg8::EpiBf16 E{(bf16_t*)(C.ws + WS_P), DIN};
            pg8::gemm_phase<pg8::EpiBf16, pg8::StaticOrder, true>(lds_, g, S, E, tid_);
            if (layer + 1 < DEPTH && !args.flags) convert_tail(C, layer + 1, 0, (MROWS / 256) * (DIN / 256), G, bx_, lds_, wave_, lane_);
        } SEAM(p0 + 1);
        if (IN(p0 + 2) && (PHMASK & 16)) {
            PHASE_IDS(); if (!(args.flags & 1)) phase_qkprep(C, layer, gw_, NGW, lane_, (args.flags & 8) ? (bf16_t*)(C.ws + WS_Y) : (bf16_t*)(C.ws + WS_P));
            if (!(args.flags & 8)) for (int u = bx_; u < NB * 4 * NCH; u += G) { const int c = u % NCH, bh = u / NCH; ret_r1_unit(C, layer, bh >> 2, bh & 3, c, lds_, tid_); }
        } SEAM(p0 + 2);
        if (IN(p0 + 3) && (PHMASK & 32)) {
            PHASE_IDS(); for (int u = bx_; u < 512; u += G) ret_r2_unit(C, layer, u, tid_);
            attn_units<false>(C, layer, G, vcu_, bx_, tid_, (char*)lds_);
        } SEAM(p0 + 3);
        if (IN(p0 + 4) && (PHMASK & 64)) {
            PHASE_IDS();
            if (!WINOFF && !(args.flags & 32)) attn_units<true>(C, layer, G, vcu_, bx_, tid_, (char*)lds_);
            if (!R3OFF && !(args.flags & 64))
            for (int u = bx_; u < NB * 4 * NCH; u += G) { const int c = u % NCH, bh = u / NCH; if (layer == DEPTH - 1 && c < 2) continue; ret_r3_unit(C, layer, bh >> 2, bh & 3, c, lds_, tid_); }
        } SEAM(p0 + 4);
        if (IN(p0 + 5) && (PHMASK & 128)) {
            pg8::Gemm g{(const bf16_t*)(C.ws + WS_Y), (const bf16_t*)(C.ws + WS_WOUT) + (size_t)layer * DM * DM, MROWS, DM, DM};
            PHASE_IDS(); pg8::StaticOrder S; S.init(MROWS, DM, G, bx_, layer == DEPTH - 1);
            pg8::EpiResid E{(bf16_t*)(C.ws + ((args.flags & 4) ? WS_P : WS_X32)), (const float*)(C.ws + WS_MOD) + (size_t)layer * 17 * 6144 + 2 * DM};
            pg8::gemm_phase<pg8::EpiResid, pg8::StaticOrder, true>(lds_, g, S, E, tid_);
            if (layer + 1 < DEPTH && !args.flags) convert_tail(C, layer + 1, 1, (MROWS / 256) * (DM / 256), G, bx_, lds_, wave_, lane_);
        } SEAM(p0 + 5);
        if (IN(p0 + 6) && (PHMASK & 256)) { PHASE_IDS(); phase_norm2_route(C, layer + ((args.flags & 2) ? 4 : 0), lds_, G, bx_, tid_); } SEAM(p0 + 6);
        if (IN(p0 + 7) && (PHMASK & 512)) {
            PHASE_IDS(); LAS int* boff = (LAS int*)(lds_ + LDSCTL_OFF + 64); LAS int* mcnt = (LAS int*)(lds_ + LDSCTL_OFF + 192); moe_offsets(C, layer, boff, mcnt, tid_);
            pg8::Gemm g{(const bf16_t*)(C.ws + WS_H), (const bf16_t*)(C.ws + WS_WGU + (size_t)layer * NE * 2 * FF * DM), 0, 2 * FF, DM};
            MoeOrder<true, 8> S{(const int*)(C.ws + WS_LIST), boff, mcnt, G, bx_};
            EpiGateUp E{(unsigned char*)(C.ws + WS_P)};
            pg8::gemm_phase<EpiGateUp, MoeOrder<true, 8>, true, true>(lds_, g, S, E, tid_);
            if (layer + 1 < DEPTH && !args.flags) convert_tail(C, layer + 1, 2, boff[16] * 8, G, bx_, lds_, wave_, lane_);
        } SEAM(p0 + 7);
        if (IN(p0 + 8) && (PHMASK & 1024)) {
            PHASE_IDS(); LAS int* boff = (LAS int*)(lds_ + LDSCTL_OFF + 64); LAS int* mcnt = (LAS int*)(lds_ + LDSCTL_OFF + 192); moe_offsets(C, layer, boff, mcnt, tid_);
            pg8::Gemm g{(const bf16_t*)(C.ws + WS_P), (const bf16_t*)(C.ws + WS_WDN + (size_t)layer * NE * DM * FF), 0, DM, FF};
            MoeOrder<false, 4> S{(const int*)(C.ws + WS_LIST), boff, mcnt, G, bx_};
            EpiDown E{(unsigned char*)(C.ws + WS_YP), (const int*)(C.ws + WS_LIST), boff, mcnt, {}};
            pg8::gemm_phase<EpiDown, MoeOrder<false, 4>, true, true>(lds_, g, S, E, tid_);
            if (layer + 1 < DEPTH && !args.flags) convert_tail(C, layer + 1, 3, boff[16] * 4, G, bx_, lds_, wave_, lane_);
        } SEAM(p0 + 8);
    }
    if (IN(PH_FINAL) && (PHMASK & 2048)) { PHASE_IDS(); phase_final(C, gw_, NGW, lane_); }
#undef IN
#undef SEAM
}

extern "C" void kernel_launch(void* const* d_in, const int* in_sizes, int n_in, void* d_out, int out_size, void* d_ws, size_t ws_size, hipStream_t stream) {
    static int grid = 0;
    if (grid == 0) {
        if (n_in != 18 || in_sizes[0] != NB * SEQ * DM || out_size != NB * SEQ * DM || ws_size < WS_END) {
            fprintf(stderr, "kernel_launch: unexpected shapes (n_in %d, in0 %d, out %d, ws %zu, need %zu); nothing launched\n", n_in, n_in > 0 ? in_sizes[0] : -1, out_size, ws_size, (size_t)WS_END); grid = -1; return; }
        int dev = 0, cus = 0, per_cu = 0;
        if (hipGetDevice(&dev) != hipSuccess || hipDeviceGetAttribute(&cus, hipDeviceAttributeMultiprocessorCount, dev) != hipSuccess) { grid = -1; return; }
        if (hipFuncSetAttribute((const void*)mega_fwd, hipFuncAttributeMaxDynamicSharedMemorySize, LDS_BYTES) != hipSuccess) { fprintf(stderr, "kernel_launch: hipFuncSetAttribute failed\n"); grid = -1; return; }
        if (hipOccupancyMaxActiveBlocksPerMultiprocessor(&per_cu, (const void*)mega_fwd, 512, LDS_BYTES) != hipSuccess || per_cu < 1) fprintf(stderr, "kernel_launch: occupancy query says %d\n", per_cu);
        (void)hipGetLastError();
        grid = cus;
    }
    if (grid < 0) return;
    if (hipMemsetAsync((char*)d_ws + WS_CTL, 0, CTL_BYTES, stream) != hipSuccess) return;
    Args a{};
    for (int i = 0; i < 18; ++i) a.in[i] = (const float*)d_in[i];
    a.out = (float*)d_out; a.ws = (unsigned char*)d_ws;
#if MK_ONE_LAUNCH
    a.ph_lo = 0; a.ph_hi = PH_COUNT;
    hipLaunchKernelGGL(mega_fwd, dim3(grid), dim3(512), LDS_BYTES, stream, a);
#else
    for (int p = 0; p < PH_COUNT; ++p) { a.ph_lo = p; a.ph_hi = p + 1;
#if !defined(PROBE_P) || !PROBE_BEFORE
        hipLaunchKernelGGL(mega_fwd, dim3(grid), dim3(512), LDS_BYTES, stream, a);
#endif
#ifdef PROBE_P
        const bool hit = (PROBE_P < 2) ? (p == PROBE_P) : (p >= PH_LAYER0 && p < PH_FINAL && (p - PH_LAYER0) % PH_PER_LAYER == PROBE_P - 2 && (!PROBE_L0 || p < PH_LAYER0 + PH_PER_LAYER));
        if (hit) { a.flags = PROBE_FLAGS; for (int r = 0; r < PROBE_REP; ++r) hipLaunchKernelGGL(mega_fwd, dim3(grid), dim3(512), LDS_BYTES, stream, a); a.flags = 0; }
#if PROBE_BEFORE
        hipLaunchKernelGGL(mega_fwd, dim3(grid), dim3(512), LDS_BYTES, stream, a);
#endif
#endif
    }
#endif
}
```

```cpp
#define MK_ONE_LAUNCH 1
#include <hip/hip_runtime.h>
#include <cstdio>
#include <cstdint>

#define GAS __attribute__((address_space(1)))
#define LAS __attribute__((address_space(3)))
typedef unsigned short bf16_t;
typedef short bf16x8 __attribute__((ext_vector_type(8)));
typedef float f32x4 __attribute__((ext_vector_type(4)));
typedef float f32x2 __attribute__((ext_vector_type(2)));
typedef float f32x16 __attribute__((ext_vector_type(16)));
typedef unsigned u32x4 __attribute__((ext_vector_type(4)));
typedef unsigned u32x2 __attribute__((ext_vector_type(2)));

constexpr int DM = 1024, NB = 16, SEQ = 4096, CTX = 256, TPB = SEQ + CTX, MROWS = NB * TPB, DEPTH = 4;
constexpr int DIN = 2560;
constexpr int C_RQ = 0, C_RK = 256, C_RV = 512, C_RG = 1024, C_WQ = 1536, C_WK = 1792, C_WV = 1920, C_GQ = 2048, C_GK = 2304, C_GV = 2432;
constexpr int NE = 16, FF = 1024, NCH = TPB / 128;
constexpr float EPS = 1e-6f;
constexpr float LOG2E = 1.4426950408889634f;
constexpr float QSCALE = 0.125f * LOG2E;

__device__ __forceinline__ unsigned f2bf(float f) { unsigned u = __builtin_bit_cast(unsigned, f); return (u + 0x7fffu + ((u >> 16) & 1u)) >> 16; }
__device__ __forceinline__ unsigned pk2(float lo, float hi) { return f2bf(lo) | (f2bf(hi) << 16); }
__device__ __forceinline__ float bf2f(unsigned short h) { return __builtin_bit_cast(float, (unsigned)h << 16); }
__device__ __forceinline__ float bflo(unsigned w) { return __builtin_bit_cast(float, w << 16); }
__device__ __forceinline__ float bfhi(unsigned w) { return __builtin_bit_cast(float, w & 0xffff0000u); }

namespace pg8 {
constexpr int BM = 256, BK = 64, HALF = 128, HTB = HALF * BK * 2, STAGE_BYTES = 8 * HTB, NXCD = 8, WGM = 8;
__host__ __device__ __forceinline__ int lds_byte(int r, int c) { const int st = (r >> 4) * 2 + (c >> 5), rr = r & 15, cc = c & 31, ob = rr * 64 + cc * 2; return st * 1024 + (ob ^ (((ob >> 9) & 1) << 5)); }
__host__ __device__ __forceinline__ void stage_rc(int b, int& R, int& C) { const int st = b / 1024, sb = b % 1024, swz = sb ^ (((sb >> 9) & 1) << 5); R = (st >> 1) * 16 + swz / 64; C = (st & 1) * 32 + (swz % 64) / 2; }
__host__ __device__ __forceinline__ int perm32(int rho) { const int n = rho >> 4, i = rho & 15; return 8 * (i >> 2) + 4 * n + (i & 3); }

struct Unit { int pm, pn; };
struct Gemm { const bf16_t* A; const bf16_t* Bt; int M, N, K; };

struct StaticOrder {
    static constexpr bool GATHER = false;
    int nM, nN, nwg, G, c; bool skipctx;
    __device__ void init(int M, int N, int G_, int c_, bool skipctx_ = false) { skipctx = skipctx_; nM = skipctx_ ? (M / BM) / 17 * 16 : M / BM; nN = N / BM; nwg = nM * nN; G = G_; c = c_; }
    __device__ bool next(int i, Unit& u) const {
        const long L = (long)i * G + c; if (L >= nwg) return false;
        int wgid = (int)L; { const int q = nwg / NXCD, r = nwg % NXCD, xcd = wgid % NXCD, off = wgid / NXCD; wgid = (xcd < r ? xcd * (q + 1) : r * (q + 1) + (xcd - r) * q) + off; }
        const int nig = WGM * nN, gid = wgid / nig, fm = gid * WGM, gsz = (nM - fm) < WGM ? (nM - fm) : WGM;
        u.pm = fm + ((wgid % nig) % gsz); u.pn = (wgid % nig) / gsz; if (skipctx) u.pm += (u.pm >> 4) + 1; return true;
    }
    __device__ __forceinline__ unsigned arow(const Unit&, int) const { return 0u; }
    __device__ __forceinline__ const int* aptr(const Unit&, int) const { return nullptr; }
    __device__ __forceinline__ unsigned tokrow(unsigned) const { return 0u; }
};

__device__ __forceinline__ unsigned cvt_pk_bf16(float lo, float hi) { unsigned r; asm volatile("v_cvt_pk_bf16_f32 %0, %1, %2" : "=v"(r) : "v"(lo), "v"(hi)); return r; }

struct EpiBf16 {
    static constexpr bool PERM = true, HAS_PRE = false;
    bf16_t* O; int ldc;
    __device__ __forceinline__ void operator()(const f32x4 (&acc)[2][2][4][2], const Unit& u, int wr, int wc, int fr, int fq) const {
        const int row0 = u.pm * BM + wr * 64 + fr; const int col0 = u.pn * BM + wc * 32 + 8 * fq;
#pragma unroll
        for (int ai = 0; ai < 2; ++ai)
#pragma unroll
            for (int m = 0; m < 4; ++m) { const unsigned off = ((unsigned)(row0 + ai * HALF + m * 16) * (unsigned)ldc + (unsigned)col0) * 2u;
#pragma unroll
                for (int bj = 0; bj < 2; ++bj) { const f32x4 v0 = acc[ai][bj][m][0], v1 = acc[ai][bj][m][1];
                    u32x4 w; w.x = cvt_pk_bf16(v0[0], v0[1]); w.y = cvt_pk_bf16(v0[2], v0[3]); w.z = cvt_pk_bf16(v1[0], v1[1]); w.w = cvt_pk_bf16(v1[2], v1[3]);
                    *(u32x4*)((char*)O + off + bj * HALF * 2) = w; } }
    }
};

struct EpiResid {
    static constexpr bool PERM = true, HAS_PRE = false;
    bf16_t* X; const float* gate;
    __device__ __forceinline__ void operator()(const f32x4 (&acc)[2][2][4][2], const Unit& u, int wr, int wc, int fr, int fq) const {
        const int set = (u.pm % 17 == 0) ? 16 : (u.pm / 17);
        const float* gp = gate + (size_t)set * 6 * DM;
        const int col0 = u.pn * BM + wc * 32 + 8 * fq;
        f32x4 gv[2][2];
#pragma unroll
        for (int bj = 0; bj < 2; ++bj)
#pragma unroll
            for (int n = 0; n < 2; ++n) gv[bj][n] = *(const f32x4*)(gp + col0 + bj * HALF + n * 4);
#pragma unroll
        for (int ai = 0; ai < 2; ++ai) {
            u32x4 xin[4][2];
#pragma unroll
            for (int m = 0; m < 4; ++m) { const unsigned off = ((unsigned)(u.pm * BM + ai * HALF + wr * 64 + m * 16 + fr) * (unsigned)DM + (unsigned)col0) * 2u;
#pragma unroll
                for (int bj = 0; bj < 2; ++bj) xin[m][bj] = *(const u32x4*)((const char*)X + off + bj * HALF * 2); }
            asm volatile("" ::: "memory");
#pragma unroll
            for (int m = 0; m < 4; ++m) { const unsigned off = ((unsigned)(u.pm * BM + ai * HALF + wr * 64 + m * 16 + fr) * (unsigned)DM + (unsigned)col0) * 2u;
#pragma unroll
                for (int bj = 0; bj < 2; ++bj) { const u32x4 x = xin[m][bj]; const f32x4 a0 = acc[ai][bj][m][0] * gv[bj][0], a1 = acc[ai][bj][m][1] * gv[bj][1];
                    u32x4 w; w.x = cvt_pk_bf16(bflo(x.x) + a0[0], bfhi(x.x) + a0[1]); w.y = cvt_pk_bf16(bflo(x.y) + a0[2], bfhi(x.y) + a0[3]);
                    w.z = cvt_pk_bf16(bflo(x.z) + a1[0], bfhi(x.z) + a1[1]); w.w = cvt_pk_bf16(bflo(x.w) + a1[2], bfhi(x.w) + a1[3]);
                    *(u32x4*)((char*)X + off + bj * HALF * 2) = w; } }
            asm volatile("" ::: "memory");
        }
    }
};

template <class Epi, class Sched, bool ALIGN_EPI, bool FP8 = false>
__device__ __forceinline__ void gemm_phase(LAS unsigned char* lds, const Gemm g, const Sched& S, Epi& E, const int tid) {
    const int wid = __builtin_amdgcn_readfirstlane(tid >> 6), lane = tid & 63, wr = wid >> 2, wc = wid & 3, fr = lane & 15, fq = lane >> 4;
    const int K = g.K, KB = FP8 ? K : 2 * K  , nt = KB / (BK * 2);
    unsigned voffB[2], vA[2][2], vAn[2][2]; int sR[2], sC[2];
#pragma unroll
    for (int i = 0; i < 2; ++i) { int R, C; stage_rc(tid * 16 + i * 8192, R, C); sR[i] = R; sC[i] = C; const int Rb = Epi::PERM ? ((R & ~31) + perm32(R & 31)) : R;
        voffB[i] = (unsigned)(Rb * KB + C * 2); }
#define PG8_SETV(v, u) do { _Pragma("unroll") for (int h_ = 0; h_ < 2; ++h_) _Pragma("unroll") for (int i_ = 0; i_ < 2; ++i_) { \
        if constexpr (Sched::GATHER) v[h_][i_] = S.arow(u, h_ * HALF + sR[i_]) * (unsigned)KB + (unsigned)(sC[i_] * 2); \
        else v[h_][i_] = (unsigned)((h_ * HALF + sR[i_]) * KB + sC[i_] * 2); } } while (0)
    const size_t kstep = (size_t)(BK * 2);
    const size_t hstep = (size_t)HALF * KB;
    const size_t tstep = 2 * hstep;
    const size_t atstep = Sched::GATHER ? (size_t)0 : tstep;
    const unsigned ldsw = (unsigned)wid * 1024u;
    const int aoff = lds_byte(wr * 64 + fr, fq * 8), boff = lds_byte(wc * 32 + fr, fq * 8);
#define PG8_SA(b, h) (((b) * 2 + (h)) * HTB)
#define PG8_SB(b, h) ((4 + (b) * 2 + (h)) * HTB)
#define PG8_STAGE(bufoff, gbase, voff) do { _Pragma("unroll") for (int _i = 0; _i < 2; ++_i) \
        __builtin_amdgcn_global_load_lds((const unsigned*)((const char*)(gbase) + (voff)[_i]), (LAS unsigned*)(lds + (bufoff) + ldsw + _i * 8192), 16, 0, 0); } while (0)
#define PG8_LDA(dst, b, h) do { _Pragma("unroll") for (int m = 0; m < 4; ++m) _Pragma("unroll") for (int k = 0; k < 2; ++k) dst[m][k] = *(const LAS bf16x8*)(lds + PG8_SA(b, h) + aoff + m * 2048 + k * 1024); } while (0)
#define PG8_LDB(dst, b, h) do { _Pragma("unroll") for (int n = 0; n < 2; ++n) _Pragma("unroll") for (int k = 0; k < 2; ++k) dst[n][k] = *(const LAS bf16x8*)(lds + PG8_SB(b, h) + boff + n * 2048 + k * 1024); } while (0)
    typedef long i64x2_ __attribute__((ext_vector_type(2)));
#define PG8_MMA(ai, bj, At, Bt) do { __builtin_amdgcn_s_setprio(1); _Pragma("unroll") for (int m = 0; m < 4; ++m) _Pragma("unroll") for (int n = 0; n < 2; ++n) _Pragma("unroll") for (int k = 0; k < 2; ++k) { \
        if constexpr (FP8) { const i64x2_ b2_ = __builtin_bit_cast(i64x2_, Bt[n][k]), a2_ = __builtin_bit_cast(i64x2_, At[m][k]); \
            acc[ai][bj][m][n] = __builtin_amdgcn_mfma_f32_16x16x32_fp8_fp8(b2_[0], a2_[0], acc[ai][bj][m][n], 0, 0, 0); \
            acc[ai][bj][m][n] = __builtin_amdgcn_mfma_f32_16x16x32_fp8_fp8(b2_[1], a2_[1], acc[ai][bj][m][n], 0, 0, 0); } \
        else acc[ai][bj][m][n] = __builtin_amdgcn_mfma_f32_16x16x32_bf16(Bt[n][k], At[m][k], acc[ai][bj][m][n], 0, 0, 0); } \
        __builtin_amdgcn_s_setprio(0); } while (0)
#define PG8_WAIT_V(n) asm volatile("s_waitcnt vmcnt(" #n ")" ::: "memory")
#define PG8_WAIT_L(n) asm volatile("s_waitcnt lgkmcnt(" #n ")" ::: "memory")
#define PG8_BAR __builtin_amdgcn_s_barrier()
#define PG8_SCHED __builtin_amdgcn_sched_barrier(0)
    Unit cur, nxt; int ui = 0;
    if (!S.next(0, cur)) return;
    float z0 = 0.f; asm volatile("" : "+v"(z0));
    f32x4 acc[2][2][4][2];
#pragma unroll
    for (int a = 0; a < 2; ++a)
#pragma unroll
        for (int b = 0; b < 2; ++b)
#pragma unroll
            for (int m = 0; m < 4; ++m)
#pragma unroll
                for (int n = 0; n < 2; ++n) acc[a][b][m][n] = (f32x4){z0, z0, z0, z0};
    bf16x8 At[4][2], B0[2][2], B1[2][2];
    const char* cA = (const char*)g.A + (size_t)cur.pm * atstep; const char* cB = (const char*)g.Bt + (size_t)cur.pn * tstep;
    PG8_SETV(vA, cur);
    PG8_STAGE(PG8_SB(0, 0), cB, voffB); PG8_STAGE(PG8_SB(0, 1), cB + hstep, voffB); PG8_STAGE(PG8_SA(0, 0), cA, vA[0]); PG8_STAGE(PG8_SA(0, 1), cA, vA[1]);
    if (wr == 1) PG8_BAR;
    PG8_WAIT_V(2); PG8_BAR;
    PG8_STAGE(PG8_SB(1, 0), cB + kstep, voffB); PG8_STAGE(PG8_SA(1, 0), cA + kstep, vA[0]); PG8_STAGE(PG8_SB(1, 1), cB + hstep + kstep, voffB);
    PG8_WAIT_V(6); PG8_BAR;
    for (;;) {
        if constexpr (Epi::HAS_PRE) E.pre(cur, wr, fr);
        const bool has_next = S.next(ui + 1, nxt);
        const char* nA = has_next ? (const char*)g.A + (size_t)nxt.pm * atstep : cA; const char* nB = has_next ? (const char*)g.Bt + (size_t)nxt.pn * tstep : cB;
        if constexpr (Sched::GATHER) { if (has_next) {
#pragma unroll
            for (int h_ = 0; h_ < 2; ++h_)
#pragma unroll
                for (int i_ = 0; i_ < 2; ++i_) { const int* ap_ = S.aptr(nxt, h_ * HALF + sR[i_]); asm volatile("global_load_dword %0, %1, off" : "=v"(vAn[h_][i_]) : "v"(ap_) : "memory"); } } }
        if (has_next) { if constexpr (!Sched::GATHER) { PG8_SETV(vAn, nxt); } } else {
#pragma unroll
            for (int h_ = 0; h_ < 2; ++h_)
#pragma unroll
                for (int i_ = 0; i_ < 2; ++i_) vAn[h_][i_] = vA[h_][i_]; }
        for (int t = 0; t < nt; t += 2) {
            const bool last = (t == nt - 2);
            const char* a1 = cA + (size_t)(t + 1) * kstep;
            const char* a2 = last ? nA : cA + (size_t)(t + 2) * kstep; const char* b2 = last ? nB : cB + (size_t)(t + 2) * kstep;
            const char* a3 = a2 + kstep; const char* b3 = b2 + kstep;
            if constexpr (Sched::GATHER) { if (t == 2 && has_next) {
#pragma unroll
                for (int h_ = 0; h_ < 2; ++h_)
#pragma unroll
                    for (int i_ = 0; i_ < 2; ++i_) { asm volatile("" : "+v"(vAn[h_][i_])); vAn[h_][i_] = S.tokrow(vAn[h_][i_]) * (unsigned)KB + (unsigned)(sC[i_] * 2); } } }
            unsigned o2[2][2];
#pragma unroll
            for (int h_ = 0; h_ < 2; ++h_)
#pragma unroll
                for (int i_ = 0; i_ < 2; ++i_) o2[h_][i_] = last ? vAn[h_][i_] : vA[h_][i_];
            PG8_LDB(B0, 0, 0); PG8_LDB(B1, 0, 1); PG8_SCHED; PG8_LDA(At, 0, 0); PG8_STAGE(PG8_SA(1, 1), a1, vA[1]);
            PG8_WAIT_V(8); PG8_WAIT_L(0); PG8_BAR; PG8_MMA(0, 0, At, B0); PG8_MMA(0, 1, At, B1); PG8_BAR; PG8_SCHED;
            PG8_LDA(At, 0, 1); PG8_STAGE(PG8_SB(0, 0), b2, voffB); PG8_STAGE(PG8_SB(0, 1), b2 + hstep, voffB); PG8_STAGE(PG8_SA(0, 0), a2, o2[0]);
            PG8_WAIT_V(8); PG8_WAIT_L(0); PG8_BAR; PG8_MMA(1, 0, At, B0); PG8_MMA(1, 1, At, B1); PG8_BAR; PG8_SCHED;
            PG8_LDB(B0, 1, 0); PG8_LDB(B1, 1, 1); PG8_SCHED; PG8_LDA(At, 1, 0); PG8_STAGE(PG8_SA(0, 1), a2, o2[1]);
            PG8_WAIT_V(8); PG8_WAIT_L(0); PG8_BAR; PG8_MMA(0, 0, At, B0); PG8_MMA(0, 1, At, B1); PG8_BAR; PG8_SCHED;
            PG8_LDA(At, 1, 1); PG8_STAGE(PG8_SB(1, 0), b3, voffB); PG8_STAGE(PG8_SB(1, 1), b3 + hstep, voffB); PG8_STAGE(PG8_SA(1, 0), a3, o2[0]);
            PG8_WAIT_V(8); PG8_WAIT_L(0); PG8_BAR; PG8_MMA(1, 0, At, B0); PG8_MMA(1, 1, At, B1); PG8_BAR; PG8_SCHED;
        }
        if constexpr (ALIGN_EPI) { if (wr == 0) PG8_BAR; }
        E(acc, cur, wr, wc, fr, fq);
        if (!has_next) break;
#pragma unroll
        for (int a = 0; a < 2; ++a)
#pragma unroll
            for (int b = 0; b < 2; ++b)
#pragma unroll
                for (int m = 0; m < 4; ++m)
#pragma unroll
                    for (int n = 0; n < 2; ++n) acc[a][b][m][n] = (f32x4){z0, z0, z0, z0};
        cur = nxt; cA = nA; cB = nB; ++ui;
#pragma unroll
        for (int h_ = 0; h_ < 2; ++h_)
#pragma unroll
            for (int i_ = 0; i_ < 2; ++i_) vA[h_][i_] = vAn[h_][i_];
        if constexpr (ALIGN_EPI) { if (wr == 1) PG8_BAR; }
    }
    PG8_WAIT_V(0);
    if constexpr (!ALIGN_EPI) { if (wr == 0) PG8_BAR; }
    PG8_BAR;
#undef PG8_SETV
#undef PG8_SA
#undef PG8_SB
#undef PG8_STAGE
#undef PG8_LDA
#undef PG8_LDB
#undef PG8_MMA
#undef PG8_WAIT_V
#undef PG8_WAIT_L
#undef PG8_BAR
#undef PG8_SCHED
}
}
#include <hip/hip_bf16.h>
#include <cmath>
namespace attn_body {
using bf16=__hip_bfloat16;
using s16x4=__attribute__((ext_vector_type(4)))short;
constexpr int D=64,QP=DIN,OP=1024;
constexpr int NW=8,QBLK=32,QB=QBLK*NW,KVBLK=64;
__device__ __forceinline__ int crow(int r,int hi){return (r&3)+8*(r>>2)+4*hi;}
#define SBAR() __builtin_amdgcn_sched_barrier(0)
__device__ __forceinline__ void wmask(f32x16&p0,f32x16&p1,int kq,int hi){
  const float NEG=-INFINITY; const int kb=kq+4*hi;
  #pragma unroll
  for(int r=0;r<16;++r){const int d=kb+(r&3)+8*(r>>2); if(d>128||d<-128)p0[r]=NEG; if(d+32>128||d+32<-128)p1[r]=NEG;}
}

constexpr int NSLOT=3, SLOTB=8192;
constexpr int LDS_K=0, LDS_V=NSLOT*SLOTB, LDS_WS=2*NSLOT*SLOTB, LDS_OST=LDS_WS+NW*64*4, LDS_BYTES=LDS_OST+NW*4096;
constexpr float C2=0.125f*1.4426950408889634f;
__device__ __forceinline__ void glds16(const void*gsrc,unsigned lds_dst){unsigned keep;
  asm volatile("s_mov_b32 %0, m0\n\ts_mov_b32 m0, %2\n\ts_nop 0\n\tglobal_load_lds_dwordx4 %1, off\n\ts_mov_b32 m0, %0":"=&s"(keep):"v"(gsrc),"s"(lds_dst):"memory");}
__device__ __forceinline__ float max3f(float a,float b,float c){float r;asm("v_max3_f32 %0, %1, %2, %3":"=v"(r):"v"(a),"v"(b),"v"(c));return r;}
__device__ __forceinline__ float max2f(float a,float b){float r;asm("v_max_f32_e32 %0, %1, %2":"=v"(r):"v"(a),"v"(b));return r;}
__device__ __forceinline__ float fadd_s(float a,float b){float r;asm("v_add_f32_e32 %0, %1, %2":"=v"(r):"v"(a),"v"(b));return r;}
__device__ __forceinline__ float fsub_s(float a,float b){float r;asm("v_sub_f32_e32 %0, %1, %2":"=v"(r):"v"(a),"v"(b));return r;}
typedef float f32x2_t __attribute__((ext_vector_type(2))); typedef __bf16 bf16x2_t __attribute__((ext_vector_type(2)));
__device__ __forceinline__ unsigned cvtpk_s(float lo,float hi){f32x2_t v={lo,hi};bf16x2_t b=__builtin_convertvector(v,bf16x2_t);return __builtin_bit_cast(unsigned,b);}
#define WAIT_BAR(N) asm volatile("s_waitcnt vmcnt(" #N ") lgkmcnt(0)\n\ts_barrier":::"memory")

__device__ __forceinline__ void qkt(f32x16&p0,f32x16&p1,const char*Kslot,const bf16x8*qr,const f32x16&negm,int r32,int hi){
  const char*kb=Kslot+hi*1024+r32*16;
  #pragma unroll
  for(int d0=0;d0<4;++d0){
    const bf16x8 b0=*reinterpret_cast<const bf16x8*>(kb+d0*2048);
    const bf16x8 b1=*reinterpret_cast<const bf16x8*>(kb+d0*2048+512);
    if(d0==0){p0=__builtin_amdgcn_mfma_f32_32x32x16_bf16(b0,qr[0],negm,0,0,0);p1=__builtin_amdgcn_mfma_f32_32x32x16_bf16(b1,qr[0],negm,0,0,0);}
    else{p0=__builtin_amdgcn_mfma_f32_32x32x16_bf16(b0,qr[d0],p0,0,0,0);p1=__builtin_amdgcn_mfma_f32_32x32x16_bf16(b1,qr[d0],p1,0,0,0);}}
}
typedef __attribute__((address_space(3))) const char* lds_cptr;
typedef short v4i16_t __attribute__((ext_vector_type(4)));
__device__ __forceinline__ void kload8(bf16x8*kf,lds_cptr kp){
  kf[0]=*(const __attribute__((address_space(3))) bf16x8*)(kp);      kf[1]=*(const __attribute__((address_space(3))) bf16x8*)(kp+512);
  kf[2]=*(const __attribute__((address_space(3))) bf16x8*)(kp+2048); kf[3]=*(const __attribute__((address_space(3))) bf16x8*)(kp+2560);
  kf[4]=*(const __attribute__((address_space(3))) bf16x8*)(kp+4096); kf[5]=*(const __attribute__((address_space(3))) bf16x8*)(kp+4608);
  kf[6]=*(const __attribute__((address_space(3))) bf16x8*)(kp+6144); kf[7]=*(const __attribute__((address_space(3))) bf16x8*)(kp+6656);
}
__device__ __forceinline__ void kload2(bf16x8*kf,lds_cptr kp,int j){ kf[2*j]=*(const __attribute__((address_space(3))) bf16x8*)(kp+j*2048); kf[2*j+1]=*(const __attribute__((address_space(3))) bf16x8*)(kp+j*2048+512); }
__device__ __forceinline__ s16x4 vtr(lds_cptr p){ return __builtin_bit_cast(s16x4,__builtin_amdgcn_ds_read_tr16_b64_v4i16((__attribute__((address_space(3))) v4i16_t*)p)); }
__device__ __forceinline__ float rowmax(const f32x16&p0,const f32x16&p1){
  float a=max3f(p0[0],p0[1],p1[0]),b=max3f(p0[2],p0[3],p1[1]);a=max3f(a,p1[2],p1[3]);
  #pragma unroll
  for(int r=4;r<16;r+=4){a=max3f(a,p0[r],p0[r+1]);b=max3f(b,p0[r+2],p0[r+3]);a=max3f(a,p1[r],p1[r+1]);b=max3f(b,p1[r+2],p1[r+3]);}
  const float m=max2f(a,b);
  auto rr=__builtin_amdgcn_permlane32_swap(__float_as_uint(m),__float_as_uint(m),false,false);
  return max2f(__uint_as_float(rr[0]),__uint_as_float(rr[1]));
}
__device__ __forceinline__ void pv(f32x16*o,int vb,bf16x8 pa0,bf16x8 pa1,bf16x8 pa2,bf16x8 pa3){
  #pragma unroll
  for(int d0=0;d0<2;++d0){s16x4 lo[4],hi[4];
    #pragma unroll
    for(int ks=0;ks<4;++ks){
      asm volatile("ds_read_b64_tr_b16 %0,%1 offset:%c2":"=&v"(lo[ks]):"v"(vb),"i"(d0*4096+ks*1024):"memory");
      asm volatile("ds_read_b64_tr_b16 %0,%1 offset:%c2":"=&v"(hi[ks]):"v"(vb),"i"(d0*4096+ks*1024+512):"memory");}
    asm volatile("s_waitcnt lgkmcnt(0)":::"memory");SBAR();
    #define PK(k) (bf16x8){lo[k][0],lo[k][1],lo[k][2],lo[k][3],hi[k][0],hi[k][1],hi[k][2],hi[k][3]}
    o[d0]=__builtin_amdgcn_mfma_f32_32x32x16_bf16(pa0,PK(0),o[d0],0,0,0);
    o[d0]=__builtin_amdgcn_mfma_f32_32x32x16_bf16(pa1,PK(1),o[d0],0,0,0);
    o[d0]=__builtin_amdgcn_mfma_f32_32x32x16_bf16(pa2,PK(2),o[d0],0,0,0);
    o[d0]=__builtin_amdgcn_mfma_f32_32x32x16_bf16(pa3,PK(3),o[d0],0,0,0);
    #undef PK
  }
}

#ifndef ATTN_STORE16
#define ATTN_STORE16(p,v) (*(u32x4*)(p)=(v))
#endif
template<int THRL,bool WIN> __device__ __forceinline__ void attn_unit(const bf16*Qb,const bf16*__restrict__ Kb,const bf16*__restrict__ Vb,bf16*Ob,int q0,int NT,int tdelta,float sink_l2,int tid,char*shm){
  const int lane=tid&63,r32=lane&31,hi=lane>>5; const int wid=__builtin_amdgcn_readfirstlane(tid>>6);
  const bf16*Qw=Qb+(long)(q0+wid*QBLK)*QP;
  const bf16*Kh=Kb,*Vh=Vb;
  const unsigned lds0=(unsigned)(uintptr_t)shm;
  float*wsf=(float*)(shm+LDS_WS)+wid*64;
  const bf16*ksrc=Kh+(long)lane*QP+wid*8;
  const bf16*vsrc=Vh+(long)(16*(wid&3)+(lane>>2))*QP+(wid>>2)*32+(lane&3)*8;
  const unsigned kdst=lds0+LDS_K+wid*1024, vdst=lds0+LDS_V+wid*1024;
  #define TM(t) ((t)<4?(t):(t)+tdelta)
  #define DMA_K(t,slot) glds16(ksrc+(long)TM(t)*KVBLK*QP,(unsigned)__builtin_amdgcn_readfirstlane(kdst+(slot)))
  #define DMA_V(t,slot) glds16(vsrc+(long)TM(t)*KVBLK*QP,(unsigned)__builtin_amdgcn_readfirstlane(vdst+(slot)))
  const int vb0=(int)(lds0+LDS_V)+((lane>>4)&1)*32+(lane&3)*8+(4*hi+((lane&15)>>2))*64;
  const char*Kbase=shm+LDS_K; bf16x8 kf[8];
  const lds_cptr shm3=(lds_cptr)shm; const lds_cptr kp0=shm3+LDS_K+hi*1024+r32*16; const lds_cptr vp0=shm3+LDS_V+((lane>>4)&1)*32+(lane&3)*8+(4*hi+((lane&15)>>2))*64;
  DMA_K(0,0);DMA_V(0,0);DMA_K(1,SLOTB);
  bf16x8 qr[4];
  #pragma unroll
  for(int d0=0;d0<4;++d0)qr[d0]=*reinterpret_cast<const bf16x8*>(&Qw[(long)r32*QP+d0*16+hi*8]);
  float mhat=0.f,l_reg=0.f;float z0_=0.f;asm volatile("":"+v"(z0_));f32x16 o[2];
  #pragma unroll
  for(int r_=0;r_<16;++r_){o[0][r_]=z0_;o[1][r_]=z0_;}
  f32x16 negm;
  #pragma unroll
  for(int r_=0;r_<16;++r_)negm[r_]=z0_;
  asm volatile("":"+v"(negm));
  const int qrow=q0+wid*QBLK+r32;
  #define CMASK(P0,P1,t) do{ if(WIN&&(t)>=4)wmask(P0,P1,TM(t)*KVBLK-qrow,hi); }while(0)
  bool resc=false;
  #define START(P0,P1) do{ const float rm=rowmax(P0,P1); resc=false; \
    { const float dl=rm; mhat=fadd_s(mhat,dl); \
      _Pragma("unroll") for(int r=0;r<16;++r){P0[r]=fsub_s(P0[r],dl);P1[r]=fsub_s(P1[r],dl);} \
      _Pragma("unroll") for(int r=0;r<16;++r)negm[r]=-mhat; asm volatile("":"+v"(negm)); } \
    _Pragma("unroll") for(int r=0;r<16;++r)P0[r]=__builtin_amdgcn_exp2f(P0[r]); }while(0)
  #define RESC() do{ if(resc){ asm volatile("s_waitcnt lgkmcnt(0)":::"memory"); \
      _Pragma("unroll") for(int d_=0;d_<2;++d_) _Pragma("unroll") for(int r=0;r<16;++r)o[d_][r]*=wsf[crow(r,hi)]; } }while(0)
  f32x16 pA0,pA1,pB0,pB1;
  int sl_prev=0,sl_cur=0,sl_next=SLOTB;
  #define ROT() do{sl_prev=sl_cur;sl_cur=sl_next;sl_next=(sl_next==(NSLOT-1)*SLOTB)?0:sl_next+SLOTB;}while(0)
  DMA_K(2,2*SLOTB);
  WAIT_BAR(3);
  qkt(pA0,pA1,Kbase,qr,negm,r32,hi);asm volatile("s_nop 15\n\ts_nop 7":"+v"(pA0),"+v"(pA1));CMASK(pA0,pA1,0);
  START(pA0,pA1);
  _Pragma("unroll") for(int r=0;r<16;++r)pA1[r]=__builtin_amdgcn_exp2f(pA1[r]);
  WAIT_BAR(0);
  DMA_K(3,0);DMA_V(1,SLOTB);
  ROT();
  kload8(kf,kp0+sl_cur);
  WAIT_BAR(2);
  s16x4 vlo[8],vhi[8]; u32x4 pw0,pw1,pw2,pw3;
  #define PKW(P,B) cvtpk_s(P[B],P[B+1])
  #define PAF(k) __builtin_bit_cast(bf16x8,pw##k)
  #define VFR(i) (bf16x8){vlo[i][0],vlo[i][1],vlo[i][2],vlo[i][3],vhi[i][0],vhi[i][1],vhi[i][2],vhi[i][3]}
  #define PIN(x) asm volatile("":"+v"(x))
  #define MX3(a,b,c) __builtin_fmaxf(__builtin_fmaxf((a),(b)),(c))
  #define GAPA(MF,A0,A1,A2,A3,W0,W1,PW) do{ MF; sacc+=A0; sacc+=A1; sacc+=A2; sacc+=A3; PIN(sacc); W0; W1; PIN(PW); SBAR(); }while(0)
  #define EX(v) __builtin_amdgcn_exp2f(v)
  #define GAPB(MF,X,B) do{ MF; X[B]=EX(X[B]); X[B+1]=EX(X[B+1]); X[B+2]=EX(X[B+2]); X[B+3]=EX(X[B+3]); PIN(X); SBAR(); }while(0)
  #define VRD(i) do{ vlo[i]=vtr(vp_+(((i)>>2)*4096+((i)&3)*1024)); vhi[i]=vtr(vp_+(((i)>>2)*4096+((i)&3)*1024+512)); }while(0)
  #define KRD(G,j) do{ if(G){ kload2(kf,kp0+sl_next,j); SBAR(); } }while(0)
  #define STEP(C0,C1,P0,P1,t,GK,GV,GL) do{ SBAR(); \
    const lds_cptr vp_=vp0+sl_prev; \
    VRD(0); SBAR(); float sacc=(P0[0]+P0[1]); \
    GAPA(C0=__builtin_amdgcn_mfma_f32_32x32x16_bf16(kf[0],qr[0],negm,0,0,0), P0[2],P0[3],P0[4],P0[5],     pw0[0]=PKW(P0,0), pw0[1]=PKW(P0,2), pw0); \
    VRD(4); SBAR(); GAPA(C1=__builtin_amdgcn_mfma_f32_32x32x16_bf16(kf[1],qr[0],negm,0,0,0), P0[6],P0[7],P0[8],P0[9],     pw0[2]=PKW(P0,4), pw0[3]=PKW(P0,6), pw0); \
    VRD(1); SBAR(); GAPA(C0=__builtin_amdgcn_mfma_f32_32x32x16_bf16(kf[2],qr[1],C0,0,0,0),   P0[10],P0[11],P0[12],P0[13], pw1[0]=PKW(P0,8), pw1[1]=PKW(P0,10), pw1); \
    VRD(5); SBAR(); GAPA(C1=__builtin_amdgcn_mfma_f32_32x32x16_bf16(kf[3],qr[1],C1,0,0,0),   P0[14],P0[15],P1[0],P1[1],   pw1[2]=PKW(P0,12),pw1[3]=PKW(P0,14), pw1); \
    VRD(2); SBAR(); GAPA(C0=__builtin_amdgcn_mfma_f32_32x32x16_bf16(kf[4],qr[2],C0,0,0,0),   P1[2],P1[3],P1[4],P1[5],     pw2[0]=PKW(P1,0), pw2[1]=PKW(P1,2), pw2); \
    VRD(6); SBAR(); GAPA(C1=__builtin_amdgcn_mfma_f32_32x32x16_bf16(kf[5],qr[2],C1,0,0,0),   P1[6],P1[7],P1[8],P1[9],     pw2[2]=PKW(P1,4), pw2[3]=PKW(P1,6), pw2); \
    VRD(3); SBAR(); GAPA(C0=__builtin_amdgcn_mfma_f32_32x32x16_bf16(kf[6],qr[3],C0,0,0,0),   P1[10],P1[11],P1[12],P1[13], pw3[0]=PKW(P1,8), pw3[1]=PKW(P1,10), pw3); \
    VRD(7); SBAR(); GAPA(C1=__builtin_amdgcn_mfma_f32_32x32x16_bf16(kf[7],qr[3],C1,0,0,0),   P1[14],P1[15],0.f,0.f,       pw3[2]=PKW(P1,12),pw3[3]=PKW(P1,14), pw3); \
    l_reg+=sacc; \
    if(GK){DMA_K((t)+3,sl_cur);} if(GV){DMA_V((t)+1,sl_next);} \
    CMASK(C0,C1,t); \
    { float a=MX3(C0[0],C0[1],C1[0]),b=MX3(C0[2],C0[3],C1[1]); a=MX3(a,C1[2],C1[3]); \
      _Pragma("unroll") for(int r=4;r<16;r+=4){a=MX3(a,C0[r],C0[r+1]);b=MX3(b,C0[r+2],C0[r+3]);a=MX3(a,C1[r],C1[r+1]);b=MX3(b,C1[r+2],C1[r+3]);} \
      float rm=__builtin_fmaxf(a,b); { auto rr=__builtin_amdgcn_permlane32_swap(__float_as_uint(rm),__float_as_uint(rm),false,false); rm=__builtin_fmaxf(__uint_as_float(rr[0]),__uint_as_float(rr[1])); } \
      resc=false; \
      if(__builtin_expect(__any(rm>(float)THRL),0)){ const float dl=__builtin_fmaxf(rm,0.f); mhat+=dl; \
        _Pragma("unroll") for(int r=0;r<16;++r){C0[r]-=dl;C1[r]-=dl;} \
        _Pragma("unroll") for(int r=0;r<16;++r)negm[r]=-mhat; asm volatile("":"+v"(negm)); \
        const float f=__builtin_amdgcn_exp2f(-dl); l_reg*=f; if(hi==0)wsf[r32]=f; resc=true; } } \
    SBAR(); \
    GAPB(o[0]=__builtin_amdgcn_mfma_f32_32x32x16_bf16(PAF(0),VFR(0),o[0],0,0,0), C0,0); \
    GAPB(o[1]=__builtin_amdgcn_mfma_f32_32x32x16_bf16(PAF(0),VFR(4),o[1],0,0,0), C0,4); \
    KRD(GL,0); GAPB(o[0]=__builtin_amdgcn_mfma_f32_32x32x16_bf16(PAF(1),VFR(1),o[0],0,0,0), C0,8); \
    KRD(GL,1); GAPB(o[1]=__builtin_amdgcn_mfma_f32_32x32x16_bf16(PAF(1),VFR(5),o[1],0,0,0), C0,12); \
    KRD(GL,2); GAPB(o[0]=__builtin_amdgcn_mfma_f32_32x32x16_bf16(PAF(2),VFR(2),o[0],0,0,0), C1,0); \
    KRD(GL,3); GAPB(o[1]=__builtin_amdgcn_mfma_f32_32x32x16_bf16(PAF(2),VFR(6),o[1],0,0,0), C1,4); \
    GAPB(o[0]=__builtin_amdgcn_mfma_f32_32x32x16_bf16(PAF(3),VFR(3),o[0],0,0,0), C1,8); \
    GAPB(o[1]=__builtin_amdgcn_mfma_f32_32x32x16_bf16(PAF(3),VFR(7),o[1],0,0,0), C1,12); \
    }while(0)
  int t=1;
  for(;t+5<NT;t+=2){
    STEP(pB0,pB1,pA0,pA1,t,true,true,true);     WAIT_BAR(2); RESC(); ROT();
    STEP(pA0,pA1,pB0,pB1,t+1,true,true,true);   WAIT_BAR(2); RESC(); ROT();
  }
  #define ENDW(tt) do{ if((tt)+3<NT){WAIT_BAR(2);} else if((tt)+2<NT){WAIT_BAR(1);} else {WAIT_BAR(0);} }while(0)
  for(;t+1<NT;t+=2){
    STEP(pB0,pB1,pA0,pA1,t,(t+3<NT),(t+1<NT),(t+1<NT));       ENDW(t);   RESC(); ROT();
    STEP(pA0,pA1,pB0,pB1,t+1,(t+4<NT),(t+2<NT),(t+2<NT));     ENDW(t+1); RESC(); ROT();
  }
  STEP(pB0,pB1,pA0,pA1,NT-1,false,false,false); RESC();
  { float sacc=pB0[0]+pB0[1]; _Pragma("unroll") for(int r=2;r<16;++r)sacc+=pB0[r]; _Pragma("unroll") for(int r=0;r<16;++r)sacc+=pB1[r]; l_reg+=sacc;
    pw0=(u32x4){PKW(pB0,0),PKW(pB0,2),PKW(pB0,4),PKW(pB0,6)};pw1=(u32x4){PKW(pB0,8),PKW(pB0,10),PKW(pB0,12),PKW(pB0,14)};pw2=(u32x4){PKW(pB1,0),PKW(pB1,2),PKW(pB1,4),PKW(pB1,6)};pw3=(u32x4){PKW(pB1,8),PKW(pB1,10),PKW(pB1,12),PKW(pB1,14)};
    SBAR(); pv(o,vb0+sl_cur,PAF(0),PAF(1),PAF(2),PAF(3)); }
  #undef PKW
  #undef PAF
  #undef VFR
  #undef PIN
  #undef MX3
  #undef GAPA
  #undef GAPB
  #undef EX
  #undef VRD
  #undef KRD
  #undef STEP
  #undef ENDW
  {auto rr=__builtin_amdgcn_permlane32_swap(__float_as_uint(l_reg),__float_as_uint(l_reg),false,false);l_reg=__uint_as_float(rr[0])+__uint_as_float(rr[1]);}
  if(WIN)l_reg+=__builtin_amdgcn_exp2f(sink_l2-mhat);
  if(hi==0)wsf[32+r32]=l_reg;asm volatile("s_waitcnt lgkmcnt(0)":::"memory");
  float rli[16];
  #pragma unroll
  for(int r=0;r<16;++r)rli[r]=__builtin_amdgcn_rcpf(wsf[32+crow(r,hi)]);
  bf16*Ow=Ob+(long)(q0+wid*QBLK)*OP;
  { bf16*stg=(bf16*)(shm+LDS_OST)+wid*2048;
    #pragma unroll
    for(int r=0;r<16;++r){const int orow=crow(r,hi);
      #pragma unroll
      for(int d0=0;d0<2;++d0)stg[orow*64+d0*32+r32]=__float2bfloat16(o[d0][r]*rli[r]);}
    asm volatile("s_waitcnt lgkmcnt(0)":::"memory");
    #pragma unroll
    for(int i=0;i<4;++i){const int row=i*8+(lane>>3),ch=lane&7; const u32x4 v=*(const u32x4*)(stg+row*64+ch*8); ATTN_STORE16(Ow+(long)row*OP+ch*8,v);} }
  asm volatile("s_waitcnt lgkmcnt(0)\n\ts_barrier":::"memory");
  #undef TM
  #undef DMA_K
  #undef DMA_V
  #undef CMASK
  #undef START
  #undef RESC
  #undef ROT
}
constexpr int ATTN_LDS_BYTES=LDS_BYTES;
#undef SBAR
#undef WAIT_BAR
}
#define XB_TMO      128
#define XB_XCNT(j)  (256  + 64 * (j))
#define XB_XSUB(j)  (1280 + 64 * (j))
#define XB_XGEN(j)  (2304 + 64 * (j))
#define XB_TOP      3328
#define XB_TOPGEN   3392
#define XCD_BAR_WORDS 3456
#define XB_SPIN_CAP (1u << 21)

__device__ __forceinline__ unsigned xb_ld(unsigned* p)              { return __hip_atomic_load(p, __ATOMIC_RELAXED, __HIP_MEMORY_SCOPE_AGENT); }
__device__ __forceinline__ unsigned xb_add(unsigned* p, unsigned v) { return __hip_atomic_fetch_add(p, v, __ATOMIC_RELAXED, __HIP_MEMORY_SCOPE_AGENT); }
__device__ __forceinline__ unsigned xb_xcc_id() { return (unsigned)__builtin_amdgcn_s_getreg((3 << 11) | 20) & 0xFu; }
#define XB_SPIN(cond, bar) do { unsigned _sp = 0; while (cond) { __builtin_amdgcn_s_sleep(1); \
    if ((++_sp & 255u) == 0u) { if (xb_ld(&(bar)[XB_TMO])) break; if (_sp > XB_SPIN_CAP) { atomicAdd(&(bar)[XB_TMO], 1u); break; } } } } while (0)

struct XcdBarrier {
    unsigned* bar; unsigned x;
    volatile LAS unsigned* st;
};

__device__ __forceinline__ XcdBarrier xcd_barrier_post(unsigned* bar, volatile LAS unsigned* st) {
    XcdBarrier b; b.bar = bar; b.x = xb_xcc_id(); b.st = st;
    if (threadIdx.x == 0) (void)xb_add(&bar[XB_XCNT(b.x)], 1u);
    return b;
}
__device__ __forceinline__ void xcd_barrier_complete(unsigned* bar, unsigned x, unsigned& nloc, unsigned& nx) {
    const unsigned G = gridDim.x * gridDim.y * gridDim.z;
    unsigned sum, cnt, mine, sp = 0u;
    for (;;) {
        sum = 0u; cnt = 0u; mine = 0u;
#pragma unroll
        for (unsigned j = 0; j < 16; ++j) { const unsigned c = xb_ld(&bar[XB_XCNT(j)]); sum += c; cnt += (c > 0u) ? 1u : 0u; mine = (j == x) ? c : mine; }
        if (sum == G) break;
        __builtin_amdgcn_s_sleep(1);
        if ((++sp & 255u) == 0u) { if (xb_ld(&bar[XB_TMO])) break; if (sp > XB_SPIN_CAP) { atomicAdd(&bar[XB_TMO], 1u); break; } }
    }
    nloc = mine > 0u ? mine : 1u; nx = cnt > 0u ? cnt : 1u;
}

__device__ __forceinline__ void xcd_barrier(const XcdBarrier& b) {
    asm volatile("s_waitcnt vmcnt(0)" ::: "memory");
    __syncthreads();
    if (threadIdx.x == 0) {
        unsigned* bar = b.bar; unsigned bx_ = b.x; asm volatile("" : "+s"(bar), "+s"(bx_));
        __builtin_amdgcn_s_waitcnt(0);
        unsigned nloc = b.st[0], nx = b.st[1];
        if (nloc == 0u) { xcd_barrier_complete(bar, bx_, nloc, nx); b.st[0] = nloc; b.st[1] = nx; }
        const unsigned old = xb_add(&bar[XB_XSUB(bx_)], 1u);
        const unsigned gen = old / nloc;
        if (old + 1u == (gen + 1u) * nloc) {
            __builtin_amdgcn_fence(__ATOMIC_RELEASE, "agent");
            asm volatile("s_waitcnt vmcnt(0)" ::: "memory");
            const unsigned og = xb_add(&bar[XB_TOP], 1u);
            const unsigned tg = og / nx;
            if (og + 1u == (tg + 1u) * nx) xb_add(&bar[XB_TOPGEN], 1u);
            else XB_SPIN(xb_ld(&bar[XB_TOPGEN]) == tg, bar);
            __builtin_amdgcn_fence(__ATOMIC_ACQUIRE, "agent");
            xb_add(&bar[XB_XGEN(bx_)], 1u);
            asm volatile("s_waitcnt vmcnt(0)" ::: "memory");
        } else {
            XB_SPIN(xb_ld(&bar[XB_XGEN(bx_)]) == gen, bar);
            __builtin_amdgcn_fence(__ATOMIC_ACQUIRE, "agent");
            asm volatile("s_waitcnt vmcnt(0)" ::: "memory");
        }
    }
    __syncthreads();
}

#ifndef CVQ0
#define CVQ0 3
#define CVQ1 4
#define CVQ2 3
#define CVQ3 3
#endif
constexpr size_t alup(size_t x) { return (x + 4095) & ~(size_t)4095; }
constexpr size_t CTL_BYTES = 1u << 20;
constexpr size_t SZ_WIN = (size_t)DEPTH * DIN * DM * 2, SZ_WOUT = (size_t)DEPTH * DM * DM * 2, SZ_WGU = (size_t)DEPTH * NE * 2 * FF * DM  , SZ_WDN = (size_t)DEPTH * NE * DM * FF  ;
constexpr size_t SZ_MODP = (size_t)DEPTH * 16 * 17 * 6144 * 4, SZ_MOD = (size_t)DEPTH * 17 * 6144 * 4;
constexpr size_t SZ_X32 = (size_t)MROWS * DM * 2  , SZ_H = (size_t)MROWS * DM * 2, SZ_P = (size_t)MROWS * DIN * 2, SZ_Y = (size_t)MROWS * DM * 2, SZ_YP = (size_t)MROWS * 2 * DM  ;
constexpr size_t SZ_LIST = (size_t)NE * MROWS * 4, SZ_GW = (size_t)NE * MROWS * 4  ;
constexpr int MAXBLK = (MROWS * 2) / 256 + NE;
static_assert((size_t)MAXBLK * 256 * FF * 2 <= SZ_P, "HMID overlays P");
static_assert((size_t)2 * NB * 4 * NCH * 128 * 64 * 4 <= SZ_H, "KVT overlays H");
static_assert((size_t)2 * NB * 4 * NCH * 128 * 64 * 2 <= SZ_YP, "ST overlays YP");
constexpr size_t WS_CTL = 0;
constexpr size_t WS_WIN = CTL_BYTES, WS_WOUT = WS_WIN + alup(SZ_WIN), WS_WGU = WS_WOUT + alup(SZ_WOUT), WS_WDN = WS_WGU + alup(SZ_WGU);
constexpr size_t WS_MODP = WS_WDN + alup(SZ_WDN), WS_MOD = WS_MODP + alup(SZ_MODP);
constexpr size_t WS_X32 = WS_MOD + alup(SZ_MOD), WS_H = WS_X32 + alup(SZ_X32), WS_P = WS_H + alup(SZ_H), WS_Y = WS_P + alup(SZ_P), WS_YP = WS_Y + alup(SZ_Y);
constexpr size_t WS_LIST = WS_YP + alup(SZ_YP), WS_GW = WS_LIST + alup(SZ_LIST), WS_END = WS_GW + alup(SZ_GW);
constexpr int CW_BAR = 4096;
constexpr int CW_CNT = 16384;

constexpr int RING_BYTES = 131072;
constexpr int LDSCTL_OFF = RING_BYTES;
constexpr int LDS_BYTES = 147456;

#define ATTN_STORE16(p,v) (*(u32x4*)(p)=(v))

#define CAS __attribute__((address_space(4)))
__device__ __forceinline__ const float* inp(int i) {
    const CAS unsigned char* k = (const CAS unsigned char*)__builtin_amdgcn_kernarg_segment_ptr();
    asm volatile("" : "+s"(k));
    return *(const float* const CAS*)(k + 8 * i);
}
#define CBAR() do { asm volatile("" ::: "memory"); __builtin_amdgcn_sched_barrier(0); } while (0)
struct Ctx {
    float* out; unsigned char* ws;
    __device__ __forceinline__ const float* x() const { return inp(0); }
    __device__ __forceinline__ const float* c() const { return inp(1); }
    __device__ __forceinline__ const float* ctx() const { return inp(2); }
    __device__ __forceinline__ const float* c_ctx() const { return inp(3); }
    __device__ __forceinline__ const float* ada_w() const { return inp(4); }
    __device__ __forceinline__ const float* ada_b() const { return inp(5); }
    __device__ __forceinline__ const float* norm1() const { return inp(6); }
    __device__ __forceinline__ const float* norm2() const { return inp(7); }
    __device__ __forceinline__ const float* w_in() const { return inp(8); }
    __device__ __forceinline__ const float* w_out() const { return inp(9); }
    __device__ __forceinline__ const float* ret_decay() const { return inp(10); }
    __device__ __forceinline__ const float* win_gain() const { return inp(11); }
    __device__ __forceinline__ const float* win_sink() const { return inp(12); }
    __device__ __forceinline__ const float* glb_gain() const { return inp(13); }
    __device__ __forceinline__ const float* w_router() const { return inp(14); }
    __device__ __forceinline__ const float* b_router() const { return inp(15); }
    __device__ __forceinline__ const float* w_gu() const { return inp(16); }
    __device__ __forceinline__ const float* w_dn() const { return inp(17); }
};

template <int CTRL> __device__ __forceinline__ float dppx(float v) { return __builtin_bit_cast(float, __builtin_amdgcn_update_dpp(0, __builtin_bit_cast(int, v), CTRL, 0xF, 0xF, true)); }
__device__ __forceinline__ float xor1(float v) { return dppx<0xB1>(v); }
__device__ __forceinline__ float xor2(float v) { return dppx<0x4E>(v); }
__device__ __forceinline__ float wave_sum(float v) {
    v += dppx<0xB1>(v); v += dppx<0x4E>(v); v += dppx<0x141>(v); v += dppx<0x140>(v);
    { const unsigned u = __builtin_bit_cast(unsigned, v); auto r = __builtin_amdgcn_permlane16_swap(u, u, false, false); v = __builtin_bit_cast(float, (unsigned)r[0]) + __builtin_bit_cast(float, (unsigned)r[1]); }
    { const unsigned u = __builtin_bit_cast(unsigned, v); auto r = __builtin_amdgcn_permlane32_swap(u, u, false, false); v = __builtin_bit_cast(float, (unsigned)r[0]) + __builtin_bit_cast(float, (unsigned)r[1]); }
    return v;
}
__device__ __forceinline__ float xor16(float v, int lane) { const unsigned u = __builtin_bit_cast(unsigned, v); auto r = __builtin_amdgcn_permlane16_swap(u, u, false, false);
    return __builtin_bit_cast(float, (lane & 16) ? (unsigned)r[0] : (unsigned)r[1]); }
__device__ __forceinline__ float silu_f(float v) { return v * __builtin_amdgcn_rcpf(1.f + __builtin_amdgcn_exp2f(-LOG2E * v)); }
__device__ __forceinline__ float log2_sigmoid(float x) { return -log1pf(expf(-x)) * LOG2E; }

__device__ __forceinline__ void transpose_item(const float* W, int N, int nsrc0, int k0, bf16_t* WT, int K, int nrow0, LAS float* scr, int lane) {
    float ld_[32];
#pragma unroll
    for (int i = 0; i < 32; ++i) ld_[i] = W[(size_t)(k0 + 2 * i + (lane >> 5)) * N + nsrc0 + (lane & 31)];
#pragma unroll
    for (int i = 0; i < 32; ++i) scr[(2 * i + (lane >> 5)) * 33 + (lane & 31)] = ld_[i];
    asm volatile("s_waitcnt lgkmcnt(0)" ::: "memory");
    const int c = lane & 7;
#pragma unroll
    for (int j = 0; j < 4; ++j) { const int n = (lane >> 3) + 8 * j; const LAS float* s = scr + (8 * c) * 33 + n;
        u32x4 o; o.x = pk2(s[0 * 33], s[1 * 33]); o.y = pk2(s[2 * 33], s[3 * 33]); o.z = pk2(s[4 * 33], s[5 * 33]); o.w = pk2(s[6 * 33], s[7 * 33]);
        *(u32x4*)(WT + (size_t)(nrow0 + n) * K + k0 + 8 * c) = o; }
    asm volatile("s_waitcnt lgkmcnt(0)" ::: "memory");
}
__device__ __forceinline__ unsigned pk4_fp8(float a, float b, float c, float d) { int w = 0; w = __builtin_amdgcn_cvt_pk_fp8_f32(a, b, w, false); w = __builtin_amdgcn_cvt_pk_fp8_f32(c, d, w, true); return (unsigned)w; }
__device__ __forceinline__ f32x4 fp8x4_f32(unsigned w) { typedef float f2_ __attribute__((ext_vector_type(2))); const f2_ lo = __builtin_amdgcn_cvt_pk_f32_fp8((int)w, false), hi = __builtin_amdgcn_cvt_pk_f32_fp8((int)w, true); return (f32x4){lo[0], lo[1], hi[0], hi[1]}; }
constexpr float YP_SCALE = 16.0f, YP_INV = 1.0f / 16.0f;
constexpr float W8_SCALE = 64.0f, W8_INV = 1.0f / 64.0f;
__device__ __forceinline__ void transpose_item8(const float* W, int N, int nsrc0, int k0, unsigned char* WT, int K, int nrow0, LAS float* scr, int lane) {
    float ld_[32];
#pragma unroll
    for (int i = 0; i < 32; ++i) ld_[i] = W[(size_t)(k0 + 2 * i + (lane >> 5)) * N + nsrc0 + (lane & 31)];
#pragma unroll
    for (int i = 0; i < 32; ++i) scr[(2 * i + (lane >> 5)) * 33 + (lane & 31)] = ld_[i];
    asm volatile("s_waitcnt lgkmcnt(0)" ::: "memory");
    const int c = lane & 7;
#pragma unroll
    for (int j = 0; j < 4; ++j) { const int n = (lane >> 3) + 8 * j; const LAS float* s = scr + (8 * c) * 33 + n;
        u32x2 o; o.x = pk4_fp8(s[0 * 33] * W8_SCALE, s[1 * 33] * W8_SCALE, s[2 * 33] * W8_SCALE, s[3 * 33] * W8_SCALE); o.y = pk4_fp8(s[4 * 33] * W8_SCALE, s[5 * 33] * W8_SCALE, s[6 * 33] * W8_SCALE, s[7 * 33] * W8_SCALE);
        *(u32x2*)(WT + (size_t)(nrow0 + n) * K + k0 + 8 * c) = o; }
    asm volatile("s_waitcnt lgkmcnt(0)" ::: "memory");
}
constexpr int IT_WIN = 16 * 80, IT_WOUT = 16 * 32, IT_GU = 16 * 64, IT_DN = 16 * 32, IT_LAYER = IT_WIN + IT_WOUT + NE * (IT_GU + IT_DN);
__device__ __forceinline__ void convert_item(const Ctx& C, int l, int r, LAS float* scr, int lane) {
    if (r < IT_WIN) { const int kb = r / 80, nb = r % 80;
        transpose_item(C.w_in() + (size_t)l * DM * DIN, DIN, 32 * nb, 64 * kb, (bf16_t*)(C.ws + WS_WIN) + (size_t)l * DIN * DM, DM, 32 * nb, scr, lane); return; }
    r -= IT_WIN;
    if (r < IT_WOUT) { const int kb = r / 32, nb = r % 32;
        transpose_item(C.w_out() + (size_t)l * DM * DM, DM, 32 * nb, 64 * kb, (bf16_t*)(C.ws + WS_WOUT) + (size_t)l * DM * DM, DM, 32 * nb, scr, lane); return; }
    r -= IT_WOUT;
    if (r < NE * IT_GU) { const int e = r / IT_GU, q = r % IT_GU, kb = q / 64, nb = q % 64;
        const int np = 32 * nb, tile = np >> 8, within = np & 255, nsrc = within < 128 ? tile * 128 + within : FF + tile * 128 + within - 128;
        transpose_item8(C.w_gu() + (size_t)(l * NE + e) * DM * 2 * FF, 2 * FF, nsrc, 64 * kb, (unsigned char*)(C.ws + WS_WGU) + (size_t)(l * NE + e) * 2 * FF * DM, DM, np, scr, lane); return; }
    r -= NE * IT_GU;
    { const int e = r / IT_DN, q = r % IT_DN, kb = q / 32, nb = q % 32;
        transpose_item8(C.w_dn() + (size_t)(l * NE + e) * FF * DM, DM, 32 * nb, 64 * kb, (unsigned char*)(C.ws + WS_WDN) + (size_t)(l * NE + e) * DM * FF, FF, 32 * nb, scr, lane); }
}
__device__ __forceinline__ int cv_lo(int p) { return p == 0 ? 0 : p == 1 ? 3840 : p == 2 ? 13056 : p == 3 ? 19712 : IT_LAYER; }
__device__ __forceinline__ int cv_q(int p) { return p == 0 ? CVQ0 : p == 1 ? CVQ1 : p == 2 ? CVQ2 : CVQ3; }
__device__ __forceinline__ int cv_covered(int p, int units, int G) { const int rem = units % G; if (rem == 0) return 0; const int n = (G - rem) * 8 * cv_q(p), len = cv_lo(p + 1) - cv_lo(p); return n < len ? n : len; }
__device__ __forceinline__ void convert_tail(const Ctx& C, int lnext, int p, int units, int G, int c, LAS unsigned char* lds, int wave, int lane) {
    const int rem = units % G; if (rem == 0 || c < rem) return;
    const int nidle = G - rem, k = c - rem, lo = cv_lo(p), hi = cv_lo(p + 1);
    LAS float* scr = (LAS float*)(lds + wave * 16384);
    for (int j = 0; j < cv_q(p); ++j) { const int it = lo + (j * nidle + k) * 8 + wave; if (it < hi) convert_item(C, lnext, it, scr, lane); }
}
__device__ __forceinline__ void convert_rest(const Ctx& C, int l, int G, int vcu, LAS unsigned char* lds, int wave, int lane, int units2, int units3) {
    LAS float* scr = (LAS float*)(lds + wave * 16384);
    const int gw = vcu * 8 + wave, NGW = G * 8;
    const int lo0 = cv_lo(0) + cv_covered(0, (MROWS / 256) * (DIN / 256), G), lo1 = cv_lo(1) + cv_covered(1, (MROWS / 256) * (DM / 256), G), lo2 = cv_lo(2) + cv_covered(2, units2, G), lo3 = cv_lo(3) + cv_covered(3, units3, G);
    const int n0 = cv_lo(1) - lo0, n1 = cv_lo(2) - lo1, n2 = cv_lo(3) - lo2, n3 = cv_lo(4) - lo3;
    for (int v = gw; v < n0 + n1 + n2 + n3; v += NGW) { int r = v, it;
        if (r < n0) it = lo0 + r; else { r -= n0; if (r < n1) it = lo1 + r; else { r -= n1; if (r < n2) it = lo2 + r; else it = lo3 + (r - n2); } }
        convert_item(C, l, it, scr, lane); }
}
__device__ __forceinline__ void phase_prologue(const Ctx& C, LAS unsigned char* lds, int G, int vcu, int bx, int tid) {
    const int lane = tid & 63, wave = tid >> 6;
    {
        LAS float* scs = (LAS float*)lds;
        bool have = false;
        for (int it = bx; it < DEPTH * 12 * 16; it += G) {
            if (!have) {
                for (int i = tid; i < 17 * DM; i += 512) { const int r = i >> 10, k = i & 1023; const float v = r < 16 ? C.c()[r * DM + k] : C.c_ctx()[k]; scs[i] = v / (1.f + expf(-v)); }
                __syncthreads(); have = true;
            }
            const int l = it / 192, rem = it % 192, cb = rem / 16, kc = rem % 16;
            const float* w = C.ada_w() + ((size_t)l * DM + kc * 64) * 6144 + cb * 512 + tid;
            float acc[17];
#pragma unroll
            for (int r = 0; r < 17; ++r) acc[r] = 0.f;
#pragma unroll 4
            for (int kk = 0; kk < 64; ++kk) { const float wv = w[(size_t)kk * 6144];
#pragma unroll
                for (int r = 0; r < 17; ++r) acc[r] += scs[r * DM + kc * 64 + kk] * wv; }
            float* mp = (float*)(C.ws + WS_MODP) + ((size_t)(l * 16 + kc) * 17) * 6144 + cb * 512 + tid;
#pragma unroll
            for (int r = 0; r < 17; ++r) mp[(size_t)r * 6144] = acc[r];
        }
        __syncthreads();
    }
    LAS float* scr = (LAS float*)(lds + wave * 16384);
    const int gw = vcu * 8 + wave, NGW = G * 8;
    for (int it = gw; it < IT_LAYER; it += NGW) convert_item(C, 0, it, scr, lane);
}
__device__ __forceinline__ void phase_modsum(const Ctx& C, int G, int bx, int tid) {
    const float* mp = (const float*)(C.ws + WS_MODP); float* mod = (float*)(C.ws + WS_MOD);
    for (int i = bx * 512 + tid; i < DEPTH * 17 * 6144; i += G * 512) {
        const int l = i / (17 * 6144), rem = i % (17 * 6144), r = rem / 6144, n = rem % 6144;
        float s = C.ada_b()[l * 6144 + n];
#pragma unroll
        for (int kc = 0; kc < 16; ++kc) s += mp[((size_t)(l * 16 + kc) * 17 + r) * 6144 + n];
        mod[i] = s;
    }
}

__device__ __forceinline__ f32x4 bf4(u32x2 a) { return (f32x4){bflo(a.x), bfhi(a.x), bflo(a.y), bfhi(a.y)}; }
__device__ __forceinline__ u32x2 pk4(f32x4 v) { u32x2 w; w.x = pk2(v[0], v[1]); w.y = pk2(v[2], v[3]); return w; }
__device__ __forceinline__ void phase_norm1(const Ctx& C, int layer, int gw, int NGW, int lane, bf16_t* XO) {
    const float* mod = (const float*)(C.ws + WS_MOD) + (size_t)layer * 17 * 6144;
    const float* gain = C.norm1() + layer * DM;
    bf16_t* XR = (bf16_t*)(C.ws + WS_X32); bf16_t* H = (bf16_t*)(C.ws + WS_H); const unsigned char* YP = (const unsigned char*)(C.ws + WS_YP);
    const float* xin = C.x(); const float* cin = C.ctx();
    f32x4 nx[4]; u32x2 nr[4]; unsigned na[4], nb[4];
#define N1_LOAD(mm) do { const int b_ = (mm) / TPB, t_ = (mm) - b_ * TPB; \
        if (layer == 0) { const f32x4* s_ = (const f32x4*)(t_ < CTX ? cin + ((size_t)b_ * CTX + t_) * DM : xin + ((size_t)b_ * SEQ + (t_ - CTX)) * DM) + lane; \
            _Pragma("unroll") for (int j = 0; j < 4; ++j) nx[j] = s_[64 * j]; } \
        else { const u32x2* s_ = (const u32x2*)(XR + (size_t)(mm) * DM) + lane; const unsigned* y0_ = (const unsigned*)(YP + (size_t)(mm) * 2 * DM) + lane; \
            _Pragma("unroll") for (int j = 0; j < 4; ++j) { nr[j] = s_[64 * j]; na[j] = y0_[64 * j]; nb[j] = y0_[DM / 4 + 64 * j]; } } } while (0)
    if (gw < MROWS) N1_LOAD(gw);
    for (int m = gw; m < MROWS; m += NGW) {
        const int b = m / TPB, t = m - b * TPB, set = t < CTX ? 16 : b;
        f32x4 v[4];
        if (layer == 0) {
#pragma unroll
            for (int j = 0; j < 4; ++j) v[j] = nx[j];
        } else {
            const f32x4* g2 = (const f32x4*)(mod - 17 * 6144 + (size_t)set * 6144 + 5 * DM) + lane;
#pragma unroll
            for (int j = 0; j < 4; ++j) v[j] = bf4(nr[j]) + (g2[64 * j] * YP_INV) * (fp8x4_f32(na[j]) + fp8x4_f32(nb[j]));
        }
        if (m + NGW < MROWS) N1_LOAD(m + NGW);
        u32x2* xo = (u32x2*)(XO + (size_t)m * DM) + lane;
        float ss = 0.f;
#pragma unroll
        for (int j = 0; j < 4; ++j) { xo[64 * j] = pk4(v[j]); ss += (v[j][0] * v[j][0] + v[j][1] * v[j][1]) + (v[j][2] * v[j][2] + v[j][3] * v[j][3]); }
        const float rstd = 1.0f / sqrtf(wave_sum(ss) * (1.f / DM) + EPS);
        const f32x4* gp = (const f32x4*)gain + lane; const f32x4* shp = (const f32x4*)(mod + (size_t)set * 6144) + lane; const f32x4* scp = shp + DM / 4;
        u32x2* ho = (u32x2*)(H + (size_t)m * DM) + lane;
#pragma unroll
        for (int j = 0; j < 4; ++j) ho[64 * j] = pk4((v[j] * rstd) * gp[64 * j] * (scp[64 * j] + 1.0f) + shp[64 * j]);
    }
#undef N1_LOAD
}

__device__ __forceinline__ float swz_xor4(float v) { return __builtin_bit_cast(float, __builtin_amdgcn_ds_swizzle(__builtin_bit_cast(int, v), 0x101F)); }
__device__ __forceinline__ float swz_xor8(float v) { return __builtin_bit_cast(float, __builtin_amdgcn_ds_swizzle(__builtin_bit_cast(int, v), 0x201F)); }
__device__ __forceinline__ void phase_qkprep(const Ctx& C, int layer, int gw, int NGW, int lane, bf16_t* PO) {
    const bf16_t* P = (const bf16_t*)(C.ws + WS_P);
    const int hs = lane >> 3, j = lane & 7;
    const int col0 = (hs < 4 ? C_WQ + 64 * hs : hs < 6 ? C_WK + 64 * (hs - 4) : C_GQ + 64 * (hs - 6)) + 8 * j;
    const int col1 = (hs < 2 ? C_GQ + 128 + 64 * hs : C_GK + 64 * ((hs - 2) & 1)) + 8 * j;
    float g0[8], g1[8], inv[8];
    { const float* wg = C.win_gain() + layer * 128; const float* gg = C.glb_gain() + layer * 128;
      const float* s0p = hs < 4 ? wg : hs < 6 ? wg + 64 : gg; const float sc0 = (hs < 4 || hs >= 6) ? QSCALE : 1.f;
      const float* s1p = hs < 2 ? gg : gg + 64; const float sc1 = hs < 2 ? QSCALE : 1.f;
#pragma unroll
      for (int i = 0; i < 8; ++i) { g0[i] = s0p[8 * j + i] * sc0; g1[i] = s1p[8 * j + i] * sc1; inv[i] = exp2f(-(float)(8 * (j & 1) + i) * (13.287712379549449f / 16.0f)); } }
    const bool x2 = (j & 2) != 0, colax = (j & 4) != 0, act1 = lane < 32;
    u32x4 w0 = {0u, 0u, 0u, 0u}, w1 = {0u, 0u, 0u, 0u};
    if (gw < MROWS) { const bf16_t* row = P + (size_t)gw * DIN; w0 = *(const u32x4*)(row + col0); if (act1) w1 = *(const u32x4*)(row + col1); }
    for (int m = gw; m < MROWS; m += NGW) {
        const u32x4 c0 = w0, c1 = w1;
        if (m + NGW < MROWS) { const bf16_t* row = P + (size_t)(m + NGW) * DIN; w0 = *(const u32x4*)(row + col0); if (act1) w1 = *(const u32x4*)(row + col1); }
        const int b = m / TPB, t = m - b * TPB; const bool isx = t >= CTX; const int pos = t - CTX;
        float cs[8], sn[8];
        if (isx) { const float pv = (float)(colax ? (pos & 63) : (pos >> 6));
#pragma unroll
            for (int i = 0; i < 8; ++i) { const float ang = pv * inv[i]; cs[i] = __cosf(ang); sn[i] = x2 ? __sinf(ang) : -__sinf(ang); } }
        else {
#pragma unroll
            for (int i = 0; i < 8; ++i) { cs[i] = 1.f; sn[i] = 0.f; } }
        bf16_t* orow = PO + (size_t)m * (PO == P ? DIN : 256);
#pragma unroll
        for (int pass = 0; pass < 2; ++pass) {
            const u32x4 w = pass ? c1 : c0;
            float x[8] = {bflo(w.x), bfhi(w.x), bflo(w.y), bfhi(w.y), bflo(w.z), bfhi(w.z), bflo(w.w), bfhi(w.w)};
            float ss = 0.f;
#pragma unroll
            for (int i = 0; i < 8; ++i) ss += x[i] * x[i];
            ss += xor1(ss); ss += xor2(ss); ss += swz_xor4(ss);
            const float r = 1.0f / sqrtf(ss * (1.f / 64.f) + EPS);
            float y[8];
#pragma unroll
            for (int i = 0; i < 8; ++i) { x[i] = x[i] * r * (pass ? g1[i] : g0[i]); }
#pragma unroll
            for (int i = 0; i < 8; ++i) { const float pr = xor2(x[i]); y[i] = x[i] * cs[i] + pr * sn[i]; }
            u32x4 o; o.x = pk2(y[0], y[1]); o.y = pk2(y[2], y[3]); o.z = pk2(y[4], y[5]); o.w = pk2(y[6], y[7]);
            const int col = pass ? col1 : col0;
            if (pass == 0 || act1) *(u32x4*)(orow + (PO == P ? col : (col & 127))) = o;
        }
    }
}

__device__ __forceinline__ unsigned off_v(unsigned row, unsigned ch) { return 256u * row + 16u * (ch ^ (((row & 3) << 2) | ((row >> 2) & 3))); }
__device__ __forceinline__ unsigned off_k(unsigned row, unsigned ch) { return 128u * row + 16u * (ch ^ (row & 7)); }
typedef short s16x4_t __attribute__((ext_vector_type(4)));
__device__ __forceinline__ s16x4_t tr_rd(const LAS unsigned char* p) { return __builtin_bit_cast(s16x4_t, __builtin_amdgcn_ds_read_tr16_b64_v4i16((LAS s16x4_t*)p)); }
template <bool KIMG> __device__ __forceinline__ bf16x8 tr_frag(const LAS unsigned char* img, int lane, int rbase, int r0off, int r1off, int cblk) {
    const unsigned blk = (lane >> 4) & 1, q = (lane & 15) >> 2, pp = lane & 3, ch = 4 * cblk + 2 * blk + (pp >> 1);
    const unsigned ra = rbase + r0off + q, rb = rbase + r1off + q;
    const s16x4_t lo = tr_rd(img + (KIMG ? off_k(ra, ch) : off_v(ra, ch)) + 8 * (pp & 1)), hi = tr_rd(img + (KIMG ? off_k(rb, ch) : off_v(rb, ch)) + 8 * (pp & 1));
    return (bf16x8){lo[0], lo[1], lo[2], lo[3], hi[0], hi[1], hi[2], hi[3]};
}
__device__ __forceinline__ void stage_v(const bf16_t* P, size_t r0, int h, LAS unsigned char* img, int tid) {
#pragma unroll
    for (int i = 0; i < 4; ++i) { const int p_ = tid + 512 * i, j = p_ >> 4, ch = p_ & 15;
        *(LAS u32x4*)(img + off_v(j, ch)) = *(const u32x4*)(P + (r0 + j) * DIN + C_RV + h * 128 + 8 * ch); }
}
__device__ __forceinline__ void ret_r1_unit(const Ctx& C, int layer, int b, int h, int c, LAS unsigned char* lds, int tid) {
    const int lane = tid & 63, wid = tid >> 6;
    const bf16_t* P = (const bf16_t*)(C.ws + WS_P); float* KVT = (float*)(C.ws + WS_H);
    LAS unsigned char* Vi = lds; LAS unsigned char* Kf = lds + 32768; LAS unsigned char* Kb = lds + 49152;
    const float* dec = C.ret_decay(); const float lf = log2_sigmoid(dec[(layer * 2 + 0) * 4 + h]), lb = log2_sigmoid(dec[(layer * 2 + 1) * 4 + h]);
    const size_t r0 = (size_t)b * TPB + c * 128;
#pragma unroll
    for (int i = 0; i < 2; ++i) { const int p_ = tid + 512 * i, j = p_ >> 3, ch = p_ & 7;
        const u32x4 w = *(const u32x4*)(P + (r0 + j) * DIN + C_RK + h * 64 + 8 * ch);
        const float zf = exp2f((float)(127 - j) * lf) * 0.125f, zb = exp2f((float)j * lb) * 0.125f;
        const float x[8] = {bflo(w.x), bfhi(w.x), bflo(w.y), bfhi(w.y), bflo(w.z), bfhi(w.z), bflo(w.w), bfhi(w.w)};
        u32x4 of, ob; of.x = pk2(x[0] * zf, x[1] * zf); of.y = pk2(x[2] * zf, x[3] * zf); of.z = pk2(x[4] * zf, x[5] * zf); of.w = pk2(x[6] * zf, x[7] * zf);
        ob.x = pk2(x[0] * zb, x[1] * zb); ob.y = pk2(x[2] * zb, x[3] * zb); ob.z = pk2(x[4] * zb, x[5] * zb); ob.w = pk2(x[6] * zb, x[7] * zb);
        *(LAS u32x4*)(Kf + off_k(j, ch)) = of; *(LAS u32x4*)(Kb + off_k(j, ch)) = ob; }
    stage_v(P, r0, h, Vi, tid);
    __syncthreads();
    const int mb = wid >> 1, nb = wid & 1, r = lane & 31, hh = lane >> 5;
    float z0 = 0.f; asm volatile("" : "+v"(z0)); f32x16 af, ab;
#pragma unroll
    for (int i = 0; i < 16; ++i) { af[i] = z0; ab[i] = z0; }
#pragma unroll
    for (int ks = 0; ks < 8; ++ks) {
        const bf16x8 a = tr_frag<false>(Vi, lane, 16 * ks + 8 * hh, 0, 4, mb);
        const bf16x8 bf = tr_frag<true>(Kf, lane, 16 * ks + 8 * hh, 0, 4, nb);
        const bf16x8 bb = tr_frag<true>(Kb, lane, 16 * ks + 8 * hh, 0, 4, nb);
        af = __builtin_amdgcn_mfma_f32_32x32x16_bf16(a, bf, af, 0, 0, 0);
        ab = __builtin_amdgcn_mfma_f32_32x32x16_bf16(a, bb, ab, 0, 0, 0);
    }
    float* of = KVT + ((size_t)((0 * NB + b) * 4 + h) * NCH + c) * 8192; float* ob = KVT + ((size_t)((1 * NB + b) * 4 + h) * NCH + c) * 8192;
#pragma unroll
    for (int reg = 0; reg < 16; ++reg) { const int dv = 32 * mb + (reg & 3) + 8 * (reg >> 2) + 4 * hh, dk = 32 * nb + r; of[dv * 64 + dk] = af[reg]; ob[dv * 64 + dk] = ab[reg]; }
    __syncthreads();
}
__device__ __forceinline__ void ret_r2_unit(const Ctx& C, int layer, int u, int tid) {
    const int q = u & 3, bh = (u >> 2) & 63, dir = u >> 8, b = bh >> 2, h = bh & 3;
    const float G = exp2f(128.f * log2_sigmoid(C.ret_decay()[(layer * 2 + dir) * 4 + h]));
    const size_t base = ((size_t)((dir * NB + b) * 4 + h) * NCH) * 8192 + q * 2048 + tid * 4;
    const float* KVT = (const float*)(C.ws + WS_H) + base; bf16_t* ST = (bf16_t*)(C.ws + WS_YP) + base;
    float z0 = 0.f; asm volatile("" : "+v"(z0)); f32x4 S = {z0, z0, z0, z0};
#pragma unroll
    for (int half = 0; half < 2; ++half) {
        f32x4 kv[17];
#pragma unroll
        for (int s = 0; s < 17; ++s) { const int step = half * 17 + s; const int c = dir == 0 ? step : (step < 2 ? 1 - step : 35 - step); kv[s] = *(const f32x4*)(KVT + (size_t)c * 8192); }
#pragma unroll
        for (int s = 0; s < 17; ++s) { const int step = half * 17 + s; const int c = dir == 0 ? step : (step < 2 ? 1 - step : 35 - step);
            u32x2 w; w.x = pk2(S[0], S[1]); w.y = pk2(S[2], S[3]); *(u32x2*)(ST + (size_t)c * 8192) = w;
            S = S * G + kv[s]; }
    }
}
__device__ __forceinline__ void ret_r3_all(const Ctx& C, int layer, int bx, int G, LAS unsigned char* lds, int tid) {
    int lane = tid & 63; asm volatile("" : "+v"(lane));
    const int wid = tid >> 6, r = lane & 31, hh = lane >> 5, ib = wid & 3, dh = wid >> 2;
    const bf16_t* P = (const bf16_t*)(C.ws + WS_P);
    LAS unsigned char* Vi = lds;
    LAS float* Ol = (LAS float*)(lds + 32768);
    const float* dec = C.ret_decay() + layer * 8;
    const int NU = NB * 4 * NCH; const bool skipc = layer == DEPTH - 1;
#define R3_NEXT(u_) do { (u_) += G; while ((u_) < NU && skipc && ((u_) % NCH) < 2) (u_) += G; } while (0)
#define R3_ZERO(v) do { float z_ = 0.f; asm volatile("" : "+v"(z_)); _Pragma("unroll") for (int i_ = 0; i_ < 16; ++i_) v[i_] = z_; } while (0)
    int u = bx - G; R3_NEXT(u); if (u >= NU) return;
    u32x4 vreg[4]; bf16x8 qf[4], kf[2][4];
#define R3_LOAD_A(u_) do { const int c_ = (u_) % NCH, bh_ = (u_) / NCH, h_ = bh_ & 3; const size_t r0_ = (size_t)(bh_ >> 2) * TPB + c_ * 128; \
        _Pragma("unroll") for (int i = 0; i < 4; ++i) { const int p_ = tid + 512 * i, j = p_ >> 4, ch = p_ & 15; vreg[i] = *(const u32x4*)(P + (r0_ + j) * DIN + C_RV + h_ * 128 + 8 * ch); } \
        { const bf16_t* Qp = P + (r0_ + 32 * ib + r) * DIN + C_RQ + h_ * 64 + 8 * hh; _Pragma("unroll") for (int ks = 0; ks < 4; ++ks) qf[ks] = *(const bf16x8*)(Qp + 16 * ks); } \
        _Pragma("unroll") for (int jb = 0; jb < 2; ++jb) { const bf16_t* Kp = P + (r0_ + 32 * jb + r) * DIN + C_RK + h_ * 64 + 8 * hh; \
            _Pragma("unroll") for (int ks = 0; ks < 4; ++ks) kf[jb][ks] = *(const bf16x8*)(Kp + 16 * ks); } } while (0)
    R3_LOAD_A(u);
    unsigned lp[2][2];
    { const unsigned blk = (lane >> 4) & 1, q = (lane & 15) >> 2, pp = lane & 3;
#pragma unroll
      for (int t = 0; t < 2; ++t)
#pragma unroll
          for (int cb = 0; cb < 2; ++cb) lp[t][cb] = off_v(4 * hh + 8 * t + q, 4 * (2 * dh + cb) + 2 * blk + (pp >> 1)) + 8 * (pp & 1); }
    for (;;) {
        const int c = u % NCH, bh = u / NCH, b = bh >> 2, h = bh & 3;
        const float lf = log2_sigmoid(dec[h]), lb = log2_sigmoid(dec[4 + h]);
        const size_t r0 = (size_t)b * TPB + c * 128;
        int rq = r, hq = hh; asm volatile("" : "+v"(rq), "+v"(hq));
#pragma unroll
        for (int i = 0; i < 4; ++i) { const int p_ = tid + 512 * i, j = p_ >> 4, ch = p_ & 15; *(LAS u32x4*)(Vi + off_v(j, ch)) = vreg[i]; }
        bf16x8 st[2][4]; u32x4 gwv[4];
        { const bf16_t* sf = (const bf16_t*)(C.ws + WS_YP) + ((size_t)((0 * NB + b) * 4 + h) * NCH + c) * 8192 + (64 * dh + r) * 64 + 8 * hh;
#pragma unroll
          for (int t = 0; t < 2; ++t)
#pragma unroll
              for (int ks = 0; ks < 4; ++ks) st[t][ks] = *(const bf16x8*)(sf + t * 32 * 64 + 16 * ks); }
        __syncthreads();
        f32x16 o[2]; R3_ZERO(o[0]); R3_ZERO(o[1]);
#pragma unroll
        for (int jb = 0; jb < 4; ++jb) {
            if (jb == 1 || jb == 3) {
                const int dir = jb >> 1; f32x16 acc[2];
#pragma unroll
                for (int t = 0; t < 2; ++t) { R3_ZERO(acc[t]);
#pragma unroll
                    for (int ks = 0; ks < 4; ++ks) acc[t] = __builtin_amdgcn_mfma_f32_32x32x16_bf16(qf[ks], st[t][ks], acc[t], 0, 0, 0); }
#pragma unroll
                for (int reg = 0; reg < 16; ++reg) { const int i = 32 * ib + (reg & 3) + 8 * (reg >> 2) + 4 * hq; const float xi = dir == 0 ? __builtin_amdgcn_exp2f((float)(i + 1) * lf) : __builtin_amdgcn_exp2f((float)(128 - i) * lb);
                    o[0][reg] += xi * acc[0][reg]; o[1][reg] += xi * acc[1][reg]; }
                CBAR();
                if (jb == 1) { const bf16_t* sb = (const bf16_t*)(C.ws + WS_YP) + ((size_t)((1 * NB + b) * 4 + h) * NCH + c) * 8192 + (64 * dh + r) * 64 + 8 * hh;
#pragma unroll
                    for (int t = 0; t < 2; ++t)
#pragma unroll
                        for (int ks = 0; ks < 4; ++ks) st[t][ks] = *(const bf16x8*)(sb + t * 32 * 64 + 16 * ks); } }
            f32x16 x; R3_ZERO(x);
#pragma unroll
            for (int ks = 0; ks < 4; ++ks) x = __builtin_amdgcn_mfma_f32_32x32x16_bf16(kf[jb & 1][ks], qf[ks], x, 0, 0, 0);
            if (jb < 2) { const bf16_t* Kp = P + (r0 + 32 * (jb + 2) + r) * DIN + C_RK + h * 64 + 8 * hh;
#pragma unroll
                for (int ks = 0; ks < 4; ++ks) kf[jb & 1][ks] = *(const bf16x8*)(Kp + 16 * ks); }
#pragma unroll
            for (int reg = 0; reg < 16; ++reg) { const int d = (32 * ib + rq) - (32 * jb + (reg & 3) + 8 * (reg >> 2) + 4 * hq);
                const float D = d > 0 ? __builtin_amdgcn_exp2f((float)d * lf) : (d < 0 ? __builtin_amdgcn_exp2f((float)(-d) * lb) : 2.0f); x[reg] *= 0.125f * D; }
#pragma unroll
            for (int s = 0; s < 2; ++s) {
                u32x4 pw; pw.x = pk2(x[8 * s + 0], x[8 * s + 1]); pw.y = pk2(x[8 * s + 2], x[8 * s + 3]); pw.z = pk2(x[8 * s + 4], x[8 * s + 5]); pw.w = pk2(x[8 * s + 6], x[8 * s + 7]);
                const bf16x8 pa = __builtin_bit_cast(bf16x8, pw);
#pragma unroll
                for (int cb = 0; cb < 2; ++cb) { const s16x4_t lo = tr_rd(Vi + lp[0][cb] + (8192 * jb + 4096 * s)), hi = tr_rd(Vi + lp[1][cb] + (8192 * jb + 4096 * s));
                    const bf16x8 vb = (bf16x8){lo[0], lo[1], lo[2], lo[3], hi[0], hi[1], hi[2], hi[3]};
                    o[cb] = __builtin_amdgcn_mfma_f32_32x32x16_bf16(pa, vb, o[cb], 0, 0, 0); }
            }
            CBAR();
        }
        { const bf16_t* gp = P + (r0 + (tid >> 2)) * DIN + C_RG + h * 128 + 32 * (tid & 3);
#pragma unroll
          for (int e2 = 0; e2 < 4; ++e2) gwv[e2] = *(const u32x4*)(gp + 8 * e2); }
#pragma unroll
        for (int cb = 0; cb < 2; ++cb)
#pragma unroll
            for (int reg = 0; reg < 16; ++reg) { const int i = 32 * ib + (reg & 3) + 8 * (reg >> 2) + 4 * hh, dv = 64 * dh + 32 * cb + r; Ol[i * 132 + dv] = o[cb][reg]; }
        __syncthreads();
        int un = u; R3_NEXT(un);
        if (un < NU) R3_LOAD_A(un);
        CBAR();
        { const int row = tid >> 2, q = tid & 3; f32x4 x[8]; float sm = 0.f;
#pragma unroll
          for (int e = 0; e < 8; ++e) { x[e] = *(const LAS f32x4*)(Ol + row * 132 + 32 * q + 4 * e); sm += (x[e][0] + x[e][1]) + (x[e][2] + x[e][3]); }
          sm += xor1(sm); sm += xor2(sm);
          const float mu = sm * (1.f / 128.f); float vs = 0.f;
#pragma unroll
          for (int e = 0; e < 8; ++e) { x[e] = x[e] - mu; vs += (x[e][0] * x[e][0] + x[e][1] * x[e][1]) + (x[e][2] * x[e][2] + x[e][3] * x[e][3]); }
          vs += xor1(vs); vs += xor2(vs);
          const float rstd = 1.0f / sqrtf(vs * (1.f / 128.f) + EPS);
          bf16_t* yp = (bf16_t*)(C.ws + WS_Y) + (r0 + row) * DM + h * 128 + 32 * q;
#pragma unroll
          for (int e2 = 0; e2 < 4; ++e2) { const u32x4 gw = gwv[e2]; const f32x4 a = x[2 * e2] * rstd, bq = x[2 * e2 + 1] * rstd;
              u32x4 ow; ow.x = pk2(a[0] * silu_f(bflo(gw.x)), a[1] * silu_f(bfhi(gw.x))); ow.y = pk2(a[2] * silu_f(bflo(gw.y)), a[3] * silu_f(bfhi(gw.y)));
              ow.z = pk2(bq[0] * silu_f(bflo(gw.z)), bq[1] * silu_f(bfhi(gw.z))); ow.w = pk2(bq[2] * silu_f(bflo(gw.w)), bq[3] * silu_f(bfhi(gw.w)));
              *(u32x4*)(yp + 8 * e2) = ow; } }
        if (un >= NU) break;
        u = un;
    }
#undef R3_NEXT
#undef R3_ZERO
#undef R3_LOAD_A
}

template <bool WIN>
__device__ __forceinline__ void attn_dispatch(const Ctx& C, int layer, int U, int tid, char* lds) {
    using attn_body::bf16;
    int b, h, q0, NT, tdelta;
    if (U < 1024) { b = U >> 6; h = ((U >> 5) & 1) * 2 + ((U >> 4) & 1); q0 = CTX + 256 * (U & 15);
        if (WIN) { const int ts = (q0 / 64 - 2) > 4 ? (q0 / 64 - 2) : 4, te = (q0 / 64 + 6) < 68 ? (q0 / 64 + 6) : 68; NT = 4 + te - ts; tdelta = ts - 4; } else { NT = 68; tdelta = 0; } }
    else { b = (U - 1024) >> 2; h = (U - 1024) & 3; q0 = 0; NT = 4; tdelta = 0; }
    const int kvh = h >> 1;
    const bf16* Pb = (const bf16*)(C.ws + WS_P) + (size_t)b * TPB * DIN; bf16* Yb = (bf16*)(C.ws + WS_Y) + (size_t)b * TPB * DM;
    if (WIN) attn_body::attn_unit<8, true>(Pb + C_WQ + 64 * h, Pb + C_WK + 64 * kvh, Pb + C_WV + 64 * kvh, Yb + 512 + 64 * h, q0, NT, tdelta, C.win_sink()[layer * 4 + h] * LOG2E, tid, lds);
    else     attn_body::attn_unit<8, false>(Pb + C_GQ + 64 * h, Pb + C_GK + 64 * kvh, Pb + C_GV + 64 * kvh, Yb + 768 + 64 * h, q0, NT, tdelta, 0.f, tid, lds);
}
template <bool WIN>
__device__ __forceinline__ void attn_units(const Ctx& C, int layer, int G, int vcu, int bx, int tid, char* lds) {
    const int nctx = (layer == DEPTH - 1) ? 0 : 64;
    if (G == 256) {
        for (int k = 0; k < 4; ++k) attn_dispatch<WIN>(C, layer, vcu * 4 + k, tid, lds);
        if (vcu < nctx) attn_dispatch<WIN>(C, layer, 1024 + vcu, tid, lds);
    } else {
        for (int U = bx; U < 1024 + nctx; U += G) attn_dispatch<WIN>(C, layer, U, tid, lds);
    }
}

__device__ __forceinline__ f32x2 swap32(float a, float b) { auto r = __builtin_amdgcn_permlane32_swap(__builtin_bit_cast(unsigned, a), __builtin_bit_cast(unsigned, b), false, false);
    return (f32x2){__builtin_bit_cast(float, (unsigned)r[0]), __builtin_bit_cast(float, (unsigned)r[1])}; }
__device__ __forceinline__ f32x2 swap16(float a, float b) { auto r = __builtin_amdgcn_permlane16_swap(__builtin_bit_cast(unsigned, a), __builtin_bit_cast(unsigned, b), false, false);
    return (f32x2){__builtin_bit_cast(float, (unsigned)r[0]), __builtin_bit_cast(float, (unsigned)r[1])}; }
__device__ __forceinline__ void phase_norm2_route(const Ctx& C, int layer_c, LAS unsigned char* lds, int G, int bx, int tid) {
    const int layer = layer_c & 3;
    const int lane = tid & 63, wave = tid >> 6;
    const float* mod = (const float*)(C.ws + WS_MOD) + (size_t)layer * 17 * 6144;
    const float* gain = C.norm2() + layer * DM;
    const bf16_t* XR = (const bf16_t*)(C.ws + WS_X32); unsigned char* H = (unsigned char*)(C.ws + WS_H);
    int* list = (int*)(C.ws + WS_LIST);
    unsigned* gcnt = (unsigned*)(C.ws + WS_CTL) + CW_CNT + 64 * layer_c;
    constexpr int RPC = MROWS / 256, RPW = RPC / 8;
    LAS float* wrT = (LAS float*)lds;
    LAS float* lgs = (LAS float*)(lds + 65536);
    LAS int* lcnt = (LAS int*)(lds + 65536 + RPC * 64);
    LAS int* lbase = lcnt + 16;
    LAS int* rec_e = lcnt + 32;
    LAS float* rec_w = (LAS float*)(rec_e + 2 * RPC);
    { const float* wr = C.w_router(); for (int i = tid; i < DM * NE; i += 512) { const int k = i >> 4, e = i & 15; wrT[e * DM + k] = wr[i]; } }
    if (tid < 16) lcnt[tid] = 0;
    __syncthreads();
    const unsigned lo4 = (unsigned)lane * 4u, lo8 = (unsigned)lane * 8u, lo16 = (unsigned)lane * 16u;
#define E_LOADROW(dst, mm) do { const char* xr_ = (const char*)(XR + (size_t)(mm) * DM); _Pragma("unroll") for (int j = 0; j < 4; ++j) dst[j] = *(const u32x2*)(xr_ + (lo8 + 512u * j)); } while (0)
#define E_NORMROW(v, nxr, mm) do { float ss_ = 0.f; _Pragma("unroll") for (int j = 0; j < 4; ++j) { v[j] = bf4(nxr[j]); ss_ += (v[j][0] * v[j][0] + v[j][1] * v[j][1]) + (v[j][2] * v[j][2] + v[j][3] * v[j][3]); } \
        const int b_ = (mm) / TPB, t_ = (mm) - b_ * TPB, set_ = t_ < CTX ? 16 : b_; const float rstd_ = 1.0f / sqrtf(wave_sum(ss_) * (1.f / DM) + EPS); \
        const char* gp_ = (const char*)gain; const char* shp_ = (const char*)(mod + (size_t)set_ * 6144 + 3 * DM); const char* scp_ = shp_ + DM * 4; \
        char* ho_ = (char*)(H + (size_t)(mm) * DM); \
        _Pragma("unroll") for (int j = 0; j < 4; ++j) { v[j] = (v[j] * rstd_) * *(const f32x4*)(gp_ + (lo16 + 1024u * j)) * (*(const f32x4*)(scp_ + (lo16 + 1024u * j)) + 1.0f) + *(const f32x4*)(shp_ + (lo16 + 1024u * j)); \
            *(unsigned*)(ho_ + (lo4 + 256u * j)) = pk4_fp8(v[j][0], v[j][1], v[j][2], v[j][3]); } } while (0)
#define E_REDUCE(pe, rowl) do { float q8_[8], q4_[4], q2_[2]; \
        _Pragma("unroll") for (int e = 0; e < 8; ++e) { const f32x2 r_ = swap32(pe[e], pe[e + 8]); q8_[e] = r_[0] + r_[1]; } \
        _Pragma("unroll") for (int e = 0; e < 4; ++e) { const f32x2 r_ = swap16(q8_[e], q8_[e + 4]); q4_[e] = r_[0] + r_[1]; } \
        _Pragma("unroll") for (int e = 0; e < 2; ++e) { const float keep_ = b3 ? q4_[e + 2] : q4_[e], send_ = b3 ? q4_[e] : q4_[e + 2]; q2_[e] = keep_ + swz_xor8(send_); } \
        float lg_ = (b2 ? q2_[1] : q2_[0]) + swz_xor4(b2 ? q2_[0] : q2_[1]); lg_ += xor2(lg_); lg_ += xor1(lg_); \
        if ((lane & 3) == 0) lgs[(rowl) * 16 + (lane >> 2)] = lg_; } while (0)
    const bool b3 = (lane & 8) != 0, b2 = (lane & 4) != 0;
    for (int chunk = bx; chunk < 256; chunk += G) {
        const int m0 = chunk * RPC + wave * RPW;
        u32x2 nxA[4], nxB[4], fxA[4], fxB[4];
        E_LOADROW(nxA, m0); E_LOADROW(nxB, m0 + 1); E_LOADROW(fxA, m0 + 2); E_LOADROW(fxB, m0 + 3);
        for (int i = 0; i < RPW; i += 2) {
            f32x4 vA[4], vB[4];
            E_NORMROW(vA, nxA, m0 + i);
            E_NORMROW(vB, nxB, m0 + i + 1);
#pragma unroll
            for (int j = 0; j < 4; ++j) { nxA[j] = fxA[j]; nxB[j] = fxB[j]; }
            if (i + 4 < RPW) { E_LOADROW(fxA, m0 + i + 4); E_LOADROW(fxB, m0 + i + 5); }
            float peA[16], peB[16];
            f32x2 hv[4][4];
#pragma unroll
            for (int j = 0; j < 4; ++j)
#pragma unroll
                for (int c = 0; c < 4; ++c) hv[j][c] = (f32x2){vA[j][c], vB[j][c]};
            const LAS float* wl = wrT + 4 * lane; asm volatile("" : "+v"(wl));
#pragma unroll
            for (int e = 0; e < 16; ++e) { f32x2 a2 = {0.f, 0.f};
#pragma unroll
                for (int j = 0; j < 4; ++j) { const f32x4 w = *(const LAS f32x4*)(wl + e * DM + 256 * j);
#pragma unroll
                    for (int c = 0; c < 4; ++c) a2 = __builtin_elementwise_fma(hv[j][c], (f32x2){w[c], w[c]}, a2); }
                peA[e] = a2[0]; peB[e] = a2[1]; }
            E_REDUCE(peA, wave * RPW + i); E_REDUCE(peB, wave * RPW + i + 1);
        }
#undef E_LOADROW
#undef E_NORMROW
#undef E_REDUCE
        asm volatile("s_waitcnt lgkmcnt(0)" ::: "memory");
        const int mrow_ = chunk * RPC + wave * RPW + lane;
        if (lane < RPW && !(layer == DEPTH - 1 && (mrow_ % TPB) < CTX)) {
            const int rl = wave * RPW + lane; const float* br = C.b_router();
            float sg[16], bs[16];
#pragma unroll
            for (int e4 = 0; e4 < 4; ++e4) { const f32x4 l4 = *(const LAS f32x4*)(lgs + rl * 16 + 4 * e4);
#pragma unroll
                for (int k = 0; k < 4; ++k) { sg[4 * e4 + k] = 1.f / (1.f + expf(-l4[k])); bs[4 * e4 + k] = sg[4 * e4 + k] + br[4 * e4 + k]; } }
            int grp = 0; float best = -1e30f;
#pragma unroll
            for (int g = 0; g < 4; ++g) { const float a0 = bs[4 * g], a1 = bs[4 * g + 1], a2 = bs[4 * g + 2], a3 = bs[4 * g + 3];
                const float hi01 = fmaxf(a0, a1), lo01 = fminf(a0, a1), hi23 = fmaxf(a2, a3), lo23 = fminf(a2, a3);
                const float top = fmaxf(hi01, hi23), second = fmaxf(fminf(hi01, hi23), hi01 >= hi23 ? lo01 : lo23);
                const float sc = top + second; if (sc > best) { best = sc; grp = g; } }
            float c4[4], s4[4];
#pragma unroll
            for (int k = 0; k < 4; ++k) { c4[k] = grp == 0 ? bs[k] : grp == 1 ? bs[4 + k] : grp == 2 ? bs[8 + k] : bs[12 + k]; s4[k] = grp == 0 ? sg[k] : grp == 1 ? sg[4 + k] : grp == 2 ? sg[8 + k] : sg[12 + k]; }
            int l0 = 0; float mx0 = c4[0];
#pragma unroll
            for (int k = 1; k < 4; ++k) if (c4[k] > mx0) { mx0 = c4[k]; l0 = k; }
            int l1 = -1; float mx1 = -1e30f;
#pragma unroll
            for (int k = 0; k < 4; ++k) if (k != l0 && c4[k] > mx1) { mx1 = c4[k]; l1 = k; }
            const float w0 = l0 == 0 ? s4[0] : l0 == 1 ? s4[1] : l0 == 2 ? s4[2] : s4[3], w1 = l1 == 0 ? s4[0] : l1 == 1 ? s4[1] : l1 == 2 ? s4[2] : s4[3];
            const float wn = 1.f / (w0 + w1);
            const int e0 = grp * 4 + l0, e1 = grp * 4 + l1;
            const int p0 = __hip_atomic_fetch_add(lcnt + e0, 1, __ATOMIC_RELAXED, __HIP_MEMORY_SCOPE_WORKGROUP);
            const int p1 = __hip_atomic_fetch_add(lcnt + e1, 1, __ATOMIC_RELAXED, __HIP_MEMORY_SCOPE_WORKGROUP);
            rec_e[2 * rl] = e0 | (p0 << 8); rec_e[2 * rl + 1] = e1 | (p1 << 8); rec_w[2 * rl] = w0 * wn; rec_w[2 * rl + 1] = w1 * wn;
        } else if (lane < RPW) { const int rl = wave * RPW + lane; rec_e[2 * rl] = -1; rec_e[2 * rl + 1] = -1; }
        __syncthreads();
        if (tid < 16) lbase[tid] = (int)__hip_atomic_fetch_add(gcnt + tid, (unsigned)lcnt[tid], __ATOMIC_RELAXED, __HIP_MEMORY_SCOPE_AGENT);
        __syncthreads();
        for (int i = tid; i < 2 * RPC; i += 512) { const int re = rec_e[i]; if (re < 0) continue; const int e = re & 255, pp = re >> 8; const int id = (chunk * RPC + (i >> 1)) * 2 + (i & 1);
            list[e * MROWS + lbase[e] + pp] = id | ((int)(rec_w[i] * 16383.f + 0.5f) << 18); }
        __syncthreads();
        if (tid < 16) lcnt[tid] = 0;
        __syncthreads();
    }
}

template <bool GATHER_, int NT>
struct MoeOrder {
    static constexpr bool GATHER = GATHER_;
    const int* list; const LAS int* boff; const LAS int* cnt; int G, c;
    __device__ __forceinline__ bool next(int i, pg8::Unit& u) const {
        const int L = i * G + c; if (L >= boff[16] * NT) return false;
        const int blk = L / NT, pn = L - blk * NT; int e = 0;
#pragma unroll
        for (int k = 1; k < 16; ++k) e += (blk >= boff[k]) ? 1 : 0;
        u.pm = blk; u.pn = e * NT + pn; return true;
    }
    __device__ __forceinline__ unsigned arow(const pg8::Unit& u, int r) const {
        const int e = u.pn / NT, li = (u.pm - boff[e]) * 256 + r;
        const int id = li < cnt[e] ? (list[e * MROWS + li] & 0x3FFFF) : 0;
        return (unsigned)(id >> 1);
    }
    __device__ __forceinline__ const int* aptr(const pg8::Unit& u, int r) const { const int e = u.pn / NT, li = (u.pm - boff[e]) * 256 + r; return list + e * MROWS + (li < cnt[e] ? li : 0); }
    __device__ __forceinline__ unsigned tokrow(unsigned w) const { return (w & 0x3FFFFu) >> 1; }
};
struct EpiGateUp {
    static constexpr bool PERM = true, HAS_PRE = false;
    unsigned char* O;
    __device__ __forceinline__ void operator()(const f32x4 (&acc)[2][2][4][2], const pg8::Unit& u, int wr, int wc, int fr, int fq) const {
        const int row0 = u.pm * 256 + wr * 64 + fr, col0 = (u.pn & 7) * 128 + wc * 32 + 8 * fq;
#pragma unroll
        for (int ai = 0; ai < 2; ++ai)
#pragma unroll
            for (int m = 0; m < 4; ++m) { const f32x4 a0 = acc[ai][0][m][0] * W8_INV, a1 = acc[ai][0][m][1] * W8_INV, u0 = acc[ai][1][m][0] * W8_INV, u1 = acc[ai][1][m][1] * W8_INV;
                u32x2 w; w.x = pk4_fp8(silu_f(a0[0]) * u0[0], silu_f(a0[1]) * u0[1], silu_f(a0[2]) * u0[2], silu_f(a0[3]) * u0[3]);
                w.y = pk4_fp8(silu_f(a1[0]) * u1[0], silu_f(a1[1]) * u1[1], silu_f(a1[2]) * u1[2], silu_f(a1[3]) * u1[3]);
                *(u32x2*)(O + ((unsigned)(row0 + ai * 128 + m * 16) * (unsigned)FF + (unsigned)col0)) = w; }
    }
};
struct EpiDown {
    static constexpr bool PERM = true, HAS_PRE = true;
    unsigned char* YP; const int* list; const LAS int* boff; const LAS int* cnt;
    int ent[2][4];
    __device__ __forceinline__ void pre(const pg8::Unit& u, int wr, int fr) {
        const int e = u.pn >> 2, lb = (u.pm - boff[e]) * 256, n = cnt[e];
#pragma unroll
        for (int ai = 0; ai < 2; ++ai)
#pragma unroll
            for (int m = 0; m < 4; ++m) { const int li = lb + ai * 128 + wr * 64 + m * 16 + fr; const bool ok = li < n; const int w = list[e * MROWS + (ok ? li : 0)]; ent[ai][m] = ok ? w : -1; }
    }
    __device__ __forceinline__ void operator()(const f32x4 (&acc)[2][2][4][2], const pg8::Unit& u, int wr, int wc, int fr, int fq) const {
        const int col0 = (u.pn & 3) * 256 + wc * 32 + 8 * fq;
#pragma unroll
        for (int ai = 0; ai < 2; ++ai)
#pragma unroll
            for (int m = 0; m < 4; ++m) { const int w = ent[ai][m];
                if (w != -1) { const unsigned id = (unsigned)w & 0x3FFFFu; const float g = (float)((unsigned)w >> 18) * ((1.f / 16383.f) * W8_INV * YP_SCALE); const unsigned off = id * (unsigned)DM + (unsigned)col0;
#pragma unroll
                    for (int bj = 0; bj < 2; ++bj) { const f32x4 v0 = acc[ai][bj][m][0] * g, v1 = acc[ai][bj][m][1] * g;
                        u32x2 ww; ww.x = pk4_fp8(v0[0], v0[1], v0[2], v0[3]); ww.y = pk4_fp8(v1[0], v1[1], v1[2], v1[3]); *(u32x2*)(YP + off + bj * 128) = ww; } } }
    }
};
__device__ __forceinline__ void moe_offsets(const Ctx& C, int layer, LAS int* boff, LAS int* cnt, int tid) {
    if (tid == 0) { const unsigned* gcnt = (const unsigned*)(C.ws + WS_CTL) + CW_CNT + 64 * layer; int acc = 0;
        for (int e = 0; e < 16; ++e) { const int n = (int)__hip_atomic_load(gcnt + e, __ATOMIC_RELAXED, __HIP_MEMORY_SCOPE_AGENT); cnt[e] = n; boff[e] = acc; acc += (n + 255) >> 8; }
        boff[16] = acc; }
    __syncthreads();
}

__device__ __forceinline__ void phase_final(const Ctx& C, int gw, int NGW, int lane) {
    const float* mod = (const float*)(C.ws + WS_MOD) + (size_t)(DEPTH - 1) * 17 * 6144;
    const bf16_t* XR = (const bf16_t*)(C.ws + WS_X32); const unsigned char* YP = (const unsigned char*)(C.ws + WS_YP);
    for (int r = gw; r < NB * SEQ; r += NGW) {
        const int b = r / SEQ, t = r - b * SEQ; const size_t m = (size_t)b * TPB + CTX + t;
        const u32x2* xr = (const u32x2*)(XR + m * DM) + lane; const unsigned* y0 = (const unsigned*)(YP + m * 2 * DM) + lane; const unsigned* y1 = y0 + DM / 4;
        const f32x4* g2 = (const f32x4*)(mod + (size_t)b * 6144 + 5 * DM) + lane; f32x4* o = (f32x4*)(C.out + (size_t)r * DM) + lane;
        unsigned a[4], bb[4]; u32x2 x[4];
#pragma unroll
        for (int j = 0; j < 4; ++j) { x[j] = xr[64 * j]; a[j] = y0[64 * j]; bb[j] = y1[64 * j]; }
#pragma unroll
        for (int j = 0; j < 4; ++j) o[64 * j] = bf4(x[j]) + (g2[64 * j] * YP_INV) * (fp8x4_f32(a[j]) + fp8x4_f32(bb[j]));
    }
}

#ifndef R3OFF
#define R3OFF 0
#endif
#ifndef WINOFF
#define WINOFF 0
#endif
#ifndef PHMASK
#define PHMASK 0xFFFF
#endif
#ifndef MK_ONE_LAUNCH
#define MK_ONE_LAUNCH 1
#endif
constexpr int PH_PER_LAYER = 9, PH_LAYER0 = 2, PH_FINAL = PH_LAYER0 + DEPTH * PH_PER_LAYER, PH_COUNT = PH_FINAL + 1;
struct Args { const float* in[18]; float* out; unsigned char* ws; int ph_lo, ph_hi, flags, pad; };
__global__ void __launch_bounds__(512, 2) mega_fwd(Args args) {
    extern __shared__ __attribute__((aligned(16))) unsigned char lds_raw[];
    LAS unsigned char* lds = (LAS unsigned char*)lds_raw;
    Ctx C; C.out = args.out; C.ws = args.ws;
    const int tid = threadIdx.x, lane = tid & 63, wave = __builtin_amdgcn_readfirstlane(tid >> 6);
    const int G = gridDim.x; const int bx = blockIdx.x; const int vcu = (G % 8 == 0) ? (bx % 8) * (G / 8) + bx / 8 : bx;
    const int gw = vcu * 8 + wave, NGW = G * 8;
    volatile LAS unsigned* MISC = (volatile LAS unsigned*)(lds + LDSCTL_OFF);
    for (int u = tid; u < (LDS_BYTES - LDSCTL_OFF) / 4; u += 512) ((LAS unsigned*)(lds + LDSCTL_OFF))[u] = 0u;
    __syncthreads();
    const int lo = args.ph_lo, hi = args.ph_hi;
    XcdBarrier bar; bar.bar = (unsigned*)(C.ws + WS_CTL) + CW_BAR; bar.x = 0; bar.st = nullptr;
    if (hi - lo > 1) bar = xcd_barrier_post((unsigned*)(C.ws + WS_CTL) + CW_BAR, MISC);
#define IN(k) (lo <= (k) && (k) < hi)
#define PHASE_IDS() int bx_ = bx, wave_ = wave; LAS unsigned char* lds_ = lds; asm volatile("" : "+s"(bx_), "+s"(wave_), "+s"(lds_)); int lane_; asm volatile("v_mbcnt_lo_u32_b32 %0, -1, 0\n\tv_mbcnt_hi_u32_b32 %0, -1, %0" : "=v"(lane_)); const int tid_ = wave_ * 64 + lane_; \
    const int vcu_ = (G % 8 == 0) ? (bx_ % 8) * (G / 8) + bx_ / 8 : bx_; const int gw_ = vcu_ * 8 + wave_; (void)lane_; (void)gw_; (void)vcu_
#define SEAM(k) do { if (IN(k) && IN((k) + 1)) xcd_barrier(bar); } while (0)

    if (IN(0) && (PHMASK & 1)) { PHASE_IDS(); phase_prologue(C, lds_, G, vcu_, bx_, tid_); } SEAM(0);
    if (IN(1) && (PHMASK & 2)) { PHASE_IDS(); phase_modsum(C, G, bx_, tid_); } SEAM(1);
#ifdef EXTRA_BARS
    if (hi - lo > 1) for (int eb = 0; eb < EXTRA_BARS; ++eb) xcd_barrier(bar);
#endif

#ifdef LAYER_UNROLL
#pragma unroll
#else
#pragma nounroll
#endif
    for (int layer = 0; layer < DEPTH; ++layer) {
        const int p0 = PH_LAYER0 + layer * PH_PER_LAYER;
        if (IN(p0 + 0) && (PHMASK & 4)) { PHASE_IDS();
            if (layer > 0 && !(args.flags & 16)) {
                const unsigned* gc = (const unsigned*)(C.ws + WS_CTL) + CW_CNT + 64 * (layer - 1); int nblk = 0;
                for (int e = 0; e < 16; ++e) nblk += ((int)__hip_atomic_load(gc + e, __ATOMIC_RELAXED, __HIP_MEMORY_SCOPE_AGENT) + 255) >> 8;
                convert_rest(C, layer, G, vcu_, lds_, wave_, lane_, nblk * 8, nblk * 4); }
            phase_norm1(C, layer, gw_, NGW, lane_, (args.flags & 16) ? (bf16_t*)(C.ws + WS_Y) : (bf16_t*)(C.ws + WS_X32)); } SEAM(p0 + 0);
        if (IN(p0 + 1) && (PHMASK & 8)) {
            pg8::Gemm g{(const bf16_t*)(C.ws + WS_H), (const bf16_t*)(C.ws + WS_WIN) + (size_t)layer * DIN * DM, MROWS, DIN, DM};
            PHASE_IDS(); pg8::StaticOrder S; S.init(MROWS, DIN, G, bx_);
            pg8::EpiBf16 E{(bf16_t*)(C.ws + WS_P), DIN};
            pg8::gemm_phase<pg8::EpiBf16, pg8::StaticOrder, true>(lds_, g, S, E, tid_);
            if (layer + 1 < DEPTH && !args.flags) convert_tail(C, layer + 1, 0, (MROWS / 256) * (DIN / 256), G, bx_, lds_, wave_, lane_);
        } SEAM(p0 + 1);
        if (IN(p0 + 2) && (PHMASK & 16)) {
            PHASE_IDS(); if (!(args.flags & 1)) phase_qkprep(C, layer, gw_, NGW, lane_, (args.flags & 8) ? (bf16_t*)(C.ws + WS_Y) : (bf16_t*)(C.ws + WS_P));
            if (!(args.flags & 8)) for (int u = bx_; u < NB * 4 * NCH; u += G) { const int c = u % NCH, bh = u / NCH; ret_r1_unit(C, layer, bh >> 2, bh & 3, c, lds_, tid_); }
        } SEAM(p0 + 2);
        if (IN(p0 + 3) && (PHMASK & 32)) {
            PHASE_IDS(); for (int u = bx_; u < 512; u += G) ret_r2_unit(C, layer, u, tid_);
            attn_units<false>(C, layer, G, vcu_, bx_, tid_, (char*)lds_);
        } SEAM(p0 + 3);
        if (IN(p0 + 4) && (PHMASK & 64)) {
            PHASE_IDS();
            if (!WINOFF && !(args.flags & 32)) attn_units<true>(C, layer, G, vcu_, bx_, tid_, (char*)lds_);
            if (!R3OFF && !(args.flags & 64))
            ret_r3_all(C, layer, bx_, G, lds_, tid_);
        } SEAM(p0 + 4);
        if (IN(p0 + 5) && (PHMASK & 128)) {
            pg8::Gemm g{(const bf16_t*)(C.ws + WS_Y), (const bf16_t*)(C.ws + WS_WOUT) + (size_t)layer * DM * DM, MROWS, DM, DM};
            PHASE_IDS(); pg8::StaticOrder S; S.init(MROWS, DM, G, bx_, layer == DEPTH - 1);
            pg8::EpiResid E{(bf16_t*)(C.ws + ((args.flags & 4) ? WS_P : WS_X32)), (const float*)(C.ws + WS_MOD) + (size_t)layer * 17 * 6144 + 2 * DM};
            pg8::gemm_phase<pg8::EpiResid, pg8::StaticOrder, true>(lds_, g, S, E, tid_);
            if (layer + 1 < DEPTH && !args.flags) convert_tail(C, layer + 1, 1, (MROWS / 256) * (DM / 256), G, bx_, lds_, wave_, lane_);
        } SEAM(p0 + 5);
        if (IN(p0 + 6) && (PHMASK & 256)) { PHASE_IDS(); phase_norm2_route(C, layer + ((args.flags & 2) ? 4 : 0), lds_, G, bx_, tid_); } SEAM(p0 + 6);
        if (IN(p0 + 7) && (PHMASK & 512)) {
            PHASE_IDS(); LAS int* boff = (LAS int*)(lds_ + LDSCTL_OFF + 64); LAS int* mcnt = (LAS int*)(lds_ + LDSCTL_OFF + 192); moe_offsets(C, layer, boff, mcnt, tid_);
            pg8::Gemm g{(const bf16_t*)(C.ws + WS_H), (const bf16_t*)(C.ws + WS_WGU + (size_t)layer * NE * 2 * FF * DM), 0, 2 * FF, DM};
            MoeOrder<true, 8> S{(const int*)(C.ws + WS_LIST), boff, mcnt, G, bx_};
            EpiGateUp E{(unsigned char*)(C.ws + WS_P)};
            pg8::gemm_phase<EpiGateUp, MoeOrder<true, 8>, true, true>(lds_, g, S, E, tid_);
            if (layer + 1 < DEPTH && !args.flags) convert_tail(C, layer + 1, 2, boff[16] * 8, G, bx_, lds_, wave_, lane_);
        } SEAM(p0 + 7);
        if (IN(p0 + 8) && (PHMASK & 1024)) {
            PHASE_IDS(); LAS int* boff = (LAS int*)(lds_ + LDSCTL_OFF + 64); LAS int* mcnt = (LAS int*)(lds_ + LDSCTL_OFF + 192); moe_offsets(C, layer, boff, mcnt, tid_);
            pg8::Gemm g{(const bf16_t*)(C.ws + WS_P), (const bf16_t*)(C.ws + WS_WDN + (size_t)layer * NE * DM * FF), 0, DM, FF};
            MoeOrder<false, 4> S{(const int*)(C.ws + WS_LIST), boff, mcnt, G, bx_};
            EpiDown E{(unsigned char*)(C.ws + WS_YP), (const int*)(C.ws + WS_LIST), boff, mcnt, {}};
            pg8::gemm_phase<EpiDown, MoeOrder<false, 4>, true, true>(lds_, g, S, E, tid_);
            if (layer + 1 < DEPTH && !args.flags) convert_tail(C, layer + 1, 3, boff[16] * 4, G, bx_, lds_, wave_, lane_);
        } SEAM(p0 + 8);
    }
    if (IN(PH_FINAL) && (PHMASK & 2048)) { PHASE_IDS(); phase_final(C, gw_, NGW, lane_); }
#undef IN
#undef SEAM
}

extern "C" void kernel_launch(void* const* d_in, const int* in_sizes, int n_in, void* d_out, int out_size, void* d_ws, size_t ws_size, hipStream_t stream) {
    static int grid = 0;
    if (grid == 0) {
        if (n_in != 18 || in_sizes[0] != NB * SEQ * DM || out_size != NB * SEQ * DM || ws_size < WS_END) {
            fprintf(stderr, "kernel_launch: unexpected shapes (n_in %d, in0 %d, out %d, ws %zu, need %zu); nothing launched\n", n_in, n_in > 0 ? in_sizes[0] : -1, out_size, ws_size, (size_t)WS_END); grid = -1; return; }
        int dev = 0, cus = 0, per_cu = 0;
        if (hipGetDevice(&dev) != hipSuccess || hipDeviceGetAttribute(&cus, hipDeviceAttributeMultiprocessorCount, dev) != hipSuccess) { grid = -1; return; }
        if (hipFuncSetAttribute((const void*)mega_fwd, hipFuncAttributeMaxDynamicSharedMemorySize, LDS_BYTES) != hipSuccess) { fprintf(stderr, "kernel_launch: hipFuncSetAttribute failed\n"); grid = -1; return; }
        if (hipOccupancyMaxActiveBlocksPerMultiprocessor(&per_cu, (const void*)mega_fwd, 512, LDS_BYTES) != hipSuccess || per_cu < 1) fprintf(stderr, "kernel_launch: occupancy query says %d\n", per_cu);
        (void)hipGetLastError();
        grid = cus;
    }
    if (grid < 0) return;
    if (hipMemsetAsync((char*)d_ws + WS_CTL, 0, CTL_BYTES, stream) != hipSuccess) return;
    Args a{};
    for (int i = 0; i < 18; ++i) a.in[i] = (const float*)d_in[i];
    a.out = (float*)d_out; a.ws = (unsigned char*)d_ws;
#if MK_ONE_LAUNCH
    a.ph_lo = 0; a.ph_hi = PH_COUNT;
    hipLaunchKernelGGL(mega_fwd, dim3(grid), dim3(512), LDS_BYTES, stream, a);
#else
    for (int p = 0; p < PH_COUNT; ++p) { a.ph_lo = p; a.ph_hi = p + 1;
#if !defined(PROBE_P) || !PROBE_BEFORE
        hipLaunchKernelGGL(mega_fwd, dim3(grid), dim3(512), LDS_BYTES, stream, a);
#endif
#ifdef PROBE_P
        const bool hit = (PROBE_P < 2) ? (p == PROBE_P) : (p >= PH_LAYER0 && p < PH_FINAL && (p - PH_LAYER0) % PH_PER_LAYER == PROBE_P - 2 && (!PROBE_L0 || p < PH_LAYER0 + PH_PER_LAYER));
        if (hit) { a.flags = PROBE_FLAGS; for (int r = 0; r < PROBE_REP; ++r) hipLaunchKernelGGL(mega_fwd, dim3(grid), dim3(512), LDS_BYTES, stream, a); a.flags = 0; }
#if PROBE_BEFORE
        hipLaunchKernelGGL(mega_fwd, dim3(grid), dim3(512), LDS_BYTES, stream, a);
#endif
#endif
    }
#endif
}
```

```cpp
#define MK_ONE_LAUNCH 1
#include <hip/hip_runtime.h>
#include <cstdio>
#include <cstdint>

#define GAS __attribute__((address_space(1)))
#define LAS __attribute__((address_space(3)))
typedef unsigned short bf16_t;
typedef short bf16x8 __attribute__((ext_vector_type(8)));
typedef float f32x4 __attribute__((ext_vector_type(4)));
typedef float f32x2 __attribute__((ext_vector_type(2)));
typedef float f32x16 __attribute__((ext_vector_type(16)));
typedef unsigned u32x4 __attribute__((ext_vector_type(4)));
typedef unsigned u32x2 __attribute__((ext_vector_type(2)));

constexpr int DM = 1024, NB = 16, SEQ = 4096, CTX = 256, TPB = SEQ + CTX, MROWS = NB * TPB, DEPTH = 4;
constexpr int DIN = 2560;
constexpr int C_RQ = 0, C_RK = 256, C_RV = 512, C_RG = 1024, C_WQ = 1536, C_WK = 1792, C_WV = 1920, C_GQ = 2048, C_GK = 2304, C_GV = 2432;
constexpr int NE = 16, FF = 1024, NCH = TPB / 128;
constexpr float EPS = 1e-6f;
constexpr float LOG2E = 1.4426950408889634f;
constexpr float QSCALE = 0.125f * LOG2E;

__device__ __forceinline__ unsigned f2bf(float f) { unsigned u = __builtin_bit_cast(unsigned, f); return (u + 0x7fffu + ((u >> 16) & 1u)) >> 16; }
__device__ __forceinline__ unsigned pk2(float lo, float hi) { return f2bf(lo) | (f2bf(hi) << 16); }
__device__ __forceinline__ float bf2f(unsigned short h) { return __builtin_bit_cast(float, (unsigned)h << 16); }
__device__ __forceinline__ float bflo(unsigned w) { return __builtin_bit_cast(float, w << 16); }
__device__ __forceinline__ float bfhi(unsigned w) { return __builtin_bit_cast(float, w & 0xffff0000u); }

namespace pg8 {
constexpr int BM = 256, BK = 64, HALF = 128, HTB = HALF * BK * 2, STAGE_BYTES = 8 * HTB, NXCD = 8, WGM = 8;
__host__ __device__ __forceinline__ int lds_byte(int r, int c) { const int st = (r >> 4) * 2 + (c >> 5), rr = r & 15, cc = c & 31, ob = rr * 64 + cc * 2; return st * 1024 + (ob ^ (((ob >> 9) & 1) << 5)); }
__host__ __device__ __forceinline__ void stage_rc(int b, int& R, int& C) { const int st = b / 1024, sb = b % 1024, swz = sb ^ (((sb >> 9) & 1) << 5); R = (st >> 1) * 16 + swz / 64; C = (st & 1) * 32 + (swz % 64) / 2; }
__host__ __device__ __forceinline__ int perm32(int rho) { const int n = rho >> 4, i = rho & 15; return 8 * (i >> 2) + 4 * n + (i & 3); }

struct Unit { int pm, pn; };
struct Gemm { const bf16_t* A; const bf16_t* Bt; int M, N, K; };

struct StaticOrder {
    static constexpr bool GATHER = false;
    int nM, nN, nwg, G, c; bool skipctx;
    __device__ void init(int M, int N, int G_, int c_, bool skipctx_ = false) { skipctx = skipctx_; nM = skipctx_ ? (M / BM) / 17 * 16 : M / BM; nN = N / BM; nwg = nM * nN; G = G_; c = c_; }
    __device__ bool next(int i, Unit& u) const {
        const long L = (long)i * G + c; if (L >= nwg) return false;
        int wgid = (int)L; { const int q = nwg / NXCD, r = nwg % NXCD, xcd = wgid % NXCD, off = wgid / NXCD; wgid = (xcd < r ? xcd * (q + 1) : r * (q + 1) + (xcd - r) * q) + off; }
        const int nig = WGM * nN, gid = wgid / nig, fm = gid * WGM, gsz = (nM - fm) < WGM ? (nM - fm) : WGM;
        u.pm = fm + ((wgid % nig) % gsz); u.pn = (wgid % nig) / gsz; if (skipctx) u.pm += (u.pm >> 4) + 1; return true;
    }
    __device__ __forceinline__ unsigned arow(const Unit&, int) const { return 0u; }
    __device__ __forceinline__ const int* aptr(const Unit&, int) const { return nullptr; }
    __device__ __forceinline__ unsigned tokrow(unsigned) const { return 0u; }
};

__device__ __forceinline__ unsigned cvt_pk_bf16(float lo, float hi) { unsigned r; asm volatile("v_cvt_pk_bf16_f32 %0, %1, %2" : "=v"(r) : "v"(lo), "v"(hi)); return r; }

struct EpiBf16 {
    static constexpr bool PERM = true, HAS_PRE = false;
    bf16_t* O; int ldc;
    __device__ __forceinline__ void operator()(const f32x4 (&acc)[2][2][4][2], const Unit& u, int wr, int wc, int fr, int fq) const {
        const int row0 = u.pm * BM + wr * 64 + fr; const int col0 = u.pn * BM + wc * 32 + 8 * fq;
#pragma unroll
        for (int ai = 0; ai < 2; ++ai)
#pragma unroll
            for (int m = 0; m < 4; ++m) { const unsigned off = ((unsigned)(row0 + ai * HALF + m * 16) * (unsigned)ldc + (unsigned)col0) * 2u;
#pragma unroll
                for (int bj = 0; bj < 2; ++bj) { const f32x4 v0 = acc[ai][bj][m][0], v1 = acc[ai][bj][m][1];
                    u32x4 w; w.x = cvt_pk_bf16(v0[0], v0[1]); w.y = cvt_pk_bf16(v0[2], v0[3]); w.z = cvt_pk_bf16(v1[0], v1[1]); w.w = cvt_pk_bf16(v1[2], v1[3]);
                    *(u32x4*)((char*)O + off + bj * HALF * 2) = w; } }
    }
};

struct EpiResid {
    static constexpr bool PERM = true, HAS_PRE = false;
    bf16_t* X; const float* gate;
    __device__ __forceinline__ void operator()(const f32x4 (&acc)[2][2][4][2], const Unit& u, int wr, int wc, int fr, int fq) const {
        const int set = (u.pm % 17 == 0) ? 16 : (u.pm / 17);
        const float* gp = gate + (size_t)set * 6 * DM;
        const int col0 = u.pn * BM + wc * 32 + 8 * fq;
        f32x4 gv[2][2];
#pragma unroll
        for (int bj = 0; bj < 2; ++bj)
#pragma unroll
            for (int n = 0; n < 2; ++n) gv[bj][n] = *(const f32x4*)(gp + col0 + bj * HALF + n * 4);
#pragma unroll
        for (int ai = 0; ai < 2; ++ai) {
            u32x4 xin[4][2];
#pragma unroll
            for (int m = 0; m < 4; ++m) { const unsigned off = ((unsigned)(u.pm * BM + ai * HALF + wr * 64 + m * 16 + fr) * (unsigned)DM + (unsigned)col0) * 2u;
#pragma unroll
                for (int bj = 0; bj < 2; ++bj) xin[m][bj] = *(const u32x4*)((const char*)X + off + bj * HALF * 2); }
            asm volatile("" ::: "memory");
#pragma unroll
            for (int m = 0; m < 4; ++m) { const unsigned off = ((unsigned)(u.pm * BM + ai * HALF + wr * 64 + m * 16 + fr) * (unsigned)DM + (unsigned)col0) * 2u;
#pragma unroll
                for (int bj = 0; bj < 2; ++bj) { const u32x4 x = xin[m][bj]; const f32x4 a0 = acc[ai][bj][m][0] * gv[bj][0], a1 = acc[ai][bj][m][1] * gv[bj][1];
                    u32x4 w; w.x = cvt_pk_bf16(bflo(x.x) + a0[0], bfhi(x.x) + a0[1]); w.y = cvt_pk_bf16(bflo(x.y) + a0[2], bfhi(x.y) + a0[3]);
                    w.z = cvt_pk_bf16(bflo(x.z) + a1[0], bfhi(x.z) + a1[1]); w.w = cvt_pk_bf16(bflo(x.w) + a1[2], bfhi(x.w) + a1[3]);
                    *(u32x4*)((char*)X + off + bj * HALF * 2) = w; } }
            asm volatile("" ::: "memory");
        }
    }
};

template <class Epi, class Sched, bool ALIGN_EPI, bool FP8 = false>
__device__ __forceinline__ void gemm_phase(LAS unsigned char* lds, const Gemm g, const Sched& S, Epi& E, const int tid) {
    const int wid = __builtin_amdgcn_readfirstlane(tid >> 6), lane = tid & 63, wr = wid >> 2, wc = wid & 3, fr = lane & 15, fq = lane >> 4;
    const int K = g.K, KB = FP8 ? K : 2 * K  , nt = KB / (BK * 2);
    unsigned voffB[2], vA[2][2], vAn[2][2]; int sR[2], sC[2];
#pragma unroll
    for (int i = 0; i < 2; ++i) { int R, C; stage_rc(tid * 16 + i * 8192, R, C); sR[i] = R; sC[i] = C; const int Rb = Epi::PERM ? ((R & ~31) + perm32(R & 31)) : R;
        voffB[i] = (unsigned)(Rb * KB + C * 2); }
#define PG8_SETV(v, u) do { _Pragma("unroll") for (int h_ = 0; h_ < 2; ++h_) _Pragma("unroll") for (int i_ = 0; i_ < 2; ++i_) { \
        if constexpr (Sched::GATHER) v[h_][i_] = S.arow(u, h_ * HALF + sR[i_]) * (unsigned)KB + (unsigned)(sC[i_] * 2); \
        else v[h_][i_] = (unsigned)((h_ * HALF + sR[i_]) * KB + sC[i_] * 2); } } while (0)
    const size_t kstep = (size_t)(BK * 2);
    const size_t hstep = (size_t)HALF * KB;
    const size_t tstep = 2 * hstep;
    const size_t atstep = Sched::GATHER ? (size_t)0 : tstep;
    const unsigned ldsw = (unsigned)wid * 1024u;
    const int aoff = lds_byte(wr * 64 + fr, fq * 8), boff = lds_byte(wc * 32 + fr, fq * 8);
#define PG8_SA(b, h) (((b) * 2 + (h)) * HTB)
#define PG8_SB(b, h) ((4 + (b) * 2 + (h)) * HTB)
#define PG8_STAGE(bufoff, gbase, voff) do { _Pragma("unroll") for (int _i = 0; _i < 2; ++_i) \
        __builtin_amdgcn_global_load_lds((const unsigned*)((const char*)(gbase) + (voff)[_i]), (LAS unsigned*)(lds + (bufoff) + ldsw + _i * 8192), 16, 0, 0); } while (0)
#define PG8_LDA(dst, b, h) do { _Pragma("unroll") for (int m = 0; m < 4; ++m) _Pragma("unroll") for (int k = 0; k < 2; ++k) dst[m][k] = *(const LAS bf16x8*)(lds + PG8_SA(b, h) + aoff + m * 2048 + k * 1024); } while (0)
#define PG8_LDB(dst, b, h) do { _Pragma("unroll") for (int n = 0; n < 2; ++n) _Pragma("unroll") for (int k = 0; k < 2; ++k) dst[n][k] = *(const LAS bf16x8*)(lds + PG8_SB(b, h) + boff + n * 2048 + k * 1024); } while (0)
    typedef long i64x2_ __attribute__((ext_vector_type(2)));
#define PG8_MMA(ai, bj, At, Bt) do { __builtin_amdgcn_s_setprio(1); _Pragma("unroll") for (int m = 0; m < 4; ++m) _Pragma("unroll") for (int n = 0; n < 2; ++n) _Pragma("unroll") for (int k = 0; k < 2; ++k) { \
        if constexpr (FP8) { const i64x2_ b2_ = __builtin_bit_cast(i64x2_, Bt[n][k]), a2_ = __builtin_bit_cast(i64x2_, At[m][k]); \
            acc[ai][bj][m][n] = __builtin_amdgcn_mfma_f32_16x16x32_fp8_fp8(b2_[0], a2_[0], acc[ai][bj][m][n], 0, 0, 0); \
            acc[ai][bj][m][n] = __builtin_amdgcn_mfma_f32_16x16x32_fp8_fp8(b2_[1], a2_[1], acc[ai][bj][m][n], 0, 0, 0); } \
        else acc[ai][bj][m][n] = __builtin_amdgcn_mfma_f32_16x16x32_bf16(Bt[n][k], At[m][k], acc[ai][bj][m][n], 0, 0, 0); } \
        __builtin_amdgcn_s_setprio(0); } while (0)
#define PG8_WAIT_V(n) asm volatile("s_waitcnt vmcnt(" #n ")" ::: "memory")
#define PG8_WAIT_L(n) asm volatile("s_waitcnt lgkmcnt(" #n ")" ::: "memory")
#define PG8_BAR __builtin_amdgcn_s_barrier()
#define PG8_SCHED __builtin_amdgcn_sched_barrier(0)
    Unit cur, nxt; int ui = 0;
    if (!S.next(0, cur)) return;
    float z0 = 0.f; asm volatile("" : "+v"(z0));
    f32x4 acc[2][2][4][2];
#pragma unroll
    for (int a = 0; a < 2; ++a)
#pragma unroll
        for (int b = 0; b < 2; ++b)
#pragma unroll
            for (int m = 0; m < 4; ++m)
#pragma unroll
                for (int n = 0; n < 2; ++n) acc[a][b][m][n] = (f32x4){z0, z0, z0, z0};
    bf16x8 At[4][2], B0[2][2], B1[2][2];
    const char* cA = (const char*)g.A + (size_t)cur.pm * atstep; const char* cB = (const char*)g.Bt + (size_t)cur.pn * tstep;
    PG8_SETV(vA, cur);
    PG8_STAGE(PG8_SB(0, 0), cB, voffB); PG8_STAGE(PG8_SB(0, 1), cB + hstep, voffB); PG8_STAGE(PG8_SA(0, 0), cA, vA[0]); PG8_STAGE(PG8_SA(0, 1), cA, vA[1]);
    if (wr == 1) PG8_BAR;
    PG8_WAIT_V(2); PG8_BAR;
    PG8_STAGE(PG8_SB(1, 0), cB + kstep, voffB); PG8_STAGE(PG8_SA(1, 0), cA + kstep, vA[0]); PG8_STAGE(PG8_SB(1, 1), cB + hstep + kstep, voffB);
    PG8_WAIT_V(6); PG8_BAR;
    for (;;) {
        if constexpr (Epi::HAS_PRE) E.pre(cur, wr, fr);
        const bool has_next = S.next(ui + 1, nxt);
        const char* nA = has_next ? (const char*)g.A + (size_t)nxt.pm * atstep : cA; const char* nB = has_next ? (const char*)g.Bt + (size_t)nxt.pn * tstep : cB;
        if constexpr (Sched::GATHER) { if (has_next) {
#pragma unroll
            for (int h_ = 0; h_ < 2; ++h_)
#pragma unroll
                for (int i_ = 0; i_ < 2; ++i_) { const int* ap_ = S.aptr(nxt, h_ * HALF + sR[i_]); asm volatile("global_load_dword %0, %1, off" : "=v"(vAn[h_][i_]) : "v"(ap_) : "memory"); } } }
        if (has_next) { if constexpr (!Sched::GATHER) { PG8_SETV(vAn, nxt); } } else {
#pragma unroll
            for (int h_ = 0; h_ < 2; ++h_)
#pragma unroll
                for (int i_ = 0; i_ < 2; ++i_) vAn[h_][i_] = vA[h_][i_]; }
        for (int t = 0; t < nt; t += 2) {
            const bool last = (t == nt - 2);
            const char* a1 = cA + (size_t)(t + 1) * kstep;
            const char* a2 = last ? nA : cA + (size_t)(t + 2) * kstep; const char* b2 = last ? nB : cB + (size_t)(t + 2) * kstep;
            const char* a3 = a2 + kstep; const char* b3 = b2 + kstep;
            if constexpr (Sched::GATHER) { if (t == 2 && has_next) {
#pragma unroll
                for (int h_ = 0; h_ < 2; ++h_)
#pragma unroll
                    for (int i_ = 0; i_ < 2; ++i_) { asm volatile("" : "+v"(vAn[h_][i_])); vAn[h_][i_] = S.tokrow(vAn[h_][i_]) * (unsigned)KB + (unsigned)(sC[i_] * 2); } } }
            unsigned o2[2][2];
#pragma unroll
            for (int h_ = 0; h_ < 2; ++h_)
#pragma unroll
                for (int i_ = 0; i_ < 2; ++i_) o2[h_][i_] = last ? vAn[h_][i_] : vA[h_][i_];
            PG8_LDB(B0, 0, 0); PG8_LDB(B1, 0, 1); PG8_SCHED; PG8_LDA(At, 0, 0); PG8_STAGE(PG8_SA(1, 1), a1, vA[1]);
            PG8_WAIT_V(8); PG8_WAIT_L(0); PG8_BAR; PG8_MMA(0, 0, At, B0); PG8_MMA(0, 1, At, B1); PG8_BAR; PG8_SCHED;
            PG8_LDA(At, 0, 1); PG8_STAGE(PG8_SB(0, 0), b2, voffB); PG8_STAGE(PG8_SB(0, 1), b2 + hstep, voffB); PG8_STAGE(PG8_SA(0, 0), a2, o2[0]);
            PG8_WAIT_V(8); PG8_WAIT_L(0); PG8_BAR; PG8_MMA(1, 0, At, B0); PG8_MMA(1, 1, At, B1); PG8_BAR; PG8_SCHED;
            PG8_LDB(B0, 1, 0); PG8_LDB(B1, 1, 1); PG8_SCHED; PG8_LDA(At, 1, 0); PG8_STAGE(PG8_SA(0, 1), a2, o2[1]);
            PG8_WAIT_V(8); PG8_WAIT_L(0); PG8_BAR; PG8_MMA(0, 0, At, B0); PG8_MMA(0, 1, At, B1); PG8_BAR; PG8_SCHED;
            PG8_LDA(At, 1, 1); PG8_STAGE(PG8_SB(1, 0), b3, voffB); PG8_STAGE(PG8_SB(1, 1), b3 + hstep, voffB); PG8_STAGE(PG8_SA(1, 0), a3, o2[0]);
            PG8_WAIT_V(8); PG8_WAIT_L(0); PG8_BAR; PG8_MMA(1, 0, At, B0); PG8_MMA(1, 1, At, B1); PG8_BAR; PG8_SCHED;
        }
        if constexpr (ALIGN_EPI) { if (wr == 0) PG8_BAR; }
        E(acc, cur, wr, wc, fr, fq);
        if (!has_next) break;
#pragma unroll
        for (int a = 0; a < 2; ++a)
#pragma unroll
            for (int b = 0; b < 2; ++b)
#pragma unroll
                for (int m = 0; m < 4; ++m)
#pragma unroll
                    for (int n = 0; n < 2; ++n) acc[a][b][m][n] = (f32x4){z0, z0, z0, z0};
        cur = nxt; cA = nA; cB = nB; ++ui;
#pragma unroll
        for (int h_ = 0; h_ < 2; ++h_)
#pragma unroll
            for (int i_ = 0; i_ < 2; ++i_) vA[h_][i_] = vAn[h_][i_];
        if constexpr (ALIGN_EPI) { if (wr == 1) PG8_BAR; }
    }
    PG8_WAIT_V(0);
    if constexpr (!ALIGN_EPI) { if (wr == 0) PG8_BAR; }
    PG8_BAR;
#undef PG8_SETV
#undef PG8_SA
#undef PG8_SB
#undef PG8_STAGE
#undef PG8_LDA
#undef PG8_LDB
#undef PG8_MMA
#undef PG8_WAIT_V
#undef PG8_WAIT_L
#undef PG8_BAR
#undef PG8_SCHED
}
}
#include <hip/hip_bf16.h>
#include <cmath>
namespace attn_body {
using bf16=__hip_bfloat16;
using s16x4=__attribute__((ext_vector_type(4)))short;
constexpr int D=64,QP=DIN,OP=1024;
constexpr int NW=8,QBLK=32,QB=QBLK*NW,KVBLK=64;
__device__ __forceinline__ int crow(int r,int hi){return (r&3)+8*(r>>2)+4*hi;}
#define SBAR() __builtin_amdgcn_sched_barrier(0)
__device__ __forceinline__ void wmask(f32x16&p0,f32x16&p1,int kq,int hi){
  const float NEG=-INFINITY; const int kb=kq+4*hi;
  #pragma unroll
  for(int r=0;r<16;++r){const int d=kb+(r&3)+8*(r>>2); if(d>128||d<-128)p0[r]=NEG; if(d+32>128||d+32<-128)p1[r]=NEG;}
}

constexpr int NSLOT=3, SLOTB=8192;
constexpr int LDS_K=0, LDS_V=NSLOT*SLOTB, LDS_WS=2*NSLOT*SLOTB, LDS_OST=LDS_WS+NW*64*4, LDS_BYTES=LDS_OST+NW*4096;
constexpr float C2=0.125f*1.4426950408889634f;
__device__ __forceinline__ void glds16(const void*gsrc,unsigned lds_dst){unsigned keep;
  asm volatile("s_mov_b32 %0, m0\n\ts_mov_b32 m0, %2\n\ts_nop 0\n\tglobal_load_lds_dwordx4 %1, off\n\ts_mov_b32 m0, %0":"=&s"(keep):"v"(gsrc),"s"(lds_dst):"memory");}
__device__ __forceinline__ float max3f(float a,float b,float c){float r;asm("v_max3_f32 %0, %1, %2, %3":"=v"(r):"v"(a),"v"(b),"v"(c));return r;}
__device__ __forceinline__ float max2f(float a,float b){float r;asm("v_max_f32_e32 %0, %1, %2":"=v"(r):"v"(a),"v"(b));return r;}
__device__ __forceinline__ float fadd_s(float a,float b){float r;asm("v_add_f32_e32 %0, %1, %2":"=v"(r):"v"(a),"v"(b));return r;}
__device__ __forceinline__ float fsub_s(float a,float b){float r;asm("v_sub_f32_e32 %0, %1, %2":"=v"(r):"v"(a),"v"(b));return r;}
typedef float f32x2_t __attribute__((ext_vector_type(2))); typedef __bf16 bf16x2_t __attribute__((ext_vector_type(2)));
__device__ __forceinline__ unsigned cvtpk_s(float lo,float hi){f32x2_t v={lo,hi};bf16x2_t b=__builtin_convertvector(v,bf16x2_t);return __builtin_bit_cast(unsigned,b);}
#define WAIT_BAR(N) asm volatile("s_waitcnt vmcnt(" #N ") lgkmcnt(0)\n\ts_barrier":::"memory")

__device__ __forceinline__ void qkt(f32x16&p0,f32x16&p1,const char*Kslot,const bf16x8*qr,const f32x16&negm,int r32,int hi){
  const char*kb=Kslot+hi*1024+r32*16;
  #pragma unroll
  for(int d0=0;d0<4;++d0){
    const bf16x8 b0=*reinterpret_cast<const bf16x8*>(kb+d0*2048);
    const bf16x8 b1=*reinterpret_cast<const bf16x8*>(kb+d0*2048+512);
    if(d0==0){p0=__builtin_amdgcn_mfma_f32_32x32x16_bf16(b0,qr[0],negm,0,0,0);p1=__builtin_amdgcn_mfma_f32_32x32x16_bf16(b1,qr[0],negm,0,0,0);}
    else{p0=__builtin_amdgcn_mfma_f32_32x32x16_bf16(b0,qr[d0],p0,0,0,0);p1=__builtin_amdgcn_mfma_f32_32x32x16_bf16(b1,qr[d0],p1,0,0,0);}}
}
typedef __attribute__((address_space(3))) const char* lds_cptr;
typedef short v4i16_t __attribute__((ext_vector_type(4)));
__device__ __forceinline__ void kload8(bf16x8*kf,lds_cptr kp){
  kf[0]=*(const __attribute__((address_space(3))) bf16x8*)(kp);      kf[1]=*(const __attribute__((address_space(3))) bf16x8*)(kp+512);
  kf[2]=*(const __attribute__((address_space(3))) bf16x8*)(kp+2048); kf[3]=*(const __attribute__((address_space(3))) bf16x8*)(kp+2560);
  kf[4]=*(const __attribute__((address_space(3))) bf16x8*)(kp+4096); kf[5]=*(const __attribute__((address_space(3))) bf16x8*)(kp+4608);
  kf[6]=*(const __attribute__((address_space(3))) bf16x8*)(kp+6144); kf[7]=*(const __attribute__((address_space(3))) bf16x8*)(kp+6656);
}
__device__ __forceinline__ void kload2(bf16x8*kf,lds_cptr kp,int j){ kf[2*j]=*(const __attribute__((address_space(3))) bf16x8*)(kp+j*2048); kf[2*j+1]=*(const __attribute__((address_space(3))) bf16x8*)(kp+j*2048+512); }
__device__ __forceinline__ s16x4 vtr(lds_cptr p){ return __builtin_bit_cast(s16x4,__builtin_amdgcn_ds_read_tr16_b64_v4i16((__attribute__((address_space(3))) v4i16_t*)p)); }
__device__ __forceinline__ float rowmax(const f32x16&p0,const f32x16&p1){
  float a=max3f(p0[0],p0[1],p1[0]),b=max3f(p0[2],p0[3],p1[1]);a=max3f(a,p1[2],p1[3]);
  #pragma unroll
  for(int r=4;r<16;r+=4){a=max3f(a,p0[r],p0[r+1]);b=max3f(b,p0[r+2],p0[r+3]);a=max3f(a,p1[r],p1[r+1]);b=max3f(b,p1[r+2],p1[r+3]);}
  const float m=max2f(a,b);
  auto rr=__builtin_amdgcn_permlane32_swap(__float_as_uint(m),__float_as_uint(m),false,false);
  return max2f(__uint_as_float(rr[0]),__uint_as_float(rr[1]));
}
__device__ __forceinline__ void pv(f32x16*o,int vb,bf16x8 pa0,bf16x8 pa1,bf16x8 pa2,bf16x8 pa3){
  #pragma unroll
  for(int d0=0;d0<2;++d0){s16x4 lo[4],hi[4];
    #pragma unroll
    for(int ks=0;ks<4;++ks){
      asm volatile("ds_read_b64_tr_b16 %0,%1 offset:%c2":"=&v"(lo[ks]):"v"(vb),"i"(d0*4096+ks*1024):"memory");
      asm volatile("ds_read_b64_tr_b16 %0,%1 offset:%c2":"=&v"(hi[ks]):"v"(vb),"i"(d0*4096+ks*1024+512):"memory");}
    asm volatile("s_waitcnt lgkmcnt(0)":::"memory");SBAR();
    #define PK(k) (bf16x8){lo[k][0],lo[k][1],lo[k][2],lo[k][3],hi[k][0],hi[k][1],hi[k][2],hi[k][3]}
    o[d0]=__builtin_amdgcn_mfma_f32_32x32x16_bf16(pa0,PK(0),o[d0],0,0,0);
    o[d0]=__builtin_amdgcn_mfma_f32_32x32x16_bf16(pa1,PK(1),o[d0],0,0,0);
    o[d0]=__builtin_amdgcn_mfma_f32_32x32x16_bf16(pa2,PK(2),o[d0],0,0,0);
    o[d0]=__builtin_amdgcn_mfma_f32_32x32x16_bf16(pa3,PK(3),o[d0],0,0,0);
    #undef PK
  }
}

#ifndef ATTN_STORE16
#define ATTN_STORE16(p,v) (*(u32x4*)(p)=(v))
#endif
template<int THRL,bool WIN> __device__ __forceinline__ void attn_unit(const bf16*Qb,const bf16*__restrict__ Kb,const bf16*__restrict__ Vb,bf16*Ob,int q0,int NT,int tdelta,float sink_l2,int tid,char*shm){
  const int lane=tid&63,r32=lane&31,hi=lane>>5; const int wid=__builtin_amdgcn_readfirstlane(tid>>6);
  const bf16*Qw=Qb+(long)(q0+wid*QBLK)*QP;
  const bf16*Kh=Kb,*Vh=Vb;
  const unsigned lds0=(unsigned)(uintptr_t)shm;
  float*wsf=(float*)(shm+LDS_WS)+wid*64;
  const bf16*ksrc=Kh+(long)lane*QP+wid*8;
  const bf16*vsrc=Vh+(long)(16*(wid&3)+(lane>>2))*QP+(wid>>2)*32+(lane&3)*8;
  const unsigned kdst=lds0+LDS_K+wid*1024, vdst=lds0+LDS_V+wid*1024;
  #define TM(t) ((t)<4?(t):(t)+tdelta)
  #define DMA_K(t,slot) glds16(ksrc+(long)TM(t)*KVBLK*QP,(unsigned)__builtin_amdgcn_readfirstlane(kdst+(slot)))
  #define DMA_V(t,slot) glds16(vsrc+(long)TM(t)*KVBLK*QP,(unsigned)__builtin_amdgcn_readfirstlane(vdst+(slot)))
  const int vb0=(int)(lds0+LDS_V)+((lane>>4)&1)*32+(lane&3)*8+(4*hi+((lane&15)>>2))*64;
  const char*Kbase=shm+LDS_K; bf16x8 kf[8];
  const lds_cptr shm3=(lds_cptr)shm; const lds_cptr kp0=shm3+LDS_K+hi*1024+r32*16; const lds_cptr vp0=shm3+LDS_V+((lane>>4)&1)*32+(lane&3)*8+(4*hi+((lane&15)>>2))*64;
  DMA_K(0,0);DMA_V(0,0);DMA_K(1,SLOTB);
  bf16x8 qr[4];
  #pragma unroll
  for(int d0=0;d0<4;++d0)qr[d0]=*reinterpret_cast<const bf16x8*>(&Qw[(long)r32*QP+d0*16+hi*8]);
  float mhat=0.f,l_reg=0.f;float z0_=0.f;asm volatile("":"+v"(z0_));f32x16 o[2];
  #pragma unroll
  for(int r_=0;r_<16;++r_){o[0][r_]=z0_;o[1][r_]=z0_;}
  f32x16 negm;
  #pragma unroll
  for(int r_=0;r_<16;++r_)negm[r_]=z0_;
  asm volatile("":"+v"(negm));
  const int qrow=q0+wid*QBLK+r32;
  #define CMASK(P0,P1,t) do{ if(WIN&&(t)>=4)wmask(P0,P1,TM(t)*KVBLK-qrow,hi); }while(0)
  bool resc=false;
  #define START(P0,P1) do{ const float rm=rowmax(P0,P1); resc=false; \
    { const float dl=rm; mhat=fadd_s(mhat,dl); \
      _Pragma("unroll") for(int r=0;r<16;++r){P0[r]=fsub_s(P0[r],dl);P1[r]=fsub_s(P1[r],dl);} \
      _Pragma("unroll") for(int r=0;r<16;++r)negm[r]=-mhat; asm volatile("":"+v"(negm)); } \
    _Pragma("unroll") for(int r=0;r<16;++r)P0[r]=__builtin_amdgcn_exp2f(P0[r]); }while(0)
  #define RESC() do{ if(resc){ asm volatile("s_waitcnt lgkmcnt(0)":::"memory"); \
      _Pragma("unroll") for(int d_=0;d_<2;++d_) _Pragma("unroll") for(int r=0;r<16;++r)o[d_][r]*=wsf[crow(r,hi)]; } }while(0)
  f32x16 pA0,pA1,pB0,pB1;
  int sl_prev=0,sl_cur=0,sl_next=SLOTB;
  #define ROT() do{sl_prev=sl_cur;sl_cur=sl_next;sl_next=(sl_next==(NSLOT-1)*SLOTB)?0:sl_next+SLOTB;}while(0)
  DMA_K(2,2*SLOTB);
  WAIT_BAR(3);
  qkt(pA0,pA1,Kbase,qr,negm,r32,hi);asm volatile("s_nop 15\n\ts_nop 7":"+v"(pA0),"+v"(pA1));CMASK(pA0,pA1,0);
  START(pA0,pA1);
  _Pragma("unroll") for(int r=0;r<16;++r)pA1[r]=__builtin_amdgcn_exp2f(pA1[r]);
  WAIT_BAR(0);
  DMA_K(3,0);DMA_V(1,SLOTB);
  ROT();
  kload8(kf,kp0+sl_cur);
  WAIT_BAR(2);
  s16x4 vlo[8],vhi[8]; u32x4 pw0,pw1,pw2,pw3;
  #define PKW(P,B) cvtpk_s(P[B],P[B+1])
  #define PAF(k) __builtin_bit_cast(bf16x8,pw##k)
  #define VFR(i) (bf16x8){vlo[i][0],vlo[i][1],vlo[i][2],vlo[i][3],vhi[i][0],vhi[i][1],vhi[i][2],vhi[i][3]}
  #define PIN(x) asm volatile("":"+v"(x))
  #define MX3(a,b,c) __builtin_fmaxf(__builtin_fmaxf((a),(b)),(c))
  #define GAPA(MF,A0,A1,A2,A3,W0,W1,PW) do{ MF; sacc+=A0; sacc+=A1; sacc+=A2; sacc+=A3; PIN(sacc); W0; W1; PIN(PW); SBAR(); }while(0)
  #define EX(v) __builtin_amdgcn_exp2f(v)
  #define GAPB(MF,X,B) do{ MF; X[B]=EX(X[B]); X[B+1]=EX(X[B+1]); X[B+2]=EX(X[B+2]); X[B+3]=EX(X[B+3]); PIN(X); SBAR(); }while(0)
  #define VRD(i) do{ vlo[i]=vtr(vp_+(((i)>>2)*4096+((i)&3)*1024)); vhi[i]=vtr(vp_+(((i)>>2)*4096+((i)&3)*1024+512)); }while(0)
  #define KRD(G,j) do{ if(G){ kload2(kf,kp0+sl_next,j); SBAR(); } }while(0)
  #define STEP(C0,C1,P0,P1,t,GK,GV,GL) do{ SBAR(); \
    const lds_cptr vp_=vp0+sl_prev; \
    VRD(0); SBAR(); float sacc=(P0[0]+P0[1]); \
    GAPA(C0=__builtin_amdgcn_mfma_f32_32x32x16_bf16(kf[0],qr[0],negm,0,0,0), P0[2],P0[3],P0[4],P0[5],     pw0[0]=PKW(P0,0), pw0[1]=PKW(P0,2), pw0); \
    VRD(4); SBAR(); GAPA(C1=__builtin_amdgcn_mfma_f32_32x32x16_bf16(kf[1],qr[0],negm,0,0,0), P0[6],P0[7],P0[8],P0[9],     pw0[2]=PKW(P0,4), pw0[3]=PKW(P0,6), pw0); \
    VRD(1); SBAR(); GAPA(C0=__builtin_amdgcn_mfma_f32_32x32x16_bf16(kf[2],qr[1],C0,0,0,0),   P0[10],P0[11],P0[12],P0[13], pw1[0]=PKW(P0,8), pw1[1]=PKW(P0,10), pw1); \
    VRD(5); SBAR(); GAPA(C1=__builtin_amdgcn_mfma_f32_32x32x16_bf16(kf[3],qr[1],C1,0,0,0),   P0[14],P0[15],P1[0],P1[1],   pw1[2]=PKW(P0,12),pw1[3]=PKW(P0,14), pw1); \
    VRD(2); SBAR(); GAPA(C0=__builtin_amdgcn_mfma_f32_32x32x16_bf16(kf[4],qr[2],C0,0,0,0),   P1[2],P1[3],P1[4],P1[5],     pw2[0]=PKW(P1,0), pw2[1]=PKW(P1,2), pw2); \
    VRD(6); SBAR(); GAPA(C1=__builtin_amdgcn_mfma_f32_32x32x16_bf16(kf[5],qr[2],C1,0,0,0),   P1[6],P1[7],P1[8],P1[9],     pw2[2]=PKW(P1,4), pw2[3]=PKW(P1,6), pw2); \
    VRD(3); SBAR(); GAPA(C0=__builtin_amdgcn_mfma_f32_32x32x16_bf16(kf[6],qr[3],C0,0,0,0),   P1[10],P1[11],P1[12],P1[13], pw3[0]=PKW(P1,8), pw3[1]=PKW(P1,10), pw3); \
    VRD(7); SBAR(); GAPA(C1=__builtin_amdgcn_mfma_f32_32x32x16_bf16(kf[7],qr[3],C1,0,0,0),   P1[14],P1[15],0.f,0.f,       pw3[2]=PKW(P1,12),pw3[3]=PKW(P1,14), pw3); \
    l_reg+=sacc; \
    if(GK){DMA_K((t)+3,sl_cur);} if(GV){DMA_V((t)+1,sl_next);} \
    CMASK(C0,C1,t); \
    { float a=MX3(C0[0],C0[1],C1[0]),b=MX3(C0[2],C0[3],C1[1]); a=MX3(a,C1[2],C1[3]); \
      _Pragma("unroll") for(int r=4;r<16;r+=4){a=MX3(a,C0[r],C0[r+1]);b=MX3(b,C0[r+2],C0[r+3]);a=MX3(a,C1[r],C1[r+1]);b=MX3(b,C1[r+2],C1[r+3]);} \
      float rm=__builtin_fmaxf(a,b); { auto rr=__builtin_amdgcn_permlane32_swap(__float_as_uint(rm),__float_as_uint(rm),false,false); rm=__builtin_fmaxf(__uint_as_float(rr[0]),__uint_as_float(rr[1])); } \
      resc=false; \
      if(__builtin_expect(__any(rm>(float)THRL),0)){ const float dl=__builtin_fmaxf(rm,0.f); mhat+=dl; \
        _Pragma("unroll") for(int r=0;r<16;++r){C0[r]-=dl;C1[r]-=dl;} \
        _Pragma("unroll") for(int r=0;r<16;++r)negm[r]=-mhat; asm volatile("":"+v"(negm)); \
        const float f=__builtin_amdgcn_exp2f(-dl); l_reg*=f; if(hi==0)wsf[r32]=f; resc=true; } } \
    SBAR(); \
    GAPB(o[0]=__builtin_amdgcn_mfma_f32_32x32x16_bf16(PAF(0),VFR(0),o[0],0,0,0), C0,0); \
    GAPB(o[1]=__builtin_amdgcn_mfma_f32_32x32x16_bf16(PAF(0),VFR(4),o[1],0,0,0), C0,4); \
    KRD(GL,0); GAPB(o[0]=__builtin_amdgcn_mfma_f32_32x32x16_bf16(PAF(1),VFR(1),o[0],0,0,0), C0,8); \
    KRD(GL,1); GAPB(o[1]=__builtin_amdgcn_mfma_f32_32x32x16_bf16(PAF(1),VFR(5),o[1],0,0,0), C0,12); \
    KRD(GL,2); GAPB(o[0]=__builtin_amdgcn_mfma_f32_32x32x16_bf16(PAF(2),VFR(2),o[0],0,0,0), C1,0); \
    KRD(GL,3); GAPB(o[1]=__builtin_amdgcn_mfma_f32_32x32x16_bf16(PAF(2),VFR(6),o[1],0,0,0), C1,4); \
    GAPB(o[0]=__builtin_amdgcn_mfma_f32_32x32x16_bf16(PAF(3),VFR(3),o[0],0,0,0), C1,8); \
    GAPB(o[1]=__builtin_amdgcn_mfma_f32_32x32x16_bf16(PAF(3),VFR(7),o[1],0,0,0), C1,12); \
    }while(0)
  int t=1;
  for(;t+5<NT;t+=2){
    STEP(pB0,pB1,pA0,pA1,t,true,true,true);     WAIT_BAR(2); RESC(); ROT();
    STEP(pA0,pA1,pB0,pB1,t+1,true,true,true);   WAIT_BAR(2); RESC(); ROT();
  }
  #define ENDW(tt) do{ if((tt)+3<NT){WAIT_BAR(2);} else if((tt)+2<NT){WAIT_BAR(1);} else {WAIT_BAR(0);} }while(0)
  for(;t+1<NT;t+=2){
    STEP(pB0,pB1,pA0,pA1,t,(t+3<NT),(t+1<NT),(t+1<NT));       ENDW(t);   RESC(); ROT();
    STEP(pA0,pA1,pB0,pB1,t+1,(t+4<NT),(t+2<NT),(t+2<NT));     ENDW(t+1); RESC(); ROT();
  }
  STEP(pB0,pB1,pA0,pA1,NT-1,false,false,false); RESC();
  { float sacc=pB0[0]+pB0[1]; _Pragma("unroll") for(int r=2;r<16;++r)sacc+=pB0[r]; _Pragma("unroll") for(int r=0;r<16;++r)sacc+=pB1[r]; l_reg+=sacc;
    pw0=(u32x4){PKW(pB0,0),PKW(pB0,2),PKW(pB0,4),PKW(pB0,6)};pw1=(u32x4){PKW(pB0,8),PKW(pB0,10),PKW(pB0,12),PKW(pB0,14)};pw2=(u32x4){PKW(pB1,0),PKW(pB1,2),PKW(pB1,4),PKW(pB1,6)};pw3=(u32x4){PKW(pB1,8),PKW(pB1,10),PKW(pB1,12),PKW(pB1,14)};
    SBAR(); pv(o,vb0+sl_cur,PAF(0),PAF(1),PAF(2),PAF(3)); }
  #undef PKW
  #undef PAF
  #undef VFR
  #undef PIN
  #undef MX3
  #undef GAPA
  #undef GAPB
  #undef EX
  #undef VRD
  #undef KRD
  #undef STEP
  #undef ENDW
  {auto rr=__builtin_amdgcn_permlane32_swap(__float_as_uint(l_reg),__float_as_uint(l_reg),false,false);l_reg=__uint_as_float(rr[0])+__uint_as_float(rr[1]);}
  if(WIN)l_reg+=__builtin_amdgcn_exp2f(sink_l2-mhat);
  if(hi==0)wsf[32+r32]=l_reg;asm volatile("s_waitcnt lgkmcnt(0)":::"memory");
  float rli[16];
  #pragma unroll
  for(int r=0;r<16;++r)rli[r]=__builtin_amdgcn_rcpf(wsf[32+crow(r,hi)]);
  bf16*Ow=Ob+(long)(q0+wid*QBLK)*OP;
  { bf16*stg=(bf16*)(shm+LDS_OST)+wid*2048;
    #pragma unroll
    for(int r=0;r<16;++r){const int orow=crow(r,hi);
      #pragma unroll
      for(int d0=0;d0<2;++d0)stg[orow*64+d0*32+r32]=__float2bfloat16(o[d0][r]*rli[r]);}
    asm volatile("s_waitcnt lgkmcnt(0)":::"memory");
    #pragma unroll
    for(int i=0;i<4;++i){const int row=i*8+(lane>>3),ch=lane&7; const u32x4 v=*(const u32x4*)(stg+row*64+ch*8); ATTN_STORE16(Ow+(long)row*OP+ch*8,v);} }
  asm volatile("s_waitcnt lgkmcnt(0)\n\ts_barrier":::"memory");
  #undef TM
  #undef DMA_K
  #undef DMA_V
  #undef CMASK
  #undef START
  #undef RESC
  #undef ROT
}
constexpr int ATTN_LDS_BYTES=LDS_BYTES;
#undef SBAR
#undef WAIT_BAR
}
#define XB_TMO      128
#define XB_XCNT(j)  (256  + 64 * (j))
#define XB_XSUB(j)  (1280 + 64 * (j))
#define XB_XGEN(j)  (2304 + 64 * (j))
#define XB_TOP      3328
#define XB_TOPGEN   3392
#define XCD_BAR_WORDS 3456
#define XB_SPIN_CAP (1u << 21)

__device__ __forceinline__ unsigned xb_ld(unsigned* p)              { return __hip_atomic_load(p, __ATOMIC_RELAXED, __HIP_MEMORY_SCOPE_AGENT); }
__device__ __forceinline__ unsigned xb_add(unsigned* p, unsigned v) { return __hip_atomic_fetch_add(p, v, __ATOMIC_RELAXED, __HIP_MEMORY_SCOPE_AGENT); }
__device__ __forceinline__ unsigned xb_xcc_id() { return (unsigned)__builtin_amdgcn_s_getreg((3 << 11) | 20) & 0xFu; }
#define XB_SPIN(cond, bar) do { unsigned _sp = 0; while (cond) { __builtin_amdgcn_s_sleep(1); \
    if ((++_sp & 255u) == 0u) { if (xb_ld(&(bar)[XB_TMO])) break; if (_sp > XB_SPIN_CAP) { atomicAdd(&(bar)[XB_TMO], 1u); break; } } } } while (0)

struct XcdBarrier {
    unsigned* bar; unsigned x;
    volatile LAS unsigned* st;
};

__device__ __forceinline__ XcdBarrier xcd_barrier_post(unsigned* bar, volatile LAS unsigned* st) {
    XcdBarrier b; b.bar = bar; b.x = xb_xcc_id(); b.st = st;
    if (threadIdx.x == 0) (void)xb_add(&bar[XB_XCNT(b.x)], 1u);
    return b;
}
__device__ __forceinline__ void xcd_barrier_complete(unsigned* bar, unsigned x, unsigned& nloc, unsigned& nx) {
    const unsigned G = gridDim.x * gridDim.y * gridDim.z;
    unsigned sum, cnt, mine, sp = 0u;
    for (;;) {
        sum = 0u; cnt = 0u; mine = 0u;
#pragma unroll
        for (unsigned j = 0; j < 16; ++j) { const unsigned c = xb_ld(&bar[XB_XCNT(j)]); sum += c; cnt += (c > 0u) ? 1u : 0u; mine = (j == x) ? c : mine; }
        if (sum == G) break;
        __builtin_amdgcn_s_sleep(1);
        if ((++sp & 255u) == 0u) { if (xb_ld(&bar[XB_TMO])) break; if (sp > XB_SPIN_CAP) { atomicAdd(&bar[XB_TMO], 1u); break; } }
    }
    nloc = mine > 0u ? mine : 1u; nx = cnt > 0u ? cnt : 1u;
}

__device__ __forceinline__ void xcd_barrier(const XcdBarrier& b) {
    asm volatile("s_waitcnt vmcnt(0)" ::: "memory");
    __syncthreads();
    if (threadIdx.x == 0) {
        unsigned* bar = b.bar; unsigned bx_ = b.x; asm volatile("" : "+s"(bar), "+s"(bx_));
        __builtin_amdgcn_s_waitcnt(0);
        unsigned nloc = b.st[0], nx = b.st[1];
        if (nloc == 0u) { xcd_barrier_complete(bar, bx_, nloc, nx); b.st[0] = nloc; b.st[1] = nx; }
        const unsigned old = xb_add(&bar[XB_XSUB(bx_)], 1u);
        const unsigned gen = old / nloc;
        if (old + 1u == (gen + 1u) * nloc) {
            __builtin_amdgcn_fence(__ATOMIC_RELEASE, "agent");
            asm volatile("s_waitcnt vmcnt(0)" ::: "memory");
            const unsigned og = xb_add(&bar[XB_TOP], 1u);
            const unsigned tg = og / nx;
            if (og + 1u == (tg + 1u) * nx) xb_add(&bar[XB_TOPGEN], 1u);
            else XB_SPIN(xb_ld(&bar[XB_TOPGEN]) == tg, bar);
            __builtin_amdgcn_fence(__ATOMIC_ACQUIRE, "agent");
            xb_add(&bar[XB_XGEN(bx_)], 1u);
            asm volatile("s_waitcnt vmcnt(0)" ::: "memory");
        } else {
            XB_SPIN(xb_ld(&bar[XB_XGEN(bx_)]) == gen, bar);
            __builtin_amdgcn_fence(__ATOMIC_ACQUIRE, "agent");
            asm volatile("s_waitcnt vmcnt(0)" ::: "memory");
        }
    }
    __syncthreads();
}

#ifndef CVQ0
#define CVQ0 3
#define CVQ1 4
#define CVQ2 3
#define CVQ3 3
#endif
constexpr size_t alup(size_t x) { return (x + 4095) & ~(size_t)4095; }
constexpr size_t CTL_BYTES = 1u << 20;
constexpr size_t SZ_WIN = (size_t)DEPTH * DIN * DM * 2, SZ_WOUT = (size_t)DEPTH * DM * DM * 2, SZ_WGU = (size_t)DEPTH * NE * 2 * FF * DM  , SZ_WDN = (size_t)DEPTH * NE * DM * FF  ;
constexpr size_t SZ_MODP = (size_t)DEPTH * 16 * 17 * 6144 * 4, SZ_MOD = (size_t)DEPTH * 17 * 6144 * 4;
constexpr size_t SZ_X32 = (size_t)MROWS * DM * 2  , SZ_H = (size_t)MROWS * DM * 2, SZ_P = (size_t)MROWS * DIN * 2, SZ_Y = (size_t)MROWS * DM * 2, SZ_YP = (size_t)MROWS * 2 * DM  ;
constexpr size_t SZ_LIST = (size_t)NE * MROWS * 4, SZ_GW = (size_t)NE * MROWS * 4  ;
constexpr int MAXBLK = (MROWS * 2) / 256 + NE;
static_assert((size_t)MAXBLK * 256 * FF * 2 <= SZ_P, "HMID overlays P");
static_assert((size_t)2 * NB * 4 * NCH * 128 * 64 * 4 <= SZ_H, "KVT overlays H");
static_assert((size_t)2 * NB * 4 * NCH * 128 * 64 * 2 <= SZ_YP, "ST overlays YP");
constexpr size_t WS_CTL = 0;
constexpr size_t WS_WIN = CTL_BYTES, WS_WOUT = WS_WIN + alup(SZ_WIN), WS_WGU = WS_WOUT + alup(SZ_WOUT), WS_WDN = WS_WGU + alup(SZ_WGU);
constexpr size_t WS_MODP = WS_WDN + alup(SZ_WDN), WS_MOD = WS_MODP + alup(SZ_MODP);
constexpr size_t WS_X32 = WS_MOD + alup(SZ_MOD), WS_H = WS_X32 + alup(SZ_X32), WS_P = WS_H + alup(SZ_H), WS_Y = WS_P + alup(SZ_P), WS_YP = WS_Y + alup(SZ_Y);
constexpr size_t WS_LIST = WS_YP + alup(SZ_YP), WS_GW = WS_LIST + alup(SZ_LIST), WS_END = WS_GW + alup(SZ_GW);
constexpr int CW_BAR = 4096;
constexpr int CW_CNT = 16384;

constexpr int RING_BYTES = 131072;
constexpr int LDSCTL_OFF = RING_BYTES;
constexpr int LDS_BYTES = 147456;

#define ATTN_STORE16(p,v) (*(u32x4*)(p)=(v))

#define CAS __attribute__((address_space(4)))
__device__ __forceinline__ const float* inp(int i) {
    const CAS unsigned char* k = (const CAS unsigned char*)__builtin_amdgcn_kernarg_segment_ptr();
    asm volatile("" : "+s"(k));
    return *(const float* const CAS*)(k + 8 * i);
}
#define CBAR() do { asm volatile("" ::: "memory"); __builtin_amdgcn_sched_barrier(0); } while (0)
struct Ctx {
    float* out; unsigned char* ws;
    __device__ __forceinline__ const float* x() const { return inp(0); }
    __device__ __forceinline__ const float* c() const { return inp(1); }
    __device__ __forceinline__ const float* ctx() const { return inp(2); }
    __device__ __forceinline__ const float* c_ctx() const { return inp(3); }
    __device__ __forceinline__ const float* ada_w() const { return inp(4); }
    __device__ __forceinline__ const float* ada_b() const { return inp(5); }
    __device__ __forceinline__ const float* norm1() const { return inp(6); }
    __device__ __forceinline__ const float* norm2() const { return inp(7); }
    __device__ __forceinline__ const float* w_in() const { return inp(8); }
    __device__ __forceinline__ const float* w_out() const { return inp(9); }
    __device__ __forceinline__ const float* ret_decay() const { return inp(10); }
    __device__ __forceinline__ const float* win_gain() const { return inp(11); }
    __device__ __forceinline__ const float* win_sink() const { return inp(12); }
    __device__ __forceinline__ const float* glb_gain() const { return inp(13); }
    __device__ __forceinline__ const float* w_router() const { return inp(14); }
    __device__ __forceinline__ const float* b_router() const { return inp(15); }
    __device__ __forceinline__ const float* w_gu() const { return inp(16); }
    __device__ __forceinline__ const float* w_dn() const { return inp(17); }
};

template <int CTRL> __device__ __forceinline__ float dppx(float v) { return __builtin_bit_cast(float, __builtin_amdgcn_update_dpp(0, __builtin_bit_cast(int, v), CTRL, 0xF, 0xF, true)); }
__device__ __forceinline__ float xor1(float v) { return dppx<0xB1>(v); }
__device__ __forceinline__ float xor2(float v) { return dppx<0x4E>(v); }
__device__ __forceinline__ float wave_sum(float v) {
    v += dppx<0xB1>(v); v += dppx<0x4E>(v); v += dppx<0x141>(v); v += dppx<0x140>(v);
    { const unsigned u = __builtin_bit_cast(unsigned, v); auto r = __builtin_amdgcn_permlane16_swap(u, u, false, false); v = __builtin_bit_cast(float, (unsigned)r[0]) + __builtin_bit_cast(float, (unsigned)r[1]); }
    { const unsigned u = __builtin_bit_cast(unsigned, v); auto r = __builtin_amdgcn_permlane32_swap(u, u, false, false); v = __builtin_bit_cast(float, (unsigned)r[0]) + __builtin_bit_cast(float, (unsigned)r[1]); }
    return v;
}
__device__ __forceinline__ float xor16(float v, int lane) { const unsigned u = __builtin_bit_cast(unsigned, v); auto r = __builtin_amdgcn_permlane16_swap(u, u, false, false);
    return __builtin_bit_cast(float, (lane & 16) ? (unsigned)r[0] : (unsigned)r[1]); }
__device__ __forceinline__ float silu_f(float v) { return v * __builtin_amdgcn_rcpf(1.f + __builtin_amdgcn_exp2f(-LOG2E * v)); }
__device__ __forceinline__ float log2_sigmoid(float x) { return -log1pf(expf(-x)) * LOG2E; }

__device__ __forceinline__ void transpose_item(const float* W, int N, int nsrc0, int k0, bf16_t* WT, int K, int nrow0, LAS float* scr, int lane) {
    float ld_[32];
#pragma unroll
    for (int i = 0; i < 32; ++i) ld_[i] = W[(size_t)(k0 + 2 * i + (lane >> 5)) * N + nsrc0 + (lane & 31)];
#pragma unroll
    for (int i = 0; i < 32; ++i) scr[(2 * i + (lane >> 5)) * 33 + (lane & 31)] = ld_[i];
    asm volatile("s_waitcnt lgkmcnt(0)" ::: "memory");
    const int c = lane & 7;
#pragma unroll
    for (int j = 0; j < 4; ++j) { const int n = (lane >> 3) + 8 * j; const LAS float* s = scr + (8 * c) * 33 + n;
        u32x4 o; o.x = pk2(s[0 * 33], s[1 * 33]); o.y = pk2(s[2 * 33], s[3 * 33]); o.z = pk2(s[4 * 33], s[5 * 33]); o.w = pk2(s[6 * 33], s[7 * 33]);
        *(u32x4*)(WT + (size_t)(nrow0 + n) * K + k0 + 8 * c) = o; }
    asm volatile("s_waitcnt lgkmcnt(0)" ::: "memory");
}
__device__ __forceinline__ unsigned pk4_fp8(float a, float b, float c, float d) { int w = 0; w = __builtin_amdgcn_cvt_pk_fp8_f32(a, b, w, false); w = __builtin_amdgcn_cvt_pk_fp8_f32(c, d, w, true); return (unsigned)w; }
__device__ __forceinline__ f32x4 fp8x4_f32(unsigned w) { typedef float f2_ __attribute__((ext_vector_type(2))); const f2_ lo = __builtin_amdgcn_cvt_pk_f32_fp8((int)w, false), hi = __builtin_amdgcn_cvt_pk_f32_fp8((int)w, true); return (f32x4){lo[0], lo[1], hi[0], hi[1]}; }
constexpr float YP_SCALE = 16.0f, YP_INV = 1.0f / 16.0f;
constexpr float W8_SCALE = 64.0f, W8_INV = 1.0f / 64.0f;
__device__ __forceinline__ void transpose_item8(const float* W, int N, int nsrc0, int k0, unsigned char* WT, int K, int nrow0, LAS float* scr, int lane) {
    float ld_[32];
#pragma unroll
    for (int i = 0; i < 32; ++i) ld_[i] = W[(size_t)(k0 + 2 * i + (lane >> 5)) * N + nsrc0 + (lane & 31)];
#pragma unroll
    for (int i = 0; i < 32; ++i) scr[(2 * i + (lane >> 5)) * 33 + (lane & 31)] = ld_[i];
    asm volatile("s_waitcnt lgkmcnt(0)" ::: "memory");
    const int c = lane & 7;
#pragma unroll
    for (int j = 0; j < 4; ++j) { const int n = (lane >> 3) + 8 * j; const LAS float* s = scr + (8 * c) * 33 + n;
        u32x2 o; o.x = pk4_fp8(s[0 * 33] * W8_SCALE, s[1 * 33] * W8_SCALE, s[2 * 33] * W8_SCALE, s[3 * 33] * W8_SCALE); o.y = pk4_fp8(s[4 * 33] * W8_SCALE, s[5 * 33] * W8_SCALE, s[6 * 33] * W8_SCALE, s[7 * 33] * W8_SCALE);
        *(u32x2*)(WT + (size_t)(nrow0 + n) * K + k0 + 8 * c) = o; }
    asm volatile("s_waitcnt lgkmcnt(0)" ::: "memory");
}
constexpr int IT_WIN = 16 * 80, IT_WOUT = 16 * 32, IT_GU = 16 * 64, IT_DN = 16 * 32, IT_LAYER = IT_WIN + IT_WOUT + NE * (IT_GU + IT_DN);
__device__ __forceinline__ void convert_item(const Ctx& C, int l, int r, LAS float* scr, int lane) {
    if (r < IT_WIN) { const int kb = r / 80, nb = r % 80;
        transpose_item(C.w_in() + (size_t)l * DM * DIN, DIN, 32 * nb, 64 * kb, (bf16_t*)(C.ws + WS_WIN) + (size_t)l * DIN * DM, DM, 32 * nb, scr, lane); return; }
    r -= IT_WIN;
    if (r < IT_WOUT) { const int kb = r / 32, nb = r % 32;
        transpose_item(C.w_out() + (size_t)l * DM * DM, DM, 32 * nb, 64 * kb, (bf16_t*)(C.ws + WS_WOUT) + (size_t)l * DM * DM, DM, 32 * nb, scr, lane); return; }
    r -= IT_WOUT;
    if (r < NE * IT_GU) { const int e = r / IT_GU, q = r % IT_GU, kb = q / 64, nb = q % 64;
        const int np = 32 * nb, tile = np >> 8, within = np & 255, nsrc = within < 128 ? tile * 128 + within : FF + tile * 128 + within - 128;
        transpose_item8(C.w_gu() + (size_t)(l * NE + e) * DM * 2 * FF, 2 * FF, nsrc, 64 * kb, (unsigned char*)(C.ws + WS_WGU) + (size_t)(l * NE + e) * 2 * FF * DM, DM, np, scr, lane); return; }
    r -= NE * IT_GU;
    { const int e = r / IT_DN, q = r % IT_DN, kb = q / 32, nb = q % 32;
        transpose_item8(C.w_dn() + (size_t)(l * NE + e) * FF * DM, DM, 32 * nb, 64 * kb, (unsigned char*)(C.ws + WS_WDN) + (size_t)(l * NE + e) * DM * FF, FF, 32 * nb, scr, lane); }
}
__device__ __forceinline__ int cv_lo(int p) { return p == 0 ? 0 : p == 1 ? 3840 : p == 2 ? 13056 : p == 3 ? 19712 : IT_LAYER; }
__device__ __forceinline__ int cv_q(int p) { return p == 0 ? CVQ0 : p == 1 ? CVQ1 : p == 2 ? CVQ2 : CVQ3; }
__device__ __forceinline__ int cv_covered(int p, int units, int G) { const int rem = units % G; if (rem == 0) return 0; const int n = (G - rem) * 8 * cv_q(p), len = cv_lo(p + 1) - cv_lo(p); return n < len ? n : len; }
__device__ __forceinline__ void convert_tail(const Ctx& C, int lnext, int p, int units, int G, int c, LAS unsigned char* lds, int wave, int lane) {
    const int rem = units % G; if (rem == 0 || c < rem) return;
    const int nidle = G - rem, k = c - rem, lo = cv_lo(p), hi = cv_lo(p + 1);
    LAS float* scr = (LAS float*)(lds + wave * 16384);
    for (int j = 0; j < cv_q(p); ++j) { const int it = lo + (j * nidle + k) * 8 + wave; if (it < hi) convert_item(C, lnext, it, scr, lane); }
}
__device__ __forceinline__ void convert_rest(const Ctx& C, int l, int G, int vcu, LAS unsigned char* lds, int wave, int lane, int units2, int units3) {
    LAS float* scr = (LAS float*)(lds + wave * 16384);
    const int gw = vcu * 8 + wave, NGW = G * 8;
    const int lo0 = cv_lo(0) + cv_covered(0, (MROWS / 256) * (DIN / 256), G), lo1 = cv_lo(1) + cv_covered(1, (MROWS / 256) * (DM / 256), G), lo2 = cv_lo(2) + cv_covered(2, units2, G), lo3 = cv_lo(3) + cv_covered(3, units3, G);
    const int n0 = cv_lo(1) - lo0, n1 = cv_lo(2) - lo1, n2 = cv_lo(3) - lo2, n3 = cv_lo(4) - lo3;
    for (int v = gw; v < n0 + n1 + n2 + n3; v += NGW) { int r = v, it;
        if (r < n0) it = lo0 + r; else { r -= n0; if (r < n1) it = lo1 + r; else { r -= n1; if (r < n2) it = lo2 + r; else it = lo3 + (r - n2); } }
        convert_item(C, l, it, scr, lane); }
}
__device__ __forceinline__ void phase_prologue(const Ctx& C, LAS unsigned char* lds, int G, int vcu, int bx, int tid) {
    const int lane = tid & 63, wave = tid >> 6;
    {
        LAS float* scs = (LAS float*)lds;
        bool have = false;
        for (int it = bx; it < DEPTH * 12 * 16; it += G) {
            if (!have) {
                for (int i = tid; i < 17 * DM; i += 512) { const int r = i >> 10, k = i & 1023; const float v = r < 16 ? C.c()[r * DM + k] : C.c_ctx()[k]; scs[i] = v / (1.f + expf(-v)); }
                __syncthreads(); have = true;
            }
            const int l = it / 192, rem = it % 192, cb = rem / 16, kc = rem % 16;
            const float* w = C.ada_w() + ((size_t)l * DM + kc * 64) * 6144 + cb * 512 + tid;
            float acc[17];
#pragma unroll
            for (int r = 0; r < 17; ++r) acc[r] = 0.f;
#pragma unroll 4
            for (int kk = 0; kk < 64; ++kk) { const float wv = w[(size_t)kk * 6144];
#pragma unroll
                for (int r = 0; r < 17; ++r) acc[r] += scs[r * DM + kc * 64 + kk] * wv; }
            float* mp = (float*)(C.ws + WS_MODP) + ((size_t)(l * 16 + kc) * 17) * 6144 + cb * 512 + tid;
#pragma unroll
            for (int r = 0; r < 17; ++r) mp[(size_t)r * 6144] = acc[r];
        }
        __syncthreads();
    }
    LAS float* scr = (LAS float*)(lds + wave * 16384);
    const int gw = vcu * 8 + wave, NGW = G * 8;
    for (int it = gw; it < IT_LAYER; it += NGW) convert_item(C, 0, it, scr, lane);
}
__device__ __forceinline__ void phase_modsum(const Ctx& C, int G, int bx, int tid) {
    const float* mp = (const float*)(C.ws + WS_MODP); float* mod = (float*)(C.ws + WS_MOD);
    for (int i = bx * 512 + tid; i < DEPTH * 17 * 6144; i += G * 512) {
        const int l = i / (17 * 6144), rem = i % (17 * 6144), r = rem / 6144, n = rem % 6144;
        float s = C.ada_b()[l * 6144 + n];
#pragma unroll
        for (int kc = 0; kc < 16; ++kc) s += mp[((size_t)(l * 16 + kc) * 17 + r) * 6144 + n];
        mod[i] = s;
    }
}

__device__ __forceinline__ f32x4 bf4(u32x2 a) { return (f32x4){bflo(a.x), bfhi(a.x), bflo(a.y), bfhi(a.y)}; }
__device__ __forceinline__ u32x2 pk4(f32x4 v) { u32x2 w; w.x = pk2(v[0], v[1]); w.y = pk2(v[2], v[3]); return w; }
__device__ __forceinline__ void phase_norm1(const Ctx& C, int layer, int gw, int NGW, int lane, bf16_t* XO) {
    const float* mod = (const float*)(C.ws + WS_MOD) + (size_t)layer * 17 * 6144;
    const float* gain = C.norm1() + layer * DM;
    bf16_t* XR = (bf16_t*)(C.ws + WS_X32); bf16_t* H = (bf16_t*)(C.ws + WS_H); const unsigned char* YP = (const unsigned char*)(C.ws + WS_YP);
    const float* xin = C.x(); const float* cin = C.ctx();
    f32x4 nx[4]; u32x2 nr[4]; unsigned na[4], nb[4];
#define N1_LOAD(mm) do { const int b_ = (mm) / TPB, t_ = (mm) - b_ * TPB; \
        if (layer == 0) { const f32x4* s_ = (const f32x4*)(t_ < CTX ? cin + ((size_t)b_ * CTX + t_) * DM : xin + ((size_t)b_ * SEQ + (t_ - CTX)) * DM) + lane; \
            _Pragma("unroll") for (int j = 0; j < 4; ++j) nx[j] = s_[64 * j]; } \
        else { const u32x2* s_ = (const u32x2*)(XR + (size_t)(mm) * DM) + lane; const unsigned* y0_ = (const unsigned*)(YP + (size_t)(mm) * 2 * DM) + lane; \
            _Pragma("unroll") for (int j = 0; j < 4; ++j) { nr[j] = s_[64 * j]; na[j] = y0_[64 * j]; nb[j] = y0_[DM / 4 + 64 * j]; } } } while (0)
    if (gw < MROWS) N1_LOAD(gw);
    for (int m = gw; m < MROWS; m += NGW) {
        const int b = m / TPB, t = m - b * TPB, set = t < CTX ? 16 : b;
        f32x4 v[4];
        if (layer == 0) {
#pragma unroll
            for (int j = 0; j < 4; ++j) v[j] = nx[j];
        } else {
            const f32x4* g2 = (const f32x4*)(mod - 17 * 6144 + (size_t)set * 6144 + 5 * DM) + lane;
#pragma unroll
            for (int j = 0; j < 4; ++j) v[j] = bf4(nr[j]) + (g2[64 * j] * YP_INV) * (fp8x4_f32(na[j]) + fp8x4_f32(nb[j]));
        }
        if (m + NGW < MROWS) N1_LOAD(m + NGW);
        u32x2* xo = (u32x2*)(XO + (size_t)m * DM) + lane;
        float ss = 0.f;
#pragma unroll
        for (int j = 0; j < 4; ++j) { xo[64 * j] = pk4(v[j]); ss += (v[j][0] * v[j][0] + v[j][1] * v[j][1]) + (v[j][2] * v[j][2] + v[j][3] * v[j][3]); }
        const float rstd = 1.0f / sqrtf(wave_sum(ss) * (1.f / DM) + EPS);
        const f32x4* gp = (const f32x4*)gain + lane; const f32x4* shp = (const f32x4*)(mod + (size_t)set * 6144) + lane; const f32x4* scp = shp + DM / 4;
        u32x2* ho = (u32x2*)(H + (size_t)m * DM) + lane;
#pragma unroll
        for (int j = 0; j < 4; ++j) ho[64 * j] = pk4((v[j] * rstd) * gp[64 * j] * (scp[64 * j] + 1.0f) + shp[64 * j]);
    }
#undef N1_LOAD
}

__device__ __forceinline__ float swz_xor4(float v) { return __builtin_bit_cast(float, __builtin_amdgcn_ds_swizzle(__builtin_bit_cast(int, v), 0x101F)); }
__device__ __forceinline__ float swz_xor8(float v) { return __builtin_bit_cast(float, __builtin_amdgcn_ds_swizzle(__builtin_bit_cast(int, v), 0x201F)); }
__device__ __forceinline__ void phase_qkprep(const Ctx& C, int layer, int gw, int NGW, int lane, bf16_t* PO) {
    const bf16_t* P = (const bf16_t*)(C.ws + WS_P);
    const int hs = lane >> 3, j = lane & 7;
    const int col0 = (hs < 4 ? C_WQ + 64 * hs : hs < 6 ? C_WK + 64 * (hs - 4) : C_GQ + 64 * (hs - 6)) + 8 * j;
    const int col1 = (hs < 2 ? C_GQ + 128 + 64 * hs : C_GK + 64 * ((hs - 2) & 1)) + 8 * j;
    float g0[8], g1[8], inv[8];
    { const float* wg = C.win_gain() + layer * 128; const float* gg = C.glb_gain() + layer * 128;
      const float* s0p = hs < 4 ? wg : hs < 6 ? wg + 64 : gg; const float sc0 = (hs < 4 || hs >= 6) ? QSCALE : 1.f;
      const float* s1p = hs < 2 ? gg : gg + 64; const float sc1 = hs < 2 ? QSCALE : 1.f;
#pragma unroll
      for (int i = 0; i < 8; ++i) { g0[i] = s0p[8 * j + i] * sc0; g1[i] = s1p[8 * j + i] * sc1; inv[i] = exp2f(-(float)(8 * (j & 1) + i) * (13.287712379549449f / 16.0f)); } }
    const bool x2 = (j & 2) != 0, colax = (j & 4) != 0, act1 = lane < 32;
    u32x4 w0 = {0u, 0u, 0u, 0u}, w1 = {0u, 0u, 0u, 0u};
    if (gw < MROWS) { const bf16_t* row = P + (size_t)gw * DIN; w0 = *(const u32x4*)(row + col0); if (act1) w1 = *(const u32x4*)(row + col1); }
    for (int m = gw; m < MROWS; m += NGW) {
        const u32x4 c0 = w0, c1 = w1;
        if (m + NGW < MROWS) { const bf16_t* row = P + (size_t)(m + NGW) * DIN; w0 = *(const u32x4*)(row + col0); if (act1) w1 = *(const u32x4*)(row + col1); }
        const int b = m / TPB, t = m - b * TPB; const bool isx = t >= CTX; const int pos = t - CTX;
        float cs[8], sn[8];
        if (isx) { const float pv = (float)(colax ? (pos & 63) : (pos >> 6));
#pragma unroll
            for (int i = 0; i < 8; ++i) { const float ang = pv * inv[i]; cs[i] = __cosf(ang); sn[i] = x2 ? __sinf(ang) : -__sinf(ang); } }
        else {
#pragma unroll
            for (int i = 0; i < 8; ++i) { cs[i] = 1.f; sn[i] = 0.f; } }
        bf16_t* orow = PO + (size_t)m * (PO == P ? DIN : 256);
#pragma unroll
        for (int pass = 0; pass < 2; ++pass) {
            const u32x4 w = pass ? c1 : c0;
            float x[8] = {bflo(w.x), bfhi(w.x), bflo(w.y), bfhi(w.y), bflo(w.z), bfhi(w.z), bflo(w.w), bfhi(w.w)};
            float ss = 0.f;
#pragma unroll
            for (int i = 0; i < 8; ++i) ss += x[i] * x[i];
            ss += xor1(ss); ss += xor2(ss); ss += swz_xor4(ss);
            const float r = 1.0f / sqrtf(ss * (1.f / 64.f) + EPS);
            float y[8];
#pragma unroll
            for (int i = 0; i < 8; ++i) { x[i] = x[i] * r * (pass ? g1[i] : g0[i]); }
#pragma unroll
            for (int i = 0; i < 8; ++i) { const float pr = xor2(x[i]); y[i] = x[i] * cs[i] + pr * sn[i]; }
            u32x4 o; o.x = pk2(y[0], y[1]); o.y = pk2(y[2], y[3]); o.z = pk2(y[4], y[5]); o.w = pk2(y[6], y[7]);
            const int col = pass ? col1 : col0;
            if (pass == 0 || act1) *(u32x4*)(orow + (PO == P ? col : (col & 127))) = o;
        }
    }
}

__device__ __forceinline__ unsigned off_v(unsigned row, unsigned ch) { return 256u * row + 16u * (ch ^ (((row & 3) << 2) | ((row >> 2) & 3))); }
__device__ __forceinline__ unsigned off_k(unsigned row, unsigned ch) { return 128u * row + 16u * (ch ^ (row & 7)); }
typedef short s16x4_t __attribute__((ext_vector_type(4)));
__device__ __forceinline__ s16x4_t tr_rd(const LAS unsigned char* p) { return __builtin_bit_cast(s16x4_t, __builtin_amdgcn_ds_read_tr16_b64_v4i16((LAS s16x4_t*)p)); }
template <bool KIMG> __device__ __forceinline__ bf16x8 tr_frag(const LAS unsigned char* img, int lane, int rbase, int r0off, int r1off, int cblk) {
    const unsigned blk = (lane >> 4) & 1, q = (lane & 15) >> 2, pp = lane & 3, ch = 4 * cblk + 2 * blk + (pp >> 1);
    const unsigned ra = rbase + r0off + q, rb = rbase + r1off + q;
    const s16x4_t lo = tr_rd(img + (KIMG ? off_k(ra, ch) : off_v(ra, ch)) + 8 * (pp & 1)), hi = tr_rd(img + (KIMG ? off_k(rb, ch) : off_v(rb, ch)) + 8 * (pp & 1));
    return (bf16x8){lo[0], lo[1], lo[2], lo[3], hi[0], hi[1], hi[2], hi[3]};
}
__device__ __forceinline__ void stage_v(const bf16_t* P, size_t r0, int h, LAS unsigned char* img, int tid) {
#pragma unroll
    for (int i = 0; i < 4; ++i) { const int p_ = tid + 512 * i, j = p_ >> 4, ch = p_ & 15;
        *(LAS u32x4*)(img + off_v(j, ch)) = *(const u32x4*)(P + (r0 + j) * DIN + C_RV + h * 128 + 8 * ch); }
}
__device__ __forceinline__ void ret_r1_all(const Ctx& C, int layer, int bx, int G, LAS unsigned char* lds, int tid) {
    int lane = tid & 63; asm volatile("" : "+v"(lane));
    const int wid = tid >> 6;
    const bf16_t* P = (const bf16_t*)(C.ws + WS_P); float* KVT = (float*)(C.ws + WS_H);
    LAS unsigned char* Vi = lds; LAS unsigned char* Kf = lds + 32768; LAS unsigned char* Kb = lds + 49152;
    const float* dec = C.ret_decay() + layer * 8;
    const int NU = NB * 4 * NCH;
    int u = bx; if (u >= NU) return;
    u32x4 kreg[2], vreg[4];
#define R1_LOAD(u_) do { const int c_ = (u_) % NCH, bh_ = (u_) / NCH, h_ = bh_ & 3; const size_t r0_ = (size_t)(bh_ >> 2) * TPB + c_ * 128; \
        _Pragma("unroll") for (int i = 0; i < 2; ++i) { const int p_ = tid + 512 * i, j = p_ >> 3, ch = p_ & 7; kreg[i] = *(const u32x4*)(P + (r0_ + j) * DIN + C_RK + h_ * 64 + 8 * ch); } \
        _Pragma("unroll") for (int i = 0; i < 4; ++i) { const int p_ = tid + 512 * i, j = p_ >> 4, ch = p_ & 15; vreg[i] = *(const u32x4*)(P + (r0_ + j) * DIN + C_RV + h_ * 128 + 8 * ch); } } while (0)
    R1_LOAD(u);
    for (;;) {
        const int c = u % NCH, bh = u / NCH, b = bh >> 2, h = bh & 3;
        const float lf = log2_sigmoid(dec[h]), lb = log2_sigmoid(dec[4 + h]);
#pragma unroll
        for (int i = 0; i < 2; ++i) { const int p_ = tid + 512 * i, j = p_ >> 3, ch = p_ & 7; const u32x4 w = kreg[i];
            const float zf = exp2f((float)(127 - j) * lf) * 0.125f, zb = exp2f((float)j * lb) * 0.125f;
            const float x[8] = {bflo(w.x), bfhi(w.x), bflo(w.y), bfhi(w.y), bflo(w.z), bfhi(w.z), bflo(w.w), bfhi(w.w)};
            u32x4 of, ob; of.x = pk2(x[0] * zf, x[1] * zf); of.y = pk2(x[2] * zf, x[3] * zf); of.z = pk2(x[4] * zf, x[5] * zf); of.w = pk2(x[6] * zf, x[7] * zf);
            ob.x = pk2(x[0] * zb, x[1] * zb); ob.y = pk2(x[2] * zb, x[3] * zb); ob.z = pk2(x[4] * zb, x[5] * zb); ob.w = pk2(x[6] * zb, x[7] * zb);
            *(LAS u32x4*)(Kf + off_k(j, ch)) = of; *(LAS u32x4*)(Kb + off_k(j, ch)) = ob; }
#pragma unroll
        for (int i = 0; i < 4; ++i) { const int p_ = tid + 512 * i, j = p_ >> 4, ch = p_ & 15; *(LAS u32x4*)(Vi + off_v(j, ch)) = vreg[i]; }
        const int un = u + G;
        if (un < NU) R1_LOAD(un);
        __syncthreads();
        const int mb = wid >> 1, nb = wid & 1, r = lane & 31, hh = lane >> 5;
        float z0 = 0.f; asm volatile("" : "+v"(z0)); f32x16 af, ab;
#pragma unroll
        for (int i = 0; i < 16; ++i) { af[i] = z0; ab[i] = z0; }
#pragma unroll
        for (int ks = 0; ks < 8; ++ks) {
            const bf16x8 a = tr_frag<false>(Vi, lane, 16 * ks + 8 * hh, 0, 4, mb);
            const bf16x8 bf = tr_frag<true>(Kf, lane, 16 * ks + 8 * hh, 0, 4, nb);
            const bf16x8 bb = tr_frag<true>(Kb, lane, 16 * ks + 8 * hh, 0, 4, nb);
            af = __builtin_amdgcn_mfma_f32_32x32x16_bf16(a, bf, af, 0, 0, 0);
            ab = __builtin_amdgcn_mfma_f32_32x32x16_bf16(a, bb, ab, 0, 0, 0);
        }
        float* of = KVT + ((size_t)((0 * NB + b) * 4 + h) * NCH + c) * 8192; float* ob = KVT + ((size_t)((1 * NB + b) * 4 + h) * NCH + c) * 8192;
#pragma unroll
        for (int reg = 0; reg < 16; ++reg) { const int dv = 32 * mb + (reg & 3) + 8 * (reg >> 2) + 4 * hh, dk = 32 * nb + r; of[dv * 64 + dk] = af[reg]; ob[dv * 64 + dk] = ab[reg]; }
        __syncthreads();
        if (un >= NU) break;
        u = un;
    }
#undef R1_LOAD
}
__device__ __forceinline__ void ret_r2_unit(const Ctx& C, int layer, int u, int tid) {
    const int q = u & 3, bh = (u >> 2) & 63, dir = u >> 8, b = bh >> 2, h = bh & 3;
    const float G = exp2f(128.f * log2_sigmoid(C.ret_decay()[(layer * 2 + dir) * 4 + h]));
    const size_t base = ((size_t)((dir * NB + b) * 4 + h) * NCH) * 8192 + q * 2048 + tid * 4;
    const float* KVT = (const float*)(C.ws + WS_H) + base; bf16_t* ST = (bf16_t*)(C.ws + WS_YP) + base;
    float z0 = 0.f; asm volatile("" : "+v"(z0)); f32x4 S = {z0, z0, z0, z0};
#pragma unroll
    for (int half = 0; half < 2; ++half) {
        f32x4 kv[17];
#pragma unroll
        for (int s = 0; s < 17; ++s) { const int step = half * 17 + s; const int c = dir == 0 ? step : (step < 2 ? 1 - step : 35 - step); kv[s] = *(const f32x4*)(KVT + (size_t)c * 8192); }
#pragma unroll
        for (int s = 0; s < 17; ++s) { const int step = half * 17 + s; const int c = dir == 0 ? step : (step < 2 ? 1 - step : 35 - step);
            u32x2 w; w.x = pk2(S[0], S[1]); w.y = pk2(S[2], S[3]); *(u32x2*)(ST + (size_t)c * 8192) = w;
            S = S * G + kv[s]; }
    }
}
__device__ __forceinline__ void ret_r3_all(const Ctx& C, int layer, int bx, int G, LAS unsigned char* lds, int tid) {
    int lane = tid & 63; asm volatile("" : "+v"(lane));
    const int wid = tid >> 6, r = lane & 31, hh = lane >> 5, ib = wid & 3, dh = wid >> 2;
    const bf16_t* P = (const bf16_t*)(C.ws + WS_P);
    LAS unsigned char* Vi = lds;
    LAS float* Ol = (LAS float*)(lds + 32768);
    const float* dec = C.ret_decay() + layer * 8;
    const int NU = NB * 4 * NCH; const bool skipc = layer == DEPTH - 1;
#define R3_NEXT(u_) do { (u_) += G; while ((u_) < NU && skipc && ((u_) % NCH) < 2) (u_) += G; } while (0)
#define R3_ZERO(v) do { float z_ = 0.f; asm volatile("" : "+v"(z_)); _Pragma("unroll") for (int i_ = 0; i_ < 16; ++i_) v[i_] = z_; } while (0)
    int u = bx - G; R3_NEXT(u); if (u >= NU) return;
    u32x4 vreg[4]; bf16x8 qf[4], kf[2][4];
#define R3_LOAD_A(u_) do { const int c_ = (u_) % NCH, bh_ = (u_) / NCH, h_ = bh_ & 3; const size_t r0_ = (size_t)(bh_ >> 2) * TPB + c_ * 128; \
        _Pragma("unroll") for (int i = 0; i < 4; ++i) { const int p_ = tid + 512 * i, j = p_ >> 4, ch = p_ & 15; vreg[i] = *(const u32x4*)(P + (r0_ + j) * DIN + C_RV + h_ * 128 + 8 * ch); } \
        { const bf16_t* Qp = P + (r0_ + 32 * ib + r) * DIN + C_RQ + h_ * 64 + 8 * hh; _Pragma("unroll") for (int ks = 0; ks < 4; ++ks) qf[ks] = *(const bf16x8*)(Qp + 16 * ks); } \
        _Pragma("unroll") for (int jb = 0; jb < 2; ++jb) { const bf16_t* Kp = P + (r0_ + 32 * jb + r) * DIN + C_RK + h_ * 64 + 8 * hh; \
            _Pragma("unroll") for (int ks = 0; ks < 4; ++ks) kf[jb][ks] = *(const bf16x8*)(Kp + 16 * ks); } } while (0)
    R3_LOAD_A(u);
    unsigned lp[2][2];
    { const unsigned blk = (lane >> 4) & 1, q = (lane & 15) >> 2, pp = lane & 3;
#pragma unroll
      for (int t = 0; t < 2; ++t)
#pragma unroll
          for (int cb = 0; cb < 2; ++cb) lp[t][cb] = off_v(4 * hh + 8 * t + q, 4 * (2 * dh + cb) + 2 * blk + (pp >> 1)) + 8 * (pp & 1); }
    for (;;) {
        const int c = u % NCH, bh = u / NCH, b = bh >> 2, h = bh & 3;
        const float lf = log2_sigmoid(dec[h]), lb = log2_sigmoid(dec[4 + h]);
        const size_t r0 = (size_t)b * TPB + c * 128;
        int rq = r, hq = hh; asm volatile("" : "+v"(rq), "+v"(hq));
#pragma unroll
        for (int i = 0; i < 4; ++i) { const int p_ = tid + 512 * i, j = p_ >> 4, ch = p_ & 15; *(LAS u32x4*)(Vi + off_v(j, ch)) = vreg[i]; }
        bf16x8 st[2][4]; u32x4 gwv[4];
        { const bf16_t* sf = (const bf16_t*)(C.ws + WS_YP) + ((size_t)((0 * NB + b) * 4 + h) * NCH + c) * 8192 + (64 * dh + r) * 64 + 8 * hh;
#pragma unroll
          for (int t = 0; t < 2; ++t)
#pragma unroll
              for (int ks = 0; ks < 4; ++ks) st[t][ks] = *(const bf16x8*)(sf + t * 32 * 64 + 16 * ks); }
        __syncthreads();
        f32x16 o[2]; R3_ZERO(o[0]); R3_ZERO(o[1]);
#pragma unroll
        for (int jb = 0; jb < 4; ++jb) {
            if (jb == 1 || jb == 3) {
                const int dir = jb >> 1; f32x16 acc[2];
#pragma unroll
                for (int t = 0; t < 2; ++t) { R3_ZERO(acc[t]);
#pragma unroll
                    for (int ks = 0; ks < 4; ++ks) acc[t] = __builtin_amdgcn_mfma_f32_32x32x16_bf16(qf[ks], st[t][ks], acc[t], 0, 0, 0); }
#pragma unroll
                for (int reg = 0; reg < 16; ++reg) { const int i = 32 * ib + (reg & 3) + 8 * (reg >> 2) + 4 * hq; const float xi = dir == 0 ? __builtin_amdgcn_exp2f((float)(i + 1) * lf) : __builtin_amdgcn_exp2f((float)(128 - i) * lb);
                    o[0][reg] += xi * acc[0][reg]; o[1][reg] += xi * acc[1][reg]; }
                CBAR();
                if (jb == 1) { const bf16_t* sb = (const bf16_t*)(C.ws + WS_YP) + ((size_t)((1 * NB + b) * 4 + h) * NCH + c) * 8192 + (64 * dh + r) * 64 + 8 * hh;
#pragma unroll
                    for (int t = 0; t < 2; ++t)
#pragma unroll
                        for (int ks = 0; ks < 4; ++ks) st[t][ks] = *(const bf16x8*)(sb + t * 32 * 64 + 16 * ks); } }
            f32x16 x; R3_ZERO(x);
#pragma unroll
            for (int ks = 0; ks < 4; ++ks) x = __builtin_amdgcn_mfma_f32_32x32x16_bf16(kf[jb & 1][ks], qf[ks], x, 0, 0, 0);
            if (jb < 2) { const bf16_t* Kp = P + (r0 + 32 * (jb + 2) + r) * DIN + C_RK + h * 64 + 8 * hh;
#pragma unroll
                for (int ks = 0; ks < 4; ++ks) kf[jb & 1][ks] = *(const bf16x8*)(Kp + 16 * ks); }
#pragma unroll
            for (int reg = 0; reg < 16; ++reg) { const int d = (32 * ib + rq) - (32 * jb + (reg & 3) + 8 * (reg >> 2) + 4 * hq);
                const float D = d > 0 ? __builtin_amdgcn_exp2f((float)d * lf) : (d < 0 ? __builtin_amdgcn_exp2f((float)(-d) * lb) : 2.0f); x[reg] *= 0.125f * D; }
#pragma unroll
            for (int s = 0; s < 2; ++s) {
                u32x4 pw; pw.x = pk2(x[8 * s + 0], x[8 * s + 1]); pw.y = pk2(x[8 * s + 2], x[8 * s + 3]); pw.z = pk2(x[8 * s + 4], x[8 * s + 5]); pw.w = pk2(x[8 * s + 6], x[8 * s + 7]);
                const bf16x8 pa = __builtin_bit_cast(bf16x8, pw);
#pragma unroll
                for (int cb = 0; cb < 2; ++cb) { const s16x4_t lo = tr_rd(Vi + lp[0][cb] + (8192 * jb + 4096 * s)), hi = tr_rd(Vi + lp[1][cb] + (8192 * jb + 4096 * s));
                    const bf16x8 vb = (bf16x8){lo[0], lo[1], lo[2], lo[3], hi[0], hi[1], hi[2], hi[3]};
                    o[cb] = __builtin_amdgcn_mfma_f32_32x32x16_bf16(pa, vb, o[cb], 0, 0, 0); }
            }
            CBAR();
        }
        { const bf16_t* gp = P + (r0 + (tid >> 2)) * DIN + C_RG + h * 128 + 32 * (tid & 3);
#pragma unroll
          for (int e2 = 0; e2 < 4; ++e2) gwv[e2] = *(const u32x4*)(gp + 8 * e2); }
#pragma unroll
        for (int cb = 0; cb < 2; ++cb)
#pragma unroll
            for (int reg = 0; reg < 16; ++reg) { const int i = 32 * ib + (reg & 3) + 8 * (reg >> 2) + 4 * hh, dv = 64 * dh + 32 * cb + r; Ol[i * 132 + dv] = o[cb][reg]; }
        __syncthreads();
        int un = u; R3_NEXT(un);
        if (un < NU) R3_LOAD_A(un);
        CBAR();
        { const int row = tid >> 2, q = tid & 3; f32x4 x[8]; float sm = 0.f;
#pragma unroll
          for (int e = 0; e < 8; ++e) { x[e] = *(const LAS f32x4*)(Ol + row * 132 + 32 * q + 4 * e); sm += (x[e][0] + x[e][1]) + (x[e][2] + x[e][3]); }
          sm += xor1(sm); sm += xor2(sm);
          const float mu = sm * (1.f / 128.f); float vs = 0.f;
#pragma unroll
          for (int e = 0; e < 8; ++e) { x[e] = x[e] - mu; vs += (x[e][0] * x[e][0] + x[e][1] * x[e][1]) + (x[e][2] * x[e][2] + x[e][3] * x[e][3]); }
          vs += xor1(vs); vs += xor2(vs);
          const float rstd = 1.0f / sqrtf(vs * (1.f / 128.f) + EPS);
          bf16_t* yp = (bf16_t*)(C.ws + WS_Y) + (r0 + row) * DM + h * 128 + 32 * q;
#pragma unroll
          for (int e2 = 0; e2 < 4; ++e2) { const u32x4 gw = gwv[e2]; const f32x4 a = x[2 * e2] * rstd, bq = x[2 * e2 + 1] * rstd;
              u32x4 ow; ow.x = pk2(a[0] * silu_f(bflo(gw.x)), a[1] * silu_f(bfhi(gw.x))); ow.y = pk2(a[2] * silu_f(bflo(gw.y)), a[3] * silu_f(bfhi(gw.y)));
              ow.z = pk2(bq[0] * silu_f(bflo(gw.z)), bq[1] * silu_f(bfhi(gw.z))); ow.w = pk2(bq[2] * silu_f(bflo(gw.w)), bq[3] * silu_f(bfhi(gw.w)));
              *(u32x4*)(yp + 8 * e2) = ow; } }
        if (un >= NU) break;
        u = un;
    }
#undef R3_NEXT
#undef R3_ZERO
#undef R3_LOAD_A
}

template <bool WIN>
__device__ __forceinline__ void attn_dispatch(const Ctx& C, int layer, int U, int tid, char* lds) {
    using attn_body::bf16;
    int b, h, q0, NT, tdelta;
    if (U < 1024) { b = U >> 6; h = ((U >> 5) & 1) * 2 + ((U >> 4) & 1); q0 = CTX + 256 * (U & 15);
        if (WIN) { const int ts = (q0 / 64 - 2) > 4 ? (q0 / 64 - 2) : 4, te = (q0 / 64 + 6) < 68 ? (q0 / 64 + 6) : 68; NT = 4 + te - ts; tdelta = ts - 4; } else { NT = 68; tdelta = 0; } }
    else { b = (U - 1024) >> 2; h = (U - 1024) & 3; q0 = 0; NT = 4; tdelta = 0; }
    const int kvh = h >> 1;
    const bf16* Pb = (const bf16*)(C.ws + WS_P) + (size_t)b * TPB * DIN; bf16* Yb = (bf16*)(C.ws + WS_Y) + (size_t)b * TPB * DM;
    if (WIN) attn_body::attn_unit<8, true>(Pb + C_WQ + 64 * h, Pb + C_WK + 64 * kvh, Pb + C_WV + 64 * kvh, Yb + 512 + 64 * h, q0, NT, tdelta, C.win_sink()[layer * 4 + h] * LOG2E, tid, lds);
    else     attn_body::attn_unit<8, false>(Pb + C_GQ + 64 * h, Pb + C_GK + 64 * kvh, Pb + C_GV + 64 * kvh, Yb + 768 + 64 * h, q0, NT, tdelta, 0.f, tid, lds);
}
template <bool WIN>
__device__ __forceinline__ void attn_units(const Ctx& C, int layer, int G, int vcu, int bx, int tid, char* lds) {
    const int nctx = (layer == DEPTH - 1) ? 0 : 64;
    if (G == 256) {
        for (int k = 0; k < 4; ++k) attn_dispatch<WIN>(C, layer, vcu * 4 + k, tid, lds);
        if (vcu < nctx) attn_dispatch<WIN>(C, layer, 1024 + vcu, tid, lds);
    } else {
        for (int U = bx; U < 1024 + nctx; U += G) attn_dispatch<WIN>(C, layer, U, tid, lds);
    }
}

__device__ __forceinline__ f32x2 swap32(float a, float b) { auto r = __builtin_amdgcn_permlane32_swap(__builtin_bit_cast(unsigned, a), __builtin_bit_cast(unsigned, b), false, false);
    return (f32x2){__builtin_bit_cast(float, (unsigned)r[0]), __builtin_bit_cast(float, (unsigned)r[1])}; }
__device__ __forceinline__ f32x2 swap16(float a, float b) { auto r = __builtin_amdgcn_permlane16_swap(__builtin_bit_cast(unsigned, a), __builtin_bit_cast(unsigned, b), false, false);
    return (f32x2){__builtin_bit_cast(float, (unsigned)r[0]), __builtin_bit_cast(float, (unsigned)r[1])}; }
__device__ __forceinline__ void phase_norm2_route(const Ctx& C, int layer_c, LAS unsigned char* lds, int G, int bx, int tid) {
    const int layer = layer_c & 3;
    const int lane = tid & 63, wave = tid >> 6;
    const float* mod = (const float*)(C.ws + WS_MOD) + (size_t)layer * 17 * 6144;
    const float* gain = C.norm2() + layer * DM;
    const bf16_t* XR = (const bf16_t*)(C.ws + WS_X32); unsigned char* H = (unsigned char*)(C.ws + WS_H);
    int* list = (int*)(C.ws + WS_LIST);
    unsigned* gcnt = (unsigned*)(C.ws + WS_CTL) + CW_CNT + 64 * layer_c;
    constexpr int RPC = MROWS / 256, RPW = RPC / 8;
    LAS float* wrT = (LAS float*)lds;
    LAS float* lgs = (LAS float*)(lds + 65536);
    LAS int* lcnt = (LAS int*)(lds + 65536 + RPC * 64);
    LAS int* lbase = lcnt + 16;
    LAS int* rec_e = lcnt + 32;
    LAS float* rec_w = (LAS float*)(rec_e + 2 * RPC);
    { const float* wr = C.w_router(); for (int i = tid; i < DM * NE; i += 512) { const int k = i >> 4, e = i & 15; wrT[e * DM + k] = wr[i]; } }
    if (tid < 16) lcnt[tid] = 0;
    __syncthreads();
    const unsigned lo4 = (unsigned)lane * 4u, lo8 = (unsigned)lane * 8u, lo16 = (unsigned)lane * 16u;
#define E_LOADROW(dst, mm) do { const char* xr_ = (const char*)(XR + (size_t)(mm) * DM); _Pragma("unroll") for (int j = 0; j < 4; ++j) dst[j] = *(const u32x2*)(xr_ + (lo8 + 512u * j)); } while (0)
#define E_NORMROW(v, nxr, mm) do { float ss_ = 0.f; _Pragma("unroll") for (int j = 0; j < 4; ++j) { v[j] = bf4(nxr[j]); ss_ += (v[j][0] * v[j][0] + v[j][1] * v[j][1]) + (v[j][2] * v[j][2] + v[j][3] * v[j][3]); } \
        const int b_ = (mm) / TPB, t_ = (mm) - b_ * TPB, set_ = t_ < CTX ? 16 : b_; const float rstd_ = 1.0f / sqrtf(wave_sum(ss_) * (1.f / DM) + EPS); \
        const char* gp_ = (const char*)gain; const char* shp_ = (const char*)(mod + (size_t)set_ * 6144 + 3 * DM); const char* scp_ = shp_ + DM * 4; \
        char* ho_ = (char*)(H + (size_t)(mm) * DM); \
        _Pragma("unroll") for (int j = 0; j < 4; ++j) { v[j] = (v[j] * rstd_) * *(const f32x4*)(gp_ + (lo16 + 1024u * j)) * (*(const f32x4*)(scp_ + (lo16 + 1024u * j)) + 1.0f) + *(const f32x4*)(shp_ + (lo16 + 1024u * j)); \
            *(unsigned*)(ho_ + (lo4 + 256u * j)) = pk4_fp8(v[j][0], v[j][1], v[j][2], v[j][3]); } } while (0)
#define E_REDUCE(pe, rowl) do { float q8_[8], q4_[4], q2_[2]; \
        _Pragma("unroll") for (int e = 0; e < 8; ++e) { const f32x2 r_ = swap32(pe[e], pe[e + 8]); q8_[e] = r_[0] + r_[1]; } \
        _Pragma("unroll") for (int e = 0; e < 4; ++e) { const f32x2 r_ = swap16(q8_[e], q8_[e + 4]); q4_[e] = r_[0] + r_[1]; } \
        _Pragma("unroll") for (int e = 0; e < 2; ++e) { const float keep_ = b3 ? q4_[e + 2] : q4_[e], send_ = b3 ? q4_[e] : q4_[e + 2]; q2_[e] = keep_ + swz_xor8(send_); } \
        float lg_ = (b2 ? q2_[1] : q2_[0]) + swz_xor4(b2 ? q2_[0] : q2_[1]); lg_ += xor2(lg_); lg_ += xor1(lg_); \
        if ((lane & 3) == 0) lgs[(rowl) * 16 + (lane >> 2)] = lg_; } while (0)
    const bool b3 = (lane & 8) != 0, b2 = (lane & 4) != 0;
    for (int chunk = bx; chunk < 256; chunk += G) {
        const int m0 = chunk * RPC + wave * RPW;
        u32x2 nxA[4], nxB[4], fxA[4], fxB[4];
        E_LOADROW(nxA, m0); E_LOADROW(nxB, m0 + 1); E_LOADROW(fxA, m0 + 2); E_LOADROW(fxB, m0 + 3);
        for (int i = 0; i < RPW; i += 2) {
            f32x4 vA[4], vB[4];
            E_NORMROW(vA, nxA, m0 + i);
            E_NORMROW(vB, nxB, m0 + i + 1);
#pragma unroll
            for (int j = 0; j < 4; ++j) { nxA[j] = fxA[j]; nxB[j] = fxB[j]; }
            if (i + 4 < RPW) { E_LOADROW(fxA, m0 + i + 4); E_LOADROW(fxB, m0 + i + 5); }
            float peA[16], peB[16];
            f32x2 hv[4][4];
#pragma unroll
            for (int j = 0; j < 4; ++j)
#pragma unroll
                for (int c = 0; c < 4; ++c) hv[j][c] = (f32x2){vA[j][c], vB[j][c]};
            const LAS float* wl = wrT + 4 * lane; asm volatile("" : "+v"(wl));
#pragma unroll
            for (int e = 0; e < 16; ++e) { f32x2 a2 = {0.f, 0.f};
#pragma unroll
                for (int j = 0; j < 4; ++j) { const f32x4 w = *(const LAS f32x4*)(wl + e * DM + 256 * j);
#pragma unroll
                    for (int c = 0; c < 4; ++c) a2 = __builtin_elementwise_fma(hv[j][c], (f32x2){w[c], w[c]}, a2); }
                peA[e] = a2[0]; peB[e] = a2[1]; }
            E_REDUCE(peA, wave * RPW + i); E_REDUCE(peB, wave * RPW + i + 1);
        }
#undef E_LOADROW
#undef E_NORMROW
#undef E_REDUCE
        asm volatile("s_waitcnt lgkmcnt(0)" ::: "memory");
        const int mrow_ = chunk * RPC + wave * RPW + lane;
        if (lane < RPW && !(layer == DEPTH - 1 && (mrow_ % TPB) < CTX)) {
            const int rl = wave * RPW + lane; const float* br = C.b_router();
            float sg[16], bs[16];
#pragma unroll
            for (int e4 = 0; e4 < 4; ++e4) { const f32x4 l4 = *(const LAS f32x4*)(lgs + rl * 16 + 4 * e4);
#pragma unroll
                for (int k = 0; k < 4; ++k) { sg[4 * e4 + k] = 1.f / (1.f + expf(-l4[k])); bs[4 * e4 + k] = sg[4 * e4 + k] + br[4 * e4 + k]; } }
            int grp = 0; float best = -1e30f;
#pragma unroll
            for (int g = 0; g < 4; ++g) { const float a0 = bs[4 * g], a1 = bs[4 * g + 1], a2 = bs[4 * g + 2], a3 = bs[4 * g + 3];
                const float hi01 = fmaxf(a0, a1), lo01 = fminf(a0, a1), hi23 = fmaxf(a2, a3), lo23 = fminf(a2, a3);
                const float top = fmaxf(hi01, hi23), second = fmaxf(fminf(hi01, hi23), hi01 >= hi23 ? lo01 : lo23);
                const float sc = top + second; if (sc > best) { best = sc; grp = g; } }
            float c4[4], s4[4];
#pragma unroll
            for (int k = 0; k < 4; ++k) { c4[k] = grp == 0 ? bs[k] : grp == 1 ? bs[4 + k] : grp == 2 ? bs[8 + k] : bs[12 + k]; s4[k] = grp == 0 ? sg[k] : grp == 1 ? sg[4 + k] : grp == 2 ? sg[8 + k] : sg[12 + k]; }
            int l0 = 0; float mx0 = c4[0];
#pragma unroll
            for (int k = 1; k < 4; ++k) if (c4[k] > mx0) { mx0 = c4[k]; l0 = k; }
            int l1 = -1; float mx1 = -1e30f;
#pragma unroll
            for (int k = 0; k < 4; ++k) if (k != l0 && c4[k] > mx1) { mx1 = c4[k]; l1 = k; }
            const float w0 = l0 == 0 ? s4[0] : l0 == 1 ? s4[1] : l0 == 2 ? s4[2] : s4[3], w1 = l1 == 0 ? s4[0] : l1 == 1 ? s4[1] : l1 == 2 ? s4[2] : s4[3];
            const float wn = 1.f / (w0 + w1);
            const int e0 = grp * 4 + l0, e1 = grp * 4 + l1;
            const int p0 = __hip_atomic_fetch_add(lcnt + e0, 1, __ATOMIC_RELAXED, __HIP_MEMORY_SCOPE_WORKGROUP);
            const int p1 = __hip_atomic_fetch_add(lcnt + e1, 1, __ATOMIC_RELAXED, __HIP_MEMORY_SCOPE_WORKGROUP);
            rec_e[2 * rl] = e0 | (p0 << 8); rec_e[2 * rl + 1] = e1 | (p1 << 8); rec_w[2 * rl] = w0 * wn; rec_w[2 * rl + 1] = w1 * wn;
        } else if (lane < RPW) { const int rl = wave * RPW + lane; rec_e[2 * rl] = -1; rec_e[2 * rl + 1] = -1; }
        __syncthreads();
        if (tid < 16) lbase[tid] = (int)__hip_atomic_fetch_add(gcnt + tid, (unsigned)lcnt[tid], __ATOMIC_RELAXED, __HIP_MEMORY_SCOPE_AGENT);
        __syncthreads();
        for (int i = tid; i < 2 * RPC; i += 512) { const int re = rec_e[i]; if (re < 0) continue; const int e = re & 255, pp = re >> 8; const int id = (chunk * RPC + (i >> 1)) * 2 + (i & 1);
            list[e * MROWS + lbase[e] + pp] = id | ((int)(rec_w[i] * 16383.f + 0.5f) << 18); }
        __syncthreads();
        if (tid < 16) lcnt[tid] = 0;
        __syncthreads();
    }
}

template <bool GATHER_, int NT>
struct MoeOrder {
    static constexpr bool GATHER = GATHER_;
    const int* list; const LAS int* boff; const LAS int* cnt; int G, c;
    __device__ __forceinline__ bool next(int i, pg8::Unit& u) const {
        const int L = i * G + c; if (L >= boff[16] * NT) return false;
        const int blk = L / NT, pn = L - blk * NT; int e = 0;
#pragma unroll
        for (int k = 1; k < 16; ++k) e += (blk >= boff[k]) ? 1 : 0;
        u.pm = blk; u.pn = e * NT + pn; return true;
    }
    __device__ __forceinline__ unsigned arow(const pg8::Unit& u, int r) const {
        const int e = u.pn / NT, li = (u.pm - boff[e]) * 256 + r;
        const int id = li < cnt[e] ? (list[e * MROWS + li] & 0x3FFFF) : 0;
        return (unsigned)(id >> 1);
    }
    __device__ __forceinline__ const int* aptr(const pg8::Unit& u, int r) const { const int e = u.pn / NT, li = (u.pm - boff[e]) * 256 + r; return list + e * MROWS + (li < cnt[e] ? li : 0); }
    __device__ __forceinline__ unsigned tokrow(unsigned w) const { return (w & 0x3FFFFu) >> 1; }
};
struct EpiGateUp {
    static constexpr bool PERM = true, HAS_PRE = false;
    unsigned char* O;
    __device__ __forceinline__ void operator()(const f32x4 (&acc)[2][2][4][2], const pg8::Unit& u, int wr, int wc, int fr, int fq) const {
        const int row0 = u.pm * 256 + wr * 64 + fr, col0 = (u.pn & 7) * 128 + wc * 32 + 8 * fq;
#pragma unroll
        for (int ai = 0; ai < 2; ++ai)
#pragma unroll
            for (int m = 0; m < 4; ++m) { const f32x4 a0 = acc[ai][0][m][0] * W8_INV, a1 = acc[ai][0][m][1] * W8_INV, u0 = acc[ai][1][m][0] * W8_INV, u1 = acc[ai][1][m][1] * W8_INV;
                u32x2 w; w.x = pk4_fp8(silu_f(a0[0]) * u0[0], silu_f(a0[1]) * u0[1], silu_f(a0[2]) * u0[2], silu_f(a0[3]) * u0[3]);
                w.y = pk4_fp8(silu_f(a1[0]) * u1[0], silu_f(a1[1]) * u1[1], silu_f(a1[2]) * u1[2], silu_f(a1[3]) * u1[3]);
                *(u32x2*)(O + ((unsigned)(row0 + ai * 128 + m * 16) * (unsigned)FF + (unsigned)col0)) = w; }
    }
};
struct EpiDown {
    static constexpr bool PERM = true, HAS_PRE = true;
    unsigned char* YP; const int* list; const LAS int* boff; const LAS int* cnt;
    int ent[2][4];
    __device__ __forceinline__ void pre(const pg8::Unit& u, int wr, int fr) {
        const int e = u.pn >> 2, lb = (u.pm - boff[e]) * 256, n = cnt[e];
#pragma unroll
        for (int ai = 0; ai < 2; ++ai)
#pragma unroll
            for (int m = 0; m < 4; ++m) { const int li = lb + ai * 128 + wr * 64 + m * 16 + fr; const bool ok = li < n; const int w = list[e * MROWS + (ok ? li : 0)]; ent[ai][m] = ok ? w : -1; }
    }
    __device__ __forceinline__ void operator()(const f32x4 (&acc)[2][2][4][2], const pg8::Unit& u, int wr, int wc, int fr, int fq) const {
        const int col0 = (u.pn & 3) * 256 + wc * 32 + 8 * fq;
#pragma unroll
        for (int ai = 0; ai < 2; ++ai)
#pragma unroll
            for (int m = 0; m < 4; ++m) { const int w = ent[ai][m];
                if (w != -1) { const unsigned id = (unsigned)w & 0x3FFFFu; const float g = (float)((unsigned)w >> 18) * ((1.f / 16383.f) * W8_INV * YP_SCALE); const unsigned off = id * (unsigned)DM + (unsigned)col0;
#pragma unroll
                    for (int bj = 0; bj < 2; ++bj) { const f32x4 v0 = acc[ai][bj][m][0] * g, v1 = acc[ai][bj][m][1] * g;
                        u32x2 ww; ww.x = pk4_fp8(v0[0], v0[1], v0[2], v0[3]); ww.y = pk4_fp8(v1[0], v1[1], v1[2], v1[3]); *(u32x2*)(YP + off + bj * 128) = ww; } } }
    }
};
__device__ __forceinline__ void moe_offsets(const Ctx& C, int layer, LAS int* boff, LAS int* cnt, int tid) {
    if (tid < 16) cnt[tid] = (int)__hip_atomic_load((const unsigned*)(C.ws + WS_CTL) + CW_CNT + 64 * layer + tid, __ATOMIC_RELAXED, __HIP_MEMORY_SCOPE_AGENT);
    __syncthreads();
    if (tid == 0) { int acc = 0;
        for (int e = 0; e < 16; ++e) { boff[e] = acc; acc += (cnt[e] + 255) >> 8; }
        boff[16] = acc; }
    __syncthreads();
}

__device__ __forceinline__ void phase_final(const Ctx& C, int gw, int NGW, int lane) {
    const float* mod = (const float*)(C.ws + WS_MOD) + (size_t)(DEPTH - 1) * 17 * 6144;
    const bf16_t* XR = (const bf16_t*)(C.ws + WS_X32); const unsigned char* YP = (const unsigned char*)(C.ws + WS_YP);
    for (int r = gw; r < NB * SEQ; r += NGW) {
        const int b = r / SEQ, t = r - b * SEQ; const size_t m = (size_t)b * TPB + CTX + t;
        const u32x2* xr = (const u32x2*)(XR + m * DM) + lane; const unsigned* y0 = (const unsigned*)(YP + m * 2 * DM) + lane; const unsigned* y1 = y0 + DM / 4;
        const f32x4* g2 = (const f32x4*)(mod + (size_t)b * 6144 + 5 * DM) + lane; f32x4* o = (f32x4*)(C.out + (size_t)r * DM) + lane;
        unsigned a[4], bb[4]; u32x2 x[4];
#pragma unroll
        for (int j = 0; j < 4; ++j) { x[j] = xr[64 * j]; a[j] = y0[64 * j]; bb[j] = y1[64 * j]; }
#pragma unroll
        for (int j = 0; j < 4; ++j) o[64 * j] = bf4(x[j]) + (g2[64 * j] * YP_INV) * (fp8x4_f32(a[j]) + fp8x4_f32(bb[j]));
    }
}

#ifndef R3OFF
#define R3OFF 0
#endif
#ifndef WINOFF
#define WINOFF 0
#endif
#ifndef PHMASK
#define PHMASK 0xFFFF
#endif
#ifndef MK_ONE_LAUNCH
#define MK_ONE_LAUNCH 1
#endif
constexpr int PH_PER_LAYER = 9, PH_LAYER0 = 2, PH_FINAL = PH_LAYER0 + DEPTH * PH_PER_LAYER, PH_COUNT = PH_FINAL + 1;
struct Args { const float* in[18]; float* out; unsigned char* ws; int ph_lo, ph_hi, flags, pad; };
__global__ void __launch_bounds__(512, 2) mega_fwd(Args args) {
    extern __shared__ __attribute__((aligned(16))) unsigned char lds_raw[];
    LAS unsigned char* lds = (LAS unsigned char*)lds_raw;
    Ctx C; C.out = args.out; C.ws = args.ws;
    const int tid = threadIdx.x, lane = tid & 63, wave = __builtin_amdgcn_readfirstlane(tid >> 6);
    const int G = gridDim.x; const int bx = blockIdx.x; const int vcu = (G % 8 == 0) ? (bx % 8) * (G / 8) + bx / 8 : bx;
    const int gw = vcu * 8 + wave, NGW = G * 8;
    volatile LAS unsigned* MISC = (volatile LAS unsigned*)(lds + LDSCTL_OFF);
    for (int u = tid; u < (LDS_BYTES - LDSCTL_OFF) / 4; u += 512) ((LAS unsigned*)(lds + LDSCTL_OFF))[u] = 0u;
    __syncthreads();
    const int lo = args.ph_lo, hi = args.ph_hi;
    XcdBarrier bar; bar.bar = (unsigned*)(C.ws + WS_CTL) + CW_BAR; bar.x = 0; bar.st = nullptr;
    if (hi - lo > 1) bar = xcd_barrier_post((unsigned*)(C.ws + WS_CTL) + CW_BAR, MISC);
#define IN(k) (lo <= (k) && (k) < hi)
#define PHASE_IDS() int bx_ = bx, wave_ = wave; LAS unsigned char* lds_ = lds; asm volatile("" : "+s"(bx_), "+s"(wave_), "+s"(lds_)); int lane_; asm volatile("v_mbcnt_lo_u32_b32 %0, -1, 0\n\tv_mbcnt_hi_u32_b32 %0, -1, %0" : "=v"(lane_)); const int tid_ = wave_ * 64 + lane_; \
    const int vcu_ = (G % 8 == 0) ? (bx_ % 8) * (G / 8) + bx_ / 8 : bx_; const int gw_ = vcu_ * 8 + wave_; (void)lane_; (void)gw_; (void)vcu_
#define SEAM(k) do { if (IN(k) && IN((k) + 1)) xcd_barrier(bar); } while (0)

    if (IN(0) && (PHMASK & 1)) { PHASE_IDS(); phase_prologue(C, lds_, G, vcu_, bx_, tid_); } SEAM(0);
    if (IN(1) && (PHMASK & 2)) { PHASE_IDS(); phase_modsum(C, G, bx_, tid_); } SEAM(1);
#ifdef EXTRA_BARS
    if (hi - lo > 1) for (int eb = 0; eb < EXTRA_BARS; ++eb) xcd_barrier(bar);
#endif

#ifdef LAYER_UNROLL
#pragma unroll
#else
#pragma nounroll
#endif
    for (int layer = 0; layer < DEPTH; ++layer) {
        const int p0 = PH_LAYER0 + layer * PH_PER_LAYER;
        if (IN(p0 + 0) && (PHMASK & 4)) { PHASE_IDS();
            if (layer > 0 && !(args.flags & 16)) {
                const unsigned* gc = (const unsigned*)(C.ws + WS_CTL) + CW_CNT + 64 * (layer - 1);
                int nblk = ((int)__hip_atomic_load(gc + (lane_ & 15), __ATOMIC_RELAXED, __HIP_MEMORY_SCOPE_AGENT) + 255) >> 8;
                nblk += __builtin_bit_cast(int, xor1(__builtin_bit_cast(float, nblk))); nblk += __builtin_bit_cast(int, xor2(__builtin_bit_cast(float, nblk)));
                nblk += __builtin_bit_cast(int, swz_xor4(__builtin_bit_cast(float, nblk))); nblk += __builtin_bit_cast(int, swz_xor8(__builtin_bit_cast(float, nblk)));
                convert_rest(C, layer, G, vcu_, lds_, wave_, lane_, nblk * 8, nblk * 4); }
            phase_norm1(C, layer, gw_, NGW, lane_, (args.flags & 16) ? (bf16_t*)(C.ws + WS_Y) : (bf16_t*)(C.ws + WS_X32)); } SEAM(p0 + 0);
        if (IN(p0 + 1) && (PHMASK & 8)) {
            pg8::Gemm g{(const bf16_t*)(C.ws + WS_H), (const bf16_t*)(C.ws + WS_WIN) + (size_t)layer * DIN * DM, MROWS, DIN, DM};
            PHASE_IDS(); pg8::StaticOrder S; S.init(MROWS, DIN, G, bx_);
            pg8::EpiBf16 E{(bf16_t*)(C.ws + WS_P), DIN};
            pg8::gemm_phase<pg8::EpiBf16, pg8::StaticOrder, true>(lds_, g, S, E, tid_);
            if (layer + 1 < DEPTH && !args.flags) convert_tail(C, layer + 1, 0, (MROWS / 256) * (DIN / 256), G, bx_, lds_, wave_, lane_);
        } SEAM(p0 + 1);
        if (IN(p0 + 2) && (PHMASK & 16)) {
            PHASE_IDS(); if (!(args.flags & 1)) phase_qkprep(C, layer, gw_, NGW, lane_, (args.flags & 8) ? (bf16_t*)(C.ws + WS_Y) : (bf16_t*)(C.ws + WS_P));
            if (!(args.flags & 8)) ret_r1_all(C, layer, bx_, G, lds_, tid_);
        } SEAM(p0 + 2);
        if (IN(p0 + 3) && (PHMASK & 32)) {
            PHASE_IDS(); for (int u = bx_; u < 512; u += G) ret_r2_unit(C, layer, u, tid_);
            attn_units<false>(C, layer, G, vcu_, bx_, tid_, (char*)lds_);
        } SEAM(p0 + 3);
        if (IN(p0 + 4) && (PHMASK & 64)) {
            PHASE_IDS();
            if (!WINOFF && !(args.flags & 32)) attn_units<true>(C, layer, G, vcu_, bx_, tid_, (char*)lds_);
            if (!R3OFF && !(args.flags & 64))
            ret_r3_all(C, layer, bx_, G, lds_, tid_);
        } SEAM(p0 + 4);
        if (IN(p0 + 5) && (PHMASK & 128)) {
            pg8::Gemm g{(const bf16_t*)(C.ws + WS_Y), (const bf16_t*)(C.ws + WS_WOUT) + (size_t)layer * DM * DM, MROWS, DM, DM};
            PHASE_IDS(); pg8::StaticOrder S; S.init(MROWS, DM, G, bx_, layer == DEPTH - 1);
            pg8::EpiResid E{(bf16_t*)(C.ws + ((args.flags & 4) ? WS_P : WS_X32)), (const float*)(C.ws + WS_MOD) + (size_t)layer * 17 * 6144 + 2 * DM};
            pg8::gemm_phase<pg8::EpiResid, pg8::StaticOrder, true>(lds_, g, S, E, tid_);
            if (layer + 1 < DEPTH && !args.flags) convert_tail(C, layer + 1, 1, (MROWS / 256) * (DM / 256), G, bx_, lds_, wave_, lane_);
        } SEAM(p0 + 5);
        if (IN(p0 + 6) && (PHMASK & 256)) { PHASE_IDS(); phase_norm2_route(C, layer + ((args.flags & 2) ? 4 : 0), lds_, G, bx_, tid_); } SEAM(p0 + 6);
        if (IN(p0 + 7) && (PHMASK & 512)) {
            PHASE_IDS(); LAS int* boff = (LAS int*)(lds_ + LDSCTL_OFF + 64); LAS int* mcnt = (LAS int*)(lds_ + LDSCTL_OFF + 192); moe_offsets(C, layer, boff, mcnt, tid_);
            pg8::Gemm g{(const bf16_t*)(C.ws + WS_H), (const bf16_t*)(C.ws + WS_WGU + (size_t)layer * NE * 2 * FF * DM), 0, 2 * FF, DM};
            MoeOrder<true, 8> S{(const int*)(C.ws + WS_LIST), boff, mcnt, G, bx_};
            EpiGateUp E{(unsigned char*)(C.ws + WS_P)};
            pg8::gemm_phase<EpiGateUp, MoeOrder<true, 8>, true, true>(lds_, g, S, E, tid_);
            if (layer + 1 < DEPTH && !args.flags) convert_tail(C, layer + 1, 2, boff[16] * 8, G, bx_, lds_, wave_, lane_);
        } SEAM(p0 + 7);
        if (IN(p0 + 8) && (PHMASK & 1024)) {
            PHASE_IDS(); LAS int* boff = (LAS int*)(lds_ + LDSCTL_OFF + 64); LAS int* mcnt = (LAS int*)(lds_ + LDSCTL_OFF + 192); moe_offsets(C, layer, boff, mcnt, tid_);
            pg8::Gemm g{(const bf16_t*)(C.ws + WS_P), (const bf16_t*)(C.ws + WS_WDN + (size_t)layer * NE * DM * FF), 0, DM, FF};
            MoeOrder<false, 4> S{(const int*)(C.ws + WS_LIST), boff, mcnt, G, bx_};
            EpiDown E{(unsigned char*)(C.ws + WS_YP), (const int*)(C.ws + WS_LIST), boff, mcnt, {}};
            pg8::gemm_phase<EpiDown, MoeOrder<false, 4>, true, true>(lds_, g, S, E, tid_);
            if (layer + 1 < DEPTH && !args.flags) convert_tail(C, layer + 1, 3, boff[16] * 4, G, bx_, lds_, wave_, lane_);
        } SEAM(p0 + 8);
    }
    if (IN(PH_FINAL) && (PHMASK & 2048)) { PHASE_IDS(); phase_final(C, gw_, NGW, lane_); }
#undef IN
#undef SEAM
}

extern "C" void kernel_launch(void* const* d_in, const int* in_sizes, int n_in, void* d_out, int out_size, void* d_ws, size_t ws_size, hipStream_t stream) {
    static int grid = 0;
    if (grid == 0) {
        if (n_in != 18 || in_sizes[0] != NB * SEQ * DM || out_size != NB * SEQ * DM || ws_size < WS_END) {
            fprintf(stderr, "kernel_launch: unexpected shapes (n_in %d, in0 %d, out %d, ws %zu, need %zu); nothing launched\n", n_in, n_in > 0 ? in_sizes[0] : -1, out_size, ws_size, (size_t)WS_END); grid = -1; return; }
        int dev = 0, cus = 0, per_cu = 0;
        if (hipGetDevice(&dev) != hipSuccess || hipDeviceGetAttribute(&cus, hipDeviceAttributeMultiprocessorCount, dev) != hipSuccess) { grid = -1; return; }
        if (hipFuncSetAttribute((const void*)mega_fwd, hipFuncAttributeMaxDynamicSharedMemorySize, LDS_BYTES) != hipSuccess) { fprintf(stderr, "kernel_launch: hipFuncSetAttribute failed\n"); grid = -1; return; }
        if (hipOccupancyMaxActiveBlocksPerMultiprocessor(&per_cu, (const void*)mega_fwd, 512, LDS_BYTES) != hipSuccess || per_cu < 1) fprintf(stderr, "kernel_launch: occupancy query says %d\n", per_cu);
        (void)hipGetLastError();
        grid = cus;
    }
    if (grid < 0) return;
    if (hipMemsetAsync((char*)d_ws + WS_CTL, 0, CTL_BYTES, stream) != hipSuccess) return;
    Args a{};
    for (int i = 0; i < 18; ++i) a.in[i] = (const float*)d_in[i];
    a.out = (float*)d_out; a.ws = (unsigned char*)d_ws;
#if MK_ONE_LAUNCH
    a.ph_lo = 0; a.ph_hi = PH_COUNT;
    hipLaunchKernelGGL(mega_fwd, dim3(grid), dim3(512), LDS_BYTES, stream, a);
#else
    for (int p = 0; p < PH_COUNT; ++p) { a.ph_lo = p; a.ph_hi = p + 1;
#if !defined(PROBE_P) || !PROBE_BEFORE
        hipLaunchKernelGGL(mega_fwd, dim3(grid), dim3(512), LDS_BYTES, stream, a);
#endif
#ifdef PROBE_P
        const bool hit = (PROBE_P < 2) ? (p == PROBE_P) : (p >= PH_LAYER0 && p < PH_FINAL && (p - PH_LAYER0) % PH_PER_LAYER == PROBE_P - 2 && (!PROBE_L0 || p < PH_LAYER0 + PH_PER_LAYER));
        if (hit) { a.flags = PROBE_FLAGS; for (int r = 0; r < PROBE_REP; ++r) hipLaunchKernelGGL(mega_fwd, dim3(grid), dim3(512), LDS_BYTES, stream, a); a.flags = 0; }
#if PROBE_BEFORE
        hipLaunchKernelGGL(mega_fwd, dim3(grid), dim3(512), LDS_BYTES, stream, a);
#endif
#endif
    }
#endif
}
```

```cpp
#define MK_ONE_LAUNCH 1
#include <hip/hip_runtime.h>
#include <cstdio>
#include <cstdint>

#define GAS __attribute__((address_space(1)))
#define LAS __attribute__((address_space(3)))
typedef unsigned short bf16_t;
typedef short bf16x8 __attribute__((ext_vector_type(8)));
typedef float f32x4 __attribute__((ext_vector_type(4)));
typedef float f32x2 __attribute__((ext_vector_type(2)));
typedef float f32x16 __attribute__((ext_vector_type(16)));
typedef unsigned u32x4 __attribute__((ext_vector_type(4)));
typedef unsigned u32x2 __attribute__((ext_vector_type(2)));

constexpr int DM = 1024, NB = 16, SEQ = 4096, CTX = 256, TPB = SEQ + CTX, MROWS = NB * TPB, DEPTH = 4;
constexpr int DIN = 2560;
constexpr int C_RQ = 0, C_RK = 256, C_RV = 512, C_RG = 1024, C_WQ = 1536, C_WK = 1792, C_WV = 1920, C_GQ = 2048, C_GK = 2304, C_GV = 2432;
constexpr int NE = 16, FF = 1024, NCH = TPB / 128;
constexpr float EPS = 1e-6f;
constexpr float LOG2E = 1.4426950408889634f;
constexpr float QSCALE = 0.125f * LOG2E;

__device__ __forceinline__ unsigned f2bf(float f) { unsigned u = __builtin_bit_cast(unsigned, f); return (u + 0x7fffu + ((u >> 16) & 1u)) >> 16; }
__device__ __forceinline__ unsigned pk2(float lo, float hi) { return f2bf(lo) | (f2bf(hi) << 16); }
__device__ __forceinline__ float bf2f(unsigned short h) { return __builtin_bit_cast(float, (unsigned)h << 16); }
__device__ __forceinline__ float bflo(unsigned w) { return __builtin_bit_cast(float, w << 16); }
__device__ __forceinline__ float bfhi(unsigned w) { return __builtin_bit_cast(float, w & 0xffff0000u); }

namespace pg8 {
constexpr int BM = 256, BK = 64, HALF = 128, HTB = HALF * BK * 2, STAGE_BYTES = 8 * HTB, NXCD = 8, WGM = 8;
__host__ __device__ __forceinline__ int lds_byte(int r, int c) { const int st = (r >> 4) * 2 + (c >> 5), rr = r & 15, cc = c & 31, ob = rr * 64 + cc * 2; return st * 1024 + (ob ^ (((ob >> 9) & 1) << 5)); }
__host__ __device__ __forceinline__ void stage_rc(int b, int& R, int& C) { const int st = b / 1024, sb = b % 1024, swz = sb ^ (((sb >> 9) & 1) << 5); R = (st >> 1) * 16 + swz / 64; C = (st & 1) * 32 + (swz % 64) / 2; }
__host__ __device__ __forceinline__ int perm32(int rho) { const int n = rho >> 4, i = rho & 15; return 8 * (i >> 2) + 4 * n + (i & 3); }

struct Unit { int pm, pn; };
struct Gemm { const bf16_t* A; const bf16_t* Bt; int M, N, K; };

struct StaticOrder {
    static constexpr bool GATHER = false;
    int nM, nN, nwg, G, c; bool skipctx;
    __device__ void init(int M, int N, int G_, int c_, bool skipctx_ = false) { skipctx = skipctx_; nM = skipctx_ ? (M / BM) / 17 * 16 : M / BM; nN = N / BM; nwg = nM * nN; G = G_; c = c_; }
    __device__ bool next(int i, Unit& u) const {
        const long L = (long)i * G + c; if (L >= nwg) return false;
        int wgid = (int)L; { const int q = nwg / NXCD, r = nwg % NXCD, xcd = wgid % NXCD, off = wgid / NXCD; wgid = (xcd < r ? xcd * (q + 1) : r * (q + 1) + (xcd - r) * q) + off; }
        const int nig = WGM * nN, gid = wgid / nig, fm = gid * WGM, gsz = (nM - fm) < WGM ? (nM - fm) : WGM;
        u.pm = fm + ((wgid % nig) % gsz); u.pn = (wgid % nig) / gsz; if (skipctx) u.pm += (u.pm >> 4) + 1; return true;
    }
    __device__ __forceinline__ unsigned arow(const Unit&, int) const { return 0u; }
    __device__ __forceinline__ const int* aptr(const Unit&, int) const { return nullptr; }
    __device__ __forceinline__ unsigned tokrow(unsigned) const { return 0u; }
};

__device__ __forceinline__ unsigned cvt_pk_bf16(float lo, float hi) { unsigned r; asm volatile("v_cvt_pk_bf16_f32 %0, %1, %2" : "=v"(r) : "v"(lo), "v"(hi)); return r; }

struct EpiBf16 {
    static constexpr bool PERM = true, HAS_PRE = false;
    bf16_t* O; int ldc;
    __device__ __forceinline__ void operator()(const f32x4 (&acc)[2][2][4][2], const Unit& u, int wr, int wc, int fr, int fq) const {
        const int row0 = u.pm * BM + wr * 64 + fr; const int col0 = u.pn * BM + wc * 32 + 8 * fq;
#pragma unroll
        for (int ai = 0; ai < 2; ++ai)
#pragma unroll
            for (int m = 0; m < 4; ++m) { const unsigned off = ((unsigned)(row0 + ai * HALF + m * 16) * (unsigned)ldc + (unsigned)col0) * 2u;
#pragma unroll
                for (int bj = 0; bj < 2; ++bj) { const f32x4 v0 = acc[ai][bj][m][0], v1 = acc[ai][bj][m][1];
                    u32x4 w; w.x = cvt_pk_bf16(v0[0], v0[1]); w.y = cvt_pk_bf16(v0[2], v0[3]); w.z = cvt_pk_bf16(v1[0], v1[1]); w.w = cvt_pk_bf16(v1[2], v1[3]);
                    *(u32x4*)((char*)O + off + bj * HALF * 2) = w; } }
    }
};

__device__ __forceinline__ f32x4 i2f4(f32x4 v) { typedef int i32x4_ __attribute__((ext_vector_type(4))); const i32x4_ i = __builtin_bit_cast(i32x4_, v); return (f32x4){(float)i[0], (float)i[1], (float)i[2], (float)i[3]}; }
struct EpiBf16Q {
    static constexpr bool PERM = true, HAS_PRE = true;
    bf16_t* O; int ldc; const float* rs; float ws; float sc[2][4];
    __device__ __forceinline__ void pre(const Unit& u, int wr, int fr) {
#pragma unroll
        for (int ai = 0; ai < 2; ++ai)
#pragma unroll
            for (int m = 0; m < 4; ++m) sc[ai][m] = rs[u.pm * BM + ai * HALF + wr * 64 + m * 16 + fr];
    }
    __device__ __forceinline__ void operator()(const f32x4 (&acc)[2][2][4][2], const Unit& u, int wr, int wc, int fr, int fq) const {
        const int row0 = u.pm * BM + wr * 64 + fr; const int col0 = u.pn * BM + wc * 32 + 8 * fq;
#pragma unroll
        for (int ai = 0; ai < 2; ++ai)
#pragma unroll
            for (int m = 0; m < 4; ++m) { const unsigned off = ((unsigned)(row0 + ai * HALF + m * 16) * (unsigned)ldc + (unsigned)col0) * 2u; const float s = sc[ai][m] * ws;
#pragma unroll
                for (int bj = 0; bj < 2; ++bj) { const f32x4 v0 = i2f4(acc[ai][bj][m][0]) * s, v1 = i2f4(acc[ai][bj][m][1]) * s;
                    u32x4 w; w.x = cvt_pk_bf16(v0[0], v0[1]); w.y = cvt_pk_bf16(v0[2], v0[3]); w.z = cvt_pk_bf16(v1[0], v1[1]); w.w = cvt_pk_bf16(v1[2], v1[3]);
                    *(u32x4*)((char*)O + off + bj * HALF * 2) = w; } }
    }
};

struct EpiResid {
    static constexpr bool PERM = true, HAS_PRE = false;
    bf16_t* X; const float* gate;
    __device__ __forceinline__ void operator()(const f32x4 (&acc)[2][2][4][2], const Unit& u, int wr, int wc, int fr, int fq) const {
        const int set = (u.pm % 17 == 0) ? 16 : (u.pm / 17);
        const float* gp = gate + (size_t)set * 6 * DM;
        const int col0 = u.pn * BM + wc * 32 + 8 * fq;
        f32x4 gv[2][2];
#pragma unroll
        for (int bj = 0; bj < 2; ++bj)
#pragma unroll
            for (int n = 0; n < 2; ++n) gv[bj][n] = *(const f32x4*)(gp + col0 + bj * HALF + n * 4);
#pragma unroll
        for (int ai = 0; ai < 2; ++ai) {
            u32x4 xin[4][2];
#pragma unroll
            for (int m = 0; m < 4; ++m) { const unsigned off = ((unsigned)(u.pm * BM + ai * HALF + wr * 64 + m * 16 + fr) * (unsigned)DM + (unsigned)col0) * 2u;
#pragma unroll
                for (int bj = 0; bj < 2; ++bj) xin[m][bj] = *(const u32x4*)((const char*)X + off + bj * HALF * 2); }
            asm volatile("" ::: "memory");
#pragma unroll
            for (int m = 0; m < 4; ++m) { const unsigned off = ((unsigned)(u.pm * BM + ai * HALF + wr * 64 + m * 16 + fr) * (unsigned)DM + (unsigned)col0) * 2u;
#pragma unroll
                for (int bj = 0; bj < 2; ++bj) { const u32x4 x = xin[m][bj]; const f32x4 a0 = acc[ai][bj][m][0] * gv[bj][0], a1 = acc[ai][bj][m][1] * gv[bj][1];
                    u32x4 w; w.x = cvt_pk_bf16(bflo(x.x) + a0[0], bfhi(x.x) + a0[1]); w.y = cvt_pk_bf16(bflo(x.y) + a0[2], bfhi(x.y) + a0[3]);
                    w.z = cvt_pk_bf16(bflo(x.z) + a1[0], bfhi(x.z) + a1[1]); w.w = cvt_pk_bf16(bflo(x.w) + a1[2], bfhi(x.w) + a1[3]);
                    *(u32x4*)((char*)X + off + bj * HALF * 2) = w; } }
            asm volatile("" ::: "memory");
        }
    }
};

template <class Epi, class Sched, bool ALIGN_EPI, int MODE = 0  >
__device__ __forceinline__ void gemm_phase(LAS unsigned char* lds, const Gemm g, const Sched& S, Epi& E, const int tid) {
    const int wid = __builtin_amdgcn_readfirstlane(tid >> 6), lane = tid & 63, wr = wid >> 2, wc = wid & 3, fr = lane & 15, fq = lane >> 4;
    constexpr bool FP8 = MODE == 1, I8 = MODE == 2;
    const int K = g.K, KB = MODE ? K : 2 * K  , nt = KB / (BK * 2);
    unsigned voffB[2], vA[2][2], vAn[2][2];
#define PG8_RC(i_, R_, C_) int R_, C_; stage_rc(tid * 16 + (i_) * 8192, R_, C_)
#pragma unroll
    for (int i = 0; i < 2; ++i) { PG8_RC(i, R, C); const int Rb = Epi::PERM ? ((R & ~31) + perm32(R & 31)) : R;
        voffB[i] = (unsigned)(Rb * KB + C * 2); }
#define PG8_SETV(v, u) do { _Pragma("unroll") for (int h_ = 0; h_ < 2; ++h_) _Pragma("unroll") for (int i_ = 0; i_ < 2; ++i_) { PG8_RC(i_, sR_, sC_); \
        if constexpr (Sched::GATHER) v[h_][i_] = S.arow(u, h_ * HALF + sR_) * (unsigned)KB + (unsigned)(sC_ * 2); \
        else v[h_][i_] = (unsigned)((h_ * HALF + sR_) * KB + sC_ * 2); } } while (0)
    const size_t kstep = (size_t)(BK * 2);
    const size_t hstep = (size_t)HALF * KB;
    const size_t tstep = 2 * hstep;
    const size_t atstep = Sched::GATHER ? (size_t)0 : tstep;
    const unsigned ldsw = (unsigned)wid * 1024u;
    const int aoff = lds_byte(wr * 64 + fr, fq * 8), boff = lds_byte(wc * 32 + fr, fq * 8);
#define PG8_SA(b, h) (((b) * 2 + (h)) * HTB)
#define PG8_SB(b, h) ((4 + (b) * 2 + (h)) * HTB)
#define PG8_STAGE(bufoff, gbase, voff) do { _Pragma("unroll") for (int _i = 0; _i < 2; ++_i) \
        __builtin_amdgcn_global_load_lds((const unsigned*)((const char*)(gbase) + (voff)[_i]), (LAS unsigned*)(lds + (bufoff) + ldsw + _i * 8192), 16, 0, 0); } while (0)
#define PG8_LDA(dst, b, h) do { _Pragma("unroll") for (int m = 0; m < 4; ++m) _Pragma("unroll") for (int k = 0; k < 2; ++k) dst[m][k] = *(const LAS bf16x8*)(lds + PG8_SA(b, h) + aoff + m * 2048 + k * 1024); } while (0)
#define PG8_LDB(dst, b, h) do { _Pragma("unroll") for (int n = 0; n < 2; ++n) _Pragma("unroll") for (int k = 0; k < 2; ++k) dst[n][k] = *(const LAS bf16x8*)(lds + PG8_SB(b, h) + boff + n * 2048 + k * 1024); } while (0)
    typedef long i64x2_ __attribute__((ext_vector_type(2)));
#define PG8_MMA(ai, bj, At, Bt) do { __builtin_amdgcn_s_setprio(1); _Pragma("unroll") for (int m = 0; m < 4; ++m) _Pragma("unroll") for (int n = 0; n < 2; ++n) _Pragma("unroll") for (int k = 0; k < 2; ++k) { \
        if constexpr (FP8) { const i64x2_ b2_ = __builtin_bit_cast(i64x2_, Bt[n][k]), a2_ = __builtin_bit_cast(i64x2_, At[m][k]); \
            acc[ai][bj][m][n] = __builtin_amdgcn_mfma_f32_16x16x32_fp8_fp8(b2_[0], a2_[0], acc[ai][bj][m][n], 0, 0, 0); \
            acc[ai][bj][m][n] = __builtin_amdgcn_mfma_f32_16x16x32_fp8_fp8(b2_[1], a2_[1], acc[ai][bj][m][n], 0, 0, 0); } \
        else if constexpr (I8) { typedef int i32x4_ __attribute__((ext_vector_type(4))); \
            acc[ai][bj][m][n] = __builtin_bit_cast(f32x4, __builtin_amdgcn_mfma_i32_16x16x64_i8(__builtin_bit_cast(i32x4_, Bt[n][k]), __builtin_bit_cast(i32x4_, At[m][k]), __builtin_bit_cast(i32x4_, acc[ai][bj][m][n]), 0, 0, 0)); } \
        else acc[ai][bj][m][n] = __builtin_amdgcn_mfma_f32_16x16x32_bf16(Bt[n][k], At[m][k], acc[ai][bj][m][n], 0, 0, 0); } \
        __builtin_amdgcn_s_setprio(0); } while (0)
#define PG8_WAIT_V(n) asm volatile("s_waitcnt vmcnt(" #n ")" ::: "memory")
#define PG8_WAIT_L(n) asm volatile("s_waitcnt lgkmcnt(" #n ")" ::: "memory")
#define PG8_BAR __builtin_amdgcn_s_barrier()
#define PG8_SCHED __builtin_amdgcn_sched_barrier(0)
    Unit cur, nxt; int ui = 0;
    if (!S.next(0, cur)) return;
    float z0 = 0.f; asm volatile("" : "+v"(z0));
    f32x4 acc[2][2][4][2];
#pragma unroll
    for (int a = 0; a < 2; ++a)
#pragma unroll
        for (int b = 0; b < 2; ++b)
#pragma unroll
            for (int m = 0; m < 4; ++m)
#pragma unroll
                for (int n = 0; n < 2; ++n) acc[a][b][m][n] = (f32x4){z0, z0, z0, z0};
    bf16x8 At[4][2], B0[2][2], B1[2][2];
    const char* cA = (const char*)g.A + (size_t)cur.pm * atstep; const char* cB = (const char*)g.Bt + (size_t)cur.pn * tstep;
    PG8_SETV(vA, cur);
    PG8_STAGE(PG8_SB(0, 0), cB, voffB); PG8_STAGE(PG8_SB(0, 1), cB + hstep, voffB); PG8_STAGE(PG8_SA(0, 0), cA, vA[0]); PG8_STAGE(PG8_SA(0, 1), cA, vA[1]);
    if (wr == 1) PG8_BAR;
    PG8_WAIT_V(2); PG8_BAR;
    PG8_STAGE(PG8_SB(1, 0), cB + kstep, voffB); PG8_STAGE(PG8_SA(1, 0), cA + kstep, vA[0]); PG8_STAGE(PG8_SB(1, 1), cB + hstep + kstep, voffB);
    PG8_WAIT_V(6); PG8_BAR;
    for (;;) {
        if constexpr (Epi::HAS_PRE) E.pre(cur, wr, fr);
        const bool has_next = S.next(ui + 1, nxt);
        const char* nA = has_next ? (const char*)g.A + (size_t)nxt.pm * atstep : cA; const char* nB = has_next ? (const char*)g.Bt + (size_t)nxt.pn * tstep : cB;
        if constexpr (Sched::GATHER) { if (has_next) {
#pragma unroll
            for (int h_ = 0; h_ < 2; ++h_)
#pragma unroll
                for (int i_ = 0; i_ < 2; ++i_) { PG8_RC(i_, sR_, sC_); (void)sC_; const int* ap_ = S.aptr(nxt, h_ * HALF + sR_); asm volatile("global_load_dword %0, %1, off" : "=v"(vAn[h_][i_]) : "v"(ap_) : "memory"); } } }
        if (has_next) { if constexpr (!Sched::GATHER) { PG8_SETV(vAn, nxt); } } else {
#pragma unroll
            for (int h_ = 0; h_ < 2; ++h_)
#pragma unroll
                for (int i_ = 0; i_ < 2; ++i_) vAn[h_][i_] = vA[h_][i_]; }
        for (int t = 0; t < nt; t += 2) {
            const bool last = (t == nt - 2);
            const char* a1 = cA + (size_t)(t + 1) * kstep;
            const char* a2 = last ? nA : cA + (size_t)(t + 2) * kstep; const char* b2 = last ? nB : cB + (size_t)(t + 2) * kstep;
            const char* a3 = a2 + kstep; const char* b3 = b2 + kstep;
            if constexpr (Sched::GATHER) { if (t == 2 && has_next) {
#pragma unroll
                for (int h_ = 0; h_ < 2; ++h_)
#pragma unroll
                    for (int i_ = 0; i_ < 2; ++i_) { PG8_RC(i_, sR_, sC_); (void)sR_; asm volatile("" : "+v"(vAn[h_][i_])); vAn[h_][i_] = S.tokrow(vAn[h_][i_]) * (unsigned)KB + (unsigned)(sC_ * 2); } } }
            unsigned o2[2][2];
#pragma unroll
            for (int h_ = 0; h_ < 2; ++h_)
#pragma unroll
                for (int i_ = 0; i_ < 2; ++i_) o2[h_][i_] = last ? vAn[h_][i_] : vA[h_][i_];
            PG8_LDB(B0, 0, 0); PG8_LDB(B1, 0, 1); PG8_SCHED; PG8_LDA(At, 0, 0); PG8_STAGE(PG8_SA(1, 1), a1, vA[1]);
            PG8_WAIT_V(8); PG8_WAIT_L(0); PG8_BAR; PG8_MMA(0, 0, At, B0); PG8_MMA(0, 1, At, B1); PG8_BAR; PG8_SCHED;
            PG8_LDA(At, 0, 1); PG8_STAGE(PG8_SB(0, 0), b2, voffB); PG8_STAGE(PG8_SB(0, 1), b2 + hstep, voffB); PG8_STAGE(PG8_SA(0, 0), a2, o2[0]);
            PG8_WAIT_V(8); PG8_WAIT_L(0); PG8_BAR; PG8_MMA(1, 0, At, B0); PG8_MMA(1, 1, At, B1); PG8_BAR; PG8_SCHED;
            PG8_LDB(B0, 1, 0); PG8_LDB(B1, 1, 1); PG8_SCHED; PG8_LDA(At, 1, 0); PG8_STAGE(PG8_SA(0, 1), a2, o2[1]);
            PG8_WAIT_V(8); PG8_WAIT_L(0); PG8_BAR; PG8_MMA(0, 0, At, B0); PG8_MMA(0, 1, At, B1); PG8_BAR; PG8_SCHED;
            PG8_LDA(At, 1, 1); PG8_STAGE(PG8_SB(1, 0), b3, voffB); PG8_STAGE(PG8_SB(1, 1), b3 + hstep, voffB); PG8_STAGE(PG8_SA(1, 0), a3, o2[0]);
            PG8_WAIT_V(8); PG8_WAIT_L(0); PG8_BAR; PG8_MMA(1, 0, At, B0); PG8_MMA(1, 1, At, B1); PG8_BAR; PG8_SCHED;
        }
        if constexpr (ALIGN_EPI) { if (wr == 0) PG8_BAR; }
        E(acc, cur, wr, wc, fr, fq);
        if (!has_next) break;
#pragma unroll
        for (int a = 0; a < 2; ++a)
#pragma unroll
            for (int b = 0; b < 2; ++b)
#pragma unroll
                for (int m = 0; m < 4; ++m)
#pragma unroll
                    for (int n = 0; n < 2; ++n) acc[a][b][m][n] = (f32x4){z0, z0, z0, z0};
        cur = nxt; cA = nA; cB = nB; ++ui;
#pragma unroll
        for (int h_ = 0; h_ < 2; ++h_)
#pragma unroll
            for (int i_ = 0; i_ < 2; ++i_) vA[h_][i_] = vAn[h_][i_];
        if constexpr (ALIGN_EPI) { if (wr == 1) PG8_BAR; }
    }
    PG8_WAIT_V(0);
    if constexpr (!ALIGN_EPI) { if (wr == 0) PG8_BAR; }
    PG8_BAR;
#undef PG8_SETV
#undef PG8_RC
#undef PG8_SA
#undef PG8_SB
#undef PG8_STAGE
#undef PG8_LDA
#undef PG8_LDB
#undef PG8_MMA
#undef PG8_WAIT_V
#undef PG8_WAIT_L
#undef PG8_BAR
#undef PG8_SCHED
}
}
#include <hip/hip_bf16.h>
#include <cmath>
namespace attn_body {
using bf16=__hip_bfloat16;
using s16x4=__attribute__((ext_vector_type(4)))short;
constexpr int D=64,QP=DIN,OP=1024;
constexpr int NW=8,QBLK=32,QB=QBLK*NW,KVBLK=64;
__device__ __forceinline__ int crow(int r,int hi){return (r&3)+8*(r>>2)+4*hi;}
#define SBAR() __builtin_amdgcn_sched_barrier(0)
__device__ __forceinline__ void wmask(f32x16&p0,f32x16&p1,int kq,int hi){
  const float NEG=-INFINITY; const int kb=kq+4*hi;
  #pragma unroll
  for(int r=0;r<16;++r){const int d=kb+(r&3)+8*(r>>2); if(d>128||d<-128)p0[r]=NEG; if(d+32>128||d+32<-128)p1[r]=NEG;}
}

constexpr int NSLOT=3, SLOTB=8192;
constexpr int LDS_K=0, LDS_V=NSLOT*SLOTB, LDS_WS=2*NSLOT*SLOTB, LDS_OST=LDS_WS+NW*64*4, LDS_BYTES=LDS_OST+NW*4096;
constexpr float C2=0.125f*1.4426950408889634f;
__device__ __forceinline__ void glds16(const void*gsrc,unsigned lds_dst){unsigned keep;
  asm volatile("s_mov_b32 %0, m0\n\ts_mov_b32 m0, %2\n\ts_nop 0\n\tglobal_load_lds_dwordx4 %1, off\n\ts_mov_b32 m0, %0":"=&s"(keep):"v"(gsrc),"s"(lds_dst):"memory");}
__device__ __forceinline__ float max3f(float a,float b,float c){float r;asm("v_max3_f32 %0, %1, %2, %3":"=v"(r):"v"(a),"v"(b),"v"(c));return r;}
__device__ __forceinline__ float max2f(float a,float b){float r;asm("v_max_f32_e32 %0, %1, %2":"=v"(r):"v"(a),"v"(b));return r;}
__device__ __forceinline__ float fadd_s(float a,float b){float r;asm("v_add_f32_e32 %0, %1, %2":"=v"(r):"v"(a),"v"(b));return r;}
__device__ __forceinline__ float fsub_s(float a,float b){float r;asm("v_sub_f32_e32 %0, %1, %2":"=v"(r):"v"(a),"v"(b));return r;}
typedef float f32x2_t __attribute__((ext_vector_type(2))); typedef __bf16 bf16x2_t __attribute__((ext_vector_type(2)));
__device__ __forceinline__ unsigned cvtpk_s(float lo,float hi){f32x2_t v={lo,hi};bf16x2_t b=__builtin_convertvector(v,bf16x2_t);return __builtin_bit_cast(unsigned,b);}
#define WAIT_BAR(N) asm volatile("s_waitcnt vmcnt(" #N ") lgkmcnt(0)\n\ts_barrier":::"memory")

__device__ __forceinline__ void qkt(f32x16&p0,f32x16&p1,const char*Kslot,const bf16x8*qr,const f32x16&negm,int r32,int hi){
  const char*kb=Kslot+hi*1024+r32*16;
  #pragma unroll
  for(int d0=0;d0<4;++d0){
    const bf16x8 b0=*reinterpret_cast<const bf16x8*>(kb+d0*2048);
    const bf16x8 b1=*reinterpret_cast<const bf16x8*>(kb+d0*2048+512);
    if(d0==0){p0=__builtin_amdgcn_mfma_f32_32x32x16_bf16(b0,qr[0],negm,0,0,0);p1=__builtin_amdgcn_mfma_f32_32x32x16_bf16(b1,qr[0],negm,0,0,0);}
    else{p0=__builtin_amdgcn_mfma_f32_32x32x16_bf16(b0,qr[d0],p0,0,0,0);p1=__builtin_amdgcn_mfma_f32_32x32x16_bf16(b1,qr[d0],p1,0,0,0);}}
}
typedef __attribute__((address_space(3))) const char* lds_cptr;
typedef short v4i16_t __attribute__((ext_vector_type(4)));
__device__ __forceinline__ void kload8(bf16x8*kf,lds_cptr kp){
  kf[0]=*(const __attribute__((address_space(3))) bf16x8*)(kp);      kf[1]=*(const __attribute__((address_space(3))) bf16x8*)(kp+512);
  kf[2]=*(const __attribute__((address_space(3))) bf16x8*)(kp+2048); kf[3]=*(const __attribute__((address_space(3))) bf16x8*)(kp+2560);
  kf[4]=*(const __attribute__((address_space(3))) bf16x8*)(kp+4096); kf[5]=*(const __attribute__((address_space(3))) bf16x8*)(kp+4608);
  kf[6]=*(const __attribute__((address_space(3))) bf16x8*)(kp+6144); kf[7]=*(const __attribute__((address_space(3))) bf16x8*)(kp+6656);
}
__device__ __forceinline__ void kload2(bf16x8*kf,lds_cptr kp,int j){ kf[2*j]=*(const __attribute__((address_space(3))) bf16x8*)(kp+j*2048); kf[2*j+1]=*(const __attribute__((address_space(3))) bf16x8*)(kp+j*2048+512); }
__device__ __forceinline__ s16x4 vtr(lds_cptr p){ return __builtin_bit_cast(s16x4,__builtin_amdgcn_ds_read_tr16_b64_v4i16((__attribute__((address_space(3))) v4i16_t*)p)); }
__device__ __forceinline__ float rowmax(const f32x16&p0,const f32x16&p1){
  float a=max3f(p0[0],p0[1],p1[0]),b=max3f(p0[2],p0[3],p1[1]);a=max3f(a,p1[2],p1[3]);
  #pragma unroll
  for(int r=4;r<16;r+=4){a=max3f(a,p0[r],p0[r+1]);b=max3f(b,p0[r+2],p0[r+3]);a=max3f(a,p1[r],p1[r+1]);b=max3f(b,p1[r+2],p1[r+3]);}
  const float m=max2f(a,b);
  auto rr=__builtin_amdgcn_permlane32_swap(__float_as_uint(m),__float_as_uint(m),false,false);
  return max2f(__uint_as_float(rr[0]),__uint_as_float(rr[1]));
}
__device__ __forceinline__ void pv(f32x16*o,int vb,bf16x8 pa0,bf16x8 pa1,bf16x8 pa2,bf16x8 pa3){
  #pragma unroll
  for(int d0=0;d0<2;++d0){s16x4 lo[4],hi[4];
    #pragma unroll
    for(int ks=0;ks<4;++ks){
      asm volatile("ds_read_b64_tr_b16 %0,%1 offset:%c2":"=&v"(lo[ks]):"v"(vb),"i"(d0*4096+ks*1024):"memory");
      asm volatile("ds_read_b64_tr_b16 %0,%1 offset:%c2":"=&v"(hi[ks]):"v"(vb),"i"(d0*4096+ks*1024+512):"memory");}
    asm volatile("s_waitcnt lgkmcnt(0)":::"memory");SBAR();
    #define PK(k) (bf16x8){lo[k][0],lo[k][1],lo[k][2],lo[k][3],hi[k][0],hi[k][1],hi[k][2],hi[k][3]}
    o[d0]=__builtin_amdgcn_mfma_f32_32x32x16_bf16(pa0,PK(0),o[d0],0,0,0);
    o[d0]=__builtin_amdgcn_mfma_f32_32x32x16_bf16(pa1,PK(1),o[d0],0,0,0);
    o[d0]=__builtin_amdgcn_mfma_f32_32x32x16_bf16(pa2,PK(2),o[d0],0,0,0);
    o[d0]=__builtin_amdgcn_mfma_f32_32x32x16_bf16(pa3,PK(3),o[d0],0,0,0);
    #undef PK
  }
}

#ifndef ATTN_STORE16
#define ATTN_STORE16(p,v) (*(u32x4*)(p)=(v))
#endif
template<int THRL,bool WIN> __device__ __forceinline__ void attn_unit(const bf16*Qb,const bf16*__restrict__ Kb,const bf16*__restrict__ Vb,bf16*Ob,int q0,int NT,int tdelta,float sink_l2,int tid,char*shm){
  const int lane=tid&63,r32=lane&31,hi=lane>>5; const int wid=__builtin_amdgcn_readfirstlane(tid>>6);
  const bf16*Qw=Qb+(long)(q0+wid*QBLK)*QP;
  const bf16*Kh=Kb,*Vh=Vb;
  const unsigned lds0=(unsigned)(uintptr_t)shm;
  float*wsf=(float*)(shm+LDS_WS)+wid*64;
  const bf16*ksrc=Kh+(long)lane*QP+wid*8;
  const bf16*vsrc=Vh+(long)(16*(wid&3)+(lane>>2))*QP+(wid>>2)*32+(lane&3)*8;
  const unsigned kdst=lds0+LDS_K+wid*1024, vdst=lds0+LDS_V+wid*1024;
  #define TM(t) ((t)<4?(t):(t)+tdelta)
  #define DMA_K(t,slot) glds16(ksrc+(long)TM(t)*KVBLK*QP,(unsigned)__builtin_amdgcn_readfirstlane(kdst+(slot)))
  #define DMA_V(t,slot) glds16(vsrc+(long)TM(t)*KVBLK*QP,(unsigned)__builtin_amdgcn_readfirstlane(vdst+(slot)))
  const int vb0=(int)(lds0+LDS_V)+((lane>>4)&1)*32+(lane&3)*8+(4*hi+((lane&15)>>2))*64;
  const char*Kbase=shm+LDS_K; bf16x8 kf[8];
  const lds_cptr shm3=(lds_cptr)shm; const lds_cptr kp0=shm3+LDS_K+hi*1024+r32*16; const lds_cptr vp0=shm3+LDS_V+((lane>>4)&1)*32+(lane&3)*8+(4*hi+((lane&15)>>2))*64;
  DMA_K(0,0);DMA_V(0,0);DMA_K(1,SLOTB);
  bf16x8 qr[4];
  #pragma unroll
  for(int d0=0;d0<4;++d0)qr[d0]=*reinterpret_cast<const bf16x8*>(&Qw[(long)r32*QP+d0*16+hi*8]);
  float mhat=0.f,l_reg=0.f;float z0_=0.f;asm volatile("":"+v"(z0_));f32x16 o[2];
  #pragma unroll
  for(int r_=0;r_<16;++r_){o[0][r_]=z0_;o[1][r_]=z0_;}
  f32x16 negm;
  #pragma unroll
  for(int r_=0;r_<16;++r_)negm[r_]=z0_;
  asm volatile("":"+v"(negm));
  const int qrow=q0+wid*QBLK+r32;
  #define CMASK(P0,P1,t) do{ if(WIN&&(t)>=4)wmask(P0,P1,TM(t)*KVBLK-qrow,hi); }while(0)
  bool resc=false;
  #define START(P0,P1) do{ const float rm=rowmax(P0,P1); resc=false; \
    { const float dl=rm; mhat=fadd_s(mhat,dl); \
      _Pragma("unroll") for(int r=0;r<16;++r){P0[r]=fsub_s(P0[r],dl);P1[r]=fsub_s(P1[r],dl);} \
      _Pragma("unroll") for(int r=0;r<16;++r)negm[r]=-mhat; asm volatile("":"+v"(negm)); } \
    _Pragma("unroll") for(int r=0;r<16;++r)P0[r]=__builtin_amdgcn_exp2f(P0[r]); }while(0)
  #define RESC() do{ if(resc){ asm volatile("s_waitcnt lgkmcnt(0)":::"memory"); \
      _Pragma("unroll") for(int d_=0;d_<2;++d_) _Pragma("unroll") for(int r=0;r<16;++r)o[d_][r]*=wsf[crow(r,hi)]; } }while(0)
  f32x16 pA0,pA1,pB0,pB1;
  int sl_prev=0,sl_cur=0,sl_next=SLOTB;
  #define ROT() do{sl_prev=sl_cur;sl_cur=sl_next;sl_next=(sl_next==(NSLOT-1)*SLOTB)?0:sl_next+SLOTB;}while(0)
  DMA_K(2,2*SLOTB);
  WAIT_BAR(3);
  qkt(pA0,pA1,Kbase,qr,negm,r32,hi);asm volatile("s_nop 15\n\ts_nop 7":"+v"(pA0),"+v"(pA1));CMASK(pA0,pA1,0);
  START(pA0,pA1);
  _Pragma("unroll") for(int r=0;r<16;++r)pA1[r]=__builtin_amdgcn_exp2f(pA1[r]);
  WAIT_BAR(0);
  DMA_K(3,0);DMA_V(1,SLOTB);
  ROT();
  kload8(kf,kp0+sl_cur);
  WAIT_BAR(2);
  s16x4 vlo[8],vhi[8]; u32x4 pw0,pw1,pw2,pw3;
  #define PKW(P,B) cvtpk_s(P[B],P[B+1])
  #define PAF(k) __builtin_bit_cast(bf16x8,pw##k)
  #define VFR(i) (bf16x8){vlo[i][0],vlo[i][1],vlo[i][2],vlo[i][3],vhi[i][0],vhi[i][1],vhi[i][2],vhi[i][3]}
  #define PIN(x) asm volatile("":"+v"(x))
  #define MX3(a,b,c) __builtin_fmaxf(__builtin_fmaxf((a),(b)),(c))
  #define GAPA(MF,A0,A1,A2,A3,W0,W1,PW) do{ MF; sacc+=A0; sacc+=A1; sacc+=A2; sacc+=A3; PIN(sacc); W0; W1; PIN(PW); SBAR(); }while(0)
  #define EX(v) __builtin_amdgcn_exp2f(v)
  #define GAPB(MF,X,B) do{ MF; X[B]=EX(X[B]); X[B+1]=EX(X[B+1]); X[B+2]=EX(X[B+2]); X[B+3]=EX(X[B+3]); PIN(X); SBAR(); }while(0)
  #define VRD(i) do{ vlo[i]=vtr(vp_+(((i)>>2)*4096+((i)&3)*1024)); vhi[i]=vtr(vp_+(((i)>>2)*4096+((i)&3)*1024+512)); }while(0)
  #define KRD(G,j) do{ if(G){ kload2(kf,kp0+sl_next,j); SBAR(); } }while(0)
  #define STEP(C0,C1,P0,P1,t,GK,GV,GL) do{ SBAR(); \
    const lds_cptr vp_=vp0+sl_prev; \
    VRD(0); SBAR(); float sacc=(P0[0]+P0[1]); \
    GAPA(C0=__builtin_amdgcn_mfma_f32_32x32x16_bf16(kf[0],qr[0],negm,0,0,0), P0[2],P0[3],P0[4],P0[5],     pw0[0]=PKW(P0,0), pw0[1]=PKW(P0,2), pw0); \
    VRD(4); SBAR(); GAPA(C1=__builtin_amdgcn_mfma_f32_32x32x16_bf16(kf[1],qr[0],negm,0,0,0), P0[6],P0[7],P0[8],P0[9],     pw0[2]=PKW(P0,4), pw0[3]=PKW(P0,6), pw0); \
    VRD(1); SBAR(); GAPA(C0=__builtin_amdgcn_mfma_f32_32x32x16_bf16(kf[2],qr[1],C0,0,0,0),   P0[10],P0[11],P0[12],P0[13], pw1[0]=PKW(P0,8), pw1[1]=PKW(P0,10), pw1); \
    VRD(5); SBAR(); GAPA(C1=__builtin_amdgcn_mfma_f32_32x32x16_bf16(kf[3],qr[1],C1,0,0,0),   P0[14],P0[15],P1[0],P1[1],   pw1[2]=PKW(P0,12),pw1[3]=PKW(P0,14), pw1); \
    VRD(2); SBAR(); GAPA(C0=__builtin_amdgcn_mfma_f32_32x32x16_bf16(kf[4],qr[2],C0,0,0,0),   P1[2],P1[3],P1[4],P1[5],     pw2[0]=PKW(P1,0), pw2[1]=PKW(P1,2), pw2); \
    VRD(6); SBAR(); GAPA(C1=__builtin_amdgcn_mfma_f32_32x32x16_bf16(kf[5],qr[2],C1,0,0,0),   P1[6],P1[7],P1[8],P1[9],     pw2[2]=PKW(P1,4), pw2[3]=PKW(P1,6), pw2); \
    VRD(3); SBAR(); GAPA(C0=__builtin_amdgcn_mfma_f32_32x32x16_bf16(kf[6],qr[3],C0,0,0,0),   P1[10],P1[11],P1[12],P1[13], pw3[0]=PKW(P1,8), pw3[1]=PKW(P1,10), pw3); \
    VRD(7); SBAR(); GAPA(C1=__builtin_amdgcn_mfma_f32_32x32x16_bf16(kf[7],qr[3],C1,0,0,0),   P1[14],P1[15],0.f,0.f,       pw3[2]=PKW(P1,12),pw3[3]=PKW(P1,14), pw3); \
    l_reg+=sacc; \
    if(GK){DMA_K((t)+3,sl_cur);} if(GV){DMA_V((t)+1,sl_next);} \
    CMASK(C0,C1,t); \
    { float a=MX3(C0[0],C0[1],C1[0]),b=MX3(C0[2],C0[3],C1[1]); a=MX3(a,C1[2],C1[3]); \
      _Pragma("unroll") for(int r=4;r<16;r+=4){a=MX3(a,C0[r],C0[r+1]);b=MX3(b,C0[r+2],C0[r+3]);a=MX3(a,C1[r],C1[r+1]);b=MX3(b,C1[r+2],C1[r+3]);} \
      float rm=__builtin_fmaxf(a,b); { auto rr=__builtin_amdgcn_permlane32_swap(__float_as_uint(rm),__float_as_uint(rm),false,false); rm=__builtin_fmaxf(__uint_as_float(rr[0]),__uint_as_float(rr[1])); } \
      resc=false; \
      if(__builtin_expect(__any(rm>(float)THRL),0)){ const float dl=__builtin_fmaxf(rm,0.f); mhat+=dl; \
        _Pragma("unroll") for(int r=0;r<16;++r){C0[r]-=dl;C1[r]-=dl;} \
        _Pragma("unroll") for(int r=0;r<16;++r)negm[r]=-mhat; asm volatile("":"+v"(negm)); \
        const float f=__builtin_amdgcn_exp2f(-dl); l_reg*=f; if(hi==0)wsf[r32]=f; resc=true; } } \
    SBAR(); \
    GAPB(o[0]=__builtin_amdgcn_mfma_f32_32x32x16_bf16(PAF(0),VFR(0),o[0],0,0,0), C0,0); \
    GAPB(o[1]=__builtin_amdgcn_mfma_f32_32x32x16_bf16(PAF(0),VFR(4),o[1],0,0,0), C0,4); \
    KRD(GL,0); GAPB(o[0]=__builtin_amdgcn_mfma_f32_32x32x16_bf16(PAF(1),VFR(1),o[0],0,0,0), C0,8); \
    KRD(GL,1); GAPB(o[1]=__builtin_amdgcn_mfma_f32_32x32x16_bf16(PAF(1),VFR(5),o[1],0,0,0), C0,12); \
    KRD(GL,2); GAPB(o[0]=__builtin_amdgcn_mfma_f32_32x32x16_bf16(PAF(2),VFR(2),o[0],0,0,0), C1,0); \
    KRD(GL,3); GAPB(o[1]=__builtin_amdgcn_mfma_f32_32x32x16_bf16(PAF(2),VFR(6),o[1],0,0,0), C1,4); \
    GAPB(o[0]=__builtin_amdgcn_mfma_f32_32x32x16_bf16(PAF(3),VFR(3),o[0],0,0,0), C1,8); \
    GAPB(o[1]=__builtin_amdgcn_mfma_f32_32x32x16_bf16(PAF(3),VFR(7),o[1],0,0,0), C1,12); \
    }while(0)
  int t=1;
  for(;t+5<NT;t+=2){
    STEP(pB0,pB1,pA0,pA1,t,true,true,true);     WAIT_BAR(2); RESC(); ROT();
    STEP(pA0,pA1,pB0,pB1,t+1,true,true,true);   WAIT_BAR(2); RESC(); ROT();
  }
  #define ENDW(tt) do{ if((tt)+3<NT){WAIT_BAR(2);} else if((tt)+2<NT){WAIT_BAR(1);} else {WAIT_BAR(0);} }while(0)
  for(;t+1<NT;t+=2){
    STEP(pB0,pB1,pA0,pA1,t,(t+3<NT),(t+1<NT),(t+1<NT));       ENDW(t);   RESC(); ROT();
    STEP(pA0,pA1,pB0,pB1,t+1,(t+4<NT),(t+2<NT),(t+2<NT));     ENDW(t+1); RESC(); ROT();
  }
  STEP(pB0,pB1,pA0,pA1,NT-1,false,false,false); RESC();
  { float sacc=pB0[0]+pB0[1]; _Pragma("unroll") for(int r=2;r<16;++r)sacc+=pB0[r]; _Pragma("unroll") for(int r=0;r<16;++r)sacc+=pB1[r]; l_reg+=sacc;
    pw0=(u32x4){PKW(pB0,0),PKW(pB0,2),PKW(pB0,4),PKW(pB0,6)};pw1=(u32x4){PKW(pB0,8),PKW(pB0,10),PKW(pB0,12),PKW(pB0,14)};pw2=(u32x4){PKW(pB1,0),PKW(pB1,2),PKW(pB1,4),PKW(pB1,6)};pw3=(u32x4){PKW(pB1,8),PKW(pB1,10),PKW(pB1,12),PKW(pB1,14)};
    SBAR(); pv(o,vb0+sl_cur,PAF(0),PAF(1),PAF(2),PAF(3)); }
  #undef PKW
  #undef PAF
  #undef VFR
  #undef PIN
  #undef MX3
  #undef GAPA
  #undef GAPB
  #undef EX
  #undef VRD
  #undef KRD
  #undef STEP
  #undef ENDW
  {auto rr=__builtin_amdgcn_permlane32_swap(__float_as_uint(l_reg),__float_as_uint(l_reg),false,false);l_reg=__uint_as_float(rr[0])+__uint_as_float(rr[1]);}
  if(WIN)l_reg+=__builtin_amdgcn_exp2f(sink_l2-mhat);
  if(hi==0)wsf[32+r32]=l_reg;asm volatile("s_waitcnt lgkmcnt(0)":::"memory");
  float rli[16];
  #pragma unroll
  for(int r=0;r<16;++r)rli[r]=__builtin_amdgcn_rcpf(wsf[32+crow(r,hi)]);
  bf16*Ow=Ob+(long)(q0+wid*QBLK)*OP;
  { bf16*stg=(bf16*)(shm+LDS_OST)+wid*2048;
    #pragma unroll
    for(int r=0;r<16;++r){const int orow=crow(r,hi);
      #pragma unroll
      for(int d0=0;d0<2;++d0)stg[orow*64+d0*32+r32]=__float2bfloat16(o[d0][r]*rli[r]);}
    asm volatile("s_waitcnt lgkmcnt(0)":::"memory");
    #pragma unroll
    for(int i=0;i<4;++i){const int row=i*8+(lane>>3),ch=lane&7; const u32x4 v=*(const u32x4*)(stg+row*64+ch*8); ATTN_STORE16(Ow+(long)row*OP+ch*8,v);} }
  asm volatile("s_waitcnt lgkmcnt(0)\n\ts_barrier":::"memory");
  #undef TM
  #undef DMA_K
  #undef DMA_V
  #undef CMASK
  #undef START
  #undef RESC
  #undef ROT
}
constexpr int ATTN_LDS_BYTES=LDS_BYTES;
#undef SBAR
#undef WAIT_BAR
}
#define XB_TMO      128
#define XB_XCNT(j)  (256  + 64 * (j))
#define XB_XSUB(j)  (1280 + 64 * (j))
#define XB_XGEN(j)  (2304 + 64 * (j))
#define XB_TOP      3328
#define XB_TOPGEN   3392
#define XCD_BAR_WORDS 3456
#define XB_SPIN_CAP (1u << 21)

__device__ __forceinline__ unsigned xb_ld(unsigned* p)              { return __hip_atomic_load(p, __ATOMIC_RELAXED, __HIP_MEMORY_SCOPE_AGENT); }
__device__ __forceinline__ unsigned xb_add(unsigned* p, unsigned v) { return __hip_atomic_fetch_add(p, v, __ATOMIC_RELAXED, __HIP_MEMORY_SCOPE_AGENT); }
__device__ __forceinline__ unsigned xb_xcc_id() { return (unsigned)__builtin_amdgcn_s_getreg((3 << 11) | 20) & 0xFu; }
#define XB_SPIN(cond, bar) do { unsigned _sp = 0; while (cond) { __builtin_amdgcn_s_sleep(1); \
    if ((++_sp & 255u) == 0u) { if (xb_ld(&(bar)[XB_TMO])) break; if (_sp > XB_SPIN_CAP) { atomicAdd(&(bar)[XB_TMO], 1u); break; } } } } while (0)

struct XcdBarrier {
    unsigned* bar; unsigned x;
    volatile LAS unsigned* st;
};

__device__ __forceinline__ XcdBarrier xcd_barrier_post(unsigned* bar, volatile LAS unsigned* st) {
    XcdBarrier b; b.bar = bar; b.x = xb_xcc_id(); b.st = st;
    if (threadIdx.x == 0) (void)xb_add(&bar[XB_XCNT(b.x)], 1u);
    return b;
}
__device__ __forceinline__ void xcd_barrier_complete(unsigned* bar, unsigned x, unsigned& nloc, unsigned& nx) {
    const unsigned G = gridDim.x * gridDim.y * gridDim.z;
    unsigned sum, cnt, mine, sp = 0u;
    for (;;) {
        sum = 0u; cnt = 0u; mine = 0u;
#pragma unroll
        for (unsigned j = 0; j < 16; ++j) { const unsigned c = xb_ld(&bar[XB_XCNT(j)]); sum += c; cnt += (c > 0u) ? 1u : 0u; mine = (j == x) ? c : mine; }
        if (sum == G) break;
        __builtin_amdgcn_s_sleep(1);
        if ((++sp & 255u) == 0u) { if (xb_ld(&bar[XB_TMO])) break; if (sp > XB_SPIN_CAP) { atomicAdd(&bar[XB_TMO], 1u); break; } }
    }
    nloc = mine > 0u ? mine : 1u; nx = cnt > 0u ? cnt : 1u;
}

__device__ __forceinline__ void xcd_barrier(const XcdBarrier& b) {
    asm volatile("s_waitcnt vmcnt(0)" ::: "memory");
    __syncthreads();
    if (threadIdx.x == 0) {
        unsigned* bar = b.bar; unsigned bx_ = b.x; asm volatile("" : "+s"(bar), "+s"(bx_));
        __builtin_amdgcn_s_waitcnt(0);
        unsigned nloc = b.st[0], nx = b.st[1];
        if (nloc == 0u) { xcd_barrier_complete(bar, bx_, nloc, nx); b.st[0] = nloc; b.st[1] = nx; }
        const unsigned old = xb_add(&bar[XB_XSUB(bx_)], 1u);
        const unsigned gen = old / nloc;
        if (old + 1u == (gen + 1u) * nloc) {
            __builtin_amdgcn_fence(__ATOMIC_RELEASE, "agent");
            asm volatile("s_waitcnt vmcnt(0)" ::: "memory");
            const unsigned og = xb_add(&bar[XB_TOP], 1u);
            const unsigned tg = og / nx;
            if (og + 1u == (tg + 1u) * nx) xb_add(&bar[XB_TOPGEN], 1u);
            else XB_SPIN(xb_ld(&bar[XB_TOPGEN]) == tg, bar);
            __builtin_amdgcn_fence(__ATOMIC_ACQUIRE, "agent");
            xb_add(&bar[XB_XGEN(bx_)], 1u);
            asm volatile("s_waitcnt vmcnt(0)" ::: "memory");
        } else {
            XB_SPIN(xb_ld(&bar[XB_XGEN(bx_)]) == gen, bar);
            __builtin_amdgcn_fence(__ATOMIC_ACQUIRE, "agent");
            asm volatile("s_waitcnt vmcnt(0)" ::: "memory");
        }
    }
    __syncthreads();
}

#ifndef CVQ0
#define CVQ0 3
#define CVQ1 4
#define CVQ2 3
#define CVQ3 3
#endif
constexpr size_t alup(size_t x) { return (x + 4095) & ~(size_t)4095; }
constexpr size_t CTL_BYTES = 1u << 20;
constexpr size_t SZ_WIN = (size_t)DEPTH * DIN * DM  , SZ_WOUT = (size_t)DEPTH * DM * DM * 2, SZ_WGU = (size_t)DEPTH * NE * 2 * FF * DM  , SZ_WDN = (size_t)DEPTH * NE * DM * FF  ;
constexpr size_t SZ_MODP = (size_t)DEPTH * 16 * 17 * 6144 * 4, SZ_MOD = (size_t)DEPTH * 17 * 6144 * 4;
constexpr size_t SZ_X32 = (size_t)MROWS * DM * 2  , SZ_H = (size_t)MROWS * DM * 2, SZ_P = (size_t)MROWS * DIN * 2, SZ_Y = (size_t)MROWS * DM * 2, SZ_YP = (size_t)MROWS * 2 * DM  ;
constexpr size_t SZ_LIST = (size_t)NE * MROWS * 4, SZ_GW = (size_t)NE * MROWS * 4  , SZ_HS = (size_t)MROWS * 4  ;
constexpr int MAXBLK = (MROWS * 2) / 256 + NE;
static_assert((size_t)MAXBLK * 256 * FF * 2 <= SZ_P, "HMID overlays P");
static_assert((size_t)2 * NB * 4 * NCH * 128 * 64 * 4 <= SZ_H, "KVT overlays H");
static_assert((size_t)2 * NB * 4 * NCH * 128 * 64 * 2 <= SZ_YP, "ST overlays YP");
constexpr size_t WS_CTL = 0;
constexpr size_t WS_WIN = CTL_BYTES, WS_WOUT = WS_WIN + alup(SZ_WIN), WS_WGU = WS_WOUT + alup(SZ_WOUT), WS_WDN = WS_WGU + alup(SZ_WGU);
constexpr size_t WS_MODP = WS_WDN + alup(SZ_WDN), WS_MOD = WS_MODP + alup(SZ_MODP);
constexpr size_t WS_X32 = WS_MOD + alup(SZ_MOD), WS_H = WS_X32 + alup(SZ_X32), WS_P = WS_H + alup(SZ_H), WS_Y = WS_P + alup(SZ_P), WS_YP = WS_Y + alup(SZ_Y);
constexpr size_t WS_LIST = WS_YP + alup(SZ_YP), WS_GW = WS_LIST + alup(SZ_LIST), WS_HS = WS_GW + alup(SZ_GW), WS_END = WS_HS + alup(SZ_HS);
constexpr int CW_BAR = 4096;
constexpr int CW_CNT = 16384;
constexpr int CW_WSC = 24576;

constexpr int RING_BYTES = 131072;
constexpr int LDSCTL_OFF = RING_BYTES;
constexpr int LDS_BYTES = 147456;

#define ATTN_STORE16(p,v) (*(u32x4*)(p)=(v))

#define CAS __attribute__((address_space(4)))
__device__ __forceinline__ const float* inp(int i) {
    const CAS unsigned char* k = (const CAS unsigned char*)__builtin_amdgcn_kernarg_segment_ptr();
    asm volatile("" : "+s"(k));
    return *(const float* const CAS*)(k + 8 * i);
}
#define CBAR() do { asm volatile("" ::: "memory"); __builtin_amdgcn_sched_barrier(0); } while (0)
struct Ctx {
    float* out; unsigned char* ws;
    __device__ __forceinline__ const float* x() const { return inp(0); }
    __device__ __forceinline__ const float* c() const { return inp(1); }
    __device__ __forceinline__ const float* ctx() const { return inp(2); }
    __device__ __forceinline__ const float* c_ctx() const { return inp(3); }
    __device__ __forceinline__ const float* ada_w() const { return inp(4); }
    __device__ __forceinline__ const float* ada_b() const { return inp(5); }
    __device__ __forceinline__ const float* norm1() const { return inp(6); }
    __device__ __forceinline__ const float* norm2() const { return inp(7); }
    __device__ __forceinline__ const float* w_in() const { return inp(8); }
    __device__ __forceinline__ const float* w_out() const { return inp(9); }
    __device__ __forceinline__ const float* ret_decay() const { return inp(10); }
    __device__ __forceinline__ const float* win_gain() const { return inp(11); }
    __device__ __forceinline__ const float* win_sink() const { return inp(12); }
    __device__ __forceinline__ const float* glb_gain() const { return inp(13); }
    __device__ __forceinline__ const float* w_router() const { return inp(14); }
    __device__ __forceinline__ const float* b_router() const { return inp(15); }
    __device__ __forceinline__ const float* w_gu() const { return inp(16); }
    __device__ __forceinline__ const float* w_dn() const { return inp(17); }
};

template <int CTRL> __device__ __forceinline__ float dppx(float v) { return __builtin_bit_cast(float, __builtin_amdgcn_update_dpp(0, __builtin_bit_cast(int, v), CTRL, 0xF, 0xF, true)); }
__device__ __forceinline__ float xor1(float v) { return dppx<0xB1>(v); }
__device__ __forceinline__ float xor2(float v) { return dppx<0x4E>(v); }
__device__ __forceinline__ float wave_sum(float v) {
    v += dppx<0xB1>(v); v += dppx<0x4E>(v); v += dppx<0x141>(v); v += dppx<0x140>(v);
    { const unsigned u = __builtin_bit_cast(unsigned, v); auto r = __builtin_amdgcn_permlane16_swap(u, u, false, false); v = __builtin_bit_cast(float, (unsigned)r[0]) + __builtin_bit_cast(float, (unsigned)r[1]); }
    { const unsigned u = __builtin_bit_cast(unsigned, v); auto r = __builtin_amdgcn_permlane32_swap(u, u, false, false); v = __builtin_bit_cast(float, (unsigned)r[0]) + __builtin_bit_cast(float, (unsigned)r[1]); }
    return v;
}
__device__ __forceinline__ float xor16(float v, int lane) { const unsigned u = __builtin_bit_cast(unsigned, v); auto r = __builtin_amdgcn_permlane16_swap(u, u, false, false);
    return __builtin_bit_cast(float, (lane & 16) ? (unsigned)r[0] : (unsigned)r[1]); }
__device__ __forceinline__ float silu_f(float v) { return v * __builtin_amdgcn_rcpf(1.f + __builtin_amdgcn_exp2f(-LOG2E * v)); }
__device__ __forceinline__ float log2_sigmoid(float x) { return -__builtin_amdgcn_logf(1.0f + __builtin_amdgcn_exp2f(-LOG2E * x)); }
__device__ __forceinline__ float rsq_f(float x) { return __builtin_amdgcn_rsqf(x); }

__device__ __forceinline__ void transpose_item(const float* W, int N, int nsrc0, int k0, bf16_t* WT, int K, int nrow0, LAS float* scr, int lane) {
    float ld_[32];
#pragma unroll
    for (int i = 0; i < 32; ++i) ld_[i] = W[(size_t)(k0 + 2 * i + (lane >> 5)) * N + nsrc0 + (lane & 31)];
#pragma unroll
    for (int i = 0; i < 32; ++i) scr[(2 * i + (lane >> 5)) * 33 + (lane & 31)] = ld_[i];
    asm volatile("s_waitcnt lgkmcnt(0)" ::: "memory");
    const int c = lane & 7;
#pragma unroll
    for (int j = 0; j < 4; ++j) { const int n = (lane >> 3) + 8 * j; const LAS float* s = scr + (8 * c) * 33 + n;
        u32x4 o; o.x = pk2(s[0 * 33], s[1 * 33]); o.y = pk2(s[2 * 33], s[3 * 33]); o.z = pk2(s[4 * 33], s[5 * 33]); o.w = pk2(s[6 * 33], s[7 * 33]);
        *(u32x4*)(WT + (size_t)(nrow0 + n) * K + k0 + 8 * c) = o; }
    asm volatile("s_waitcnt lgkmcnt(0)" ::: "memory");
}
__device__ __forceinline__ unsigned pk4_fp8(float a, float b, float c, float d) { int w = 0; w = __builtin_amdgcn_cvt_pk_fp8_f32(a, b, w, false); w = __builtin_amdgcn_cvt_pk_fp8_f32(c, d, w, true); return (unsigned)w; }
__device__ __forceinline__ unsigned pk4_i8(float a, float b, float c, float d) {
    const int qa = (int)__builtin_fminf(__builtin_fmaxf(__builtin_rintf(a), -127.f), 127.f), qb = (int)__builtin_fminf(__builtin_fmaxf(__builtin_rintf(b), -127.f), 127.f);
    const int qc = (int)__builtin_fminf(__builtin_fmaxf(__builtin_rintf(c), -127.f), 127.f), qd = (int)__builtin_fminf(__builtin_fmaxf(__builtin_rintf(d), -127.f), 127.f);
    return (unsigned)(qa & 255) | ((unsigned)(qb & 255) << 8) | ((unsigned)(qc & 255) << 16) | ((unsigned)qd << 24);
}
__device__ __forceinline__ float wave_max(float v) {
    v = __builtin_fmaxf(v, dppx<0xB1>(v)); v = __builtin_fmaxf(v, dppx<0x4E>(v)); v = __builtin_fmaxf(v, dppx<0x141>(v)); v = __builtin_fmaxf(v, dppx<0x140>(v));
    { const unsigned u = __builtin_bit_cast(unsigned, v); auto r = __builtin_amdgcn_permlane16_swap(u, u, false, false); v = __builtin_fmaxf(__builtin_bit_cast(float, (unsigned)r[0]), __builtin_bit_cast(float, (unsigned)r[1])); }
    { const unsigned u = __builtin_bit_cast(unsigned, v); auto r = __builtin_amdgcn_permlane32_swap(u, u, false, false); v = __builtin_fmaxf(__builtin_bit_cast(float, (unsigned)r[0]), __builtin_bit_cast(float, (unsigned)r[1])); }
    return v;
}
__device__ __forceinline__ f32x4 fp8x4_f32(unsigned w) { typedef float f2_ __attribute__((ext_vector_type(2))); const f2_ lo = __builtin_amdgcn_cvt_pk_f32_fp8((int)w, false), hi = __builtin_amdgcn_cvt_pk_f32_fp8((int)w, true); return (f32x4){lo[0], lo[1], hi[0], hi[1]}; }
constexpr float YP_SCALE = 16.0f, YP_INV = 1.0f / 16.0f;
constexpr float W8_SCALE = 64.0f, W8_INV = 1.0f / 64.0f;
__device__ __forceinline__ void transpose_item8(const float* W, int N, int nsrc0, int k0, unsigned char* WT, int K, int nrow0, LAS float* scr, int lane) {
    float ld_[32];
#pragma unroll
    for (int i = 0; i < 32; ++i) ld_[i] = W[(size_t)(k0 + 2 * i + (lane >> 5)) * N + nsrc0 + (lane & 31)];
#pragma unroll
    for (int i = 0; i < 32; ++i) scr[(2 * i + (lane >> 5)) * 33 + (lane & 31)] = ld_[i];
    asm volatile("s_waitcnt lgkmcnt(0)" ::: "memory");
    const int c = lane & 7;
#pragma unroll
    for (int j = 0; j < 4; ++j) { const int n = (lane >> 3) + 8 * j; const LAS float* s = scr + (8 * c) * 33 + n;
        u32x2 o; o.x = pk4_fp8(s[0 * 33] * W8_SCALE, s[1 * 33] * W8_SCALE, s[2 * 33] * W8_SCALE, s[3 * 33] * W8_SCALE); o.y = pk4_fp8(s[4 * 33] * W8_SCALE, s[5 * 33] * W8_SCALE, s[6 * 33] * W8_SCALE, s[7 * 33] * W8_SCALE);
        *(u32x2*)(WT + (size_t)(nrow0 + n) * K + k0 + 8 * c) = o; }
    asm volatile("s_waitcnt lgkmcnt(0)" ::: "memory");
}
__device__ __forceinline__ void transpose_item_i8(const float* W, int N, int nsrc0, int k0, unsigned char* WT, int K, int nrow0, LAS float* scr, int lane, float inv) {
    float ld_[32];
#pragma unroll
    for (int i = 0; i < 32; ++i) ld_[i] = W[(size_t)(k0 + 2 * i + (lane >> 5)) * N + nsrc0 + (lane & 31)];
#pragma unroll
    for (int i = 0; i < 32; ++i) scr[(2 * i + (lane >> 5)) * 33 + (lane & 31)] = ld_[i];
    asm volatile("s_waitcnt lgkmcnt(0)" ::: "memory");
    const int c = lane & 7;
#pragma unroll
    for (int j = 0; j < 4; ++j) { const int n = (lane >> 3) + 8 * j; const LAS float* s = scr + (8 * c) * 33 + n;
        u32x2 o; o.x = pk4_i8(s[0 * 33] * inv, s[1 * 33] * inv, s[2 * 33] * inv, s[3 * 33] * inv); o.y = pk4_i8(s[4 * 33] * inv, s[5 * 33] * inv, s[6 * 33] * inv, s[7 * 33] * inv);
        *(u32x2*)(WT + (size_t)(nrow0 + n) * K + k0 + 8 * c) = o; }
    asm volatile("s_waitcnt lgkmcnt(0)" ::: "memory");
}
constexpr int IT_WIN = 16 * 80, IT_WOUT = 16 * 32, IT_GU = 16 * 64, IT_DN = 16 * 32, IT_LAYER = IT_WIN + IT_WOUT + NE * (IT_GU + IT_DN);
__device__ __forceinline__ void convert_item(const Ctx& C, int l, int r, LAS float* scr, int lane) {
    if (r < IT_WIN) { const int kb = r / 80, nb = r % 80;
        const float sc = __builtin_bit_cast(float, ((const unsigned*)(C.ws + WS_CTL))[CW_WSC + 17 * l]);
        transpose_item_i8(C.w_in() + (size_t)l * DM * DIN, DIN, 32 * nb, 64 * kb, (unsigned char*)(C.ws + WS_WIN) + (size_t)l * DIN * DM, DM, 32 * nb, scr, lane, 1.0f / sc); return; }
    r -= IT_WIN;
    if (r < IT_WOUT) { const int kb = r / 32, nb = r % 32;
        transpose_item(C.w_out() + (size_t)l * DM * DM, DM, 32 * nb, 64 * kb, (bf16_t*)(C.ws + WS_WOUT) + (size_t)l * DM * DM, DM, 32 * nb, scr, lane); return; }
    r -= IT_WOUT;
    if (r < NE * IT_GU) { const int e = r / IT_GU, q = r % IT_GU, kb = q / 64, nb = q % 64;
        const int np = 32 * nb, tile = np >> 8, within = np & 255, nsrc = within < 128 ? tile * 128 + within : FF + tile * 128 + within - 128;
        const float sc = __builtin_bit_cast(float, ((const unsigned*)(C.ws + WS_CTL))[CW_WSC + 17 * l + 1 + e]);
        transpose_item_i8(C.w_gu() + (size_t)(l * NE + e) * DM * 2 * FF, 2 * FF, nsrc, 64 * kb, (unsigned char*)(C.ws + WS_WGU) + (size_t)(l * NE + e) * 2 * FF * DM, DM, np, scr, lane, 1.0f / sc); return; }
    r -= NE * IT_GU;
    { const int e = r / IT_DN, q = r % IT_DN, kb = q / 32, nb = q % 32;
        transpose_item8(C.w_dn() + (size_t)(l * NE + e) * FF * DM, DM, 32 * nb, 64 * kb, (unsigned char*)(C.ws + WS_WDN) + (size_t)(l * NE + e) * DM * FF, FF, 32 * nb, scr, lane); }
}
__device__ __forceinline__ int cv_lo(int p) { return p == 0 ? 0 : p == 1 ? 3840 : p == 2 ? 13056 : p == 3 ? 19712 : IT_LAYER; }
__device__ __forceinline__ int cv_q(int p) { return p == 0 ? CVQ0 : p == 1 ? CVQ1 : p == 2 ? CVQ2 : CVQ3; }
__device__ __forceinline__ int cv_covered(int p, int units, int G) { const int rem = units % G; if (rem == 0) return 0; const int n = (G - rem) * 8 * cv_q(p), len = cv_lo(p + 1) - cv_lo(p); return n < len ? n : len; }
__device__ __forceinline__ void convert_tail(const Ctx& C, int lnext, int p, int units, int G, int c, LAS unsigned char* lds, int wave, int lane) {
    const int rem = units % G; if (rem == 0 || c < rem) return;
    const int nidle = G - rem, k = c - rem, lo = cv_lo(p), hi = cv_lo(p + 1);
    LAS float* scr = (LAS float*)(lds + wave * 16384);
    for (int j = 0; j < cv_q(p); ++j) { const int it = lo + (j * nidle + k) * 8 + wave; if (it < hi) convert_item(C, lnext, it, scr, lane); }
}
__device__ __forceinline__ void convert_rest(const Ctx& C, int l, int G, int vcu, LAS unsigned char* lds, int wave, int lane, int units2, int units3) {
    LAS float* scr = (LAS float*)(lds + wave * 16384);
    const int gw = vcu * 8 + wave, NGW = G * 8;
    const int lo0 = cv_lo(0) + cv_covered(0, (MROWS / 256) * (DIN / 256), G), lo1 = cv_lo(1) + cv_covered(1, (MROWS / 256) * (DM / 256), G), lo2 = cv_lo(2) + cv_covered(2, units2, G), lo3 = cv_lo(3) + cv_covered(3, units3, G);
    const int n0 = cv_lo(1) - lo0, n1 = cv_lo(2) - lo1, n2 = cv_lo(3) - lo2, n3 = cv_lo(4) - lo3;
    for (int v = gw; v < n0 + n1 + n2 + n3; v += NGW) { int r = v, it;
        if (r < n0) it = lo0 + r; else { r -= n0; if (r < n1) it = lo1 + r; else { r -= n1; if (r < n2) it = lo2 + r; else it = lo3 + (r - n2); } }
        convert_item(C, l, it, scr, lane); }
}
__device__ __forceinline__ void phase_prologue(const Ctx& C, LAS unsigned char* lds, int G, int vcu, int bx, int tid) {
    const int lane = tid & 63, wave = tid >> 6;
    {
        LAS float* scs = (LAS float*)lds;
        bool have = false;
        for (int it = bx; it < DEPTH * 12 * 16; it += G) {
            if (!have) {
                for (int i = tid; i < 17 * DM; i += 512) { const int r = i >> 10, k = i & 1023; const float v = r < 16 ? C.c()[r * DM + k] : C.c_ctx()[k]; scs[i] = v / (1.f + expf(-v)); }
                __syncthreads(); have = true;
            }
            const int l = it / 192, rem = it % 192, cb = rem / 16, kc = rem % 16;
            const float* w = C.ada_w() + ((size_t)l * DM + kc * 64) * 6144 + cb * 512 + tid;
            float acc[17];
#pragma unroll
            for (int r = 0; r < 17; ++r) acc[r] = 0.f;
#pragma unroll 4
            for (int kk = 0; kk < 64; ++kk) { const float wv = w[(size_t)kk * 6144];
#pragma unroll
                for (int r = 0; r < 17; ++r) acc[r] += scs[r * DM + kc * 64 + kk] * wv; }
            float* mp = (float*)(C.ws + WS_MODP) + ((size_t)(l * 16 + kc) * 17) * 6144 + cb * 512 + tid;
#pragma unroll
            for (int r = 0; r < 17; ++r) mp[(size_t)r * 6144] = acc[r];
        }
        __syncthreads();
    }
    for (int id = bx; id < DEPTH * 17; id += G) {
        const int l = id / 17, t = id % 17; const float* W = t == 0 ? C.w_in() + (size_t)l * DM * DIN : C.w_gu() + (size_t)(l * NE + t - 1) * DM * 2 * FF; const size_t n = t == 0 ? (size_t)DM * DIN : (size_t)DM * 2 * FF;
        float ss = 0.f;
        for (int i = tid; i < 8192; i += 512) { const float v = W[(size_t)i * (n / 8192) + (i & 63)]; ss += v * v; }
        ss = wave_sum(ss); LAS float* red = (LAS float*)(lds + 131072 - 64);
        __syncthreads(); if (lane == 0) red[wave] = ss; __syncthreads();
        if (tid == 0) { float tot = 0.f; for (int w = 0; w < 8; ++w) tot += red[w]; const float sc = 6.0f * sqrtf(tot * (1.f / 8192.f)) * (1.f / 127.f);
            __hip_atomic_store((unsigned*)(C.ws + WS_CTL) + CW_WSC + id, __builtin_bit_cast(unsigned, sc > 0.f ? sc : 1.0f), __ATOMIC_RELAXED, __HIP_MEMORY_SCOPE_AGENT); }
        __syncthreads();
    }
    LAS float* scr = (LAS float*)(lds + wave * 16384);
    const int gw = vcu * 8 + wave, NGW = G * 8;
    for (int v = gw; v < IT_WOUT + NE * IT_DN; v += NGW) convert_item(C, 0, v < IT_WOUT ? IT_WIN + v : IT_WIN + IT_WOUT + NE * IT_GU + (v - IT_WOUT), scr, lane);
}
__device__ __forceinline__ void phase_modsum(const Ctx& C, int G, int bx, int tid, int vcu, LAS unsigned char* lds) {
    const float* mp = (const float*)(C.ws + WS_MODP); float* mod = (float*)(C.ws + WS_MOD);
    for (int i = bx * 512 + tid; i < DEPTH * 17 * 6144; i += G * 512) {
        const int l = i / (17 * 6144), rem = i % (17 * 6144), r = rem / 6144, n = rem % 6144;
        float s = C.ada_b()[l * 6144 + n];
#pragma unroll
        for (int kc = 0; kc < 16; ++kc) s += mp[((size_t)(l * 16 + kc) * 17 + r) * 6144 + n];
        mod[i] = s;
    }
    { const int lane = tid & 63, wave = tid >> 6; LAS float* scr = (LAS float*)(lds + wave * 16384); const int gw = vcu * 8 + wave, NGW = G * 8;
      for (int v = gw; v < IT_WIN + NE * IT_GU; v += NGW) convert_item(C, 0, v < IT_WIN ? v : IT_WOUT + v, scr, lane); }
}

__device__ __forceinline__ f32x4 bf4(u32x2 a) { return (f32x4){bflo(a.x), bfhi(a.x), bflo(a.y), bfhi(a.y)}; }
__device__ __forceinline__ u32x2 pk4(f32x4 v) { u32x2 w; w.x = pk2(v[0], v[1]); w.y = pk2(v[2], v[3]); return w; }
__device__ __forceinline__ void phase_norm1(const Ctx& C, int layer, int gw, int NGW, int lane, bf16_t* XO) {
    const float* mod = (const float*)(C.ws + WS_MOD) + (size_t)layer * 17 * 6144;
    const float* gain = C.norm1() + layer * DM;
    bf16_t* XR = (bf16_t*)(C.ws + WS_X32); unsigned char* H = (unsigned char*)(C.ws + WS_H); float* HS = (float*)(C.ws + WS_HS); const unsigned char* YP = (const unsigned char*)(C.ws + WS_YP);
    const float* xin = C.x(); const float* cin = C.ctx();
    f32x4 nx[4]; u32x2 nr[4]; unsigned na[4], nb[4];
#define N1_LOAD(mm) do { const int b_ = (mm) / TPB, t_ = (mm) - b_ * TPB; \
        if (layer == 0) { const f32x4* s_ = (const f32x4*)(t_ < CTX ? cin + ((size_t)b_ * CTX + t_) * DM : xin + ((size_t)b_ * SEQ + (t_ - CTX)) * DM) + lane; \
            _Pragma("unroll") for (int j = 0; j < 4; ++j) nx[j] = s_[64 * j]; } \
        else { const u32x2* s_ = (const u32x2*)(XR + (size_t)(mm) * DM) + lane; const unsigned* y0_ = (const unsigned*)(YP + (size_t)(mm) * 2 * DM) + lane; \
            _Pragma("unroll") for (int j = 0; j < 4; ++j) { nr[j] = s_[64 * j]; na[j] = y0_[64 * j]; nb[j] = y0_[DM / 4 + 64 * j]; } } } while (0)
    if (gw < MROWS) N1_LOAD(gw);
    for (int m = gw; m < MROWS; m += NGW) {
        const int b = m / TPB, t = m - b * TPB, set = t < CTX ? 16 : b;
        f32x4 v[4];
        if (layer == 0) {
#pragma unroll
            for (int j = 0; j < 4; ++j) v[j] = nx[j];
        } else {
            const f32x4* g2 = (const f32x4*)(mod - 17 * 6144 + (size_t)set * 6144 + 5 * DM) + lane;
#pragma unroll
            for (int j = 0; j < 4; ++j) v[j] = bf4(nr[j]) + (g2[64 * j] * YP_INV) * (fp8x4_f32(na[j]) + fp8x4_f32(nb[j]));
        }
        if (m + NGW < MROWS) N1_LOAD(m + NGW);
        u32x2* xo = (u32x2*)(XO + (size_t)m * DM) + lane;
        float ss = 0.f;
#pragma unroll
        for (int j = 0; j < 4; ++j) { xo[64 * j] = pk4(v[j]); ss += (v[j][0] * v[j][0] + v[j][1] * v[j][1]) + (v[j][2] * v[j][2] + v[j][3] * v[j][3]); }
        const float rstd = rsq_f(wave_sum(ss) * (1.f / DM) + EPS);
        const f32x4* gp = (const f32x4*)gain + lane; const f32x4* shp = (const f32x4*)(mod + (size_t)set * 6144) + lane; const f32x4* scp = shp + DM / 4;
        float mx = 0.f;
#pragma unroll
        for (int j = 0; j < 4; ++j) { v[j] = (v[j] * rstd) * gp[64 * j] * (scp[64 * j] + 1.0f) + shp[64 * j];
            mx = __builtin_fmaxf(mx, __builtin_fmaxf(__builtin_fmaxf(__builtin_fabsf(v[j][0]), __builtin_fabsf(v[j][1])), __builtin_fmaxf(__builtin_fabsf(v[j][2]), __builtin_fabsf(v[j][3])))); }
        mx = __builtin_fmaxf(wave_max(mx), 1e-20f); const float inv = 127.0f / mx;
        if (lane == 0) HS[m] = mx * (1.0f / 127.0f);
        unsigned* ho = (unsigned*)(H + (size_t)m * DM) + lane;
#pragma unroll
        for (int j = 0; j < 4; ++j) ho[64 * j] = pk4_i8(v[j][0] * inv, v[j][1] * inv, v[j][2] * inv, v[j][3] * inv);
    }
#undef N1_LOAD
}

__device__ __forceinline__ float swz_xor4(float v) { return __builtin_bit_cast(float, __builtin_amdgcn_ds_swizzle(__builtin_bit_cast(int, v), 0x101F)); }
__device__ __forceinline__ float swz_xor8(float v) { return __builtin_bit_cast(float, __builtin_amdgcn_ds_swizzle(__builtin_bit_cast(int, v), 0x201F)); }
__device__ __forceinline__ void phase_qkprep(const Ctx& C, int layer, int gw, int NGW, int lane, bf16_t* PO) {
    const bf16_t* P = (const bf16_t*)(C.ws + WS_P);
    const int hs = lane >> 3, j = lane & 7;
    const int col0 = (hs < 4 ? C_WQ + 64 * hs : hs < 6 ? C_WK + 64 * (hs - 4) : C_GQ + 64 * (hs - 6)) + 8 * j;
    const int col1 = (hs < 2 ? C_GQ + 128 + 64 * hs : C_GK + 64 * ((hs - 2) & 1)) + 8 * j;
    float g0[8], g1[8], inv[8];
    { const float* wg = C.win_gain() + layer * 128; const float* gg = C.glb_gain() + layer * 128;
      const float* s0p = hs < 4 ? wg : hs < 6 ? wg + 64 : gg; const float sc0 = (hs < 4 || hs >= 6) ? QSCALE : 1.f;
      const float* s1p = hs < 2 ? gg : gg + 64; const float sc1 = hs < 2 ? QSCALE : 1.f;
#pragma unroll
      for (int i = 0; i < 8; ++i) { g0[i] = s0p[8 * j + i] * sc0; g1[i] = s1p[8 * j + i] * sc1; inv[i] = __builtin_amdgcn_exp2f(-(float)(8 * (j & 1) + i) * (13.287712379549449f / 16.0f)); } }
    const bool x2 = (j & 2) != 0, colax = (j & 4) != 0, act1 = lane < 32;
    u32x4 w0 = {0u, 0u, 0u, 0u}, w1 = {0u, 0u, 0u, 0u};
    if (gw < MROWS) { const bf16_t* row = P + (size_t)gw * DIN; w0 = *(const u32x4*)(row + col0); if (act1) w1 = *(const u32x4*)(row + col1); }
    for (int m = gw; m < MROWS; m += NGW) {
        const u32x4 c0 = w0, c1 = w1;
        if (m + NGW < MROWS) { const bf16_t* row = P + (size_t)(m + NGW) * DIN; w0 = *(const u32x4*)(row + col0); if (act1) w1 = *(const u32x4*)(row + col1); }
        const int b = m / TPB, t = m - b * TPB; const bool isx = t >= CTX; const int pos = t - CTX;
        float cs[8], sn[8];
        if (isx) { const float pv = (float)(colax ? (pos & 63) : (pos >> 6));
#pragma unroll
            for (int i = 0; i < 8; ++i) { const float ang = pv * inv[i]; cs[i] = __cosf(ang); sn[i] = x2 ? __sinf(ang) : -__sinf(ang); } }
        else {
#pragma unroll
            for (int i = 0; i < 8; ++i) { cs[i] = 1.f; sn[i] = 0.f; } }
        bf16_t* orow = PO + (size_t)m * (PO == P ? DIN : 256);
#pragma unroll
        for (int pass = 0; pass < 2; ++pass) {
            const u32x4 w = pass ? c1 : c0;
            float x[8] = {bflo(w.x), bfhi(w.x), bflo(w.y), bfhi(w.y), bflo(w.z), bfhi(w.z), bflo(w.w), bfhi(w.w)};
            float ss = 0.f;
#pragma unroll
            for (int i = 0; i < 8; ++i) ss += x[i] * x[i];
            ss += xor1(ss); ss += xor2(ss); ss += swz_xor4(ss);
            const float r = rsq_f(ss * (1.f / 64.f) + EPS);
            float y[8];
#pragma unroll
            for (int i = 0; i < 8; ++i) { x[i] = x[i] * r * (pass ? g1[i] : g0[i]); }
#pragma unroll
            for (int i = 0; i < 8; ++i) { const float pr = xor2(x[i]); y[i] = x[i] * cs[i] + pr * sn[i]; }
            u32x4 o; o.x = pk2(y[0], y[1]); o.y = pk2(y[2], y[3]); o.z = pk2(y[4], y[5]); o.w = pk2(y[6], y[7]);
            const int col = pass ? col1 : col0;
            if (pass == 0 || act1) *(u32x4*)(orow + (PO == P ? col : (col & 127))) = o;
        }
    }
}

__device__ __forceinline__ unsigned off_v(unsigned row, unsigned ch) { return 256u * row + 16u * (ch ^ (((row & 3) << 2) | ((row >> 2) & 3))); }
__device__ __forceinline__ unsigned off_k(unsigned row, unsigned ch) { return 128u * row + 16u * (ch ^ (row & 7)); }
typedef short s16x4_t __attribute__((ext_vector_type(4)));
__device__ __forceinline__ s16x4_t tr_rd(const LAS unsigned char* p) { return __builtin_bit_cast(s16x4_t, __builtin_amdgcn_ds_read_tr16_b64_v4i16((LAS s16x4_t*)p)); }
template <bool KIMG> __device__ __forceinline__ bf16x8 tr_frag(const LAS unsigned char* img, int lane, int rbase, int r0off, int r1off, int cblk) {
    const unsigned blk = (lane >> 4) & 1, q = (lane & 15) >> 2, pp = lane & 3, ch = 4 * cblk + 2 * blk + (pp >> 1);
    const unsigned ra = rbase + r0off + q, rb = rbase + r1off + q;
    const s16x4_t lo = tr_rd(img + (KIMG ? off_k(ra, ch) : off_v(ra, ch)) + 8 * (pp & 1)), hi = tr_rd(img + (KIMG ? off_k(rb, ch) : off_v(rb, ch)) + 8 * (pp & 1));
    return (bf16x8){lo[0], lo[1], lo[2], lo[3], hi[0], hi[1], hi[2], hi[3]};
}
__device__ __forceinline__ void stage_v(const bf16_t* P, size_t r0, int h, LAS unsigned char* img, int tid) {
#pragma unroll
    for (int i = 0; i < 4; ++i) { const int p_ = tid + 512 * i, j = p_ >> 4, ch = p_ & 15;
        *(LAS u32x4*)(img + off_v(j, ch)) = *(const u32x4*)(P + (r0 + j) * DIN + C_RV + h * 128 + 8 * ch); }
}
__device__ __forceinline__ void ret_r1_all(const Ctx& C, int layer, int bx, int G, LAS unsigned char* lds, int tid) {
    int lane = tid & 63; asm volatile("" : "+v"(lane));
    const int wid = tid >> 6;
    const bf16_t* P = (const bf16_t*)(C.ws + WS_P); float* KVT = (float*)(C.ws + WS_H);
    LAS unsigned char* Vi = lds; LAS unsigned char* Kf = lds + 32768; LAS unsigned char* Kb = lds + 49152;
    const float* dec = C.ret_decay() + layer * 8;
    const int NU = NB * 4 * NCH;
    int u = bx; if (u >= NU) return;
    u32x4 kreg[2], vreg[4];
#define R1_LOAD(u_) do { const int c_ = (u_) % NCH, bh_ = (u_) / NCH, h_ = bh_ & 3; const size_t r0_ = (size_t)(bh_ >> 2) * TPB + c_ * 128; \
        _Pragma("unroll") for (int i = 0; i < 2; ++i) { const int p_ = tid + 512 * i, j = p_ >> 3, ch = p_ & 7; kreg[i] = *(const u32x4*)(P + (r0_ + j) * DIN + C_RK + h_ * 64 + 8 * ch); } \
        _Pragma("unroll") for (int i = 0; i < 4; ++i) { const int p_ = tid + 512 * i, j = p_ >> 4, ch = p_ & 15; vreg[i] = *(const u32x4*)(P + (r0_ + j) * DIN + C_RV + h_ * 128 + 8 * ch); } } while (0)
    R1_LOAD(u);
    for (;;) {
        const int c = u % NCH, bh = u / NCH, b = bh >> 2, h = bh & 3;
        const float lf = log2_sigmoid(dec[h]), lb = log2_sigmoid(dec[4 + h]);
#pragma unroll
        for (int i = 0; i < 2; ++i) { const int p_ = tid + 512 * i, j = p_ >> 3, ch = p_ & 7; const u32x4 w = kreg[i];
            const float zf = __builtin_amdgcn_exp2f((float)(127 - j) * lf) * 0.125f, zb = __builtin_amdgcn_exp2f((float)j * lb) * 0.125f;
            const float x[8] = {bflo(w.x), bfhi(w.x), bflo(w.y), bfhi(w.y), bflo(w.z), bfhi(w.z), bflo(w.w), bfhi(w.w)};
            u32x4 of, ob; of.x = pk2(x[0] * zf, x[1] * zf); of.y = pk2(x[2] * zf, x[3] * zf); of.z = pk2(x[4] * zf, x[5] * zf); of.w = pk2(x[6] * zf, x[7] * zf);
            ob.x = pk2(x[0] * zb, x[1] * zb); ob.y = pk2(x[2] * zb, x[3] * zb); ob.z = pk2(x[4] * zb, x[5] * zb); ob.w = pk2(x[6] * zb, x[7] * zb);
            *(LAS u32x4*)(Kf + off_k(j, ch)) = of; *(LAS u32x4*)(Kb + off_k(j, ch)) = ob; }
#pragma unroll
        for (int i = 0; i < 4; ++i) { const int p_ = tid + 512 * i, j = p_ >> 4, ch = p_ & 15; *(LAS u32x4*)(Vi + off_v(j, ch)) = vreg[i]; }
        const int un = u + G;
        if (un < NU) R1_LOAD(un);
        __syncthreads();
        const int mb = wid >> 1, nb = wid & 1, r = lane & 31, hh = lane >> 5;
        float z0 = 0.f; asm volatile("" : "+v"(z0)); f32x16 af, ab;
#pragma unroll
        for (int i = 0; i < 16; ++i) { af[i] = z0; ab[i] = z0; }
#pragma unroll
        for (int ks = 0; ks < 8; ++ks) {
            const bf16x8 a = tr_frag<false>(Vi, lane, 16 * ks + 8 * hh, 0, 4, mb);
            const bf16x8 bf = tr_frag<true>(Kf, lane, 16 * ks + 8 * hh, 0, 4, nb);
            const bf16x8 bb = tr_frag<true>(Kb, lane, 16 * ks + 8 * hh, 0, 4, nb);
            af = __builtin_amdgcn_mfma_f32_32x32x16_bf16(a, bf, af, 0, 0, 0);
            ab = __builtin_amdgcn_mfma_f32_32x32x16_bf16(a, bb, ab, 0, 0, 0);
        }
        float* of = KVT + ((size_t)((0 * NB + b) * 4 + h) * NCH + c) * 8192; float* ob = KVT + ((size_t)((1 * NB + b) * 4 + h) * NCH + c) * 8192;
#pragma unroll
        for (int reg = 0; reg < 16; ++reg) { const int dv = 32 * mb + (reg & 3) + 8 * (reg >> 2) + 4 * hh, dk = 32 * nb + r; of[dv * 64 + dk] = af[reg]; ob[dv * 64 + dk] = ab[reg]; }
        __syncthreads();
        if (un >= NU) break;
        u = un;
    }
#undef R1_LOAD
}
__device__ __forceinline__ void ret_r2_unit(const Ctx& C, int layer, int u, int tid) {
    const int q = u & 3, bh = (u >> 2) & 63, dir = u >> 8, b = bh >> 2, h = bh & 3;
    const float G = __builtin_amdgcn_exp2f(128.f * log2_sigmoid(C.ret_decay()[(layer * 2 + dir) * 4 + h]));
    const size_t base = ((size_t)((dir * NB + b) * 4 + h) * NCH) * 8192 + q * 2048 + tid * 4;
    const float* KVT = (const float*)(C.ws + WS_H) + base; bf16_t* ST = (bf16_t*)(C.ws + WS_YP) + base;
    float z0 = 0.f; asm volatile("" : "+v"(z0)); f32x4 S = {z0, z0, z0, z0};
#pragma unroll
    for (int half = 0; half < 2; ++half) {
        f32x4 kv[17];
#pragma unroll
        for (int s = 0; s < 17; ++s) { const int step = half * 17 + s; const int c = dir == 0 ? step : (step < 2 ? 1 - step : 35 - step); kv[s] = *(const f32x4*)(KVT + (size_t)c * 8192); }
#pragma unroll
        for (int s = 0; s < 17; ++s) { const int step = half * 17 + s; const int c = dir == 0 ? step : (step < 2 ? 1 - step : 35 - step);
            u32x2 w; w.x = pk2(S[0], S[1]); w.y = pk2(S[2], S[3]); *(u32x2*)(ST + (size_t)c * 8192) = w;
            S = S * G + kv[s]; }
    }
}
__device__ __forceinline__ void ret_r3_all(const Ctx& C, int layer, int bx, int G, LAS unsigned char* lds, int tid) {
    int lane = tid & 63; asm volatile("" : "+v"(lane));
    const int wid = tid >> 6, r = lane & 31, hh = lane >> 5, ib = wid & 3, dh = wid >> 2;
    const bf16_t* P = (const bf16_t*)(C.ws + WS_P);
    LAS unsigned char* Vi = lds;
    LAS float* Ol = (LAS float*)(lds + 32768);
    const float* dec = C.ret_decay() + layer * 8;
    const int NU = NB * 4 * NCH; const bool skipc = layer == DEPTH - 1;
#define R3_NEXT(u_) do { (u_) += G; while ((u_) < NU && skipc && ((u_) % NCH) < 2) (u_) += G; } while (0)
#define R3_ZERO(v) do { float z_ = 0.f; asm volatile("" : "+v"(z_)); _Pragma("unroll") for (int i_ = 0; i_ < 16; ++i_) v[i_] = z_; } while (0)
    int u = bx - G; R3_NEXT(u); if (u >= NU) return;
    u32x4 vreg[4]; bf16x8 qf[4], kf[2][4];
#define R3_LOAD_A(u_) do { const int c_ = (u_) % NCH, bh_ = (u_) / NCH, h_ = bh_ & 3; const size_t r0_ = (size_t)(bh_ >> 2) * TPB + c_ * 128; \
        _Pragma("unroll") for (int i = 0; i < 4; ++i) { const int p_ = tid + 512 * i, j = p_ >> 4, ch = p_ & 15; vreg[i] = *(const u32x4*)(P + (r0_ + j) * DIN + C_RV + h_ * 128 + 8 * ch); } \
        { const bf16_t* Qp = P + (r0_ + 32 * ib + r) * DIN + C_RQ + h_ * 64 + 8 * hh; _Pragma("unroll") for (int ks = 0; ks < 4; ++ks) qf[ks] = *(const bf16x8*)(Qp + 16 * ks); } \
        _Pragma("unroll") for (int jb = 0; jb < 2; ++jb) { const bf16_t* Kp = P + (r0_ + 32 * jb + r) * DIN + C_RK + h_ * 64 + 8 * hh; \
            _Pragma("unroll") for (int ks = 0; ks < 4; ++ks) kf[jb][ks] = *(const bf16x8*)(Kp + 16 * ks); } } while (0)
    R3_LOAD_A(u);
    unsigned lp[2][2];
    { const unsigned blk = (lane >> 4) & 1, q = (lane & 15) >> 2, pp = lane & 3;
#pragma unroll
      for (int t = 0; t < 2; ++t)
#pragma unroll
          for (int cb = 0; cb < 2; ++cb) lp[t][cb] = off_v(4 * hh + 8 * t + q, 4 * (2 * dh + cb) + 2 * blk + (pp >> 1)) + 8 * (pp & 1); }
    for (;;) {
        const int c = u % NCH, bh = u / NCH, b = bh >> 2, h = bh & 3;
        const float lf = log2_sigmoid(dec[h]), lb = log2_sigmoid(dec[4 + h]);
        const size_t r0 = (size_t)b * TPB + c * 128;
        int rq = r, hq = hh; asm volatile("" : "+v"(rq), "+v"(hq));
#pragma unroll
        for (int i = 0; i < 4; ++i) { const int p_ = tid + 512 * i, j = p_ >> 4, ch = p_ & 15; *(LAS u32x4*)(Vi + off_v(j, ch)) = vreg[i]; }
        bf16x8 st[2][4]; u32x4 gwv[4];
        { const bf16_t* sf = (const bf16_t*)(C.ws + WS_YP) + ((size_t)((0 * NB + b) * 4 + h) * NCH + c) * 8192 + (64 * dh + r) * 64 + 8 * hh;
#pragma unroll
          for (int t = 0; t < 2; ++t)
#pragma unroll
              for (int ks = 0; ks < 4; ++ks) st[t][ks] = *(const bf16x8*)(sf + t * 32 * 64 + 16 * ks); }
        __syncthreads();
        f32x16 o[2]; R3_ZERO(o[0]); R3_ZERO(o[1]);
#pragma unroll
        for (int jb = 0; jb < 4; ++jb) {
            if (jb == 1 || jb == 3) {
                const int dir = jb >> 1; f32x16 acc[2];
#pragma unroll
                for (int t = 0; t < 2; ++t) { R3_ZERO(acc[t]);
#pragma unroll
                    for (int ks = 0; ks < 4; ++ks) acc[t] = __builtin_amdgcn_mfma_f32_32x32x16_bf16(qf[ks], st[t][ks], acc[t], 0, 0, 0); }
#pragma unroll
                for (int reg = 0; reg < 16; ++reg) { const int i = 32 * ib + (reg & 3) + 8 * (reg >> 2) + 4 * hq; const float xi = dir == 0 ? __builtin_amdgcn_exp2f((float)(i + 1) * lf) : __builtin_amdgcn_exp2f((float)(128 - i) * lb);
                    o[0][reg] += xi * acc[0][reg]; o[1][reg] += xi * acc[1][reg]; }
                CBAR();
                if (jb == 1) { const bf16_t* sb = (const bf16_t*)(C.ws + WS_YP) + ((size_t)((1 * NB + b) * 4 + h) * NCH + c) * 8192 + (64 * dh + r) * 64 + 8 * hh;
#pragma unroll
                    for (int t = 0; t < 2; ++t)
#pragma unroll
                        for (int ks = 0; ks < 4; ++ks) st[t][ks] = *(const bf16x8*)(sb + t * 32 * 64 + 16 * ks); } }
            f32x16 x; R3_ZERO(x);
#pragma unroll
            for (int ks = 0; ks < 4; ++ks) x = __builtin_amdgcn_mfma_f32_32x32x16_bf16(kf[jb & 1][ks], qf[ks], x, 0, 0, 0);
            if (jb < 2) { const bf16_t* Kp = P + (r0 + 32 * (jb + 2) + r) * DIN + C_RK + h * 64 + 8 * hh;
#pragma unroll
                for (int ks = 0; ks < 4; ++ks) kf[jb & 1][ks] = *(const bf16x8*)(Kp + 16 * ks); }
#pragma unroll
            for (int reg = 0; reg < 16; ++reg) { const int d = (32 * ib + rq) - (32 * jb + (reg & 3) + 8 * (reg >> 2) + 4 * hq);
                const float D = d > 0 ? __builtin_amdgcn_exp2f((float)d * lf) : (d < 0 ? __builtin_amdgcn_exp2f((float)(-d) * lb) : 2.0f); x[reg] *= 0.125f * D; }
#pragma unroll
            for (int s = 0; s < 2; ++s) {
                u32x4 pw; pw.x = pk2(x[8 * s + 0], x[8 * s + 1]); pw.y = pk2(x[8 * s + 2], x[8 * s + 3]); pw.z = pk2(x[8 * s + 4], x[8 * s + 5]); pw.w = pk2(x[8 * s + 6], x[8 * s + 7]);
                const bf16x8 pa = __builtin_bit_cast(bf16x8, pw);
#pragma unroll
                for (int cb = 0; cb < 2; ++cb) { const s16x4_t lo = tr_rd(Vi + lp[0][cb] + (8192 * jb + 4096 * s)), hi = tr_rd(Vi + lp[1][cb] + (8192 * jb + 4096 * s));
                    const bf16x8 vb = (bf16x8){lo[0], lo[1], lo[2], lo[3], hi[0], hi[1], hi[2], hi[3]};
                    o[cb] = __builtin_amdgcn_mfma_f32_32x32x16_bf16(pa, vb, o[cb], 0, 0, 0); }
            }
            CBAR();
        }
        { const bf16_t* gp = P + (r0 + (tid >> 2)) * DIN + C_RG + h * 128 + 32 * (tid & 3);
#pragma unroll
          for (int e2 = 0; e2 < 4; ++e2) gwv[e2] = *(const u32x4*)(gp + 8 * e2); }
#pragma unroll
        for (int cb = 0; cb < 2; ++cb)
#pragma unroll
            for (int reg = 0; reg < 16; ++reg) { const int i = 32 * ib + (reg & 3) + 8 * (reg >> 2) + 4 * hh, dv = 64 * dh + 32 * cb + r; Ol[i * 132 + dv] = o[cb][reg]; }
        __syncthreads();
        int un = u; R3_NEXT(un);
        if (un < NU) R3_LOAD_A(un);
        CBAR();
        { const int row = tid >> 2, q = tid & 3; f32x4 x[8]; float sm = 0.f;
#pragma unroll
          for (int e = 0; e < 8; ++e) { x[e] = *(const LAS f32x4*)(Ol + row * 132 + 32 * q + 4 * e); sm += (x[e][0] + x[e][1]) + (x[e][2] + x[e][3]); }
          sm += xor1(sm); sm += xor2(sm);
          const float mu = sm * (1.f / 128.f); float vs = 0.f;
#pragma unroll
          for (int e = 0; e < 8; ++e) { x[e] = x[e] - mu; vs += (x[e][0] * x[e][0] + x[e][1] * x[e][1]) + (x[e][2] * x[e][2] + x[e][3] * x[e][3]); }
          vs += xor1(vs); vs += xor2(vs);
          const float rstd = rsq_f(vs * (1.f / 128.f) + EPS);
          bf16_t* yp = (bf16_t*)(C.ws + WS_Y) + (r0 + row) * DM + h * 128 + 32 * q;
#pragma unroll
          for (int e2 = 0; e2 < 4; ++e2) { const u32x4 gw = gwv[e2]; const f32x4 a = x[2 * e2] * rstd, bq = x[2 * e2 + 1] * rstd;
              u32x4 ow; ow.x = pk2(a[0] * silu_f(bflo(gw.x)), a[1] * silu_f(bfhi(gw.x))); ow.y = pk2(a[2] * silu_f(bflo(gw.y)), a[3] * silu_f(bfhi(gw.y)));
              ow.z = pk2(bq[0] * silu_f(bflo(gw.z)), bq[1] * silu_f(bfhi(gw.z))); ow.w = pk2(bq[2] * silu_f(bflo(gw.w)), bq[3] * silu_f(bfhi(gw.w)));
              *(u32x4*)(yp + 8 * e2) = ow; } }
        if (un >= NU) break;
        u = un;
    }
#undef R3_NEXT
#undef R3_ZERO
#undef R3_LOAD_A
}

template <bool WIN>
__device__ __forceinline__ void attn_dispatch(const Ctx& C, int layer, int U, int tid, char* lds) {
    using attn_body::bf16;
    int b, h, q0, NT, tdelta;
    if (U < 1024) { b = U >> 6; h = ((U >> 5) & 1) * 2 + ((U >> 4) & 1); q0 = CTX + 256 * (U & 15);
        if (WIN) { const int ts = (q0 / 64 - 2) > 4 ? (q0 / 64 - 2) : 4, te = (q0 / 64 + 6) < 68 ? (q0 / 64 + 6) : 68; NT = 4 + te - ts; tdelta = ts - 4; } else { NT = 68; tdelta = 0; } }
    else { b = (U - 1024) >> 2; h = (U - 1024) & 3; q0 = 0; NT = 4; tdelta = 0; }
    const int kvh = h >> 1;
    const bf16* Pb = (const bf16*)(C.ws + WS_P) + (size_t)b * TPB * DIN; bf16* Yb = (bf16*)(C.ws + WS_Y) + (size_t)b * TPB * DM;
    if (WIN) attn_body::attn_unit<8, true>(Pb + C_WQ + 64 * h, Pb + C_WK + 64 * kvh, Pb + C_WV + 64 * kvh, Yb + 512 + 64 * h, q0, NT, tdelta, C.win_sink()[layer * 4 + h] * LOG2E, tid, lds);
    else     attn_body::attn_unit<8, false>(Pb + C_GQ + 64 * h, Pb + C_GK + 64 * kvh, Pb + C_GV + 64 * kvh, Yb + 768 + 64 * h, q0, NT, tdelta, 0.f, tid, lds);
}
template <bool WIN>
__device__ __forceinline__ void attn_units(const Ctx& C, int layer, int G, int vcu, int bx, int tid, char* lds) {
    const int nctx = (layer == DEPTH - 1) ? 0 : 64;
    if (G == 256) {
        for (int k = 0; k < 4; ++k) attn_dispatch<WIN>(C, layer, vcu * 4 + k, tid, lds);
        if (vcu < nctx) attn_dispatch<WIN>(C, layer, 1024 + vcu, tid, lds);
    } else {
        for (int U = bx; U < 1024 + nctx; U += G) attn_dispatch<WIN>(C, layer, U, tid, lds);
    }
}

__device__ __forceinline__ f32x2 swap32(float a, float b) { auto r = __builtin_amdgcn_permlane32_swap(__builtin_bit_cast(unsigned, a), __builtin_bit_cast(unsigned, b), false, false);
    return (f32x2){__builtin_bit_cast(float, (unsigned)r[0]), __builtin_bit_cast(float, (unsigned)r[1])}; }
__device__ __forceinline__ f32x2 swap16(float a, float b) { auto r = __builtin_amdgcn_permlane16_swap(__builtin_bit_cast(unsigned, a), __builtin_bit_cast(unsigned, b), false, false);
    return (f32x2){__builtin_bit_cast(float, (unsigned)r[0]), __builtin_bit_cast(float, (unsigned)r[1])}; }
__device__ __forceinline__ void phase_norm2_route(const Ctx& C, int layer_c, LAS unsigned char* lds, int G, int bx, int tid) {
    const int layer = layer_c & 3;
    const int lane = tid & 63, wave = tid >> 6;
    const float* mod = (const float*)(C.ws + WS_MOD) + (size_t)layer * 17 * 6144;
    const float* gain = C.norm2() + layer * DM;
    const bf16_t* XR = (const bf16_t*)(C.ws + WS_X32); unsigned char* H = (unsigned char*)(C.ws + WS_H);
    float* LSC = (float*)(C.ws + WS_GW);
    int* list = (int*)(C.ws + WS_LIST);
    unsigned* gcnt = (unsigned*)(C.ws + WS_CTL) + CW_CNT + 64 * layer_c;
    constexpr int RPC = MROWS / 256, RPW = RPC / 8;
    LAS float* wrT = (LAS float*)lds;
    LAS float* lgs = (LAS float*)(lds + 65536);
    LAS int* lcnt = (LAS int*)(lds + 65536 + RPC * 64);
    LAS int* lbase = lcnt + 16;
    LAS int* rec_e = lcnt + 32;
    LAS float* rec_w = (LAS float*)(rec_e + 2 * RPC);
    LAS float* row_s = rec_w + 2 * RPC;
    { const float* wr = C.w_router(); for (int i = tid; i < DM * NE; i += 512) { const int k = i >> 4, e = i & 15; wrT[e * DM + k] = wr[i]; } }
    if (tid < 16) lcnt[tid] = 0;
    __syncthreads();
    const unsigned lo4 = (unsigned)lane * 4u, lo8 = (unsigned)lane * 8u, lo16 = (unsigned)lane * 16u;
#define E_LOADROW(dst, mm) do { const char* xr_ = (const char*)(XR + (size_t)(mm) * DM); _Pragma("unroll") for (int j = 0; j < 4; ++j) dst[j] = *(const u32x2*)(xr_ + (lo8 + 512u * j)); } while (0)
#define E_NORMROW(v, nxr, mm) do { float ss_ = 0.f; _Pragma("unroll") for (int j = 0; j < 4; ++j) { v[j] = bf4(nxr[j]); ss_ += (v[j][0] * v[j][0] + v[j][1] * v[j][1]) + (v[j][2] * v[j][2] + v[j][3] * v[j][3]); } \
        const int b_ = (mm) / TPB, t_ = (mm) - b_ * TPB, set_ = t_ < CTX ? 16 : b_; const float rstd_ = rsq_f(wave_sum(ss_) * (1.f / DM) + EPS); \
        const char* gp_ = (const char*)gain; const char* shp_ = (const char*)(mod + (size_t)set_ * 6144 + 3 * DM); const char* scp_ = shp_ + DM * 4; \
        char* ho_ = (char*)(H + (size_t)(mm) * DM); \
        float mx_ = 0.f; \
        _Pragma("unroll") for (int j = 0; j < 4; ++j) { v[j] = (v[j] * rstd_) * *(const f32x4*)(gp_ + (lo16 + 1024u * j)) * (*(const f32x4*)(scp_ + (lo16 + 1024u * j)) + 1.0f) + *(const f32x4*)(shp_ + (lo16 + 1024u * j)); \
            mx_ = __builtin_fmaxf(mx_, __builtin_fmaxf(__builtin_fmaxf(__builtin_fabsf(v[j][0]), __builtin_fabsf(v[j][1])), __builtin_fmaxf(__builtin_fabsf(v[j][2]), __builtin_fabsf(v[j][3])))); } \
        mx_ = __builtin_fmaxf(wave_max(mx_), 1e-20f); const float inv_ = 127.0f / mx_; if (lane == 0) row_s[(mm) - chunk * RPC] = mx_ * (1.0f / 127.0f); \
        _Pragma("unroll") for (int j = 0; j < 4; ++j) *(unsigned*)(ho_ + (lo4 + 256u * j)) = pk4_i8(v[j][0] * inv_, v[j][1] * inv_, v[j][2] * inv_, v[j][3] * inv_); } while (0)
#define E_REDUCE(pe, rowl) do { float q8_[8], q4_[4], q2_[2]; \
        _Pragma("unroll") for (int e = 0; e < 8; ++e) { const f32x2 r_ = swap32(pe[e], pe[e + 8]); q8_[e] = r_[0] + r_[1]; } \
        _Pragma("unroll") for (int e = 0; e < 4; ++e) { const f32x2 r_ = swap16(q8_[e], q8_[e + 4]); q4_[e] = r_[0] + r_[1]; } \
        _Pragma("unroll") for (int e = 0; e < 2; ++e) { const float keep_ = b3 ? q4_[e + 2] : q4_[e], send_ = b3 ? q4_[e] : q4_[e + 2]; q2_[e] = keep_ + swz_xor8(send_); } \
        float lg_ = (b2 ? q2_[1] : q2_[0]) + swz_xor4(b2 ? q2_[0] : q2_[1]); lg_ += xor2(lg_); lg_ += xor1(lg_); \
        if ((lane & 3) == 0) lgs[(rowl) * 16 + (lane >> 2)] = lg_; } while (0)
    const bool b3 = (lane & 8) != 0, b2 = (lane & 4) != 0;
    for (int chunk = bx; chunk < 256; chunk += G) {
        const int m0 = chunk * RPC + wave * RPW;
        u32x2 nxA[4], nxB[4], fxA[4], fxB[4];
        E_LOADROW(nxA, m0); E_LOADROW(nxB, m0 + 1); E_LOADROW(fxA, m0 + 2); E_LOADROW(fxB, m0 + 3);
        for (int i = 0; i < RPW; i += 2) {
            f32x4 vA[4], vB[4];
            E_NORMROW(vA, nxA, m0 + i);
            E_NORMROW(vB, nxB, m0 + i + 1);
#pragma unroll
            for (int j = 0; j < 4; ++j) { nxA[j] = fxA[j]; nxB[j] = fxB[j]; }
            if (i + 4 < RPW) { E_LOADROW(fxA, m0 + i + 4); E_LOADROW(fxB, m0 + i + 5); }
            float peA[16], peB[16];
            f32x2 hv[4][4];
#pragma unroll
            for (int j = 0; j < 4; ++j)
#pragma unroll
                for (int c = 0; c < 4; ++c) hv[j][c] = (f32x2){vA[j][c], vB[j][c]};
            const LAS float* wl = wrT + 4 * lane; asm volatile("" : "+v"(wl));
#pragma unroll
            for (int e = 0; e < 16; ++e) { f32x2 a2 = {0.f, 0.f};
#pragma unroll
                for (int j = 0; j < 4; ++j) { const f32x4 w = *(const LAS f32x4*)(wl + e * DM + 256 * j);
#pragma unroll
                    for (int c = 0; c < 4; ++c) a2 = __builtin_elementwise_fma(hv[j][c], (f32x2){w[c], w[c]}, a2); }
                peA[e] = a2[0]; peB[e] = a2[1]; }
            E_REDUCE(peA, wave * RPW + i); E_REDUCE(peB, wave * RPW + i + 1);
        }
#undef E_LOADROW
#undef E_NORMROW
#undef E_REDUCE
        asm volatile("s_waitcnt lgkmcnt(0)" ::: "memory");
        const int mrow_ = chunk * RPC + wave * RPW + lane;
        if (lane < RPW && !(layer == DEPTH - 1 && (mrow_ % TPB) < CTX)) {
            const int rl = wave * RPW + lane; const float* br = C.b_router();
            float sg[16], bs[16];
#pragma unroll
            for (int e4 = 0; e4 < 4; ++e4) { const f32x4 l4 = *(const LAS f32x4*)(lgs + rl * 16 + 4 * e4);
#pragma unroll
                for (int k = 0; k < 4; ++k) { sg[4 * e4 + k] = __builtin_amdgcn_rcpf(1.f + __builtin_amdgcn_exp2f(-LOG2E * l4[k])); bs[4 * e4 + k] = sg[4 * e4 + k] + br[4 * e4 + k]; } }
            int grp = 0; float best = -1e30f;
#pragma unroll
            for (int g = 0; g < 4; ++g) { const float a0 = bs[4 * g], a1 = bs[4 * g + 1], a2 = bs[4 * g + 2], a3 = bs[4 * g + 3];
                const float hi01 = fmaxf(a0, a1), lo01 = fminf(a0, a1), hi23 = fmaxf(a2, a3), lo23 = fminf(a2, a3);
                const float top = fmaxf(hi01, hi23), second = fmaxf(fminf(hi01, hi23), hi01 >= hi23 ? lo01 : lo23);
                const float sc = top + second; if (sc > best) { best = sc; grp = g; } }
            float c4[4], s4[4];
#pragma unroll
            for (int k = 0; k < 4; ++k) { c4[k] = grp == 0 ? bs[k] : grp == 1 ? bs[4 + k] : grp == 2 ? bs[8 + k] : bs[12 + k]; s4[k] = grp == 0 ? sg[k] : grp == 1 ? sg[4 + k] : grp == 2 ? sg[8 + k] : sg[12 + k]; }
            int l0 = 0; float mx0 = c4[0];
#pragma unroll
            for (int k = 1; k < 4; ++k) if (c4[k] > mx0) { mx0 = c4[k]; l0 = k; }
            int l1 = -1; float mx1 = -1e30f;
#pragma unroll
            for (int k = 0; k < 4; ++k) if (k != l0 && c4[k] > mx1) { mx1 = c4[k]; l1 = k; }
            const float w0 = l0 == 0 ? s4[0] : l0 == 1 ? s4[1] : l0 == 2 ? s4[2] : s4[3], w1 = l1 == 0 ? s4[0] : l1 == 1 ? s4[1] : l1 == 2 ? s4[2] : s4[3];
            const float wn = 1.f / (w0 + w1);
            const int e0 = grp * 4 + l0, e1 = grp * 4 + l1;
            const int p0 = __hip_atomic_fetch_add(lcnt + e0, 1, __ATOMIC_RELAXED, __HIP_MEMORY_SCOPE_WORKGROUP);
            const int p1 = __hip_atomic_fetch_add(lcnt + e1, 1, __ATOMIC_RELAXED, __HIP_MEMORY_SCOPE_WORKGROUP);
            rec_e[2 * rl] = e0 | (p0 << 8); rec_e[2 * rl + 1] = e1 | (p1 << 8); rec_w[2 * rl] = w0 * wn; rec_w[2 * rl + 1] = w1 * wn;
        } else if (lane < RPW) { const int rl = wave * RPW + lane; rec_e[2 * rl] = -1; rec_e[2 * rl + 1] = -1; }
        __syncthreads();
        if (tid < 16) lbase[tid] = (int)__hip_atomic_fetch_add(gcnt + tid, (unsigned)lcnt[tid], __ATOMIC_RELAXED, __HIP_MEMORY_SCOPE_AGENT);
        __syncthreads();
        for (int i = tid; i < 2 * RPC; i += 512) { const int re = rec_e[i]; if (re < 0) continue; const int e = re & 255, pp = re >> 8; const int id = (chunk * RPC + (i >> 1)) * 2 + (i & 1);
            list[e * MROWS + lbase[e] + pp] = id | ((int)(rec_w[i] * 16383.f + 0.5f) << 18); LSC[e * MROWS + lbase[e] + pp] = row_s[i >> 1]; }
        __syncthreads();
        if (tid < 16) lcnt[tid] = 0;
        __syncthreads();
    }
}

template <bool GATHER_, int NT>
struct MoeOrder {
    static constexpr bool GATHER = GATHER_;
    const int* list; const LAS int* boff; const LAS int* cnt; int G, c;
    __device__ __forceinline__ bool next(int i, pg8::Unit& u) const {
        const int L = i * G + c; if (L >= boff[16] * NT) return false;
        const int blk = L / NT, pn = L - blk * NT; int e = 0;
#pragma unroll
        for (int k = 1; k < 16; ++k) e += (blk >= boff[k]) ? 1 : 0;
        u.pm = blk; u.pn = e * NT + pn; return true;
    }
    __device__ __forceinline__ unsigned arow(const pg8::Unit& u, int r) const {
        const int e = u.pn / NT, li = (u.pm - boff[e]) * 256 + r;
        const int id = li < cnt[e] ? (list[e * MROWS + li] & 0x3FFFF) : 0;
        return (unsigned)(id >> 1);
    }
    __device__ __forceinline__ const int* aptr(const pg8::Unit& u, int r) const { const int e = u.pn / NT, li = (u.pm - boff[e]) * 256 + r; return list + e * MROWS + (li < cnt[e] ? li : 0); }
    __device__ __forceinline__ unsigned tokrow(unsigned w) const { return (w & 0x3FFFFu) >> 1; }
};
struct EpiGateUp {
    static constexpr bool PERM = true, HAS_PRE = false;
    unsigned char* O;
    const float* lsc; const float* wsc; const LAS int* boff;
    __device__ __forceinline__ void operator()(const f32x4 (&acc)[2][2][4][2], const pg8::Unit& u, int wr, int wc, int fr, int fq) const {
        const int row0 = u.pm * 256 + wr * 64 + fr, col0 = (u.pn & 7) * 128 + wc * 32 + 8 * fq;
        const int e = u.pn >> 3, lb = (u.pm - boff[e]) * 256; const float w = wsc[1 + e];
        float sc[2][4];
#pragma unroll
        for (int ai = 0; ai < 2; ++ai)
#pragma unroll
            for (int m = 0; m < 4; ++m) sc[ai][m] = lsc[e * MROWS + lb + ai * 128 + wr * 64 + m * 16 + fr];
#pragma unroll
        for (int ai = 0; ai < 2; ++ai)
#pragma unroll
            for (int m = 0; m < 4; ++m) { const float s = sc[ai][m] * w;
                const f32x4 a0 = pg8::i2f4(acc[ai][0][m][0]) * s, a1 = pg8::i2f4(acc[ai][0][m][1]) * s, u0 = pg8::i2f4(acc[ai][1][m][0]) * s, u1 = pg8::i2f4(acc[ai][1][m][1]) * s;
                u32x2 ww; ww.x = pk4_fp8(silu_f(a0[0]) * u0[0], silu_f(a0[1]) * u0[1], silu_f(a0[2]) * u0[2], silu_f(a0[3]) * u0[3]);
                ww.y = pk4_fp8(silu_f(a1[0]) * u1[0], silu_f(a1[1]) * u1[1], silu_f(a1[2]) * u1[2], silu_f(a1[3]) * u1[3]);
                *(u32x2*)(O + ((unsigned)(row0 + ai * 128 + m * 16) * (unsigned)FF + (unsigned)col0)) = ww; }
    }
};
struct EpiDown {
    static constexpr bool PERM = true, HAS_PRE = true;
    unsigned char* YP; const int* list; const LAS int* boff; const LAS int* cnt;
    int ent[2][4];
    __device__ __forceinline__ void pre(const pg8::Unit& u, int wr, int fr) {
        const int e = u.pn >> 2, lb = (u.pm - boff[e]) * 256, n = cnt[e];
#pragma unroll
        for (int ai = 0; ai < 2; ++ai)
#pragma unroll
            for (int m = 0; m < 4; ++m) { const int li = lb + ai * 128 + wr * 64 + m * 16 + fr; const bool ok = li < n; const int w = list[e * MROWS + (ok ? li : 0)]; ent[ai][m] = ok ? w : -1; }
    }
    __device__ __forceinline__ void operator()(const f32x4 (&acc)[2][2][4][2], const pg8::Unit& u, int wr, int wc, int fr, int fq) const {
        const int col0 = (u.pn & 3) * 256 + wc * 32 + 8 * fq;
#pragma unroll
        for (int ai = 0; ai < 2; ++ai)
#pragma unroll
            for (int m = 0; m < 4; ++m) { const int w = ent[ai][m];
                if (w != -1) { const unsigned id = (unsigned)w & 0x3FFFFu; const float g = (float)((unsigned)w >> 18) * ((1.f / 16383.f) * W8_INV * YP_SCALE); const unsigned off = id * (unsigned)DM + (unsigned)col0;
#pragma unroll
                    for (int bj = 0; bj < 2; ++bj) { const f32x4 v0 = acc[ai][bj][m][0] * g, v1 = acc[ai][bj][m][1] * g;
                        u32x2 ww; ww.x = pk4_fp8(v0[0], v0[1], v0[2], v0[3]); ww.y = pk4_fp8(v1[0], v1[1], v1[2], v1[3]); *(u32x2*)(YP + off + bj * 128) = ww; } } }
    }
};
__device__ __forceinline__ void moe_offsets(const Ctx& C, int layer, LAS int* boff, LAS int* cnt, int tid) {
    if (tid < 16) cnt[tid] = (int)__hip_atomic_load((const unsigned*)(C.ws + WS_CTL) + CW_CNT + 64 * layer + tid, __ATOMIC_RELAXED, __HIP_MEMORY_SCOPE_AGENT);
    __syncthreads();
    if (tid == 0) { int acc = 0;
        for (int e = 0; e < 16; ++e) { boff[e] = acc; acc += (cnt[e] + 255) >> 8; }
        boff[16] = acc; }
    __syncthreads();
}

__device__ __forceinline__ void phase_final(const Ctx& C, int gw, int NGW, int lane) {
    const float* mod = (const float*)(C.ws + WS_MOD) + (size_t)(DEPTH - 1) * 17 * 6144;
    const bf16_t* XR = (const bf16_t*)(C.ws + WS_X32); const unsigned char* YP = (const unsigned char*)(C.ws + WS_YP);
    for (int r = gw; r < NB * SEQ; r += NGW) {
        const int b = r / SEQ, t = r - b * SEQ; const size_t m = (size_t)b * TPB + CTX + t;
        const u32x2* xr = (const u32x2*)(XR + m * DM) + lane; const unsigned* y0 = (const unsigned*)(YP + m * 2 * DM) + lane; const unsigned* y1 = y0 + DM / 4;
        const f32x4* g2 = (const f32x4*)(mod + (size_t)b * 6144 + 5 * DM) + lane; f32x4* o = (f32x4*)(C.out + (size_t)r * DM) + lane;
        unsigned a[4], bb[4]; u32x2 x[4];
#pragma unroll
        for (int j = 0; j < 4; ++j) { x[j] = xr[64 * j]; a[j] = y0[64 * j]; bb[j] = y1[64 * j]; }
#pragma unroll
        for (int j = 0; j < 4; ++j) o[64 * j] = bf4(x[j]) + (g2[64 * j] * YP_INV) * (fp8x4_f32(a[j]) + fp8x4_f32(bb[j]));
    }
}

#ifndef R3OFF
#define R3OFF 0
#endif
#ifndef WINOFF
#define WINOFF 0
#endif
#ifndef PHMASK
#define PHMASK 0xFFFF
#endif
#ifndef MK_ONE_LAUNCH
#define MK_ONE_LAUNCH 1
#endif
constexpr int PH_PER_LAYER = 9, PH_LAYER0 = 2, PH_FINAL = PH_LAYER0 + DEPTH * PH_PER_LAYER, PH_COUNT = PH_FINAL + 1;
struct Args { const float* in[18]; float* out; unsigned char* ws; int ph_lo, ph_hi, flags, pad; };
__global__ void __launch_bounds__(512, 2) mega_fwd(Args args) {
    extern __shared__ __attribute__((aligned(16))) unsigned char lds_raw[];
    LAS unsigned char* lds = (LAS unsigned char*)lds_raw;
    Ctx C; C.out = args.out; C.ws = args.ws;
    const int tid = threadIdx.x, lane = tid & 63, wave = __builtin_amdgcn_readfirstlane(tid >> 6);
    const int G = gridDim.x; const int bx = blockIdx.x; const int vcu = (G % 8 == 0) ? (bx % 8) * (G / 8) + bx / 8 : bx;
    const int gw = vcu * 8 + wave, NGW = G * 8;
    volatile LAS unsigned* MISC = (volatile LAS unsigned*)(lds + LDSCTL_OFF);
    for (int u = tid; u < (LDS_BYTES - LDSCTL_OFF) / 4; u += 512) ((LAS unsigned*)(lds + LDSCTL_OFF))[u] = 0u;
    __syncthreads();
    const int lo = args.ph_lo, hi = args.ph_hi;
    XcdBarrier bar; bar.bar = (unsigned*)(C.ws + WS_CTL) + CW_BAR; bar.x = 0; bar.st = nullptr;
    if (hi - lo > 1) bar = xcd_barrier_post((unsigned*)(C.ws + WS_CTL) + CW_BAR, MISC);
#define IN(k) (lo <= (k) && (k) < hi)
#define PHASE_IDS() int bx_ = bx, wave_ = wave; LAS unsigned char* lds_ = lds; asm volatile("" : "+s"(bx_), "+s"(wave_), "+s"(lds_)); int lane_; asm volatile("v_mbcnt_lo_u32_b32 %0, -1, 0\n\tv_mbcnt_hi_u32_b32 %0, -1, %0" : "=v"(lane_)); const int tid_ = wave_ * 64 + lane_; \
    const int vcu_ = (G % 8 == 0) ? (bx_ % 8) * (G / 8) + bx_ / 8 : bx_; const int gw_ = vcu_ * 8 + wave_; (void)lane_; (void)gw_; (void)vcu_
#define SEAM(k) do { if (IN(k) && IN((k) + 1)) xcd_barrier(bar); } while (0)

    if (IN(0) && (PHMASK & 1)) { PHASE_IDS(); phase_prologue(C, lds_, G, vcu_, bx_, tid_); } SEAM(0);
    if (IN(1) && (PHMASK & 2)) { PHASE_IDS(); phase_modsum(C, G, bx_, tid_, vcu_, lds_); } SEAM(1);
#ifdef EXTRA_BARS
    if (hi - lo > 1) for (int eb = 0; eb < EXTRA_BARS; ++eb) xcd_barrier(bar);
#endif

#ifdef LAYER_UNROLL
#pragma unroll
#else
#pragma nounroll
#endif
    for (int layer = 0; layer < DEPTH; ++layer) {
        const int p0 = PH_LAYER0 + layer * PH_PER_LAYER;
        if (IN(p0 + 0) && (PHMASK & 4)) { PHASE_IDS();
            if (layer > 0 && !(args.flags & 16)) {
                const unsigned* gc = (const unsigned*)(C.ws + WS_CTL) + CW_CNT + 64 * (layer - 1);
                int nblk = ((int)__hip_atomic_load(gc + (lane_ & 15), __ATOMIC_RELAXED, __HIP_MEMORY_SCOPE_AGENT) + 255) >> 8;
                nblk += __builtin_bit_cast(int, xor1(__builtin_bit_cast(float, nblk))); nblk += __builtin_bit_cast(int, xor2(__builtin_bit_cast(float, nblk)));
                nblk += __builtin_bit_cast(int, swz_xor4(__builtin_bit_cast(float, nblk))); nblk += __builtin_bit_cast(int, swz_xor8(__builtin_bit_cast(float, nblk)));
                convert_rest(C, layer, G, vcu_, lds_, wave_, lane_, nblk * 8, nblk * 4); }
            phase_norm1(C, layer, gw_, NGW, lane_, (args.flags & 16) ? (bf16_t*)(C.ws + WS_Y) : (bf16_t*)(C.ws + WS_X32)); } SEAM(p0 + 0);
        if (IN(p0 + 1) && (PHMASK & 8)) {
            pg8::Gemm g{(const bf16_t*)(C.ws + WS_H), (const bf16_t*)(C.ws + WS_WIN + (size_t)layer * DIN * DM), MROWS, DIN, DM};
            PHASE_IDS(); pg8::StaticOrder S; S.init(MROWS, DIN, G, bx_);
            pg8::EpiBf16Q E{(bf16_t*)(C.ws + WS_P), DIN, (const float*)(C.ws + WS_HS), __builtin_bit_cast(float, ((const unsigned*)(C.ws + WS_CTL))[CW_WSC + 17 * layer]), {}};
            pg8::gemm_phase<pg8::EpiBf16Q, pg8::StaticOrder, true, 2>(lds_, g, S, E, tid_);
            if (layer + 1 < DEPTH && !args.flags) convert_tail(C, layer + 1, 0, (MROWS / 256) * (DIN / 256), G, bx_, lds_, wave_, lane_);
        } SEAM(p0 + 1);
        if (IN(p0 + 2) && (PHMASK & 16)) {
            PHASE_IDS(); if (!(args.flags & 1)) phase_qkprep(C, layer, gw_, NGW, lane_, (args.flags & 8) ? (bf16_t*)(C.ws + WS_Y) : (bf16_t*)(C.ws + WS_P));
            if (!(args.flags & 8)) ret_r1_all(C, layer, bx_, G, lds_, tid_);
        } SEAM(p0 + 2);
        if (IN(p0 + 3) && (PHMASK & 32)) {
            PHASE_IDS(); for (int u = bx_; u < 512; u += G) ret_r2_unit(C, layer, u, tid_);
            attn_units<false>(C, layer, G, vcu_, bx_, tid_, (char*)lds_);
        } SEAM(p0 + 3);
        if (IN(p0 + 4) && (PHMASK & 64)) {
            PHASE_IDS();
            if (!WINOFF && !(args.flags & 32)) attn_units<true>(C, layer, G, vcu_, bx_, tid_, (char*)lds_);
            if (!R3OFF && !(args.flags & 64))
            ret_r3_all(C, layer, bx_, G, lds_, tid_);
        } SEAM(p0 + 4);
        if (IN(p0 + 5) && (PHMASK & 128)) {
            pg8::Gemm g{(const bf16_t*)(C.ws + WS_Y), (const bf16_t*)(C.ws + WS_WOUT) + (size_t)layer * DM * DM, MROWS, DM, DM};
            PHASE_IDS(); pg8::StaticOrder S; S.init(MROWS, DM, G, bx_, layer == DEPTH - 1);
            pg8::EpiResid E{(bf16_t*)(C.ws + ((args.flags & 4) ? WS_P : WS_X32)), (const float*)(C.ws + WS_MOD) + (size_t)layer * 17 * 6144 + 2 * DM};
            pg8::gemm_phase<pg8::EpiResid, pg8::StaticOrder, true>(lds_, g, S, E, tid_);
            if (layer + 1 < DEPTH && !args.flags) convert_tail(C, layer + 1, 1, (MROWS / 256) * (DM / 256), G, bx_, lds_, wave_, lane_);
        } SEAM(p0 + 5);
        if (IN(p0 + 6) && (PHMASK & 256)) { PHASE_IDS(); phase_norm2_route(C, layer + ((args.flags & 2) ? 4 : 0), lds_, G, bx_, tid_); } SEAM(p0 + 6);
        if (IN(p0 + 7) && (PHMASK & 512)) {
            PHASE_IDS(); LAS int* boff = (LAS int*)(lds_ + LDSCTL_OFF + 64); LAS int* mcnt = (LAS int*)(lds_ + LDSCTL_OFF + 192); moe_offsets(C, layer, boff, mcnt, tid_);
            pg8::Gemm g{(const bf16_t*)(C.ws + WS_H), (const bf16_t*)(C.ws + WS_WGU + (size_t)layer * NE * 2 * FF * DM), 0, 2 * FF, DM};
            MoeOrder<true, 8> S{(const int*)(C.ws + WS_LIST), boff, mcnt, G, bx_};
            EpiGateUp E{(unsigned char*)(C.ws + WS_P), (const float*)(C.ws + WS_GW), (const float*)(C.ws + WS_CTL) + CW_WSC + 17 * layer, boff};
            pg8::gemm_phase<EpiGateUp, MoeOrder<true, 8>, true, 2>(lds_, g, S, E, tid_);
            if (layer + 1 < DEPTH && !args.flags) convert_tail(C, layer + 1, 2, boff[16] * 8, G, bx_, lds_, wave_, lane_);
        } SEAM(p0 + 7);
        if (IN(p0 + 8) && (PHMASK & 1024)) {
            PHASE_IDS(); LAS int* boff = (LAS int*)(lds_ + LDSCTL_OFF + 64); LAS int* mcnt = (LAS int*)(lds_ + LDSCTL_OFF + 192); moe_offsets(C, layer, boff, mcnt, tid_);
            pg8::Gemm g{(const bf16_t*)(C.ws + WS_P), (const bf16_t*)(C.ws + WS_WDN + (size_t)layer * NE * DM * FF), 0, DM, FF};
            MoeOrder<false, 4> S{(const int*)(C.ws + WS_LIST), boff, mcnt, G, bx_};
            EpiDown E{(unsigned char*)(C.ws + WS_YP), (const int*)(C.ws + WS_LIST), boff, mcnt, {}};
            pg8::gemm_phase<EpiDown, MoeOrder<false, 4>, true, 1>(lds_, g, S, E, tid_);
            if (layer + 1 < DEPTH && !args.flags) convert_tail(C, layer + 1, 3, boff[16] * 4, G, bx_, lds_, wave_, lane_);
        } SEAM(p0 + 8);
    }
    if (IN(PH_FINAL) && (PHMASK & 2048)) { PHASE_IDS(); phase_final(C, gw_, NGW, lane_); }
#undef IN
#undef SEAM
}

extern "C" void kernel_launch(void* const* d_in, const int* in_sizes, int n_in, void* d_out, int out_size, void* d_ws, size_t ws_size, hipStream_t stream) {
    static int grid = 0;
    if (grid == 0) {
        if (n_in != 18 || in_sizes[0] != NB * SEQ * DM || out_size != NB * SEQ * DM || ws_size < WS_END) {
            fprintf(stderr, "kernel_launch: unexpected shapes (n_in %d, in0 %d, out %d, ws %zu, need %zu); nothing launched\n", n_in, n_in > 0 ? in_sizes[0] : -1, out_size, ws_size, (size_t)WS_END); grid = -1; return; }
        int dev = 0, cus = 0, per_cu = 0;
        if (hipGetDevice(&dev) != hipSuccess || hipDeviceGetAttribute(&cus, hipDeviceAttributeMultiprocessorCount, dev) != hipSuccess) { grid = -1; return; }
        if (hipFuncSetAttribute((const void*)mega_fwd, hipFuncAttributeMaxDynamicSharedMemorySize, LDS_BYTES) != hipSuccess) { fprintf(stderr, "kernel_launch: hipFuncSetAttribute failed\n"); grid = -1; return; }
        if (hipOccupancyMaxActiveBlocksPerMultiprocessor(&per_cu, (const void*)mega_fwd, 512, LDS_BYTES) != hipSuccess || per_cu < 1) fprintf(stderr, "kernel_launch: occupancy query says %d\n", per_cu);
        (void)hipGetLastError();
        grid = cus;
    }
    if (grid < 0) return;
    if (hipMemsetAsync((char*)d_ws + WS_CTL, 0, CTL_BYTES, stream) != hipSuccess) return;
    Args a{};
    for (int i = 0; i < 18; ++i) a.in[i] = (const float*)d_in[i];
    a.out = (float*)d_out; a.ws = (unsigned char*)d_ws;
#if MK_ONE_LAUNCH
    a.ph_lo = 0; a.ph_hi = PH_COUNT;
    hipLaunchKernelGGL(mega_fwd, dim3(grid), dim3(512), LDS_BYTES, stream, a);
#else
    for (int p = 0; p < PH_COUNT; ++p) { a.ph_lo = p; a.ph_hi = p + 1;
#if !defined(PROBE_P) || !PROBE_BEFORE
        hipLaunchKernelGGL(mega_fwd, dim3(grid), dim3(512), LDS_BYTES, stream, a);
#endif
#ifdef PROBE_P
        const bool hit = (PROBE_P < 2) ? (p == PROBE_P) : (p >= PH_LAYER0 && p < PH_FINAL && (p - PH_LAYER0) % PH_PER_LAYER == PROBE_P - 2 && (!PROBE_L0 || p < PH_LAYER0 + PH_PER_LAYER));
        if (hit) { a.flags = PROBE_FLAGS; for (int r = 0; r < PROBE_REP; ++r) hipLaunchKernelGGL(mega_fwd, dim3(grid), dim3(512), LDS_BYTES, stream, a); a.flags = 0; }
#if PROBE_BEFORE
        hipLaunchKernelGGL(mega_fwd, dim3(grid), dim3(512), LDS_BYTES, stream, a);
#endif
#endif
    }
#endif
}
```

```cpp
#define MK_ONE_LAUNCH 1
#include <hip/hip_runtime.h>
#include <cstdio>
#include <cstdint>

#define GAS __attribute__((address_space(1)))
#define LAS __attribute__((address_space(3)))
typedef unsigned short bf16_t;
typedef short bf16x8 __attribute__((ext_vector_type(8)));
typedef float f32x4 __attribute__((ext_vector_type(4)));
typedef float f32x2 __attribute__((ext_vector_type(2)));
typedef float f32x16 __attribute__((ext_vector_type(16)));
typedef unsigned u32x4 __attribute__((ext_vector_type(4)));
typedef unsigned u32x2 __attribute__((ext_vector_type(2)));

constexpr int DM = 1024, NB = 16, SEQ = 4096, CTX = 256, TPB = SEQ + CTX, MROWS = NB * TPB, DEPTH = 4;
constexpr int DIN = 2560;
constexpr int C_RQ = 0, C_RK = 256, C_RV = 512, C_RG = 1024, C_WQ = 1536, C_WK = 1792, C_WV = 1920, C_GQ = 2048, C_GK = 2304, C_GV = 2432;
constexpr int NE = 16, FF = 1024, NCH = TPB / 128;
constexpr float EPS = 1e-6f;
constexpr float LOG2E = 1.4426950408889634f;
constexpr float QSCALE = 0.125f * LOG2E;

__device__ __forceinline__ unsigned f2bf(float f) { unsigned u = __builtin_bit_cast(unsigned, f); return (u + 0x7fffu + ((u >> 16) & 1u)) >> 16; }
__device__ __forceinline__ unsigned pk2(float lo, float hi) { return f2bf(lo) | (f2bf(hi) << 16); }
__device__ __forceinline__ float bf2f(unsigned short h) { return __builtin_bit_cast(float, (unsigned)h << 16); }
__device__ __forceinline__ float bflo(unsigned w) { return __builtin_bit_cast(float, w << 16); }
__device__ __forceinline__ float bfhi(unsigned w) { return __builtin_bit_cast(float, w & 0xffff0000u); }

namespace pg8 {
constexpr int BM = 256, BK = 64, HALF = 128, HTB = HALF * BK * 2, STAGE_BYTES = 8 * HTB, NXCD = 8, WGM = 8;
__host__ __device__ __forceinline__ int lds_byte(int r, int c) { const int st = (r >> 4) * 2 + (c >> 5), rr = r & 15, cc = c & 31, ob = rr * 64 + cc * 2; return st * 1024 + (ob ^ (((ob >> 9) & 1) << 5)); }
__host__ __device__ __forceinline__ void stage_rc(int b, int& R, int& C) { const int st = b / 1024, sb = b % 1024, swz = sb ^ (((sb >> 9) & 1) << 5); R = (st >> 1) * 16 + swz / 64; C = (st & 1) * 32 + (swz % 64) / 2; }
__host__ __device__ __forceinline__ int perm32(int rho) { const int n = rho >> 4, i = rho & 15; return 8 * (i >> 2) + 4 * n + (i & 3); }

struct Unit { int pm, pn; };
struct Gemm { const bf16_t* A; const bf16_t* Bt; int M, N, K; };

struct StaticOrder {
    static constexpr bool GATHER = false;
    int nM, nN, nwg, G, c; bool skipctx;
    __device__ void init(int M, int N, int G_, int c_, bool skipctx_ = false) { skipctx = skipctx_; nM = skipctx_ ? (M / BM) / 17 * 16 : M / BM; nN = N / BM; nwg = nM * nN; G = G_; c = c_; }
    __device__ bool next(int i, Unit& u) const {
        const long L = (long)i * G + c; if (L >= nwg) return false;
        int wgid = (int)L; { const int q = nwg / NXCD, r = nwg % NXCD, xcd = wgid % NXCD, off = wgid / NXCD; wgid = (xcd < r ? xcd * (q + 1) : r * (q + 1) + (xcd - r) * q) + off; }
        const int nig = WGM * nN, gid = wgid / nig, fm = gid * WGM, gsz = (nM - fm) < WGM ? (nM - fm) : WGM;
        u.pm = fm + ((wgid % nig) % gsz); u.pn = (wgid % nig) / gsz; if (skipctx) u.pm += (u.pm >> 4) + 1; return true;
    }
    __device__ __forceinline__ unsigned arow(const Unit&, int) const { return 0u; }
    __device__ __forceinline__ const int* aptr(const Unit&, int) const { return nullptr; }
    __device__ __forceinline__ unsigned tokrow(unsigned) const { return 0u; }
};

__device__ __forceinline__ unsigned cvt_pk_bf16(float lo, float hi) { unsigned r; asm volatile("v_cvt_pk_bf16_f32 %0, %1, %2" : "=v"(r) : "v"(lo), "v"(hi)); return r; }

struct EpiBf16 {
    static constexpr bool PERM = true, HAS_PRE = false;
    bf16_t* O; int ldc;
    __device__ __forceinline__ void operator()(const f32x4 (&acc)[2][2][4][2], const Unit& u, int wr, int wc, int fr, int fq) const {
        const int row0 = u.pm * BM + wr * 64 + fr; const int col0 = u.pn * BM + wc * 32 + 8 * fq;
#pragma unroll
        for (int ai = 0; ai < 2; ++ai)
#pragma unroll
            for (int m = 0; m < 4; ++m) { const unsigned off = ((unsigned)(row0 + ai * HALF + m * 16) * (unsigned)ldc + (unsigned)col0) * 2u;
#pragma unroll
                for (int bj = 0; bj < 2; ++bj) { const f32x4 v0 = acc[ai][bj][m][0], v1 = acc[ai][bj][m][1];
                    u32x4 w; w.x = cvt_pk_bf16(v0[0], v0[1]); w.y = cvt_pk_bf16(v0[2], v0[3]); w.z = cvt_pk_bf16(v1[0], v1[1]); w.w = cvt_pk_bf16(v1[2], v1[3]);
                    *(u32x4*)((char*)O + off + bj * HALF * 2) = w; } }
    }
};

__device__ __forceinline__ f32x4 i2f4(f32x4 v) { typedef int i32x4_ __attribute__((ext_vector_type(4))); const i32x4_ i = __builtin_bit_cast(i32x4_, v); return (f32x4){(float)i[0], (float)i[1], (float)i[2], (float)i[3]}; }
struct EpiBf16Q {
    static constexpr bool PERM = true, HAS_PRE = true;
    bf16_t* O; int ldc; const float* rs; float ws; float sc[2][4];
    __device__ __forceinline__ void pre(const Unit& u, int wr, int fr) {
#pragma unroll
        for (int ai = 0; ai < 2; ++ai)
#pragma unroll
            for (int m = 0; m < 4; ++m) sc[ai][m] = rs[u.pm * BM + ai * HALF + wr * 64 + m * 16 + fr];
    }
    __device__ __forceinline__ void operator()(const f32x4 (&acc)[2][2][4][2], const Unit& u, int wr, int wc, int fr, int fq) const {
        const int row0 = u.pm * BM + wr * 64 + fr; const int col0 = u.pn * BM + wc * 32 + 8 * fq;
#pragma unroll
        for (int ai = 0; ai < 2; ++ai)
#pragma unroll
            for (int m = 0; m < 4; ++m) { const unsigned off = ((unsigned)(row0 + ai * HALF + m * 16) * (unsigned)ldc + (unsigned)col0) * 2u; const float s = sc[ai][m] * ws;
#pragma unroll
                for (int bj = 0; bj < 2; ++bj) { const f32x4 v0 = i2f4(acc[ai][bj][m][0]) * s, v1 = i2f4(acc[ai][bj][m][1]) * s;
                    u32x4 w; w.x = cvt_pk_bf16(v0[0], v0[1]); w.y = cvt_pk_bf16(v0[2], v0[3]); w.z = cvt_pk_bf16(v1[0], v1[1]); w.w = cvt_pk_bf16(v1[2], v1[3]);
                    *(u32x4*)((char*)O + off + bj * HALF * 2) = w; } }
    }
};

struct EpiResid {
    static constexpr bool PERM = true, HAS_PRE = false;
    bf16_t* X; const float* gate;
    __device__ __forceinline__ void operator()(const f32x4 (&acc)[2][2][4][2], const Unit& u, int wr, int wc, int fr, int fq) const {
        const int set = (u.pm % 17 == 0) ? 16 : (u.pm / 17);
        const float* gp = gate + (size_t)set * 6 * DM;
        const int col0 = u.pn * BM + wc * 32 + 8 * fq;
        f32x4 gv[2][2];
#pragma unroll
        for (int bj = 0; bj < 2; ++bj)
#pragma unroll
            for (int n = 0; n < 2; ++n) gv[bj][n] = *(const f32x4*)(gp + col0 + bj * HALF + n * 4);
#pragma unroll
        for (int ai = 0; ai < 2; ++ai) {
            u32x4 xin[4][2];
#pragma unroll
            for (int m = 0; m < 4; ++m) { const unsigned off = ((unsigned)(u.pm * BM + ai * HALF + wr * 64 + m * 16 + fr) * (unsigned)DM + (unsigned)col0) * 2u;
#pragma unroll
                for (int bj = 0; bj < 2; ++bj) xin[m][bj] = *(const u32x4*)((const char*)X + off + bj * HALF * 2); }
            asm volatile("" ::: "memory");
#pragma unroll
            for (int m = 0; m < 4; ++m) { const unsigned off = ((unsigned)(u.pm * BM + ai * HALF + wr * 64 + m * 16 + fr) * (unsigned)DM + (unsigned)col0) * 2u;
#pragma unroll
                for (int bj = 0; bj < 2; ++bj) { const u32x4 x = xin[m][bj]; const f32x4 a0 = acc[ai][bj][m][0] * gv[bj][0], a1 = acc[ai][bj][m][1] * gv[bj][1];
                    u32x4 w; w.x = cvt_pk_bf16(bflo(x.x) + a0[0], bfhi(x.x) + a0[1]); w.y = cvt_pk_bf16(bflo(x.y) + a0[2], bfhi(x.y) + a0[3]);
                    w.z = cvt_pk_bf16(bflo(x.z) + a1[0], bfhi(x.z) + a1[1]); w.w = cvt_pk_bf16(bflo(x.w) + a1[2], bfhi(x.w) + a1[3]);
                    *(u32x4*)((char*)X + off + bj * HALF * 2) = w; } }
            asm volatile("" ::: "memory");
        }
    }
};

template <class Epi, class Sched, bool ALIGN_EPI, int MODE = 0  >
__device__ __forceinline__ void gemm_phase(LAS unsigned char* lds, const Gemm g, const Sched& S, Epi& E, const int tid) {
    const int wid = __builtin_amdgcn_readfirstlane(tid >> 6), lane = tid & 63, wr = wid >> 2, wc = wid & 3, fr = lane & 15, fq = lane >> 4;
    constexpr bool FP8 = MODE == 1, I8 = MODE == 2;
    const int K = g.K, KB = MODE ? K : 2 * K  , nt = KB / (BK * 2);
    unsigned voffB[2], vA[2][2], vAn[2][2];
#define PG8_RC(i_, R_, C_) int R_, C_; stage_rc(tid * 16 + (i_) * 8192, R_, C_)
#pragma unroll
    for (int i = 0; i < 2; ++i) { PG8_RC(i, R, C); const int Rb = Epi::PERM ? ((R & ~31) + perm32(R & 31)) : R;
        voffB[i] = (unsigned)(Rb * KB + C * 2); }
#define PG8_SETV(v, u) do { _Pragma("unroll") for (int h_ = 0; h_ < 2; ++h_) _Pragma("unroll") for (int i_ = 0; i_ < 2; ++i_) { PG8_RC(i_, sR_, sC_); \
        if constexpr (Sched::GATHER) v[h_][i_] = S.arow(u, h_ * HALF + sR_) * (unsigned)KB + (unsigned)(sC_ * 2); \
        else v[h_][i_] = (unsigned)((h_ * HALF + sR_) * KB + sC_ * 2); } } while (0)
    const size_t kstep = (size_t)(BK * 2);
    const size_t hstep = (size_t)HALF * KB;
    const size_t tstep = 2 * hstep;
    const size_t atstep = Sched::GATHER ? (size_t)0 : tstep;
    const unsigned ldsw = (unsigned)wid * 1024u;
    const int aoff = lds_byte(wr * 64 + fr, fq * 8), boff = lds_byte(wc * 32 + fr, fq * 8);
#define PG8_SA(b, h) (((b) * 2 + (h)) * HTB)
#define PG8_SB(b, h) ((4 + (b) * 2 + (h)) * HTB)
#define PG8_STAGE(bufoff, gbase, voff) do { _Pragma("unroll") for (int _i = 0; _i < 2; ++_i) \
        __builtin_amdgcn_global_load_lds((const unsigned*)((const char*)(gbase) + (voff)[_i]), (LAS unsigned*)(lds + (bufoff) + ldsw + _i * 8192), 16, 0, 0); } while (0)
#define PG8_LDA(dst, b, h) do { _Pragma("unroll") for (int m = 0; m < 4; ++m) _Pragma("unroll") for (int k = 0; k < 2; ++k) dst[m][k] = *(const LAS bf16x8*)(lds + PG8_SA(b, h) + aoff + m * 2048 + k * 1024); } while (0)
#define PG8_LDB(dst, b, h) do { _Pragma("unroll") for (int n = 0; n < 2; ++n) _Pragma("unroll") for (int k = 0; k < 2; ++k) dst[n][k] = *(const LAS bf16x8*)(lds + PG8_SB(b, h) + boff + n * 2048 + k * 1024); } while (0)
    typedef long i64x2_ __attribute__((ext_vector_type(2)));
#define PG8_MMA(ai, bj, At, Bt) do { __builtin_amdgcn_s_setprio(1); _Pragma("unroll") for (int m = 0; m < 4; ++m) _Pragma("unroll") for (int n = 0; n < 2; ++n) _Pragma("unroll") for (int k = 0; k < 2; ++k) { \
        if constexpr (FP8) { const i64x2_ b2_ = __builtin_bit_cast(i64x2_, Bt[n][k]), a2_ = __builtin_bit_cast(i64x2_, At[m][k]); \
            acc[ai][bj][m][n] = __builtin_amdgcn_mfma_f32_16x16x32_fp8_fp8(b2_[0], a2_[0], acc[ai][bj][m][n], 0, 0, 0); \
            acc[ai][bj][m][n] = __builtin_amdgcn_mfma_f32_16x16x32_fp8_fp8(b2_[1], a2_[1], acc[ai][bj][m][n], 0, 0, 0); } \
        else if constexpr (I8) { typedef int i32x4_ __attribute__((ext_vector_type(4))); \
            acc[ai][bj][m][n] = __builtin_bit_cast(f32x4, __builtin_amdgcn_mfma_i32_16x16x64_i8(__builtin_bit_cast(i32x4_, Bt[n][k]), __builtin_bit_cast(i32x4_, At[m][k]), __builtin_bit_cast(i32x4_, acc[ai][bj][m][n]), 0, 0, 0)); } \
        else acc[ai][bj][m][n] = __builtin_amdgcn_mfma_f32_16x16x32_bf16(Bt[n][k], At[m][k], acc[ai][bj][m][n], 0, 0, 0); } \
        __builtin_amdgcn_s_setprio(0); } while (0)
#define PG8_WAIT_V(n) asm volatile("s_waitcnt vmcnt(" #n ")" ::: "memory")
#define PG8_WAIT_L(n) asm volatile("s_waitcnt lgkmcnt(" #n ")" ::: "memory")
#define PG8_BAR __builtin_amdgcn_s_barrier()
#define PG8_SCHED __builtin_amdgcn_sched_barrier(0)
    Unit cur, nxt; int ui = 0;
    if (!S.next(0, cur)) return;
    float z0 = 0.f; asm volatile("" : "+v"(z0));
    f32x4 acc[2][2][4][2];
#pragma unroll
    for (int a = 0; a < 2; ++a)
#pragma unroll
        for (int b = 0; b < 2; ++b)
#pragma unroll
            for (int m = 0; m < 4; ++m)
#pragma unroll
                for (int n = 0; n < 2; ++n) acc[a][b][m][n] = (f32x4){z0, z0, z0, z0};
    bf16x8 At[4][2], B0[2][2], B1[2][2];
    const char* cA = (const char*)g.A + (size_t)cur.pm * atstep; const char* cB = (const char*)g.Bt + (size_t)cur.pn * tstep;
    PG8_SETV(vA, cur);
    PG8_STAGE(PG8_SB(0, 0), cB, voffB); PG8_STAGE(PG8_SB(0, 1), cB + hstep, voffB); PG8_STAGE(PG8_SA(0, 0), cA, vA[0]); PG8_STAGE(PG8_SA(0, 1), cA, vA[1]);
    if (wr == 1) PG8_BAR;
    PG8_WAIT_V(2); PG8_BAR;
    PG8_STAGE(PG8_SB(1, 0), cB + kstep, voffB); PG8_STAGE(PG8_SA(1, 0), cA + kstep, vA[0]); PG8_STAGE(PG8_SB(1, 1), cB + hstep + kstep, voffB);
    PG8_WAIT_V(6); PG8_BAR;
    for (;;) {
        if constexpr (Epi::HAS_PRE) E.pre(cur, wr, fr);
        const bool has_next = S.next(ui + 1, nxt);
        const char* nA = has_next ? (const char*)g.A + (size_t)nxt.pm * atstep : cA; const char* nB = has_next ? (const char*)g.Bt + (size_t)nxt.pn * tstep : cB;
        if constexpr (Sched::GATHER) { if (has_next) {
#pragma unroll
            for (int h_ = 0; h_ < 2; ++h_)
#pragma unroll
                for (int i_ = 0; i_ < 2; ++i_) { PG8_RC(i_, sR_, sC_); (void)sC_; const int* ap_ = S.aptr(nxt, h_ * HALF + sR_); asm volatile("global_load_dword %0, %1, off" : "=v"(vAn[h_][i_]) : "v"(ap_) : "memory"); } } }
        if (has_next) { if constexpr (!Sched::GATHER) { PG8_SETV(vAn, nxt); } } else {
#pragma unroll
            for (int h_ = 0; h_ < 2; ++h_)
#pragma unroll
                for (int i_ = 0; i_ < 2; ++i_) vAn[h_][i_] = vA[h_][i_]; }
        for (int t = 0; t < nt; t += 2) {
            const bool last = (t == nt - 2);
            const char* a1 = cA + (size_t)(t + 1) * kstep;
            const char* a2 = last ? nA : cA + (size_t)(t + 2) * kstep; const char* b2 = last ? nB : cB + (size_t)(t + 2) * kstep;
            const char* a3 = a2 + kstep; const char* b3 = b2 + kstep;
            if constexpr (Sched::GATHER) { if (t == 2 && has_next) {
#pragma unroll
                for (int h_ = 0; h_ < 2; ++h_)
#pragma unroll
                    for (int i_ = 0; i_ < 2; ++i_) { PG8_RC(i_, sR_, sC_); (void)sR_; asm volatile("" : "+v"(vAn[h_][i_])); vAn[h_][i_] = S.tokrow(vAn[h_][i_]) * (unsigned)KB + (unsigned)(sC_ * 2); } } }
            unsigned o2[2][2];
#pragma unroll
            for (int h_ = 0; h_ < 2; ++h_)
#pragma unroll
                for (int i_ = 0; i_ < 2; ++i_) o2[h_][i_] = last ? vAn[h_][i_] : vA[h_][i_];
            PG8_LDB(B0, 0, 0); PG8_LDB(B1, 0, 1); PG8_SCHED; PG8_LDA(At, 0, 0); PG8_STAGE(PG8_SA(1, 1), a1, vA[1]);
            PG8_WAIT_V(8); PG8_WAIT_L(0); PG8_BAR; PG8_MMA(0, 0, At, B0); PG8_MMA(0, 1, At, B1); PG8_BAR; PG8_SCHED;
            PG8_LDA(At, 0, 1); PG8_STAGE(PG8_SB(0, 0), b2, voffB); PG8_STAGE(PG8_SB(0, 1), b2 + hstep, voffB); PG8_STAGE(PG8_SA(0, 0), a2, o2[0]);
            PG8_WAIT_V(8); PG8_WAIT_L(0); PG8_BAR; PG8_MMA(1, 0, At, B0); PG8_MMA(1, 1, At, B1); PG8_BAR; PG8_SCHED;
            PG8_LDB(B0, 1, 0); PG8_LDB(B1, 1, 1); PG8_SCHED; PG8_LDA(At, 1, 0); PG8_STAGE(PG8_SA(0, 1), a2, o2[1]);
            PG8_WAIT_V(8); PG8_WAIT_L(0); PG8_BAR; PG8_MMA(0, 0, At, B0); PG8_MMA(0, 1, At, B1); PG8_BAR; PG8_SCHED;
            PG8_LDA(At, 1, 1); PG8_STAGE(PG8_SB(1, 0), b3, voffB); PG8_STAGE(PG8_SB(1, 1), b3 + hstep, voffB); PG8_STAGE(PG8_SA(1, 0), a3, o2[0]);
            PG8_WAIT_V(8); PG8_WAIT_L(0); PG8_BAR; PG8_MMA(1, 0, At, B0); PG8_MMA(1, 1, At, B1); PG8_BAR; PG8_SCHED;
        }
        if constexpr (ALIGN_EPI) { if (wr == 0) PG8_BAR; }
        E(acc, cur, wr, wc, fr, fq);
        if (!has_next) break;
#pragma unroll
        for (int a = 0; a < 2; ++a)
#pragma unroll
            for (int b = 0; b < 2; ++b)
#pragma unroll
                for (int m = 0; m < 4; ++m)
#pragma unroll
                    for (int n = 0; n < 2; ++n) acc[a][b][m][n] = (f32x4){z0, z0, z0, z0};
        cur = nxt; cA = nA; cB = nB; ++ui;
#pragma unroll
        for (int h_ = 0; h_ < 2; ++h_)
#pragma unroll
            for (int i_ = 0; i_ < 2; ++i_) vA[h_][i_] = vAn[h_][i_];
        if constexpr (ALIGN_EPI) { if (wr == 1) PG8_BAR; }
    }
    PG8_WAIT_V(0);
    if constexpr (!ALIGN_EPI) { if (wr == 0) PG8_BAR; }
    PG8_BAR;
#undef PG8_SETV
#undef PG8_RC
#undef PG8_SA
#undef PG8_SB
#undef PG8_STAGE
#undef PG8_LDA
#undef PG8_LDB
#undef PG8_MMA
#undef PG8_WAIT_V
#undef PG8_WAIT_L
#undef PG8_BAR
#undef PG8_SCHED
}
}
#include <hip/hip_bf16.h>
#include <cmath>
namespace attn_body {
using bf16=__hip_bfloat16;
using s16x4=__attribute__((ext_vector_type(4)))short;
constexpr int D=64,QP=DIN,OP=1024;
constexpr int NW=8,QBLK=32,QB=QBLK*NW,KVBLK=64;
__device__ __forceinline__ int crow(int r,int hi){return (r&3)+8*(r>>2)+4*hi;}
#define SBAR() __builtin_amdgcn_sched_barrier(0)
__device__ __forceinline__ void wmask(f32x16&p0,f32x16&p1,int kq,int hi){
  const float NEG=-INFINITY; const int kb=kq+4*hi;
  #pragma unroll
  for(int r=0;r<16;++r){const int d=kb+(r&3)+8*(r>>2); if(d>128||d<-128)p0[r]=NEG; if(d+32>128||d+32<-128)p1[r]=NEG;}
}

constexpr int NSLOT=3, SLOTB=8192;
constexpr int LDS_K=0, LDS_V=NSLOT*SLOTB, LDS_WS=2*NSLOT*SLOTB, LDS_OST=LDS_WS+NW*64*4, LDS_BYTES=LDS_OST+NW*4096;
constexpr float C2=0.125f*1.4426950408889634f;
__device__ __forceinline__ void glds16(const void*gsrc,unsigned lds_dst){unsigned keep;
  asm volatile("s_mov_b32 %0, m0\n\ts_mov_b32 m0, %2\n\ts_nop 0\n\tglobal_load_lds_dwordx4 %1, off\n\ts_mov_b32 m0, %0":"=&s"(keep):"v"(gsrc),"s"(lds_dst):"memory");}
__device__ __forceinline__ float max3f(float a,float b,float c){float r;asm("v_max3_f32 %0, %1, %2, %3":"=v"(r):"v"(a),"v"(b),"v"(c));return r;}
__device__ __forceinline__ float max2f(float a,float b){float r;asm("v_max_f32_e32 %0, %1, %2":"=v"(r):"v"(a),"v"(b));return r;}
__device__ __forceinline__ float fadd_s(float a,float b){float r;asm("v_add_f32_e32 %0, %1, %2":"=v"(r):"v"(a),"v"(b));return r;}
__device__ __forceinline__ float fsub_s(float a,float b){float r;asm("v_sub_f32_e32 %0, %1, %2":"=v"(r):"v"(a),"v"(b));return r;}
typedef float f32x2_t __attribute__((ext_vector_type(2))); typedef __bf16 bf16x2_t __attribute__((ext_vector_type(2)));
__device__ __forceinline__ unsigned cvtpk_s(float lo,float hi){f32x2_t v={lo,hi};bf16x2_t b=__builtin_convertvector(v,bf16x2_t);return __builtin_bit_cast(unsigned,b);}
#define WAIT_BAR(N) asm volatile("s_waitcnt vmcnt(" #N ") lgkmcnt(0)\n\ts_barrier":::"memory")

__device__ __forceinline__ void qkt(f32x16&p0,f32x16&p1,const char*Kslot,const bf16x8*qr,const f32x16&negm,int r32,int hi){
  const char*kb=Kslot+hi*1024+r32*16;
  #pragma unroll
  for(int d0=0;d0<4;++d0){
    const bf16x8 b0=*reinterpret_cast<const bf16x8*>(kb+d0*2048);
    const bf16x8 b1=*reinterpret_cast<const bf16x8*>(kb+d0*2048+512);
    if(d0==0){p0=__builtin_amdgcn_mfma_f32_32x32x16_bf16(b0,qr[0],negm,0,0,0);p1=__builtin_amdgcn_mfma_f32_32x32x16_bf16(b1,qr[0],negm,0,0,0);}
    else{p0=__builtin_amdgcn_mfma_f32_32x32x16_bf16(b0,qr[d0],p0,0,0,0);p1=__builtin_amdgcn_mfma_f32_32x32x16_bf16(b1,qr[d0],p1,0,0,0);}}
}
typedef __attribute__((address_space(3))) const char* lds_cptr;
typedef short v4i16_t __attribute__((ext_vector_type(4)));
__device__ __forceinline__ void kload8(bf16x8*kf,lds_cptr kp){
  kf[0]=*(const __attribute__((address_space(3))) bf16x8*)(kp);      kf[1]=*(const __attribute__((address_space(3))) bf16x8*)(kp+512);
  kf[2]=*(const __attribute__((address_space(3))) bf16x8*)(kp+2048); kf[3]=*(const __attribute__((address_space(3))) bf16x8*)(kp+2560);
  kf[4]=*(const __attribute__((address_space(3))) bf16x8*)(kp+4096); kf[5]=*(const __attribute__((address_space(3))) bf16x8*)(kp+4608);
  kf[6]=*(const __attribute__((address_space(3))) bf16x8*)(kp+6144); kf[7]=*(const __attribute__((address_space(3))) bf16x8*)(kp+6656);
}
__device__ __forceinline__ void kload2(bf16x8*kf,lds_cptr kp,int j){ kf[2*j]=*(const __attribute__((address_space(3))) bf16x8*)(kp+j*2048); kf[2*j+1]=*(const __attribute__((address_space(3))) bf16x8*)(kp+j*2048+512); }
__device__ __forceinline__ s16x4 vtr(lds_cptr p){ return __builtin_bit_cast(s16x4,__builtin_amdgcn_ds_read_tr16_b64_v4i16((__attribute__((address_space(3))) v4i16_t*)p)); }
__device__ __forceinline__ float rowmax(const f32x16&p0,const f32x16&p1){
  float a=max3f(p0[0],p0[1],p1[0]),b=max3f(p0[2],p0[3],p1[1]);a=max3f(a,p1[2],p1[3]);
  #pragma unroll
  for(int r=4;r<16;r+=4){a=max3f(a,p0[r],p0[r+1]);b=max3f(b,p0[r+2],p0[r+3]);a=max3f(a,p1[r],p1[r+1]);b=max3f(b,p1[r+2],p1[r+3]);}
  const float m=max2f(a,b);
  auto rr=__builtin_amdgcn_permlane32_swap(__float_as_uint(m),__float_as_uint(m),false,false);
  return max2f(__uint_as_float(rr[0]),__uint_as_float(rr[1]));
}
__device__ __forceinline__ void pv(f32x16*o,int vb,bf16x8 pa0,bf16x8 pa1,bf16x8 pa2,bf16x8 pa3){
  #pragma unroll
  for(int d0=0;d0<2;++d0){s16x4 lo[4],hi[4];
    #pragma unroll
    for(int ks=0;ks<4;++ks){
      asm volatile("ds_read_b64_tr_b16 %0,%1 offset:%c2":"=&v"(lo[ks]):"v"(vb),"i"(d0*4096+ks*1024):"memory");
      asm volatile("ds_read_b64_tr_b16 %0,%1 offset:%c2":"=&v"(hi[ks]):"v"(vb),"i"(d0*4096+ks*1024+512):"memory");}
    asm volatile("s_waitcnt lgkmcnt(0)":::"memory");SBAR();
    #define PK(k) (bf16x8){lo[k][0],lo[k][1],lo[k][2],lo[k][3],hi[k][0],hi[k][1],hi[k][2],hi[k][3]}
    o[d0]=__builtin_amdgcn_mfma_f32_32x32x16_bf16(pa0,PK(0),o[d0],0,0,0);
    o[d0]=__builtin_amdgcn_mfma_f32_32x32x16_bf16(pa1,PK(1),o[d0],0,0,0);
    o[d0]=__builtin_amdgcn_mfma_f32_32x32x16_bf16(pa2,PK(2),o[d0],0,0,0);
    o[d0]=__builtin_amdgcn_mfma_f32_32x32x16_bf16(pa3,PK(3),o[d0],0,0,0);
    #undef PK
  }
}

#ifndef ATTN_STORE16
#define ATTN_STORE16(p,v) (*(u32x4*)(p)=(v))
#endif
template<int THRL,bool WIN> __device__ __forceinline__ void attn_unit(const bf16*Qb,const bf16*__restrict__ Kb,const bf16*__restrict__ Vb,bf16*Ob,int q0,int NT,int tdelta,float sink_l2,int tid,char*shm){
  const int lane=tid&63,r32=lane&31,hi=lane>>5; const int wid=__builtin_amdgcn_readfirstlane(tid>>6);
  const bf16*Qw=Qb+(long)(q0+wid*QBLK)*QP;
  const bf16*Kh=Kb,*Vh=Vb;
  const unsigned lds0=(unsigned)(uintptr_t)shm;
  float*wsf=(float*)(shm+LDS_WS)+wid*64;
  const bf16*ksrc=Kh+(long)lane*QP+wid*8;
  const bf16*vsrc=Vh+(long)(16*(wid&3)+(lane>>2))*QP+(wid>>2)*32+(lane&3)*8;
  const unsigned kdst=lds0+LDS_K+wid*1024, vdst=lds0+LDS_V+wid*1024;
  #define TM(t) ((t)<4?(t):(t)+tdelta)
  #define DMA_K(t,slot) glds16(ksrc+(long)TM(t)*KVBLK*QP,(unsigned)__builtin_amdgcn_readfirstlane(kdst+(slot)))
  #define DMA_V(t,slot) glds16(vsrc+(long)TM(t)*KVBLK*QP,(unsigned)__builtin_amdgcn_readfirstlane(vdst+(slot)))
  const int vb0=(int)(lds0+LDS_V)+((lane>>4)&1)*32+(lane&3)*8+(4*hi+((lane&15)>>2))*64;
  const char*Kbase=shm+LDS_K; bf16x8 kf[8];
  const lds_cptr shm3=(lds_cptr)shm; const lds_cptr kp0=shm3+LDS_K+hi*1024+r32*16; const lds_cptr vp0=shm3+LDS_V+((lane>>4)&1)*32+(lane&3)*8+(4*hi+((lane&15)>>2))*64;
  DMA_K(0,0);DMA_V(0,0);DMA_K(1,SLOTB);
  bf16x8 qr[4];
  #pragma unroll
  for(int d0=0;d0<4;++d0)qr[d0]=*reinterpret_cast<const bf16x8*>(&Qw[(long)r32*QP+d0*16+hi*8]);
  float mhat=0.f,l_reg=0.f;float z0_=0.f;asm volatile("":"+v"(z0_));f32x16 o[2];
  #pragma unroll
  for(int r_=0;r_<16;++r_){o[0][r_]=z0_;o[1][r_]=z0_;}
  f32x16 negm;
  #pragma unroll
  for(int r_=0;r_<16;++r_)negm[r_]=z0_;
  asm volatile("":"+v"(negm));
  const int qrow=q0+wid*QBLK+r32;
  #define CMASK(P0,P1,t) do{ if(WIN&&(t)>=4)wmask(P0,P1,TM(t)*KVBLK-qrow,hi); }while(0)
  bool resc=false;
  #define START(P0,P1) do{ const float rm=rowmax(P0,P1); resc=false; \
    { const float dl=rm; mhat=fadd_s(mhat,dl); \
      _Pragma("unroll") for(int r=0;r<16;++r){P0[r]=fsub_s(P0[r],dl);P1[r]=fsub_s(P1[r],dl);} \
      _Pragma("unroll") for(int r=0;r<16;++r)negm[r]=-mhat; asm volatile("":"+v"(negm)); } \
    _Pragma("unroll") for(int r=0;r<16;++r)P0[r]=__builtin_amdgcn_exp2f(P0[r]); }while(0)
  #define RESC() do{ if(resc){ asm volatile("s_waitcnt lgkmcnt(0)":::"memory"); \
      _Pragma("unroll") for(int d_=0;d_<2;++d_) _Pragma("unroll") for(int r=0;r<16;++r)o[d_][r]*=wsf[crow(r,hi)]; } }while(0)
  f32x16 pA0,pA1,pB0,pB1;
  int sl_prev=0,sl_cur=0,sl_next=SLOTB;
  #define ROT() do{sl_prev=sl_cur;sl_cur=sl_next;sl_next=(sl_next==(NSLOT-1)*SLOTB)?0:sl_next+SLOTB;}while(0)
  DMA_K(2,2*SLOTB);
  WAIT_BAR(3);
  qkt(pA0,pA1,Kbase,qr,negm,r32,hi);asm volatile("s_nop 15\n\ts_nop 7":"+v"(pA0),"+v"(pA1));CMASK(pA0,pA1,0);
  START(pA0,pA1);
  _Pragma("unroll") for(int r=0;r<16;++r)pA1[r]=__builtin_amdgcn_exp2f(pA1[r]);
  WAIT_BAR(0);
  DMA_K(3,0);DMA_V(1,SLOTB);
  ROT();
  kload8(kf,kp0+sl_cur);
  WAIT_BAR(2);
  s16x4 vlo[8],vhi[8]; u32x4 pw0,pw1,pw2,pw3;
  #define PKW(P,B) cvtpk_s(P[B],P[B+1])
  #define PAF(k) __builtin_bit_cast(bf16x8,pw##k)
  #define VFR(i) (bf16x8){vlo[i][0],vlo[i][1],vlo[i][2],vlo[i][3],vhi[i][0],vhi[i][1],vhi[i][2],vhi[i][3]}
  #define PIN(x) asm volatile("":"+v"(x))
  #define MX3(a,b,c) __builtin_fmaxf(__builtin_fmaxf((a),(b)),(c))
  #define GAPA(MF,A0,A1,A2,A3,W0,W1,PW) do{ MF; sacc+=A0; sacc+=A1; sacc+=A2; sacc+=A3; PIN(sacc); W0; W1; PIN(PW); SBAR(); }while(0)
  #define EX(v) __builtin_amdgcn_exp2f(v)
  #define GAPB(MF,X,B) do{ MF; X[B]=EX(X[B]); X[B+1]=EX(X[B+1]); X[B+2]=EX(X[B+2]); X[B+3]=EX(X[B+3]); PIN(X); SBAR(); }while(0)
  #define VRD(i) do{ vlo[i]=vtr(vp_+(((i)>>2)*4096+((i)&3)*1024)); vhi[i]=vtr(vp_+(((i)>>2)*4096+((i)&3)*1024+512)); }while(0)
  #define KRD(G,j) do{ if(G){ kload2(kf,kp0+sl_next,j); SBAR(); } }while(0)
  #define STEP(C0,C1,P0,P1,t,GK,GV,GL) do{ SBAR(); \
    const lds_cptr vp_=vp0+sl_prev; \
    VRD(0); SBAR(); float sacc=(P0[0]+P0[1]); \
    GAPA(C0=__builtin_amdgcn_mfma_f32_32x32x16_bf16(kf[0],qr[0],negm,0,0,0), P0[2],P0[3],P0[4],P0[5],     pw0[0]=PKW(P0,0), pw0[1]=PKW(P0,2), pw0); \
    VRD(4); SBAR(); GAPA(C1=__builtin_amdgcn_mfma_f32_32x32x16_bf16(kf[1],qr[0],negm,0,0,0), P0[6],P0[7],P0[8],P0[9],     pw0[2]=PKW(P0,4), pw0[3]=PKW(P0,6), pw0); \
    VRD(1); SBAR(); GAPA(C0=__builtin_amdgcn_mfma_f32_32x32x16_bf16(kf[2],qr[1],C0,0,0,0),   P0[10],P0[11],P0[12],P0[13], pw1[0]=PKW(P0,8), pw1[1]=PKW(P0,10), pw1); \
    VRD(5); SBAR(); GAPA(C1=__builtin_amdgcn_mfma_f32_32x32x16_bf16(kf[3],qr[1],C1,0,0,0),   P0[14],P0[15],P1[0],P1[1],   pw1[2]=PKW(P0,12),pw1[3]=PKW(P0,14), pw1); \
    VRD(2); SBAR(); GAPA(C0=__builtin_amdgcn_mfma_f32_32x32x16_bf16(kf[4],qr[2],C0,0,0,0),   P1[2],P1[3],P1[4],P1[5],     pw2[0]=PKW(P1,0), pw2[1]=PKW(P1,2), pw2); \
    VRD(6); SBAR(); GAPA(C1=__builtin_amdgcn_mfma_f32_32x32x16_bf16(kf[5],qr[2],C1,0,0,0),   P1[6],P1[7],P1[8],P1[9],     pw2[2]=PKW(P1,4), pw2[3]=PKW(P1,6), pw2); \
    VRD(3); SBAR(); GAPA(C0=__builtin_amdgcn_mfma_f32_32x32x16_bf16(kf[6],qr[3],C0,0,0,0),   P1[10],P1[11],P1[12],P1[13], pw3[0]=PKW(P1,8), pw3[1]=PKW(P1,10), pw3); \
    VRD(7); SBAR(); GAPA(C1=__builtin_amdgcn_mfma_f32_32x32x16_bf16(kf[7],qr[3],C1,0,0,0),   P1[14],P1[15],0.f,0.f,       pw3[2]=PKW(P1,12),pw3[3]=PKW(P1,14), pw3); \
    l_reg+=sacc; \
    if(GK){DMA_K((t)+3,sl_cur);} if(GV){DMA_V((t)+1,sl_next);} \
    CMASK(C0,C1,t); \
    { float a=MX3(C0[0],C0[1],C1[0]),b=MX3(C0[2],C0[3],C1[1]); a=MX3(a,C1[2],C1[3]); \
      _Pragma("unroll") for(int r=4;r<16;r+=4){a=MX3(a,C0[r],C0[r+1]);b=MX3(b,C0[r+2],C0[r+3]);a=MX3(a,C1[r],C1[r+1]);b=MX3(b,C1[r+2],C1[r+3]);} \
      float rm=__builtin_fmaxf(a,b); { auto rr=__builtin_amdgcn_permlane32_swap(__float_as_uint(rm),__float_as_uint(rm),false,false); rm=__builtin_fmaxf(__uint_as_float(rr[0]),__uint_as_float(rr[1])); } \
      resc=false; \
      if(__builtin_expect(__any(rm>(float)THRL),0)){ const float dl=__builtin_fmaxf(rm,0.f); mhat+=dl; \
        _Pragma("unroll") for(int r=0;r<16;++r){C0[r]-=dl;C1[r]-=dl;} \
        _Pragma("unroll") for(int r=0;r<16;++r)negm[r]=-mhat; asm volatile("":"+v"(negm)); \
        const float f=__builtin_amdgcn_exp2f(-dl); l_reg*=f; if(hi==0)wsf[r32]=f; resc=true; } } \
    SBAR(); \
    GAPB(o[0]=__builtin_amdgcn_mfma_f32_32x32x16_bf16(PAF(0),VFR(0),o[0],0,0,0), C0,0); \
    GAPB(o[1]=__builtin_amdgcn_mfma_f32_32x32x16_bf16(PAF(0),VFR(4),o[1],0,0,0), C0,4); \
    KRD(GL,0); GAPB(o[0]=__builtin_amdgcn_mfma_f32_32x32x16_bf16(PAF(1),VFR(1),o[0],0,0,0), C0,8); \
    KRD(GL,1); GAPB(o[1]=__builtin_amdgcn_mfma_f32_32x32x16_bf16(PAF(1),VFR(5),o[1],0,0,0), C0,12); \
    KRD(GL,2); GAPB(o[0]=__builtin_amdgcn_mfma_f32_32x32x16_bf16(PAF(2),VFR(2),o[0],0,0,0), C1,0); \
    KRD(GL,3); GAPB(o[1]=__builtin_amdgcn_mfma_f32_32x32x16_bf16(PAF(2),VFR(6),o[1],0,0,0), C1,4); \
    GAPB(o[0]=__builtin_amdgcn_mfma_f32_32x32x16_bf16(PAF(3),VFR(3),o[0],0,0,0), C1,8); \
    GAPB(o[1]=__builtin_amdgcn_mfma_f32_32x32x16_bf16(PAF(3),VFR(7),o[1],0,0,0), C1,12); \
    }while(0)
  int t=1;
  for(;t+5<NT;t+=2){
    STEP(pB0,pB1,pA0,pA1,t,true,true,true);     WAIT_BAR(2); RESC(); ROT();
    STEP(pA0,pA1,pB0,pB1,t+1,true,true,true);   WAIT_BAR(2); RESC(); ROT();
  }
  #define ENDW(tt) do{ if((tt)+3<NT){WAIT_BAR(2);} else if((tt)+2<NT){WAIT_BAR(1);} else {WAIT_BAR(0);} }while(0)
  for(;t+1<NT;t+=2){
    STEP(pB0,pB1,pA0,pA1,t,(t+3<NT),(t+1<NT),(t+1<NT));       ENDW(t);   RESC(); ROT();
    STEP(pA0,pA1,pB0,pB1,t+1,(t+4<NT),(t+2<NT),(t+2<NT));     ENDW(t+1); RESC(); ROT();
  }
  STEP(pB0,pB1,pA0,pA1,NT-1,false,false,false); RESC();
  { float sacc=pB0[0]+pB0[1]; _Pragma("unroll") for(int r=2;r<16;++r)sacc+=pB0[r]; _Pragma("unroll") for(int r=0;r<16;++r)sacc+=pB1[r]; l_reg+=sacc;
    pw0=(u32x4){PKW(pB0,0),PKW(pB0,2),PKW(pB0,4),PKW(pB0,6)};pw1=(u32x4){PKW(pB0,8),PKW(pB0,10),PKW(pB0,12),PKW(pB0,14)};pw2=(u32x4){PKW(pB1,0),PKW(pB1,2),PKW(pB1,4),PKW(pB1,6)};pw3=(u32x4){PKW(pB1,8),PKW(pB1,10),PKW(pB1,12),PKW(pB1,14)};
    SBAR(); pv(o,vb0+sl_cur,PAF(0),PAF(1),PAF(2),PAF(3)); }
  #undef PKW
  #undef PAF
  #undef VFR
  #undef PIN
  #undef MX3
  #undef GAPA
  #undef GAPB
  #undef EX
  #undef VRD
  #undef KRD
  #undef STEP
  #undef ENDW
  {auto rr=__builtin_amdgcn_permlane32_swap(__float_as_uint(l_reg),__float_as_uint(l_reg),false,false);l_reg=__uint_as_float(rr[0])+__uint_as_float(rr[1]);}
  if(WIN)l_reg+=__builtin_amdgcn_exp2f(sink_l2-mhat);
  if(hi==0)wsf[32+r32]=l_reg;asm volatile("s_waitcnt lgkmcnt(0)":::"memory");
  float rli[16];
  #pragma unroll
  for(int r=0;r<16;++r)rli[r]=__builtin_amdgcn_rcpf(wsf[32+crow(r,hi)]);
  bf16*Ow=Ob+(long)(q0+wid*QBLK)*OP;
  { bf16*stg=(bf16*)(shm+LDS_OST)+wid*2048;
    #pragma unroll
    for(int r=0;r<16;++r){const int orow=crow(r,hi);
      #pragma unroll
      for(int d0=0;d0<2;++d0)stg[orow*64+d0*32+r32]=__float2bfloat16(o[d0][r]*rli[r]);}
    asm volatile("s_waitcnt lgkmcnt(0)":::"memory");
    #pragma unroll
    for(int i=0;i<4;++i){const int row=i*8+(lane>>3),ch=lane&7; const u32x4 v=*(const u32x4*)(stg+row*64+ch*8); ATTN_STORE16(Ow+(long)row*OP+ch*8,v);} }
  asm volatile("s_waitcnt lgkmcnt(0)\n\ts_barrier":::"memory");
  #undef TM
  #undef DMA_K
  #undef DMA_V
  #undef CMASK
  #undef START
  #undef RESC
  #undef ROT
}
constexpr int ATTN_LDS_BYTES=LDS_BYTES;
#undef SBAR
#undef WAIT_BAR
}
#define XB_TMO      128
#define XB_XCNT(j)  (256  + 64 * (j))
#define XB_XSUB(j)  (1280 + 64 * (j))
#define XB_XGEN(j)  (2304 + 64 * (j))
#define XB_TOP      3328
#define XB_TOPGEN   3392
#define XCD_BAR_WORDS 3456
#define XB_SPIN_CAP (1u << 21)

__device__ __forceinline__ unsigned xb_ld(unsigned* p)              { return __hip_atomic_load(p, __ATOMIC_RELAXED, __HIP_MEMORY_SCOPE_AGENT); }
__device__ __forceinline__ unsigned xb_add(unsigned* p, unsigned v) { return __hip_atomic_fetch_add(p, v, __ATOMIC_RELAXED, __HIP_MEMORY_SCOPE_AGENT); }
__device__ __forceinline__ unsigned xb_xcc_id() { return (unsigned)__builtin_amdgcn_s_getreg((3 << 11) | 20) & 0xFu; }
#define XB_SPIN(cond, bar) do { unsigned _sp = 0; while (cond) { __builtin_amdgcn_s_sleep(1); \
    if ((++_sp & 255u) == 0u) { if (xb_ld(&(bar)[XB_TMO])) break; if (_sp > XB_SPIN_CAP) { atomicAdd(&(bar)[XB_TMO], 1u); break; } } } } while (0)

struct XcdBarrier {
    unsigned* bar; unsigned x;
    volatile LAS unsigned* st;
};

__device__ __forceinline__ XcdBarrier xcd_barrier_post(unsigned* bar, volatile LAS unsigned* st) {
    XcdBarrier b; b.bar = bar; b.x = xb_xcc_id(); b.st = st;
    if (threadIdx.x == 0) (void)xb_add(&bar[XB_XCNT(b.x)], 1u);
    return b;
}
__device__ __forceinline__ void xcd_barrier_complete(unsigned* bar, unsigned x, unsigned& nloc, unsigned& nx) {
    const unsigned G = gridDim.x * gridDim.y * gridDim.z;
    unsigned sum, cnt, mine, sp = 0u;
    for (;;) {
        sum = 0u; cnt = 0u; mine = 0u;
#pragma unroll
        for (unsigned j = 0; j < 16; ++j) { const unsigned c = xb_ld(&bar[XB_XCNT(j)]); sum += c; cnt += (c > 0u) ? 1u : 0u; mine = (j == x) ? c : mine; }
        if (sum == G) break;
        __builtin_amdgcn_s_sleep(1);
        if ((++sp & 255u) == 0u) { if (xb_ld(&bar[XB_TMO])) break; if (sp > XB_SPIN_CAP) { atomicAdd(&bar[XB_TMO], 1u); break; } }
    }
    nloc = mine > 0u ? mine : 1u; nx = cnt > 0u ? cnt : 1u;
}

__device__ __forceinline__ void xcd_barrier(const XcdBarrier& b) {
    asm volatile("s_waitcnt vmcnt(0)" ::: "memory");
    __syncthreads();
    if (threadIdx.x == 0) {
        unsigned* bar = b.bar; unsigned bx_ = b.x; asm volatile("" : "+s"(bar), "+s"(bx_));
        __builtin_amdgcn_s_waitcnt(0);
        unsigned nloc = b.st[0], nx = b.st[1];
        if (nloc == 0u) { xcd_barrier_complete(bar, bx_, nloc, nx); b.st[0] = nloc; b.st[1] = nx; }
        const unsigned old = xb_add(&bar[XB_XSUB(bx_)], 1u);
        const unsigned gen = old / nloc;
        if (old + 1u == (gen + 1u) * nloc) {
            __builtin_amdgcn_fence(__ATOMIC_RELEASE, "agent");
            asm volatile("s_waitcnt vmcnt(0)" ::: "memory");
            const unsigned og = xb_add(&bar[XB_TOP], 1u);
            const unsigned tg = og / nx;
            if (og + 1u == (tg + 1u) * nx) xb_add(&bar[XB_TOPGEN], 1u);
            else XB_SPIN(xb_ld(&bar[XB_TOPGEN]) == tg, bar);
            __builtin_amdgcn_fence(__ATOMIC_ACQUIRE, "agent");
            xb_add(&bar[XB_XGEN(bx_)], 1u);
            asm volatile("s_waitcnt vmcnt(0)" ::: "memory");
        } else {
            XB_SPIN(xb_ld(&bar[XB_XGEN(bx_)]) == gen, bar);
            __builtin_amdgcn_fence(__ATOMIC_ACQUIRE, "agent");
            asm volatile("s_waitcnt vmcnt(0)" ::: "memory");
        }
    }
    __syncthreads();
}

#ifndef EPROBE
#define EPROBE 0
#endif
#ifndef CVQ0
#define CVQ0 3
#define CVQ1 4
#define CVQ2 3
#define CVQ3 3
#endif
constexpr size_t alup(size_t x) { return (x + 4095) & ~(size_t)4095; }
constexpr size_t CTL_BYTES = 1u << 20;
constexpr size_t SZ_WIN = (size_t)DEPTH * DIN * DM  , SZ_WOUT = (size_t)DEPTH * DM * DM * 2, SZ_WGU = (size_t)DEPTH * NE * 2 * FF * DM  , SZ_WDN = (size_t)DEPTH * NE * DM * FF  ;
constexpr size_t SZ_MODP = (size_t)DEPTH * 16 * 17 * 6144 * 4, SZ_MOD = (size_t)DEPTH * 17 * 6144 * 4;
constexpr size_t SZ_X32 = (size_t)MROWS * DM * 2  , SZ_H = (size_t)MROWS * DM * 2, SZ_P = (size_t)MROWS * DIN * 2, SZ_Y = (size_t)MROWS * DM * 2, SZ_YP = (size_t)MROWS * 2 * DM  ;
constexpr size_t SZ_LIST = (size_t)NE * MROWS * 4, SZ_GW = (size_t)NE * MROWS * 4  , SZ_HS = (size_t)MROWS * 4  ;
constexpr int MAXBLK = (MROWS * 2) / 256 + NE;
static_assert((size_t)MAXBLK * 256 * FF * 2 <= SZ_P, "HMID overlays P");
static_assert((size_t)2 * NB * 4 * NCH * 128 * 64 * 4 <= SZ_H, "KVT overlays H");
static_assert((size_t)2 * NB * 4 * NCH * 128 * 64 * 2 <= SZ_YP, "ST overlays YP");
constexpr size_t WS_CTL = 0;
constexpr size_t WS_WIN = CTL_BYTES, WS_WOUT = WS_WIN + alup(SZ_WIN), WS_WGU = WS_WOUT + alup(SZ_WOUT), WS_WDN = WS_WGU + alup(SZ_WGU);
constexpr size_t WS_MODP = WS_WDN + alup(SZ_WDN), WS_MOD = WS_MODP + alup(SZ_MODP);
constexpr size_t WS_X32 = WS_MOD + alup(SZ_MOD), WS_H = WS_X32 + alup(SZ_X32), WS_P = WS_H + alup(SZ_H), WS_Y = WS_P + alup(SZ_P), WS_YP = WS_Y + alup(SZ_Y);
constexpr size_t WS_LIST = WS_YP + alup(SZ_YP), WS_GW = WS_LIST + alup(SZ_LIST), WS_HS = WS_GW + alup(SZ_GW), WS_END = WS_HS + alup(SZ_HS);
constexpr int CW_BAR = 4096;
constexpr int CW_CNT = 16384;
constexpr int CW_WSC = 24576;

constexpr int RING_BYTES = 131072;
constexpr int LDSCTL_OFF = RING_BYTES;
constexpr int LDS_BYTES = 147456;

#define ATTN_STORE16(p,v) (*(u32x4*)(p)=(v))

#define CAS __attribute__((address_space(4)))
__device__ __forceinline__ const float* inp(int i) {
    const CAS unsigned char* k = (const CAS unsigned char*)__builtin_amdgcn_kernarg_segment_ptr();
    asm volatile("" : "+s"(k));
    return *(const float* const CAS*)(k + 8 * i);
}
#define CBAR() do { asm volatile("" ::: "memory"); __builtin_amdgcn_sched_barrier(0); } while (0)
struct Ctx {
    float* out; unsigned char* ws;
    __device__ __forceinline__ const float* x() const { return inp(0); }
    __device__ __forceinline__ const float* c() const { return inp(1); }
    __device__ __forceinline__ const float* ctx() const { return inp(2); }
    __device__ __forceinline__ const float* c_ctx() const { return inp(3); }
    __device__ __forceinline__ const float* ada_w() const { return inp(4); }
    __device__ __forceinline__ const float* ada_b() const { return inp(5); }
    __device__ __forceinline__ const float* norm1() const { return inp(6); }
    __device__ __forceinline__ const float* norm2() const { return inp(7); }
    __device__ __forceinline__ const float* w_in() const { return inp(8); }
    __device__ __forceinline__ const float* w_out() const { return inp(9); }
    __device__ __forceinline__ const float* ret_decay() const { return inp(10); }
    __device__ __forceinline__ const float* win_gain() const { return inp(11); }
    __device__ __forceinline__ const float* win_sink() const { return inp(12); }
    __device__ __forceinline__ const float* glb_gain() const { return inp(13); }
    __device__ __forceinline__ const float* w_router() const { return inp(14); }
    __device__ __forceinline__ const float* b_router() const { return inp(15); }
    __device__ __forceinline__ const float* w_gu() const { return inp(16); }
    __device__ __forceinline__ const float* w_dn() const { return inp(17); }
};

template <int CTRL> __device__ __forceinline__ float dppx(float v) { return __builtin_bit_cast(float, __builtin_amdgcn_update_dpp(0, __builtin_bit_cast(int, v), CTRL, 0xF, 0xF, true)); }
__device__ __forceinline__ float xor1(float v) { return dppx<0xB1>(v); }
__device__ __forceinline__ float xor2(float v) { return dppx<0x4E>(v); }
__device__ __forceinline__ float wave_sum(float v) {
    v += dppx<0xB1>(v); v += dppx<0x4E>(v); v += dppx<0x141>(v); v += dppx<0x140>(v);
    { const unsigned u = __builtin_bit_cast(unsigned, v); auto r = __builtin_amdgcn_permlane16_swap(u, u, false, false); v = __builtin_bit_cast(float, (unsigned)r[0]) + __builtin_bit_cast(float, (unsigned)r[1]); }
    { const unsigned u = __builtin_bit_cast(unsigned, v); auto r = __builtin_amdgcn_permlane32_swap(u, u, false, false); v = __builtin_bit_cast(float, (unsigned)r[0]) + __builtin_bit_cast(float, (unsigned)r[1]); }
    return v;
}
__device__ __forceinline__ float xor16(float v, int lane) { const unsigned u = __builtin_bit_cast(unsigned, v); auto r = __builtin_amdgcn_permlane16_swap(u, u, false, false);
    return __builtin_bit_cast(float, (lane & 16) ? (unsigned)r[0] : (unsigned)r[1]); }
__device__ __forceinline__ float silu_f(float v) { return v * __builtin_amdgcn_rcpf(1.f + __builtin_amdgcn_exp2f(-LOG2E * v)); }
__device__ __forceinline__ float log2_sigmoid(float x) { return -__builtin_amdgcn_logf(1.0f + __builtin_amdgcn_exp2f(-LOG2E * x)); }
__device__ __forceinline__ float rsq_f(float x) { return __builtin_amdgcn_rsqf(x); }

__device__ __forceinline__ void transpose_item(const float* W, int N, int nsrc0, int k0, bf16_t* WT, int K, int nrow0, LAS float* scr, int lane) {
    float ld_[32];
#pragma unroll
    for (int i = 0; i < 32; ++i) ld_[i] = W[(size_t)(k0 + 2 * i + (lane >> 5)) * N + nsrc0 + (lane & 31)];
#pragma unroll
    for (int i = 0; i < 32; ++i) scr[(2 * i + (lane >> 5)) * 33 + (lane & 31)] = ld_[i];
    asm volatile("s_waitcnt lgkmcnt(0)" ::: "memory");
    const int c = lane & 7;
#pragma unroll
    for (int j = 0; j < 4; ++j) { const int n = (lane >> 3) + 8 * j; const LAS float* s = scr + (8 * c) * 33 + n;
        u32x4 o; o.x = pk2(s[0 * 33], s[1 * 33]); o.y = pk2(s[2 * 33], s[3 * 33]); o.z = pk2(s[4 * 33], s[5 * 33]); o.w = pk2(s[6 * 33], s[7 * 33]);
        *(u32x4*)(WT + (size_t)(nrow0 + n) * K + k0 + 8 * c) = o; }
    asm volatile("s_waitcnt lgkmcnt(0)" ::: "memory");
}
__device__ __forceinline__ unsigned pk4_fp8(float a, float b, float c, float d) { int w = 0; w = __builtin_amdgcn_cvt_pk_fp8_f32(a, b, w, false); w = __builtin_amdgcn_cvt_pk_fp8_f32(c, d, w, true); return (unsigned)w; }
__device__ __forceinline__ unsigned pk4_i8(float a, float b, float c, float d) {
    const int qa = (int)__builtin_fminf(__builtin_fmaxf(__builtin_rintf(a), -127.f), 127.f), qb = (int)__builtin_fminf(__builtin_fmaxf(__builtin_rintf(b), -127.f), 127.f);
    const int qc = (int)__builtin_fminf(__builtin_fmaxf(__builtin_rintf(c), -127.f), 127.f), qd = (int)__builtin_fminf(__builtin_fmaxf(__builtin_rintf(d), -127.f), 127.f);
    return (unsigned)(qa & 255) | ((unsigned)(qb & 255) << 8) | ((unsigned)(qc & 255) << 16) | ((unsigned)qd << 24);
}
__device__ __forceinline__ float wave_max(float v) {
    v = __builtin_fmaxf(v, dppx<0xB1>(v)); v = __builtin_fmaxf(v, dppx<0x4E>(v)); v = __builtin_fmaxf(v, dppx<0x141>(v)); v = __builtin_fmaxf(v, dppx<0x140>(v));
    { const unsigned u = __builtin_bit_cast(unsigned, v); auto r = __builtin_amdgcn_permlane16_swap(u, u, false, false); v = __builtin_fmaxf(__builtin_bit_cast(float, (unsigned)r[0]), __builtin_bit_cast(float, (unsigned)r[1])); }
    { const unsigned u = __builtin_bit_cast(unsigned, v); auto r = __builtin_amdgcn_permlane32_swap(u, u, false, false); v = __builtin_fmaxf(__builtin_bit_cast(float, (unsigned)r[0]), __builtin_bit_cast(float, (unsigned)r[1])); }
    return v;
}
__device__ __forceinline__ f32x4 fp8x4_f32(unsigned w) { typedef float f2_ __attribute__((ext_vector_type(2))); const f2_ lo = __builtin_amdgcn_cvt_pk_f32_fp8((int)w, false), hi = __builtin_amdgcn_cvt_pk_f32_fp8((int)w, true); return (f32x4){lo[0], lo[1], hi[0], hi[1]}; }
constexpr float YP_SCALE = 16.0f, YP_INV = 1.0f / 16.0f;
constexpr float W8_SCALE = 64.0f, W8_INV = 1.0f / 64.0f;
__device__ __forceinline__ void transpose_item8(const float* W, int N, int nsrc0, int k0, unsigned char* WT, int K, int nrow0, LAS float* scr, int lane) {
    float ld_[32];
#pragma unroll
    for (int i = 0; i < 32; ++i) ld_[i] = W[(size_t)(k0 + 2 * i + (lane >> 5)) * N + nsrc0 + (lane & 31)];
#pragma unroll
    for (int i = 0; i < 32; ++i) scr[(2 * i + (lane >> 5)) * 33 + (lane & 31)] = ld_[i];
    asm volatile("s_waitcnt lgkmcnt(0)" ::: "memory");
    const int c = lane & 7;
#pragma unroll
    for (int j = 0; j < 4; ++j) { const int n = (lane >> 3) + 8 * j; const LAS float* s = scr + (8 * c) * 33 + n;
        u32x2 o; o.x = pk4_fp8(s[0 * 33] * W8_SCALE, s[1 * 33] * W8_SCALE, s[2 * 33] * W8_SCALE, s[3 * 33] * W8_SCALE); o.y = pk4_fp8(s[4 * 33] * W8_SCALE, s[5 * 33] * W8_SCALE, s[6 * 33] * W8_SCALE, s[7 * 33] * W8_SCALE);
        *(u32x2*)(WT + (size_t)(nrow0 + n) * K + k0 + 8 * c) = o; }
    asm volatile("s_waitcnt lgkmcnt(0)" ::: "memory");
}
__device__ __forceinline__ void transpose_item_i8(const float* W, int N, int nsrc0, int k0, unsigned char* WT, int K, int nrow0, LAS float* scr, int lane, float inv) {
    float ld_[32];
#pragma unroll
    for (int i = 0; i < 32; ++i) ld_[i] = W[(size_t)(k0 + 2 * i + (lane >> 5)) * N + nsrc0 + (lane & 31)];
#pragma unroll
    for (int i = 0; i < 32; ++i) scr[(2 * i + (lane >> 5)) * 33 + (lane & 31)] = ld_[i];
    asm volatile("s_waitcnt lgkmcnt(0)" ::: "memory");
    const int c = lane & 7;
#pragma unroll
    for (int j = 0; j < 4; ++j) { const int n = (lane >> 3) + 8 * j; const LAS float* s = scr + (8 * c) * 33 + n;
        u32x2 o; o.x = pk4_i8(s[0 * 33] * inv, s[1 * 33] * inv, s[2 * 33] * inv, s[3 * 33] * inv); o.y = pk4_i8(s[4 * 33] * inv, s[5 * 33] * inv, s[6 * 33] * inv, s[7 * 33] * inv);
        *(u32x2*)(WT + (size_t)(nrow0 + n) * K + k0 + 8 * c) = o; }
    asm volatile("s_waitcnt lgkmcnt(0)" ::: "memory");
}
constexpr int IT_WIN = 16 * 80, IT_WOUT = 16 * 32, IT_GU = 16 * 64, IT_DN = 16 * 32, IT_LAYER = IT_WIN + IT_WOUT + NE * (IT_GU + IT_DN);
__device__ __forceinline__ void convert_item(const Ctx& C, int l, int r, LAS float* scr, int lane) {
    if (r < IT_WIN) { const int kb = r / 80, nb = r % 80;
        const float sc = __builtin_bit_cast(float, ((const unsigned*)(C.ws + WS_CTL))[CW_WSC + 17 * l]);
        transpose_item_i8(C.w_in() + (size_t)l * DM * DIN, DIN, 32 * nb, 64 * kb, (unsigned char*)(C.ws + WS_WIN) + (size_t)l * DIN * DM, DM, 32 * nb, scr, lane, 1.0f / sc); return; }
    r -= IT_WIN;
    if (r < IT_WOUT) { const int kb = r / 32, nb = r % 32;
        transpose_item(C.w_out() + (size_t)l * DM * DM, DM, 32 * nb, 64 * kb, (bf16_t*)(C.ws + WS_WOUT) + (size_t)l * DM * DM, DM, 32 * nb, scr, lane); return; }
    r -= IT_WOUT;
    if (r < NE * IT_GU) { const int e = r / IT_GU, q = r % IT_GU, kb = q / 64, nb = q % 64;
        const int np = 32 * nb, tile = np >> 8, within = np & 255, nsrc = within < 128 ? tile * 128 + within : FF + tile * 128 + within - 128;
        const float sc = __builtin_bit_cast(float, ((const unsigned*)(C.ws + WS_CTL))[CW_WSC + 17 * l + 1 + e]);
        transpose_item_i8(C.w_gu() + (size_t)(l * NE + e) * DM * 2 * FF, 2 * FF, nsrc, 64 * kb, (unsigned char*)(C.ws + WS_WGU) + (size_t)(l * NE + e) * 2 * FF * DM, DM, np, scr, lane, 1.0f / sc); return; }
    r -= NE * IT_GU;
    { const int e = r / IT_DN, q = r % IT_DN, kb = q / 32, nb = q % 32;
        transpose_item8(C.w_dn() + (size_t)(l * NE + e) * FF * DM, DM, 32 * nb, 64 * kb, (unsigned char*)(C.ws + WS_WDN) + (size_t)(l * NE + e) * DM * FF, FF, 32 * nb, scr, lane); }
}
__device__ __forceinline__ int cv_lo(int p) { return p == 0 ? 0 : p == 1 ? 3840 : p == 2 ? 13056 : p == 3 ? 19712 : IT_LAYER; }
__device__ __forceinline__ int cv_q(int p) { return p == 0 ? CVQ0 : p == 1 ? CVQ1 : p == 2 ? CVQ2 : CVQ3; }
__device__ __forceinline__ int cv_covered(int p, int units, int G) { const int rem = units % G; if (rem == 0) return 0; const int n = (G - rem) * 8 * cv_q(p), len = cv_lo(p + 1) - cv_lo(p); return n < len ? n : len; }
__device__ __forceinline__ void convert_tail(const Ctx& C, int lnext, int p, int units, int G, int c, LAS unsigned char* lds, int wave, int lane) {
    const int rem = units % G; if (rem == 0 || c < rem) return;
    const int nidle = G - rem, k = c - rem, lo = cv_lo(p), hi = cv_lo(p + 1);
    LAS float* scr = (LAS float*)(lds + wave * 16384);
    for (int j = 0; j < cv_q(p); ++j) { const int it = lo + (j * nidle + k) * 8 + wave; if (it < hi) convert_item(C, lnext, it, scr, lane); }
}
__device__ __forceinline__ void convert_rest(const Ctx& C, int l, int G, int vcu, LAS unsigned char* lds, int wave, int lane, int units2, int units3) {
    LAS float* scr = (LAS float*)(lds + wave * 16384);
    const int gw = vcu * 8 + wave, NGW = G * 8;
    const int lo0 = cv_lo(0) + cv_covered(0, (MROWS / 256) * (DIN / 256), G), lo1 = cv_lo(1) + cv_covered(1, (MROWS / 256) * (DM / 256), G), lo2 = cv_lo(2) + cv_covered(2, units2, G), lo3 = cv_lo(3) + cv_covered(3, units3, G);
    const int n0 = cv_lo(1) - lo0, n1 = cv_lo(2) - lo1, n2 = cv_lo(3) - lo2, n3 = cv_lo(4) - lo3;
    for (int v = gw; v < n0 + n1 + n2 + n3; v += NGW) { int r = v, it;
        if (r < n0) it = lo0 + r; else { r -= n0; if (r < n1) it = lo1 + r; else { r -= n1; if (r < n2) it = lo2 + r; else it = lo3 + (r - n2); } }
        convert_item(C, l, it, scr, lane); }
}
__device__ __forceinline__ void phase_prologue(const Ctx& C, LAS unsigned char* lds, int G, int vcu, int bx, int tid) {
    const int lane = tid & 63, wave = tid >> 6;
    {
        LAS float* scs = (LAS float*)lds;
        bool have = false;
        for (int it = bx; it < DEPTH * 12 * 16; it += G) {
            if (!have) {
                for (int i = tid; i < 17 * DM; i += 512) { const int r = i >> 10, k = i & 1023; const float v = r < 16 ? C.c()[r * DM + k] : C.c_ctx()[k]; scs[i] = v / (1.f + expf(-v)); }
                __syncthreads(); have = true;
            }
            const int l = it / 192, rem = it % 192, cb = rem / 16, kc = rem % 16;
            const float* w = C.ada_w() + ((size_t)l * DM + kc * 64) * 6144 + cb * 512 + tid;
            float acc[17];
#pragma unroll
            for (int r = 0; r < 17; ++r) acc[r] = 0.f;
#pragma unroll 4
            for (int kk = 0; kk < 64; ++kk) { const float wv = w[(size_t)kk * 6144];
#pragma unroll
                for (int r = 0; r < 17; ++r) acc[r] += scs[r * DM + kc * 64 + kk] * wv; }
            float* mp = (float*)(C.ws + WS_MODP) + ((size_t)(l * 16 + kc) * 17) * 6144 + cb * 512 + tid;
#pragma unroll
            for (int r = 0; r < 17; ++r) mp[(size_t)r * 6144] = acc[r];
        }
        __syncthreads();
    }
    for (int id = bx; id < DEPTH * 17; id += G) {
        const int l = id / 17, t = id % 17; const float* W = t == 0 ? C.w_in() + (size_t)l * DM * DIN : C.w_gu() + (size_t)(l * NE + t - 1) * DM * 2 * FF; const size_t n = t == 0 ? (size_t)DM * DIN : (size_t)DM * 2 * FF;
        float ss = 0.f;
        for (int i = tid; i < 8192; i += 512) { const float v = W[(size_t)i * (n / 8192) + (i & 63)]; ss += v * v; }
        ss = wave_sum(ss); LAS float* red = (LAS float*)(lds + 131072 - 64);
        __syncthreads(); if (lane == 0) red[wave] = ss; __syncthreads();
        if (tid == 0) { float tot = 0.f; for (int w = 0; w < 8; ++w) tot += red[w]; const float sc = 6.0f * sqrtf(tot * (1.f / 8192.f)) * (1.f / 127.f);
            __hip_atomic_store((unsigned*)(C.ws + WS_CTL) + CW_WSC + id, __builtin_bit_cast(unsigned, sc > 0.f ? sc : 1.0f), __ATOMIC_RELAXED, __HIP_MEMORY_SCOPE_AGENT); }
        __syncthreads();
    }
    LAS float* scr = (LAS float*)(lds + wave * 16384);
    const int gw = vcu * 8 + wave, NGW = G * 8;
    for (int v = gw; v < IT_WOUT + NE * IT_DN; v += NGW) convert_item(C, 0, v < IT_WOUT ? IT_WIN + v : IT_WIN + IT_WOUT + NE * IT_GU + (v - IT_WOUT), scr, lane);
}
__device__ __forceinline__ void phase_modsum(const Ctx& C, int G, int bx, int tid, int vcu, LAS unsigned char* lds) {
    const float* mp = (const float*)(C.ws + WS_MODP); float* mod = (float*)(C.ws + WS_MOD);
    for (int i = bx * 512 + tid; i < DEPTH * 17 * 6144; i += G * 512) {
        const int l = i / (17 * 6144), rem = i % (17 * 6144), r = rem / 6144, n = rem % 6144;
        float s = C.ada_b()[l * 6144 + n];
#pragma unroll
        for (int kc = 0; kc < 16; ++kc) s += mp[((size_t)(l * 16 + kc) * 17 + r) * 6144 + n];
        mod[i] = s;
    }
    { const int lane = tid & 63, wave = tid >> 6; LAS float* scr = (LAS float*)(lds + wave * 16384); const int gw = vcu * 8 + wave, NGW = G * 8;
      for (int v = gw; v < IT_WIN + NE * IT_GU; v += NGW) convert_item(C, 0, v < IT_WIN ? v : IT_WOUT + v, scr, lane); }
}

__device__ __forceinline__ f32x4 bf4(u32x2 a) { return (f32x4){bflo(a.x), bfhi(a.x), bflo(a.y), bfhi(a.y)}; }
__device__ __forceinline__ u32x2 pk4(f32x4 v) { u32x2 w; w.x = pk2(v[0], v[1]); w.y = pk2(v[2], v[3]); return w; }
__device__ __forceinline__ void phase_norm1(const Ctx& C, int layer, int gw, int NGW, int lane, bf16_t* XO) {
    const float* mod = (const float*)(C.ws + WS_MOD) + (size_t)layer * 17 * 6144;
    const float* gain = C.norm1() + layer * DM;
    bf16_t* XR = (bf16_t*)(C.ws + WS_X32); unsigned char* H = (unsigned char*)(C.ws + WS_H); float* HS = (float*)(C.ws + WS_HS); const unsigned char* YP = (const unsigned char*)(C.ws + WS_YP);
    const float* xin = C.x(); const float* cin = C.ctx();
    f32x4 nx[4]; u32x2 nr[4]; unsigned na[4], nb[4];
#define N1_LOAD(mm) do { const int b_ = (mm) / TPB, t_ = (mm) - b_ * TPB; \
        if (layer == 0) { const f32x4* s_ = (const f32x4*)(t_ < CTX ? cin + ((size_t)b_ * CTX + t_) * DM : xin + ((size_t)b_ * SEQ + (t_ - CTX)) * DM) + lane; \
            _Pragma("unroll") for (int j = 0; j < 4; ++j) nx[j] = s_[64 * j]; } \
        else { const u32x2* s_ = (const u32x2*)(XR + (size_t)(mm) * DM) + lane; const unsigned* y0_ = (const unsigned*)(YP + (size_t)(mm) * 2 * DM) + lane; \
            _Pragma("unroll") for (int j = 0; j < 4; ++j) { nr[j] = s_[64 * j]; na[j] = y0_[64 * j]; nb[j] = y0_[DM / 4 + 64 * j]; } } } while (0)
    if (gw < MROWS) N1_LOAD(gw);
    for (int m = gw; m < MROWS; m += NGW) {
        const int b = m / TPB, t = m - b * TPB, set = t < CTX ? 16 : b;
        f32x4 v[4];
        if (layer == 0) {
#pragma unroll
            for (int j = 0; j < 4; ++j) v[j] = nx[j];
        } else {
            const f32x4* g2 = (const f32x4*)(mod - 17 * 6144 + (size_t)set * 6144 + 5 * DM) + lane;
#pragma unroll
            for (int j = 0; j < 4; ++j) v[j] = bf4(nr[j]) + (g2[64 * j] * YP_INV) * (fp8x4_f32(na[j]) + fp8x4_f32(nb[j]));
        }
        if (m + NGW < MROWS) N1_LOAD(m + NGW);
        u32x2* xo = (u32x2*)(XO + (size_t)m * DM) + lane;
        float ss = 0.f;
#pragma unroll
        for (int j = 0; j < 4; ++j) { xo[64 * j] = pk4(v[j]); ss += (v[j][0] * v[j][0] + v[j][1] * v[j][1]) + (v[j][2] * v[j][2] + v[j][3] * v[j][3]); }
        const float rstd = rsq_f(wave_sum(ss) * (1.f / DM) + EPS);
        const f32x4* gp = (const f32x4*)gain + lane; const f32x4* shp = (const f32x4*)(mod + (size_t)set * 6144) + lane; const f32x4* scp = shp + DM / 4;
        float mx = 0.f;
#pragma unroll
        for (int j = 0; j < 4; ++j) { v[j] = (v[j] * rstd) * gp[64 * j] * (scp[64 * j] + 1.0f) + shp[64 * j];
            mx = __builtin_fmaxf(mx, __builtin_fmaxf(__builtin_fmaxf(__builtin_fabsf(v[j][0]), __builtin_fabsf(v[j][1])), __builtin_fmaxf(__builtin_fabsf(v[j][2]), __builtin_fabsf(v[j][3])))); }
        mx = __builtin_fmaxf(wave_max(mx), 1e-20f); const float inv = 127.0f / mx;
        if (lane == 0) HS[m] = mx * (1.0f / 127.0f);
        unsigned* ho = (unsigned*)(H + (size_t)m * DM) + lane;
#pragma unroll
        for (int j = 0; j < 4; ++j) ho[64 * j] = pk4_i8(v[j][0] * inv, v[j][1] * inv, v[j][2] * inv, v[j][3] * inv);
    }
#undef N1_LOAD
}

__device__ __forceinline__ float swz_xor4(float v) { return __builtin_bit_cast(float, __builtin_amdgcn_ds_swizzle(__builtin_bit_cast(int, v), 0x101F)); }
__device__ __forceinline__ float swz_xor8(float v) { return __builtin_bit_cast(float, __builtin_amdgcn_ds_swizzle(__builtin_bit_cast(int, v), 0x201F)); }
__device__ __forceinline__ void phase_qkprep(const Ctx& C, int layer, int gw, int NGW, int lane, bf16_t* PO) {
    const bf16_t* P = (const bf16_t*)(C.ws + WS_P);
    const int hs = lane >> 3, j = lane & 7;
    const int col0 = (hs < 4 ? C_WQ + 64 * hs : hs < 6 ? C_WK + 64 * (hs - 4) : C_GQ + 64 * (hs - 6)) + 8 * j;
    const int col1 = (hs < 2 ? C_GQ + 128 + 64 * hs : C_GK + 64 * ((hs - 2) & 1)) + 8 * j;
    float g0[8], g1[8], inv[8];
    { const float* wg = C.win_gain() + layer * 128; const float* gg = C.glb_gain() + layer * 128;
      const float* s0p = hs < 4 ? wg : hs < 6 ? wg + 64 : gg; const float sc0 = (hs < 4 || hs >= 6) ? QSCALE : 1.f;
      const float* s1p = hs < 2 ? gg : gg + 64; const float sc1 = hs < 2 ? QSCALE : 1.f;
#pragma unroll
      for (int i = 0; i < 8; ++i) { g0[i] = s0p[8 * j + i] * sc0; g1[i] = s1p[8 * j + i] * sc1; inv[i] = __builtin_amdgcn_exp2f(-(float)(8 * (j & 1) + i) * (13.287712379549449f / 16.0f)); } }
    const bool x2 = (j & 2) != 0, colax = (j & 4) != 0, act1 = lane < 32;
    u32x4 w0 = {0u, 0u, 0u, 0u}, w1 = {0u, 0u, 0u, 0u};
    if (gw < MROWS) { const bf16_t* row = P + (size_t)gw * DIN; w0 = *(const u32x4*)(row + col0); if (act1) w1 = *(const u32x4*)(row + col1); }
    for (int m = gw; m < MROWS; m += NGW) {
        const u32x4 c0 = w0, c1 = w1;
        if (m + NGW < MROWS) { const bf16_t* row = P + (size_t)(m + NGW) * DIN; w0 = *(const u32x4*)(row + col0); if (act1) w1 = *(const u32x4*)(row + col1); }
        const int b = m / TPB, t = m - b * TPB; const bool isx = t >= CTX; const int pos = t - CTX;
        float cs[8], sn[8];
        if (isx) { const float pv = (float)(colax ? (pos & 63) : (pos >> 6));
#pragma unroll
            for (int i = 0; i < 8; ++i) { const float ang = pv * inv[i]; cs[i] = __cosf(ang); sn[i] = x2 ? __sinf(ang) : -__sinf(ang); } }
        else {
#pragma unroll
            for (int i = 0; i < 8; ++i) { cs[i] = 1.f; sn[i] = 0.f; } }
        bf16_t* orow = PO + (size_t)m * (PO == P ? DIN : 256);
#pragma unroll
        for (int pass = 0; pass < 2; ++pass) {
            const u32x4 w = pass ? c1 : c0;
            float x[8] = {bflo(w.x), bfhi(w.x), bflo(w.y), bfhi(w.y), bflo(w.z), bfhi(w.z), bflo(w.w), bfhi(w.w)};
            float ss = 0.f;
#pragma unroll
            for (int i = 0; i < 8; ++i) ss += x[i] * x[i];
            ss += xor1(ss); ss += xor2(ss); ss += swz_xor4(ss);
            const float r = rsq_f(ss * (1.f / 64.f) + EPS);
            float y[8];
#pragma unroll
            for (int i = 0; i < 8; ++i) { x[i] = x[i] * r * (pass ? g1[i] : g0[i]); }
#pragma unroll
            for (int i = 0; i < 8; ++i) { const float pr = xor2(x[i]); y[i] = x[i] * cs[i] + pr * sn[i]; }
            u32x4 o; o.x = pk2(y[0], y[1]); o.y = pk2(y[2], y[3]); o.z = pk2(y[4], y[5]); o.w = pk2(y[6], y[7]);
            const int col = pass ? col1 : col0;
            if (pass == 0 || act1) *(u32x4*)(orow + (PO == P ? col : (col & 127))) = o;
        }
    }
}

__device__ __forceinline__ unsigned off_v(unsigned row, unsigned ch) { return 256u * row + 16u * (ch ^ (((row & 3) << 2) | ((row >> 2) & 3))); }
__device__ __forceinline__ unsigned off_k(unsigned row, unsigned ch) { return 128u * row + 16u * (ch ^ (row & 7)); }
typedef short s16x4_t __attribute__((ext_vector_type(4)));
__device__ __forceinline__ s16x4_t tr_rd(const LAS unsigned char* p) { return __builtin_bit_cast(s16x4_t, __builtin_amdgcn_ds_read_tr16_b64_v4i16((LAS s16x4_t*)p)); }
template <bool KIMG> __device__ __forceinline__ bf16x8 tr_frag(const LAS unsigned char* img, int lane, int rbase, int r0off, int r1off, int cblk) {
    const unsigned blk = (lane >> 4) & 1, q = (lane & 15) >> 2, pp = lane & 3, ch = 4 * cblk + 2 * blk + (pp >> 1);
    const unsigned ra = rbase + r0off + q, rb = rbase + r1off + q;
    const s16x4_t lo = tr_rd(img + (KIMG ? off_k(ra, ch) : off_v(ra, ch)) + 8 * (pp & 1)), hi = tr_rd(img + (KIMG ? off_k(rb, ch) : off_v(rb, ch)) + 8 * (pp & 1));
    return (bf16x8){lo[0], lo[1], lo[2], lo[3], hi[0], hi[1], hi[2], hi[3]};
}
__device__ __forceinline__ void stage_v(const bf16_t* P, size_t r0, int h, LAS unsigned char* img, int tid) {
#pragma unroll
    for (int i = 0; i < 4; ++i) { const int p_ = tid + 512 * i, j = p_ >> 4, ch = p_ & 15;
        *(LAS u32x4*)(img + off_v(j, ch)) = *(const u32x4*)(P + (r0 + j) * DIN + C_RV + h * 128 + 8 * ch); }
}
__device__ __forceinline__ void ret_r1_all(const Ctx& C, int layer, int bx, int G, LAS unsigned char* lds, int tid) {
    int lane = tid & 63; asm volatile("" : "+v"(lane));
    const int wid = tid >> 6;
    const bf16_t* P = (const bf16_t*)(C.ws + WS_P); float* KVT = (float*)(C.ws + WS_H);
    LAS unsigned char* Vi = lds; LAS unsigned char* Kf = lds + 32768; LAS unsigned char* Kb = lds + 49152;
    const float* dec = C.ret_decay() + layer * 8;
    const int NU = NB * 4 * NCH;
    int u = bx; if (u >= NU) return;
    u32x4 kreg[2], vreg[4];
#define R1_LOAD(u_) do { const int c_ = (u_) % NCH, bh_ = (u_) / NCH, h_ = bh_ & 3; const size_t r0_ = (size_t)(bh_ >> 2) * TPB + c_ * 128; \
        _Pragma("unroll") for (int i = 0; i < 2; ++i) { const int p_ = tid + 512 * i, j = p_ >> 3, ch = p_ & 7; kreg[i] = *(const u32x4*)(P + (r0_ + j) * DIN + C_RK + h_ * 64 + 8 * ch); } \
        _Pragma("unroll") for (int i = 0; i < 4; ++i) { const int p_ = tid + 512 * i, j = p_ >> 4, ch = p_ & 15; vreg[i] = *(const u32x4*)(P + (r0_ + j) * DIN + C_RV + h_ * 128 + 8 * ch); } } while (0)
    R1_LOAD(u);
    for (;;) {
        const int c = u % NCH, bh = u / NCH, b = bh >> 2, h = bh & 3;
        const float lf = log2_sigmoid(dec[h]), lb = log2_sigmoid(dec[4 + h]);
#pragma unroll
        for (int i = 0; i < 2; ++i) { const int p_ = tid + 512 * i, j = p_ >> 3, ch = p_ & 7; const u32x4 w = kreg[i];
            const float zf = __builtin_amdgcn_exp2f((float)(127 - j) * lf) * 0.125f, zb = __builtin_amdgcn_exp2f((float)j * lb) * 0.125f;
            const float x[8] = {bflo(w.x), bfhi(w.x), bflo(w.y), bfhi(w.y), bflo(w.z), bfhi(w.z), bflo(w.w), bfhi(w.w)};
            u32x4 of, ob; of.x = pk2(x[0] * zf, x[1] * zf); of.y = pk2(x[2] * zf, x[3] * zf); of.z = pk2(x[4] * zf, x[5] * zf); of.w = pk2(x[6] * zf, x[7] * zf);
            ob.x = pk2(x[0] * zb, x[1] * zb); ob.y = pk2(x[2] * zb, x[3] * zb); ob.z = pk2(x[4] * zb, x[5] * zb); ob.w = pk2(x[6] * zb, x[7] * zb);
            *(LAS u32x4*)(Kf + off_k(j, ch)) = of; *(LAS u32x4*)(Kb + off_k(j, ch)) = ob; }
#pragma unroll
        for (int i = 0; i < 4; ++i) { const int p_ = tid + 512 * i, j = p_ >> 4, ch = p_ & 15; *(LAS u32x4*)(Vi + off_v(j, ch)) = vreg[i]; }
        const int un = u + G;
        if (un < NU) R1_LOAD(un);
        __syncthreads();
        const int mb = wid >> 1, nb = wid & 1, r = lane & 31, hh = lane >> 5;
        float z0 = 0.f; asm volatile("" : "+v"(z0)); f32x16 af, ab;
#pragma unroll
        for (int i = 0; i < 16; ++i) { af[i] = z0; ab[i] = z0; }
#pragma unroll
        for (int ks = 0; ks < 8; ++ks) {
            const bf16x8 a = tr_frag<false>(Vi, lane, 16 * ks + 8 * hh, 0, 4, mb);
            const bf16x8 bf = tr_frag<true>(Kf, lane, 16 * ks + 8 * hh, 0, 4, nb);
            const bf16x8 bb = tr_frag<true>(Kb, lane, 16 * ks + 8 * hh, 0, 4, nb);
            af = __builtin_amdgcn_mfma_f32_32x32x16_bf16(a, bf, af, 0, 0, 0);
            ab = __builtin_amdgcn_mfma_f32_32x32x16_bf16(a, bb, ab, 0, 0, 0);
        }
        float* of = KVT + ((size_t)((0 * NB + b) * 4 + h) * NCH + c) * 8192; float* ob = KVT + ((size_t)((1 * NB + b) * 4 + h) * NCH + c) * 8192;
#pragma unroll
        for (int reg = 0; reg < 16; ++reg) { const int dv = 32 * mb + (reg & 3) + 8 * (reg >> 2) + 4 * hh, dk = 32 * nb + r; of[dv * 64 + dk] = af[reg]; ob[dv * 64 + dk] = ab[reg]; }
        __syncthreads();
        if (un >= NU) break;
        u = un;
    }
#undef R1_LOAD
}
__device__ __forceinline__ void ret_r2_unit(const Ctx& C, int layer, int u, int tid) {
    const int q = u & 3, bh = (u >> 2) & 63, dir = u >> 8, b = bh >> 2, h = bh & 3;
    const float G = __builtin_amdgcn_exp2f(128.f * log2_sigmoid(C.ret_decay()[(layer * 2 + dir) * 4 + h]));
    const size_t base = ((size_t)((dir * NB + b) * 4 + h) * NCH) * 8192 + q * 2048 + tid * 4;
    const float* KVT = (const float*)(C.ws + WS_H) + base; bf16_t* ST = (bf16_t*)(C.ws + WS_YP) + base;
    float z0 = 0.f; asm volatile("" : "+v"(z0)); f32x4 S = {z0, z0, z0, z0};
#pragma unroll
    for (int half = 0; half < 2; ++half) {
        f32x4 kv[17];
#pragma unroll
        for (int s = 0; s < 17; ++s) { const int step = half * 17 + s; const int c = dir == 0 ? step : (step < 2 ? 1 - step : 35 - step); kv[s] = *(const f32x4*)(KVT + (size_t)c * 8192); }
#pragma unroll
        for (int s = 0; s < 17; ++s) { const int step = half * 17 + s; const int c = dir == 0 ? step : (step < 2 ? 1 - step : 35 - step);
            u32x2 w; w.x = pk2(S[0], S[1]); w.y = pk2(S[2], S[3]); *(u32x2*)(ST + (size_t)c * 8192) = w;
            S = S * G + kv[s]; }
    }
}
__device__ __forceinline__ void ret_r3_all(const Ctx& C, int layer, int bx, int G, LAS unsigned char* lds, int tid) {
    int lane = tid & 63; asm volatile("" : "+v"(lane));
    const int wid = tid >> 6, r = lane & 31, hh = lane >> 5, ib = wid & 3, dh = wid >> 2;
    const bf16_t* P = (const bf16_t*)(C.ws + WS_P);
    LAS unsigned char* Vi = lds;
    LAS float* Ol = (LAS float*)(lds + 32768);
    const float* dec = C.ret_decay() + layer * 8;
    const int NU = NB * 4 * NCH; const bool skipc = layer == DEPTH - 1;
#define R3_NEXT(u_) do { (u_) += G; while ((u_) < NU && skipc && ((u_) % NCH) < 2) (u_) += G; } while (0)
#define R3_ZERO(v) do { float z_ = 0.f; asm volatile("" : "+v"(z_)); _Pragma("unroll") for (int i_ = 0; i_ < 16; ++i_) v[i_] = z_; } while (0)
    int u = bx - G; R3_NEXT(u); if (u >= NU) return;
    u32x4 vreg[4]; bf16x8 qf[4], kf[2][4];
#define R3_LOAD_A(u_) do { const int c_ = (u_) % NCH, bh_ = (u_) / NCH, h_ = bh_ & 3; const size_t r0_ = (size_t)(bh_ >> 2) * TPB + c_ * 128; \
        _Pragma("unroll") for (int i = 0; i < 4; ++i) { const int p_ = tid + 512 * i, j = p_ >> 4, ch = p_ & 15; vreg[i] = *(const u32x4*)(P + (r0_ + j) * DIN + C_RV + h_ * 128 + 8 * ch); } \
        { const bf16_t* Qp = P + (r0_ + 32 * ib + r) * DIN + C_RQ + h_ * 64 + 8 * hh; _Pragma("unroll") for (int ks = 0; ks < 4; ++ks) qf[ks] = *(const bf16x8*)(Qp + 16 * ks); } \
        _Pragma("unroll") for (int jb = 0; jb < 2; ++jb) { const bf16_t* Kp = P + (r0_ + 32 * jb + r) * DIN + C_RK + h_ * 64 + 8 * hh; \
            _Pragma("unroll") for (int ks = 0; ks < 4; ++ks) kf[jb][ks] = *(const bf16x8*)(Kp + 16 * ks); } } while (0)
    R3_LOAD_A(u);
    unsigned lp[2][2];
    { const unsigned blk = (lane >> 4) & 1, q = (lane & 15) >> 2, pp = lane & 3;
#pragma unroll
      for (int t = 0; t < 2; ++t)
#pragma unroll
          for (int cb = 0; cb < 2; ++cb) lp[t][cb] = off_v(4 * hh + 8 * t + q, 4 * (2 * dh + cb) + 2 * blk + (pp >> 1)) + 8 * (pp & 1); }
    for (;;) {
        const int c = u % NCH, bh = u / NCH, b = bh >> 2, h = bh & 3;
        const float lf = log2_sigmoid(dec[h]), lb = log2_sigmoid(dec[4 + h]);
        const size_t r0 = (size_t)b * TPB + c * 128;
        int rq = r, hq = hh; asm volatile("" : "+v"(rq), "+v"(hq));
#pragma unroll
        for (int i = 0; i < 4; ++i) { const int p_ = tid + 512 * i, j = p_ >> 4, ch = p_ & 15; *(LAS u32x4*)(Vi + off_v(j, ch)) = vreg[i]; }
        bf16x8 st[2][4]; u32x4 gwv[4];
        { const bf16_t* sf = (const bf16_t*)(C.ws + WS_YP) + ((size_t)((0 * NB + b) * 4 + h) * NCH + c) * 8192 + (64 * dh + r) * 64 + 8 * hh;
#pragma unroll
          for (int t = 0; t < 2; ++t)
#pragma unroll
              for (int ks = 0; ks < 4; ++ks) st[t][ks] = *(const bf16x8*)(sf + t * 32 * 64 + 16 * ks); }
        __syncthreads();
        f32x16 o[2]; R3_ZERO(o[0]); R3_ZERO(o[1]);
#pragma unroll
        for (int jb = 0; jb < 4; ++jb) {
            if (jb == 1 || jb == 3) {
                const int dir = jb >> 1; f32x16 acc[2];
#pragma unroll
                for (int t = 0; t < 2; ++t) { R3_ZERO(acc[t]);
#pragma unroll
                    for (int ks = 0; ks < 4; ++ks) acc[t] = __builtin_amdgcn_mfma_f32_32x32x16_bf16(qf[ks], st[t][ks], acc[t], 0, 0, 0); }
#pragma unroll
                for (int reg = 0; reg < 16; ++reg) { const int i = 32 * ib + (reg & 3) + 8 * (reg >> 2) + 4 * hq; const float xi = dir == 0 ? __builtin_amdgcn_exp2f((float)(i + 1) * lf) : __builtin_amdgcn_exp2f((float)(128 - i) * lb);
                    o[0][reg] += xi * acc[0][reg]; o[1][reg] += xi * acc[1][reg]; }
                CBAR();
                if (jb == 1) { const bf16_t* sb = (const bf16_t*)(C.ws + WS_YP) + ((size_t)((1 * NB + b) * 4 + h) * NCH + c) * 8192 + (64 * dh + r) * 64 + 8 * hh;
#pragma unroll
                    for (int t = 0; t < 2; ++t)
#pragma unroll
                        for (int ks = 0; ks < 4; ++ks) st[t][ks] = *(const bf16x8*)(sb + t * 32 * 64 + 16 * ks); } }
            f32x16 x; R3_ZERO(x);
#pragma unroll
            for (int ks = 0; ks < 4; ++ks) x = __builtin_amdgcn_mfma_f32_32x32x16_bf16(kf[jb & 1][ks], qf[ks], x, 0, 0, 0);
            if (jb < 2) { const bf16_t* Kp = P + (r0 + 32 * (jb + 2) + r) * DIN + C_RK + h * 64 + 8 * hh;
#pragma unroll
                for (int ks = 0; ks < 4; ++ks) kf[jb & 1][ks] = *(const bf16x8*)(Kp + 16 * ks); }
#pragma unroll
            for (int reg = 0; reg < 16; ++reg) { const int d = (32 * ib + rq) - (32 * jb + (reg & 3) + 8 * (reg >> 2) + 4 * hq);
                const float D = d > 0 ? __builtin_amdgcn_exp2f((float)d * lf) : (d < 0 ? __builtin_amdgcn_exp2f((float)(-d) * lb) : 2.0f); x[reg] *= 0.125f * D; }
#pragma unroll
            for (int s = 0; s < 2; ++s) {
                u32x4 pw; pw.x = pk2(x[8 * s + 0], x[8 * s + 1]); pw.y = pk2(x[8 * s + 2], x[8 * s + 3]); pw.z = pk2(x[8 * s + 4], x[8 * s + 5]); pw.w = pk2(x[8 * s + 6], x[8 * s + 7]);
                const bf16x8 pa = __builtin_bit_cast(bf16x8, pw);
#pragma unroll
                for (int cb = 0; cb < 2; ++cb) { const s16x4_t lo = tr_rd(Vi + lp[0][cb] + (8192 * jb + 4096 * s)), hi = tr_rd(Vi + lp[1][cb] + (8192 * jb + 4096 * s));
                    const bf16x8 vb = (bf16x8){lo[0], lo[1], lo[2], lo[3], hi[0], hi[1], hi[2], hi[3]};
                    o[cb] = __builtin_amdgcn_mfma_f32_32x32x16_bf16(pa, vb, o[cb], 0, 0, 0); }
            }
            CBAR();
        }
        { const bf16_t* gp = P + (r0 + (tid >> 2)) * DIN + C_RG + h * 128 + 32 * (tid & 3);
#pragma unroll
          for (int e2 = 0; e2 < 4; ++e2) gwv[e2] = *(const u32x4*)(gp + 8 * e2); }
#pragma unroll
        for (int cb = 0; cb < 2; ++cb)
#pragma unroll
            for (int reg = 0; reg < 16; ++reg) { const int i = 32 * ib + (reg & 3) + 8 * (reg >> 2) + 4 * hh, dv = 64 * dh + 32 * cb + r; Ol[i * 132 + dv] = o[cb][reg]; }
        __syncthreads();
        int un = u; R3_NEXT(un);
        if (un < NU) R3_LOAD_A(un);
        CBAR();
        { const int row = tid >> 2, q = tid & 3; f32x4 x[8]; float sm = 0.f;
#pragma unroll
          for (int e = 0; e < 8; ++e) { x[e] = *(const LAS f32x4*)(Ol + row * 132 + 32 * q + 4 * e); sm += (x[e][0] + x[e][1]) + (x[e][2] + x[e][3]); }
          sm += xor1(sm); sm += xor2(sm);
          const float mu = sm * (1.f / 128.f); float vs = 0.f;
#pragma unroll
          for (int e = 0; e < 8; ++e) { x[e] = x[e] - mu; vs += (x[e][0] * x[e][0] + x[e][1] * x[e][1]) + (x[e][2] * x[e][2] + x[e][3] * x[e][3]); }
          vs += xor1(vs); vs += xor2(vs);
          const float rstd = rsq_f(vs * (1.f / 128.f) + EPS);
          bf16_t* yp = (bf16_t*)(C.ws + WS_Y) + (r0 + row) * DM + h * 128 + 32 * q;
#pragma unroll
          for (int e2 = 0; e2 < 4; ++e2) { const u32x4 gw = gwv[e2]; const f32x4 a = x[2 * e2] * rstd, bq = x[2 * e2 + 1] * rstd;
              u32x4 ow; ow.x = pk2(a[0] * silu_f(bflo(gw.x)), a[1] * silu_f(bfhi(gw.x))); ow.y = pk2(a[2] * silu_f(bflo(gw.y)), a[3] * silu_f(bfhi(gw.y)));
              ow.z = pk2(bq[0] * silu_f(bflo(gw.z)), bq[1] * silu_f(bfhi(gw.z))); ow.w = pk2(bq[2] * silu_f(bflo(gw.w)), bq[3] * silu_f(bfhi(gw.w)));
              *(u32x4*)(yp + 8 * e2) = ow; } }
        if (un >= NU) break;
        u = un;
    }
#undef R3_NEXT
#undef R3_ZERO
#undef R3_LOAD_A
}

template <bool WIN>
__device__ __forceinline__ void attn_dispatch(const Ctx& C, int layer, int U, int tid, char* lds) {
    using attn_body::bf16;
    int b, h, q0, NT, tdelta;
    if (U < 1024) { b = U >> 6; h = ((U >> 5) & 1) * 2 + ((U >> 4) & 1); q0 = CTX + 256 * (U & 15);
        if (WIN) { const int ts = (q0 / 64 - 2) > 4 ? (q0 / 64 - 2) : 4, te = (q0 / 64 + 6) < 68 ? (q0 / 64 + 6) : 68; NT = 4 + te - ts; tdelta = ts - 4; } else { NT = 68; tdelta = 0; } }
    else { b = (U - 1024) >> 2; h = (U - 1024) & 3; q0 = 0; NT = 4; tdelta = 0; }
    const int kvh = h >> 1;
    const bf16* Pb = (const bf16*)(C.ws + WS_P) + (size_t)b * TPB * DIN; bf16* Yb = (bf16*)(C.ws + WS_Y) + (size_t)b * TPB * DM;
    if (WIN) attn_body::attn_unit<8, true>(Pb + C_WQ + 64 * h, Pb + C_WK + 64 * kvh, Pb + C_WV + 64 * kvh, Yb + 512 + 64 * h, q0, NT, tdelta, C.win_sink()[layer * 4 + h] * LOG2E, tid, lds);
    else     attn_body::attn_unit<8, false>(Pb + C_GQ + 64 * h, Pb + C_GK + 64 * kvh, Pb + C_GV + 64 * kvh, Yb + 768 + 64 * h, q0, NT, tdelta, 0.f, tid, lds);
}
template <bool WIN>
__device__ __forceinline__ void attn_units(const Ctx& C, int layer, int G, int vcu, int bx, int tid, char* lds) {
    const int nctx = (layer == DEPTH - 1) ? 0 : 64;
    if (G == 256) {
        for (int k = 0; k < 4; ++k) attn_dispatch<WIN>(C, layer, vcu * 4 + k, tid, lds);
        if (vcu < nctx) attn_dispatch<WIN>(C, layer, 1024 + vcu, tid, lds);
    } else {
        for (int U = bx; U < 1024 + nctx; U += G) attn_dispatch<WIN>(C, layer, U, tid, lds);
    }
}

__device__ __forceinline__ f32x2 swap32(float a, float b) { auto r = __builtin_amdgcn_permlane32_swap(__builtin_bit_cast(unsigned, a), __builtin_bit_cast(unsigned, b), false, false);
    return (f32x2){__builtin_bit_cast(float, (unsigned)r[0]), __builtin_bit_cast(float, (unsigned)r[1])}; }
__device__ __forceinline__ f32x2 swap16(float a, float b) { auto r = __builtin_amdgcn_permlane16_swap(__builtin_bit_cast(unsigned, a), __builtin_bit_cast(unsigned, b), false, false);
    return (f32x2){__builtin_bit_cast(float, (unsigned)r[0]), __builtin_bit_cast(float, (unsigned)r[1])}; }
__device__ __forceinline__ void phase_norm2_route(const Ctx& C, int layer_c, LAS unsigned char* lds, int G, int bx, int tid, bool skipdot  ) {
    const int layer = layer_c & 3;
    const int lane = tid & 63, wave = tid >> 6;
    const float* mod = (const float*)(C.ws + WS_MOD) + (size_t)layer * 17 * 6144;
    const float* gain = C.norm2() + layer * DM;
    const bf16_t* XR = (const bf16_t*)(C.ws + WS_X32); unsigned char* H = (unsigned char*)(C.ws + WS_H);
    float* LSC = (float*)(C.ws + WS_GW);
    int* list = (int*)(C.ws + WS_LIST);
    unsigned* gcnt = (unsigned*)(C.ws + WS_CTL) + CW_CNT + 64 * layer_c;
    constexpr int RPC = MROWS / 256, RPW = RPC / 8;
    LAS float* wrT = (LAS float*)lds;
    LAS float* lgs = (LAS float*)(lds + 65536);
    LAS int* lcnt = (LAS int*)(lds + 65536 + RPC * 64);
    LAS int* lbase = lcnt + 16;
    LAS int* rec_e = lcnt + 32;
    LAS float* rec_w = (LAS float*)(rec_e + 2 * RPC);
    LAS float* row_s = rec_w + 2 * RPC;
    { const float* wr = C.w_router(); for (int i = tid; i < DM * NE; i += 512) { const int k = i >> 4, e = i & 15; wrT[e * DM + k] = wr[i]; } }
    if (tid < 16) lcnt[tid] = 0;
    __syncthreads();
    const unsigned lo4 = (unsigned)lane * 4u, lo8 = (unsigned)lane * 8u, lo16 = (unsigned)lane * 16u;
#define E_LOADROW(dst, mm) do { const char* xr_ = (const char*)(XR + (size_t)(mm) * DM); _Pragma("unroll") for (int j = 0; j < 4; ++j) dst[j] = *(const u32x2*)(xr_ + (lo8 + 512u * j)); } while (0)
#define E_NORMROW(v, nxr, mm) do { float ss_ = 0.f; _Pragma("unroll") for (int j = 0; j < 4; ++j) { v[j] = bf4(nxr[j]); ss_ += (v[j][0] * v[j][0] + v[j][1] * v[j][1]) + (v[j][2] * v[j][2] + v[j][3] * v[j][3]); } \
        const int b_ = (mm) / TPB, t_ = (mm) - b_ * TPB, set_ = t_ < CTX ? 16 : b_; const float rstd_ = rsq_f(wave_sum(ss_) * (1.f / DM) + EPS); \
        const char* gp_ = (const char*)gain; const char* shp_ = (const char*)(mod + (size_t)set_ * 6144 + 3 * DM); const char* scp_ = shp_ + DM * 4; \
        char* ho_ = (char*)(H + (size_t)(mm) * DM); \
        float mx_ = 0.f; \
        _Pragma("unroll") for (int j = 0; j < 4; ++j) { v[j] = (v[j] * rstd_) * *(const f32x4*)(gp_ + (lo16 + 1024u * j)) * (*(const f32x4*)(scp_ + (lo16 + 1024u * j)) + 1.0f) + *(const f32x4*)(shp_ + (lo16 + 1024u * j)); \
            mx_ = __builtin_fmaxf(mx_, __builtin_fmaxf(__builtin_fmaxf(__builtin_fabsf(v[j][0]), __builtin_fabsf(v[j][1])), __builtin_fmaxf(__builtin_fabsf(v[j][2]), __builtin_fabsf(v[j][3])))); } \
        mx_ = __builtin_fmaxf(wave_max(mx_), 1e-20f); const float inv_ = 127.0f / mx_; if (lane == 0) row_s[(mm) - chunk * RPC] = mx_ * (1.0f / 127.0f); \
        _Pragma("unroll") for (int j = 0; j < 4; ++j) *(unsigned*)(ho_ + (lo4 + 256u * j)) = pk4_i8(v[j][0] * inv_, v[j][1] * inv_, v[j][2] * inv_, v[j][3] * inv_); } while (0)
#define E_REDUCE(pe, rowl) do { float q8_[8], q4_[4], q2_[2]; \
        _Pragma("unroll") for (int e = 0; e < 8; ++e) { const f32x2 r_ = swap32(pe[e], pe[e + 8]); q8_[e] = r_[0] + r_[1]; } \
        _Pragma("unroll") for (int e = 0; e < 4; ++e) { const f32x2 r_ = swap16(q8_[e], q8_[e + 4]); q4_[e] = r_[0] + r_[1]; } \
        _Pragma("unroll") for (int e = 0; e < 2; ++e) { const float keep_ = b3 ? q4_[e + 2] : q4_[e], send_ = b3 ? q4_[e] : q4_[e + 2]; q2_[e] = keep_ + swz_xor8(send_); } \
        float lg_ = (b2 ? q2_[1] : q2_[0]) + swz_xor4(b2 ? q2_[0] : q2_[1]); lg_ += xor2(lg_); lg_ += xor1(lg_); \
        if ((lane & 3) == 0) lgs[(rowl) * 16 + (lane >> 2)] = lg_; } while (0)
    const bool b3 = (lane & 8) != 0, b2 = (lane & 4) != 0;
    for (int chunk = bx; chunk < 256; chunk += G) {
        const int m0 = chunk * RPC + wave;
        u32x2 nxA[4], nxB[4], fxA[4], fxB[4], gxA[4], gxB[4];
        E_LOADROW(nxA, m0); E_LOADROW(nxB, m0 + 8); E_LOADROW(fxA, m0 + 16); E_LOADROW(fxB, m0 + 24); E_LOADROW(gxA, m0 + 32); E_LOADROW(gxB, m0 + 40);
        for (int i = 0; i < RPW; i += 2) {
            f32x4 vA[4], vB[4];
            E_NORMROW(vA, nxA, m0 + 8 * i);
            E_NORMROW(vB, nxB, m0 + 8 * (i + 1));
#pragma unroll
            for (int j = 0; j < 4; ++j) { nxA[j] = fxA[j]; nxB[j] = fxB[j]; fxA[j] = gxA[j]; fxB[j] = gxB[j]; }
            if (i + 6 < RPW) { E_LOADROW(gxA, m0 + 8 * (i + 6)); E_LOADROW(gxB, m0 + 8 * (i + 7)); }
            float peA[16], peB[16];
            f32x2 hv[4][4];
#pragma unroll
            for (int j = 0; j < 4; ++j)
#pragma unroll
                for (int c = 0; c < 4; ++c) hv[j][c] = (f32x2){vA[j][c], vB[j][c]};
            const LAS float* wl = wrT + 4 * lane; asm volatile("" : "+v"(wl));
#pragma unroll
            for (int e = 0; e < 16; ++e) { f32x2 a2 = {0.f, 0.f};
#pragma unroll
                for (int j = 0; j < 4; ++j) { if (skipdot) break; const f32x4 w = *(const LAS f32x4*)(wl + e * DM + 256 * j);
#pragma unroll
                    for (int c = 0; c < 4; ++c) a2 = __builtin_elementwise_fma(hv[j][c], (f32x2){w[c], w[c]}, a2); }
                peA[e] = a2[0]; peB[e] = a2[1]; }
            E_REDUCE(peA, 8 * i + wave); E_REDUCE(peB, 8 * (i + 1) + wave);
        }
#undef E_LOADROW
#undef E_NORMROW
#undef E_REDUCE
        asm volatile("s_waitcnt lgkmcnt(0)" ::: "memory");
        const int mrow_ = chunk * RPC + 8 * lane + wave;
        if (lane < RPW && !(layer == DEPTH - 1 && (mrow_ % TPB) < CTX)) {
            const int rl = 8 * lane + wave; const float* br = C.b_router();
            float sg[16], bs[16];
#pragma unroll
            for (int e4 = 0; e4 < 4; ++e4) { const f32x4 l4 = *(const LAS f32x4*)(lgs + rl * 16 + 4 * e4);
#pragma unroll
                for (int k = 0; k < 4; ++k) { sg[4 * e4 + k] = __builtin_amdgcn_rcpf(1.f + __builtin_amdgcn_exp2f(-LOG2E * l4[k])); bs[4 * e4 + k] = sg[4 * e4 + k] + br[4 * e4 + k]; } }
            int grp = 0; float best = -1e30f;
#pragma unroll
            for (int g = 0; g < 4; ++g) { const float a0 = bs[4 * g], a1 = bs[4 * g + 1], a2 = bs[4 * g + 2], a3 = bs[4 * g + 3];
                const float hi01 = fmaxf(a0, a1), lo01 = fminf(a0, a1), hi23 = fmaxf(a2, a3), lo23 = fminf(a2, a3);
                const float top = fmaxf(hi01, hi23), second = fmaxf(fminf(hi01, hi23), hi01 >= hi23 ? lo01 : lo23);
                const float sc = top + second; if (sc > best) { best = sc; grp = g; } }
            float c4[4], s4[4];
#pragma unroll
            for (int k = 0; k < 4; ++k) { c4[k] = grp == 0 ? bs[k] : grp == 1 ? bs[4 + k] : grp == 2 ? bs[8 + k] : bs[12 + k]; s4[k] = grp == 0 ? sg[k] : grp == 1 ? sg[4 + k] : grp == 2 ? sg[8 + k] : sg[12 + k]; }
            int l0 = 0; float mx0 = c4[0];
#pragma unroll
            for (int k = 1; k < 4; ++k) if (c4[k] > mx0) { mx0 = c4[k]; l0 = k; }
            int l1 = -1; float mx1 = -1e30f;
#pragma unroll
            for (int k = 0; k < 4; ++k) if (k != l0 && c4[k] > mx1) { mx1 = c4[k]; l1 = k; }
            const float w0 = l0 == 0 ? s4[0] : l0 == 1 ? s4[1] : l0 == 2 ? s4[2] : s4[3], w1 = l1 == 0 ? s4[0] : l1 == 1 ? s4[1] : l1 == 2 ? s4[2] : s4[3];
            const float wn = 1.f / (w0 + w1);
            const int e0 = grp * 4 + l0, e1 = grp * 4 + l1;
            const int p0 = __hip_atomic_fetch_add(lcnt + e0, 1, __ATOMIC_RELAXED, __HIP_MEMORY_SCOPE_WORKGROUP);
            const int p1 = __hip_atomic_fetch_add(lcnt + e1, 1, __ATOMIC_RELAXED, __HIP_MEMORY_SCOPE_WORKGROUP);
            rec_e[2 * rl] = e0 | (p0 << 8); rec_e[2 * rl + 1] = e1 | (p1 << 8); rec_w[2 * rl] = w0 * wn; rec_w[2 * rl + 1] = w1 * wn;
        } else if (lane < RPW) { const int rl = 8 * lane + wave; rec_e[2 * rl] = -1; rec_e[2 * rl + 1] = -1; }
        __syncthreads();
        if (tid < 16) lbase[tid] = (int)__hip_atomic_fetch_add(gcnt + tid, (unsigned)lcnt[tid], __ATOMIC_RELAXED, __HIP_MEMORY_SCOPE_AGENT);
        __syncthreads();
        for (int i = tid; i < 2 * RPC; i += 512) { const int re = rec_e[i]; if (re < 0) continue; const int e = re & 255, pp = re >> 8; const int id = (chunk * RPC + (i >> 1)) * 2 + (i & 1);
            list[e * MROWS + lbase[e] + pp] = id | ((int)(rec_w[i] * 16383.f + 0.5f) << 18); LSC[e * MROWS + lbase[e] + pp] = row_s[i >> 1]; }
        __syncthreads();
        if (tid < 16) lcnt[tid] = 0;
        __syncthreads();
    }
}

template <bool GATHER_, int NT>
struct MoeOrder {
    static constexpr bool GATHER = GATHER_;
    const int* list; const LAS int* boff; const LAS int* cnt; int G, c;
    __device__ __forceinline__ bool next(int i, pg8::Unit& u) const {
        const int L = i * G + c; if (L >= boff[16] * NT) return false;
        const int blk = L / NT, pn = L - blk * NT; int e = 0;
#pragma unroll
        for (int k = 1; k < 16; ++k) e += (blk >= boff[k]) ? 1 : 0;
        u.pm = blk; u.pn = e * NT + pn; return true;
    }
    __device__ __forceinline__ unsigned arow(const pg8::Unit& u, int r) const {
        const int e = u.pn / NT, li = (u.pm - boff[e]) * 256 + r;
        const int id = li < cnt[e] ? (list[e * MROWS + li] & 0x3FFFF) : 0;
        return (unsigned)(id >> 1);
    }
    __device__ __forceinline__ const int* aptr(const pg8::Unit& u, int r) const { const int e = u.pn / NT, li = (u.pm - boff[e]) * 256 + r; return list + e * MROWS + (li < cnt[e] ? li : 0); }
    __device__ __forceinline__ unsigned tokrow(unsigned w) const { return (w & 0x3FFFFu) >> 1; }
};
struct EpiGateUp {
    static constexpr bool PERM = true, HAS_PRE = false;
    unsigned char* O;
    const float* lsc; const float* wsc; const LAS int* boff;
    __device__ __forceinline__ void operator()(const f32x4 (&acc)[2][2][4][2], const pg8::Unit& u, int wr, int wc, int fr, int fq) const {
        const int row0 = u.pm * 256 + wr * 64 + fr, col0 = (u.pn & 7) * 128 + wc * 32 + 8 * fq;
        const int e = u.pn >> 3, lb = (u.pm - boff[e]) * 256; const float w = wsc[1 + e];
        float sc[2][4];
#pragma unroll
        for (int ai = 0; ai < 2; ++ai)
#pragma unroll
            for (int m = 0; m < 4; ++m) sc[ai][m] = lsc[e * MROWS + lb + ai * 128 + wr * 64 + m * 16 + fr];
#pragma unroll
        for (int ai = 0; ai < 2; ++ai)
#pragma unroll
            for (int m = 0; m < 4; ++m) { const float s = sc[ai][m] * w;
                const f32x4 a0 = pg8::i2f4(acc[ai][0][m][0]) * s, a1 = pg8::i2f4(acc[ai][0][m][1]) * s, u0 = pg8::i2f4(acc[ai][1][m][0]) * s, u1 = pg8::i2f4(acc[ai][1][m][1]) * s;
                u32x2 ww; ww.x = pk4_fp8(silu_f(a0[0]) * u0[0], silu_f(a0[1]) * u0[1], silu_f(a0[2]) * u0[2], silu_f(a0[3]) * u0[3]);
                ww.y = pk4_fp8(silu_f(a1[0]) * u1[0], silu_f(a1[1]) * u1[1], silu_f(a1[2]) * u1[2], silu_f(a1[3]) * u1[3]);
                *(u32x2*)(O + ((unsigned)(row0 + ai * 128 + m * 16) * (unsigned)FF + (unsigned)col0)) = ww; }
    }
};
struct EpiDown {
    static constexpr bool PERM = true, HAS_PRE = true;
    unsigned char* YP; const int* list; const LAS int* boff; const LAS int* cnt;
    int ent[2][4];
    __device__ __forceinline__ void pre(const pg8::Unit& u, int wr, int fr) {
        const int e = u.pn >> 2, lb = (u.pm - boff[e]) * 256, n = cnt[e];
#pragma unroll
        for (int ai = 0; ai < 2; ++ai)
#pragma unroll
            for (int m = 0; m < 4; ++m) { const int li = lb + ai * 128 + wr * 64 + m * 16 + fr; const bool ok = li < n; const int w = list[e * MROWS + (ok ? li : 0)]; ent[ai][m] = ok ? w : -1; }
    }
    __device__ __forceinline__ void operator()(const f32x4 (&acc)[2][2][4][2], const pg8::Unit& u, int wr, int wc, int fr, int fq) const {
        const int col0 = (u.pn & 3) * 256 + wc * 32 + 8 * fq;
#pragma unroll
        for (int ai = 0; ai < 2; ++ai)
#pragma unroll
            for (int m = 0; m < 4; ++m) { const int w = ent[ai][m];
                if (w != -1) { const unsigned id = (unsigned)w & 0x3FFFFu; const float g = (float)((unsigned)w >> 18) * ((1.f / 16383.f) * W8_INV * YP_SCALE); const unsigned off = id * (unsigned)DM + (unsigned)col0;
#pragma unroll
                    for (int bj = 0; bj < 2; ++bj) { const f32x4 v0 = acc[ai][bj][m][0] * g, v1 = acc[ai][bj][m][1] * g;
                        u32x2 ww; ww.x = pk4_fp8(v0[0], v0[1], v0[2], v0[3]); ww.y = pk4_fp8(v1[0], v1[1], v1[2], v1[3]); *(u32x2*)(YP + off + bj * 128) = ww; } } }
    }
};
__device__ __forceinline__ void moe_offsets(const Ctx& C, int layer, LAS int* boff, LAS int* cnt, int tid) {
    if (tid < 16) cnt[tid] = (int)__hip_atomic_load((const unsigned*)(C.ws + WS_CTL) + CW_CNT + 64 * layer + tid, __ATOMIC_RELAXED, __HIP_MEMORY_SCOPE_AGENT);
    __syncthreads();
    if (tid == 0) { int acc = 0;
        for (int e = 0; e < 16; ++e) { boff[e] = acc; acc += (cnt[e] + 255) >> 8; }
        boff[16] = acc; }
    __syncthreads();
}

__device__ __forceinline__ void phase_final(const Ctx& C, int gw, int NGW, int lane) {
    const float* mod = (const float*)(C.ws + WS_MOD) + (size_t)(DEPTH - 1) * 17 * 6144;
    const bf16_t* XR = (const bf16_t*)(C.ws + WS_X32); const unsigned char* YP = (const unsigned char*)(C.ws + WS_YP);
    for (int r = gw; r < NB * SEQ; r += NGW) {
        const int b = r / SEQ, t = r - b * SEQ; const size_t m = (size_t)b * TPB + CTX + t;
        const u32x2* xr = (const u32x2*)(XR + m * DM) + lane; const unsigned* y0 = (const unsigned*)(YP + m * 2 * DM) + lane; const unsigned* y1 = y0 + DM / 4;
        const f32x4* g2 = (const f32x4*)(mod + (size_t)b * 6144 + 5 * DM) + lane; f32x4* o = (f32x4*)(C.out + (size_t)r * DM) + lane;
        unsigned a[4], bb[4]; u32x2 x[4];
#pragma unroll
        for (int j = 0; j < 4; ++j) { x[j] = xr[64 * j]; a[j] = y0[64 * j]; bb[j] = y1[64 * j]; }
#pragma unroll
        for (int j = 0; j < 4; ++j) o[64 * j] = bf4(x[j]) + (g2[64 * j] * YP_INV) * (fp8x4_f32(a[j]) + fp8x4_f32(bb[j]));
    }
}

#ifndef R3OFF
#define R3OFF 0
#endif
#ifndef WINOFF
#define WINOFF 0
#endif
#ifndef PHMASK
#define PHMASK 0xFFFF
#endif
#ifndef MK_ONE_LAUNCH
#define MK_ONE_LAUNCH 1
#endif
constexpr int PH_PER_LAYER = 9, PH_LAYER0 = 2, PH_FINAL = PH_LAYER0 + DEPTH * PH_PER_LAYER, PH_COUNT = PH_FINAL + 1;
struct Args { const float* in[18]; float* out; unsigned char* ws; int ph_lo, ph_hi, flags, pad; };
__global__ void __launch_bounds__(512, 2) mega_fwd(Args args) {
    extern __shared__ __attribute__((aligned(16))) unsigned char lds_raw[];
    LAS unsigned char* lds = (LAS unsigned char*)lds_raw;
    Ctx C; C.out = args.out; C.ws = args.ws;
    const int tid = threadIdx.x, lane = tid & 63, wave = __builtin_amdgcn_readfirstlane(tid >> 6);
    const int G = gridDim.x; const int bx = blockIdx.x; const int vcu = (G % 8 == 0) ? (bx % 8) * (G / 8) + bx / 8 : bx;
    const int gw = vcu * 8 + wave, NGW = G * 8;
    volatile LAS unsigned* MISC = (volatile LAS unsigned*)(lds + LDSCTL_OFF);
    for (int u = tid; u < (LDS_BYTES - LDSCTL_OFF) / 4; u += 512) ((LAS unsigned*)(lds + LDSCTL_OFF))[u] = 0u;
    __syncthreads();
    const int lo = args.ph_lo, hi = args.ph_hi;
    XcdBarrier bar; bar.bar = (unsigned*)(C.ws + WS_CTL) + CW_BAR; bar.x = 0; bar.st = nullptr;
    if (hi - lo > 1) bar = xcd_barrier_post((unsigned*)(C.ws + WS_CTL) + CW_BAR, MISC);
#define IN(k) (lo <= (k) && (k) < hi)
#define PHASE_IDS() int bx_ = bx, wave_ = wave; LAS unsigned char* lds_ = lds; asm volatile("" : "+s"(bx_), "+s"(wave_), "+s"(lds_)); int lane_; asm volatile("v_mbcnt_lo_u32_b32 %0, -1, 0\n\tv_mbcnt_hi_u32_b32 %0, -1, %0" : "=v"(lane_)); const int tid_ = wave_ * 64 + lane_; \
    const int vcu_ = (G % 8 == 0) ? (bx_ % 8) * (G / 8) + bx_ / 8 : bx_; const int gw_ = vcu_ * 8 + wave_; (void)lane_; (void)gw_; (void)vcu_
#define SEAM(k) do { if (IN(k) && IN((k) + 1)) xcd_barrier(bar); } while (0)

    if (IN(0) && (PHMASK & 1)) { PHASE_IDS(); phase_prologue(C, lds_, G, vcu_, bx_, tid_); } SEAM(0);
    if (IN(1) && (PHMASK & 2)) { PHASE_IDS(); phase_modsum(C, G, bx_, tid_, vcu_, lds_); } SEAM(1);
#ifdef EXTRA_BARS
    if (hi - lo > 1) for (int eb = 0; eb < EXTRA_BARS; ++eb) xcd_barrier(bar);
#endif

#ifdef LAYER_UNROLL
#pragma unroll
#else
#pragma nounroll
#endif
    for (int layer = 0; layer < DEPTH; ++layer) {
        const int p0 = PH_LAYER0 + layer * PH_PER_LAYER;
        if (IN(p0 + 0) && (PHMASK & 4)) { PHASE_IDS();
            if (layer > 0 && !(args.flags & 16)) {
                const unsigned* gc = (const unsigned*)(C.ws + WS_CTL) + CW_CNT + 64 * (layer - 1);
                int nblk = ((int)__hip_atomic_load(gc + (lane_ & 15), __ATOMIC_RELAXED, __HIP_MEMORY_SCOPE_AGENT) + 255) >> 8;
                nblk += __builtin_bit_cast(int, xor1(__builtin_bit_cast(float, nblk))); nblk += __builtin_bit_cast(int, xor2(__builtin_bit_cast(float, nblk)));
                nblk += __builtin_bit_cast(int, swz_xor4(__builtin_bit_cast(float, nblk))); nblk += __builtin_bit_cast(int, swz_xor8(__builtin_bit_cast(float, nblk)));
                convert_rest(C, layer, G, vcu_, lds_, wave_, lane_, nblk * 8, nblk * 4); }
            phase_norm1(C, layer, gw_, NGW, lane_, (args.flags & 16) ? (bf16_t*)(C.ws + WS_Y) : (bf16_t*)(C.ws + WS_X32)); } SEAM(p0 + 0);
        if (IN(p0 + 1) && (PHMASK & 8)) {
            pg8::Gemm g{(const bf16_t*)(C.ws + WS_H), (const bf16_t*)(C.ws + WS_WIN + (size_t)layer * DIN * DM), MROWS, DIN, DM};
            PHASE_IDS(); pg8::StaticOrder S; S.init(MROWS, DIN, G, bx_);
            pg8::EpiBf16Q E{(bf16_t*)(C.ws + WS_P), DIN, (const float*)(C.ws + WS_HS), __builtin_bit_cast(float, ((const unsigned*)(C.ws + WS_CTL))[CW_WSC + 17 * layer]), {}};
            pg8::gemm_phase<pg8::EpiBf16Q, pg8::StaticOrder, true, 2>(lds_, g, S, E, tid_);
            if (layer + 1 < DEPTH && !args.flags) convert_tail(C, layer + 1, 0, (MROWS / 256) * (DIN / 256), G, bx_, lds_, wave_, lane_);
        } SEAM(p0 + 1);
        if (IN(p0 + 2) && (PHMASK & 16)) {
            PHASE_IDS(); if (!(args.flags & 1)) phase_qkprep(C, layer, gw_, NGW, lane_, (args.flags & 8) ? (bf16_t*)(C.ws + WS_Y) : (bf16_t*)(C.ws + WS_P));
            if (!(args.flags & 8)) ret_r1_all(C, layer, bx_, G, lds_, tid_);
        } SEAM(p0 + 2);
        if (IN(p0 + 3) && (PHMASK & 32)) {
            PHASE_IDS(); for (int u = bx_; u < 512; u += G) ret_r2_unit(C, layer, u, tid_);
            attn_units<false>(C, layer, G, vcu_, bx_, tid_, (char*)lds_);
        } SEAM(p0 + 3);
        if (IN(p0 + 4) && (PHMASK & 64)) {
            PHASE_IDS();
            if (!WINOFF && !(args.flags & 32)) attn_units<true>(C, layer, G, vcu_, bx_, tid_, (char*)lds_);
            if (!R3OFF && !(args.flags & 64))
            ret_r3_all(C, layer, bx_, G, lds_, tid_);
        } SEAM(p0 + 4);
        if (IN(p0 + 5) && (PHMASK & 128)) {
            pg8::Gemm g{(const bf16_t*)(C.ws + WS_Y), (const bf16_t*)(C.ws + WS_WOUT) + (size_t)layer * DM * DM, MROWS, DM, DM};
            PHASE_IDS(); pg8::StaticOrder S; S.init(MROWS, DM, G, bx_, layer == DEPTH - 1);
            pg8::EpiResid E{(bf16_t*)(C.ws + ((args.flags & 4) ? WS_P : WS_X32)), (const float*)(C.ws + WS_MOD) + (size_t)layer * 17 * 6144 + 2 * DM};
            pg8::gemm_phase<pg8::EpiResid, pg8::StaticOrder, true>(lds_, g, S, E, tid_);
            if (layer + 1 < DEPTH && !args.flags) convert_tail(C, layer + 1, 1, (MROWS / 256) * (DM / 256), G, bx_, lds_, wave_, lane_);
        } SEAM(p0 + 5);
        if (IN(p0 + 6) && (PHMASK & 256)) { PHASE_IDS(); phase_norm2_route(C, layer + ((args.flags & 2) ? 4 : 0), lds_, G, bx_, tid_, (args.flags & 128) != 0); } SEAM(p0 + 6);
        if (IN(p0 + 7) && (PHMASK & 512)) {
            PHASE_IDS(); LAS int* boff = (LAS int*)(lds_ + LDSCTL_OFF + 64); LAS int* mcnt = (LAS int*)(lds_ + LDSCTL_OFF + 192); moe_offsets(C, layer, boff, mcnt, tid_);
            pg8::Gemm g{(const bf16_t*)(C.ws + WS_H), (const bf16_t*)(C.ws + WS_WGU + (size_t)layer * NE * 2 * FF * DM), 0, 2 * FF, DM};
            MoeOrder<true, 8> S{(const int*)(C.ws + WS_LIST), boff, mcnt, G, bx_};
            EpiGateUp E{(unsigned char*)(C.ws + WS_P), (const float*)(C.ws + WS_GW), (const float*)(C.ws + WS_CTL) + CW_WSC + 17 * layer, boff};
            pg8::gemm_phase<EpiGateUp, MoeOrder<true, 8>, true, 2>(lds_, g, S, E, tid_);
            if (layer + 1 < DEPTH && !args.flags) convert_tail(C, layer + 1, 2, boff[16] * 8, G, bx_, lds_, wave_, lane_);
        } SEAM(p0 + 7);
        if (IN(p0 + 8) && (PHMASK & 1024)) {
            PHASE_IDS(); LAS int* boff = (LAS int*)(lds_ + LDSCTL_OFF + 64); LAS int* mcnt = (LAS int*)(lds_ + LDSCTL_OFF + 192); moe_offsets(C, layer, boff, mcnt, tid_);
            pg8::Gemm g{(const bf16_t*)(C.ws + WS_P), (const bf16_t*)(C.ws + WS_WDN + (size_t)layer * NE * DM * FF), 0, DM, FF};
            MoeOrder<false, 4> S{(const int*)(C.ws + WS_LIST), boff, mcnt, G, bx_};
            EpiDown E{(unsigned char*)(C.ws + WS_YP), (const int*)(C.ws + WS_LIST), boff, mcnt, {}};
            pg8::gemm_phase<EpiDown, MoeOrder<false, 4>, true, 1>(lds_, g, S, E, tid_);
            if (layer + 1 < DEPTH && !args.flags) convert_tail(C, layer + 1, 3, boff[16] * 4, G, bx_, lds_, wave_, lane_);
        } SEAM(p0 + 8);
    }
    if (IN(PH_FINAL) && (PHMASK & 2048)) { PHASE_IDS(); phase_final(C, gw_, NGW, lane_); }
#undef IN
#undef SEAM
}

extern "C" void kernel_launch(void* const* d_in, const int* in_sizes, int n_in, void* d_out, int out_size, void* d_ws, size_t ws_size, hipStream_t stream) {
    static int grid = 0;
    if (grid == 0) {
        if (n_in != 18 || in_sizes[0] != NB * SEQ * DM || out_size != NB * SEQ * DM || ws_size < WS_END) {
            fprintf(stderr, "kernel_launch: unexpected shapes (n_in %d, in0 %d, out %d, ws %zu, need %zu); nothing launched\n", n_in, n_in > 0 ? in_sizes[0] : -1, out_size, ws_size, (size_t)WS_END); grid = -1; return; }
        int dev = 0, cus = 0, per_cu = 0;
        if (hipGetDevice(&dev) != hipSuccess || hipDeviceGetAttribute(&cus, hipDeviceAttributeMultiprocessorCount, dev) != hipSuccess) { grid = -1; return; }
        if (hipFuncSetAttribute((const void*)mega_fwd, hipFuncAttributeMaxDynamicSharedMemorySize, LDS_BYTES) != hipSuccess) { fprintf(stderr, "kernel_launch: hipFuncSetAttribute failed\n"); grid = -1; return; }
        if (hipOccupancyMaxActiveBlocksPerMultiprocessor(&per_cu, (const void*)mega_fwd, 512, LDS_BYTES) != hipSuccess || per_cu < 1) fprintf(stderr, "kernel_launch: occupancy query says %d\n", per_cu);
        (void)hipGetLastError();
        grid = cus;
    }
    if (grid < 0) return;
    if (hipMemsetAsync((char*)d_ws + WS_CTL, 0, CTL_BYTES, stream) != hipSuccess) return;
    Args a{};
    for (int i = 0; i < 18; ++i) a.in[i] = (const float*)d_in[i];
    a.out = (float*)d_out; a.ws = (unsigned char*)d_ws;
#if MK_ONE_LAUNCH
    a.ph_lo = 0; a.ph_hi = PH_COUNT;
    hipLaunchKernelGGL(mega_fwd, dim3(grid), dim3(512), LDS_BYTES, stream, a);
#else
    for (int p = 0; p < PH_COUNT; ++p) { a.ph_lo = p; a.ph_hi = p + 1;
#if !defined(PROBE_P) || !PROBE_BEFORE
        hipLaunchKernelGGL(mega_fwd, dim3(grid), dim3(512), LDS_BYTES, stream, a);
#endif
#ifdef PROBE_P
        const bool hit = (PROBE_P < 2) ? (p == PROBE_P) : (p >= PH_LAYER0 && p < PH_FINAL && (p - PH_LAYER0) % PH_PER_LAYER == PROBE_P - 2 && (!PROBE_L0 || p < PH_LAYER0 + PH_PER_LAYER));
        if (hit) { a.flags = PROBE_FLAGS; for (int r = 0; r < PROBE_REP; ++r) hipLaunchKernelGGL(mega_fwd, dim3(grid), dim3(512), LDS_BYTES, stream, a); a.flags = 0; }
#if PROBE_BEFORE
        hipLaunchKernelGGL(mega_fwd, dim3(grid), dim3(512), LDS_BYTES, stream, a);
#endif
#endif
    }
#endif
}
```
